# Optimizing an MI355X kernel written in HIP

```python
import jax, jax.numpy as jnp
from jax import lax
import numpy as np

D_MODEL = 4096
BATCH = 2
SEQ = 4096
DEPTH = 2

HEAD_DIM = 128
ROT_DIM = HEAD_DIM // 4
ROPE_THETA = 500000.0
N_HEADS_OUT = D_MODEL // HEAD_DIM
N_HEADS_B_GROUP = N_HEADS_OUT // 4
N_HEADS_A = N_HEADS_OUT - N_HEADS_B_GROUP
B_PATTERNS = ((128, 1), (512, 4), (2048, 16))
N_HEADS_B = N_HEADS_B_GROUP * len(B_PATTERNS)
QKV_COLS = 3 * (N_HEADS_A + N_HEADS_B) * HEAD_DIM
MOBA_BLOCK = 256
MOBA_TOPK = 3
MOBA_QCHUNK = 16
DWIN_BLOCK = 128
GMLP_CHUNK = 128
GMLP_WIDTH = D_MODEL
GMLP_GROUP_DIM = 128
GMLP_GROUPS = GMLP_WIDTH // GMLP_GROUP_DIM
D_FF = 7 * D_MODEL // 2
CONV_WIDTH = 3
NORM_EPS = 1e-5
N_EVEN = (DEPTH + 1) // 2
N_ODD = DEPTH // 2

kernel_name = "hybrid_moba_dilated_gmlp_convffn"

F32 = jnp.float32


def rms_norm(x, g):
    xf = x.astype(F32)
    y = xf * lax.rsqrt(jnp.mean(xf * xf, axis=-1, keepdims=True) + NORM_EPS)
    return (y * g.astype(F32)).astype(x.dtype)


def layer_norm(x, g, b):
    xf = x.astype(F32)
    mu = jnp.mean(xf, axis=-1, keepdims=True)
    xc = xf - mu
    y = xc * lax.rsqrt(jnp.mean(xc * xc, axis=-1, keepdims=True) + NORM_EPS)
    return (y * g.astype(F32) + b.astype(F32)).astype(x.dtype)


def partial_rotary(x, positions):
    half = ROT_DIM // 2
    inv_freq = jnp.power(ROPE_THETA, -jnp.arange(half, dtype=F32) * (2.0 / ROT_DIM))
    ang = positions.astype(F32)[:, None, :, None] * inv_freq
    cos, sin = jnp.cos(ang), jnp.sin(ang)
    xr = x[..., :ROT_DIM].astype(F32)
    x1, x2 = xr[..., :half], xr[..., half:]
    rot = jnp.concatenate([x1 * cos - x2 * sin, x2 * cos + x1 * sin], axis=-1).astype(x.dtype)
    return jnp.concatenate([rot, x[..., ROT_DIM:]], axis=-1)


def moba_attention(q, k, v):
    bsz, nh, s, dh = q.shape
    blk, cq = MOBA_BLOCK, MOBA_QCHUNK
    nb = -(-s // blk)
    sp = nb * blk
    pad = ((0, 0), (0, 0), (0, sp - s), (0, 0))
    bh = bsz * nh
    qf = jnp.pad(q, pad).reshape(bh, sp, dh)
    kf = jnp.pad(k, pad).reshape(bh, sp, dh)
    vf = jnp.pad(v, pad).reshape(bh, sp, dh)
    kb = kf.reshape(bh, nb, blk, dh)
    vb = vf.reshape(bh, nb, blk, dh)
    kmean = jnp.mean(kb.astype(F32), axis=2)
    gate = jnp.einsum('zsd,znd->zsn', qf.astype(F32), kmean)
    qblk = jnp.arange(sp) // blk
    past = jnp.arange(nb)[None, :] < qblk[:, None]
    gate = jnp.where(past[None], gate, -jnp.inf)
    kk = min(MOBA_TOPK, nb)
    _, sel = lax.top_k(gate, kk)
    sel_valid = jnp.arange(kk)[None, :] < qblk[:, None]
    nc = sp // cq
    qc = qf.reshape(bh, nc, cq, dh).transpose(1, 0, 2, 3)
    selc = sel.reshape(bh, nc, cq, kk).transpose(1, 0, 2, 3)
    validc = sel_valid.reshape(nc, cq, kk)
    starts = jnp.arange(nc, dtype=jnp.int32) * cq
    scale = dh ** -0.5

    def one_chunk(args):
        qi, si, vi, t0 = args
        gk = jax.vmap(lambda kz, iz: kz[iz])(kb, si)
        gv = jax.vmap(lambda vz, iz: vz[iz])(vb, si)
        s_sel = jnp.einsum('zcd,zcnjd->zcnj', qi, gk, preferred_element_type=F32) * scale
        s_sel = jnp.where(vi[None, :, :, None], s_sel, -jnp.inf).reshape(bh, cq, kk * blk)
        b0 = (t0 // blk) * blk
        ko = lax.dynamic_slice_in_dim(kf, b0, blk, axis=1)
        vo = lax.dynamic_slice_in_dim(vf, b0, blk, axis=1)
        s_own = jnp.einsum('zcd,zjd->zcj', qi, ko, preferred_element_type=F32) * scale
        causal = (b0 + jnp.arange(blk))[None, :] <= (t0 + jnp.arange(cq))[:, None]
        s_own = jnp.where(causal[None], s_own, -jnp.inf)
        p = jax.nn.softmax(jnp.concatenate([s_sel, s_own], axis=-1), axis=-1).astype(vf.dtype)
        out = jnp.einsum('zcm,zcmd->zcd', p[..., :kk * blk], gv.reshape(bh, cq, kk * blk, dh))
        return out + jnp.einsum('zcj,zjd->zcd', p[..., kk * blk:], vo)

    out = lax.map(one_chunk, (qc, selc, validc, starts))
    out = out.transpose(1, 0, 2, 3).reshape(bh, sp, dh)[:, :s]
    return out.reshape(bsz, nh, s, dh)


def dilated_window_attention(q, k, v, window, dilation):
    bsz, nh, s, dh = q.shape
    n_back = window // dilation
    blk = DWIN_BLOCK
    sub = s // dilation
    nblk = -(-sub // blk)
    lp = nblk * blk

    def to_blocks(t):
        t = t.reshape(bsz, nh, sub, dilation, dh).swapaxes(2, 3)
        t = jnp.pad(t, ((0, 0), (0, 0), (0, 0), (0, lp - sub), (0, 0)))
        return t.reshape(bsz, nh, dilation, nblk, blk, dh)

    def band(t):
        prev = jnp.pad(t, ((0, 0), (0, 0), (0, 0), (1, 0), (0, 0), (0, 0)))[:, :, :, :nblk]
        return jnp.concatenate([prev, t], axis=4)

    qb = to_blocks(q)
    kband = band(to_blocks(k))
    vband = band(to_blocks(v))
    scores = jnp.einsum('bhrnid,bhrnjd->bhrnij', qb, kband, preferred_element_type=F32) * (dh ** -0.5)
    qi = jnp.arange(blk)[:, None]
    kj = jnp.arange(2 * blk)[None, :]
    dist = blk + qi - kj
    in_band = (dist >= 0) & (dist <= n_back)
    not_pad = (jnp.arange(nblk)[:, None, None] > 0) | (kj >= blk)[None]
    mask = in_band[None] & not_pad
    scores = jnp.where(mask, scores, -jnp.inf)
    lse = jax.nn.logsumexp(scores, axis=-1)
    p = jnp.exp(scores - lse[..., None]).astype(v.dtype)
    out = jnp.einsum('bhrnij,bhrnjd->bhrnid', p, vband)
    out = out.reshape(bsz, nh, dilation, lp, dh)[:, :, :, :sub].swapaxes(2, 3).reshape(bsz, nh, s, dh)
    lse = lse.reshape(bsz, nh, dilation, lp)[..., :sub].swapaxes(2, 3).reshape(bsz, nh, s)
    return out, lse


def dilated_mixture(q, k, v):
    outs, lses = [], []
    for g, (window, dilation) in enumerate(B_PATTERNS):
        sl = slice(g * N_HEADS_B_GROUP, (g + 1) * N_HEADS_B_GROUP)
        o, l = dilated_window_attention(q[:, sl], k[:, sl], v[:, sl], window, dilation)
        outs.append(o)
        lses.append(l)
    w = jax.nn.softmax(jnp.stack(lses, axis=0), axis=0)
    return jnp.einsum('gbhs,gbhsd->bhsd', w.astype(q.dtype), jnp.stack(outs, axis=0))


def hybrid_attention_block(x, positions, norm_g, w_in, w_out):
    bsz, s, _ = x.shape
    h = rms_norm(x, norm_g)
    proj = (h @ w_in).reshape(bsz, s, 3, N_HEADS_A + N_HEADS_B, HEAD_DIM)
    proj = proj.transpose(2, 0, 3, 1, 4)
    q = partial_rotary(proj[0], positions)
    k = partial_rotary(proj[1], positions)
    v = proj[2]
    oa = moba_attention(q[:, :N_HEADS_A], k[:, :N_HEADS_A], v[:, :N_HEADS_A])
    ob = dilated_mixture(q[:, N_HEADS_A:], k[:, N_HEADS_A:], v[:, N_HEADS_A:])
    o = jnp.concatenate([oa, ob], axis=1).transpose(0, 2, 1, 3).reshape(bsz, s, N_HEADS_OUT * HEAD_DIM)
    return x + o @ w_out


def spatial_gating_block(x, norm_g, w_in, b_in, v_gain, v_bias, w_s, b_s, w_out):
    bsz, s, _ = x.shape
    nc = s // GMLP_CHUNK
    h = rms_norm(x, norm_g)
    z = jax.nn.gelu(h @ w_in + b_in, approximate=False)
    u, v = jnp.split(z, 2, axis=-1)
    v = layer_norm(v, v_gain, v_bias).reshape(bsz, nc, GMLP_CHUNK, GMLP_GROUPS, GMLP_GROUP_DIM)
    w_causal = jnp.tril(w_s)
    f = jnp.einsum('gts,bcsgd->bctgd', w_causal, v) + b_s.T[None, None, :, :, None]
    out = u * f.reshape(bsz, s, GMLP_WIDTH)
    return x + out @ w_out


def conv_ffn_block(x, norm_g, w_up, conv_w, conv_b, w_down):
    s = x.shape[1]
    h = rms_norm(x, norm_g)
    a = h @ w_up
    ap = jnp.pad(a, ((0, 0), (CONV_WIDTH - 1, 0), (0, 0)))
    c = conv_b + ap[:, 0:s] * conv_w[0]
    for j in range(1, CONV_WIDTH):
        c = c + ap[:, j:j + s] * conv_w[j]
    gate, up = jnp.split(c, 2, axis=-1)
    return x + (jax.nn.silu(gate) * up) @ w_down


def setup_inputs(seed: int = 0) -> dict:
    key = jax.random.key(seed)
    ks = jax.random.split(key, 24)

    def nrm(k, shape, scale):
        return jax.random.normal(k, shape, F32) * scale

    d, e, f2 = D_MODEL, GMLP_WIDTH, 2 * D_FF
    return {
        "x": nrm(ks[0], (BATCH, SEQ, d), 1.0),
        "positions": jnp.broadcast_to(jnp.arange(SEQ, dtype=jnp.int32), (BATCH, SEQ)),
        "attn_norm": 1.0 + nrm(ks[1], (N_EVEN, d), 0.02),
        "attn_w_in": nrm(ks[2], (N_EVEN, d, QKV_COLS), d ** -0.5),
        "attn_w_out": nrm(ks[3], (N_EVEN, N_HEADS_OUT * HEAD_DIM, d), (N_HEADS_OUT * HEAD_DIM) ** -0.5),
        "sg_norm": 1.0 + nrm(ks[4], (N_ODD, d), 0.02),
        "sg_w_in": nrm(ks[5], (N_ODD, d, 2 * e), d ** -0.5),
        "sg_b_in": nrm(ks[6], (N_ODD, 2 * e), 0.02),
        "sg_v_gain": 1.0 + nrm(ks[7], (N_ODD, e), 0.02),
        "sg_v_bias": nrm(ks[8], (N_ODD, e), 0.02),
        "sg_w_s": nrm(ks[9], (N_ODD, GMLP_GROUPS, GMLP_CHUNK, GMLP_CHUNK), GMLP_CHUNK ** -0.5),
        "sg_b_s": 1.0 + nrm(ks[10], (N_ODD, GMLP_GROUPS, GMLP_CHUNK), 0.02),
        "sg_w_out": nrm(ks[11], (N_ODD, e, d), e ** -0.5),
        "ffn_norm": 1.0 + nrm(ks[12], (DEPTH, d), 0.02),
        "ffn_w_up": nrm(ks[13], (DEPTH, d, f2), d ** -0.5),
        "ffn_conv_w": nrm(ks[14], (DEPTH, CONV_WIDTH, f2), CONV_WIDTH ** -0.5),
        "ffn_conv_b": nrm(ks[15], (DEPTH, f2), 0.02),
        "ffn_w_down": nrm(ks[16], (DEPTH, D_FF, d), D_FF ** -0.5),
        "final_norm": 1.0 + nrm(ks[17], (d,), 0.02),
    }


def reference(x, positions, attn_norm, attn_w_in, attn_w_out, sg_norm, sg_w_in, sg_b_in,
              sg_v_gain, sg_v_bias, sg_w_s, sg_b_s, sg_w_out, ffn_norm, ffn_w_up,
              ffn_conv_w, ffn_conv_b, ffn_w_down, final_norm):
    h = x
    for layer in range(DEPTH):
        i = layer // 2
        if layer % 2 == 0:
            h = hybrid_attention_block(h, positions, attn_norm[i], attn_w_in[i], attn_w_out[i])
        else:
            h = spatial_gating_block(h, sg_norm[i], sg_w_in[i], sg_b_in[i], sg_v_gain[i],
                                     sg_v_bias[i], sg_w_s[i], sg_b_s[i], sg_w_out[i])
        h = conv_ffn_block(h, ffn_norm[layer], ffn_w_up[layer], ffn_conv_w[layer],
                           ffn_conv_b[layer], ffn_w_down[layer])
    return rms_norm(h, final_norm)
```

```cpp
#include <hip/hip_runtime.h>
#include <cstdio>
#include <cstdint>
#ifndef MK_N_LAUNCHES
#define MK_N_LAUNCHES 15
#endif
namespace pg8 {
#define PG8_LAS __attribute__((address_space(3)))
typedef unsigned short bf16_t;
typedef short bf16x8 __attribute__((ext_vector_type(8)));
typedef float f32x4 __attribute__((ext_vector_type(4)));
typedef unsigned u32x4 __attribute__((ext_vector_type(4)));
constexpr int BM = 256, BK = 64, HALF = 128, HTB = HALF * BK * 2  , STAGE_BYTES = 8 * HTB, NXCD = 8, WGM = 8;

__host__ __device__ __forceinline__ int lds_byte(int r, int c) { const int st = (r >> 4) * 2 + (c >> 5), rr = r & 15, cc = c & 31, ob = rr * 64 + cc * 2; return st * 1024 + (ob ^ (((ob >> 9) & 1) << 5)); }
__host__ __device__ __forceinline__ void stage_rc(int b, int& R, int& C) { const int st = b / 1024, sb = b % 1024, swz = sb ^ (((sb >> 9) & 1) << 5); R = (st >> 1) * 16 + swz / 64; C = (st & 1) * 32 + (swz % 64) / 2; }
__host__ __device__ __forceinline__ int perm32(int rho) { const int n = rho >> 4, i = rho & 15; return 8 * (i >> 2) + 4 * n + (i & 3); }

struct Unit { int pm, pn; };
struct Gemm { const bf16_t* A; const bf16_t* Bt; int M, N, K; };

struct StaticOrder {
    int nM, nN, nwg, G, c;
    __host__ __device__ void init(int M, int N, int G_, int c_) { nM = M / BM; nN = N / BM; nwg = nM * nN; G = G_; c = c_; }
    __host__ __device__ bool next(int i, Unit& u) const {
        const long L = (long)i * G + c; if (L >= nwg) return false;
        int wgid = (int)L; { const int q = nwg / NXCD, r = nwg % NXCD, xcd = wgid % NXCD, off = wgid / NXCD; wgid = (xcd < r ? xcd * (q + 1) : r * (q + 1) + (xcd - r) * q) + off; }
        const int nig = WGM * nN, gid = wgid / nig, fm = gid * WGM, gsz = (nM - fm) < WGM ? (nM - fm) : WGM;
        u.pm = fm + ((wgid % nig) % gsz); u.pn = (wgid % nig) / gsz; return true;
    }
    __device__ __forceinline__ void a_ready(const Unit&) const {}
    __device__ __forceinline__ void done(const Unit&) const {}
};
__device__ __forceinline__ unsigned cvt_pk_bf16(float lo, float hi) { unsigned r; asm volatile("v_cvt_pk_bf16_f32 %0, %1, %2" : "=v"(r) : "v"(lo), "v"(hi)); return r; }
typedef float f32x2 __attribute__((ext_vector_type(2)));
__device__ __forceinline__ f32x2 gelu_pk(f32x2 v) {
    const f32x2 av = __builtin_elementwise_abs(v), d = av * 0.2316418882f + 1.0f;
    f32x2 t; t.x = __builtin_amdgcn_rcpf(d.x); t.y = __builtin_amdgcn_rcpf(d.y);
    f32x2 q = t * 0.5307027145f + (-0.7265760135f); q = q * t + 0.7107068705f; q = q * t + (-0.142248368f); q = q * t + 0.127414796f; q = q * t;
    const f32x2 s = (v * v) * (-0.72134752044f);
    f32x2 e; e.x = __builtin_amdgcn_exp2f(s.x); e.y = __builtin_amdgcn_exp2f(s.y);
    const f32x2 m = v * (q * e), r = v - m;
    f32x2 o; o.x = v.x < 0.f ? m.x : r.x; o.y = v.y < 0.f ? m.y : r.y; return o;
}
typedef unsigned u32x2 __attribute__((ext_vector_type(2)));
constexpr int SSP = 64;
__device__ __forceinline__ float rstd_from_ss(const float* ss, int r) {
    const f32x4* p = (const f32x4*)(ss + (size_t)r * SSP);
    float s = 0.f;
#pragma unroll
    for (int i = 0; i < SSP / 4; ++i) { const f32x4 v = p[i]; s += (v[0] + v[1]) + (v[2] + v[3]); }
    return 1.0f / sqrtf(s * (1.0f / 4096.0f) + 1e-5f);
}

struct EpiQKV {
    static constexpr bool PERM = false, AFTER_DRAIN = false;
    bf16_t* qkv; const float* ss; const float* ropec; const float* ropes;
    __device__ __forceinline__ void operator()(const f32x4 (&acc)[2][2][4][2], const Unit& u, int wr, int wc, int fr, int fq) const {
        const int row0 = u.pm * BM + wr * 64 + fr;
#pragma unroll
        for (int ai = 0; ai < 2; ++ai)
#pragma unroll
            for (int m = 0; m < 4; ++m) {
                const int r = row0 + ai * HALF + m * 16;
                const float rs = rstd_from_ss(ss, r);
                const int b = r >> 12, s = r & 4095;
                f32x4 cs = (f32x4){1.f, 1.f, 1.f, 1.f}, sn = (f32x4){0.f, 0.f, 0.f, 0.f};
                if (wc == 0) { cs = *(const f32x4*)(ropec + (size_t)r * 16 + 4 * fq); sn = *(const f32x4*)(ropes + (size_t)r * 16 + 4 * fq); }
#pragma unroll
                for (int bj = 0; bj < 2; ++bj) {
                    const int colh = 2 * u.pn + bj, which = colh / 48, head = colh - which * 48;
                    bf16_t* dst = qkv + ((size_t)((which * 2 + b) * 48 + head) * 4096 + s) * 128 + wc * 32 + 4 * fq;
                    f32x4 v0 = acc[ai][bj][m][0] * rs, v1 = acc[ai][bj][m][1] * rs;
                    if (which < 2 && wc == 0) { const f32x4 n0 = v0 * cs - v1 * sn, n1 = v1 * cs + v0 * sn; v0 = n0; v1 = n1; }
                    u32x2 w0, w1; w0.x = cvt_pk_bf16(v0[0], v0[1]); w0.y = cvt_pk_bf16(v0[2], v0[3]); w1.x = cvt_pk_bf16(v1[0], v1[1]); w1.y = cvt_pk_bf16(v1[2], v1[3]);
                    *(u32x2*)(dst) = w0; *(u32x2*)(dst + 16) = w1;
                }
                asm volatile("" ::: "memory");
            }
    }
};

struct EpiRes {
    static constexpr bool PERM = false, AFTER_DRAIN = false;
    const float* hin; float* hout; bf16_t* xb; float* ss;
    __device__ __forceinline__ void operator()(const f32x4 (&acc)[2][2][4][2], const Unit& u, int wr, int wc, int fr, int fq) const {
        const int row0 = u.pm * BM + wr * 64 + fr, col0 = u.pn * BM + wc * 32 + 4 * fq;
#pragma unroll
        for (int ai = 0; ai < 2; ++ai)
#pragma unroll
            for (int m = 0; m < 4; ++m) {
                const int r = row0 + ai * HALF + m * 16; const size_t off = (size_t)r * 4096 + col0;
                float sq = 0.f;
#pragma unroll
                for (int bj = 0; bj < 2; ++bj)
#pragma unroll
                    for (int n = 0; n < 2; ++n) {
                        const f32x4 h = *(const f32x4*)(hin + off + bj * HALF + n * 16) + acc[ai][bj][m][n];
                        *(f32x4*)(hout + off + bj * HALF + n * 16) = h;
                        u32x2 w; w.x = cvt_pk_bf16(h[0], h[1]); w.y = cvt_pk_bf16(h[2], h[3]);
                        *(u32x2*)(xb + off + bj * HALF + n * 16) = w;
                        sq += (h[0] * h[0] + h[1] * h[1]) + (h[2] * h[2] + h[3] * h[3]);
                    }
                sq += __shfl_xor(sq, 16); sq += __shfl_xor(sq, 32);
                if (fq == 0) ss[(size_t)r * SSP + u.pn * 4 + wc] = sq;
                asm volatile("" ::: "memory");
            }
    }
};

struct EpiUpPre {
    static constexpr bool PERM = true, AFTER_DRAIN = false;
    bf16_t* apre; const float* ss;
    __device__ __forceinline__ void operator()(const f32x4 (&acc)[2][2][4][2], const Unit& u, int wr, int wc, int fr, int fq) const {
        const int row0 = u.pm * BM + wr * 64 + fr, col0 = u.pn * 128 + wc * 32 + 8 * fq;
#pragma unroll
        for (int ai = 0; ai < 2; ++ai)
#pragma unroll
            for (int m = 0; m < 4; ++m) {
                const int r = row0 + ai * HALF + m * 16;
                const float rs = rstd_from_ss(ss, r);
                bf16_t* rowp = apre + (size_t)r * 28672 + col0;
#pragma unroll
                for (int bj = 0; bj < 2; ++bj) {
                    const f32x4 v0 = acc[ai][bj][m][0] * rs, v1 = acc[ai][bj][m][1] * rs;
                    u32x4 w; w.x = cvt_pk_bf16(v0[0], v0[1]); w.y = cvt_pk_bf16(v0[2], v0[3]); w.z = cvt_pk_bf16(v1[0], v1[1]); w.w = cvt_pk_bf16(v1[2], v1[3]);
                    *(u32x4*)(rowp + bj * 14336) = w;
                }
                asm volatile("" ::: "memory");
            }
    }
};

struct EpiSgIn {
    static constexpr bool PERM = true, AFTER_DRAIN = false;
    bf16_t* U; bf16_t* V; const float* ss; const float* bias; float* vs;
    __device__ __forceinline__ void operator()(const f32x4 (&acc)[2][2][4][2], const Unit& u, int wr, int wc, int fr, int fq) const {
        const int row0 = u.pm * BM + wr * 64 + fr, gcol0 = u.pn * BM + wc * 32 + 8 * fq;
        const bool isv = u.pn >= 16;
        bf16_t* base = isv ? V : U; const int col0 = isv ? gcol0 - 4096 : gcol0;
        f32x4 bv[2][2];
#pragma unroll
        for (int bj = 0; bj < 2; ++bj)
#pragma unroll
            for (int n = 0; n < 2; ++n) bv[bj][n] = *(const f32x4*)(bias + gcol0 + bj * HALF + 4 * n);
#pragma unroll
        for (int ai = 0; ai < 2; ++ai)
#pragma unroll
            for (int m = 0; m < 4; ++m) {
                const int r = row0 + ai * HALF + m * 16;
                const float rs = rstd_from_ss(ss, r);
                bf16_t* rowp = base + (size_t)r * 4096 + col0;
                float s1 = 0.f, s2 = 0.f;
#pragma unroll
                for (int bj = 0; bj < 2; ++bj) {
                    f32x4 v0 = acc[ai][bj][m][0] * rs + bv[bj][0], v1 = acc[ai][bj][m][1] * rs + bv[bj][1];
                    const f32x2 a = gelu_pk((f32x2){v0[0], v0[1]}), b = gelu_pk((f32x2){v0[2], v0[3]}), c = gelu_pk((f32x2){v1[0], v1[1]}), d = gelu_pk((f32x2){v1[2], v1[3]});
                    s1 += (a.x + a.y) + (b.x + b.y) + (c.x + c.y) + (d.x + d.y);
                    s2 += (a.x * a.x + a.y * a.y) + (b.x * b.x + b.y * b.y) + (c.x * c.x + c.y * c.y) + (d.x * d.x + d.y * d.y);
                    u32x4 w; w.x = cvt_pk_bf16(a.x, a.y); w.y = cvt_pk_bf16(b.x, b.y); w.z = cvt_pk_bf16(c.x, c.y); w.w = cvt_pk_bf16(d.x, d.y);
                    *(u32x4*)(rowp + bj * HALF) = w;
                }
                if (isv) {
                    s1 += __shfl_xor(s1, 16); s1 += __shfl_xor(s1, 32); s2 += __shfl_xor(s2, 16); s2 += __shfl_xor(s2, 32);
                    if (fq == 0) *(f32x2*)(vs + ((size_t)r * 64 + (u.pn - 16) * 4 + wc) * 2) = (f32x2){s1, s2};
                }
                asm volatile("" ::: "memory");
            }
    }
};
template <class Epi, class Sched, bool ALIGN_EPI = false, bool SP2 = false>
__device__ __forceinline__ void gemm_phase(PG8_LAS unsigned char* lds, const Gemm g, const Sched& S, const Epi& E) {
    const int tid = threadIdx.x, wid = __builtin_amdgcn_readfirstlane(tid >> 6), lane = tid & 63, wr = wid >> 2, wc = wid & 3, fr = lane & 15, fq = lane >> 4;
    const int K = g.K, nt = K / BK;
    unsigned voffA[2], voffB[2];
#pragma unroll
    for (int i = 0; i < 2; ++i) { int R, C; stage_rc(tid * 16 + i * 8192, R, C); const int Rb = Epi::PERM ? ((R & ~31) + perm32(R & 31)) : R;
        voffA[i] = (unsigned)(R * K + C) * 2u; voffB[i] = (unsigned)(Rb * K + C) * 2u; }
    const size_t kstep = (size_t)(BK * 2);
    const size_t hstep = (size_t)HALF * K * 2;
    const size_t tstep = 2 * hstep;
    const unsigned ldsw = (unsigned)wid * 1024u;
    const int aoff = lds_byte(wr * 64 + fr, fq * 8), boff = lds_byte(wc * 32 + fr, fq * 8);
#define PG8_SA(b, h) (((b) * 2 + (h)) * HTB)
#define PG8_SB(b, h) ((4 + (b) * 2 + (h)) * HTB)
#define PG8_STAGE(bufoff, gbase, voff) do { _Pragma("unroll") for (int _i = 0; _i < 2; ++_i) \
        __builtin_amdgcn_global_load_lds((const unsigned*)((const char*)(gbase) + (voff)[_i]), (PG8_LAS unsigned*)(lds + (bufoff) + ldsw + _i * 8192), 16, 0, 0); } while (0)
#define PG8_LDA(dst, b, h) do { _Pragma("unroll") for (int m = 0; m < 4; ++m) _Pragma("unroll") for (int k = 0; k < 2; ++k) dst[m][k] = *(const PG8_LAS bf16x8*)(lds + PG8_SA(b, h) + aoff + m * 2048 + k * 1024); } while (0)
#define PG8_LDB(dst, b, h) do { _Pragma("unroll") for (int n = 0; n < 2; ++n) _Pragma("unroll") for (int k = 0; k < 2; ++k) dst[n][k] = *(const PG8_LAS bf16x8*)(lds + PG8_SB(b, h) + boff + n * 2048 + k * 1024); } while (0)
#define PG8_MMA(ai, bj, At, Bt) do { __builtin_amdgcn_s_setprio(1); _Pragma("unroll") for (int m = 0; m < 4; ++m) _Pragma("unroll") for (int n = 0; n < 2; ++n) _Pragma("unroll") for (int k = 0; k < 2; ++k) \
        acc[ai][bj][m][n] = __builtin_amdgcn_mfma_f32_16x16x32_bf16(Bt[n][k], At[m][k], acc[ai][bj][m][n], 0, 0, 0); __builtin_amdgcn_s_setprio(0); } while (0)
#define PG8_WAIT_V(n) asm volatile("s_waitcnt vmcnt(" #n ")" ::: "memory")
#define PG8_WAIT_L(n) asm volatile("s_waitcnt lgkmcnt(" #n ")" ::: "memory")
#define PG8_BAR __builtin_amdgcn_s_barrier()
#define PG8_SCHED __builtin_amdgcn_sched_barrier(0)
    Unit cur, nxt; int ui = 0;
    if (!S.next(0, cur)) return;
    f32x4 acc[2][2][4][2];
#pragma unroll
    for (int a = 0; a < 2; ++a)
#pragma unroll
        for (int b = 0; b < 2; ++b)
#pragma unroll
            for (int m = 0; m < 4; ++m)
#pragma unroll
                for (int n = 0; n < 2; ++n) acc[a][b][m][n] = (f32x4){0.f, 0.f, 0.f, 0.f};
    bf16x8 At[4][2], B0[2][2], B1[2][2];
    const char* cA = (const char*)g.A + (size_t)cur.pm * tstep; const char* cB = (const char*)g.Bt + (size_t)cur.pn * tstep;
    S.a_ready(cur);
    if constexpr (SP2) {
        PG8_STAGE(PG8_SB(0, 0), cB, voffB); PG8_STAGE(PG8_SB(0, 1), cB + hstep, voffB); PG8_STAGE(PG8_SA(0, 0), cA, voffA); PG8_STAGE(PG8_SA(0, 1), cA + hstep, voffA);
        if (wr == 1) PG8_BAR;
        PG8_WAIT_V(2); PG8_BAR;
        PG8_STAGE(PG8_SB(1, 0), cB + kstep, voffB); PG8_STAGE(PG8_SA(1, 0), cA + kstep, voffA); PG8_STAGE(PG8_SB(1, 1), cB + hstep + kstep, voffB);
        PG8_WAIT_V(6); PG8_BAR;
    } else {
        PG8_STAGE(PG8_SB(0, 0), cB, voffB); PG8_STAGE(PG8_SA(0, 0), cA, voffA); PG8_STAGE(PG8_SB(0, 1), cB + hstep, voffB); PG8_STAGE(PG8_SA(0, 1), cA + hstep, voffA);
        if (wr == 1) PG8_BAR;
        PG8_WAIT_V(4); PG8_BAR;
        PG8_STAGE(PG8_SB(1, 0), cB + kstep, voffB); PG8_STAGE(PG8_SA(1, 0), cA + kstep, voffA); PG8_STAGE(PG8_SB(1, 1), cB + hstep + kstep, voffB);
        PG8_WAIT_V(6); PG8_BAR;
    }
    for (;;) {
        const bool has_next = S.next(ui + 1, nxt);
        const char* nA = has_next ? (const char*)g.A + (size_t)nxt.pm * tstep : cA; const char* nB = has_next ? (const char*)g.Bt + (size_t)nxt.pn * tstep : cB;
        for (int t = 0; t < nt; t += 2) {
            const bool last = (t == nt - 2);
            const char* a1 = cA + (size_t)(t + 1) * kstep;
            const char* a2 = last ? nA : cA + (size_t)(t + 2) * kstep; const char* b2 = last ? nB : cB + (size_t)(t + 2) * kstep;
            const char* a3 = a2 + kstep; const char* b3 = b2 + kstep;
            if (last && has_next) S.a_ready(nxt);
            if constexpr (SP2) {
            PG8_LDB(B0, 0, 0); PG8_LDB(B1, 0, 1); PG8_SCHED; PG8_LDA(At, 0, 0); PG8_STAGE(PG8_SA(1, 1), a1 + hstep, voffA);
            PG8_WAIT_V(8); PG8_WAIT_L(0); PG8_BAR; PG8_MMA(0, 0, At, B0); PG8_MMA(0, 1, At, B1); PG8_BAR; PG8_SCHED;
            PG8_LDA(At, 0, 1); PG8_STAGE(PG8_SB(0, 0), b2, voffB); PG8_STAGE(PG8_SB(0, 1), b2 + hstep, voffB); PG8_STAGE(PG8_SA(0, 0), a2, voffA);
            PG8_WAIT_V(8); PG8_WAIT_L(0); PG8_BAR; PG8_MMA(1, 0, At, B0); PG8_MMA(1, 1, At, B1); PG8_BAR; PG8_SCHED;
            PG8_LDB(B0, 1, 0); PG8_LDB(B1, 1, 1); PG8_SCHED; PG8_LDA(At, 1, 0); PG8_STAGE(PG8_SA(0, 1), a2 + hstep, voffA);
            PG8_WAIT_V(8); PG8_WAIT_L(0); PG8_BAR; PG8_MMA(0, 0, At, B0); PG8_MMA(0, 1, At, B1); PG8_BAR; PG8_SCHED;
            PG8_LDA(At, 1, 1); PG8_STAGE(PG8_SB(1, 0), b3, voffB); PG8_STAGE(PG8_SB(1, 1), b3 + hstep, voffB); PG8_STAGE(PG8_SA(1, 0), a3, voffA);
            PG8_WAIT_V(8); PG8_WAIT_L(0); PG8_BAR; PG8_MMA(1, 0, At, B0); PG8_MMA(1, 1, At, B1); PG8_BAR; PG8_SCHED;
            } else {
            PG8_LDB(B0, 0, 0); PG8_SCHED; PG8_LDA(At, 0, 0); PG8_STAGE(PG8_SA(1, 1), a1 + hstep, voffA);
            PG8_WAIT_L(8); PG8_BAR; PG8_WAIT_L(0); PG8_MMA(0, 0, At, B0); PG8_BAR; PG8_SCHED;
            PG8_LDB(B1, 0, 1); PG8_STAGE(PG8_SB(0, 0), b2, voffB);
            PG8_BAR; PG8_WAIT_L(0); PG8_MMA(0, 1, At, B1); PG8_BAR;
            PG8_LDA(At, 0, 1); PG8_STAGE(PG8_SA(0, 0), a2, voffA);
            PG8_BAR; PG8_WAIT_L(0); PG8_MMA(1, 0, At, B0); PG8_BAR; PG8_SCHED;
            PG8_STAGE(PG8_SB(0, 1), b2 + hstep, voffB);
            PG8_WAIT_V(6); PG8_BAR; PG8_MMA(1, 1, At, B1); PG8_BAR;
            PG8_LDB(B0, 1, 0); PG8_SCHED; PG8_LDA(At, 1, 0); PG8_STAGE(PG8_SA(0, 1), a2 + hstep, voffA);
            PG8_WAIT_L(8); PG8_BAR; PG8_WAIT_L(0); PG8_MMA(0, 0, At, B0); PG8_BAR; PG8_SCHED;
            PG8_LDB(B1, 1, 1); PG8_STAGE(PG8_SB(1, 0), b3, voffB);
            PG8_BAR; PG8_WAIT_L(0); PG8_MMA(0, 1, At, B1); PG8_BAR;
            PG8_LDA(At, 1, 1); PG8_STAGE(PG8_SA(1, 0), a3, voffA);
            PG8_BAR; PG8_WAIT_L(0); PG8_MMA(1, 0, At, B0); PG8_BAR; PG8_SCHED;
            PG8_STAGE(PG8_SB(1, 1), b3 + hstep, voffB);
            PG8_WAIT_V(6); PG8_BAR; PG8_MMA(1, 1, At, B1); PG8_BAR;
            }
        }
        if constexpr (ALIGN_EPI) { if (wr == 0) PG8_BAR; }
        if constexpr (!Epi::AFTER_DRAIN) { E(acc, cur, wr, wc, fr, fq); S.done(cur); }
        if (!has_next) break;
#pragma unroll
        for (int a = 0; a < 2; ++a)
#pragma unroll
            for (int b = 0; b < 2; ++b)
#pragma unroll
                for (int m = 0; m < 4; ++m)
#pragma unroll
                    for (int n = 0; n < 2; ++n) acc[a][b][m][n] = (f32x4){0.f, 0.f, 0.f, 0.f};
        cur = nxt; cA = nA; cB = nB; ++ui;
        if constexpr (ALIGN_EPI) { if (wr == 1) PG8_BAR; }
    }
    PG8_WAIT_V(0);
    if constexpr (!ALIGN_EPI) { if (wr == 0) PG8_BAR; }
    PG8_BAR;
    if constexpr (Epi::AFTER_DRAIN) { E.fused(acc, cur, wr, wc, fr, fq, lds, wid, lane); S.done(cur); }
#undef PG8_SA
#undef PG8_SB
#undef PG8_STAGE
#undef PG8_LDA
#undef PG8_LDB
#undef PG8_MMA
#undef PG8_WAIT_V
#undef PG8_WAIT_L
#undef PG8_BAR
#undef PG8_SCHED
}
}
#ifndef PG8_SP2
#define PG8_SP2 true
#endif
#ifndef PG8_ALIGN
#define PG8_ALIGN true
#endif
constexpr int NWAVES = 8;
constexpr int NB = 2, NS = 4096, DM = 4096, MR = NB * NS;
constexpr int NHQ = 48, NHA = 24, HD = 128, QKVC = 3 * NHQ * HD;
constexpr int DFF = 14336, F2 = 2 * DFF;
constexpr float ATT_SCALE = 0.08838834764831845f;
constexpr float NORM_EPS = 1e-5f;
constexpr size_t MiB = 1u << 20;
constexpr size_t WS_CTL = 0, CTL_ZERO_BYTES = 1 * MiB;
constexpr size_t WS_ROPE = 1 * MiB;
constexpr size_t WS_KMEAN = 2 * MiB;
constexpr size_t WS_SS = 3 * MiB, SS_SITE = 2 * MiB;
constexpr size_t WS_VS = 13 * MiB;
constexpr size_t WS_WIN = 32 * MiB;
constexpr size_t WS_WOUT = 176 * MiB;
constexpr size_t WS_SGWIN = 208 * MiB;
constexpr size_t WS_SGWOUT = 272 * MiB;
constexpr size_t WS_WUP = 304 * MiB, WUP_L = 224 * MiB;
constexpr size_t WS_WDOWN = 752 * MiB, WDOWN_L = 112 * MiB;
constexpr size_t WS_XB = 976 * MiB;
constexpr size_t WS_H = 1040 * MiB;
constexpr size_t WS_QKV = 1168 * MiB;
constexpr size_t WS_U = WS_QKV, WS_V = WS_QKV + 64 * MiB;
constexpr size_t WS_O = 1456 * MiB;
constexpr size_t WS_G = 1520 * MiB;
constexpr size_t WS_APRE = 1744 * MiB;
constexpr size_t WS_END = 2192 * MiB;
constexpr int RING_OFF = 0, RING_BYTES = 131072;
constexpr int LDSCTL_OFF = RING_BYTES, MISC_OFF = LDSCTL_OFF + 320;
constexpr int XTRA_OFF = RING_BYTES + 1024;
constexpr int LDS_BYTES = 147456;
static_assert(MISC_OFF + 128 <= XTRA_OFF, "LDS map");
constexpr int CW_TMO = 0, CW_BAR = 4096;

#define GAS __attribute__((address_space(1)))
#define LAS __attribute__((address_space(3)))
typedef unsigned short bf16;
typedef unsigned v4u __attribute__((ext_vector_type(4)));
typedef unsigned v2u __attribute__((ext_vector_type(2)));
typedef float f32x4 __attribute__((ext_vector_type(4)));
typedef float f32x2 __attribute__((ext_vector_type(2)));
#define LDS_WAIT() asm volatile("s_waitcnt lgkmcnt(0)" ::: "memory")
#define VM_WAIT() asm volatile("s_waitcnt vmcnt(0)" ::: "memory")
__device__ __forceinline__ unsigned f2bf(float f) { unsigned u = __builtin_bit_cast(unsigned, f); return (u + 0x7fffu + ((u >> 16) & 1u)) >> 16; }
__device__ __forceinline__ unsigned pk2(float lo, float hi) { return f2bf(lo) | (f2bf(hi) << 16); }
__device__ __forceinline__ float bflo(unsigned w) { return __builtin_bit_cast(float, w << 16); }
__device__ __forceinline__ float bfhi(unsigned w) { return __builtin_bit_cast(float, w & 0xffff0000u); }
__device__ __forceinline__ float bf1(bf16 h) { return __builtin_bit_cast(float, (unsigned)h << 16); }
#define XB_TMO      128
#define XB_XCNT(j)  (256  + 64 * (j))
#define XB_XSUB(j)  (1280 + 64 * (j))
#define XB_XGEN(j)  (2304 + 64 * (j))
#define XB_TOP      3328
#define XB_TOPGEN   3392
#define XCD_BAR_WORDS 3456
#define XB_SPIN_CAP (1u << 18)

__device__ __forceinline__ unsigned xb_ld(unsigned* p)              { return __hip_atomic_load(p, __ATOMIC_RELAXED, __HIP_MEMORY_SCOPE_AGENT); }
__device__ __forceinline__ unsigned xb_add(unsigned* p, unsigned v) { return __hip_atomic_fetch_add(p, v, __ATOMIC_RELAXED, __HIP_MEMORY_SCOPE_AGENT); }
__device__ __forceinline__ unsigned xb_xcc_id() { return (unsigned)__builtin_amdgcn_s_getreg((3 << 11) | 20) & 0xFu; }
#define XB_SPIN(cond, bar) do { unsigned _sp = 0; while (cond) { __builtin_amdgcn_s_sleep(1); \
    if ((++_sp & 255u) == 0u) { if (xb_ld(&(bar)[XB_TMO])) break; if (_sp > XB_SPIN_CAP) { atomicAdd(&(bar)[XB_TMO], 1u); break; } } } } while (0)

struct XcdBarrier {
    unsigned* bar; unsigned x;
    volatile LAS unsigned* st;
};

__device__ __forceinline__ XcdBarrier xcd_barrier_post(unsigned* bar, volatile LAS unsigned* st) {
    XcdBarrier b; b.bar = bar; b.x = xb_xcc_id(); b.st = st;
    if (threadIdx.x == 0) (void)xb_add(&bar[XB_XCNT(b.x)], 1u);
    return b;
}
__device__ __forceinline__ void xcd_barrier_complete(unsigned* bar, unsigned x, unsigned& nloc, unsigned& nx) {
    const unsigned G = gridDim.x * gridDim.y * gridDim.z;
    unsigned sum, cnt, mine, sp = 0u;
    for (;;) {
        sum = 0u; cnt = 0u; mine = 0u;
#pragma unroll
        for (unsigned j = 0; j < 16; ++j) { const unsigned c = xb_ld(&bar[XB_XCNT(j)]); sum += c; cnt += (c > 0u) ? 1u : 0u; mine = (j == x) ? c : mine; }
        if (sum == G) break;
        __builtin_amdgcn_s_sleep(1);
        if ((++sp & 255u) == 0u) { if (xb_ld(&bar[XB_TMO])) break; if (sp > XB_SPIN_CAP) { atomicAdd(&bar[XB_TMO], 1u); break; } }
    }
    nloc = mine > 0u ? mine : 1u; nx = cnt > 0u ? cnt : 1u;
}

__device__ __forceinline__ void xcd_barrier(const XcdBarrier& b) {
    asm volatile("s_waitcnt vmcnt(0)" ::: "memory");
    __syncthreads();
    if (threadIdx.x == 0) {
        unsigned* bar = b.bar;
        __builtin_amdgcn_s_waitcnt(0);
        unsigned nloc = b.st[0], nx = b.st[1];
        if (nloc == 0u) { xcd_barrier_complete(bar, b.x, nloc, nx); b.st[0] = nloc; b.st[1] = nx; }
        const unsigned old = xb_add(&bar[XB_XSUB(b.x)], 1u);
        const unsigned gen = old / nloc;
        if (old + 1u == (gen + 1u) * nloc) {
            __builtin_amdgcn_fence(__ATOMIC_RELEASE, "agent");
            asm volatile("s_waitcnt vmcnt(0)" ::: "memory");
            const unsigned og = xb_add(&bar[XB_TOP], 1u);
            const unsigned tg = og / nx;
            if (og + 1u == (tg + 1u) * nx) xb_add(&bar[XB_TOPGEN], 1u);
            else XB_SPIN(xb_ld(&bar[XB_TOPGEN]) == tg, bar);
            __builtin_amdgcn_fence(__ATOMIC_ACQUIRE, "agent");
            xb_add(&bar[XB_XGEN(b.x)], 1u);
            asm volatile("s_waitcnt vmcnt(0)" ::: "memory");
        } else {
            XB_SPIN(xb_ld(&bar[XB_XGEN(b.x)]) == gen, bar);
            __builtin_amdgcn_fence(__ATOMIC_ACQUIRE, "agent");
            asm volatile("s_waitcnt vmcnt(0)" ::: "memory");
        }
    }
    __syncthreads();
}
struct Frame {
    LAS unsigned char* lds;
    volatile LAS unsigned* MISC;
    unsigned* ctl;
    int tid, lane, wave, G, gw, NGW;
    unsigned char* ws;
    const float* x; const int* pos;
    const float *attn_norm, *attn_w_in, *attn_w_out, *sg_norm, *sg_w_in, *sg_b_in, *sg_v_gain, *sg_v_bias, *sg_w_s, *sg_b_s, *sg_w_out, *ffn_norm, *ffn_w_up, *ffn_conv_w, *ffn_conv_b, *ffn_w_down, *final_norm;
    float* out;
};
__device__ __forceinline__ float wave_sum(float v) {
#pragma unroll
    for (int o = 1; o < 64; o <<= 1) v += __shfl_xor(v, o);
    return v;
}
__device__ __forceinline__ float wave_max(float v) {
#pragma unroll
    for (int o = 1; o < 64; o <<= 1) v = fmaxf(v, __shfl_xor(v, o));
    return v;
}
__device__ __forceinline__ float ss_rstd(const float* ss, int r) { return pg8::rstd_from_ss(ss, r); }

struct MapId { __device__ __forceinline__ int operator()(int n) const { return n; } };
struct MapUp { __device__ __forceinline__ int operator()(int n) const { return n < DFF ? ((n >> 7) << 8) + (n & 127) : (((n - DFF) >> 7) << 8) + 128 + ((n - DFF) & 127); } };
template <class RowMap>
__device__ __forceinline__ void transpose_item(const float* W, int K, int N, const float* gain, bf16* WT, RowMap rm, LAS float* scr, int item, int lane) {
    const int nblk = N / 32, kb = item / nblk, nb = item - kb * nblk, k0 = 64 * kb, n0 = 32 * nb;
#pragma unroll 8
    for (int i = 0; i < 32; ++i) { const int kk = 2 * i + (lane >> 5); float v = W[(size_t)(k0 + kk) * N + n0 + (lane & 31)]; if (gain) v *= gain[k0 + kk]; scr[kk * 33 + (lane & 31)] = v; }
    LDS_WAIT(); asm volatile("" ::: "memory");
    const int c = lane & 7;
#pragma unroll
    for (int j = 0; j < 4; ++j) { const int n = (lane >> 3) + 8 * j; const LAS float* s = scr + (8 * c) * 33 + n;
        v4u o; o.x = pk2(s[0 * 33], s[1 * 33]); o.y = pk2(s[2 * 33], s[3 * 33]); o.z = pk2(s[4 * 33], s[5 * 33]); o.w = pk2(s[6 * 33], s[7 * 33]);
        *(v4u*)(WT + (size_t)rm(n0 + n) * K + k0 + 8 * c) = o; }
    LDS_WAIT(); asm volatile("" ::: "memory");
}
__device__ __forceinline__ void sincos_d(double a, double& sn, double& cs) {
    const double n = __builtin_rint(a * 0.15915494309189535);
    const double r = a - n * 6.283185307179586;
    const double r2 = r * r;
    double ts = r, tc = 1.0, s = r, c = 1.0;
#pragma unroll
    for (int k = 1; k <= 15; ++k) { tc = -tc * r2 / (double)((2 * k - 1) * (2 * k)); ts = -ts * r2 / (double)((2 * k) * (2 * k + 1)); c += tc; s += ts; }
    sn = s; cs = c;
}
__device__ __forceinline__ void p0_prologue(Frame& F) {
    LAS float* scr = (LAS float*)(F.lds + RING_OFF + F.wave * 16384);
    constexpr int I_WIN = 64 * (QKVC / 32), I_SQ = 64 * (DM / 32), I_SGIN = 64 * (2 * DM / 32), I_UP = 64 * (F2 / 32), I_DN = (DFF / 64) * (DM / 32);
    constexpr int NITEMS = I_WIN + 2 * I_SQ + I_SGIN + 2 * I_UP + 2 * I_DN;
    for (int it = F.gw; it < NITEMS; it += F.NGW) {
        int r = it;
        if (r < I_WIN) { transpose_item(F.attn_w_in, DM, QKVC, F.attn_norm, (bf16*)(F.ws + WS_WIN), MapId(), scr, r, F.lane); continue; } r -= I_WIN;
        if (r < I_SQ) { transpose_item(F.attn_w_out, DM, DM, nullptr, (bf16*)(F.ws + WS_WOUT), MapId(), scr, r, F.lane); continue; } r -= I_SQ;
        if (r < I_SGIN) { transpose_item(F.sg_w_in, DM, 2 * DM, F.sg_norm, (bf16*)(F.ws + WS_SGWIN), MapId(), scr, r, F.lane); continue; } r -= I_SGIN;
        if (r < I_SQ) { transpose_item(F.sg_w_out, DM, DM, nullptr, (bf16*)(F.ws + WS_SGWOUT), MapId(), scr, r, F.lane); continue; } r -= I_SQ;
        if (r < I_UP) { transpose_item(F.ffn_w_up, DM, F2, F.ffn_norm, (bf16*)(F.ws + WS_WUP), MapUp(), scr, r, F.lane); continue; } r -= I_UP;
        if (r < I_UP) { transpose_item(F.ffn_w_up + (size_t)DM * F2, DM, F2, F.ffn_norm + DM, (bf16*)(F.ws + WS_WUP + WUP_L), MapUp(), scr, r, F.lane); continue; } r -= I_UP;
        if (r < I_DN) { transpose_item(F.ffn_w_down, DFF, DM, nullptr, (bf16*)(F.ws + WS_WDOWN), MapId(), scr, r, F.lane); continue; } r -= I_DN;
        transpose_item(F.ffn_w_down + (size_t)DFF * DM, DFF, DM, nullptr, (bf16*)(F.ws + WS_WDOWN + WDOWN_L), MapId(), scr, r, F.lane);
    }
    bf16* XB = (bf16*)(F.ws + WS_XB); float* SS0 = (float*)(F.ws + WS_SS);
    for (int m = F.gw; m < MR; m += F.NGW) {
        const f32x4* xr = (const f32x4*)(F.x + (size_t)m * DM) + F.lane;
        v2u* o8 = (v2u*)(XB + (size_t)m * DM) + F.lane;
        float sq = 0.f;
#pragma unroll
        for (int j = 0; j < 16; ++j) { const f32x4 v = xr[64 * j]; sq += (v[0] * v[0] + v[1] * v[1]) + (v[2] * v[2] + v[3] * v[3]); v2u w; w.x = pk2(v[0], v[1]); w.y = pk2(v[2], v[3]); o8[64 * j] = w; }
        sq = wave_sum(sq);
        SS0[(size_t)m * 64 + F.lane] = F.lane == 0 ? sq : 0.f;
    }
    float* rc = (float*)(F.ws + WS_ROPE); float* rs = rc + MR * 16;
    for (int idx = F.gw * 64 + F.lane; idx < MR * 16; idx += F.NGW * 64) {
        const int r = idx >> 4, i = idx & 15;
        double invd = 1.0;
        for (int k = 0; k < i; ++k) invd *= 0.44036660267178046;
        const float inv = (float)invd;
        const float ang = (float)F.pos[r] * inv;
        double sn, cs; sincos_d((double)ang, sn, cs);
        rc[idx] = (float)cs; rs[idx] = (float)sn;
    }
}

__device__ __forceinline__ void p_kmean(Frame& F) {
    const bf16* QKV = (const bf16*)(F.ws + WS_QKV); float* KM = (float*)(F.ws + WS_KMEAN);
    LAS float* red = (LAS float*)(F.lds + RING_OFF);
    for (int item = blockIdx.x; item < NB * NHA * 16; item += F.G) {
        const int j = item & 15, bh = item >> 4, b = bh / NHA, h = bh - b * NHA;
        const bf16* kb = QKV + ((size_t)((1 * 2 + b) * NHQ + h) * NS + 256 * j) * HD;
        const int d = F.tid & 127, part = F.tid >> 7;
        float s = 0.f;
        for (int i = 0; i < 64; ++i) s += bf1(kb[(size_t)(part * 64 + i) * HD + d]);
        red[part * 128 + d] = s;
        __syncthreads();
        if (F.tid < 128) KM[(size_t)item * 128 + F.tid] = (red[F.tid] + red[128 + F.tid] + red[256 + F.tid] + red[384 + F.tid]) * (1.0f / 256.0f);
        __syncthreads();
    }
}

__device__ __forceinline__ float dot128(const LAS float* qs, const bf16* krow) {
    float s = 0.f;
#pragma unroll 4
    for (int c = 0; c < 16; ++c) {
        const v4u kv = *(const v4u*)(krow + 8 * c); const LAS float* q8 = qs + 8 * c;
        s += q8[0] * bflo(kv.x) + q8[1] * bfhi(kv.x) + q8[2] * bflo(kv.y) + q8[3] * bfhi(kv.y) + q8[4] * bflo(kv.z) + q8[5] * bfhi(kv.z) + q8[6] * bflo(kv.w) + q8[7] * bfhi(kv.w);
    }
    return s;
}
__device__ __forceinline__ void p_attn_naive(Frame& F) {
    const bf16* QKV = (const bf16*)(F.ws + WS_QKV); const float* KM = (const float*)(F.ws + WS_KMEAN); bf16* O = (bf16*)(F.ws + WS_O);
    LAS float* qs = (LAS float*)(F.lds + RING_OFF + F.wave * 8192);
    LAS float* ps = qs + 128;
    const int lane = F.lane;
    constexpr int NMOBA = NB * NHA * NS, NDIL = NB * 8 * NS;
    const float NEG = -__builtin_inff();
    for (int task = F.gw; task < NMOBA + NDIL; task += F.NGW) {
        if (task < NMOBA) {
            const int b = task / (NHA * NS), rem = task - b * (NHA * NS), h = rem >> 12, t = rem & 4095;
            const bf16* qrow = QKV + ((size_t)((0 * 2 + b) * NHQ + h) * NS + t) * HD;
            const bf16* Kb = QKV + (size_t)((1 * 2 + b) * NHQ + h) * NS * HD;
            const bf16* Vb = QKV + (size_t)((2 * 2 + b) * NHQ + h) * NS * HD;
            { const unsigned w = *(const unsigned*)(qrow + 2 * lane); qs[2 * lane] = bflo(w); qs[2 * lane + 1] = bfhi(w); }
            LDS_WAIT(); asm volatile("" ::: "memory");
            const int qb = t >> 8, tin = t & 255;
            float g = NEG;
            if (lane < qb) { const float* km = KM + ((size_t)((b * NHA + h) * 16 + lane)) * 128; float s = 0.f; for (int d = 0; d < 128; ++d) s += qs[d] * km[d]; g = s; }
            unsigned selmask = 0u;
            if (qb <= 3) selmask = (1u << qb) - 1u;
            else {
#pragma unroll
                for (int rd = 0; rd < 3; ++rd) {
                    float best = g; int bi = lane;
#pragma unroll
                    for (int o = 1; o < 64; o <<= 1) { const float ob = __shfl_xor(best, o); const int oi = __shfl_xor(bi, o); if (ob > best || (ob == best && oi < bi)) { best = ob; bi = oi; } }
                    selmask |= 1u << bi; if (lane == bi) g = NEG;
                }
            }
            float sc[4][4]; int jsel[3];
            unsigned mk = selmask;
#pragma unroll
            for (int sl = 0; sl < 3; ++sl) {
                int j = -1; if (mk) { j = __builtin_ctz(mk); mk &= mk - 1u; }
                jsel[sl] = j;
#pragma unroll
                for (int c = 0; c < 4; ++c) sc[sl][c] = (j >= 0) ? ATT_SCALE * dot128(qs, Kb + (size_t)(256 * j + lane + 64 * c) * HD) : NEG;
            }
#pragma unroll
            for (int c = 0; c < 4; ++c) { const int i = lane + 64 * c; sc[3][c] = (i <= tin) ? ATT_SCALE * dot128(qs, Kb + (size_t)(256 * qb + i) * HD) : NEG; }
            float mx = NEG;
#pragma unroll
            for (int sl = 0; sl < 4; ++sl)
#pragma unroll
                for (int c = 0; c < 4; ++c) mx = fmaxf(mx, sc[sl][c]);
            mx = wave_max(mx);
            float sum = 0.f;
#pragma unroll
            for (int sl = 0; sl < 4; ++sl)
#pragma unroll
                for (int c = 0; c < 4; ++c) { sc[sl][c] = __expf(sc[sl][c] - mx); sum += sc[sl][c]; }
            sum = wave_sum(sum);
            const float inv = 1.0f / sum;
#pragma unroll
            for (int sl = 0; sl < 4; ++sl)
#pragma unroll
                for (int c = 0; c < 4; ++c) ps[sl * 256 + lane + 64 * c] = sc[sl][c] * inv;
            LDS_WAIT(); asm volatile("" ::: "memory");
            float o0 = 0.f, o1 = 0.f;
#pragma unroll
            for (int sl = 0; sl < 3; ++sl) {
                if (jsel[sl] >= 0) { const bf16* vb = Vb + (size_t)(256 * jsel[sl]) * HD + 2 * lane;
                    for (int i = 0; i < 256; ++i) { const float p = ps[sl * 256 + i]; const unsigned w = *(const unsigned*)(vb + (size_t)i * HD); o0 += p * bflo(w); o1 += p * bfhi(w); } }
            }
            { const bf16* vb = Vb + (size_t)(256 * qb) * HD + 2 * lane;
              for (int i = 0; i <= tin; ++i) { const float p = ps[3 * 256 + i]; const unsigned w = *(const unsigned*)(vb + (size_t)i * HD); o0 += p * bflo(w); o1 += p * bfhi(w); } }
            *(unsigned*)(O + (size_t)(b * NS + t) * DM + h * HD + 2 * lane) = pk2(o0, o1);
            LDS_WAIT(); asm volatile("" ::: "memory");
        } else {
            const int td = task - NMOBA, b = td / (8 * NS), rem = td - b * (8 * NS), hh = rem >> 12, t = rem & 4095;
            float lse[3], og0[3], og1[3];
#pragma unroll
            for (int g = 0; g < 3; ++g) {
                const int head = NHA + g * 8 + hh, dil = g == 0 ? 1 : (g == 1 ? 4 : 16);
                const bf16* qrow = QKV + ((size_t)((0 * 2 + b) * NHQ + head) * NS + t) * HD;
                const bf16* Kb = QKV + (size_t)((1 * 2 + b) * NHQ + head) * NS * HD;
                const bf16* Vb = QKV + (size_t)((2 * 2 + b) * NHQ + head) * NS * HD;
                { const unsigned w = *(const unsigned*)(qrow + 2 * lane); qs[2 * lane] = bflo(w); qs[2 * lane + 1] = bfhi(w); }
                LDS_WAIT(); asm volatile("" ::: "memory");
                float sc[3];
#pragma unroll
                for (int c = 0; c < 3; ++c) { const int m = lane + 64 * c; const int kp = t - m * dil; sc[c] = (m <= 128 && kp >= 0) ? ATT_SCALE * dot128(qs, Kb + (size_t)kp * HD) : NEG; }
                float mx = wave_max(fmaxf(fmaxf(sc[0], sc[1]), sc[2]));
                float e0 = __expf(sc[0] - mx), e1 = __expf(sc[1] - mx), e2 = __expf(sc[2] - mx);
                const float sum = wave_sum(e0 + e1 + e2), inv = 1.0f / sum;
                lse[g] = mx + __logf(sum);
                ps[lane] = e0 * inv; ps[lane + 64] = e1 * inv; if (lane == 0) ps[128] = e2 * inv;
                LDS_WAIT(); asm volatile("" ::: "memory");
                const int nb = t / dil, nk = (nb < 128 ? nb : 128) + 1;
                float o0 = 0.f, o1 = 0.f;
                for (int m = 0; m < nk; ++m) { const float p = ps[m]; const unsigned w = *(const unsigned*)(Vb + (size_t)(t - m * dil) * HD + 2 * lane); o0 += p * bflo(w); o1 += p * bfhi(w); }
                og0[g] = o0; og1[g] = o1;
                LDS_WAIT(); asm volatile("" ::: "memory");
            }
            const float ml = fmaxf(fmaxf(lse[0], lse[1]), lse[2]);
            const float w0 = __expf(lse[0] - ml), w1 = __expf(lse[1] - ml), w2 = __expf(lse[2] - ml), wi = 1.0f / (w0 + w1 + w2);
            const float r0 = (w0 * og0[0] + w1 * og0[1] + w2 * og0[2]) * wi, r1 = (w0 * og1[0] + w1 * og1[1] + w2 * og1[2]) * wi;
            *(unsigned*)(O + (size_t)(b * NS + t) * DM + (NHA + hh) * HD + 2 * lane) = pk2(r0, r1);
        }
    }
}

__device__ __forceinline__ float silu_f(float x) { return x / (1.0f + __expf(-x)); }
__device__ __forceinline__ void unpack8(const v4u w, float (&f)[8]) { f[0] = bflo(w.x); f[1] = bfhi(w.x); f[2] = bflo(w.y); f[3] = bfhi(w.y); f[4] = bflo(w.z); f[5] = bfhi(w.z); f[6] = bflo(w.w); f[7] = bfhi(w.w); }
__device__ __forceinline__ void p_conv(Frame& F, int layer) {
    const bf16* AP = (const bf16*)(F.ws + WS_APRE); bf16* Gb = (bf16*)(F.ws + WS_G);
    const float* cw = F.ffn_conv_w + (size_t)layer * 3 * F2; const float* cb = F.ffn_conv_b + (size_t)layer * F2;
    constexpr int C8 = DFF / 8;
    const size_t total = (size_t)MR * C8;
    for (size_t idx = (size_t)blockIdx.x * 512 + F.tid; idx < total; idx += (size_t)F.G * 512) {
        const int r = (int)(idx / C8), j0 = (int)(idx - (size_t)r * C8) * 8, s = r & 4095;
        float cg[8], cu[8];
#pragma unroll
        for (int e = 0; e < 8; ++e) { cg[e] = cb[j0 + e]; cu[e] = cb[DFF + j0 + e]; }
#pragma unroll
        for (int tp = 0; tp < 3; ++tp) {
            const int back = 2 - tp;
            if (s >= back) {
                float ag[8], au[8];
                unpack8(*(const v4u*)(AP + (size_t)(r - back) * F2 + j0), ag);
                unpack8(*(const v4u*)(AP + (size_t)(r - back) * F2 + DFF + j0), au);
#pragma unroll
                for (int e = 0; e < 8; ++e) { cg[e] += cw[(size_t)tp * F2 + j0 + e] * ag[e]; cu[e] += cw[(size_t)tp * F2 + DFF + j0 + e] * au[e]; }
            }
        }
        v4u o; o.x = pk2(silu_f(cg[0]) * cu[0], silu_f(cg[1]) * cu[1]); o.y = pk2(silu_f(cg[2]) * cu[2], silu_f(cg[3]) * cu[3]);
        o.z = pk2(silu_f(cg[4]) * cu[4], silu_f(cg[5]) * cu[5]); o.w = pk2(silu_f(cg[6]) * cu[6], silu_f(cg[7]) * cu[7]);
        *(v4u*)(Gb + (size_t)r * DFF + j0) = o;
    }
}

__device__ __forceinline__ void p_sgate_naive(Frame& F) {
    const bf16* U = (const bf16*)(F.ws + WS_U); const bf16* V = (const bf16*)(F.ws + WS_V); const float* VS = (const float*)(F.ws + WS_VS); bf16* GT = (bf16*)(F.ws + WS_O);
    LAS float* vn = (LAS float*)(F.lds + RING_OFF);
    LAS float* wsl = vn + 128 * 128;
    LAS float* rstat = (LAS float*)(F.lds + XTRA_OFF);
    for (int item = blockIdx.x; item < 64 * 32; item += F.G) {
        const int bc = item >> 5, g = item & 31, r0 = bc * 128;
        if (F.tid < 128) {
            const f32x4* p = (const f32x4*)(VS + (size_t)(r0 + F.tid) * 128);
            float s1 = 0.f, s2 = 0.f;
#pragma unroll 8
            for (int i = 0; i < 32; ++i) { const f32x4 v = p[i]; s1 += v[0] + v[2]; s2 += v[1] + v[3]; }
            const float mean = s1 * (1.0f / 4096.0f), var = s2 * (1.0f / 4096.0f) - mean * mean;
            rstat[2 * F.tid] = mean; rstat[2 * F.tid + 1] = 1.0f / sqrtf(var + NORM_EPS);
        }
        __syncthreads();
        for (int idx = F.tid; idx < 128 * 128; idx += 512) {
            const int s = idx >> 7, d = idx & 127, col = g * 128 + d;
            const float v = bf1(V[(size_t)(r0 + s) * DM + col]);
            vn[idx] = (v - rstat[2 * s]) * rstat[2 * s + 1] * F.sg_v_gain[col] + F.sg_v_bias[col];
            wsl[idx] = F.sg_w_s[(size_t)g * 16384 + idx];
        }
        __syncthreads();
        for (int idx = F.tid; idx < 128 * 128; idx += 512) {
            const int t = idx >> 7, d = idx & 127;
            float a = 0.f;
            for (int s = 0; s <= t; ++s) a += wsl[t * 128 + s] * vn[s * 128 + d];
            const float f = a + F.sg_b_s[g * 128 + t];
            const size_t o = (size_t)(r0 + t) * DM + g * 128 + d;
            GT[o] = (bf16)f2bf(bf1(U[o]) * f);
        }
        __syncthreads();
    }
}

__device__ __forceinline__ void p_final(Frame& F) {
    const float* H = (const float*)(F.ws + WS_H); const float* SS4 = (const float*)(F.ws + WS_SS + 4 * SS_SITE);
    for (int m = F.gw; m < MR; m += F.NGW) {
        const float rs = ss_rstd(SS4, m);
        const f32x4* hr = (const f32x4*)(H + (size_t)m * DM) + F.lane; const f32x4* gr = (const f32x4*)F.final_norm + F.lane;
        f32x4* orow = (f32x4*)(F.out + (size_t)m * DM) + F.lane;
#pragma unroll 4
        for (int j = 0; j < 16; ++j) orow[64 * j] = hr[64 * j] * rs * gr[64 * j];
    }
}
constexpr int N_PHASES = 15;
struct Args { const void* in[19]; float* out; unsigned char* ws; int ph_lo, ph_hi, li, pad; };
__global__ void __launch_bounds__(NWAVES * 64, 2) mk_fwd(Args args) {
    extern __shared__ __attribute__((aligned(16))) unsigned char lds[];
    Frame F;
    F.lds = (LAS unsigned char*)lds;
    F.MISC = (volatile LAS unsigned*)(F.lds + MISC_OFF);
    F.tid = threadIdx.x; F.lane = F.tid & 63; F.wave = __builtin_amdgcn_readfirstlane(F.tid >> 6);
    F.G = gridDim.x; F.gw = blockIdx.x * NWAVES + F.wave; F.NGW = F.G * NWAVES;
    F.ws = args.ws; F.ctl = (unsigned*)(args.ws + WS_CTL);
    F.x = (const float*)args.in[0]; F.pos = (const int*)args.in[1];
    F.attn_norm = (const float*)args.in[2]; F.attn_w_in = (const float*)args.in[3]; F.attn_w_out = (const float*)args.in[4];
    F.sg_norm = (const float*)args.in[5]; F.sg_w_in = (const float*)args.in[6]; F.sg_b_in = (const float*)args.in[7]; F.sg_v_gain = (const float*)args.in[8]; F.sg_v_bias = (const float*)args.in[9];
    F.sg_w_s = (const float*)args.in[10]; F.sg_b_s = (const float*)args.in[11]; F.sg_w_out = (const float*)args.in[12];
    F.ffn_norm = (const float*)args.in[13]; F.ffn_w_up = (const float*)args.in[14]; F.ffn_conv_w = (const float*)args.in[15]; F.ffn_conv_b = (const float*)args.in[16]; F.ffn_w_down = (const float*)args.in[17];
    F.final_norm = (const float*)args.in[18]; F.out = args.out;
    for (int u = F.tid; u < (XTRA_OFF - LDSCTL_OFF) / 4; u += NWAVES * 64) ((LAS unsigned*)(F.lds + LDSCTL_OFF))[u] = 0u;
    __syncthreads();
    const int lo = args.ph_lo, hi = args.ph_hi;
    XcdBarrier bar; bar.bar = F.ctl + CW_BAR + args.li * XCD_BAR_WORDS; bar.x = 0; bar.st = nullptr;
    if (hi - lo > 1) bar = xcd_barrier_post(F.ctl + CW_BAR + args.li * XCD_BAR_WORDS, F.MISC + 8);
#define IN(k) (lo <= (k) && (k) < hi)
#define SEAM(k) do { if (IN(k) && IN((k) + 1)) xcd_barrier(bar); } while (0)
    unsigned char* ws = args.ws;
    bf16* XB = (bf16*)(ws + WS_XB); float* H = (float*)(ws + WS_H); bf16* O = (bf16*)(ws + WS_O); bf16* Gb = (bf16*)(ws + WS_G); bf16* AP = (bf16*)(ws + WS_APRE);
    float* SS = (float*)(ws + WS_SS); constexpr size_t SSF = SS_SITE / 4;
    const int c = (int)blockIdx.x;

    if (IN(0)) { p0_prologue(F); } SEAM(0);
    if (IN(1)) {
        pg8::Gemm g{XB, (const bf16*)(ws + WS_WIN), MR, QKVC, DM}; pg8::StaticOrder S; S.init(MR, QKVC, F.G, c);
        pg8::EpiQKV E{(bf16*)(ws + WS_QKV), SS, (const float*)(ws + WS_ROPE), (const float*)(ws + WS_ROPE) + MR * 16};
        pg8::gemm_phase<pg8::EpiQKV, pg8::StaticOrder, PG8_ALIGN, PG8_SP2>(F.lds + RING_OFF, g, S, E);
    } SEAM(1);
    if (IN(2)) { p_kmean(F); } SEAM(2);
    if (IN(3)) { p_attn_naive(F); } SEAM(3);
    if (IN(4)) {
        pg8::Gemm g{O, (const bf16*)(ws + WS_WOUT), MR, DM, DM}; pg8::StaticOrder S; S.init(MR, DM, F.G, c);
        pg8::EpiRes E{F.x, H, XB, SS + 1 * SSF};
        pg8::gemm_phase<pg8::EpiRes, pg8::StaticOrder, PG8_ALIGN, PG8_SP2>(F.lds + RING_OFF, g, S, E);
    } SEAM(4);
    if (IN(5)) {
        pg8::Gemm g{XB, (const bf16*)(ws + WS_WUP), MR, F2, DM}; pg8::StaticOrder S; S.init(MR, F2, F.G, c);
        pg8::EpiUpPre E{AP, SS + 1 * SSF};
        pg8::gemm_phase<pg8::EpiUpPre, pg8::StaticOrder, PG8_ALIGN, PG8_SP2>(F.lds + RING_OFF, g, S, E);
    } SEAM(5);
    if (IN(6)) { p_conv(F, 0); } SEAM(6);
    if (IN(7)) {
        pg8::Gemm g{Gb, (const bf16*)(ws + WS_WDOWN), MR, DM, DFF}; pg8::StaticOrder S; S.init(MR, DM, F.G, c);
        pg8::EpiRes E{H, H, XB, SS + 2 * SSF};
        pg8::gemm_phase<pg8::EpiRes, pg8::StaticOrder, PG8_ALIGN, PG8_SP2>(F.lds + RING_OFF, g, S, E);
    } SEAM(7);
    if (IN(8)) {
        pg8::Gemm g{XB, (const bf16*)(ws + WS_SGWIN), MR, 2 * DM, DM}; pg8::StaticOrder S; S.init(MR, 2 * DM, F.G, c);
        pg8::EpiSgIn E{(bf16*)(ws + WS_U), (bf16*)(ws + WS_V), SS + 2 * SSF, F.sg_b_in, (float*)(ws + WS_VS)};
        pg8::gemm_phase<pg8::EpiSgIn, pg8::StaticOrder, PG8_ALIGN, PG8_SP2>(F.lds + RING_OFF, g, S, E);
    } SEAM(8);
    if (IN(9)) { p_sgate_naive(F); } SEAM(9);
    if (IN(10)) {
        pg8::Gemm g{O, (const bf16*)(ws + WS_SGWOUT), MR, DM, DM}; pg8::StaticOrder S; S.init(MR, DM, F.G, c);
        pg8::EpiRes E{H, H, XB, SS + 3 * SSF};
        pg8::gemm_phase<pg8::EpiRes, pg8::StaticOrder, PG8_ALIGN, PG8_SP2>(F.lds + RING_OFF, g, S, E);
    } SEAM(10);
    if (IN(11)) {
        pg8::Gemm g{XB, (const bf16*)(ws + WS_WUP + WUP_L), MR, F2, DM}; pg8::StaticOrder S; S.init(MR, F2, F.G, c);
        pg8::EpiUpPre E{AP, SS + 3 * SSF};
        pg8::gemm_phase<pg8::EpiUpPre, pg8::StaticOrder, PG8_ALIGN, PG8_SP2>(F.lds + RING_OFF, g, S, E);
    } SEAM(11);
    if (IN(12)) { p_conv(F, 1); } SEAM(12);
    if (IN(13)) {
        pg8::Gemm g{Gb, (const bf16*)(ws + WS_WDOWN + WDOWN_L), MR, DM, DFF}; pg8::StaticOrder S; S.init(MR, DM, F.G, c);
        pg8::EpiRes E{H, H, XB, SS + 4 * SSF};
        pg8::gemm_phase<pg8::EpiRes, pg8::StaticOrder, PG8_ALIGN, PG8_SP2>(F.lds + RING_OFF, g, S, E);
    } SEAM(13);
    if (IN(14)) { p_final(F); }
#undef IN
#undef SEAM
}

extern "C" void kernel_launch(void* const* d_in, const int* in_sizes, int n_in, void* d_out, int out_size, void* d_ws, size_t ws_size, hipStream_t stream) {
    static int grid = 0;
    if (grid == 0) {
        if (n_in != 19 || out_size != MR * DM || ws_size < WS_END) { fprintf(stderr, "kernel_launch: unexpected shapes (n_in %d, out %d, ws %zu); nothing launched\n", n_in, out_size, ws_size); grid = -1; return; }
        int dev = 0, cus = 0, per_cu = 0;
        if (hipGetDevice(&dev) != hipSuccess || hipDeviceGetAttribute(&cus, hipDeviceAttributeMultiprocessorCount, dev) != hipSuccess) { grid = -1; return; }
        if (hipFuncSetAttribute((const void*)mk_fwd, hipFuncAttributeMaxDynamicSharedMemorySize, LDS_BYTES) != hipSuccess) { fprintf(stderr, "kernel_launch: hipFuncSetAttribute failed\n"); grid = -1; return; }
        if (hipOccupancyMaxActiveBlocksPerMultiprocessor(&per_cu, (const void*)mk_fwd, NWAVES * 64, LDS_BYTES) != hipSuccess || per_cu < 1) fprintf(stderr, "kernel_launch: occupancy query reports %d\n", per_cu);
        (void)hipGetLastError();
        grid = cus;
    }
    if (grid < 0) return;
    if (hipMemsetAsync((char*)d_ws + WS_CTL, 0, CTL_ZERO_BYTES, stream) != hipSuccess) return;
    Args a{};
    for (int i = 0; i < 19; ++i) a.in[i] = d_in[i];
    a.out = (float*)d_out; a.ws = (unsigned char*)d_ws; a.pad = 0;
    if (MK_N_LAUNCHES == 1) {
        a.ph_lo = 0; a.ph_hi = N_PHASES; a.li = 0;
        hipLaunchKernelGGL(mk_fwd, dim3(grid), dim3(NWAVES * 64), LDS_BYTES, stream, a);
    } else {
        for (int p = 0; p < N_PHASES; ++p) { a.ph_lo = p; a.ph_hi = p + 1; a.li = 0; hipLaunchKernelGGL(mk_fwd, dim3(grid), dim3(NWAVES * 64), LDS_BYTES, stream, a); }
    }
}
```

```cpp
#include <hip/hip_runtime.h>
#include <cstdio>
#include <cstdint>
#ifndef MK_N_LAUNCHES
#define MK_N_LAUNCHES 1
#endif
namespace pg8 {
#define PG8_LAS __attribute__((address_space(3)))
typedef unsigned short bf16_t;
typedef short bf16x8 __attribute__((ext_vector_type(8)));
typedef float f32x4 __attribute__((ext_vector_type(4)));
typedef unsigned u32x4 __attribute__((ext_vector_type(4)));
constexpr int BM = 256, BK = 64, HALF = 128, HTB = HALF * BK * 2  , STAGE_BYTES = 8 * HTB, NXCD = 8, WGM = 8;

__host__ __device__ __forceinline__ int lds_byte(int r, int c) { const int st = (r >> 4) * 2 + (c >> 5), rr = r & 15, cc = c & 31, ob = rr * 64 + cc * 2; return st * 1024 + (ob ^ (((ob >> 9) & 1) << 5)); }
__host__ __device__ __forceinline__ void stage_rc(int b, int& R, int& C) { const int st = b / 1024, sb = b % 1024, swz = sb ^ (((sb >> 9) & 1) << 5); R = (st >> 1) * 16 + swz / 64; C = (st & 1) * 32 + (swz % 64) / 2; }
__host__ __device__ __forceinline__ int perm32(int rho) { const int n = rho >> 4, i = rho & 15; return 8 * (i >> 2) + 4 * n + (i & 3); }

struct Unit { int pm, pn; };
struct Gemm { const bf16_t* A; const bf16_t* Bt; int M, N, K; };

struct StaticOrder {
    int nM, nN, nwg, G, c;
    __host__ __device__ void init(int M, int N, int G_, int c_) { nM = M / BM; nN = N / BM; nwg = nM * nN; G = G_; c = c_; }
    __host__ __device__ bool next(int i, Unit& u) const {
        const long L = (long)i * G + c; if (L >= nwg) return false;
        int wgid = (int)L; { const int q = nwg / NXCD, r = nwg % NXCD, xcd = wgid % NXCD, off = wgid / NXCD; wgid = (xcd < r ? xcd * (q + 1) : r * (q + 1) + (xcd - r) * q) + off; }
        const int nig = WGM * nN, gid = wgid / nig, fm = gid * WGM, gsz = (nM - fm) < WGM ? (nM - fm) : WGM;
        u.pm = fm + ((wgid % nig) % gsz); u.pn = (wgid % nig) / gsz; return true;
    }
    __device__ __forceinline__ void a_ready(const Unit&) const {}
    __device__ __forceinline__ void done(const Unit&) const {}
};
__device__ __forceinline__ unsigned cvt_pk_bf16(float lo, float hi) { unsigned r; asm volatile("v_cvt_pk_bf16_f32 %0, %1, %2" : "=v"(r) : "v"(lo), "v"(hi)); return r; }
typedef float f32x2 __attribute__((ext_vector_type(2)));
__device__ __forceinline__ f32x2 gelu_pk(f32x2 v) {
    const f32x2 av = __builtin_elementwise_abs(v), d = av * 0.2316418882f + 1.0f;
    f32x2 t; t.x = __builtin_amdgcn_rcpf(d.x); t.y = __builtin_amdgcn_rcpf(d.y);
    f32x2 q = t * 0.5307027145f + (-0.7265760135f); q = q * t + 0.7107068705f; q = q * t + (-0.142248368f); q = q * t + 0.127414796f; q = q * t;
    const f32x2 s = (v * v) * (-0.72134752044f);
    f32x2 e; e.x = __builtin_amdgcn_exp2f(s.x); e.y = __builtin_amdgcn_exp2f(s.y);
    const f32x2 m = v * (q * e), r = v - m;
    f32x2 o; o.x = v.x < 0.f ? m.x : r.x; o.y = v.y < 0.f ? m.y : r.y; return o;
}
typedef unsigned u32x2 __attribute__((ext_vector_type(2)));
constexpr int SSP = 64;
__device__ __forceinline__ float rstd_from_ss(const float* ss, int r) {
    const f32x4* p = (const f32x4*)(ss + (size_t)r * SSP);
    float s = 0.f;
#pragma unroll
    for (int i = 0; i < SSP / 4; ++i) { const f32x4 v = p[i]; s += (v[0] + v[1]) + (v[2] + v[3]); }
    return 1.0f / sqrtf(s * (1.0f / 4096.0f) + 1e-5f);
}

struct EpiQKV {
    static constexpr bool PERM = false, AFTER_DRAIN = false;
    bf16_t* qkv; const float* ss; const float* ropec; const float* ropes;
    __device__ __forceinline__ void operator()(const f32x4 (&acc)[2][2][4][2], const Unit& u, int wr, int wc, int fr, int fq) const {
        const int row0 = u.pm * BM + wr * 64 + fr;
#pragma unroll
        for (int ai = 0; ai < 2; ++ai)
#pragma unroll
            for (int m = 0; m < 4; ++m) {
                const int r = row0 + ai * HALF + m * 16;
                const float rs = rstd_from_ss(ss, r);
                const int b = r >> 12, s = r & 4095;
                f32x4 cs = (f32x4){1.f, 1.f, 1.f, 1.f}, sn = (f32x4){0.f, 0.f, 0.f, 0.f};
                if (wc == 0) { cs = *(const f32x4*)(ropec + (size_t)r * 16 + 4 * fq); sn = *(const f32x4*)(ropes + (size_t)r * 16 + 4 * fq); }
#pragma unroll
                for (int bj = 0; bj < 2; ++bj) {
                    const int colh = 2 * u.pn + bj, which = colh / 48, head = colh - which * 48;
                    bf16_t* dst = qkv + ((size_t)((which * 2 + b) * 48 + head) * 4096 + s) * 128 + wc * 32 + 4 * fq;
                    f32x4 v0 = acc[ai][bj][m][0] * rs, v1 = acc[ai][bj][m][1] * rs;
                    if (which < 2 && wc == 0) { const f32x4 n0 = v0 * cs - v1 * sn, n1 = v1 * cs + v0 * sn; v0 = n0; v1 = n1; }
                    u32x2 w0, w1; w0.x = cvt_pk_bf16(v0[0], v0[1]); w0.y = cvt_pk_bf16(v0[2], v0[3]); w1.x = cvt_pk_bf16(v1[0], v1[1]); w1.y = cvt_pk_bf16(v1[2], v1[3]);
                    *(u32x2*)(dst) = w0; *(u32x2*)(dst + 16) = w1;
                }
                asm volatile("" ::: "memory");
            }
    }
};

struct EpiRes {
    static constexpr bool PERM = false, AFTER_DRAIN = false;
    const float* hin; float* hout; bf16_t* xb; float* ss;
    __device__ __forceinline__ void operator()(const f32x4 (&acc)[2][2][4][2], const Unit& u, int wr, int wc, int fr, int fq) const {
        const int row0 = u.pm * BM + wr * 64 + fr, col0 = u.pn * BM + wc * 32 + 4 * fq;
#pragma unroll
        for (int ai = 0; ai < 2; ++ai)
#pragma unroll
            for (int m = 0; m < 4; ++m) {
                const int r = row0 + ai * HALF + m * 16; const size_t off = (size_t)r * 4096 + col0;
                float sq = 0.f;
#pragma unroll
                for (int bj = 0; bj < 2; ++bj)
#pragma unroll
                    for (int n = 0; n < 2; ++n) {
                        const f32x4 h = *(const f32x4*)(hin + off + bj * HALF + n * 16) + acc[ai][bj][m][n];
                        *(f32x4*)(hout + off + bj * HALF + n * 16) = h;
                        u32x2 w; w.x = cvt_pk_bf16(h[0], h[1]); w.y = cvt_pk_bf16(h[2], h[3]);
                        *(u32x2*)(xb + off + bj * HALF + n * 16) = w;
                        sq += (h[0] * h[0] + h[1] * h[1]) + (h[2] * h[2] + h[3] * h[3]);
                    }
                sq += __shfl_xor(sq, 16); sq += __shfl_xor(sq, 32);
                if (fq == 0) ss[(size_t)r * SSP + u.pn * 4 + wc] = sq;
                asm volatile("" ::: "memory");
            }
    }
};

struct EpiUpPre {
    static constexpr bool PERM = true, AFTER_DRAIN = false;
    bf16_t* apre; const float* ss;
    __device__ __forceinline__ void operator()(const f32x4 (&acc)[2][2][4][2], const Unit& u, int wr, int wc, int fr, int fq) const {
        const int row0 = u.pm * BM + wr * 64 + fr, col0 = u.pn * 128 + wc * 32 + 8 * fq;
#pragma unroll
        for (int ai = 0; ai < 2; ++ai)
#pragma unroll
            for (int m = 0; m < 4; ++m) {
                const int r = row0 + ai * HALF + m * 16;
                const float rs = rstd_from_ss(ss, r);
                bf16_t* rowp = apre + (size_t)r * 28672 + col0;
#pragma unroll
                for (int bj = 0; bj < 2; ++bj) {
                    const f32x4 v0 = acc[ai][bj][m][0] * rs, v1 = acc[ai][bj][m][1] * rs;
                    u32x4 w; w.x = cvt_pk_bf16(v0[0], v0[1]); w.y = cvt_pk_bf16(v0[2], v0[3]); w.z = cvt_pk_bf16(v1[0], v1[1]); w.w = cvt_pk_bf16(v1[2], v1[3]);
                    *(u32x4*)(rowp + bj * 14336) = w;
                }
                asm volatile("" ::: "memory");
            }
    }
};

struct EpiSgIn {
    static constexpr bool PERM = true, AFTER_DRAIN = false;
    bf16_t* U; bf16_t* V; const float* ss; const float* bias; float* vs;
    __device__ __forceinline__ void operator()(const f32x4 (&acc)[2][2][4][2], const Unit& u, int wr, int wc, int fr, int fq) const {
        const int row0 = u.pm * BM + wr * 64 + fr, gcol0 = u.pn * BM + wc * 32 + 8 * fq;
        const bool isv = u.pn >= 16;
        bf16_t* base = isv ? V : U; const int col0 = isv ? gcol0 - 4096 : gcol0;
        f32x4 bv[2][2];
#pragma unroll
        for (int bj = 0; bj < 2; ++bj)
#pragma unroll
            for (int n = 0; n < 2; ++n) bv[bj][n] = *(const f32x4*)(bias + gcol0 + bj * HALF + 4 * n);
#pragma unroll
        for (int ai = 0; ai < 2; ++ai)
#pragma unroll
            for (int m = 0; m < 4; ++m) {
                const int r = row0 + ai * HALF + m * 16;
                const float rs = rstd_from_ss(ss, r);
                bf16_t* rowp = base + (size_t)r * 4096 + col0;
                float s1 = 0.f, s2 = 0.f;
#pragma unroll
                for (int bj = 0; bj < 2; ++bj) {
                    f32x4 v0 = acc[ai][bj][m][0] * rs + bv[bj][0], v1 = acc[ai][bj][m][1] * rs + bv[bj][1];
                    const f32x2 a = gelu_pk((f32x2){v0[0], v0[1]}), b = gelu_pk((f32x2){v0[2], v0[3]}), c = gelu_pk((f32x2){v1[0], v1[1]}), d = gelu_pk((f32x2){v1[2], v1[3]});
                    s1 += (a.x + a.y) + (b.x + b.y) + (c.x + c.y) + (d.x + d.y);
                    s2 += (a.x * a.x + a.y * a.y) + (b.x * b.x + b.y * b.y) + (c.x * c.x + c.y * c.y) + (d.x * d.x + d.y * d.y);
                    u32x4 w; w.x = cvt_pk_bf16(a.x, a.y); w.y = cvt_pk_bf16(b.x, b.y); w.z = cvt_pk_bf16(c.x, c.y); w.w = cvt_pk_bf16(d.x, d.y);
                    *(u32x4*)(rowp + bj * HALF) = w;
                }
                if (isv) {
                    s1 += __shfl_xor(s1, 16); s1 += __shfl_xor(s1, 32); s2 += __shfl_xor(s2, 16); s2 += __shfl_xor(s2, 32);
                    if (fq == 0) *(f32x2*)(vs + ((size_t)r * 64 + (u.pn - 16) * 4 + wc) * 2) = (f32x2){s1, s2};
                }
                asm volatile("" ::: "memory");
            }
    }
};
template <class Epi, class Sched, bool ALIGN_EPI = false, bool SP2 = false>
__device__ __forceinline__ void gemm_phase(PG8_LAS unsigned char* lds, const Gemm g, const Sched& S, const Epi& E) {
    const int tid = threadIdx.x, wid = __builtin_amdgcn_readfirstlane(tid >> 6), lane = tid & 63, wr = wid >> 2, wc = wid & 3, fr = lane & 15, fq = lane >> 4;
    const int K = g.K, nt = K / BK;
    unsigned voffA[2], voffB[2];
#pragma unroll
    for (int i = 0; i < 2; ++i) { int R, C; stage_rc(tid * 16 + i * 8192, R, C); const int Rb = Epi::PERM ? ((R & ~31) + perm32(R & 31)) : R;
        voffA[i] = (unsigned)(R * K + C) * 2u; voffB[i] = (unsigned)(Rb * K + C) * 2u; }
    const size_t kstep = (size_t)(BK * 2);
    const size_t hstep = (size_t)HALF * K * 2;
    const size_t tstep = 2 * hstep;
    const unsigned ldsw = (unsigned)wid * 1024u;
    const int aoff = lds_byte(wr * 64 + fr, fq * 8), boff = lds_byte(wc * 32 + fr, fq * 8);
#define PG8_SA(b, h) (((b) * 2 + (h)) * HTB)
#define PG8_SB(b, h) ((4 + (b) * 2 + (h)) * HTB)
#define PG8_STAGE(bufoff, gbase, voff) do { _Pragma("unroll") for (int _i = 0; _i < 2; ++_i) \
        __builtin_amdgcn_global_load_lds((const unsigned*)((const char*)(gbase) + (voff)[_i]), (PG8_LAS unsigned*)(lds + (bufoff) + ldsw + _i * 8192), 16, 0, 0); } while (0)
#define PG8_LDA(dst, b, h) do { _Pragma("unroll") for (int m = 0; m < 4; ++m) _Pragma("unroll") for (int k = 0; k < 2; ++k) dst[m][k] = *(const PG8_LAS bf16x8*)(lds + PG8_SA(b, h) + aoff + m * 2048 + k * 1024); } while (0)
#define PG8_LDB(dst, b, h) do { _Pragma("unroll") for (int n = 0; n < 2; ++n) _Pragma("unroll") for (int k = 0; k < 2; ++k) dst[n][k] = *(const PG8_LAS bf16x8*)(lds + PG8_SB(b, h) + boff + n * 2048 + k * 1024); } while (0)
#define PG8_MMA(ai, bj, At, Bt) do { __builtin_amdgcn_s_setprio(1); _Pragma("unroll") for (int m = 0; m < 4; ++m) _Pragma("unroll") for (int n = 0; n < 2; ++n) _Pragma("unroll") for (int k = 0; k < 2; ++k) \
        acc[ai][bj][m][n] = __builtin_amdgcn_mfma_f32_16x16x32_bf16(Bt[n][k], At[m][k], acc[ai][bj][m][n], 0, 0, 0); __builtin_amdgcn_s_setprio(0); } while (0)
#define PG8_WAIT_V(n) asm volatile("s_waitcnt vmcnt(" #n ")" ::: "memory")
#define PG8_WAIT_L(n) asm volatile("s_waitcnt lgkmcnt(" #n ")" ::: "memory")
#define PG8_BAR __builtin_amdgcn_s_barrier()
#define PG8_SCHED __builtin_amdgcn_sched_barrier(0)
    Unit cur, nxt; int ui = 0;
    if (!S.next(0, cur)) return;
    f32x4 acc[2][2][4][2];
#pragma unroll
    for (int a = 0; a < 2; ++a)
#pragma unroll
        for (int b = 0; b < 2; ++b)
#pragma unroll
            for (int m = 0; m < 4; ++m)
#pragma unroll
                for (int n = 0; n < 2; ++n) acc[a][b][m][n] = (f32x4){0.f, 0.f, 0.f, 0.f};
    bf16x8 At[4][2], B0[2][2], B1[2][2];
    const char* cA = (const char*)g.A + (size_t)cur.pm * tstep; const char* cB = (const char*)g.Bt + (size_t)cur.pn * tstep;
    S.a_ready(cur);
    if constexpr (SP2) {
        PG8_STAGE(PG8_SB(0, 0), cB, voffB); PG8_STAGE(PG8_SB(0, 1), cB + hstep, voffB); PG8_STAGE(PG8_SA(0, 0), cA, voffA); PG8_STAGE(PG8_SA(0, 1), cA + hstep, voffA);
        if (wr == 1) PG8_BAR;
        PG8_WAIT_V(2); PG8_BAR;
        PG8_STAGE(PG8_SB(1, 0), cB + kstep, voffB); PG8_STAGE(PG8_SA(1, 0), cA + kstep, voffA); PG8_STAGE(PG8_SB(1, 1), cB + hstep + kstep, voffB);
        PG8_WAIT_V(6); PG8_BAR;
    } else {
        PG8_STAGE(PG8_SB(0, 0), cB, voffB); PG8_STAGE(PG8_SA(0, 0), cA, voffA); PG8_STAGE(PG8_SB(0, 1), cB + hstep, voffB); PG8_STAGE(PG8_SA(0, 1), cA + hstep, voffA);
        if (wr == 1) PG8_BAR;
        PG8_WAIT_V(4); PG8_BAR;
        PG8_STAGE(PG8_SB(1, 0), cB + kstep, voffB); PG8_STAGE(PG8_SA(1, 0), cA + kstep, voffA); PG8_STAGE(PG8_SB(1, 1), cB + hstep + kstep, voffB);
        PG8_WAIT_V(6); PG8_BAR;
    }
    for (;;) {
        const bool has_next = S.next(ui + 1, nxt);
        const char* nA = has_next ? (const char*)g.A + (size_t)nxt.pm * tstep : cA; const char* nB = has_next ? (const char*)g.Bt + (size_t)nxt.pn * tstep : cB;
        for (int t = 0; t < nt; t += 2) {
            const bool last = (t == nt - 2);
            const char* a1 = cA + (size_t)(t + 1) * kstep;
            const char* a2 = last ? nA : cA + (size_t)(t + 2) * kstep; const char* b2 = last ? nB : cB + (size_t)(t + 2) * kstep;
            const char* a3 = a2 + kstep; const char* b3 = b2 + kstep;
            if (last && has_next) S.a_ready(nxt);
            if constexpr (SP2) {
            PG8_LDB(B0, 0, 0); PG8_LDB(B1, 0, 1); PG8_SCHED; PG8_LDA(At, 0, 0); PG8_STAGE(PG8_SA(1, 1), a1 + hstep, voffA);
            PG8_WAIT_V(8); PG8_WAIT_L(0); PG8_BAR; PG8_MMA(0, 0, At, B0); PG8_MMA(0, 1, At, B1); PG8_BAR; PG8_SCHED;
            PG8_LDA(At, 0, 1); PG8_STAGE(PG8_SB(0, 0), b2, voffB); PG8_STAGE(PG8_SB(0, 1), b2 + hstep, voffB); PG8_STAGE(PG8_SA(0, 0), a2, voffA);
            PG8_WAIT_V(8); PG8_WAIT_L(0); PG8_BAR; PG8_MMA(1, 0, At, B0); PG8_MMA(1, 1, At, B1); PG8_BAR; PG8_SCHED;
            PG8_LDB(B0, 1, 0); PG8_LDB(B1, 1, 1); PG8_SCHED; PG8_LDA(At, 1, 0); PG8_STAGE(PG8_SA(0, 1), a2 + hstep, voffA);
            PG8_WAIT_V(8); PG8_WAIT_L(0); PG8_BAR; PG8_MMA(0, 0, At, B0); PG8_MMA(0, 1, At, B1); PG8_BAR; PG8_SCHED;
            PG8_LDA(At, 1, 1); PG8_STAGE(PG8_SB(1, 0), b3, voffB); PG8_STAGE(PG8_SB(1, 1), b3 + hstep, voffB); PG8_STAGE(PG8_SA(1, 0), a3, voffA);
            PG8_WAIT_V(8); PG8_WAIT_L(0); PG8_BAR; PG8_MMA(1, 0, At, B0); PG8_MMA(1, 1, At, B1); PG8_BAR; PG8_SCHED;
            } else {
            PG8_LDB(B0, 0, 0); PG8_SCHED; PG8_LDA(At, 0, 0); PG8_STAGE(PG8_SA(1, 1), a1 + hstep, voffA);
            PG8_WAIT_L(8); PG8_BAR; PG8_WAIT_L(0); PG8_MMA(0, 0, At, B0); PG8_BAR; PG8_SCHED;
            PG8_LDB(B1, 0, 1); PG8_STAGE(PG8_SB(0, 0), b2, voffB);
            PG8_BAR; PG8_WAIT_L(0); PG8_MMA(0, 1, At, B1); PG8_BAR;
            PG8_LDA(At, 0, 1); PG8_STAGE(PG8_SA(0, 0), a2, voffA);
            PG8_BAR; PG8_WAIT_L(0); PG8_MMA(1, 0, At, B0); PG8_BAR; PG8_SCHED;
            PG8_STAGE(PG8_SB(0, 1), b2 + hstep, voffB);
            PG8_WAIT_V(6); PG8_BAR; PG8_MMA(1, 1, At, B1); PG8_BAR;
            PG8_LDB(B0, 1, 0); PG8_SCHED; PG8_LDA(At, 1, 0); PG8_STAGE(PG8_SA(0, 1), a2 + hstep, voffA);
            PG8_WAIT_L(8); PG8_BAR; PG8_WAIT_L(0); PG8_MMA(0, 0, At, B0); PG8_BAR; PG8_SCHED;
            PG8_LDB(B1, 1, 1); PG8_STAGE(PG8_SB(1, 0), b3, voffB);
            PG8_BAR; PG8_WAIT_L(0); PG8_MMA(0, 1, At, B1); PG8_BAR;
            PG8_LDA(At, 1, 1); PG8_STAGE(PG8_SA(1, 0), a3, voffA);
            PG8_BAR; PG8_WAIT_L(0); PG8_MMA(1, 0, At, B0); PG8_BAR; PG8_SCHED;
            PG8_STAGE(PG8_SB(1, 1), b3 + hstep, voffB);
            PG8_WAIT_V(6); PG8_BAR; PG8_MMA(1, 1, At, B1); PG8_BAR;
            }
        }
        if constexpr (ALIGN_EPI) { if (wr == 0) PG8_BAR; }
        if constexpr (!Epi::AFTER_DRAIN) { E(acc, cur, wr, wc, fr, fq); S.done(cur); }
        if (!has_next) break;
#pragma unroll
        for (int a = 0; a < 2; ++a)
#pragma unroll
            for (int b = 0; b < 2; ++b)
#pragma unroll
                for (int m = 0; m < 4; ++m)
#pragma unroll
                    for (int n = 0; n < 2; ++n) acc[a][b][m][n] = (f32x4){0.f, 0.f, 0.f, 0.f};
        cur = nxt; cA = nA; cB = nB; ++ui;
        if constexpr (ALIGN_EPI) { if (wr == 1) PG8_BAR; }
    }
    PG8_WAIT_V(0);
    if constexpr (!ALIGN_EPI) { if (wr == 0) PG8_BAR; }
    PG8_BAR;
    if constexpr (Epi::AFTER_DRAIN) { E.fused(acc, cur, wr, wc, fr, fq, lds, wid, lane); S.done(cur); }
#undef PG8_SA
#undef PG8_SB
#undef PG8_STAGE
#undef PG8_LDA
#undef PG8_LDB
#undef PG8_MMA
#undef PG8_WAIT_V
#undef PG8_WAIT_L
#undef PG8_BAR
#undef PG8_SCHED
}
}
#ifndef PG8_SP2
#define PG8_SP2 true
#endif
#ifndef PG8_ALIGN
#define PG8_ALIGN true
#endif
constexpr int NWAVES = 8;
constexpr int NB = 2, NS = 4096, DM = 4096, MR = NB * NS;
constexpr int NHQ = 48, NHA = 24, HD = 128, QKVC = 3 * NHQ * HD;
constexpr int DFF = 14336, F2 = 2 * DFF;
constexpr float ATT_SCALE = 0.08838834764831845f;
constexpr float NORM_EPS = 1e-5f;
constexpr size_t MiB = 1u << 20;
constexpr size_t WS_CTL = 0, CTL_ZERO_BYTES = 1 * MiB;
constexpr size_t WS_ROPE = 1 * MiB;
constexpr size_t WS_KMEAN = 2 * MiB;
constexpr size_t WS_SS = 3 * MiB, SS_SITE = 2 * MiB;
constexpr size_t WS_VS = 13 * MiB;
constexpr size_t WS_WIN = 32 * MiB;
constexpr size_t WS_WOUT = 176 * MiB;
constexpr size_t WS_SGWIN = 208 * MiB;
constexpr size_t WS_SGWOUT = 272 * MiB;
constexpr size_t WS_WUP = 304 * MiB, WUP_L = 224 * MiB;
constexpr size_t WS_WDOWN = 752 * MiB, WDOWN_L = 112 * MiB;
constexpr size_t WS_XB = 976 * MiB;
constexpr size_t WS_H = 1040 * MiB;
constexpr size_t WS_QKV = 1168 * MiB;
constexpr size_t WS_U = WS_QKV, WS_V = WS_QKV + 64 * MiB;
constexpr size_t WS_O = 1456 * MiB;
constexpr size_t WS_G = 1520 * MiB;
constexpr size_t WS_APRE = 1744 * MiB;
constexpr size_t WS_END = 2192 * MiB;
constexpr int RING_OFF = 0, RING_BYTES = 131072;
constexpr int LDSCTL_OFF = RING_BYTES, MISC_OFF = LDSCTL_OFF + 320;
constexpr int XTRA_OFF = RING_BYTES + 1024;
constexpr int LDS_BYTES = 147456;
static_assert(MISC_OFF + 128 <= XTRA_OFF, "LDS map");
constexpr int CW_TMO = 0, CW_BAR = 4096;

#define GAS __attribute__((address_space(1)))
#define LAS __attribute__((address_space(3)))
typedef unsigned short bf16;
typedef unsigned v4u __attribute__((ext_vector_type(4)));
typedef unsigned v2u __attribute__((ext_vector_type(2)));
typedef float f32x4 __attribute__((ext_vector_type(4)));
typedef float f32x2 __attribute__((ext_vector_type(2)));
#define LDS_WAIT() asm volatile("s_waitcnt lgkmcnt(0)" ::: "memory")
#define VM_WAIT() asm volatile("s_waitcnt vmcnt(0)" ::: "memory")
__device__ __forceinline__ unsigned f2bf(float f) { unsigned u = __builtin_bit_cast(unsigned, f); return (u + 0x7fffu + ((u >> 16) & 1u)) >> 16; }
__device__ __forceinline__ unsigned pk2(float lo, float hi) { return f2bf(lo) | (f2bf(hi) << 16); }
__device__ __forceinline__ float bflo(unsigned w) { return __builtin_bit_cast(float, w << 16); }
__device__ __forceinline__ float bfhi(unsigned w) { return __builtin_bit_cast(float, w & 0xffff0000u); }
__device__ __forceinline__ float bf1(bf16 h) { return __builtin_bit_cast(float, (unsigned)h << 16); }
#define XB_TMO      128
#define XB_XCNT(j)  (256  + 64 * (j))
#define XB_XSUB(j)  (1280 + 64 * (j))
#define XB_XGEN(j)  (2304 + 64 * (j))
#define XB_TOP      3328
#define XB_TOPGEN   3392
#define XCD_BAR_WORDS 3456
#define XB_SPIN_CAP (1u << 18)

__device__ __forceinline__ unsigned xb_ld(unsigned* p)              { return __hip_atomic_load(p, __ATOMIC_RELAXED, __HIP_MEMORY_SCOPE_AGENT); }
__device__ __forceinline__ unsigned xb_add(unsigned* p, unsigned v) { return __hip_atomic_fetch_add(p, v, __ATOMIC_RELAXED, __HIP_MEMORY_SCOPE_AGENT); }
__device__ __forceinline__ unsigned xb_xcc_id() { return (unsigned)__builtin_amdgcn_s_getreg((3 << 11) | 20) & 0xFu; }
#define XB_SPIN(cond, bar) do { unsigned _sp = 0; while (cond) { __builtin_amdgcn_s_sleep(1); \
    if ((++_sp & 255u) == 0u) { if (xb_ld(&(bar)[XB_TMO])) break; if (_sp > XB_SPIN_CAP) { atomicAdd(&(bar)[XB_TMO], 1u); break; } } } } while (0)

struct XcdBarrier {
    unsigned* bar; unsigned x;
    volatile LAS unsigned* st;
};

__device__ __forceinline__ XcdBarrier xcd_barrier_post(unsigned* bar, volatile LAS unsigned* st) {
    XcdBarrier b; b.bar = bar; b.x = xb_xcc_id(); b.st = st;
    if (threadIdx.x == 0) (void)xb_add(&bar[XB_XCNT(b.x)], 1u);
    return b;
}
__device__ __forceinline__ void xcd_barrier_complete(unsigned* bar, unsigned x, unsigned& nloc, unsigned& nx) {
    const unsigned G = gridDim.x * gridDim.y * gridDim.z;
    unsigned sum, cnt, mine, sp = 0u;
    for (;;) {
        sum = 0u; cnt = 0u; mine = 0u;
#pragma unroll
        for (unsigned j = 0; j < 16; ++j) { const unsigned c = xb_ld(&bar[XB_XCNT(j)]); sum += c; cnt += (c > 0u) ? 1u : 0u; mine = (j == x) ? c : mine; }
        if (sum == G) break;
        __builtin_amdgcn_s_sleep(1);
        if ((++sp & 255u) == 0u) { if (xb_ld(&bar[XB_TMO])) break; if (sp > XB_SPIN_CAP) { atomicAdd(&bar[XB_TMO], 1u); break; } }
    }
    nloc = mine > 0u ? mine : 1u; nx = cnt > 0u ? cnt : 1u;
}

__device__ __forceinline__ void xcd_barrier(const XcdBarrier& b) {
    asm volatile("s_waitcnt vmcnt(0)" ::: "memory");
    __syncthreads();
    if (threadIdx.x == 0) {
        unsigned* bar = b.bar;
        __builtin_amdgcn_s_waitcnt(0);
        unsigned nloc = b.st[0], nx = b.st[1];
        if (nloc == 0u) { xcd_barrier_complete(bar, b.x, nloc, nx); b.st[0] = nloc; b.st[1] = nx; }
        const unsigned old = xb_add(&bar[XB_XSUB(b.x)], 1u);
        const unsigned gen = old / nloc;
        if (old + 1u == (gen + 1u) * nloc) {
            __builtin_amdgcn_fence(__ATOMIC_RELEASE, "agent");
            asm volatile("s_waitcnt vmcnt(0)" ::: "memory");
            const unsigned og = xb_add(&bar[XB_TOP], 1u);
            const unsigned tg = og / nx;
            if (og + 1u == (tg + 1u) * nx) xb_add(&bar[XB_TOPGEN], 1u);
            else XB_SPIN(xb_ld(&bar[XB_TOPGEN]) == tg, bar);
            __builtin_amdgcn_fence(__ATOMIC_ACQUIRE, "agent");
            xb_add(&bar[XB_XGEN(b.x)], 1u);
            asm volatile("s_waitcnt vmcnt(0)" ::: "memory");
        } else {
            XB_SPIN(xb_ld(&bar[XB_XGEN(b.x)]) == gen, bar);
            __builtin_amdgcn_fence(__ATOMIC_ACQUIRE, "agent");
            asm volatile("s_waitcnt vmcnt(0)" ::: "memory");
        }
    }
    __syncthreads();
}
struct Frame {
    LAS unsigned char* lds;
    volatile LAS unsigned* MISC;
    unsigned* ctl;
    int tid, lane, wave, G, gw, NGW;
    unsigned char* ws;
    const float* x; const int* pos;
    const float *attn_norm, *attn_w_in, *attn_w_out, *sg_norm, *sg_w_in, *sg_b_in, *sg_v_gain, *sg_v_bias, *sg_w_s, *sg_b_s, *sg_w_out, *ffn_norm, *ffn_w_up, *ffn_conv_w, *ffn_conv_b, *ffn_w_down, *final_norm;
    float* out;
};
__device__ __forceinline__ float wave_sum(float v) {
#pragma unroll
    for (int o = 1; o < 64; o <<= 1) v += __shfl_xor(v, o);
    return v;
}
__device__ __forceinline__ float wave_max(float v) {
#pragma unroll
    for (int o = 1; o < 64; o <<= 1) v = fmaxf(v, __shfl_xor(v, o));
    return v;
}
__device__ __forceinline__ float ss_rstd(const float* ss, int r) { return pg8::rstd_from_ss(ss, r); }

struct MapId { __device__ __forceinline__ int operator()(int n) const { return n; } };
struct MapUp { __device__ __forceinline__ int operator()(int n) const { return n < DFF ? ((n >> 7) << 8) + (n & 127) : (((n - DFF) >> 7) << 8) + 128 + ((n - DFF) & 127); } };
template <class RowMap>
__device__ __forceinline__ void transpose_item(const float* W, int K, int N, const float* gain, bf16* WT, RowMap rm, LAS float* scr, int item, int lane) {
    const int nblk = N / 32, kb = item / nblk, nb = item - kb * nblk, k0 = 64 * kb, n0 = 32 * nb;
#pragma unroll 8
    for (int i = 0; i < 32; ++i) { const int kk = 2 * i + (lane >> 5); float v = W[(size_t)(k0 + kk) * N + n0 + (lane & 31)]; if (gain) v *= gain[k0 + kk]; scr[kk * 33 + (lane & 31)] = v; }
    LDS_WAIT(); asm volatile("" ::: "memory");
    const int c = lane & 7;
#pragma unroll
    for (int j = 0; j < 4; ++j) { const int n = (lane >> 3) + 8 * j; const LAS float* s = scr + (8 * c) * 33 + n;
        v4u o; o.x = pk2(s[0 * 33], s[1 * 33]); o.y = pk2(s[2 * 33], s[3 * 33]); o.z = pk2(s[4 * 33], s[5 * 33]); o.w = pk2(s[6 * 33], s[7 * 33]);
        *(v4u*)(WT + (size_t)rm(n0 + n) * K + k0 + 8 * c) = o; }
    LDS_WAIT(); asm volatile("" ::: "memory");
}
__device__ __forceinline__ void sincos_d(double a, double& sn, double& cs) {
    const double n = __builtin_rint(a * 0.15915494309189535);
    const double r = a - n * 6.283185307179586;
    const double r2 = r * r;
    double ts = r, tc = 1.0, s = r, c = 1.0;
#pragma unroll
    for (int k = 1; k <= 15; ++k) { tc = -tc * r2 / (double)((2 * k - 1) * (2 * k)); ts = -ts * r2 / (double)((2 * k) * (2 * k + 1)); c += tc; s += ts; }
    sn = s; cs = c;
}
__device__ __forceinline__ void p0_prologue(Frame& F) {
    LAS float* scr = (LAS float*)(F.lds + RING_OFF + F.wave * 16384);
    constexpr int I_WIN = 64 * (QKVC / 32), I_SQ = 64 * (DM / 32), I_SGIN = 64 * (2 * DM / 32), I_UP = 64 * (F2 / 32), I_DN = (DFF / 64) * (DM / 32);
    constexpr int NITEMS = I_WIN + 2 * I_SQ + I_SGIN + 2 * I_UP + 2 * I_DN;
    for (int it = F.gw; it < NITEMS; it += F.NGW) {
        int r = it;
        if (r < I_WIN) { transpose_item(F.attn_w_in, DM, QKVC, F.attn_norm, (bf16*)(F.ws + WS_WIN), MapId(), scr, r, F.lane); continue; } r -= I_WIN;
        if (r < I_SQ) { transpose_item(F.attn_w_out, DM, DM, nullptr, (bf16*)(F.ws + WS_WOUT), MapId(), scr, r, F.lane); continue; } r -= I_SQ;
        if (r < I_SGIN) { transpose_item(F.sg_w_in, DM, 2 * DM, F.sg_norm, (bf16*)(F.ws + WS_SGWIN), MapId(), scr, r, F.lane); continue; } r -= I_SGIN;
        if (r < I_SQ) { transpose_item(F.sg_w_out, DM, DM, nullptr, (bf16*)(F.ws + WS_SGWOUT), MapId(), scr, r, F.lane); continue; } r -= I_SQ;
        if (r < I_UP) { transpose_item(F.ffn_w_up, DM, F2, F.ffn_norm, (bf16*)(F.ws + WS_WUP), MapUp(), scr, r, F.lane); continue; } r -= I_UP;
        if (r < I_UP) { transpose_item(F.ffn_w_up + (size_t)DM * F2, DM, F2, F.ffn_norm + DM, (bf16*)(F.ws + WS_WUP + WUP_L), MapUp(), scr, r, F.lane); continue; } r -= I_UP;
        if (r < I_DN) { transpose_item(F.ffn_w_down, DFF, DM, nullptr, (bf16*)(F.ws + WS_WDOWN), MapId(), scr, r, F.lane); continue; } r -= I_DN;
        transpose_item(F.ffn_w_down + (size_t)DFF * DM, DFF, DM, nullptr, (bf16*)(F.ws + WS_WDOWN + WDOWN_L), MapId(), scr, r, F.lane);
    }
    bf16* XB = (bf16*)(F.ws + WS_XB); float* SS0 = (float*)(F.ws + WS_SS);
    for (int m = F.gw; m < MR; m += F.NGW) {
        const f32x4* xr = (const f32x4*)(F.x + (size_t)m * DM) + F.lane;
        v2u* o8 = (v2u*)(XB + (size_t)m * DM) + F.lane;
        float sq = 0.f;
#pragma unroll
        for (int j = 0; j < 16; ++j) { const f32x4 v = xr[64 * j]; sq += (v[0] * v[0] + v[1] * v[1]) + (v[2] * v[2] + v[3] * v[3]); v2u w; w.x = pk2(v[0], v[1]); w.y = pk2(v[2], v[3]); o8[64 * j] = w; }
        sq = wave_sum(sq);
        SS0[(size_t)m * 64 + F.lane] = F.lane == 0 ? sq : 0.f;
    }
    float* rc = (float*)(F.ws + WS_ROPE); float* rs = rc + MR * 16;
    for (int idx = F.gw * 64 + F.lane; idx < MR * 16; idx += F.NGW * 64) {
        const int r = idx >> 4, i = idx & 15;
        double invd = 1.0;
        for (int k = 0; k < i; ++k) invd *= 0.44036660267178046;
        const float inv = (float)invd;
        const float ang = (float)F.pos[r] * inv;
        double sn, cs; sincos_d((double)ang, sn, cs);
        rc[idx] = (float)cs; rs[idx] = (float)sn;
    }
}

__device__ __forceinline__ void p_kmean(Frame& F) {
    const bf16* QKV = (const bf16*)(F.ws + WS_QKV); float* KM = (float*)(F.ws + WS_KMEAN);
    LAS float* red = (LAS float*)(F.lds + RING_OFF);
    for (int item = blockIdx.x; item < NB * NHA * 16; item += F.G) {
        const int j = item & 15, bh = item >> 4, b = bh / NHA, h = bh - b * NHA;
        const bf16* kb = QKV + ((size_t)((1 * 2 + b) * NHQ + h) * NS + 256 * j) * HD;
        const int d = F.tid & 127, part = F.tid >> 7;
        float s = 0.f;
        for (int i = 0; i < 64; ++i) s += bf1(kb[(size_t)(part * 64 + i) * HD + d]);
        red[part * 128 + d] = s;
        __syncthreads();
        if (F.tid < 128) KM[(size_t)item * 128 + F.tid] = (red[F.tid] + red[128 + F.tid] + red[256 + F.tid] + red[384 + F.tid]) * (1.0f / 256.0f);
        __syncthreads();
    }
}

__device__ __forceinline__ float dot128(const LAS float* qs, const bf16* krow) {
    float s = 0.f;
#pragma unroll 4
    for (int c = 0; c < 16; ++c) {
        const v4u kv = *(const v4u*)(krow + 8 * c); const LAS float* q8 = qs + 8 * c;
        s += q8[0] * bflo(kv.x) + q8[1] * bfhi(kv.x) + q8[2] * bflo(kv.y) + q8[3] * bfhi(kv.y) + q8[4] * bflo(kv.z) + q8[5] * bfhi(kv.z) + q8[6] * bflo(kv.w) + q8[7] * bfhi(kv.w);
    }
    return s;
}
__device__ __forceinline__ void p_attn_naive(Frame& F) {
    const bf16* QKV = (const bf16*)(F.ws + WS_QKV); const float* KM = (const float*)(F.ws + WS_KMEAN); bf16* O = (bf16*)(F.ws + WS_O);
    LAS float* qs = (LAS float*)(F.lds + RING_OFF + F.wave * 8192);
    LAS float* ps = qs + 128;
    const int lane = F.lane;
    constexpr int NMOBA = NB * NHA * NS, NDIL = NB * 8 * NS;
    const float NEG = -__builtin_inff();
    for (int task = F.gw; task < NMOBA + NDIL; task += F.NGW) {
        if (task < NMOBA) {
            const int b = task / (NHA * NS), rem = task - b * (NHA * NS), h = rem >> 12, t = rem & 4095;
            const bf16* qrow = QKV + ((size_t)((0 * 2 + b) * NHQ + h) * NS + t) * HD;
            const bf16* Kb = QKV + (size_t)((1 * 2 + b) * NHQ + h) * NS * HD;
            const bf16* Vb = QKV + (size_t)((2 * 2 + b) * NHQ + h) * NS * HD;
            { const unsigned w = *(const unsigned*)(qrow + 2 * lane); qs[2 * lane] = bflo(w); qs[2 * lane + 1] = bfhi(w); }
            LDS_WAIT(); asm volatile("" ::: "memory");
            const int qb = t >> 8, tin = t & 255;
            float g = NEG;
            if (lane < qb) { const float* km = KM + ((size_t)((b * NHA + h) * 16 + lane)) * 128; float s = 0.f; for (int d = 0; d < 128; ++d) s += qs[d] * km[d]; g = s; }
            unsigned selmask = 0u;
            if (qb <= 3) selmask = (1u << qb) - 1u;
            else {
#pragma unroll
                for (int rd = 0; rd < 3; ++rd) {
                    float best = g; int bi = lane;
#pragma unroll
                    for (int o = 1; o < 64; o <<= 1) { const float ob = __shfl_xor(best, o); const int oi = __shfl_xor(bi, o); if (ob > best || (ob == best && oi < bi)) { best = ob; bi = oi; } }
                    selmask |= 1u << bi; if (lane == bi) g = NEG;
                }
            }
            float sc[4][4]; int jsel[3];
            unsigned mk = selmask;
#pragma unroll
            for (int sl = 0; sl < 3; ++sl) {
                int j = -1; if (mk) { j = __builtin_ctz(mk); mk &= mk - 1u; }
                jsel[sl] = j;
#pragma unroll
                for (int c = 0; c < 4; ++c) sc[sl][c] = (j >= 0) ? ATT_SCALE * dot128(qs, Kb + (size_t)(256 * j + lane + 64 * c) * HD) : NEG;
            }
#pragma unroll
            for (int c = 0; c < 4; ++c) { const int i = lane + 64 * c; sc[3][c] = (i <= tin) ? ATT_SCALE * dot128(qs, Kb + (size_t)(256 * qb + i) * HD) : NEG; }
            float mx = NEG;
#pragma unroll
            for (int sl = 0; sl < 4; ++sl)
#pragma unroll
                for (int c = 0; c < 4; ++c) mx = fmaxf(mx, sc[sl][c]);
            mx = wave_max(mx);
            float sum = 0.f;
#pragma unroll
            for (int sl = 0; sl < 4; ++sl)
#pragma unroll
                for (int c = 0; c < 4; ++c) { sc[sl][c] = __expf(sc[sl][c] - mx); sum += sc[sl][c]; }
            sum = wave_sum(sum);
            const float inv = 1.0f / sum;
#pragma unroll
            for (int sl = 0; sl < 4; ++sl)
#pragma unroll
                for (int c = 0; c < 4; ++c) ps[sl * 256 + lane + 64 * c] = sc[sl][c] * inv;
            LDS_WAIT(); asm volatile("" ::: "memory");
            float o0 = 0.f, o1 = 0.f;
#pragma unroll
            for (int sl = 0; sl < 3; ++sl) {
                if (jsel[sl] >= 0) { const bf16* vb = Vb + (size_t)(256 * jsel[sl]) * HD + 2 * lane;
                    for (int i = 0; i < 256; ++i) { const float p = ps[sl * 256 + i]; const unsigned w = *(const unsigned*)(vb + (size_t)i * HD); o0 += p * bflo(w); o1 += p * bfhi(w); } }
            }
            { const bf16* vb = Vb + (size_t)(256 * qb) * HD + 2 * lane;
              for (int i = 0; i <= tin; ++i) { const float p = ps[3 * 256 + i]; const unsigned w = *(const unsigned*)(vb + (size_t)i * HD); o0 += p * bflo(w); o1 += p * bfhi(w); } }
            *(unsigned*)(O + (size_t)(b * NS + t) * DM + h * HD + 2 * lane) = pk2(o0, o1);
            LDS_WAIT(); asm volatile("" ::: "memory");
        } else {
            const int td = task - NMOBA, b = td / (8 * NS), rem = td - b * (8 * NS), hh = rem >> 12, t = rem & 4095;
            float lse[3], og0[3], og1[3];
#pragma unroll
            for (int g = 0; g < 3; ++g) {
                const int head = NHA + g * 8 + hh, dil = g == 0 ? 1 : (g == 1 ? 4 : 16);
                const bf16* qrow = QKV + ((size_t)((0 * 2 + b) * NHQ + head) * NS + t) * HD;
                const bf16* Kb = QKV + (size_t)((1 * 2 + b) * NHQ + head) * NS * HD;
                const bf16* Vb = QKV + (size_t)((2 * 2 + b) * NHQ + head) * NS * HD;
                { const unsigned w = *(const unsigned*)(qrow + 2 * lane); qs[2 * lane] = bflo(w); qs[2 * lane + 1] = bfhi(w); }
                LDS_WAIT(); asm volatile("" ::: "memory");
                float sc[3];
#pragma unroll
                for (int c = 0; c < 3; ++c) { const int m = lane + 64 * c; const int kp = t - m * dil; sc[c] = (m <= 128 && kp >= 0) ? ATT_SCALE * dot128(qs, Kb + (size_t)kp * HD) : NEG; }
                float mx = wave_max(fmaxf(fmaxf(sc[0], sc[1]), sc[2]));
                float e0 = __expf(sc[0] - mx), e1 = __expf(sc[1] - mx), e2 = __expf(sc[2] - mx);
                const float sum = wave_sum(e0 + e1 + e2), inv = 1.0f / sum;
                lse[g] = mx + __logf(sum);
                ps[lane] = e0 * inv; ps[lane + 64] = e1 * inv; if (lane == 0) ps[128] = e2 * inv;
                LDS_WAIT(); asm volatile("" ::: "memory");
                const int nb = t / dil, nk = (nb < 128 ? nb : 128) + 1;
                float o0 = 0.f, o1 = 0.f;
                for (int m = 0; m < nk; ++m) { const float p = ps[m]; const unsigned w = *(const unsigned*)(Vb + (size_t)(t - m * dil) * HD + 2 * lane); o0 += p * bflo(w); o1 += p * bfhi(w); }
                og0[g] = o0; og1[g] = o1;
                LDS_WAIT(); asm volatile("" ::: "memory");
            }
            const float ml = fmaxf(fmaxf(lse[0], lse[1]), lse[2]);
            const float w0 = __expf(lse[0] - ml), w1 = __expf(lse[1] - ml), w2 = __expf(lse[2] - ml), wi = 1.0f / (w0 + w1 + w2);
            const float r0 = (w0 * og0[0] + w1 * og0[1] + w2 * og0[2]) * wi, r1 = (w0 * og1[0] + w1 * og1[1] + w2 * og1[2]) * wi;
            *(unsigned*)(O + (size_t)(b * NS + t) * DM + (NHA + hh) * HD + 2 * lane) = pk2(r0, r1);
        }
    }
}

__device__ __forceinline__ float silu_f(float x) { return x / (1.0f + __expf(-x)); }
__device__ __forceinline__ void unpack8(const v4u w, float (&f)[8]) { f[0] = bflo(w.x); f[1] = bfhi(w.x); f[2] = bflo(w.y); f[3] = bfhi(w.y); f[4] = bflo(w.z); f[5] = bfhi(w.z); f[6] = bflo(w.w); f[7] = bfhi(w.w); }
__device__ __forceinline__ void p_conv(Frame& F, int layer) {
    const bf16* AP = (const bf16*)(F.ws + WS_APRE); bf16* Gb = (bf16*)(F.ws + WS_G);
    const float* cw = F.ffn_conv_w + (size_t)layer * 3 * F2; const float* cb = F.ffn_conv_b + (size_t)layer * F2;
    constexpr int C8 = DFF / 8;
    const size_t total = (size_t)MR * C8;
    for (size_t idx = (size_t)blockIdx.x * 512 + F.tid; idx < total; idx += (size_t)F.G * 512) {
        const int r = (int)(idx / C8), j0 = (int)(idx - (size_t)r * C8) * 8, s = r & 4095;
        float cg[8], cu[8];
#pragma unroll
        for (int e = 0; e < 8; ++e) { cg[e] = cb[j0 + e]; cu[e] = cb[DFF + j0 + e]; }
#pragma unroll
        for (int tp = 0; tp < 3; ++tp) {
            const int back = 2 - tp;
            if (s >= back) {
                float ag[8], au[8];
                unpack8(*(const v4u*)(AP + (size_t)(r - back) * F2 + j0), ag);
                unpack8(*(const v4u*)(AP + (size_t)(r - back) * F2 + DFF + j0), au);
#pragma unroll
                for (int e = 0; e < 8; ++e) { cg[e] += cw[(size_t)tp * F2 + j0 + e] * ag[e]; cu[e] += cw[(size_t)tp * F2 + DFF + j0 + e] * au[e]; }
            }
        }
        v4u o; o.x = pk2(silu_f(cg[0]) * cu[0], silu_f(cg[1]) * cu[1]); o.y = pk2(silu_f(cg[2]) * cu[2], silu_f(cg[3]) * cu[3]);
        o.z = pk2(silu_f(cg[4]) * cu[4], silu_f(cg[5]) * cu[5]); o.w = pk2(silu_f(cg[6]) * cu[6], silu_f(cg[7]) * cu[7]);
        *(v4u*)(Gb + (size_t)r * DFF + j0) = o;
    }
}

__device__ __forceinline__ void p_sgate_naive(Frame& F) {
    const bf16* U = (const bf16*)(F.ws + WS_U); const bf16* V = (const bf16*)(F.ws + WS_V); const float* VS = (const float*)(F.ws + WS_VS); bf16* GT = (bf16*)(F.ws + WS_O);
    LAS float* vn = (LAS float*)(F.lds + RING_OFF);
    LAS float* wsl = vn + 128 * 128;
    LAS float* rstat = (LAS float*)(F.lds + XTRA_OFF);
    for (int item = blockIdx.x; item < 64 * 32; item += F.G) {
        const int bc = item >> 5, g = item & 31, r0 = bc * 128;
        if (F.tid < 128) {
            const f32x4* p = (const f32x4*)(VS + (size_t)(r0 + F.tid) * 128);
            float s1 = 0.f, s2 = 0.f;
#pragma unroll 8
            for (int i = 0; i < 32; ++i) { const f32x4 v = p[i]; s1 += v[0] + v[2]; s2 += v[1] + v[3]; }
            const float mean = s1 * (1.0f / 4096.0f), var = s2 * (1.0f / 4096.0f) - mean * mean;
            rstat[2 * F.tid] = mean; rstat[2 * F.tid + 1] = 1.0f / sqrtf(var + NORM_EPS);
        }
        __syncthreads();
        for (int idx = F.tid; idx < 128 * 128; idx += 512) {
            const int s = idx >> 7, d = idx & 127, col = g * 128 + d;
            const float v = bf1(V[(size_t)(r0 + s) * DM + col]);
            vn[idx] = (v - rstat[2 * s]) * rstat[2 * s + 1] * F.sg_v_gain[col] + F.sg_v_bias[col];
            wsl[idx] = F.sg_w_s[(size_t)g * 16384 + idx];
        }
        __syncthreads();
        for (int idx = F.tid; idx < 128 * 128; idx += 512) {
            const int t = idx >> 7, d = idx & 127;
            float a = 0.f;
            for (int s = 0; s <= t; ++s) a += wsl[t * 128 + s] * vn[s * 128 + d];
            const float f = a + F.sg_b_s[g * 128 + t];
            const size_t o = (size_t)(r0 + t) * DM + g * 128 + d;
            GT[o] = (bf16)f2bf(bf1(U[o]) * f);
        }
        __syncthreads();
    }
}

__device__ __forceinline__ void p_final(Frame& F) {
    const float* H = (const float*)(F.ws + WS_H); const float* SS4 = (const float*)(F.ws + WS_SS + 4 * SS_SITE);
    for (int m = F.gw; m < MR; m += F.NGW) {
        const float rs = ss_rstd(SS4, m);
        const f32x4* hr = (const f32x4*)(H + (size_t)m * DM) + F.lane; const f32x4* gr = (const f32x4*)F.final_norm + F.lane;
        f32x4* orow = (f32x4*)(F.out + (size_t)m * DM) + F.lane;
#pragma unroll 4
        for (int j = 0; j < 16; ++j) orow[64 * j] = hr[64 * j] * rs * gr[64 * j];
    }
}
constexpr int N_PHASES = 15;
struct Args { const void* in[19]; float* out; unsigned char* ws; int ph_lo, ph_hi, li, pad; };
__global__ void __launch_bounds__(NWAVES * 64, 2) mk_fwd(Args args) {
    extern __shared__ __attribute__((aligned(16))) unsigned char lds[];
    Frame F;
    F.lds = (LAS unsigned char*)lds;
    F.MISC = (volatile LAS unsigned*)(F.lds + MISC_OFF);
    F.tid = threadIdx.x; F.lane = F.tid & 63; F.wave = __builtin_amdgcn_readfirstlane(F.tid >> 6);
    F.G = gridDim.x; F.gw = blockIdx.x * NWAVES + F.wave; F.NGW = F.G * NWAVES;
    F.ws = args.ws; F.ctl = (unsigned*)(args.ws + WS_CTL);
    F.x = (const float*)args.in[0]; F.pos = (const int*)args.in[1];
    F.attn_norm = (const float*)args.in[2]; F.attn_w_in = (const float*)args.in[3]; F.attn_w_out = (const float*)args.in[4];
    F.sg_norm = (const float*)args.in[5]; F.sg_w_in = (const float*)args.in[6]; F.sg_b_in = (const float*)args.in[7]; F.sg_v_gain = (const float*)args.in[8]; F.sg_v_bias = (const float*)args.in[9];
    F.sg_w_s = (const float*)args.in[10]; F.sg_b_s = (const float*)args.in[11]; F.sg_w_out = (const float*)args.in[12];
    F.ffn_norm = (const float*)args.in[13]; F.ffn_w_up = (const float*)args.in[14]; F.ffn_conv_w = (const float*)args.in[15]; F.ffn_conv_b = (const float*)args.in[16]; F.ffn_w_down = (const float*)args.in[17];
    F.final_norm = (const float*)args.in[18]; F.out = args.out;
    for (int u = F.tid; u < (XTRA_OFF - LDSCTL_OFF) / 4; u += NWAVES * 64) ((LAS unsigned*)(F.lds + LDSCTL_OFF))[u] = 0u;
    __syncthreads();
    const int lo = args.ph_lo, hi = args.ph_hi;
    XcdBarrier bar; bar.bar = F.ctl + CW_BAR + args.li * XCD_BAR_WORDS; bar.x = 0; bar.st = nullptr;
    if (hi - lo > 1) bar = xcd_barrier_post(F.ctl + CW_BAR + args.li * XCD_BAR_WORDS, F.MISC + 8);
#define IN(k) (lo <= (k) && (k) < hi)
#define SEAM(k) do { if (IN(k) && IN((k) + 1)) xcd_barrier(bar); } while (0)
    unsigned char* ws = args.ws;
    bf16* XB = (bf16*)(ws + WS_XB); float* H = (float*)(ws + WS_H); bf16* O = (bf16*)(ws + WS_O); bf16* Gb = (bf16*)(ws + WS_G); bf16* AP = (bf16*)(ws + WS_APRE);
    float* SS = (float*)(ws + WS_SS); constexpr size_t SSF = SS_SITE / 4;
    const int c = (int)blockIdx.x;

    if (IN(0)) { p0_prologue(F); } SEAM(0);
    if (IN(1)) {
        pg8::Gemm g{XB, (const bf16*)(ws + WS_WIN), MR, QKVC, DM}; pg8::StaticOrder S; S.init(MR, QKVC, F.G, c);
        pg8::EpiQKV E{(bf16*)(ws + WS_QKV), SS, (const float*)(ws + WS_ROPE), (const float*)(ws + WS_ROPE) + MR * 16};
        pg8::gemm_phase<pg8::EpiQKV, pg8::StaticOrder, PG8_ALIGN, PG8_SP2>(F.lds + RING_OFF, g, S, E);
    } SEAM(1);
    if (IN(2)) { p_kmean(F); } SEAM(2);
    if (IN(3)) { p_attn_naive(F); } SEAM(3);
    if (IN(4)) {
        pg8::Gemm g{O, (const bf16*)(ws + WS_WOUT), MR, DM, DM}; pg8::StaticOrder S; S.init(MR, DM, F.G, c);
        pg8::EpiRes E{F.x, H, XB, SS + 1 * SSF};
        pg8::gemm_phase<pg8::EpiRes, pg8::StaticOrder, PG8_ALIGN, PG8_SP2>(F.lds + RING_OFF, g, S, E);
    } SEAM(4);
    if (IN(5)) {
        pg8::Gemm g{XB, (const bf16*)(ws + WS_WUP), MR, F2, DM}; pg8::StaticOrder S; S.init(MR, F2, F.G, c);
        pg8::EpiUpPre E{AP, SS + 1 * SSF};
        pg8::gemm_phase<pg8::EpiUpPre, pg8::StaticOrder, PG8_ALIGN, PG8_SP2>(F.lds + RING_OFF, g, S, E);
    } SEAM(5);
    if (IN(6)) { p_conv(F, 0); } SEAM(6);
    if (IN(7)) {
        pg8::Gemm g{Gb, (const bf16*)(ws + WS_WDOWN), MR, DM, DFF}; pg8::StaticOrder S; S.init(MR, DM, F.G, c);
        pg8::EpiRes E{H, H, XB, SS + 2 * SSF};
        pg8::gemm_phase<pg8::EpiRes, pg8::StaticOrder, PG8_ALIGN, PG8_SP2>(F.lds + RING_OFF, g, S, E);
    } SEAM(7);
    if (IN(8)) {
        pg8::Gemm g{XB, (const bf16*)(ws + WS_SGWIN), MR, 2 * DM, DM}; pg8::StaticOrder S; S.init(MR, 2 * DM, F.G, c);
        pg8::EpiSgIn E{(bf16*)(ws + WS_U), (bf16*)(ws + WS_V), SS + 2 * SSF, F.sg_b_in, (float*)(ws + WS_VS)};
        pg8::gemm_phase<pg8::EpiSgIn, pg8::StaticOrder, PG8_ALIGN, PG8_SP2>(F.lds + RING_OFF, g, S, E);
    } SEAM(8);
    if (IN(9)) { p_sgate_naive(F); } SEAM(9);
    if (IN(10)) {
        pg8::Gemm g{O, (const bf16*)(ws + WS_SGWOUT), MR, DM, DM}; pg8::StaticOrder S; S.init(MR, DM, F.G, c);
        pg8::EpiRes E{H, H, XB, SS + 3 * SSF};
        pg8::gemm_phase<pg8::EpiRes, pg8::StaticOrder, PG8_ALIGN, PG8_SP2>(F.lds + RING_OFF, g, S, E);
    } SEAM(10);
    if (IN(11)) {
        pg8::Gemm g{XB, (const bf16*)(ws + WS_WUP + WUP_L), MR, F2, DM}; pg8::StaticOrder S; S.init(MR, F2, F.G, c);
        pg8::EpiUpPre E{AP, SS + 3 * SSF};
        pg8::gemm_phase<pg8::EpiUpPre, pg8::StaticOrder, PG8_ALIGN, PG8_SP2>(F.lds + RING_OFF, g, S, E);
    } SEAM(11);
    if (IN(12)) { p_conv(F, 1); } SEAM(12);
    if (IN(13)) {
        pg8::Gemm g{Gb, (const bf16*)(ws + WS_WDOWN + WDOWN_L), MR, DM, DFF}; pg8::StaticOrder S; S.init(MR, DM, F.G, c);
        pg8::EpiRes E{H, H, XB, SS + 4 * SSF};
        pg8::gemm_phase<pg8::EpiRes, pg8::StaticOrder, PG8_ALIGN, PG8_SP2>(F.lds + RING_OFF, g, S, E);
    } SEAM(13);
    if (IN(14)) { p_final(F); }
#undef IN
#undef SEAM
}

extern "C" void kernel_launch(void* const* d_in, const int* in_sizes, int n_in, void* d_out, int out_size, void* d_ws, size_t ws_size, hipStream_t stream) {
    static int grid = 0;
    if (grid == 0) {
        if (n_in != 19 || out_size != MR * DM || ws_size < WS_END) { fprintf(stderr, "kernel_launch: unexpected shapes (n_in %d, out %d, ws %zu); nothing launched\n", n_in, out_size, ws_size); grid = -1; return; }
        int dev = 0, cus = 0, per_cu = 0;
        if (hipGetDevice(&dev) != hipSuccess || hipDeviceGetAttribute(&cus, hipDeviceAttributeMultiprocessorCount, dev) != hipSuccess) { grid = -1; return; }
        if (hipFuncSetAttribute((const void*)mk_fwd, hipFuncAttributeMaxDynamicSharedMemorySize, LDS_BYTES) != hipSuccess) { fprintf(stderr, "kernel_launch: hipFuncSetAttribute failed\n"); grid = -1; return; }
        if (hipOccupancyMaxActiveBlocksPerMultiprocessor(&per_cu, (const void*)mk_fwd, NWAVES * 64, LDS_BYTES) != hipSuccess || per_cu < 1) fprintf(stderr, "kernel_launch: occupancy query reports %d\n", per_cu);
        (void)hipGetLastError();
        grid = cus;
    }
    if (grid < 0) return;
    if (hipMemsetAsync((char*)d_ws + WS_CTL, 0, CTL_ZERO_BYTES, stream) != hipSuccess) return;
    Args a{};
    for (int i = 0; i < 19; ++i) a.in[i] = d_in[i];
    a.out = (float*)d_out; a.ws = (unsigned char*)d_ws; a.pad = 0;
    if (MK_N_LAUNCHES == 1) {
        a.ph_lo = 0; a.ph_hi = N_PHASES; a.li = 0;
        hipLaunchKernelGGL(mk_fwd, dim3(grid), dim3(NWAVES * 64), LDS_BYTES, stream, a);
    } else {
        for (int p = 0; p < N_PHASES; ++p) { a.ph_lo = p; a.ph_hi = p + 1; a.li = 0; hipLaunchKernelGGL(mk_fwd, dim3(grid), dim3(NWAVES * 64), LDS_BYTES, stream, a); }
    }
}
```

```cpp
#include <hip/hip_runtime.h>
#include <cstdio>
#include <cstdint>
#ifndef MK_N_LAUNCHES
#define MK_N_LAUNCHES 1
#endif
namespace pg8 {
#define PG8_LAS __attribute__((address_space(3)))
typedef unsigned short bf16_t;
typedef short bf16x8 __attribute__((ext_vector_type(8)));
typedef float f32x4 __attribute__((ext_vector_type(4)));
typedef unsigned u32x4 __attribute__((ext_vector_type(4)));
constexpr int BM = 256, BK = 64, HALF = 128, HTB = HALF * BK * 2  , STAGE_BYTES = 8 * HTB, NXCD = 8, WGM = 8;

__host__ __device__ __forceinline__ int lds_byte(int r, int c) { const int st = (r >> 4) * 2 + (c >> 5), rr = r & 15, cc = c & 31, ob = rr * 64 + cc * 2; return st * 1024 + (ob ^ (((ob >> 9) & 1) << 5)); }
__host__ __device__ __forceinline__ void stage_rc(int b, int& R, int& C) { const int st = b / 1024, sb = b % 1024, swz = sb ^ (((sb >> 9) & 1) << 5); R = (st >> 1) * 16 + swz / 64; C = (st & 1) * 32 + (swz % 64) / 2; }
__host__ __device__ __forceinline__ int perm32(int rho) { const int n = rho >> 4, i = rho & 15; return 8 * (i >> 2) + 4 * n + (i & 3); }

struct Unit { int pm, pn; };
struct Gemm { const bf16_t* A; const bf16_t* Bt; int M, N, K; };

struct StaticOrder {
    int nM, nN, nwg, G, c;
    __host__ __device__ void init(int M, int N, int G_, int c_) { nM = M / BM; nN = N / BM; nwg = nM * nN; G = G_; c = c_; }
    __host__ __device__ bool next(int i, Unit& u) const {
        const long L = (long)i * G + c; if (L >= nwg) return false;
        int wgid = (int)L; { const int q = nwg / NXCD, r = nwg % NXCD, xcd = wgid % NXCD, off = wgid / NXCD; wgid = (xcd < r ? xcd * (q + 1) : r * (q + 1) + (xcd - r) * q) + off; }
        const int nig = WGM * nN, gid = wgid / nig, fm = gid * WGM, gsz = (nM - fm) < WGM ? (nM - fm) : WGM;
        u.pm = fm + ((wgid % nig) % gsz); u.pn = (wgid % nig) / gsz; return true;
    }
    __device__ __forceinline__ void a_ready(const Unit&) const {}
    __device__ __forceinline__ void done(const Unit&) const {}
};
__device__ __forceinline__ unsigned cvt_pk_bf16(float lo, float hi) { unsigned r; asm volatile("v_cvt_pk_bf16_f32 %0, %1, %2" : "=v"(r) : "v"(lo), "v"(hi)); return r; }
typedef float f32x2 __attribute__((ext_vector_type(2)));
__device__ __forceinline__ f32x2 gelu_pk(f32x2 v) {
    const f32x2 av = __builtin_elementwise_abs(v), d = av * 0.2316418882f + 1.0f;
    f32x2 t; t.x = __builtin_amdgcn_rcpf(d.x); t.y = __builtin_amdgcn_rcpf(d.y);
    f32x2 q = t * 0.5307027145f + (-0.7265760135f); q = q * t + 0.7107068705f; q = q * t + (-0.142248368f); q = q * t + 0.127414796f; q = q * t;
    const f32x2 s = (v * v) * (-0.72134752044f);
    f32x2 e; e.x = __builtin_amdgcn_exp2f(s.x); e.y = __builtin_amdgcn_exp2f(s.y);
    const f32x2 m = v * (q * e), r = v - m;
    f32x2 o; o.x = v.x < 0.f ? m.x : r.x; o.y = v.y < 0.f ? m.y : r.y; return o;
}
typedef unsigned u32x2 __attribute__((ext_vector_type(2)));
__device__ __forceinline__ float rstd_from_ss(const float* ss, int r) { return 1.0f / sqrtf(ss[r] * (1.0f / 4096.0f) + 1e-5f); }

struct EpiQKV {
    static constexpr bool PERM = false, AFTER_DRAIN = false;
    bf16_t* qkv; const float* ss; const float* ropec; const float* ropes;
    __device__ __forceinline__ void operator()(const f32x4 (&acc)[2][2][4][2], const Unit& u, int wr, int wc, int fr, int fq) const {
        const int row0 = u.pm * BM + wr * 64 + fr;
#pragma unroll
        for (int ai = 0; ai < 2; ++ai)
#pragma unroll
            for (int m = 0; m < 4; ++m) {
                const int r = row0 + ai * HALF + m * 16;
                const float rs = rstd_from_ss(ss, r);
                const int b = r >> 12, s = r & 4095;
                f32x4 cs = (f32x4){1.f, 1.f, 1.f, 1.f}, sn = (f32x4){0.f, 0.f, 0.f, 0.f};
                if (wc == 0) { cs = *(const f32x4*)(ropec + (size_t)r * 16 + 4 * fq); sn = *(const f32x4*)(ropes + (size_t)r * 16 + 4 * fq); }
#pragma unroll
                for (int bj = 0; bj < 2; ++bj) {
                    const int colh = 2 * u.pn + bj, which = colh / 48, head = colh - which * 48;
                    bf16_t* dst = qkv + ((size_t)((which * 2 + b) * 48 + head) * 4096 + s) * 128 + wc * 32 + 4 * fq;
                    f32x4 v0 = acc[ai][bj][m][0] * rs, v1 = acc[ai][bj][m][1] * rs;
                    if (which < 2 && wc == 0) { const f32x4 n0 = v0 * cs - v1 * sn, n1 = v1 * cs + v0 * sn; v0 = n0; v1 = n1; }
                    u32x2 w0, w1; w0.x = cvt_pk_bf16(v0[0], v0[1]); w0.y = cvt_pk_bf16(v0[2], v0[3]); w1.x = cvt_pk_bf16(v1[0], v1[1]); w1.y = cvt_pk_bf16(v1[2], v1[3]);
                    *(u32x2*)(dst) = w0; *(u32x2*)(dst + 16) = w1;
                }
                asm volatile("" ::: "memory");
            }
    }
};

struct EpiRes {
    static constexpr bool PERM = false, AFTER_DRAIN = false;
    const float* hin; float* hout; bf16_t* xb; float* ss;
    __device__ __forceinline__ void operator()(const f32x4 (&acc)[2][2][4][2], const Unit& u, int wr, int wc, int fr, int fq) const {
        const int row0 = u.pm * BM + wr * 64 + fr, col0 = u.pn * BM + wc * 32 + 4 * fq;
#pragma unroll
        for (int ai = 0; ai < 2; ++ai)
#pragma unroll
            for (int m = 0; m < 4; ++m) {
                const int r = row0 + ai * HALF + m * 16; const size_t off = (size_t)r * 4096 + col0;
                float sq = 0.f;
#pragma unroll
                for (int bj = 0; bj < 2; ++bj)
#pragma unroll
                    for (int n = 0; n < 2; ++n) {
                        const f32x4 h = *(const f32x4*)(hin + off + bj * HALF + n * 16) + acc[ai][bj][m][n];
                        *(f32x4*)(hout + off + bj * HALF + n * 16) = h;
                        u32x2 w; w.x = cvt_pk_bf16(h[0], h[1]); w.y = cvt_pk_bf16(h[2], h[3]);
                        *(u32x2*)(xb + off + bj * HALF + n * 16) = w;
                        sq += (h[0] * h[0] + h[1] * h[1]) + (h[2] * h[2] + h[3] * h[3]);
                    }
                sq += __shfl_xor(sq, 16); sq += __shfl_xor(sq, 32);
                if (fq == 0) atomicAdd(ss + r, sq);
                asm volatile("" ::: "memory");
            }
    }
};

struct EpiUpPre {
    static constexpr bool PERM = true, AFTER_DRAIN = false;
    bf16_t* apre; const float* ss;
    __device__ __forceinline__ void operator()(const f32x4 (&acc)[2][2][4][2], const Unit& u, int wr, int wc, int fr, int fq) const {
        const int row0 = u.pm * BM + wr * 64 + fr, col0 = u.pn * 128 + wc * 32 + 8 * fq;
#pragma unroll
        for (int ai = 0; ai < 2; ++ai)
#pragma unroll
            for (int m = 0; m < 4; ++m) {
                const int r = row0 + ai * HALF + m * 16;
                const float rs = rstd_from_ss(ss, r);
                bf16_t* rowp = apre + (size_t)r * 28672 + col0;
#pragma unroll
                for (int bj = 0; bj < 2; ++bj) {
                    const f32x4 v0 = acc[ai][bj][m][0] * rs, v1 = acc[ai][bj][m][1] * rs;
                    u32x4 w; w.x = cvt_pk_bf16(v0[0], v0[1]); w.y = cvt_pk_bf16(v0[2], v0[3]); w.z = cvt_pk_bf16(v1[0], v1[1]); w.w = cvt_pk_bf16(v1[2], v1[3]);
                    *(u32x4*)(rowp + bj * 14336) = w;
                }
                asm volatile("" ::: "memory");
            }
    }
};

struct EpiSgIn {
    static constexpr bool PERM = true, AFTER_DRAIN = false;
    bf16_t* U; bf16_t* V; const float* ss; const float* bias; float* vs;
    __device__ __forceinline__ void operator()(const f32x4 (&acc)[2][2][4][2], const Unit& u, int wr, int wc, int fr, int fq) const {
        const int row0 = u.pm * BM + wr * 64 + fr, gcol0 = u.pn * BM + wc * 32 + 8 * fq;
        const bool isv = u.pn >= 16;
        bf16_t* base = isv ? V : U; const int col0 = isv ? gcol0 - 4096 : gcol0;
        f32x4 bv[2][2];
#pragma unroll
        for (int bj = 0; bj < 2; ++bj)
#pragma unroll
            for (int n = 0; n < 2; ++n) bv[bj][n] = *(const f32x4*)(bias + gcol0 + bj * HALF + 4 * n);
#pragma unroll
        for (int ai = 0; ai < 2; ++ai)
#pragma unroll
            for (int m = 0; m < 4; ++m) {
                const int r = row0 + ai * HALF + m * 16;
                const float rs = rstd_from_ss(ss, r);
                bf16_t* rowp = base + (size_t)r * 4096 + col0;
                float s1 = 0.f, s2 = 0.f;
#pragma unroll
                for (int bj = 0; bj < 2; ++bj) {
                    f32x4 v0 = acc[ai][bj][m][0] * rs + bv[bj][0], v1 = acc[ai][bj][m][1] * rs + bv[bj][1];
                    const f32x2 a = gelu_pk((f32x2){v0[0], v0[1]}), b = gelu_pk((f32x2){v0[2], v0[3]}), c = gelu_pk((f32x2){v1[0], v1[1]}), d = gelu_pk((f32x2){v1[2], v1[3]});
                    s1 += (a.x + a.y) + (b.x + b.y) + (c.x + c.y) + (d.x + d.y);
                    s2 += (a.x * a.x + a.y * a.y) + (b.x * b.x + b.y * b.y) + (c.x * c.x + c.y * c.y) + (d.x * d.x + d.y * d.y);
                    u32x4 w; w.x = cvt_pk_bf16(a.x, a.y); w.y = cvt_pk_bf16(b.x, b.y); w.z = cvt_pk_bf16(c.x, c.y); w.w = cvt_pk_bf16(d.x, d.y);
                    *(u32x4*)(rowp + bj * HALF) = w;
                }
                if (isv) {
                    s1 += __shfl_xor(s1, 16); s1 += __shfl_xor(s1, 32); s2 += __shfl_xor(s2, 16); s2 += __shfl_xor(s2, 32);
                    if (fq == 0) { atomicAdd(vs + 2 * r, s1); atomicAdd(vs + 2 * r + 1, s2); }
                }
                asm volatile("" ::: "memory");
            }
    }
};

#define PG8_DPP(oldv, srcv, ctrl) __builtin_bit_cast(float, __builtin_amdgcn_update_dpp(__builtin_bit_cast(int, (float)(oldv)), __builtin_bit_cast(int, (float)(srcv)), (ctrl), 0xf, 0xf, false))
struct EpiUpConv {
    static constexpr bool PERM = true, AFTER_DRAIN = false;
    bf16_t* G; const float* ss; const float* cw; const float* cb; float* top; float* bot; PG8_LAS float* xch;
    __device__ __forceinline__ static float silu(float x) { return x * __builtin_amdgcn_rcpf(1.0f + __builtin_amdgcn_exp2f(-1.4426950408889634f * x)); }
    __device__ __forceinline__ void operator()(const f32x4 (&acc)[2][2][4][2], const Unit& u, int wr, int wc, int fr, int fq) const {
        const int row0 = u.pm * BM + wr * 64 + fr, colg = u.pn * 128 + wc * 32 + 8 * fq;
        float rs[2][4];
#pragma unroll
        for (int ai = 0; ai < 2; ++ai)
#pragma unroll
            for (int m = 0; m < 4; ++m) rs[ai][m] = rstd_from_ss(ss, row0 + ai * HALF + m * 16);
#pragma unroll
        for (int ai = 0; ai < 2; ++ai)
#pragma unroll
            for (int bj = 0; bj < 2; ++bj)
#pragma unroll
                for (int n = 0; n < 2; ++n) {
                    const f32x4 v = acc[ai][bj][3][n] * rs[ai][3];
                    if (fr >= 14) {
                        *(PG8_LAS f32x4*)(xch + ((((((ai * 2 + wr) * 4 + wc) * 2 + bj) * 2 + n) * 4 + fq) * 2 + (fr - 14)) * 4) = v;
                        if (ai == 1 && wr == 1) *(f32x4*)(bot + ((size_t)(u.pm * 2 + (fr - 14)) * 28672) + bj * 14336 + colg + 4 * n) = v;
                    }
                }
        if (wr == 0 && fr < 2) {
#pragma unroll
            for (int bj = 0; bj < 2; ++bj)
#pragma unroll
                for (int n = 0; n < 2; ++n) *(f32x4*)(top + ((size_t)(u.pm * 2 + fr) * 28672) + bj * 14336 + colg + 4 * n) = acc[0][bj][0][n] * rs[0][0];
        }
        asm volatile("s_waitcnt lgkmcnt(0)" ::: "memory"); __builtin_amdgcn_s_barrier(); asm volatile("" ::: "memory");
#pragma unroll
        for (int n = 0; n < 2; ++n) {
            f32x4 w0[2], w1[2], w2[2], cbv[2];
#pragma unroll
            for (int bj = 0; bj < 2; ++bj) { const int off = bj * 14336 + colg + 4 * n;
                w0[bj] = *(const f32x4*)(cw + off); w1[bj] = *(const f32x4*)(cw + 28672 + off); w2[bj] = *(const f32x4*)(cw + 2 * 28672 + off); cbv[bj] = *(const f32x4*)(cb + off); }
#pragma unroll
            for (int ai = 0; ai < 2; ++ai) {
                f32x4 prev[2];
                const bool has = !(ai == 0 && wr == 0);
                const int pai = wr == 1 ? ai : 0, pwr = wr == 1 ? 0 : 1;
#pragma unroll
                for (int bj = 0; bj < 2; ++bj) {
                    prev[bj] = (f32x4){0.f, 0.f, 0.f, 0.f};
                    if (has && fr >= 14) prev[bj] = *(const PG8_LAS f32x4*)(xch + ((((((pai * 2 + pwr) * 4 + wc) * 2 + bj) * 2 + n) * 4 + fq) * 2 + (fr - 14)) * 4);
                }
#pragma unroll
                for (int m = 0; m < 4; ++m) {
                    f32x4 cv[2];
#pragma unroll
                    for (int bj = 0; bj < 2; ++bj) {
                        const f32x4 cur = acc[ai][bj][m][n] * rs[ai][m];
#pragma unroll
                        for (int j = 0; j < 4; ++j) {
                            const float r1 = PG8_DPP(0.f, prev[bj][j], 0x121), r2 = PG8_DPP(0.f, prev[bj][j], 0x122);
                            const float p1 = PG8_DPP(r1, cur[j], 0x111), p2 = PG8_DPP(r2, cur[j], 0x112);
                            cv[bj][j] = cbv[bj][j] + w0[bj][j] * p2 + w1[bj][j] * p1 + w2[bj][j] * cur[j];
                        }
                        prev[bj] = cur;
                    }
                    u32x2 w; w.x = cvt_pk_bf16(silu(cv[0][0]) * cv[1][0], silu(cv[0][1]) * cv[1][1]); w.y = cvt_pk_bf16(silu(cv[0][2]) * cv[1][2], silu(cv[0][3]) * cv[1][3]);
                    *(u32x2*)(G + (size_t)(row0 + ai * HALF + m * 16) * 14336 + colg + 4 * n) = w;
                    asm volatile("" ::: "memory");
                }
            }
            asm volatile("" ::: "memory");
        }
    }
};
template <class Epi, class Sched, bool ALIGN_EPI = false, bool SP2 = false>
__device__ __forceinline__ void gemm_phase(PG8_LAS unsigned char* lds, const Gemm g, const Sched& S, const Epi& E) {
    const int tid = threadIdx.x, wid = __builtin_amdgcn_readfirstlane(tid >> 6), lane = tid & 63, wr = wid >> 2, wc = wid & 3, fr = lane & 15, fq = lane >> 4;
    const int K = g.K, nt = K / BK;
    unsigned voffA[2], voffB[2];
#pragma unroll
    for (int i = 0; i < 2; ++i) { int R, C; stage_rc(tid * 16 + i * 8192, R, C); const int Rb = Epi::PERM ? ((R & ~31) + perm32(R & 31)) : R;
        voffA[i] = (unsigned)(R * K + C) * 2u; voffB[i] = (unsigned)(Rb * K + C) * 2u; }
    const size_t kstep = (size_t)(BK * 2);
    const size_t hstep = (size_t)HALF * K * 2;
    const size_t tstep = 2 * hstep;
    const unsigned ldsw = (unsigned)wid * 1024u;
    const int aoff = lds_byte(wr * 64 + fr, fq * 8), boff = lds_byte(wc * 32 + fr, fq * 8);
#define PG8_SA(b, h) (((b) * 2 + (h)) * HTB)
#define PG8_SB(b, h) ((4 + (b) * 2 + (h)) * HTB)
#define PG8_STAGE(bufoff, gbase, voff) do { _Pragma("unroll") for (int _i = 0; _i < 2; ++_i) \
        __builtin_amdgcn_global_load_lds((const unsigned*)((const char*)(gbase) + (voff)[_i]), (PG8_LAS unsigned*)(lds + (bufoff) + ldsw + _i * 8192), 16, 0, 0); } while (0)
#define PG8_LDA(dst, b, h) do { _Pragma("unroll") for (int m = 0; m < 4; ++m) _Pragma("unroll") for (int k = 0; k < 2; ++k) dst[m][k] = *(const PG8_LAS bf16x8*)(lds + PG8_SA(b, h) + aoff + m * 2048 + k * 1024); } while (0)
#define PG8_LDB(dst, b, h) do { _Pragma("unroll") for (int n = 0; n < 2; ++n) _Pragma("unroll") for (int k = 0; k < 2; ++k) dst[n][k] = *(const PG8_LAS bf16x8*)(lds + PG8_SB(b, h) + boff + n * 2048 + k * 1024); } while (0)
#define PG8_MMA(ai, bj, At, Bt) do { __builtin_amdgcn_s_setprio(1); _Pragma("unroll") for (int m = 0; m < 4; ++m) _Pragma("unroll") for (int n = 0; n < 2; ++n) _Pragma("unroll") for (int k = 0; k < 2; ++k) \
        acc[ai][bj][m][n] = __builtin_amdgcn_mfma_f32_16x16x32_bf16(Bt[n][k], At[m][k], acc[ai][bj][m][n], 0, 0, 0); __builtin_amdgcn_s_setprio(0); } while (0)
#define PG8_WAIT_V(n) asm volatile("s_waitcnt vmcnt(" #n ")" ::: "memory")
#define PG8_WAIT_L(n) asm volatile("s_waitcnt lgkmcnt(" #n ")" ::: "memory")
#define PG8_BAR __builtin_amdgcn_s_barrier()
#define PG8_SCHED __builtin_amdgcn_sched_barrier(0)
    Unit cur, nxt; int ui = 0;
    if (!S.next(0, cur)) return;
    f32x4 acc[2][2][4][2];
#pragma unroll
    for (int a = 0; a < 2; ++a)
#pragma unroll
        for (int b = 0; b < 2; ++b)
#pragma unroll
            for (int m = 0; m < 4; ++m)
#pragma unroll
                for (int n = 0; n < 2; ++n) acc[a][b][m][n] = (f32x4){0.f, 0.f, 0.f, 0.f};
    bf16x8 At[4][2], B0[2][2], B1[2][2];
    const char* cA = (const char*)g.A + (size_t)cur.pm * tstep; const char* cB = (const char*)g.Bt + (size_t)cur.pn * tstep;
    S.a_ready(cur);
    if constexpr (SP2) {
        PG8_STAGE(PG8_SB(0, 0), cB, voffB); PG8_STAGE(PG8_SB(0, 1), cB + hstep, voffB); PG8_STAGE(PG8_SA(0, 0), cA, voffA); PG8_STAGE(PG8_SA(0, 1), cA + hstep, voffA);
        if (wr == 1) PG8_BAR;
        PG8_WAIT_V(2); PG8_BAR;
        PG8_STAGE(PG8_SB(1, 0), cB + kstep, voffB); PG8_STAGE(PG8_SA(1, 0), cA + kstep, voffA); PG8_STAGE(PG8_SB(1, 1), cB + hstep + kstep, voffB);
        PG8_WAIT_V(6); PG8_BAR;
    } else {
        PG8_STAGE(PG8_SB(0, 0), cB, voffB); PG8_STAGE(PG8_SA(0, 0), cA, voffA); PG8_STAGE(PG8_SB(0, 1), cB + hstep, voffB); PG8_STAGE(PG8_SA(0, 1), cA + hstep, voffA);
        if (wr == 1) PG8_BAR;
        PG8_WAIT_V(4); PG8_BAR;
        PG8_STAGE(PG8_SB(1, 0), cB + kstep, voffB); PG8_STAGE(PG8_SA(1, 0), cA + kstep, voffA); PG8_STAGE(PG8_SB(1, 1), cB + hstep + kstep, voffB);
        PG8_WAIT_V(6); PG8_BAR;
    }
    for (;;) {
        const bool has_next = S.next(ui + 1, nxt);
        const char* nA = has_next ? (const char*)g.A + (size_t)nxt.pm * tstep : cA; const char* nB = has_next ? (const char*)g.Bt + (size_t)nxt.pn * tstep : cB;
        for (int t = 0; t < nt; t += 2) {
            const bool last = (t == nt - 2);
            const char* a1 = cA + (size_t)(t + 1) * kstep;
            const char* a2 = last ? nA : cA + (size_t)(t + 2) * kstep; const char* b2 = last ? nB : cB + (size_t)(t + 2) * kstep;
            const char* a3 = a2 + kstep; const char* b3 = b2 + kstep;
            if (last && has_next) S.a_ready(nxt);
            if constexpr (SP2) {
            PG8_LDB(B0, 0, 0); PG8_LDB(B1, 0, 1); PG8_SCHED; PG8_LDA(At, 0, 0); PG8_STAGE(PG8_SA(1, 1), a1 + hstep, voffA);
            PG8_WAIT_V(8); PG8_WAIT_L(0); PG8_BAR; PG8_MMA(0, 0, At, B0); PG8_MMA(0, 1, At, B1); PG8_BAR; PG8_SCHED;
            PG8_LDA(At, 0, 1); PG8_STAGE(PG8_SB(0, 0), b2, voffB); PG8_STAGE(PG8_SB(0, 1), b2 + hstep, voffB); PG8_STAGE(PG8_SA(0, 0), a2, voffA);
            PG8_WAIT_V(8); PG8_WAIT_L(0); PG8_BAR; PG8_MMA(1, 0, At, B0); PG8_MMA(1, 1, At, B1); PG8_BAR; PG8_SCHED;
            PG8_LDB(B0, 1, 0); PG8_LDB(B1, 1, 1); PG8_SCHED; PG8_LDA(At, 1, 0); PG8_STAGE(PG8_SA(0, 1), a2 + hstep, voffA);
            PG8_WAIT_V(8); PG8_WAIT_L(0); PG8_BAR; PG8_MMA(0, 0, At, B0); PG8_MMA(0, 1, At, B1); PG8_BAR; PG8_SCHED;
            PG8_LDA(At, 1, 1); PG8_STAGE(PG8_SB(1, 0), b3, voffB); PG8_STAGE(PG8_SB(1, 1), b3 + hstep, voffB); PG8_STAGE(PG8_SA(1, 0), a3, voffA);
            PG8_WAIT_V(8); PG8_WAIT_L(0); PG8_BAR; PG8_MMA(1, 0, At, B0); PG8_MMA(1, 1, At, B1); PG8_BAR; PG8_SCHED;
            } else {
            PG8_LDB(B0, 0, 0); PG8_SCHED; PG8_LDA(At, 0, 0); PG8_STAGE(PG8_SA(1, 1), a1 + hstep, voffA);
            PG8_WAIT_L(8); PG8_BAR; PG8_WAIT_L(0); PG8_MMA(0, 0, At, B0); PG8_BAR; PG8_SCHED;
            PG8_LDB(B1, 0, 1); PG8_STAGE(PG8_SB(0, 0), b2, voffB);
            PG8_BAR; PG8_WAIT_L(0); PG8_MMA(0, 1, At, B1); PG8_BAR;
            PG8_LDA(At, 0, 1); PG8_STAGE(PG8_SA(0, 0), a2, voffA);
            PG8_BAR; PG8_WAIT_L(0); PG8_MMA(1, 0, At, B0); PG8_BAR; PG8_SCHED;
            PG8_STAGE(PG8_SB(0, 1), b2 + hstep, voffB);
            PG8_WAIT_V(6); PG8_BAR; PG8_MMA(1, 1, At, B1); PG8_BAR;
            PG8_LDB(B0, 1, 0); PG8_SCHED; PG8_LDA(At, 1, 0); PG8_STAGE(PG8_SA(0, 1), a2 + hstep, voffA);
            PG8_WAIT_L(8); PG8_BAR; PG8_WAIT_L(0); PG8_MMA(0, 0, At, B0); PG8_BAR; PG8_SCHED;
            PG8_LDB(B1, 1, 1); PG8_STAGE(PG8_SB(1, 0), b3, voffB);
            PG8_BAR; PG8_WAIT_L(0); PG8_MMA(0, 1, At, B1); PG8_BAR;
            PG8_LDA(At, 1, 1); PG8_STAGE(PG8_SA(1, 0), a3, voffA);
            PG8_BAR; PG8_WAIT_L(0); PG8_MMA(1, 0, At, B0); PG8_BAR; PG8_SCHED;
            PG8_STAGE(PG8_SB(1, 1), b3 + hstep, voffB);
            PG8_WAIT_V(6); PG8_BAR; PG8_MMA(1, 1, At, B1); PG8_BAR;
            }
        }
        if constexpr (ALIGN_EPI) { if (wr == 0) PG8_BAR; }
        if constexpr (!Epi::AFTER_DRAIN) { E(acc, cur, wr, wc, fr, fq); S.done(cur); }
        if (!has_next) break;
#pragma unroll
        for (int a = 0; a < 2; ++a)
#pragma unroll
            for (int b = 0; b < 2; ++b)
#pragma unroll
                for (int m = 0; m < 4; ++m)
#pragma unroll
                    for (int n = 0; n < 2; ++n) acc[a][b][m][n] = (f32x4){0.f, 0.f, 0.f, 0.f};
        cur = nxt; cA = nA; cB = nB; ++ui;
        if constexpr (ALIGN_EPI) { if (wr == 1) PG8_BAR; }
    }
    PG8_WAIT_V(0);
    if constexpr (!ALIGN_EPI) { if (wr == 0) PG8_BAR; }
    PG8_BAR;
    if constexpr (Epi::AFTER_DRAIN) { E.fused(acc, cur, wr, wc, fr, fq, lds, wid, lane); S.done(cur); }
#undef PG8_SA
#undef PG8_SB
#undef PG8_STAGE
#undef PG8_LDA
#undef PG8_LDB
#undef PG8_MMA
#undef PG8_WAIT_V
#undef PG8_WAIT_L
#undef PG8_BAR
#undef PG8_SCHED
}
}
#ifndef PG8_SP2
#define PG8_SP2 true
#endif
#ifndef PG8_ALIGN
#define PG8_ALIGN true
#endif
constexpr int NWAVES = 8;
constexpr int NB = 2, NS = 4096, DM = 4096, MR = NB * NS;
constexpr int NHQ = 48, NHA = 24, HD = 128, QKVC = 3 * NHQ * HD;
constexpr int DFF = 14336, F2 = 2 * DFF;
constexpr float ATT_SCALE = 0.08838834764831845f;
constexpr float NORM_EPS = 1e-5f;
constexpr size_t MiB = 1u << 20;
constexpr size_t WS_CTL = 0, CTL_ZERO_BYTES = 1 * MiB;
constexpr size_t WS_SSQ = 256 * 1024, SSQ_SITE = 32 * 1024;
constexpr size_t WS_VSQ = 512 * 1024;
constexpr size_t WS_ROPE = 1 * MiB;
constexpr size_t WS_KMEAN = 2 * MiB;
constexpr size_t WS_SS = 3 * MiB, SS_SITE = 2 * MiB;
constexpr size_t WS_VS = 13 * MiB;
constexpr size_t WS_SEL = 18 * MiB;
constexpr size_t WS_LSE = 20 * MiB;
constexpr size_t WS_WIN = 32 * MiB;
constexpr size_t WS_WOUT = 176 * MiB;
constexpr size_t WS_SGWIN = 208 * MiB;
constexpr size_t WS_SGWOUT = 272 * MiB;
constexpr size_t WS_WUP = 304 * MiB, WUP_L = 224 * MiB;
constexpr size_t WS_WDOWN = 752 * MiB, WDOWN_L = 112 * MiB;
constexpr size_t WS_XB = 976 * MiB;
constexpr size_t WS_H = 1040 * MiB;
constexpr size_t WS_QKV = 1168 * MiB;
constexpr size_t WS_U = WS_QKV, WS_V = WS_QKV + 64 * MiB;
constexpr size_t WS_O = 1456 * MiB;
constexpr size_t WS_G = 1520 * MiB;
constexpr size_t WS_DO = WS_G;
constexpr size_t WS_APRE = 1744 * MiB;
constexpr size_t WS_TOP = WS_APRE + 128 * MiB, WS_BOT = WS_APRE + 136 * MiB;
constexpr size_t WS_END = 2192 * MiB;
constexpr int RING_OFF = 0, RING_BYTES = 131072;
constexpr int LDSCTL_OFF = RING_BYTES, MISC_OFF = LDSCTL_OFF + 320;
constexpr int XTRA_OFF = RING_BYTES + 1024;
constexpr int LDS_BYTES = 147456;
static_assert(MISC_OFF + 128 <= XTRA_OFF, "LDS map");
constexpr int CW_TMO = 0, CW_BAR = 4096;

#define GAS __attribute__((address_space(1)))
#define LAS __attribute__((address_space(3)))
typedef unsigned short bf16;
typedef unsigned v4u __attribute__((ext_vector_type(4)));
typedef unsigned v2u __attribute__((ext_vector_type(2)));
typedef float f32x4 __attribute__((ext_vector_type(4)));
typedef float f32x2 __attribute__((ext_vector_type(2)));
#define LDS_WAIT() asm volatile("s_waitcnt lgkmcnt(0)" ::: "memory")
#define VM_WAIT() asm volatile("s_waitcnt vmcnt(0)" ::: "memory")
__device__ __forceinline__ unsigned f2bf(float f) { unsigned u = __builtin_bit_cast(unsigned, f); return (u + 0x7fffu + ((u >> 16) & 1u)) >> 16; }
__device__ __forceinline__ unsigned pk2(float lo, float hi) { return f2bf(lo) | (f2bf(hi) << 16); }
__device__ __forceinline__ float bflo(unsigned w) { return __builtin_bit_cast(float, w << 16); }
__device__ __forceinline__ float bfhi(unsigned w) { return __builtin_bit_cast(float, w & 0xffff0000u); }
__device__ __forceinline__ float bf1(bf16 h) { return __builtin_bit_cast(float, (unsigned)h << 16); }
namespace att {
typedef unsigned short bf16;
typedef short bf16x8 __attribute__((ext_vector_type(8)));
typedef short s16x4 __attribute__((ext_vector_type(4)));
typedef float f32x16 __attribute__((ext_vector_type(16)));
typedef float f32x4 __attribute__((ext_vector_type(4)));
typedef unsigned u32x4 __attribute__((ext_vector_type(4)));
template <class A, class Bt> struct same_t { static constexpr bool v = false; };
template <class A> struct same_t<A, A> { static constexpr bool v = true; };
constexpr int D = 128;
constexpr float SCALE = 0.08838834764831845f, THR = 8.f;
constexpr int NW = 8, QBLK = 32, KVBLK = 64, QB = NW * QBLK;
constexpr int SHM_V = KVBLK * D * 2, SHM_K = KVBLK * D * 2;
constexpr int ATT_LDS_BYTES = 2 * SHM_V + 2 * SHM_K + NW * 64 * 4;
#define KSWZ(row, colB) ((row) * 256 + ((colB) ^ (((row) & 7) << 4)))
#define SBAR() __builtin_amdgcn_sched_barrier(0)
__device__ __forceinline__ int v_st(int k, int c) { const int kk = (k & ~0xC) | ((k & 4) << 1) | ((k & 8) >> 1); return ((kk >> 3) * 4 + (c >> 5)) * 512 + ((kk & 7) * 32 + (c & 31)) * 2; }
__device__ __forceinline__ int v_rd_base(int lane) { return ((lane & 3) << 3) | (((lane >> 2) & 3) << 6) | (((lane >> 4) & 1) << 5) | (((lane >> 5) & 1) << 8); }
constexpr int v_rd_off(int d0, int ks, int half) { return d0 * 512 + ks * 4096 + half * 2048; }
__device__ __forceinline__ int crow(int r, int hi) { return (r & 3) + 8 * (r >> 2) + 4 * hi; }
__device__ __forceinline__ unsigned cvtpk(float lo, float hi) {
    unsigned r; asm volatile("v_cvt_pk_bf16_f32 %0, %1, %2" : "=v"(r) : "v"(lo), "v"(hi)); return r;
}
__device__ __forceinline__ bf16x8 pack8(f32x4 a, f32x4 b) {
    u32x4 w = {cvtpk(a[0], a[1]), cvtpk(a[2], a[3]), cvtpk(b[0], b[1]), cvtpk(b[2], b[3])};
    return *reinterpret_cast<bf16x8*>(&w);
}
template <class T> __device__ __forceinline__ bf16x8 load8(const T* p) {
    if constexpr (same_t<T, float>::v) { return pack8(*(const f32x4*)p, *(const f32x4*)(p + 4)); }
    else { return *reinterpret_cast<const bf16x8*>(p); }
}
__device__ __forceinline__ void mask_tile(f32x16& p0, f32x16& p1, int dq, unsigned W) {
    const float NEG = -__builtin_inff();
#pragma unroll
    for (int r = 0; r < 16; ++r) {
        const int c = (r & 3) + 8 * (r >> 2);
        if ((unsigned)(dq - c) >= W) p0[r] = NEG;
        if ((unsigned)(dq - c - 32) >= W) p1[r] = NEG;
    }
}
__device__ __forceinline__ void partialSM(f32x16& p0, f32x16& p1, float& m_reg, float& mn, float& alpha) {
    float pmax = p0[0]; for (int r = 1; r < 16; ++r) pmax = fmaxf(pmax, p0[r]); for (int r = 0; r < 16; ++r) pmax = fmaxf(pmax, p1[r]);
    { auto rr = __builtin_amdgcn_permlane32_swap(__float_as_uint(pmax), __float_as_uint(pmax), false, false);
      pmax = fmaxf(__uint_as_float(rr[0]), __uint_as_float(rr[1])); }
    constexpr float C2 = 1.4426950408889634f * SCALE;
    if (__builtin_expect(__all((pmax - m_reg) * SCALE <= THR), 1)) { mn = m_reg; alpha = 1.f; }
    else { mn = fmaxf(m_reg, pmax); alpha = __builtin_amdgcn_exp2f((m_reg - mn) * C2); m_reg = mn; }
    const float mnL = -mn * C2;
    for (int r = 0; r < 16; ++r) p0[r] = fmaf(p0[r], C2, mnL); for (int r = 0; r < 16; ++r) p1[r] = fmaf(p1[r], C2, mnL);
    for (int r = 0; r < 16; ++r) p0[r] = __builtin_amdgcn_exp2f(p0[r]);
}
__device__ __forceinline__ void finishSM(f32x16& p0, f32x16& p1, float alpha, float& l_reg, bf16x8& pa0, bf16x8& pa1, bf16x8& pa2, bf16x8& pa3) {
    for (int r = 0; r < 16; ++r) p1[r] = __builtin_amdgcn_exp2f(p1[r]);
    float ps = 0; for (int r = 0; r < 16; ++r) ps += p0[r]; for (int r = 0; r < 16; ++r) ps += p1[r];
    { auto rr = __builtin_amdgcn_permlane32_swap(__float_as_uint(ps), __float_as_uint(ps), false, false);
      ps = __uint_as_float(rr[0]) + __uint_as_float(rr[1]); }
    l_reg = l_reg * alpha + ps;
#define PK4(P, B_, OUT) do { unsigned a0 = cvtpk(P[B_+0], P[B_+1]), a1 = cvtpk(P[B_+2], P[B_+3]);                          \
        unsigned b0 = cvtpk(P[B_+4], P[B_+5]), b1 = cvtpk(P[B_+6], P[B_+7]);                                             \
        auto r0 = __builtin_amdgcn_permlane32_swap(a0, b0, false, false); auto r1 = __builtin_amdgcn_permlane32_swap(a1, b1, false, false); \
        u32x4 w = {r0[0], r1[0], r0[1], r1[1]}; OUT = *reinterpret_cast<bf16x8*>(&w); } while (0)
    PK4(p0, 0, pa0); PK4(p0, 8, pa1); PK4(p1, 0, pa2); PK4(p1, 8, pa3);
#undef PK4
}
template <int KB, bool SK>
__device__ __forceinline__ void qkt(f32x16& p0, f32x16& p1, const char* K_lds, int r32, int hi, const bf16x8* qr, bool act) {
    if (SK && !act) { const float NEG = -__builtin_inff();
#pragma unroll
        for (int r = 0; r < 16; ++r) { p0[r] = NEG; p1[r] = NEG; } return; }
    p0 = f32x16{}; p1 = f32x16{};
    const char* kb[4];
#pragma unroll
    for (int dd = 0; dd < 4; ++dd) kb[dd] = K_lds + KB * SHM_K + KSWZ(r32, (dd * 16 + hi * 8) * 2);
#pragma unroll
    for (int d0 = 0; d0 < 8; ++d0) { const char* a = kb[d0 & 3] + (d0 >> 2) * 128;
        bf16x8 b0 = *reinterpret_cast<const bf16x8*>(a);
        bf16x8 b1 = *reinterpret_cast<const bf16x8*>(a + 32 * 256);
        p0 = __builtin_amdgcn_mfma_f32_32x32x16_bf16(b0, qr[d0], p0, 0, 0, 0);
        p1 = __builtin_amdgcn_mfma_f32_32x32x16_bf16(b1, qr[d0], p1, 0, 0, 0); }
}
template <int VB, bool SK>
__device__ __forceinline__ void pv_tile(f32x16* o, int vb0, bf16x8 pa0, bf16x8 pa1, bf16x8 pa2, bf16x8 pa3, bool act) {
    if (SK && !act) return;
#define TRRD(dst, off) asm volatile("ds_read_b64_tr_b16 %0, %1 offset:%2" : "=&v"(dst) : "v"(vb0), "i"(off) : "memory")
#define PV_D0(d0) do { s16x4 l0, l1, l2, l3, h0, h1, h2, h3; constexpr int b_ = VB * SHM_V + v_rd_off(d0, 0, 0);     \
        TRRD(l0, b_); TRRD(h0, b_ + 2048); TRRD(l1, b_ + 4096); TRRD(h1, b_ + 6144); TRRD(l2, b_ + 8192); TRRD(h2, b_ + 10240); TRRD(l3, b_ + 12288); TRRD(h3, b_ + 14336); \
        asm volatile("s_waitcnt lgkmcnt(0)" ::: "memory"); SBAR();                 \
        o[d0] = __builtin_amdgcn_mfma_f32_32x32x16_bf16(pa0, (bf16x8){l0[0], l0[1], l0[2], l0[3], h0[0], h0[1], h0[2], h0[3]}, o[d0], 0, 0, 0);   \
        o[d0] = __builtin_amdgcn_mfma_f32_32x32x16_bf16(pa1, (bf16x8){l1[0], l1[1], l1[2], l1[3], h1[0], h1[1], h1[2], h1[3]}, o[d0], 0, 0, 0);   \
        o[d0] = __builtin_amdgcn_mfma_f32_32x32x16_bf16(pa2, (bf16x8){l2[0], l2[1], l2[2], l2[3], h2[0], h2[1], h2[2], h2[3]}, o[d0], 0, 0, 0);   \
        o[d0] = __builtin_amdgcn_mfma_f32_32x32x16_bf16(pa3, (bf16x8){l3[0], l3[1], l3[2], l3[3], h3[0], h3[1], h3[2], h3[3]}, o[d0], 0, 0, 0); } while (0)
    PV_D0(0); PV_D0(1); PV_D0(2); PV_D0(3);
#undef PV_D0
#undef TRRD
}

template <class TIn, class TOut> struct BlockRef { const TIn* Q; const TIn* K; const TIn* V; TOut* O; int P0; const unsigned short* sel; float* L; };
template <class TIn> struct Seam {
    bf16x8 qr[8];
    bf16x8 st_v0, st_v1, st_k0, st_k1; f32x4 sf0, sf1, sf2, sf3;
    f32x4 tq[16];
};
__device__ __forceinline__ int swa_jlo(int P0, int W) { const int lowk = P0 - W + 1; return lowk > 0 ? lowk / KVBLK : 0; }
#define ROW(p, k0, rr) ((p) + (size_t)((k0) + (rr)) * rs_ + sc)
#define ROWN(p, k0, rr) ((p) + (size_t)((k0) + (rr)) * rsn_ + sc)
#define VMW() asm volatile("s_waitcnt vmcnt(0)" ::: "memory")
#define VMWN(n) asm volatile("s_waitcnt vmcnt(%0)" :: "i"(n) : "memory")
#define SLOAD_H(Kp, Vp, k0) do { S.st_v0 = load8<TIn>(ROW(Vp, k0, sr)); S.st_v1 = load8<TIn>(ROW(Vp, k0, 32 + sr));              \
                         S.st_k0 = load8<TIn>(ROW(Kp, k0, sr)); S.st_k1 = load8<TIn>(ROW(Kp, k0, 32 + sr)); } while (0)
#define SLOAD_HN(Kp, Vp, k0) do { S.st_v0 = load8<TIn>(ROWN(Vp, k0, sr)); S.st_v1 = load8<TIn>(ROWN(Vp, k0, 32 + sr));              \
                         S.st_k0 = load8<TIn>(ROWN(Kp, k0, sr)); S.st_k1 = load8<TIn>(ROWN(Kp, k0, 32 + sr)); } while (0)
#define SWRITE_HK(bf) do { *(bf16x8*)(K_lds + (bf) * SHM_K + kws) = S.st_k0; *(bf16x8*)(K_lds + (bf) * SHM_K + kws + 32 * 256) = S.st_k1; } while (0)
#define SWRITE_HV(bf) do { *(bf16x8*)(V_lds + (bf) * SHM_V + vst0) = S.st_v0; *(bf16x8*)(V_lds + (bf) * SHM_V + vst1) = S.st_v1; } while (0)
#define SWRITE_H(bf) do { SWRITE_HV(bf); SWRITE_HK(bf); } while (0)
#define SLOAD_F(p, k0) do { S.sf0 = *(const f32x4*)ROW(p, k0, sr); S.sf1 = *(const f32x4*)(ROW(p, k0, sr) + 4);                \
                            S.sf2 = *(const f32x4*)ROW(p, k0, 32 + sr); S.sf3 = *(const f32x4*)(ROW(p, k0, 32 + sr) + 4); } while (0)
#define SWRITE_KF(bf) do { *(bf16x8*)(K_lds + (bf) * SHM_K + kws) = pack8(S.sf0, S.sf1); *(bf16x8*)(K_lds + (bf) * SHM_K + kws + 32 * 256) = pack8(S.sf2, S.sf3); } while (0)
#define SWRITE_VF(bf) do { *(bf16x8*)(V_lds + (bf) * SHM_V + vst0) = pack8(S.sf0, S.sf1); *(bf16x8*)(V_lds + (bf) * SHM_V + vst1) = pack8(S.sf2, S.sf3); } while (0)
template <class TIn, class TOut, int RSC, int W>
__device__ __forceinline__ void causal_swa_prime(const BlockRef<TIn, TOut>& cur, char* lds, Seam<TIn>& S) {
    constexpr bool F32 = same_t<TIn, float>::v;
    const int tid = threadIdx.x, wid = __builtin_amdgcn_readfirstlane(tid >> 6), lane = tid & 63, r32 = lane & 31, hi = lane >> 5;
    const int sr = tid >> 4, sc = (tid & 15) * 8, kws = KSWZ(sr, sc * 2); char* K_lds = lds + 2 * SHM_V;
    const int kb0 = swa_jlo(cur.P0, W) * KVBLK; constexpr int rs_ = RSC;
    for (int d0 = 0; d0 < 8; ++d0) S.qr[d0] = load8<TIn>(cur.Q + (size_t)(wid * QBLK + r32) * rs_ + d0 * 16 + hi * 8);
    if constexpr (F32) { SLOAD_F((const float*)cur.K, kb0); VMW(); SWRITE_KF(0); SBAR(); SLOAD_F((const float*)cur.V, kb0); }
    else { SLOAD_H(cur.K, cur.V, kb0); VMW(); SWRITE_HK(0); }
    __syncthreads();
}
template <class TIn, class TOut, bool SKP, int MODE, int RSC, int RSN, int OSC, int W, int WN, int skv>
__device__ __forceinline__ void causal_swa_block(const BlockRef<TIn, TOut>& cur, const BlockRef<TIn, TOut>& nxt, char* lds, Seam<TIn>& S) {
    constexpr bool F32 = same_t<TIn, float>::v; static_assert(!F32, "bf16 inputs only in this build");
    constexpr int rs_ = RSC, rsn_ = RSN, os_ = OSC;
    const int tid = threadIdx.x, wid = __builtin_amdgcn_readfirstlane(tid >> 6), lane = tid & 63, r32 = lane & 31, hi = lane >> 5;
    const int j_lo = swa_jlo(cur.P0, W);
    int j_hi = (cur.P0 + QB - 1) / KVBLK + 1; if (j_hi > skv / KVBLK) j_hi = skv / KVBLK;
    const int NT = j_hi - j_lo;
    const int kbn = swa_jlo(nxt.P0, WN) * KVBLK;
    const int qlo = cur.P0 + wid * QBLK, qm = qlo + r32 - 4 * hi;
    char* V_lds = lds; char* K_lds = lds + 2 * SHM_V;
    float* ws = (float*)(lds + 2 * SHM_V + 2 * SHM_K) + wid * 64; float* li_l = ws, * al_l = ws + 32;
    float m_reg = -1e30f, l_reg = 0; f32x16 o[4] = {};
    unsigned selm = 0u; if constexpr (MODE == 0) selm = cur.sel[wid * QBLK + r32];
    const int sr = tid >> 4, sc = (tid & 15) * 8, vst0 = v_st(sr, sc), vst1 = v_st(32 + sr, sc), kws = KSWZ(sr, sc * 2);
    const int vb0 = (int)(uintptr_t)V_lds + v_rd_base(lane);
    const TIn* Kh = cur.K; const TIn* Vh = cur.V;
#define RESC(a) do { if (__any((a) < 1.f)) { if (hi == 0) al_l[r32] = (a); asm volatile("s_waitcnt lgkmcnt(0)" ::: "memory");              \
                     for (int d_ = 0; d_ < 4; ++d_) for (int r = 0; r < 16; ++r) o[d_][r] *= al_l[crow(r, hi)]; } } while (0)
#define KBASE(t) ((j_lo + (t)) * KVBLK)
#define ACT(t) (KBASE(t) <= qlo + QBLK - 1 && KBASE(t) + KVBLK - 1 >= qlo - W + 1)
#define MASKT(P0_, P1_, t) do { const int kb_ = KBASE(t); if ((!SK || ACT(t)) && (kb_ + KVBLK - 1 > qlo || kb_ <= qlo + QBLK - 1 - W)) mask_tile(P0_, P1_, qm - kb_, (unsigned)W); \
        if constexpr (MODE == 0) { if (kb_ < cur.P0) { const bool dead_ = ((selm >> (kb_ >> 8)) & 1u) == 0u; const float NEG_ = -__builtin_inff(); \
            _Pragma("unroll") for (int r_ = 0; r_ < 16; ++r_) { P0_[r_] = dead_ ? NEG_ : P0_[r_]; P1_[r_] = dead_ ? NEG_ : P1_[r_]; } } } } while (0)
    constexpr int NQL = F32 ? 16 : 8;
    constexpr bool SK = SKP && !F32;
#define SEAM_K0() do { VMWN(NQL); if constexpr (F32) { SWRITE_KF(0); SBAR(); SLOAD_F((const float*)nxt.V, kbn); } else { SWRITE_HK(0); } SBAR(); } while (0)
    f32x16 pA0, pA1, pB0, pB1; float mnA, mnB, alA, alB; bf16x8 pa0, pa1, pa2, pa3;
    if constexpr (F32) { VMW(); SWRITE_VF(0); SBAR(); } else { SWRITE_HV(0); SBAR(); }
    if (NT > 1) { if constexpr (F32) SLOAD_F((const float*)Kh, KBASE(1)); else SLOAD_H(Kh, Vh, KBASE(1)); }
    SBAR(); qkt<0, SK>(pA0, pA1, K_lds, r32, hi, S.qr, ACT(0));
    if constexpr (F32) { if (NT > 1) { VMW(); SWRITE_KF(1); SBAR(); SLOAD_F((const float*)Vh, KBASE(1)); } }
    MASKT(pA0, pA1, 0); partialSM(pA0, pA1, m_reg, mnA, alA);
    if (NT > 1) { VMW(); if constexpr (F32) { SWRITE_VF(1); SBAR(); if (NT > 2) SLOAD_F((const float*)Kh, KBASE(2)); } else SWRITE_H(1); }
    __syncthreads();
#define HALF_STEP(PX0, PX1, mnX, alX, PY0, PY1, alY, t, KB, VB, SB) do {                                                      \
        SBAR(); qkt<KB, SK>(PX0, PX1, K_lds, r32, hi, S.qr, ACT(t));                                             \
        finishSM(PY0, PY1, alY, l_reg, pa0, pa1, pa2, pa3); SBAR();                                                           \
        if ((t) + 1 < NT) { if constexpr (F32) { VMW(); SWRITE_KF(SB); SBAR(); SLOAD_F((const float*)Vh, KBASE((t) + 1)); }  \
                            else { SLOAD_H(Kh, Vh, KBASE((t) + 1)); } SBAR(); }                                               \
        pv_tile<VB, SK>(o, vb0, pa0, pa1, pa2, pa3, ACT((t) - 1)); MASKT(PX0, PX1, (t)); partialSM(PX0, PX1, m_reg, mnX, alX);                                        \
        __syncthreads();                                                                                                      \
        if ((t) + 1 < NT) { VMW(); if constexpr (F32) { SWRITE_VF(SB); SBAR(); if ((t) + 2 < NT) SLOAD_F((const float*)Kh, KBASE((t) + 2)); } \
                            else { SWRITE_H(SB); } }                                                                          \
        RESC(alX); __syncthreads(); } while (0)
    for (int t = 1; t + 1 < NT; t += 2) {
        HALF_STEP(pB0, pB1, mnB, alB, pA0, pA1, alA, t, 1, 0, 0);
        HALF_STEP(pA0, pA1, mnA, alA, pB0, pB1, alB, t + 1, 0, 1, 1);
    }
    const bool even = (NT & 1) == 0;
    if (even) { SBAR(); qkt<1, SK>(pB0, pB1, K_lds, r32, hi, S.qr, ACT(NT - 1)); SBAR(); }
#define QROW(e) (nxt.Q + (size_t)(wid * QBLK + r32) * rsn_ + ((e) >> 1) * 16 + hi * 8 + ((e) & 1) * 4)
    if constexpr (F32) { SLOAD_F((const float*)nxt.K, kbn); SBAR();
#pragma unroll
        for (int e = 0; e < 8; ++e) S.tq[e] = *(const f32x4*)QROW(e); }
    else { SLOAD_HN(nxt.K, nxt.V, kbn); SBAR();
#pragma unroll
        for (int d0 = 0; d0 < 8; ++d0) S.qr[d0] = load8<TIn>(nxt.Q + (size_t)(wid * QBLK + r32) * rsn_ + d0 * 16 + hi * 8); }
    SBAR();
    finishSM(pA0, pA1, alA, l_reg, pa0, pa1, pa2, pa3); SBAR();
    if constexpr (F32) {
#pragma unroll
        for (int e = 8; e < 16; ++e) S.tq[e] = *(const f32x4*)QROW(e); SBAR(); }
#undef QROW
    pv_tile<0, SK>(o, vb0, pa0, pa1, pa2, pa3, ACT(even ? NT - 2 : NT - 1));
    if (even) { MASKT(pB0, pB1, NT - 1); partialSM(pB0, pB1, m_reg, mnB, alB); __syncthreads(); RESC(alB);
        finishSM(pB0, pB1, alB, l_reg, pa0, pa1, pa2, pa3); SBAR(); pv_tile<1, SK>(o, vb0, pa0, pa1, pa2, pa3, ACT(NT - 1)); }
    SBAR(); SEAM_K0();
    if (hi == 0) li_l[r32] = l_reg; asm volatile("s_waitcnt lgkmcnt(0)" ::: "memory");
    if constexpr (MODE == 1) { if (hi == 0) cur.L[(size_t)(wid * QBLK + r32) * (RSC / 128 * 24)] = m_reg * SCALE + __logf(l_reg); }
    float rli[16];
#pragma unroll
    for (int r = 0; r < 16; ++r) rli[r] = __builtin_amdgcn_rcpf(li_l[crow(r, hi)]);
    TOut* Ow = cur.O + (size_t)(wid * QBLK) * os_;
#pragma unroll
    for (int r = 0; r < 16; ++r) { const int orow = crow(r, hi);
#pragma unroll
        for (int d0 = 0; d0 < 4; ++d0) { const float v = o[d0][r] * rli[r];
            if constexpr (same_t<TOut, float>::v) { Ow[(size_t)orow * os_ + d0 * 32 + r32] = v; }
            else { const float vn = __shfl_xor(v, 1);
                   if ((r32 & 1) == 0) *(unsigned*)(Ow + (size_t)orow * os_ + d0 * 32 + r32) = cvtpk(v, vn); } } }
    if constexpr (F32) {
#pragma unroll
        for (int d0 = 0; d0 < 8; ++d0) S.qr[d0] = pack8(S.tq[2 * d0], S.tq[2 * d0 + 1]); }
    __syncthreads();
#undef RESC
#undef KBASE
#undef ACT
#undef MASKT
#undef SEAM_K0
#undef HALF_STEP
}
#undef ROW
#undef ROWN
#undef SLOAD_HN
#undef VMW
#undef VMWN
#undef SLOAD_H
#undef SWRITE_HK
#undef SWRITE_HV
#undef SWRITE_H
#undef SLOAD_F
#undef SWRITE_KF
#undef SWRITE_VF
}
#define XB_TMO      128
#define XB_XCNT(j)  (256  + 64 * (j))
#define XB_XSUB(j)  (1280 + 64 * (j))
#define XB_XGEN(j)  (2304 + 64 * (j))
#define XB_TOP      3328
#define XB_TOPGEN   3392
#define XCD_BAR_WORDS 3456
#define XB_SPIN_CAP (1u << 18)

__device__ __forceinline__ unsigned xb_ld(unsigned* p)              { return __hip_atomic_load(p, __ATOMIC_RELAXED, __HIP_MEMORY_SCOPE_AGENT); }
__device__ __forceinline__ unsigned xb_add(unsigned* p, unsigned v) { return __hip_atomic_fetch_add(p, v, __ATOMIC_RELAXED, __HIP_MEMORY_SCOPE_AGENT); }
__device__ __forceinline__ unsigned xb_xcc_id() { return (unsigned)__builtin_amdgcn_s_getreg((3 << 11) | 20) & 0xFu; }
#define XB_SPIN(cond, bar) do { unsigned _sp = 0; while (cond) { __builtin_amdgcn_s_sleep(1); \
    if ((++_sp & 255u) == 0u) { if (xb_ld(&(bar)[XB_TMO])) break; if (_sp > XB_SPIN_CAP) { atomicAdd(&(bar)[XB_TMO], 1u); break; } } } } while (0)

struct XcdBarrier {
    unsigned* bar; unsigned x;
    volatile LAS unsigned* st;
};

__device__ __forceinline__ XcdBarrier xcd_barrier_post(unsigned* bar, volatile LAS unsigned* st) {
    XcdBarrier b; b.bar = bar; b.x = xb_xcc_id(); b.st = st;
    if (threadIdx.x == 0) (void)xb_add(&bar[XB_XCNT(b.x)], 1u);
    return b;
}
__device__ __forceinline__ void xcd_barrier_complete(unsigned* bar, unsigned x, unsigned& nloc, unsigned& nx) {
    const unsigned G = gridDim.x * gridDim.y * gridDim.z;
    unsigned sum, cnt, mine, sp = 0u;
    for (;;) {
        sum = 0u; cnt = 0u; mine = 0u;
#pragma unroll
        for (unsigned j = 0; j < 16; ++j) { const unsigned c = xb_ld(&bar[XB_XCNT(j)]); sum += c; cnt += (c > 0u) ? 1u : 0u; mine = (j == x) ? c : mine; }
        if (sum == G) break;
        __builtin_amdgcn_s_sleep(1);
        if ((++sp & 255u) == 0u) { if (xb_ld(&bar[XB_TMO])) break; if (sp > XB_SPIN_CAP) { atomicAdd(&bar[XB_TMO], 1u); break; } }
    }
    nloc = mine > 0u ? mine : 1u; nx = cnt > 0u ? cnt : 1u;
}

__device__ __forceinline__ void xcd_barrier(const XcdBarrier& b) {
    asm volatile("s_waitcnt vmcnt(0)" ::: "memory");
    __syncthreads();
    if (threadIdx.x == 0) {
        unsigned* bar = b.bar;
        __builtin_amdgcn_s_waitcnt(0);
        unsigned nloc = b.st[0], nx = b.st[1];
        if (nloc == 0u) { xcd_barrier_complete(bar, b.x, nloc, nx); b.st[0] = nloc; b.st[1] = nx; }
        const unsigned old = xb_add(&bar[XB_XSUB(b.x)], 1u);
        const unsigned gen = old / nloc;
        if (old + 1u == (gen + 1u) * nloc) {
            __builtin_amdgcn_fence(__ATOMIC_RELEASE, "agent");
            asm volatile("s_waitcnt vmcnt(0)" ::: "memory");
            const unsigned og = xb_add(&bar[XB_TOP], 1u);
            const unsigned tg = og / nx;
            if (og + 1u == (tg + 1u) * nx) xb_add(&bar[XB_TOPGEN], 1u);
            else XB_SPIN(xb_ld(&bar[XB_TOPGEN]) == tg, bar);
            __builtin_amdgcn_fence(__ATOMIC_ACQUIRE, "agent");
            xb_add(&bar[XB_XGEN(b.x)], 1u);
            asm volatile("s_waitcnt vmcnt(0)" ::: "memory");
        } else {
            XB_SPIN(xb_ld(&bar[XB_XGEN(b.x)]) == gen, bar);
            __builtin_amdgcn_fence(__ATOMIC_ACQUIRE, "agent");
            asm volatile("s_waitcnt vmcnt(0)" ::: "memory");
        }
    }
    __syncthreads();
}
struct Frame {
    LAS unsigned char* lds;
    volatile LAS unsigned* MISC;
    unsigned* ctl;
    int tid, lane, wave, G, gw, NGW;
    unsigned char* ws;
    const float* x; const int* pos;
    const float *attn_norm, *attn_w_in, *attn_w_out, *sg_norm, *sg_w_in, *sg_b_in, *sg_v_gain, *sg_v_bias, *sg_w_s, *sg_b_s, *sg_w_out, *ffn_norm, *ffn_w_up, *ffn_conv_w, *ffn_conv_b, *ffn_w_down, *final_norm;
    float* out;
};
__device__ __forceinline__ float wave_sum(float v) {
#pragma unroll
    for (int o = 1; o < 64; o <<= 1) v += __shfl_xor(v, o);
    return v;
}
__device__ __forceinline__ float wave_max(float v) {
#pragma unroll
    for (int o = 1; o < 64; o <<= 1) v = fmaxf(v, __shfl_xor(v, o));
    return v;
}
__device__ __forceinline__ float ss_rstd(const float* ss, int r) { return pg8::rstd_from_ss(ss, r); }

struct MapId { __device__ __forceinline__ int operator()(int n) const { return n; } };
struct MapUp { __device__ __forceinline__ int operator()(int n) const { return n < DFF ? ((n >> 7) << 8) + (n & 127) : (((n - DFF) >> 7) << 8) + 128 + ((n - DFF) & 127); } };
template <class RowMap>
__device__ __forceinline__ void transpose_item(const float* W, int K, int N, const float* gain, bf16* WT, RowMap rm, LAS float* scr, int item, int lane) {
    const int nblk = N / 32, kb = item / nblk, nb = item - kb * nblk, k0 = 64 * kb, n0 = 32 * nb;
#pragma unroll 8
    for (int i = 0; i < 32; ++i) { const int kk = 2 * i + (lane >> 5); float v = W[(size_t)(k0 + kk) * N + n0 + (lane & 31)]; if (gain) v *= gain[k0 + kk]; scr[kk * 33 + (lane & 31)] = v; }
    LDS_WAIT(); asm volatile("" ::: "memory");
    const int c = lane & 7;
#pragma unroll
    for (int j = 0; j < 4; ++j) { const int n = (lane >> 3) + 8 * j; const LAS float* s = scr + (8 * c) * 33 + n;
        v4u o; o.x = pk2(s[0 * 33], s[1 * 33]); o.y = pk2(s[2 * 33], s[3 * 33]); o.z = pk2(s[4 * 33], s[5 * 33]); o.w = pk2(s[6 * 33], s[7 * 33]);
        *(v4u*)(WT + (size_t)rm(n0 + n) * K + k0 + 8 * c) = o; }
    LDS_WAIT(); asm volatile("" ::: "memory");
}
__device__ __forceinline__ void sincos_d(double a, double& sn, double& cs) {
    const double n = __builtin_rint(a * 0.15915494309189535);
    const double r = a - n * 6.283185307179586;
    const double r2 = r * r;
    double ts = r, tc = 1.0, s = r, c = 1.0;
#pragma unroll
    for (int k = 1; k <= 15; ++k) { tc = -tc * r2 / (double)((2 * k - 1) * (2 * k)); ts = -ts * r2 / (double)((2 * k) * (2 * k + 1)); c += tc; s += ts; }
    sn = s; cs = c;
}
__device__ __forceinline__ void p0_prologue(Frame& F) {
    LAS float* scr = (LAS float*)(F.lds + RING_OFF + F.wave * 16384);
    constexpr int I_WIN = 64 * (QKVC / 32), I_SQ = 64 * (DM / 32), I_SGIN = 64 * (2 * DM / 32), I_UP = 64 * (F2 / 32), I_DN = (DFF / 64) * (DM / 32);
    constexpr int NITEMS = I_WIN + 2 * I_SQ + I_SGIN + 2 * I_UP + 2 * I_DN;
    for (int it = F.gw; it < NITEMS; it += F.NGW) {
        int r = it;
        if (r < I_WIN) { transpose_item(F.attn_w_in, DM, QKVC, F.attn_norm, (bf16*)(F.ws + WS_WIN), MapId(), scr, r, F.lane); continue; } r -= I_WIN;
        if (r < I_SQ) { transpose_item(F.attn_w_out, DM, DM, nullptr, (bf16*)(F.ws + WS_WOUT), MapId(), scr, r, F.lane); continue; } r -= I_SQ;
        if (r < I_SGIN) { transpose_item(F.sg_w_in, DM, 2 * DM, F.sg_norm, (bf16*)(F.ws + WS_SGWIN), MapId(), scr, r, F.lane); continue; } r -= I_SGIN;
        if (r < I_SQ) { transpose_item(F.sg_w_out, DM, DM, nullptr, (bf16*)(F.ws + WS_SGWOUT), MapId(), scr, r, F.lane); continue; } r -= I_SQ;
        if (r < I_UP) { transpose_item(F.ffn_w_up, DM, F2, F.ffn_norm, (bf16*)(F.ws + WS_WUP), MapUp(), scr, r, F.lane); continue; } r -= I_UP;
        if (r < I_UP) { transpose_item(F.ffn_w_up + (size_t)DM * F2, DM, F2, F.ffn_norm + DM, (bf16*)(F.ws + WS_WUP + WUP_L), MapUp(), scr, r, F.lane); continue; } r -= I_UP;
        if (r < I_DN) { transpose_item(F.ffn_w_down, DFF, DM, nullptr, (bf16*)(F.ws + WS_WDOWN), MapId(), scr, r, F.lane); continue; } r -= I_DN;
        transpose_item(F.ffn_w_down + (size_t)DFF * DM, DFF, DM, nullptr, (bf16*)(F.ws + WS_WDOWN + WDOWN_L), MapId(), scr, r, F.lane);
    }
    bf16* XB = (bf16*)(F.ws + WS_XB); float* SS0 = (float*)(F.ws + WS_SSQ);
    for (int m = F.gw; m < MR; m += F.NGW) {
        const f32x4* xr = (const f32x4*)(F.x + (size_t)m * DM) + F.lane;
        v2u* o8 = (v2u*)(XB + (size_t)m * DM) + F.lane;
        float sq = 0.f;
#pragma unroll
        for (int j = 0; j < 16; ++j) { const f32x4 v = xr[64 * j]; sq += (v[0] * v[0] + v[1] * v[1]) + (v[2] * v[2] + v[3] * v[3]); v2u w; w.x = pk2(v[0], v[1]); w.y = pk2(v[2], v[3]); o8[64 * j] = w; }
        sq = wave_sum(sq);
        if (F.lane == 0) SS0[m] = sq;
    }
    float* rc = (float*)(F.ws + WS_ROPE); float* rs = rc + MR * 16;
    for (int idx = F.gw * 64 + F.lane; idx < MR * 16; idx += F.NGW * 64) {
        const int r = idx >> 4, i = idx & 15;
        double invd = 1.0;
        for (int k = 0; k < i; ++k) invd *= 0.44036660267178046;
        const float inv = (float)invd;
        const float ang = (float)F.pos[r] * inv;
        double sn, cs; sincos_d((double)ang, sn, cs);
        rc[idx] = (float)cs; rs[idx] = (float)sn;
    }
}

__device__ __forceinline__ void p_kmean(Frame& F) {
    const bf16* QKV = (const bf16*)(F.ws + WS_QKV); float* KM = (float*)(F.ws + WS_KMEAN);
    LAS float* red = (LAS float*)(F.lds + RING_OFF);
    for (int item = blockIdx.x; item < NB * NHA * 16; item += F.G) {
        const int j = item & 15, bh = item >> 4, b = bh / NHA, h = bh - b * NHA;
        const bf16* kb = QKV + ((size_t)((1 * 2 + b) * NHQ + h) * NS + 256 * j) * HD;
        const int d = F.tid & 127, part = F.tid >> 7;
        float s = 0.f;
        for (int i = 0; i < 64; ++i) s += bf1(kb[(size_t)(part * 64 + i) * HD + d]);
        red[part * 128 + d] = s;
        __syncthreads();
        if (F.tid < 128) KM[(size_t)item * 128 + F.tid] = (red[F.tid] + red[128 + F.tid] + red[256 + F.tid] + red[384 + F.tid]) * (1.0f / 256.0f);
        __syncthreads();
    }
}

__device__ __forceinline__ float dot128(const LAS float* qs, const bf16* krow) {
    float s = 0.f;
#pragma unroll 4
    for (int c = 0; c < 16; ++c) {
        const v4u kv = *(const v4u*)(krow + 8 * c); const LAS float* q8 = qs + 8 * c;
        s += q8[0] * bflo(kv.x) + q8[1] * bfhi(kv.x) + q8[2] * bflo(kv.y) + q8[3] * bfhi(kv.y) + q8[4] * bflo(kv.z) + q8[5] * bfhi(kv.z) + q8[6] * bflo(kv.w) + q8[7] * bfhi(kv.w);
    }
    return s;
}
__device__ __forceinline__ void p_attn_naive(Frame& F, bf16* O) {
    const bf16* QKV = (const bf16*)(F.ws + WS_QKV); const float* KM = (const float*)(F.ws + WS_KMEAN);
    LAS float* qs = (LAS float*)(F.lds + RING_OFF + F.wave * 8192);
    LAS float* ps = qs + 128;
    const int lane = F.lane;
    constexpr int NMOBA = NB * NHA * NS, NDIL = NB * 8 * NS;
    const float NEG = -__builtin_inff();
    for (int task = F.gw; task < NMOBA + NDIL; task += F.NGW) {
        if (task < NMOBA) {
            const int b = task / (NHA * NS), rem = task - b * (NHA * NS), h = rem >> 12, t = rem & 4095;
            const bf16* qrow = QKV + ((size_t)((0 * 2 + b) * NHQ + h) * NS + t) * HD;
            const bf16* Kb = QKV + (size_t)((1 * 2 + b) * NHQ + h) * NS * HD;
            const bf16* Vb = QKV + (size_t)((2 * 2 + b) * NHQ + h) * NS * HD;
            { const unsigned w = *(const unsigned*)(qrow + 2 * lane); qs[2 * lane] = bflo(w); qs[2 * lane + 1] = bfhi(w); }
            LDS_WAIT(); asm volatile("" ::: "memory");
            const int qb = t >> 8, tin = t & 255;
            float g = NEG;
            if (lane < qb) { const float* km = KM + ((size_t)((b * NHA + h) * 16 + lane)) * 128; float s = 0.f; for (int d = 0; d < 128; ++d) s += qs[d] * km[d]; g = s; }
            unsigned selmask = 0u;
            if (qb <= 3) selmask = (1u << qb) - 1u;
            else {
#pragma unroll
                for (int rd = 0; rd < 3; ++rd) {
                    float best = g; int bi = lane;
#pragma unroll
                    for (int o = 1; o < 64; o <<= 1) { const float ob = __shfl_xor(best, o); const int oi = __shfl_xor(bi, o); if (ob > best || (ob == best && oi < bi)) { best = ob; bi = oi; } }
                    selmask |= 1u << bi; if (lane == bi) g = NEG;
                }
            }
            float sc[4][4]; int jsel[3];
            unsigned mk = selmask;
#pragma unroll
            for (int sl = 0; sl < 3; ++sl) {
                int j = -1; if (mk) { j = __builtin_ctz(mk); mk &= mk - 1u; }
                jsel[sl] = j;
#pragma unroll
                for (int c = 0; c < 4; ++c) sc[sl][c] = (j >= 0) ? ATT_SCALE * dot128(qs, Kb + (size_t)(256 * j + lane + 64 * c) * HD) : NEG;
            }
#pragma unroll
            for (int c = 0; c < 4; ++c) { const int i = lane + 64 * c; sc[3][c] = (i <= tin) ? ATT_SCALE * dot128(qs, Kb + (size_t)(256 * qb + i) * HD) : NEG; }
            float mx = NEG;
#pragma unroll
            for (int sl = 0; sl < 4; ++sl)
#pragma unroll
                for (int c = 0; c < 4; ++c) mx = fmaxf(mx, sc[sl][c]);
            mx = wave_max(mx);
            float sum = 0.f;
#pragma unroll
            for (int sl = 0; sl < 4; ++sl)
#pragma unroll
                for (int c = 0; c < 4; ++c) { sc[sl][c] = __expf(sc[sl][c] - mx); sum += sc[sl][c]; }
            sum = wave_sum(sum);
            const float inv = 1.0f / sum;
#pragma unroll
            for (int sl = 0; sl < 4; ++sl)
#pragma unroll
                for (int c = 0; c < 4; ++c) ps[sl * 256 + lane + 64 * c] = sc[sl][c] * inv;
            LDS_WAIT(); asm volatile("" ::: "memory");
            float o0 = 0.f, o1 = 0.f;
#pragma unroll
            for (int sl = 0; sl < 3; ++sl) {
                if (jsel[sl] >= 0) { const bf16* vb = Vb + (size_t)(256 * jsel[sl]) * HD + 2 * lane;
                    for (int i = 0; i < 256; ++i) { const float p = ps[sl * 256 + i]; const unsigned w = *(const unsigned*)(vb + (size_t)i * HD); o0 += p * bflo(w); o1 += p * bfhi(w); } }
            }
            { const bf16* vb = Vb + (size_t)(256 * qb) * HD + 2 * lane;
              for (int i = 0; i <= tin; ++i) { const float p = ps[3 * 256 + i]; const unsigned w = *(const unsigned*)(vb + (size_t)i * HD); o0 += p * bflo(w); o1 += p * bfhi(w); } }
            *(unsigned*)(O + (size_t)(b * NS + t) * DM + h * HD + 2 * lane) = pk2(o0, o1);
            LDS_WAIT(); asm volatile("" ::: "memory");
        } else {
            const int td = task - NMOBA, b = td / (8 * NS), rem = td - b * (8 * NS), hh = rem >> 12, t = rem & 4095;
            float lse[3], og0[3], og1[3];
#pragma unroll
            for (int g = 0; g < 3; ++g) {
                const int head = NHA + g * 8 + hh, dil = g == 0 ? 1 : (g == 1 ? 4 : 16);
                const bf16* qrow = QKV + ((size_t)((0 * 2 + b) * NHQ + head) * NS + t) * HD;
                const bf16* Kb = QKV + (size_t)((1 * 2 + b) * NHQ + head) * NS * HD;
                const bf16* Vb = QKV + (size_t)((2 * 2 + b) * NHQ + head) * NS * HD;
                { const unsigned w = *(const unsigned*)(qrow + 2 * lane); qs[2 * lane] = bflo(w); qs[2 * lane + 1] = bfhi(w); }
                LDS_WAIT(); asm volatile("" ::: "memory");
                float sc[3];
#pragma unroll
                for (int c = 0; c < 3; ++c) { const int m = lane + 64 * c; const int kp = t - m * dil; sc[c] = (m <= 128 && kp >= 0) ? ATT_SCALE * dot128(qs, Kb + (size_t)kp * HD) : NEG; }
                float mx = wave_max(fmaxf(fmaxf(sc[0], sc[1]), sc[2]));
                float e0 = __expf(sc[0] - mx), e1 = __expf(sc[1] - mx), e2 = __expf(sc[2] - mx);
                const float sum = wave_sum(e0 + e1 + e2), inv = 1.0f / sum;
                lse[g] = mx + __logf(sum);
                ps[lane] = e0 * inv; ps[lane + 64] = e1 * inv; if (lane == 0) ps[128] = e2 * inv;
                LDS_WAIT(); asm volatile("" ::: "memory");
                const int nb = t / dil, nk = (nb < 128 ? nb : 128) + 1;
                float o0 = 0.f, o1 = 0.f;
                for (int m = 0; m < nk; ++m) { const float p = ps[m]; const unsigned w = *(const unsigned*)(Vb + (size_t)(t - m * dil) * HD + 2 * lane); o0 += p * bflo(w); o1 += p * bfhi(w); }
                og0[g] = o0; og1[g] = o1;
                LDS_WAIT(); asm volatile("" ::: "memory");
            }
            const float ml = fmaxf(fmaxf(lse[0], lse[1]), lse[2]);
            const float w0 = __expf(lse[0] - ml), w1 = __expf(lse[1] - ml), w2 = __expf(lse[2] - ml), wi = 1.0f / (w0 + w1 + w2);
            const float r0 = (w0 * og0[0] + w1 * og0[1] + w2 * og0[2]) * wi, r1 = (w0 * og1[0] + w1 * og1[1] + w2 * og1[2]) * wi;
            *(unsigned*)(O + (size_t)(b * NS + t) * DM + (NHA + hh) * HD + 2 * lane) = pk2(r0, r1);
        }
    }
}

__device__ __forceinline__ float silu_f(float x) { return x / (1.0f + __expf(-x)); }
__device__ __forceinline__ void unpack8(const v4u w, float (&f)[8]) { f[0] = bflo(w.x); f[1] = bfhi(w.x); f[2] = bflo(w.y); f[3] = bfhi(w.y); f[4] = bflo(w.z); f[5] = bfhi(w.z); f[6] = bflo(w.w); f[7] = bfhi(w.w); }
__device__ __forceinline__ void p_conv(Frame& F, int layer) {
    const bf16* AP = (const bf16*)(F.ws + WS_APRE); bf16* Gb = (bf16*)(F.ws + WS_G);
    const float* cw = F.ffn_conv_w + (size_t)layer * 3 * F2; const float* cb = F.ffn_conv_b + (size_t)layer * F2;
    constexpr int C8 = DFF / 8;
    const size_t total = (size_t)MR * C8;
    for (size_t idx = (size_t)blockIdx.x * 512 + F.tid; idx < total; idx += (size_t)F.G * 512) {
        const int r = (int)(idx / C8), j0 = (int)(idx - (size_t)r * C8) * 8, s = r & 4095;
        float cg[8], cu[8];
#pragma unroll
        for (int e = 0; e < 8; ++e) { cg[e] = cb[j0 + e]; cu[e] = cb[DFF + j0 + e]; }
#pragma unroll
        for (int tp = 0; tp < 3; ++tp) {
            const int back = 2 - tp;
            if (s >= back) {
                float ag[8], au[8];
                unpack8(*(const v4u*)(AP + (size_t)(r - back) * F2 + j0), ag);
                unpack8(*(const v4u*)(AP + (size_t)(r - back) * F2 + DFF + j0), au);
#pragma unroll
                for (int e = 0; e < 8; ++e) { cg[e] += cw[(size_t)tp * F2 + j0 + e] * ag[e]; cu[e] += cw[(size_t)tp * F2 + DFF + j0 + e] * au[e]; }
            }
        }
        v4u o; o.x = pk2(silu_f(cg[0]) * cu[0], silu_f(cg[1]) * cu[1]); o.y = pk2(silu_f(cg[2]) * cu[2], silu_f(cg[3]) * cu[3]);
        o.z = pk2(silu_f(cg[4]) * cu[4], silu_f(cg[5]) * cu[5]); o.w = pk2(silu_f(cg[6]) * cu[6], silu_f(cg[7]) * cu[7]);
        *(v4u*)(Gb + (size_t)r * DFF + j0) = o;
    }
}

__device__ __forceinline__ void p_sgate_naive(Frame& F) {
    const bf16* U = (const bf16*)(F.ws + WS_U); const bf16* V = (const bf16*)(F.ws + WS_V); const float* VS = (const float*)(F.ws + WS_VSQ); bf16* GT = (bf16*)(F.ws + WS_O);
    LAS float* vn = (LAS float*)(F.lds + RING_OFF);
    LAS float* wsl = vn + 128 * 128;
    LAS float* rstat = (LAS float*)(F.lds + XTRA_OFF);
    for (int item = blockIdx.x; item < 64 * 32; item += F.G) {
        const int bc = item >> 5, g = item & 31, r0 = bc * 128;
        if (F.tid < 128) {
            const float s1 = VS[2 * (r0 + F.tid)], s2 = VS[2 * (r0 + F.tid) + 1];
            const float mean = s1 * (1.0f / 4096.0f), var = s2 * (1.0f / 4096.0f) - mean * mean;
            rstat[2 * F.tid] = mean; rstat[2 * F.tid + 1] = 1.0f / sqrtf(var + NORM_EPS);
        }
        __syncthreads();
        for (int idx = F.tid; idx < 128 * 128; idx += 512) {
            const int s = idx >> 7, d = idx & 127, col = g * 128 + d;
            const float v = bf1(V[(size_t)(r0 + s) * DM + col]);
            vn[idx] = (v - rstat[2 * s]) * rstat[2 * s + 1] * F.sg_v_gain[col] + F.sg_v_bias[col];
            wsl[idx] = F.sg_w_s[(size_t)g * 16384 + idx];
        }
        __syncthreads();
        for (int idx = F.tid; idx < 128 * 128; idx += 512) {
            const int t = idx >> 7, d = idx & 127;
            float a = 0.f;
            for (int s = 0; s <= t; ++s) a += wsl[t * 128 + s] * vn[s * 128 + d];
            const float f = a + F.sg_b_s[g * 128 + t];
            const size_t o = (size_t)(r0 + t) * DM + g * 128 + d;
            GT[o] = (bf16)f2bf(bf1(U[o]) * f);
        }
        __syncthreads();
    }
}

__device__ __forceinline__ void p_final(Frame& F) {
    const float* H = (const float*)(F.ws + WS_H); const float* SS4 = (const float*)(F.ws + WS_SSQ + 4 * SSQ_SITE);
#ifdef CHECK_ATTN
    const unsigned nbad = __hip_atomic_load(F.ctl + 8, __ATOMIC_RELAXED, __HIP_MEMORY_SCOPE_AGENT);
#endif
    for (int m = F.gw; m < MR; m += F.NGW) {
        float rs = ss_rstd(SS4, m);
#ifdef CHECK_ATTN
        if (nbad > CHECK_ATTN) rs = __builtin_nanf("");
#endif
        const f32x4* hr = (const f32x4*)(H + (size_t)m * DM) + F.lane; const f32x4* gr = (const f32x4*)F.final_norm + F.lane;
        f32x4* orow = (f32x4*)(F.out + (size_t)m * DM) + F.lane;
#pragma unroll 4
        for (int j = 0; j < 16; ++j) orow[64 * j] = hr[64 * j] * rs * gr[64 * j];
    }
}
__device__ __forceinline__ void p_gate(Frame& F) {
    const bf16* QKV = (const bf16*)(F.ws + WS_QKV); const float* KM = (const float*)(F.ws + WS_KMEAN); unsigned short* SEL = (unsigned short*)(F.ws + WS_SEL);
    LAS float* km = (LAS float*)(F.lds + RING_OFF);
    const float NEG = -__builtin_inff();
    for (int item = blockIdx.x; item < NB * NHA * 8; item += F.G) {
        const int bh = item >> 3, ch = item & 7, b = bh / NHA, h = bh - b * NHA;
        for (int i = F.tid; i < 2048; i += 512) km[i] = KM[(size_t)bh * 2048 + i];
        __syncthreads();
        const int t = ch * 512 + F.tid, qb = t >> 8;
        unsigned sel;
        if (qb <= 3) sel = (1u << qb) - 1u;
        else {
            const bf16* qrow = QKV + ((size_t)((0 * 2 + b) * NHQ + h) * NS + t) * HD;
            float g[16];
#pragma unroll
            for (int j = 0; j < 16; ++j) g[j] = 0.f;
            for (int c = 0; c < 16; ++c) {
                float q8[8]; unpack8(*(const v4u*)(qrow + 8 * c), q8);
#pragma unroll
                for (int j = 0; j < 16; ++j) {
                    const f32x4 k0 = *(const LAS f32x4*)(km + j * 128 + 8 * c), k1 = *(const LAS f32x4*)(km + j * 128 + 8 * c + 4);
                    g[j] += q8[0] * k0[0] + q8[1] * k0[1] + q8[2] * k0[2] + q8[3] * k0[3] + q8[4] * k1[0] + q8[5] * k1[1] + q8[6] * k1[2] + q8[7] * k1[3];
                }
            }
#pragma unroll
            for (int j = 0; j < 16; ++j) if (j >= qb) g[j] = NEG;
            sel = 0u;
#pragma unroll
            for (int rd = 0; rd < 3; ++rd) {
                float best = NEG; unsigned bi = 0u;
#pragma unroll
                for (int j = 0; j < 16; ++j) { const bool take = (((sel >> j) & 1u) == 0u) && (g[j] > best); best = take ? g[j] : best; bi = take ? (unsigned)j : bi; }
                sel |= 1u << bi;
            }
        }
        SEL[(size_t)bh * NS + t] = (unsigned short)sel;
        __syncthreads();
    }
}

typedef att::BlockRef<bf16, bf16> ABR;
#ifndef DIL_SK
#define DIL_SK false
#endif
__device__ __forceinline__ ABR moba_ref(const Frame& F, int vc, int i) {
    const int grp = vc >> 4, a = vc & 15;
    const unsigned long long PB = 0x24310cbfed5a9687ull, PC = 0x6579b13024c8aedfull;
    const int qb = i == 0 ? a : (i == 1 ? (int)((PB >> (4 * a)) & 15ull) : (int)((PC >> (4 * a)) & 15ull));
    const int bh = 3 * grp + i, b = bh / NHA, h = bh - NHA * b;
    const bf16* QKV = (const bf16*)(F.ws + WS_QKV);
    ABR r;
    r.Q = QKV + ((size_t)((0 * 2 + b) * NHQ + h) * NS + 256 * qb) * HD;
    r.K = QKV + (size_t)((1 * 2 + b) * NHQ + h) * NS * HD;
    r.V = QKV + (size_t)((2 * 2 + b) * NHQ + h) * NS * HD;
    r.O = (bf16*)(F.ws + WS_O) + (size_t)(b * NS + 256 * qb) * DM + h * HD;
    r.P0 = 256 * qb;
    r.sel = (const unsigned short*)(F.ws + WS_SEL) + (size_t)bh * NS + 256 * qb; r.L = nullptr;
    return r;
}
__device__ __forceinline__ ABR dil_ref(const Frame& F, int vc, int g) {
    const int bhh = vc >> 4, b = bhh >> 3, hh = bhh & 7, lo = vc & 15;
    const int dil = g == 0 ? 1 : (g == 1 ? 4 : 16);
    const int res = g == 0 ? 0 : (g == 1 ? (lo >> 2) : lo), blk = g == 0 ? lo : (g == 1 ? (lo & 3) : 0);
    const int head = NHA + 8 * g + hh, pos0 = res + dil * 256 * blk;
    const bf16* QKV = (const bf16*)(F.ws + WS_QKV);
    ABR r;
    r.Q = QKV + ((size_t)((0 * 2 + b) * NHQ + head) * NS + pos0) * HD;
    r.K = QKV + ((size_t)((1 * 2 + b) * NHQ + head) * NS + res) * HD;
    r.V = QKV + ((size_t)((2 * 2 + b) * NHQ + head) * NS + res) * HD;
    r.O = (bf16*)(F.ws + WS_DO) + (size_t)(b * NS + pos0) * 3072 + g * 1024 + hh * HD;
    r.P0 = 256 * blk;
    r.sel = nullptr; r.L = (float*)(F.ws + WS_LSE) + (size_t)(b * NS + pos0) * 24 + g * 8 + hh;
    return r;
}
__device__ __forceinline__ void p_attn(Frame& F, char* lds) {
    for (int vc = blockIdx.x; vc < 256; vc += F.G) {
#ifndef NO_MOBA
        {
            att::Seam<bf16> S;
            constexpr int WM = 1 << 30;
            ABR cur = moba_ref(F, vc, 0);
            att::causal_swa_prime<bf16, bf16, 128, WM>(cur, lds, S);
            for (int i = 0; i < 3; ++i) {
                const ABR nxt = moba_ref(F, vc, i < 2 ? i + 1 : 2);
                att::causal_swa_block<bf16, bf16, false, 0, 128, 128, DM, WM, WM, NS>(cur, nxt, lds, S);
                cur = nxt;
            }
        }
#endif
    }
    for (int vc = blockIdx.x; vc < 256; vc += F.G) {
#ifndef NO_DIL
        {
            att::Seam<bf16> S;
            const ABR r0 = dil_ref(F, vc, 0), r1 = dil_ref(F, vc, 1), r2 = dil_ref(F, vc, 2);
            att::causal_swa_prime<bf16, bf16, 128, 129>(r0, lds, S);
            att::causal_swa_block<bf16, bf16, DIL_SK, 1, 128, 512, 3072, 129, 129, NS>(r0, r1, lds, S);
            att::causal_swa_block<bf16, bf16, DIL_SK, 1, 512, 2048, 4 * 3072, 129, 129, NS / 4>(r1, r2, lds, S);
            att::causal_swa_block<bf16, bf16, DIL_SK, 1, 2048, 2048, 16 * 3072, 129, 129, NS / 16>(r2, r2, lds, S);
        }
#endif
    }
}
__device__ __forceinline__ void p_dilmerge(Frame& F) {
    const bf16* DO = (const bf16*)(F.ws + WS_DO); const float* LSE = (const float*)(F.ws + WS_LSE); bf16* O = (bf16*)(F.ws + WS_O);
    const size_t total = (size_t)MR * 8 * 16;
    for (size_t idx = (size_t)blockIdx.x * 512 + F.tid; idx < total; idx += (size_t)F.G * 512) {
        const int r = (int)(idx >> 7), hh = (int)(idx >> 4) & 7, c8 = (int)idx & 15;
        const float l0 = LSE[(size_t)r * 24 + hh], l1 = LSE[(size_t)r * 24 + 8 + hh], l2 = LSE[(size_t)r * 24 + 16 + hh];
        const float ml = fmaxf(fmaxf(l0, l1), l2);
        float w0 = __expf(l0 - ml), w1 = __expf(l1 - ml), w2 = __expf(l2 - ml); const float wi = 1.0f / (w0 + w1 + w2); w0 *= wi; w1 *= wi; w2 *= wi;
        float a0[8], a1[8], a2[8];
        unpack8(*(const v4u*)(DO + (size_t)r * 3072 + hh * HD + c8 * 8), a0);
        unpack8(*(const v4u*)(DO + (size_t)r * 3072 + 1024 + hh * HD + c8 * 8), a1);
        unpack8(*(const v4u*)(DO + (size_t)r * 3072 + 2048 + hh * HD + c8 * 8), a2);
        float o[8];
#pragma unroll
        for (int e = 0; e < 8; ++e) o[e] = w0 * a0[e] + w1 * a1[e] + w2 * a2[e];
        v4u w; w.x = pk2(o[0], o[1]); w.y = pk2(o[2], o[3]); w.z = pk2(o[4], o[5]); w.w = pk2(o[6], o[7]);
        *(v4u*)(O + (size_t)r * DM + (NHA + hh) * HD + c8 * 8) = w;
    }
}
__device__ __forceinline__ void p_convfix(Frame& F, int layer) {
    const float* top = (const float*)(F.ws + WS_TOP); const float* bot = (const float*)(F.ws + WS_BOT); bf16* Gb = (bf16*)(F.ws + WS_G);
    const float* cw = F.ffn_conv_w + (size_t)layer * 3 * F2; const float* cb = F.ffn_conv_b + (size_t)layer * F2;
    constexpr int C4 = DFF / 4, NIT = 30 * C4;
    for (int idx = blockIdx.x * 512 + F.tid; idx < NIT; idx += F.G * 512) {
        const int pmi = idx / C4, j0 = (idx - pmi * C4) * 4, pm = pmi + 1 + (pmi >= 15 ? 1 : 0);
        f32x4 c0[2], c1[2];
#pragma unroll
        for (int bj = 0; bj < 2; ++bj) {
            const int col = bj * DFF + j0;
            const f32x4 w0 = *(const f32x4*)(cw + col), w1 = *(const f32x4*)(cw + F2 + col), w2 = *(const f32x4*)(cw + 2 * F2 + col), bb = *(const f32x4*)(cb + col);
            const f32x4 am2 = *(const f32x4*)(bot + (size_t)((pm - 1) * 2 + 0) * F2 + col), am1 = *(const f32x4*)(bot + (size_t)((pm - 1) * 2 + 1) * F2 + col);
            const f32x4 a0 = *(const f32x4*)(top + (size_t)(pm * 2 + 0) * F2 + col), a1 = *(const f32x4*)(top + (size_t)(pm * 2 + 1) * F2 + col);
            c0[bj] = bb + w0 * am2 + w1 * am1 + w2 * a0;
            c1[bj] = bb + w0 * am1 + w1 * a0 + w2 * a1;
        }
        v2u o0, o1;
        o0.x = pk2(silu_f(c0[0][0]) * c0[1][0], silu_f(c0[0][1]) * c0[1][1]); o0.y = pk2(silu_f(c0[0][2]) * c0[1][2], silu_f(c0[0][3]) * c0[1][3]);
        o1.x = pk2(silu_f(c1[0][0]) * c1[1][0], silu_f(c1[0][1]) * c1[1][1]); o1.y = pk2(silu_f(c1[0][2]) * c1[1][2], silu_f(c1[0][3]) * c1[1][3]);
        *(v2u*)(Gb + (size_t)(pm * 256) * DFF + j0) = o0;
        *(v2u*)(Gb + (size_t)(pm * 256 + 1) * DFF + j0) = o1;
    }
}
constexpr int N_PHASES = 17;
struct Args { const void* in[19]; float* out; unsigned char* ws; int ph_lo, ph_hi, li, pad; };
__global__ void __launch_bounds__(NWAVES * 64, 2) mk_fwd(Args args) {
    extern __shared__ __attribute__((aligned(16))) unsigned char lds[];
    Frame F;
    F.lds = (LAS unsigned char*)lds;
    F.MISC = (volatile LAS unsigned*)(F.lds + MISC_OFF);
    F.tid = threadIdx.x; F.lane = F.tid & 63; F.wave = __builtin_amdgcn_readfirstlane(F.tid >> 6);
    F.G = gridDim.x; F.gw = blockIdx.x * NWAVES + F.wave; F.NGW = F.G * NWAVES;
    F.ws = args.ws; F.ctl = (unsigned*)(args.ws + WS_CTL);
    F.x = (const float*)args.in[0]; F.pos = (const int*)args.in[1];
    F.attn_norm = (const float*)args.in[2]; F.attn_w_in = (const float*)args.in[3]; F.attn_w_out = (const float*)args.in[4];
    F.sg_norm = (const float*)args.in[5]; F.sg_w_in = (const float*)args.in[6]; F.sg_b_in = (const float*)args.in[7]; F.sg_v_gain = (const float*)args.in[8]; F.sg_v_bias = (const float*)args.in[9];
    F.sg_w_s = (const float*)args.in[10]; F.sg_b_s = (const float*)args.in[11]; F.sg_w_out = (const float*)args.in[12];
    F.ffn_norm = (const float*)args.in[13]; F.ffn_w_up = (const float*)args.in[14]; F.ffn_conv_w = (const float*)args.in[15]; F.ffn_conv_b = (const float*)args.in[16]; F.ffn_w_down = (const float*)args.in[17];
    F.final_norm = (const float*)args.in[18]; F.out = args.out;
    for (int u = F.tid; u < (XTRA_OFF - LDSCTL_OFF) / 4; u += NWAVES * 64) ((LAS unsigned*)(F.lds + LDSCTL_OFF))[u] = 0u;
    __syncthreads();
    const int lo = args.ph_lo, hi = args.ph_hi;
    XcdBarrier bar; bar.bar = F.ctl + CW_BAR + args.li * XCD_BAR_WORDS; bar.x = 0; bar.st = nullptr;
    if (hi - lo > 1) bar = xcd_barrier_post(F.ctl + CW_BAR + args.li * XCD_BAR_WORDS, F.MISC + 8);
#define IN(k) (lo <= (k) && (k) < hi)
#define SEAM(k) do { if (IN(k) && IN((k) + 1)) xcd_barrier(bar); } while (0)
    unsigned char* ws = args.ws;
    bf16* XB = (bf16*)(ws + WS_XB); float* H = (float*)(ws + WS_H); bf16* O = (bf16*)(ws + WS_O); bf16* Gb = (bf16*)(ws + WS_G); bf16* AP = (bf16*)(ws + WS_APRE);
    float* SS = (float*)(ws + WS_SSQ); constexpr size_t SSF = SSQ_SITE / 4;
    const int c = (int)blockIdx.x;

    if (IN(0)) { p0_prologue(F); } SEAM(0);
    if (IN(1)) {
        pg8::Gemm g{XB, (const bf16*)(ws + WS_WIN), MR, QKVC, DM}; pg8::StaticOrder S; S.init(MR, QKVC, F.G, c);
        pg8::EpiQKV E{(bf16*)(ws + WS_QKV), SS, (const float*)(ws + WS_ROPE), (const float*)(ws + WS_ROPE) + MR * 16};
        pg8::gemm_phase<pg8::EpiQKV, pg8::StaticOrder, PG8_ALIGN, PG8_SP2>(F.lds + RING_OFF, g, S, E);
    } SEAM(1);
    if (IN(2)) { p_kmean(F); } SEAM(2);
    if (IN(3)) { p_gate(F); } SEAM(3);
    if (IN(4)) { p_attn(F, (char*)lds + RING_OFF); } SEAM(4);
    if (IN(5)) { p_dilmerge(F);
#ifdef CHECK_ATTN
        xcd_barrier(bar); p_attn_naive(F, AP); xcd_barrier(bar);
        { unsigned bad = 0; for (size_t idx = (size_t)blockIdx.x * 512 + F.tid; idx < (size_t)MR * DM; idx += (size_t)F.G * 512) { const float a = bf1(O[idx]), b = bf1(AP[idx]); if (!(fabsf(a - b) <= 0.004f + 0.03f * fabsf(b))) ++bad; }
          if (bad) atomicAdd(F.ctl + 8, bad); }
#endif
    } SEAM(5);
    if (IN(6)) {
        pg8::Gemm g{O, (const bf16*)(ws + WS_WOUT), MR, DM, DM}; pg8::StaticOrder S; S.init(MR, DM, F.G, c);
        pg8::EpiRes E{F.x, H, XB, SS + 1 * SSF};
        pg8::gemm_phase<pg8::EpiRes, pg8::StaticOrder, PG8_ALIGN, PG8_SP2>(F.lds + RING_OFF, g, S, E);
    } SEAM(6);
    if (IN(7)) {
        pg8::Gemm g{XB, (const bf16*)(ws + WS_WUP), MR, F2, DM}; pg8::StaticOrder S; S.init(MR, F2, F.G, c);
        pg8::EpiUpConv E{Gb, SS + 1 * SSF, F.ffn_conv_w, F.ffn_conv_b, (float*)(ws + WS_TOP), (float*)(ws + WS_BOT), (LAS float*)(F.lds + XTRA_OFF)};
        pg8::gemm_phase<pg8::EpiUpConv, pg8::StaticOrder, true, PG8_SP2>(F.lds + RING_OFF, g, S, E);
    } SEAM(7);
    if (IN(8)) { p_convfix(F, 0); } SEAM(8);
    if (IN(9)) {
        pg8::Gemm g{Gb, (const bf16*)(ws + WS_WDOWN), MR, DM, DFF}; pg8::StaticOrder S; S.init(MR, DM, F.G, c);
        pg8::EpiRes E{H, H, XB, SS + 2 * SSF};
        pg8::gemm_phase<pg8::EpiRes, pg8::StaticOrder, PG8_ALIGN, PG8_SP2>(F.lds + RING_OFF, g, S, E);
    } SEAM(9);
    if (IN(10)) {
        pg8::Gemm g{XB, (const bf16*)(ws + WS_SGWIN), MR, 2 * DM, DM}; pg8::StaticOrder S; S.init(MR, 2 * DM, F.G, c);
        pg8::EpiSgIn E{(bf16*)(ws + WS_U), (bf16*)(ws + WS_V), SS + 2 * SSF, F.sg_b_in, (float*)(ws + WS_VSQ)};
        pg8::gemm_phase<pg8::EpiSgIn, pg8::StaticOrder, PG8_ALIGN, PG8_SP2>(F.lds + RING_OFF, g, S, E);
    } SEAM(10);
    if (IN(11)) { p_sgate_naive(F); } SEAM(11);
    if (IN(12)) {
        pg8::Gemm g{O, (const bf16*)(ws + WS_SGWOUT), MR, DM, DM}; pg8::StaticOrder S; S.init(MR, DM, F.G, c);
        pg8::EpiRes E{H, H, XB, SS + 3 * SSF};
        pg8::gemm_phase<pg8::EpiRes, pg8::StaticOrder, PG8_ALIGN, PG8_SP2>(F.lds + RING_OFF, g, S, E);
    } SEAM(12);
    if (IN(13)) {
        pg8::Gemm g{XB, (const bf16*)(ws + WS_WUP + WUP_L), MR, F2, DM}; pg8::StaticOrder S; S.init(MR, F2, F.G, c);
        pg8::EpiUpConv E{Gb, SS + 3 * SSF, F.ffn_conv_w + 3 * F2, F.ffn_conv_b + F2, (float*)(ws + WS_TOP), (float*)(ws + WS_BOT), (LAS float*)(F.lds + XTRA_OFF)};
        pg8::gemm_phase<pg8::EpiUpConv, pg8::StaticOrder, true, PG8_SP2>(F.lds + RING_OFF, g, S, E);
    } SEAM(13);
    if (IN(14)) { p_convfix(F, 1); } SEAM(14);
    if (IN(15)) {
        pg8::Gemm g{Gb, (const bf16*)(ws + WS_WDOWN + WDOWN_L), MR, DM, DFF}; pg8::StaticOrder S; S.init(MR, DM, F.G, c);
        pg8::EpiRes E{H, H, XB, SS + 4 * SSF};
        pg8::gemm_phase<pg8::EpiRes, pg8::StaticOrder, PG8_ALIGN, PG8_SP2>(F.lds + RING_OFF, g, S, E);
    } SEAM(15);
    if (IN(16)) { p_final(F); }
#undef IN
#undef SEAM
}

extern "C" void kernel_launch(void* const* d_in, const int* in_sizes, int n_in, void* d_out, int out_size, void* d_ws, size_t ws_size, hipStream_t stream) {
    static int grid = 0;
    if (grid == 0) {
        if (n_in != 19 || out_size != MR * DM || ws_size < WS_END) { fprintf(stderr, "kernel_launch: unexpected shapes (n_in %d, out %d, ws %zu); nothing launched\n", n_in, out_size, ws_size); grid = -1; return; }
        int dev = 0, cus = 0, per_cu = 0;
        if (hipGetDevice(&dev) != hipSuccess || hipDeviceGetAttribute(&cus, hipDeviceAttributeMultiprocessorCount, dev) != hipSuccess) { grid = -1; return; }
        if (hipFuncSetAttribute((const void*)mk_fwd, hipFuncAttributeMaxDynamicSharedMemorySize, LDS_BYTES) != hipSuccess) { fprintf(stderr, "kernel_launch: hipFuncSetAttribute failed\n"); grid = -1; return; }
        if (hipOccupancyMaxActiveBlocksPerMultiprocessor(&per_cu, (const void*)mk_fwd, NWAVES * 64, LDS_BYTES) != hipSuccess || per_cu < 1) fprintf(stderr, "kernel_launch: occupancy query reports %d\n", per_cu);
        (void)hipGetLastError();
        grid = cus;
    }
    if (grid < 0) return;
    if (hipMemsetAsync((char*)d_ws + WS_CTL, 0, CTL_ZERO_BYTES, stream) != hipSuccess) return;
    Args a{};
    for (int i = 0; i < 19; ++i) a.in[i] = d_in[i];
    a.out = (float*)d_out; a.ws = (unsigned char*)d_ws; a.pad = 0;
    if (MK_N_LAUNCHES == 1) {
        a.ph_lo = 0; a.ph_hi = N_PHASES; a.li = 0;
        hipLaunchKernelGGL(mk_fwd, dim3(grid), dim3(NWAVES * 64), LDS_BYTES, stream, a);
    } else {
        for (int p = 0; p < N_PHASES; ++p) { a.ph_lo = p; a.ph_hi = p + 1; a.li = 0; hipLaunchKernelGGL(mk_fwd, dim3(grid), dim3(NWAVES * 64), LDS_BYTES, stream, a); }
    }
}
```

```cpp
#include <hip/hip_runtime.h>
#include <cstdio>
#include <cstdint>
#ifndef MK_N_LAUNCHES
#define MK_N_LAUNCHES 1
#endif
namespace pg8 {
#define PG8_LAS __attribute__((address_space(3)))
typedef unsigned short bf16_t;
typedef short bf16x8 __attribute__((ext_vector_type(8)));
typedef float f32x4 __attribute__((ext_vector_type(4)));
typedef unsigned u32x4 __attribute__((ext_vector_type(4)));
constexpr int BM = 256, BK = 64, HALF = 128, HTB = HALF * BK * 2  , STAGE_BYTES = 8 * HTB, NXCD = 8, WGM = 8;

__host__ __device__ __forceinline__ int lds_byte(int r, int c) { const int st = (r >> 4) * 2 + (c >> 5), rr = r & 15, cc = c & 31, ob = rr * 64 + cc * 2; return st * 1024 + (ob ^ (((ob >> 9) & 1) << 5)); }
__host__ __device__ __forceinline__ void stage_rc(int b, int& R, int& C) { const int st = b / 1024, sb = b % 1024, swz = sb ^ (((sb >> 9) & 1) << 5); R = (st >> 1) * 16 + swz / 64; C = (st & 1) * 32 + (swz % 64) / 2; }
__host__ __device__ __forceinline__ int perm32(int rho) { const int n = rho >> 4, i = rho & 15; return 8 * (i >> 2) + 4 * n + (i & 3); }

struct Unit { int pm, pn; };
struct Gemm { const bf16_t* A; const bf16_t* Bt; int M, N, K; };

struct StaticOrder {
    int nM, nN, nwg, G, c;
    __host__ __device__ void init(int M, int N, int G_, int c_) { nM = M / BM; nN = N / BM; nwg = nM * nN; G = G_; c = c_; }
    __host__ __device__ bool next(int i, Unit& u) const {
        const long L = (long)i * G + c; if (L >= nwg) return false;
        int wgid = (int)L; { const int q = nwg / NXCD, r = nwg % NXCD, xcd = wgid % NXCD, off = wgid / NXCD; wgid = (xcd < r ? xcd * (q + 1) : r * (q + 1) + (xcd - r) * q) + off; }
        const int nig = WGM * nN, gid = wgid / nig, fm = gid * WGM, gsz = (nM - fm) < WGM ? (nM - fm) : WGM;
        u.pm = fm + ((wgid % nig) % gsz); u.pn = (wgid % nig) / gsz; return true;
    }
    __device__ __forceinline__ void a_ready(const Unit&) const {}
    __device__ __forceinline__ void done(const Unit&) const {}
};
__device__ __forceinline__ unsigned cvt_pk_bf16(float lo, float hi) { unsigned r; asm volatile("v_cvt_pk_bf16_f32 %0, %1, %2" : "=v"(r) : "v"(lo), "v"(hi)); return r; }
typedef float f32x2 __attribute__((ext_vector_type(2)));
__device__ __forceinline__ f32x2 gelu_pk(f32x2 v) {
    const f32x2 av = __builtin_elementwise_abs(v), d = av * 0.2316418882f + 1.0f;
    f32x2 t; t.x = __builtin_amdgcn_rcpf(d.x); t.y = __builtin_amdgcn_rcpf(d.y);
    f32x2 q = t * 0.5307027145f + (-0.7265760135f); q = q * t + 0.7107068705f; q = q * t + (-0.142248368f); q = q * t + 0.127414796f; q = q * t;
    const f32x2 s = (v * v) * (-0.72134752044f);
    f32x2 e; e.x = __builtin_amdgcn_exp2f(s.x); e.y = __builtin_amdgcn_exp2f(s.y);
    const f32x2 m = v * (q * e), r = v - m;
    f32x2 o; o.x = v.x < 0.f ? m.x : r.x; o.y = v.y < 0.f ? m.y : r.y; return o;
}
typedef unsigned u32x2 __attribute__((ext_vector_type(2)));
__device__ __forceinline__ float rstd_from_ss(const float* ss, int r) { return 1.0f / sqrtf(ss[r] * (1.0f / 4096.0f) + 1e-5f); }

struct EpiQKV {
    static constexpr bool PERM = false, AFTER_DRAIN = false;
    bf16_t* qkv; const float* ss; const float* ropec; const float* ropes;
    __device__ __forceinline__ void operator()(const f32x4 (&acc)[2][2][4][2], const Unit& u, int wr, int wc, int fr, int fq) const {
        const int row0 = u.pm * BM + wr * 64 + fr;
#pragma unroll
        for (int ai = 0; ai < 2; ++ai)
#pragma unroll
            for (int m = 0; m < 4; ++m) {
                const int r = row0 + ai * HALF + m * 16;
                const float rs = rstd_from_ss(ss, r);
                const int b = r >> 12, s = r & 4095;
                f32x4 cs = (f32x4){1.f, 1.f, 1.f, 1.f}, sn = (f32x4){0.f, 0.f, 0.f, 0.f};
                if (wc == 0) { cs = *(const f32x4*)(ropec + (size_t)r * 16 + 4 * fq); sn = *(const f32x4*)(ropes + (size_t)r * 16 + 4 * fq); }
#pragma unroll
                for (int bj = 0; bj < 2; ++bj) {
                    const int colh = 2 * u.pn + bj, which = colh / 48, head = colh - which * 48;
                    bf16_t* dst = qkv + ((size_t)((which * 2 + b) * 48 + head) * 4096 + s) * 128 + wc * 32 + 4 * fq;
                    f32x4 v0 = acc[ai][bj][m][0] * rs, v1 = acc[ai][bj][m][1] * rs;
                    if (which < 2 && wc == 0) { const f32x4 n0 = v0 * cs - v1 * sn, n1 = v1 * cs + v0 * sn; v0 = n0; v1 = n1; }
                    u32x2 w0, w1; w0.x = cvt_pk_bf16(v0[0], v0[1]); w0.y = cvt_pk_bf16(v0[2], v0[3]); w1.x = cvt_pk_bf16(v1[0], v1[1]); w1.y = cvt_pk_bf16(v1[2], v1[3]);
                    *(u32x2*)(dst) = w0; *(u32x2*)(dst + 16) = w1;
                }
                asm volatile("" ::: "memory");
            }
    }
};

struct EpiRes {
    static constexpr bool PERM = false, AFTER_DRAIN = false;
    const float* hin; float* hout; bf16_t* xb; float* ss;
    __device__ __forceinline__ void operator()(const f32x4 (&acc)[2][2][4][2], const Unit& u, int wr, int wc, int fr, int fq) const {
        const int row0 = u.pm * BM + wr * 64 + fr, col0 = u.pn * BM + wc * 32 + 4 * fq;
#pragma unroll
        for (int ai = 0; ai < 2; ++ai)
#pragma unroll
            for (int m = 0; m < 4; ++m) {
                const int r = row0 + ai * HALF + m * 16; const size_t off = (size_t)r * 4096 + col0;
                float sq = 0.f;
#pragma unroll
                for (int bj = 0; bj < 2; ++bj)
#pragma unroll
                    for (int n = 0; n < 2; ++n) {
                        const f32x4 h = *(const f32x4*)(hin + off + bj * HALF + n * 16) + acc[ai][bj][m][n];
                        *(f32x4*)(hout + off + bj * HALF + n * 16) = h;
                        u32x2 w; w.x = cvt_pk_bf16(h[0], h[1]); w.y = cvt_pk_bf16(h[2], h[3]);
                        *(u32x2*)(xb + off + bj * HALF + n * 16) = w;
                        sq += (h[0] * h[0] + h[1] * h[1]) + (h[2] * h[2] + h[3] * h[3]);
                    }
                sq += __shfl_xor(sq, 16); sq += __shfl_xor(sq, 32);
                if (fq == 0) atomicAdd(ss + r, sq);
                asm volatile("" ::: "memory");
            }
    }
};

struct EpiUpPre {
    static constexpr bool PERM = true, AFTER_DRAIN = false;
    bf16_t* apre; const float* ss;
    __device__ __forceinline__ void operator()(const f32x4 (&acc)[2][2][4][2], const Unit& u, int wr, int wc, int fr, int fq) const {
        const int row0 = u.pm * BM + wr * 64 + fr, col0 = u.pn * 128 + wc * 32 + 8 * fq;
#pragma unroll
        for (int ai = 0; ai < 2; ++ai)
#pragma unroll
            for (int m = 0; m < 4; ++m) {
                const int r = row0 + ai * HALF + m * 16;
                const float rs = rstd_from_ss(ss, r);
                bf16_t* rowp = apre + (size_t)r * 28672 + col0;
#pragma unroll
                for (int bj = 0; bj < 2; ++bj) {
                    const f32x4 v0 = acc[ai][bj][m][0] * rs, v1 = acc[ai][bj][m][1] * rs;
                    u32x4 w; w.x = cvt_pk_bf16(v0[0], v0[1]); w.y = cvt_pk_bf16(v0[2], v0[3]); w.z = cvt_pk_bf16(v1[0], v1[1]); w.w = cvt_pk_bf16(v1[2], v1[3]);
                    *(u32x4*)(rowp + bj * 14336) = w;
                }
                asm volatile("" ::: "memory");
            }
    }
};

struct EpiSgIn {
    static constexpr bool PERM = true, AFTER_DRAIN = false;
    bf16_t* U; bf16_t* V; const float* ss; const float* bias; float* vs;
    __device__ __forceinline__ void operator()(const f32x4 (&acc)[2][2][4][2], const Unit& u, int wr, int wc, int fr, int fq) const {
        const int row0 = u.pm * BM + wr * 64 + fr, gcol0 = u.pn * BM + wc * 32 + 8 * fq;
        const bool isv = u.pn >= 16;
        bf16_t* base = isv ? V : U; const int col0 = isv ? gcol0 - 4096 : gcol0;
        f32x4 bv[2][2];
#pragma unroll
        for (int bj = 0; bj < 2; ++bj)
#pragma unroll
            for (int n = 0; n < 2; ++n) bv[bj][n] = *(const f32x4*)(bias + gcol0 + bj * HALF + 4 * n);
#pragma unroll
        for (int ai = 0; ai < 2; ++ai)
#pragma unroll
            for (int m = 0; m < 4; ++m) {
                const int r = row0 + ai * HALF + m * 16;
                const float rs = rstd_from_ss(ss, r);
                bf16_t* rowp = base + (size_t)r * 4096 + col0;
                float s1 = 0.f, s2 = 0.f;
#pragma unroll
                for (int bj = 0; bj < 2; ++bj) {
                    f32x4 v0 = acc[ai][bj][m][0] * rs + bv[bj][0], v1 = acc[ai][bj][m][1] * rs + bv[bj][1];
                    const f32x2 a = gelu_pk((f32x2){v0[0], v0[1]}), b = gelu_pk((f32x2){v0[2], v0[3]}), c = gelu_pk((f32x2){v1[0], v1[1]}), d = gelu_pk((f32x2){v1[2], v1[3]});
                    s1 += (a.x + a.y) + (b.x + b.y) + (c.x + c.y) + (d.x + d.y);
                    s2 += (a.x * a.x + a.y * a.y) + (b.x * b.x + b.y * b.y) + (c.x * c.x + c.y * c.y) + (d.x * d.x + d.y * d.y);
                    u32x4 w; w.x = cvt_pk_bf16(a.x, a.y); w.y = cvt_pk_bf16(b.x, b.y); w.z = cvt_pk_bf16(c.x, c.y); w.w = cvt_pk_bf16(d.x, d.y);
                    *(u32x4*)(rowp + bj * HALF) = w;
                }
                if (isv) {
                    s1 += __shfl_xor(s1, 16); s1 += __shfl_xor(s1, 32); s2 += __shfl_xor(s2, 16); s2 += __shfl_xor(s2, 32);
                    if (fq == 0) { atomicAdd(vs + 2 * r, s1); atomicAdd(vs + 2 * r + 1, s2); }
                }
                asm volatile("" ::: "memory");
            }
    }
};

#define PG8_DPP(oldv, srcv, ctrl) __builtin_bit_cast(float, __builtin_amdgcn_update_dpp(__builtin_bit_cast(int, (float)(oldv)), __builtin_bit_cast(int, (float)(srcv)), (ctrl), 0xf, 0xf, false))
struct EpiUpConv {
    static constexpr bool PERM = true, AFTER_DRAIN = false;
    bf16_t* G; const float* ss; const float* cw; const float* cb; float* top; float* bot; PG8_LAS float* xch;
    __device__ __forceinline__ static float silu(float x) { return x * __builtin_amdgcn_rcpf(1.0f + __builtin_amdgcn_exp2f(-1.4426950408889634f * x)); }
    __device__ __forceinline__ void operator()(const f32x4 (&acc)[2][2][4][2], const Unit& u, int wr, int wc, int fr, int fq) const {
        const int row0 = u.pm * BM + wr * 64 + fr, colg = u.pn * 128 + wc * 32 + 8 * fq;
        float rs[2][4];
#pragma unroll
        for (int ai = 0; ai < 2; ++ai)
#pragma unroll
            for (int m = 0; m < 4; ++m) rs[ai][m] = rstd_from_ss(ss, row0 + ai * HALF + m * 16);
#pragma unroll
        for (int ai = 0; ai < 2; ++ai)
#pragma unroll
            for (int bj = 0; bj < 2; ++bj)
#pragma unroll
                for (int n = 0; n < 2; ++n) {
                    const f32x4 v = acc[ai][bj][3][n] * rs[ai][3];
                    if (fr >= 14) {
                        *(PG8_LAS f32x4*)(xch + ((((((ai * 2 + wr) * 4 + wc) * 2 + bj) * 2 + n) * 4 + fq) * 2 + (fr - 14)) * 4) = v;
                        if (ai == 1 && wr == 1) *(f32x4*)(bot + ((size_t)(u.pm * 2 + (fr - 14)) * 28672) + bj * 14336 + colg + 4 * n) = v;
                    }
                }
        if (wr == 0 && fr < 2) {
#pragma unroll
            for (int bj = 0; bj < 2; ++bj)
#pragma unroll
                for (int n = 0; n < 2; ++n) *(f32x4*)(top + ((size_t)(u.pm * 2 + fr) * 28672) + bj * 14336 + colg + 4 * n) = acc[0][bj][0][n] * rs[0][0];
        }
        asm volatile("s_waitcnt lgkmcnt(0)" ::: "memory"); __builtin_amdgcn_s_barrier(); asm volatile("" ::: "memory");
#pragma unroll
        for (int n = 0; n < 2; ++n) {
            f32x4 w0[2], w1[2], w2[2], cbv[2];
#pragma unroll
            for (int bj = 0; bj < 2; ++bj) { const int off = bj * 14336 + colg + 4 * n;
                w0[bj] = *(const f32x4*)(cw + off); w1[bj] = *(const f32x4*)(cw + 28672 + off); w2[bj] = *(const f32x4*)(cw + 2 * 28672 + off); cbv[bj] = *(const f32x4*)(cb + off); }
#pragma unroll
            for (int ai = 0; ai < 2; ++ai) {
                f32x4 prev[2];
                const bool has = !(ai == 0 && wr == 0);
                const int pai = wr == 1 ? ai : 0, pwr = wr == 1 ? 0 : 1;
#pragma unroll
                for (int bj = 0; bj < 2; ++bj) {
                    prev[bj] = (f32x4){0.f, 0.f, 0.f, 0.f};
                    if (has && fr >= 14) prev[bj] = *(const PG8_LAS f32x4*)(xch + ((((((pai * 2 + pwr) * 4 + wc) * 2 + bj) * 2 + n) * 4 + fq) * 2 + (fr - 14)) * 4);
                }
#pragma unroll
                for (int m = 0; m < 4; ++m) {
                    f32x4 cv[2];
#pragma unroll
                    for (int bj = 0; bj < 2; ++bj) {
                        const f32x4 cur = acc[ai][bj][m][n] * rs[ai][m];
#pragma unroll
                        for (int j = 0; j < 4; ++j) {
                            const float r1 = PG8_DPP(0.f, prev[bj][j], 0x121), r2 = PG8_DPP(0.f, prev[bj][j], 0x122);
                            const float p1 = PG8_DPP(r1, cur[j], 0x111), p2 = PG8_DPP(r2, cur[j], 0x112);
                            cv[bj][j] = cbv[bj][j] + w0[bj][j] * p2 + w1[bj][j] * p1 + w2[bj][j] * cur[j];
                        }
                        prev[bj] = cur;
                    }
                    u32x2 w; w.x = cvt_pk_bf16(silu(cv[0][0]) * cv[1][0], silu(cv[0][1]) * cv[1][1]); w.y = cvt_pk_bf16(silu(cv[0][2]) * cv[1][2], silu(cv[0][3]) * cv[1][3]);
                    *(u32x2*)(G + (size_t)(row0 + ai * HALF + m * 16) * 14336 + colg + 4 * n) = w;
                    asm volatile("" ::: "memory");
                }
            }
            asm volatile("" ::: "memory");
        }
    }
};
template <class Epi, class Sched, bool ALIGN_EPI = false, bool SP2 = false>
__device__ __forceinline__ void gemm_phase(PG8_LAS unsigned char* lds, const Gemm g, const Sched& S, const Epi& E) {
    const int tid = threadIdx.x, wid = __builtin_amdgcn_readfirstlane(tid >> 6), lane = tid & 63, wr = wid >> 2, wc = wid & 3, fr = lane & 15, fq = lane >> 4;
    const int K = g.K, nt = K / BK;
    unsigned voffA[2], voffB[2];
#pragma unroll
    for (int i = 0; i < 2; ++i) { int R, C; stage_rc(tid * 16 + i * 8192, R, C); const int Rb = Epi::PERM ? ((R & ~31) + perm32(R & 31)) : R;
        voffA[i] = (unsigned)(R * K + C) * 2u; voffB[i] = (unsigned)(Rb * K + C) * 2u; }
    const size_t kstep = (size_t)(BK * 2);
    const size_t hstep = (size_t)HALF * K * 2;
    const size_t tstep = 2 * hstep;
    const unsigned ldsw = (unsigned)wid * 1024u;
    const int aoff = lds_byte(wr * 64 + fr, fq * 8), boff = lds_byte(wc * 32 + fr, fq * 8);
#define PG8_SA(b, h) (((b) * 2 + (h)) * HTB)
#define PG8_SB(b, h) ((4 + (b) * 2 + (h)) * HTB)
#define PG8_STAGE(bufoff, gbase, voff) do { _Pragma("unroll") for (int _i = 0; _i < 2; ++_i) \
        __builtin_amdgcn_global_load_lds((const unsigned*)((const char*)(gbase) + (voff)[_i]), (PG8_LAS unsigned*)(lds + (bufoff) + ldsw + _i * 8192), 16, 0, 0); } while (0)
#define PG8_LDA(dst, b, h) do { _Pragma("unroll") for (int m = 0; m < 4; ++m) _Pragma("unroll") for (int k = 0; k < 2; ++k) dst[m][k] = *(const PG8_LAS bf16x8*)(lds + PG8_SA(b, h) + aoff + m * 2048 + k * 1024); } while (0)
#define PG8_LDB(dst, b, h) do { _Pragma("unroll") for (int n = 0; n < 2; ++n) _Pragma("unroll") for (int k = 0; k < 2; ++k) dst[n][k] = *(const PG8_LAS bf16x8*)(lds + PG8_SB(b, h) + boff + n * 2048 + k * 1024); } while (0)
#define PG8_MMA(ai, bj, At, Bt) do { __builtin_amdgcn_s_setprio(1); _Pragma("unroll") for (int m = 0; m < 4; ++m) _Pragma("unroll") for (int n = 0; n < 2; ++n) _Pragma("unroll") for (int k = 0; k < 2; ++k) \
        acc[ai][bj][m][n] = __builtin_amdgcn_mfma_f32_16x16x32_bf16(Bt[n][k], At[m][k], acc[ai][bj][m][n], 0, 0, 0); __builtin_amdgcn_s_setprio(0); } while (0)
#define PG8_WAIT_V(n) asm volatile("s_waitcnt vmcnt(" #n ")" ::: "memory")
#define PG8_WAIT_L(n) asm volatile("s_waitcnt lgkmcnt(" #n ")" ::: "memory")
#define PG8_BAR __builtin_amdgcn_s_barrier()
#define PG8_SCHED __builtin_amdgcn_sched_barrier(0)
    Unit cur, nxt; int ui = 0;
    if (!S.next(0, cur)) return;
    f32x4 acc[2][2][4][2];
#pragma unroll
    for (int a = 0; a < 2; ++a)
#pragma unroll
        for (int b = 0; b < 2; ++b)
#pragma unroll
            for (int m = 0; m < 4; ++m)
#pragma unroll
                for (int n = 0; n < 2; ++n) acc[a][b][m][n] = (f32x4){0.f, 0.f, 0.f, 0.f};
    bf16x8 At[4][2], B0[2][2], B1[2][2];
    const char* cA = (const char*)g.A + (size_t)cur.pm * tstep; const char* cB = (const char*)g.Bt + (size_t)cur.pn * tstep;
    S.a_ready(cur);
    if constexpr (SP2) {
        PG8_STAGE(PG8_SB(0, 0), cB, voffB); PG8_STAGE(PG8_SB(0, 1), cB + hstep, voffB); PG8_STAGE(PG8_SA(0, 0), cA, voffA); PG8_STAGE(PG8_SA(0, 1), cA + hstep, voffA);
        if (wr == 1) PG8_BAR;
        PG8_WAIT_V(2); PG8_BAR;
        PG8_STAGE(PG8_SB(1, 0), cB + kstep, voffB); PG8_STAGE(PG8_SA(1, 0), cA + kstep, voffA); PG8_STAGE(PG8_SB(1, 1), cB + hstep + kstep, voffB);
        PG8_WAIT_V(6); PG8_BAR;
    } else {
        PG8_STAGE(PG8_SB(0, 0), cB, voffB); PG8_STAGE(PG8_SA(0, 0), cA, voffA); PG8_STAGE(PG8_SB(0, 1), cB + hstep, voffB); PG8_STAGE(PG8_SA(0, 1), cA + hstep, voffA);
        if (wr == 1) PG8_BAR;
        PG8_WAIT_V(4); PG8_BAR;
        PG8_STAGE(PG8_SB(1, 0), cB + kstep, voffB); PG8_STAGE(PG8_SA(1, 0), cA + kstep, voffA); PG8_STAGE(PG8_SB(1, 1), cB + hstep + kstep, voffB);
        PG8_WAIT_V(6); PG8_BAR;
    }
    for (;;) {
        const bool has_next = S.next(ui + 1, nxt);
        const char* nA = has_next ? (const char*)g.A + (size_t)nxt.pm * tstep : cA; const char* nB = has_next ? (const char*)g.Bt + (size_t)nxt.pn * tstep : cB;
        for (int t = 0; t < nt; t += 2) {
            const bool last = (t == nt - 2);
            const char* a1 = cA + (size_t)(t + 1) * kstep;
            const char* a2 = last ? nA : cA + (size_t)(t + 2) * kstep; const char* b2 = last ? nB : cB + (size_t)(t + 2) * kstep;
            const char* a3 = a2 + kstep; const char* b3 = b2 + kstep;
            if (last && has_next) S.a_ready(nxt);
            if constexpr (SP2) {
            PG8_LDB(B0, 0, 0); PG8_LDB(B1, 0, 1); PG8_SCHED; PG8_LDA(At, 0, 0); PG8_STAGE(PG8_SA(1, 1), a1 + hstep, voffA);
            PG8_WAIT_V(8); PG8_WAIT_L(0); PG8_BAR; PG8_MMA(0, 0, At, B0); PG8_MMA(0, 1, At, B1); PG8_BAR; PG8_SCHED;
            PG8_LDA(At, 0, 1); PG8_STAGE(PG8_SB(0, 0), b2, voffB); PG8_STAGE(PG8_SB(0, 1), b2 + hstep, voffB); PG8_STAGE(PG8_SA(0, 0), a2, voffA);
            PG8_WAIT_V(8); PG8_WAIT_L(0); PG8_BAR; PG8_MMA(1, 0, At, B0); PG8_MMA(1, 1, At, B1); PG8_BAR; PG8_SCHED;
            PG8_LDB(B0, 1, 0); PG8_LDB(B1, 1, 1); PG8_SCHED; PG8_LDA(At, 1, 0); PG8_STAGE(PG8_SA(0, 1), a2 + hstep, voffA);
            PG8_WAIT_V(8); PG8_WAIT_L(0); PG8_BAR; PG8_MMA(0, 0, At, B0); PG8_MMA(0, 1, At, B1); PG8_BAR; PG8_SCHED;
            PG8_LDA(At, 1, 1); PG8_STAGE(PG8_SB(1, 0), b3, voffB); PG8_STAGE(PG8_SB(1, 1), b3 + hstep, voffB); PG8_STAGE(PG8_SA(1, 0), a3, voffA);
            PG8_WAIT_V(8); PG8_WAIT_L(0); PG8_BAR; PG8_MMA(1, 0, At, B0); PG8_MMA(1, 1, At, B1); PG8_BAR; PG8_SCHED;
            } else {
            PG8_LDB(B0, 0, 0); PG8_SCHED; PG8_LDA(At, 0, 0); PG8_STAGE(PG8_SA(1, 1), a1 + hstep, voffA);
            PG8_WAIT_L(8); PG8_BAR; PG8_WAIT_L(0); PG8_MMA(0, 0, At, B0); PG8_BAR; PG8_SCHED;
            PG8_LDB(B1, 0, 1); PG8_STAGE(PG8_SB(0, 0), b2, voffB);
            PG8_BAR; PG8_WAIT_L(0); PG8_MMA(0, 1, At, B1); PG8_BAR;
            PG8_LDA(At, 0, 1); PG8_STAGE(PG8_SA(0, 0), a2, voffA);
            PG8_BAR; PG8_WAIT_L(0); PG8_MMA(1, 0, At, B0); PG8_BAR; PG8_SCHED;
            PG8_STAGE(PG8_SB(0, 1), b2 + hstep, voffB);
            PG8_WAIT_V(6); PG8_BAR; PG8_MMA(1, 1, At, B1); PG8_BAR;
            PG8_LDB(B0, 1, 0); PG8_SCHED; PG8_LDA(At, 1, 0); PG8_STAGE(PG8_SA(0, 1), a2 + hstep, voffA);
            PG8_WAIT_L(8); PG8_BAR; PG8_WAIT_L(0); PG8_MMA(0, 0, At, B0); PG8_BAR; PG8_SCHED;
            PG8_LDB(B1, 1, 1); PG8_STAGE(PG8_SB(1, 0), b3, voffB);
            PG8_BAR; PG8_WAIT_L(0); PG8_MMA(0, 1, At, B1); PG8_BAR;
            PG8_LDA(At, 1, 1); PG8_STAGE(PG8_SA(1, 0), a3, voffA);
            PG8_BAR; PG8_WAIT_L(0); PG8_MMA(1, 0, At, B0); PG8_BAR; PG8_SCHED;
            PG8_STAGE(PG8_SB(1, 1), b3 + hstep, voffB);
            PG8_WAIT_V(6); PG8_BAR; PG8_MMA(1, 1, At, B1); PG8_BAR;
            }
        }
        if constexpr (ALIGN_EPI) { if (wr == 0) PG8_BAR; }
        if constexpr (!Epi::AFTER_DRAIN) { E(acc, cur, wr, wc, fr, fq); S.done(cur); }
        if (!has_next) break;
#pragma unroll
        for (int a = 0; a < 2; ++a)
#pragma unroll
            for (int b = 0; b < 2; ++b)
#pragma unroll
                for (int m = 0; m < 4; ++m)
#pragma unroll
                    for (int n = 0; n < 2; ++n) acc[a][b][m][n] = (f32x4){0.f, 0.f, 0.f, 0.f};
        cur = nxt; cA = nA; cB = nB; ++ui;
        if constexpr (ALIGN_EPI) { if (wr == 1) PG8_BAR; }
    }
    PG8_WAIT_V(0);
    if constexpr (!ALIGN_EPI) { if (wr == 0) PG8_BAR; }
    PG8_BAR;
    if constexpr (Epi::AFTER_DRAIN) { E.fused(acc, cur, wr, wc, fr, fq, lds, wid, lane); S.done(cur); }
#undef PG8_SA
#undef PG8_SB
#undef PG8_STAGE
#undef PG8_LDA
#undef PG8_LDB
#undef PG8_MMA
#undef PG8_WAIT_V
#undef PG8_WAIT_L
#undef PG8_BAR
#undef PG8_SCHED
}
}
#ifndef PG8_SP2
#define PG8_SP2 true
#endif
#ifndef PG8_ALIGN
#define PG8_ALIGN true
#endif
constexpr int NWAVES = 8;
constexpr int NB = 2, NS = 4096, DM = 4096, MR = NB * NS;
constexpr int NHQ = 48, NHA = 24, HD = 128, QKVC = 3 * NHQ * HD;
constexpr int DFF = 14336, F2 = 2 * DFF;
constexpr float ATT_SCALE = 0.08838834764831845f;
constexpr float NORM_EPS = 1e-5f;
constexpr size_t MiB = 1u << 20;
constexpr size_t WS_CTL = 0, CTL_ZERO_BYTES = 1 * MiB;
constexpr size_t WS_SSQ = 256 * 1024, SSQ_SITE = 32 * 1024;
constexpr size_t WS_VSQ = 512 * 1024;
constexpr size_t WS_ROPE = 1 * MiB;
constexpr size_t WS_KMEAN = 2 * MiB;
constexpr size_t WS_SS = 3 * MiB, SS_SITE = 2 * MiB;
constexpr size_t WS_VS = 13 * MiB;
constexpr size_t WS_SEL = 18 * MiB;
constexpr size_t WS_LSE = 20 * MiB;
constexpr size_t WS_WIN = 32 * MiB;
constexpr size_t WS_WOUT = 176 * MiB;
constexpr size_t WS_SGWIN = 208 * MiB;
constexpr size_t WS_SGWOUT = 272 * MiB;
constexpr size_t WS_WUP = 304 * MiB, WUP_L = 224 * MiB;
constexpr size_t WS_WDOWN = 752 * MiB, WDOWN_L = 112 * MiB;
constexpr size_t WS_XB = 976 * MiB;
constexpr size_t WS_H = 1040 * MiB;
constexpr size_t WS_QKV = 1168 * MiB;
constexpr size_t WS_U = WS_QKV, WS_V = WS_QKV + 64 * MiB;
constexpr size_t WS_O = 1456 * MiB;
constexpr size_t WS_G = 1520 * MiB;
constexpr size_t WS_DO = WS_G;
constexpr size_t WS_APRE = 1744 * MiB;
constexpr size_t WS_TOP = WS_APRE + 128 * MiB, WS_BOT = WS_APRE + 136 * MiB;
constexpr size_t WS_END = 2192 * MiB;
constexpr int RING_OFF = 0, RING_BYTES = 131072;
constexpr int SCR_BYTES = 133120;
constexpr int LDSCTL_OFF = SCR_BYTES, MISC_OFF = LDSCTL_OFF + 320;
constexpr int XTRA_OFF = SCR_BYTES + 1024;
constexpr int LDS_BYTES = 147456;
static_assert(MISC_OFF + 128 <= XTRA_OFF, "LDS map");
constexpr int CW_TMO = 0, CW_BAR = 4096;

#define GAS __attribute__((address_space(1)))
#define LAS __attribute__((address_space(3)))
typedef unsigned short bf16;
typedef unsigned v4u __attribute__((ext_vector_type(4)));
typedef unsigned v2u __attribute__((ext_vector_type(2)));
typedef float f32x4 __attribute__((ext_vector_type(4)));
typedef float f32x2 __attribute__((ext_vector_type(2)));
#define LDS_WAIT() asm volatile("s_waitcnt lgkmcnt(0)" ::: "memory")
#define VM_WAIT() asm volatile("s_waitcnt vmcnt(0)" ::: "memory")
__device__ __forceinline__ unsigned f2bf(float f) { unsigned u = __builtin_bit_cast(unsigned, f); return (u + 0x7fffu + ((u >> 16) & 1u)) >> 16; }
__device__ __forceinline__ unsigned pk2(float lo, float hi) { return f2bf(lo) | (f2bf(hi) << 16); }
__device__ __forceinline__ float bflo(unsigned w) { return __builtin_bit_cast(float, w << 16); }
__device__ __forceinline__ float bfhi(unsigned w) { return __builtin_bit_cast(float, w & 0xffff0000u); }
__device__ __forceinline__ float bf1(bf16 h) { return __builtin_bit_cast(float, (unsigned)h << 16); }
namespace att {
typedef unsigned short bf16;
typedef short bf16x8 __attribute__((ext_vector_type(8)));
typedef short s16x4 __attribute__((ext_vector_type(4)));
typedef float f32x16 __attribute__((ext_vector_type(16)));
typedef float f32x4 __attribute__((ext_vector_type(4)));
typedef unsigned u32x4 __attribute__((ext_vector_type(4)));
template <class A, class Bt> struct same_t { static constexpr bool v = false; };
template <class A> struct same_t<A, A> { static constexpr bool v = true; };
constexpr int D = 128;
constexpr float SCALE = 0.08838834764831845f, THR = 8.f;
constexpr int NW = 8, QBLK = 32, KVBLK = 64, QB = NW * QBLK;
constexpr int SHM_V = KVBLK * D * 2, SHM_K = KVBLK * D * 2;
constexpr int ATT_LDS_BYTES = 2 * SHM_V + 2 * SHM_K + NW * 64 * 4;
#define KSWZ(row, colB) ((row) * 256 + ((colB) ^ (((row) & 7) << 4)))
#define SBAR() __builtin_amdgcn_sched_barrier(0)
__device__ __forceinline__ int v_st(int k, int c) { const int kk = (k & ~0xC) | ((k & 4) << 1) | ((k & 8) >> 1); return ((kk >> 3) * 4 + (c >> 5)) * 512 + ((kk & 7) * 32 + (c & 31)) * 2; }
__device__ __forceinline__ int v_rd_base(int lane) { return ((lane & 3) << 3) | (((lane >> 2) & 3) << 6) | (((lane >> 4) & 1) << 5) | (((lane >> 5) & 1) << 8); }
constexpr int v_rd_off(int d0, int ks, int half) { return d0 * 512 + ks * 4096 + half * 2048; }
__device__ __forceinline__ int crow(int r, int hi) { return (r & 3) + 8 * (r >> 2) + 4 * hi; }
__device__ __forceinline__ unsigned cvtpk(float lo, float hi) {
    unsigned r; asm volatile("v_cvt_pk_bf16_f32 %0, %1, %2" : "=v"(r) : "v"(lo), "v"(hi)); return r;
}
__device__ __forceinline__ bf16x8 pack8(f32x4 a, f32x4 b) {
    u32x4 w = {cvtpk(a[0], a[1]), cvtpk(a[2], a[3]), cvtpk(b[0], b[1]), cvtpk(b[2], b[3])};
    return *reinterpret_cast<bf16x8*>(&w);
}
template <class T> __device__ __forceinline__ bf16x8 load8(const T* p) {
    if constexpr (same_t<T, float>::v) { return pack8(*(const f32x4*)p, *(const f32x4*)(p + 4)); }
    else { return *reinterpret_cast<const bf16x8*>(p); }
}
__device__ __forceinline__ void mask_tile(f32x16& p0, f32x16& p1, int dq, unsigned W) {
    const float NEG = -__builtin_inff();
#pragma unroll
    for (int r = 0; r < 16; ++r) {
        const int c = (r & 3) + 8 * (r >> 2);
        if ((unsigned)(dq - c) >= W) p0[r] = NEG;
        if ((unsigned)(dq - c - 32) >= W) p1[r] = NEG;
    }
}
__device__ __forceinline__ void partialSM(f32x16& p0, f32x16& p1, float& m_reg, float& mn, float& alpha) {
    float pmax = p0[0]; for (int r = 1; r < 16; ++r) pmax = fmaxf(pmax, p0[r]); for (int r = 0; r < 16; ++r) pmax = fmaxf(pmax, p1[r]);
    { auto rr = __builtin_amdgcn_permlane32_swap(__float_as_uint(pmax), __float_as_uint(pmax), false, false);
      pmax = fmaxf(__uint_as_float(rr[0]), __uint_as_float(rr[1])); }
    constexpr float C2 = 1.4426950408889634f * SCALE;
    if (__builtin_expect(__all((pmax - m_reg) * SCALE <= THR), 1)) { mn = m_reg; alpha = 1.f; }
    else { mn = fmaxf(m_reg, pmax); alpha = __builtin_amdgcn_exp2f((m_reg - mn) * C2); m_reg = mn; }
    const float mnL = -mn * C2;
    for (int r = 0; r < 16; ++r) p0[r] = fmaf(p0[r], C2, mnL); for (int r = 0; r < 16; ++r) p1[r] = fmaf(p1[r], C2, mnL);
    for (int r = 0; r < 16; ++r) p0[r] = __builtin_amdgcn_exp2f(p0[r]);
}
__device__ __forceinline__ void finishSM(f32x16& p0, f32x16& p1, float alpha, float& l_reg, bf16x8& pa0, bf16x8& pa1, bf16x8& pa2, bf16x8& pa3) {
    for (int r = 0; r < 16; ++r) p1[r] = __builtin_amdgcn_exp2f(p1[r]);
    float ps = 0; for (int r = 0; r < 16; ++r) ps += p0[r]; for (int r = 0; r < 16; ++r) ps += p1[r];
    { auto rr = __builtin_amdgcn_permlane32_swap(__float_as_uint(ps), __float_as_uint(ps), false, false);
      ps = __uint_as_float(rr[0]) + __uint_as_float(rr[1]); }
    l_reg = l_reg * alpha + ps;
#define PK4(P, B_, OUT) do { unsigned a0 = cvtpk(P[B_+0], P[B_+1]), a1 = cvtpk(P[B_+2], P[B_+3]);                          \
        unsigned b0 = cvtpk(P[B_+4], P[B_+5]), b1 = cvtpk(P[B_+6], P[B_+7]);                                             \
        auto r0 = __builtin_amdgcn_permlane32_swap(a0, b0, false, false); auto r1 = __builtin_amdgcn_permlane32_swap(a1, b1, false, false); \
        u32x4 w = {r0[0], r1[0], r0[1], r1[1]}; OUT = *reinterpret_cast<bf16x8*>(&w); } while (0)
    PK4(p0, 0, pa0); PK4(p0, 8, pa1); PK4(p1, 0, pa2); PK4(p1, 8, pa3);
#undef PK4
}
template <int KB, bool SK>
__device__ __forceinline__ void qkt(f32x16& p0, f32x16& p1, const char* K_lds, int r32, int hi, const bf16x8* qr, bool act) {
    if (SK && !act) { const float NEG = -__builtin_inff();
#pragma unroll
        for (int r = 0; r < 16; ++r) { p0[r] = NEG; p1[r] = NEG; } return; }
    p0 = f32x16{}; p1 = f32x16{};
    const char* kb[4];
#pragma unroll
    for (int dd = 0; dd < 4; ++dd) kb[dd] = K_lds + KB * SHM_K + KSWZ(r32, (dd * 16 + hi * 8) * 2);
#pragma unroll
    for (int d0 = 0; d0 < 8; ++d0) { const char* a = kb[d0 & 3] + (d0 >> 2) * 128;
        bf16x8 b0 = *reinterpret_cast<const bf16x8*>(a);
        bf16x8 b1 = *reinterpret_cast<const bf16x8*>(a + 32 * 256);
        p0 = __builtin_amdgcn_mfma_f32_32x32x16_bf16(b0, qr[d0], p0, 0, 0, 0);
        p1 = __builtin_amdgcn_mfma_f32_32x32x16_bf16(b1, qr[d0], p1, 0, 0, 0); }
}
template <int VB, bool SK>
__device__ __forceinline__ void pv_tile(f32x16* o, int vb0, bf16x8 pa0, bf16x8 pa1, bf16x8 pa2, bf16x8 pa3, bool act) {
    if (SK && !act) return;
#define TRRD(dst, off) asm volatile("ds_read_b64_tr_b16 %0, %1 offset:%2" : "=&v"(dst) : "v"(vb0), "i"(off) : "memory")
#define PV_D0(d0) do { s16x4 l0, l1, l2, l3, h0, h1, h2, h3; constexpr int b_ = VB * SHM_V + v_rd_off(d0, 0, 0);     \
        TRRD(l0, b_); TRRD(h0, b_ + 2048); TRRD(l1, b_ + 4096); TRRD(h1, b_ + 6144); TRRD(l2, b_ + 8192); TRRD(h2, b_ + 10240); TRRD(l3, b_ + 12288); TRRD(h3, b_ + 14336); \
        asm volatile("s_waitcnt lgkmcnt(0)" ::: "memory"); SBAR();                 \
        o[d0] = __builtin_amdgcn_mfma_f32_32x32x16_bf16(pa0, (bf16x8){l0[0], l0[1], l0[2], l0[3], h0[0], h0[1], h0[2], h0[3]}, o[d0], 0, 0, 0);   \
        o[d0] = __builtin_amdgcn_mfma_f32_32x32x16_bf16(pa1, (bf16x8){l1[0], l1[1], l1[2], l1[3], h1[0], h1[1], h1[2], h1[3]}, o[d0], 0, 0, 0);   \
        o[d0] = __builtin_amdgcn_mfma_f32_32x32x16_bf16(pa2, (bf16x8){l2[0], l2[1], l2[2], l2[3], h2[0], h2[1], h2[2], h2[3]}, o[d0], 0, 0, 0);   \
        o[d0] = __builtin_amdgcn_mfma_f32_32x32x16_bf16(pa3, (bf16x8){l3[0], l3[1], l3[2], l3[3], h3[0], h3[1], h3[2], h3[3]}, o[d0], 0, 0, 0); } while (0)
    PV_D0(0); PV_D0(1); PV_D0(2); PV_D0(3);
#undef PV_D0
#undef TRRD
}

template <class TIn, class TOut> struct BlockRef { const TIn* Q; const TIn* K; const TIn* V; TOut* O; int P0; const unsigned short* sel; float* L; };
template <class TIn> struct Seam {
    bf16x8 qr[8];
    bf16x8 st_v0, st_v1, st_k0, st_k1; f32x4 sf0, sf1, sf2, sf3;
    f32x4 tq[16];
};
__device__ __forceinline__ int swa_jlo(int P0, int W) { const int lowk = P0 - W + 1; return lowk > 0 ? lowk / KVBLK : 0; }
#define ROW(p, k0, rr) ((p) + (size_t)((k0) + (rr)) * rs_ + sc)
#define ROWN(p, k0, rr) ((p) + (size_t)((k0) + (rr)) * rsn_ + sc)
#define VMW() asm volatile("s_waitcnt vmcnt(0)" ::: "memory")
#define VMWN(n) asm volatile("s_waitcnt vmcnt(%0)" :: "i"(n) : "memory")
#define SLOAD_H(Kp, Vp, k0) do { S.st_v0 = load8<TIn>(ROW(Vp, k0, sr)); S.st_v1 = load8<TIn>(ROW(Vp, k0, 32 + sr));              \
                         S.st_k0 = load8<TIn>(ROW(Kp, k0, sr)); S.st_k1 = load8<TIn>(ROW(Kp, k0, 32 + sr)); } while (0)
#define SLOAD_HN(Kp, Vp, k0) do { S.st_v0 = load8<TIn>(ROWN(Vp, k0, sr)); S.st_v1 = load8<TIn>(ROWN(Vp, k0, 32 + sr));              \
                         S.st_k0 = load8<TIn>(ROWN(Kp, k0, sr)); S.st_k1 = load8<TIn>(ROWN(Kp, k0, 32 + sr)); } while (0)
#define SWRITE_HK(bf) do { *(bf16x8*)(K_lds + (bf) * SHM_K + kws) = S.st_k0; *(bf16x8*)(K_lds + (bf) * SHM_K + kws + 32 * 256) = S.st_k1; } while (0)
#define SWRITE_HV(bf) do { *(bf16x8*)(V_lds + (bf) * SHM_V + vst0) = S.st_v0; *(bf16x8*)(V_lds + (bf) * SHM_V + vst1) = S.st_v1; } while (0)
#define SWRITE_H(bf) do { SWRITE_HV(bf); SWRITE_HK(bf); } while (0)
#define SLOAD_F(p, k0) do { S.sf0 = *(const f32x4*)ROW(p, k0, sr); S.sf1 = *(const f32x4*)(ROW(p, k0, sr) + 4);                \
                            S.sf2 = *(const f32x4*)ROW(p, k0, 32 + sr); S.sf3 = *(const f32x4*)(ROW(p, k0, 32 + sr) + 4); } while (0)
#define SWRITE_KF(bf) do { *(bf16x8*)(K_lds + (bf) * SHM_K + kws) = pack8(S.sf0, S.sf1); *(bf16x8*)(K_lds + (bf) * SHM_K + kws + 32 * 256) = pack8(S.sf2, S.sf3); } while (0)
#define SWRITE_VF(bf) do { *(bf16x8*)(V_lds + (bf) * SHM_V + vst0) = pack8(S.sf0, S.sf1); *(bf16x8*)(V_lds + (bf) * SHM_V + vst1) = pack8(S.sf2, S.sf3); } while (0)
template <class TIn, class TOut, int RSC, int W>
__device__ __forceinline__ void causal_swa_prime(const BlockRef<TIn, TOut>& cur, char* lds, Seam<TIn>& S) {
    constexpr bool F32 = same_t<TIn, float>::v;
    const int tid = threadIdx.x, wid = __builtin_amdgcn_readfirstlane(tid >> 6), lane = tid & 63, r32 = lane & 31, hi = lane >> 5;
    const int sr = tid >> 4, sc = (tid & 15) * 8, kws = KSWZ(sr, sc * 2); char* K_lds = lds + 2 * SHM_V;
    const int kb0 = swa_jlo(cur.P0, W) * KVBLK; constexpr int rs_ = RSC;
    for (int d0 = 0; d0 < 8; ++d0) S.qr[d0] = load8<TIn>(cur.Q + (size_t)(wid * QBLK + r32) * rs_ + d0 * 16 + hi * 8);
    if constexpr (F32) { SLOAD_F((const float*)cur.K, kb0); VMW(); SWRITE_KF(0); SBAR(); SLOAD_F((const float*)cur.V, kb0); }
    else { SLOAD_H(cur.K, cur.V, kb0); VMW(); SWRITE_HK(0); }
    __syncthreads();
}
template <class TIn, class TOut, bool SKP, int MODE, int RSC, int RSN, int OSC, int W, int WN, int skv>
__device__ __forceinline__ void causal_swa_block(const BlockRef<TIn, TOut>& cur, const BlockRef<TIn, TOut>& nxt, char* lds, Seam<TIn>& S) {
    constexpr bool F32 = same_t<TIn, float>::v; static_assert(!F32, "bf16 inputs only in this build");
    constexpr int rs_ = RSC, rsn_ = RSN, os_ = OSC;
    const int tid = threadIdx.x, wid = __builtin_amdgcn_readfirstlane(tid >> 6), lane = tid & 63, r32 = lane & 31, hi = lane >> 5;
    const int j_lo = swa_jlo(cur.P0, W);
    int j_hi = (cur.P0 + QB - 1) / KVBLK + 1; if (j_hi > skv / KVBLK) j_hi = skv / KVBLK;
    const int NT = j_hi - j_lo;
    const int kbn = swa_jlo(nxt.P0, WN) * KVBLK;
    const int qlo = cur.P0 + wid * QBLK, qm = qlo + r32 - 4 * hi;
    char* V_lds = lds; char* K_lds = lds + 2 * SHM_V;
    float* ws = (float*)(lds + 2 * SHM_V + 2 * SHM_K) + wid * 64; float* li_l = ws, * al_l = ws + 32;
    float m_reg = -1e30f, l_reg = 0; f32x16 o[4] = {};
    unsigned selm = 0u; if constexpr (MODE == 0) selm = cur.sel[wid * QBLK + r32];
    const int sr = tid >> 4, sc = (tid & 15) * 8, vst0 = v_st(sr, sc), vst1 = v_st(32 + sr, sc), kws = KSWZ(sr, sc * 2);
    const int vb0 = (int)(uintptr_t)V_lds + v_rd_base(lane);
    const TIn* Kh = cur.K; const TIn* Vh = cur.V;
#define RESC(a) do { if (__any((a) < 1.f)) { if (hi == 0) al_l[r32] = (a); asm volatile("s_waitcnt lgkmcnt(0)" ::: "memory");              \
                     for (int d_ = 0; d_ < 4; ++d_) for (int r = 0; r < 16; ++r) o[d_][r] *= al_l[crow(r, hi)]; } } while (0)
#define KBASE(t) ((j_lo + (t)) * KVBLK)
#define ACT(t) (KBASE(t) <= qlo + QBLK - 1 && KBASE(t) + KVBLK - 1 >= qlo - W + 1)
#define MASKT(P0_, P1_, t) do { const int kb_ = KBASE(t); if ((!SK || ACT(t)) && (kb_ + KVBLK - 1 > qlo || kb_ <= qlo + QBLK - 1 - W)) mask_tile(P0_, P1_, qm - kb_, (unsigned)W); \
        if constexpr (MODE == 0) { if (kb_ < cur.P0) { const bool dead_ = ((selm >> (kb_ >> 8)) & 1u) == 0u; const float NEG_ = -__builtin_inff(); \
            _Pragma("unroll") for (int r_ = 0; r_ < 16; ++r_) { P0_[r_] = dead_ ? NEG_ : P0_[r_]; P1_[r_] = dead_ ? NEG_ : P1_[r_]; } } } } while (0)
    constexpr int NQL = F32 ? 16 : 8;
    constexpr bool SK = SKP && !F32;
#define SEAM_K0() do { VMWN(NQL); if constexpr (F32) { SWRITE_KF(0); SBAR(); SLOAD_F((const float*)nxt.V, kbn); } else { SWRITE_HK(0); } SBAR(); } while (0)
    f32x16 pA0, pA1, pB0, pB1; float mnA, mnB, alA, alB; bf16x8 pa0, pa1, pa2, pa3;
    if constexpr (F32) { VMW(); SWRITE_VF(0); SBAR(); } else { SWRITE_HV(0); SBAR(); }
    if (NT > 1) { if constexpr (F32) SLOAD_F((const float*)Kh, KBASE(1)); else SLOAD_H(Kh, Vh, KBASE(1)); }
    SBAR(); qkt<0, SK>(pA0, pA1, K_lds, r32, hi, S.qr, ACT(0));
    if constexpr (F32) { if (NT > 1) { VMW(); SWRITE_KF(1); SBAR(); SLOAD_F((const float*)Vh, KBASE(1)); } }
    MASKT(pA0, pA1, 0); partialSM(pA0, pA1, m_reg, mnA, alA);
    if (NT > 1) { VMW(); if constexpr (F32) { SWRITE_VF(1); SBAR(); if (NT > 2) SLOAD_F((const float*)Kh, KBASE(2)); } else SWRITE_H(1); }
    __syncthreads();
#define HALF_STEP(PX0, PX1, mnX, alX, PY0, PY1, alY, t, KB, VB, SB) do {                                                      \
        SBAR(); qkt<KB, SK>(PX0, PX1, K_lds, r32, hi, S.qr, ACT(t));                                             \
        finishSM(PY0, PY1, alY, l_reg, pa0, pa1, pa2, pa3); SBAR();                                                           \
        if ((t) + 1 < NT) { if constexpr (F32) { VMW(); SWRITE_KF(SB); SBAR(); SLOAD_F((const float*)Vh, KBASE((t) + 1)); }  \
                            else { SLOAD_H(Kh, Vh, KBASE((t) + 1)); } SBAR(); }                                               \
        pv_tile<VB, SK>(o, vb0, pa0, pa1, pa2, pa3, ACT((t) - 1)); MASKT(PX0, PX1, (t)); partialSM(PX0, PX1, m_reg, mnX, alX);                                        \
        __syncthreads();                                                                                                      \
        if ((t) + 1 < NT) { VMW(); if constexpr (F32) { SWRITE_VF(SB); SBAR(); if ((t) + 2 < NT) SLOAD_F((const float*)Kh, KBASE((t) + 2)); } \
                            else { SWRITE_H(SB); } }                                                                          \
        RESC(alX); __syncthreads(); } while (0)
    for (int t = 1; t + 1 < NT; t += 2) {
        HALF_STEP(pB0, pB1, mnB, alB, pA0, pA1, alA, t, 1, 0, 0);
        HALF_STEP(pA0, pA1, mnA, alA, pB0, pB1, alB, t + 1, 0, 1, 1);
    }
    const bool even = (NT & 1) == 0;
    if (even) { SBAR(); qkt<1, SK>(pB0, pB1, K_lds, r32, hi, S.qr, ACT(NT - 1)); SBAR(); }
#define QROW(e) (nxt.Q + (size_t)(wid * QBLK + r32) * rsn_ + ((e) >> 1) * 16 + hi * 8 + ((e) & 1) * 4)
    if constexpr (F32) { SLOAD_F((const float*)nxt.K, kbn); SBAR();
#pragma unroll
        for (int e = 0; e < 8; ++e) S.tq[e] = *(const f32x4*)QROW(e); }
    else { SLOAD_HN(nxt.K, nxt.V, kbn); SBAR();
#pragma unroll
        for (int d0 = 0; d0 < 8; ++d0) S.qr[d0] = load8<TIn>(nxt.Q + (size_t)(wid * QBLK + r32) * rsn_ + d0 * 16 + hi * 8); }
    SBAR();
    finishSM(pA0, pA1, alA, l_reg, pa0, pa1, pa2, pa3); SBAR();
    if constexpr (F32) {
#pragma unroll
        for (int e = 8; e < 16; ++e) S.tq[e] = *(const f32x4*)QROW(e); SBAR(); }
#undef QROW
    pv_tile<0, SK>(o, vb0, pa0, pa1, pa2, pa3, ACT(even ? NT - 2 : NT - 1));
    if (even) { MASKT(pB0, pB1, NT - 1); partialSM(pB0, pB1, m_reg, mnB, alB); __syncthreads(); RESC(alB);
        finishSM(pB0, pB1, alB, l_reg, pa0, pa1, pa2, pa3); SBAR(); pv_tile<1, SK>(o, vb0, pa0, pa1, pa2, pa3, ACT(NT - 1)); }
    SBAR(); SEAM_K0();
    if (hi == 0) li_l[r32] = l_reg; asm volatile("s_waitcnt lgkmcnt(0)" ::: "memory");
    if constexpr (MODE == 1) { if (hi == 0) cur.L[(size_t)(wid * QBLK + r32) * (RSC / 128 * 24)] = m_reg * SCALE + __logf(l_reg); }
    float rli[16];
#pragma unroll
    for (int r = 0; r < 16; ++r) rli[r] = __builtin_amdgcn_rcpf(li_l[crow(r, hi)]);
    TOut* Ow = cur.O + (size_t)(wid * QBLK) * os_;
#pragma unroll
    for (int r = 0; r < 16; ++r) { const int orow = crow(r, hi);
#pragma unroll
        for (int d0 = 0; d0 < 4; ++d0) { const float v = o[d0][r] * rli[r];
            if constexpr (same_t<TOut, float>::v) { Ow[(size_t)orow * os_ + d0 * 32 + r32] = v; }
            else { const float vn = __shfl_xor(v, 1);
                   if ((r32 & 1) == 0) *(unsigned*)(Ow + (size_t)orow * os_ + d0 * 32 + r32) = cvtpk(v, vn); } } }
    if constexpr (F32) {
#pragma unroll
        for (int d0 = 0; d0 < 8; ++d0) S.qr[d0] = pack8(S.tq[2 * d0], S.tq[2 * d0 + 1]); }
    __syncthreads();
#undef RESC
#undef KBASE
#undef ACT
#undef MASKT
#undef SEAM_K0
#undef HALF_STEP
}
#undef ROW
#undef ROWN
#undef SLOAD_HN
#undef VMW
#undef VMWN
#undef SLOAD_H
#undef SWRITE_HK
#undef SWRITE_HV
#undef SWRITE_H
#undef SLOAD_F
#undef SWRITE_KF
#undef SWRITE_VF
}
#define XB_TMO      128
#define XB_XCNT(j)  (256  + 64 * (j))
#define XB_XSUB(j)  (1280 + 64 * (j))
#define XB_XGEN(j)  (2304 + 64 * (j))
#define XB_TOP      3328
#define XB_TOPGEN   3392
#define XCD_BAR_WORDS 3456
#define XB_SPIN_CAP (1u << 18)

__device__ __forceinline__ unsigned xb_ld(unsigned* p)              { return __hip_atomic_load(p, __ATOMIC_RELAXED, __HIP_MEMORY_SCOPE_AGENT); }
__device__ __forceinline__ unsigned xb_add(unsigned* p, unsigned v) { return __hip_atomic_fetch_add(p, v, __ATOMIC_RELAXED, __HIP_MEMORY_SCOPE_AGENT); }
__device__ __forceinline__ unsigned xb_xcc_id() { return (unsigned)__builtin_amdgcn_s_getreg((3 << 11) | 20) & 0xFu; }
#define XB_SPIN(cond, bar) do { unsigned _sp = 0; while (cond) { __builtin_amdgcn_s_sleep(1); \
    if ((++_sp & 255u) == 0u) { if (xb_ld(&(bar)[XB_TMO])) break; if (_sp > XB_SPIN_CAP) { atomicAdd(&(bar)[XB_TMO], 1u); break; } } } } while (0)

struct XcdBarrier {
    unsigned* bar; unsigned x;
    volatile LAS unsigned* st;
};

__device__ __forceinline__ XcdBarrier xcd_barrier_post(unsigned* bar, volatile LAS unsigned* st) {
    XcdBarrier b; b.bar = bar; b.x = xb_xcc_id(); b.st = st;
    if (threadIdx.x == 0) (void)xb_add(&bar[XB_XCNT(b.x)], 1u);
    return b;
}
__device__ __forceinline__ void xcd_barrier_complete(unsigned* bar, unsigned x, unsigned& nloc, unsigned& nx) {
    const unsigned G = gridDim.x * gridDim.y * gridDim.z;
    unsigned sum, cnt, mine, sp = 0u;
    for (;;) {
        sum = 0u; cnt = 0u; mine = 0u;
#pragma unroll
        for (unsigned j = 0; j < 16; ++j) { const unsigned c = xb_ld(&bar[XB_XCNT(j)]); sum += c; cnt += (c > 0u) ? 1u : 0u; mine = (j == x) ? c : mine; }
        if (sum == G) break;
        __builtin_amdgcn_s_sleep(1);
        if ((++sp & 255u) == 0u) { if (xb_ld(&bar[XB_TMO])) break; if (sp > XB_SPIN_CAP) { atomicAdd(&bar[XB_TMO], 1u); break; } }
    }
    nloc = mine > 0u ? mine : 1u; nx = cnt > 0u ? cnt : 1u;
}

__device__ __forceinline__ void xcd_barrier(const XcdBarrier& b) {
    asm volatile("s_waitcnt vmcnt(0)" ::: "memory");
    __syncthreads();
    if (threadIdx.x == 0) {
        unsigned* bar = b.bar;
        __builtin_amdgcn_s_waitcnt(0);
        unsigned nloc = b.st[0], nx = b.st[1];
        if (nloc == 0u) { xcd_barrier_complete(bar, b.x, nloc, nx); b.st[0] = nloc; b.st[1] = nx; }
        const unsigned old = xb_add(&bar[XB_XSUB(b.x)], 1u);
        const unsigned gen = old / nloc;
        if (old + 1u == (gen + 1u) * nloc) {
            __builtin_amdgcn_fence(__ATOMIC_RELEASE, "agent");
            asm volatile("s_waitcnt vmcnt(0)" ::: "memory");
            const unsigned og = xb_add(&bar[XB_TOP], 1u);
            const unsigned tg = og / nx;
            if (og + 1u == (tg + 1u) * nx) xb_add(&bar[XB_TOPGEN], 1u);
            else XB_SPIN(xb_ld(&bar[XB_TOPGEN]) == tg, bar);
            __builtin_amdgcn_fence(__ATOMIC_ACQUIRE, "agent");
            xb_add(&bar[XB_XGEN(b.x)], 1u);
            asm volatile("s_waitcnt vmcnt(0)" ::: "memory");
        } else {
            XB_SPIN(xb_ld(&bar[XB_XGEN(b.x)]) == gen, bar);
            __builtin_amdgcn_fence(__ATOMIC_ACQUIRE, "agent");
            asm volatile("s_waitcnt vmcnt(0)" ::: "memory");
        }
    }
    __syncthreads();
}
struct Frame {
    LAS unsigned char* lds;
    volatile LAS unsigned* MISC;
    unsigned* ctl;
    int tid, lane, wave, G, gw, NGW;
    unsigned char* ws;
    const float* x; const int* pos;
    const float *attn_norm, *attn_w_in, *attn_w_out, *sg_norm, *sg_w_in, *sg_b_in, *sg_v_gain, *sg_v_bias, *sg_w_s, *sg_b_s, *sg_w_out, *ffn_norm, *ffn_w_up, *ffn_conv_w, *ffn_conv_b, *ffn_w_down, *final_norm;
    float* out;
};
__device__ __forceinline__ float wave_sum(float v) {
#pragma unroll
    for (int o = 1; o < 64; o <<= 1) v += __shfl_xor(v, o);
    return v;
}
__device__ __forceinline__ float wave_max(float v) {
#pragma unroll
    for (int o = 1; o < 64; o <<= 1) v = fmaxf(v, __shfl_xor(v, o));
    return v;
}
__device__ __forceinline__ float ss_rstd(const float* ss, int r) { return pg8::rstd_from_ss(ss, r); }

struct MapId { __device__ __forceinline__ int operator()(int n) const { return n; } };
struct MapUp { __device__ __forceinline__ int operator()(int n) const { return n < DFF ? ((n >> 7) << 8) + (n & 127) : (((n - DFF) >> 7) << 8) + 128 + ((n - DFF) & 127); } };
template <class RowMap>
__device__ __forceinline__ void transpose_item(const float* W, int K, int N, const float* gain, bf16* WT, RowMap rm, LAS float* scr, int item, int lane) {
    const int nblk = N / 64, kb = item / nblk, nb = item - kb * nblk, k0 = 64 * kb, n0 = 64 * nb;
    const int lr = lane >> 4, lc = (lane & 15) * 4;
    f32x4 v[16];
#pragma unroll
    for (int i = 0; i < 16; ++i) v[i] = *(const f32x4*)(W + (size_t)(k0 + 4 * i + lr) * N + n0 + lc);
#pragma unroll
    for (int i = 0; i < 16; ++i) { const int kk = 4 * i + lr; f32x4 x = v[i]; if (gain) x = x * gain[k0 + kk]; LAS float* d = scr + kk * 65 + lc; d[0] = x[0]; d[1] = x[1]; d[2] = x[2]; d[3] = x[3]; }
    LDS_WAIT(); asm volatile("" ::: "memory");
    const int c = lane & 7;
#pragma unroll
    for (int j = 0; j < 8; ++j) { const int n = (lane >> 3) + 8 * j; const LAS float* s = scr + (8 * c) * 65 + n;
        v4u o; o.x = pk2(s[0 * 65], s[1 * 65]); o.y = pk2(s[2 * 65], s[3 * 65]); o.z = pk2(s[4 * 65], s[5 * 65]); o.w = pk2(s[6 * 65], s[7 * 65]);
        *(v4u*)(WT + (size_t)rm(n0 + n) * K + k0 + 8 * c) = o; }
    LDS_WAIT(); asm volatile("" ::: "memory");
}
__device__ __forceinline__ void sincos_d(double a, double& sn, double& cs) {
    const double n = __builtin_rint(a * 0.15915494309189535);
    const double r = a - n * 6.283185307179586;
    const double r2 = r * r;
    double ts = r, tc = 1.0, s = r, c = 1.0;
#pragma unroll
    for (int k = 1; k <= 15; ++k) { tc = -tc * r2 / (double)((2 * k - 1) * (2 * k)); ts = -ts * r2 / (double)((2 * k) * (2 * k + 1)); c += tc; s += ts; }
    sn = s; cs = c;
}
__device__ __forceinline__ void p0_prologue(Frame& F) {
    LAS float* scr = (LAS float*)(F.lds + RING_OFF + F.wave * 16640);
    constexpr int I_WIN = 64 * (QKVC / 64), I_SQ = 64 * (DM / 64), I_SGIN = 64 * (2 * DM / 64), I_UP = 64 * (F2 / 64), I_DN = (DFF / 64) * (DM / 64);
    constexpr int NITEMS = I_WIN + 2 * I_SQ + I_SGIN + 2 * I_UP + 2 * I_DN;
    for (int it = F.gw; it < NITEMS; it += F.NGW) {
        int r = it;
        if (r < I_WIN) { transpose_item(F.attn_w_in, DM, QKVC, F.attn_norm, (bf16*)(F.ws + WS_WIN), MapId(), scr, r, F.lane); continue; } r -= I_WIN;
        if (r < I_SQ) { transpose_item(F.attn_w_out, DM, DM, nullptr, (bf16*)(F.ws + WS_WOUT), MapId(), scr, r, F.lane); continue; } r -= I_SQ;
        if (r < I_SGIN) { transpose_item(F.sg_w_in, DM, 2 * DM, F.sg_norm, (bf16*)(F.ws + WS_SGWIN), MapId(), scr, r, F.lane); continue; } r -= I_SGIN;
        if (r < I_SQ) { transpose_item(F.sg_w_out, DM, DM, nullptr, (bf16*)(F.ws + WS_SGWOUT), MapId(), scr, r, F.lane); continue; } r -= I_SQ;
        if (r < I_UP) { transpose_item(F.ffn_w_up, DM, F2, F.ffn_norm, (bf16*)(F.ws + WS_WUP), MapUp(), scr, r, F.lane); continue; } r -= I_UP;
        if (r < I_UP) { transpose_item(F.ffn_w_up + (size_t)DM * F2, DM, F2, F.ffn_norm + DM, (bf16*)(F.ws + WS_WUP + WUP_L), MapUp(), scr, r, F.lane); continue; } r -= I_UP;
        if (r < I_DN) { transpose_item(F.ffn_w_down, DFF, DM, nullptr, (bf16*)(F.ws + WS_WDOWN), MapId(), scr, r, F.lane); continue; } r -= I_DN;
        transpose_item(F.ffn_w_down + (size_t)DFF * DM, DFF, DM, nullptr, (bf16*)(F.ws + WS_WDOWN + WDOWN_L), MapId(), scr, r, F.lane);
    }
    bf16* XB = (bf16*)(F.ws + WS_XB); float* SS0 = (float*)(F.ws + WS_SSQ);
    for (int m = F.gw; m < MR; m += F.NGW) {
        const f32x4* xr = (const f32x4*)(F.x + (size_t)m * DM) + F.lane;
        v2u* o8 = (v2u*)(XB + (size_t)m * DM) + F.lane;
        float sq = 0.f;
#pragma unroll
        for (int j = 0; j < 16; ++j) { const f32x4 v = xr[64 * j]; sq += (v[0] * v[0] + v[1] * v[1]) + (v[2] * v[2] + v[3] * v[3]); v2u w; w.x = pk2(v[0], v[1]); w.y = pk2(v[2], v[3]); o8[64 * j] = w; }
        sq = wave_sum(sq);
        if (F.lane == 0) SS0[m] = sq;
    }
    float* rc = (float*)(F.ws + WS_ROPE); float* rs = rc + MR * 16;
    for (int idx = F.gw * 64 + F.lane; idx < MR * 16; idx += F.NGW * 64) {
        const int r = idx >> 4, i = idx & 15;
        double invd = 1.0;
        for (int k = 0; k < i; ++k) invd *= 0.44036660267178046;
        const float inv = (float)invd;
        const float ang = (float)F.pos[r] * inv;
        double sn, cs; sincos_d((double)ang, sn, cs);
        rc[idx] = (float)cs; rs[idx] = (float)sn;
    }
}

__device__ __forceinline__ void p_kmean(Frame& F) {
    const bf16* QKV = (const bf16*)(F.ws + WS_QKV); float* KM = (float*)(F.ws + WS_KMEAN);
    LAS float* red = (LAS float*)(F.lds + RING_OFF);
    for (int item = blockIdx.x; item < NB * NHA * 16; item += F.G) {
        const int j = item & 15, bh = item >> 4, b = bh / NHA, h = bh - b * NHA;
        const bf16* kb = QKV + ((size_t)((1 * 2 + b) * NHQ + h) * NS + 256 * j) * HD;
        const int d = F.tid & 127, part = F.tid >> 7;
        float s = 0.f;
        for (int i = 0; i < 64; ++i) s += bf1(kb[(size_t)(part * 64 + i) * HD + d]);
        red[part * 128 + d] = s;
        __syncthreads();
        if (F.tid < 128) KM[(size_t)item * 128 + F.tid] = (red[F.tid] + red[128 + F.tid] + red[256 + F.tid] + red[384 + F.tid]) * (1.0f / 256.0f);
        __syncthreads();
    }
}

__device__ __forceinline__ float dot128(const LAS float* qs, const bf16* krow) {
    float s = 0.f;
#pragma unroll 4
    for (int c = 0; c < 16; ++c) {
        const v4u kv = *(const v4u*)(krow + 8 * c); const LAS float* q8 = qs + 8 * c;
        s += q8[0] * bflo(kv.x) + q8[1] * bfhi(kv.x) + q8[2] * bflo(kv.y) + q8[3] * bfhi(kv.y) + q8[4] * bflo(kv.z) + q8[5] * bfhi(kv.z) + q8[6] * bflo(kv.w) + q8[7] * bfhi(kv.w);
    }
    return s;
}
__device__ __forceinline__ void p_attn_naive(Frame& F, bf16* O) {
    const bf16* QKV = (const bf16*)(F.ws + WS_QKV); const float* KM = (const float*)(F.ws + WS_KMEAN);
    LAS float* qs = (LAS float*)(F.lds + RING_OFF + F.wave * 8192);
    LAS float* ps = qs + 128;
    const int lane = F.lane;
    constexpr int NMOBA = NB * NHA * NS, NDIL = NB * 8 * NS;
    const float NEG = -__builtin_inff();
    for (int task = F.gw; task < NMOBA + NDIL; task += F.NGW) {
        if (task < NMOBA) {
            const int b = task / (NHA * NS), rem = task - b * (NHA * NS), h = rem >> 12, t = rem & 4095;
            const bf16* qrow = QKV + ((size_t)((0 * 2 + b) * NHQ + h) * NS + t) * HD;
            const bf16* Kb = QKV + (size_t)((1 * 2 + b) * NHQ + h) * NS * HD;
            const bf16* Vb = QKV + (size_t)((2 * 2 + b) * NHQ + h) * NS * HD;
            { const unsigned w = *(const unsigned*)(qrow + 2 * lane); qs[2 * lane] = bflo(w); qs[2 * lane + 1] = bfhi(w); }
            LDS_WAIT(); asm volatile("" ::: "memory");
            const int qb = t >> 8, tin = t & 255;
            float g = NEG;
            if (lane < qb) { const float* km = KM + ((size_t)((b * NHA + h) * 16 + lane)) * 128; float s = 0.f; for (int d = 0; d < 128; ++d) s += qs[d] * km[d]; g = s; }
            unsigned selmask = 0u;
            if (qb <= 3) selmask = (1u << qb) - 1u;
            else {
#pragma unroll
                for (int rd = 0; rd < 3; ++rd) {
                    float best = g; int bi = lane;
#pragma unroll
                    for (int o = 1; o < 64; o <<= 1) { const float ob = __shfl_xor(best, o); const int oi = __shfl_xor(bi, o); if (ob > best || (ob == best && oi < bi)) { best = ob; bi = oi; } }
                    selmask |= 1u << bi; if (lane == bi) g = NEG;
                }
            }
            float sc[4][4]; int jsel[3];
            unsigned mk = selmask;
#pragma unroll
            for (int sl = 0; sl < 3; ++sl) {
                int j = -1; if (mk) { j = __builtin_ctz(mk); mk &= mk - 1u; }
                jsel[sl] = j;
#pragma unroll
                for (int c = 0; c < 4; ++c) sc[sl][c] = (j >= 0) ? ATT_SCALE * dot128(qs, Kb + (size_t)(256 * j + lane + 64 * c) * HD) : NEG;
            }
#pragma unroll
            for (int c = 0; c < 4; ++c) { const int i = lane + 64 * c; sc[3][c] = (i <= tin) ? ATT_SCALE * dot128(qs, Kb + (size_t)(256 * qb + i) * HD) : NEG; }
            float mx = NEG;
#pragma unroll
            for (int sl = 0; sl < 4; ++sl)
#pragma unroll
                for (int c = 0; c < 4; ++c) mx = fmaxf(mx, sc[sl][c]);
            mx = wave_max(mx);
            float sum = 0.f;
#pragma unroll
            for (int sl = 0; sl < 4; ++sl)
#pragma unroll
                for (int c = 0; c < 4; ++c) { sc[sl][c] = __expf(sc[sl][c] - mx); sum += sc[sl][c]; }
            sum = wave_sum(sum);
            const float inv = 1.0f / sum;
#pragma unroll
            for (int sl = 0; sl < 4; ++sl)
#pragma unroll
                for (int c = 0; c < 4; ++c) ps[sl * 256 + lane + 64 * c] = sc[sl][c] * inv;
            LDS_WAIT(); asm volatile("" ::: "memory");
            float o0 = 0.f, o1 = 0.f;
#pragma unroll
            for (int sl = 0; sl < 3; ++sl) {
                if (jsel[sl] >= 0) { const bf16* vb = Vb + (size_t)(256 * jsel[sl]) * HD + 2 * lane;
                    for (int i = 0; i < 256; ++i) { const float p = ps[sl * 256 + i]; const unsigned w = *(const unsigned*)(vb + (size_t)i * HD); o0 += p * bflo(w); o1 += p * bfhi(w); } }
            }
            { const bf16* vb = Vb + (size_t)(256 * qb) * HD + 2 * lane;
              for (int i = 0; i <= tin; ++i) { const float p = ps[3 * 256 + i]; const unsigned w = *(const unsigned*)(vb + (size_t)i * HD); o0 += p * bflo(w); o1 += p * bfhi(w); } }
            *(unsigned*)(O + (size_t)(b * NS + t) * DM + h * HD + 2 * lane) = pk2(o0, o1);
            LDS_WAIT(); asm volatile("" ::: "memory");
        } else {
            const int td = task - NMOBA, b = td / (8 * NS), rem = td - b * (8 * NS), hh = rem >> 12, t = rem & 4095;
            float lse[3], og0[3], og1[3];
#pragma unroll
            for (int g = 0; g < 3; ++g) {
                const int head = NHA + g * 8 + hh, dil = g == 0 ? 1 : (g == 1 ? 4 : 16);
                const bf16* qrow = QKV + ((size_t)((0 * 2 + b) * NHQ + head) * NS + t) * HD;
                const bf16* Kb = QKV + (size_t)((1 * 2 + b) * NHQ + head) * NS * HD;
                const bf16* Vb = QKV + (size_t)((2 * 2 + b) * NHQ + head) * NS * HD;
                { const unsigned w = *(const unsigned*)(qrow + 2 * lane); qs[2 * lane] = bflo(w); qs[2 * lane + 1] = bfhi(w); }
                LDS_WAIT(); asm volatile("" ::: "memory");
                float sc[3];
#pragma unroll
                for (int c = 0; c < 3; ++c) { const int m = lane + 64 * c; const int kp = t - m * dil; sc[c] = (m <= 128 && kp >= 0) ? ATT_SCALE * dot128(qs, Kb + (size_t)kp * HD) : NEG; }
                float mx = wave_max(fmaxf(fmaxf(sc[0], sc[1]), sc[2]));
                float e0 = __expf(sc[0] - mx), e1 = __expf(sc[1] - mx), e2 = __expf(sc[2] - mx);
                const float sum = wave_sum(e0 + e1 + e2), inv = 1.0f / sum;
                lse[g] = mx + __logf(sum);
                ps[lane] = e0 * inv; ps[lane + 64] = e1 * inv; if (lane == 0) ps[128] = e2 * inv;
                LDS_WAIT(); asm volatile("" ::: "memory");
                const int nb = t / dil, nk = (nb < 128 ? nb : 128) + 1;
                float o0 = 0.f, o1 = 0.f;
                for (int m = 0; m < nk; ++m) { const float p = ps[m]; const unsigned w = *(const unsigned*)(Vb + (size_t)(t - m * dil) * HD + 2 * lane); o0 += p * bflo(w); o1 += p * bfhi(w); }
                og0[g] = o0; og1[g] = o1;
                LDS_WAIT(); asm volatile("" ::: "memory");
            }
            const float ml = fmaxf(fmaxf(lse[0], lse[1]), lse[2]);
            const float w0 = __expf(lse[0] - ml), w1 = __expf(lse[1] - ml), w2 = __expf(lse[2] - ml), wi = 1.0f / (w0 + w1 + w2);
            const float r0 = (w0 * og0[0] + w1 * og0[1] + w2 * og0[2]) * wi, r1 = (w0 * og1[0] + w1 * og1[1] + w2 * og1[2]) * wi;
            *(unsigned*)(O + (size_t)(b * NS + t) * DM + (NHA + hh) * HD + 2 * lane) = pk2(r0, r1);
        }
    }
}

__device__ __forceinline__ float silu_f(float x) { return x / (1.0f + __expf(-x)); }
__device__ __forceinline__ void unpack8(const v4u w, float (&f)[8]) { f[0] = bflo(w.x); f[1] = bfhi(w.x); f[2] = bflo(w.y); f[3] = bfhi(w.y); f[4] = bflo(w.z); f[5] = bfhi(w.z); f[6] = bflo(w.w); f[7] = bfhi(w.w); }
__device__ __forceinline__ void p_conv(Frame& F, int layer) {
    const bf16* AP = (const bf16*)(F.ws + WS_APRE); bf16* Gb = (bf16*)(F.ws + WS_G);
    const float* cw = F.ffn_conv_w + (size_t)layer * 3 * F2; const float* cb = F.ffn_conv_b + (size_t)layer * F2;
    constexpr int C8 = DFF / 8;
    const size_t total = (size_t)MR * C8;
    for (size_t idx = (size_t)blockIdx.x * 512 + F.tid; idx < total; idx += (size_t)F.G * 512) {
        const int r = (int)(idx / C8), j0 = (int)(idx - (size_t)r * C8) * 8, s = r & 4095;
        float cg[8], cu[8];
#pragma unroll
        for (int e = 0; e < 8; ++e) { cg[e] = cb[j0 + e]; cu[e] = cb[DFF + j0 + e]; }
#pragma unroll
        for (int tp = 0; tp < 3; ++tp) {
            const int back = 2 - tp;
            if (s >= back) {
                float ag[8], au[8];
                unpack8(*(const v4u*)(AP + (size_t)(r - back) * F2 + j0), ag);
                unpack8(*(const v4u*)(AP + (size_t)(r - back) * F2 + DFF + j0), au);
#pragma unroll
                for (int e = 0; e < 8; ++e) { cg[e] += cw[(size_t)tp * F2 + j0 + e] * ag[e]; cu[e] += cw[(size_t)tp * F2 + DFF + j0 + e] * au[e]; }
            }
        }
        v4u o; o.x = pk2(silu_f(cg[0]) * cu[0], silu_f(cg[1]) * cu[1]); o.y = pk2(silu_f(cg[2]) * cu[2], silu_f(cg[3]) * cu[3]);
        o.z = pk2(silu_f(cg[4]) * cu[4], silu_f(cg[5]) * cu[5]); o.w = pk2(silu_f(cg[6]) * cu[6], silu_f(cg[7]) * cu[7]);
        *(v4u*)(Gb + (size_t)r * DFF + j0) = o;
    }
}

__device__ __forceinline__ void p_sgate_naive(Frame& F) {
    const bf16* U = (const bf16*)(F.ws + WS_U); const bf16* V = (const bf16*)(F.ws + WS_V); const float* VS = (const float*)(F.ws + WS_VSQ); bf16* GT = (bf16*)(F.ws + WS_O);
    LAS float* vn = (LAS float*)(F.lds + RING_OFF);
    LAS float* wsl = vn + 128 * 128;
    LAS float* rstat = (LAS float*)(F.lds + XTRA_OFF);
    for (int item = blockIdx.x; item < 64 * 32; item += F.G) {
        const int bc = item >> 5, g = item & 31, r0 = bc * 128;
        if (F.tid < 128) {
            const float s1 = VS[2 * (r0 + F.tid)], s2 = VS[2 * (r0 + F.tid) + 1];
            const float mean = s1 * (1.0f / 4096.0f), var = s2 * (1.0f / 4096.0f) - mean * mean;
            rstat[2 * F.tid] = mean; rstat[2 * F.tid + 1] = 1.0f / sqrtf(var + NORM_EPS);
        }
        __syncthreads();
        for (int idx = F.tid; idx < 128 * 128; idx += 512) {
            const int s = idx >> 7, d = idx & 127, col = g * 128 + d;
            const float v = bf1(V[(size_t)(r0 + s) * DM + col]);
            vn[idx] = (v - rstat[2 * s]) * rstat[2 * s + 1] * F.sg_v_gain[col] + F.sg_v_bias[col];
            wsl[idx] = F.sg_w_s[(size_t)g * 16384 + idx];
        }
        __syncthreads();
        for (int idx = F.tid; idx < 128 * 128; idx += 512) {
            const int t = idx >> 7, d = idx & 127;
            float a = 0.f;
            for (int s = 0; s <= t; ++s) a += wsl[t * 128 + s] * vn[s * 128 + d];
            const float f = a + F.sg_b_s[g * 128 + t];
            const size_t o = (size_t)(r0 + t) * DM + g * 128 + d;
            GT[o] = (bf16)f2bf(bf1(U[o]) * f);
        }
        __syncthreads();
    }
}

__device__ __forceinline__ void p_final(Frame& F) {
    const float* H = (const float*)(F.ws + WS_H); const float* SS4 = (const float*)(F.ws + WS_SSQ + 4 * SSQ_SITE);
#ifdef CHECK_ATTN
    const unsigned nbad = __hip_atomic_load(F.ctl + 8, __ATOMIC_RELAXED, __HIP_MEMORY_SCOPE_AGENT);
#endif
    for (int m = F.gw; m < MR; m += F.NGW) {
        float rs = ss_rstd(SS4, m);
#ifdef CHECK_ATTN
        if (nbad > CHECK_ATTN) rs = __builtin_nanf("");
#endif
        const f32x4* hr = (const f32x4*)(H + (size_t)m * DM) + F.lane; const f32x4* gr = (const f32x4*)F.final_norm + F.lane;
        f32x4* orow = (f32x4*)(F.out + (size_t)m * DM) + F.lane;
#pragma unroll 4
        for (int j = 0; j < 16; ++j) orow[64 * j] = hr[64 * j] * rs * gr[64 * j];
    }
}
__device__ __forceinline__ void p_gate(Frame& F) {
    const bf16* QKV = (const bf16*)(F.ws + WS_QKV); const float* KM = (const float*)(F.ws + WS_KMEAN); unsigned short* SEL = (unsigned short*)(F.ws + WS_SEL);
    LAS float* km = (LAS float*)(F.lds + RING_OFF);
    const float NEG = -__builtin_inff();
    for (int item = blockIdx.x; item < NB * NHA * 8; item += F.G) {
        const int bh = item >> 3, ch = item & 7, b = bh / NHA, h = bh - b * NHA;
        for (int i = F.tid; i < 2048; i += 512) km[i] = KM[(size_t)bh * 2048 + i];
        __syncthreads();
        const int t = ch * 512 + F.tid, qb = t >> 8;
        unsigned sel;
        if (qb <= 3) sel = (1u << qb) - 1u;
        else {
            const bf16* qrow = QKV + ((size_t)((0 * 2 + b) * NHQ + h) * NS + t) * HD;
            float g[16];
#pragma unroll
            for (int j = 0; j < 16; ++j) g[j] = 0.f;
            for (int c = 0; c < 16; ++c) {
                float q8[8]; unpack8(*(const v4u*)(qrow + 8 * c), q8);
#pragma unroll
                for (int j = 0; j < 16; ++j) {
                    const f32x4 k0 = *(const LAS f32x4*)(km + j * 128 + 8 * c), k1 = *(const LAS f32x4*)(km + j * 128 + 8 * c + 4);
                    g[j] += q8[0] * k0[0] + q8[1] * k0[1] + q8[2] * k0[2] + q8[3] * k0[3] + q8[4] * k1[0] + q8[5] * k1[1] + q8[6] * k1[2] + q8[7] * k1[3];
                }
            }
#pragma unroll
            for (int j = 0; j < 16; ++j) if (j >= qb) g[j] = NEG;
            sel = 0u;
#pragma unroll
            for (int rd = 0; rd < 3; ++rd) {
                float best = NEG; unsigned bi = 0u;
#pragma unroll
                for (int j = 0; j < 16; ++j) { const bool take = (((sel >> j) & 1u) == 0u) && (g[j] > best); best = take ? g[j] : best; bi = take ? (unsigned)j : bi; }
                sel |= 1u << bi;
            }
        }
        SEL[(size_t)bh * NS + t] = (unsigned short)sel;
        __syncthreads();
    }
}

typedef att::BlockRef<bf16, bf16> ABR;
#ifndef DIL_SK
#define DIL_SK false
#endif
__device__ __forceinline__ ABR moba_ref(const Frame& F, int vc, int i) {
    const int grp = vc >> 4, a = vc & 15;
    const unsigned long long PB = 0x24310cbfed5a9687ull, PC = 0x6579b13024c8aedfull;
    const int qb = i == 0 ? a : (i == 1 ? (int)((PB >> (4 * a)) & 15ull) : (int)((PC >> (4 * a)) & 15ull));
    const int bh = 3 * grp + i, b = bh / NHA, h = bh - NHA * b;
    const bf16* QKV = (const bf16*)(F.ws + WS_QKV);
    ABR r;
    r.Q = QKV + ((size_t)((0 * 2 + b) * NHQ + h) * NS + 256 * qb) * HD;
    r.K = QKV + (size_t)((1 * 2 + b) * NHQ + h) * NS * HD;
    r.V = QKV + (size_t)((2 * 2 + b) * NHQ + h) * NS * HD;
    r.O = (bf16*)(F.ws + WS_O) + (size_t)(b * NS + 256 * qb) * DM + h * HD;
    r.P0 = 256 * qb;
    r.sel = (const unsigned short*)(F.ws + WS_SEL) + (size_t)bh * NS + 256 * qb; r.L = nullptr;
    return r;
}
__device__ __forceinline__ ABR dil_ref(const Frame& F, int vc, int g) {
    const int bhh = vc >> 4, b = bhh >> 3, hh = bhh & 7, lo = vc & 15;
    const int dil = g == 0 ? 1 : (g == 1 ? 4 : 16);
    const int res = g == 0 ? 0 : (g == 1 ? (lo >> 2) : lo), blk = g == 0 ? lo : (g == 1 ? (lo & 3) : 0);
    const int head = NHA + 8 * g + hh, pos0 = res + dil * 256 * blk;
    const bf16* QKV = (const bf16*)(F.ws + WS_QKV);
    ABR r;
    r.Q = QKV + ((size_t)((0 * 2 + b) * NHQ + head) * NS + pos0) * HD;
    r.K = QKV + ((size_t)((1 * 2 + b) * NHQ + head) * NS + res) * HD;
    r.V = QKV + ((size_t)((2 * 2 + b) * NHQ + head) * NS + res) * HD;
    r.O = (bf16*)(F.ws + WS_DO) + (size_t)(b * NS + pos0) * 3072 + g * 1024 + hh * HD;
    r.P0 = 256 * blk;
    r.sel = nullptr; r.L = (float*)(F.ws + WS_LSE) + (size_t)(b * NS + pos0) * 24 + g * 8 + hh;
    return r;
}
__device__ __forceinline__ void p_attn(Frame& F, char* lds) {
    for (int vc = blockIdx.x; vc < 256; vc += F.G) {
#ifndef NO_MOBA
        {
            att::Seam<bf16> S;
            constexpr int WM = 1 << 30;
            ABR cur = moba_ref(F, vc, 0);
            att::causal_swa_prime<bf16, bf16, 128, WM>(cur, lds, S);
            for (int i = 0; i < 3; ++i) {
                const ABR nxt = moba_ref(F, vc, i < 2 ? i + 1 : 2);
                att::causal_swa_block<bf16, bf16, false, 0, 128, 128, DM, WM, WM, NS>(cur, nxt, lds, S);
                cur = nxt;
            }
        }
#endif
    }
    for (int vc = blockIdx.x; vc < 256; vc += F.G) {
#ifndef NO_DIL
        {
            att::Seam<bf16> S;
            const ABR r0 = dil_ref(F, vc, 0), r1 = dil_ref(F, vc, 1), r2 = dil_ref(F, vc, 2);
            att::causal_swa_prime<bf16, bf16, 128, 129>(r0, lds, S);
            att::causal_swa_block<bf16, bf16, DIL_SK, 1, 128, 512, 3072, 129, 129, NS>(r0, r1, lds, S);
            att::causal_swa_block<bf16, bf16, DIL_SK, 1, 512, 2048, 4 * 3072, 129, 129, NS / 4>(r1, r2, lds, S);
            att::causal_swa_block<bf16, bf16, DIL_SK, 1, 2048, 2048, 16 * 3072, 129, 129, NS / 16>(r2, r2, lds, S);
        }
#endif
    }
}
__device__ __forceinline__ void p_dilmerge(Frame& F) {
    const bf16* DO = (const bf16*)(F.ws + WS_DO); const float* LSE = (const float*)(F.ws + WS_LSE); bf16* O = (bf16*)(F.ws + WS_O);
    const size_t total = (size_t)MR * 8 * 16;
    for (size_t idx = (size_t)blockIdx.x * 512 + F.tid; idx < total; idx += (size_t)F.G * 512) {
        const int r = (int)(idx >> 7), hh = (int)(idx >> 4) & 7, c8 = (int)idx & 15;
        const float l0 = LSE[(size_t)r * 24 + hh], l1 = LSE[(size_t)r * 24 + 8 + hh], l2 = LSE[(size_t)r * 24 + 16 + hh];
        const float ml = fmaxf(fmaxf(l0, l1), l2);
        float w0 = __expf(l0 - ml), w1 = __expf(l1 - ml), w2 = __expf(l2 - ml); const float wi = 1.0f / (w0 + w1 + w2); w0 *= wi; w1 *= wi; w2 *= wi;
        float a0[8], a1[8], a2[8];
        unpack8(*(const v4u*)(DO + (size_t)r * 3072 + hh * HD + c8 * 8), a0);
        unpack8(*(const v4u*)(DO + (size_t)r * 3072 + 1024 + hh * HD + c8 * 8), a1);
        unpack8(*(const v4u*)(DO + (size_t)r * 3072 + 2048 + hh * HD + c8 * 8), a2);
        float o[8];
#pragma unroll
        for (int e = 0; e < 8; ++e) o[e] = w0 * a0[e] + w1 * a1[e] + w2 * a2[e];
        v4u w; w.x = pk2(o[0], o[1]); w.y = pk2(o[2], o[3]); w.z = pk2(o[4], o[5]); w.w = pk2(o[6], o[7]);
        *(v4u*)(O + (size_t)r * DM + (NHA + hh) * HD + c8 * 8) = w;
    }
}
__device__ __forceinline__ void p_convfix(Frame& F, int layer) {
    const float* top = (const float*)(F.ws + WS_TOP); const float* bot = (const float*)(F.ws + WS_BOT); bf16* Gb = (bf16*)(F.ws + WS_G);
    const float* cw = F.ffn_conv_w + (size_t)layer * 3 * F2; const float* cb = F.ffn_conv_b + (size_t)layer * F2;
    constexpr int C4 = DFF / 4, NIT = 30 * C4;
    for (int idx = blockIdx.x * 512 + F.tid; idx < NIT; idx += F.G * 512) {
        const int pmi = idx / C4, j0 = (idx - pmi * C4) * 4, pm = pmi + 1 + (pmi >= 15 ? 1 : 0);
        f32x4 c0[2], c1[2];
#pragma unroll
        for (int bj = 0; bj < 2; ++bj) {
            const int col = bj * DFF + j0;
            const f32x4 w0 = *(const f32x4*)(cw + col), w1 = *(const f32x4*)(cw + F2 + col), w2 = *(const f32x4*)(cw + 2 * F2 + col), bb = *(const f32x4*)(cb + col);
            const f32x4 am2 = *(const f32x4*)(bot + (size_t)((pm - 1) * 2 + 0) * F2 + col), am1 = *(const f32x4*)(bot + (size_t)((pm - 1) * 2 + 1) * F2 + col);
            const f32x4 a0 = *(const f32x4*)(top + (size_t)(pm * 2 + 0) * F2 + col), a1 = *(const f32x4*)(top + (size_t)(pm * 2 + 1) * F2 + col);
            c0[bj] = bb + w0 * am2 + w1 * am1 + w2 * a0;
            c1[bj] = bb + w0 * am1 + w1 * a0 + w2 * a1;
        }
        v2u o0, o1;
        o0.x = pk2(silu_f(c0[0][0]) * c0[1][0], silu_f(c0[0][1]) * c0[1][1]); o0.y = pk2(silu_f(c0[0][2]) * c0[1][2], silu_f(c0[0][3]) * c0[1][3]);
        o1.x = pk2(silu_f(c1[0][0]) * c1[1][0], silu_f(c1[0][1]) * c1[1][1]); o1.y = pk2(silu_f(c1[0][2]) * c1[1][2], silu_f(c1[0][3]) * c1[1][3]);
        *(v2u*)(Gb + (size_t)(pm * 256) * DFF + j0) = o0;
        *(v2u*)(Gb + (size_t)(pm * 256 + 1) * DFF + j0) = o1;
    }
}
constexpr int N_PHASES = 17;
struct Args { const void* in[19]; float* out; unsigned char* ws; int ph_lo, ph_hi, li, pad; };
__global__ void __launch_bounds__(NWAVES * 64, 2) mk_fwd(Args args) {
    extern __shared__ __attribute__((aligned(16))) unsigned char lds[];
    Frame F;
    F.lds = (LAS unsigned char*)lds;
    F.MISC = (volatile LAS unsigned*)(F.lds + MISC_OFF);
    F.tid = threadIdx.x; F.lane = F.tid & 63; F.wave = __builtin_amdgcn_readfirstlane(F.tid >> 6);
    F.G = gridDim.x; F.gw = blockIdx.x * NWAVES + F.wave; F.NGW = F.G * NWAVES;
    F.ws = args.ws; F.ctl = (unsigned*)(args.ws + WS_CTL);
    F.x = (const float*)args.in[0]; F.pos = (const int*)args.in[1];
    F.attn_norm = (const float*)args.in[2]; F.attn_w_in = (const float*)args.in[3]; F.attn_w_out = (const float*)args.in[4];
    F.sg_norm = (const float*)args.in[5]; F.sg_w_in = (const float*)args.in[6]; F.sg_b_in = (const float*)args.in[7]; F.sg_v_gain = (const float*)args.in[8]; F.sg_v_bias = (const float*)args.in[9];
    F.sg_w_s = (const float*)args.in[10]; F.sg_b_s = (const float*)args.in[11]; F.sg_w_out = (const float*)args.in[12];
    F.ffn_norm = (const float*)args.in[13]; F.ffn_w_up = (const float*)args.in[14]; F.ffn_conv_w = (const float*)args.in[15]; F.ffn_conv_b = (const float*)args.in[16]; F.ffn_w_down = (const float*)args.in[17];
    F.final_norm = (const float*)args.in[18]; F.out = args.out;
    for (int u = F.tid; u < (XTRA_OFF - LDSCTL_OFF) / 4; u += NWAVES * 64) ((LAS unsigned*)(F.lds + LDSCTL_OFF))[u] = 0u;
    __syncthreads();
    const int lo = args.ph_lo, hi = args.ph_hi;
    XcdBarrier bar; bar.bar = F.ctl + CW_BAR + args.li * XCD_BAR_WORDS; bar.x = 0; bar.st = nullptr;
    if (hi - lo > 1) bar = xcd_barrier_post(F.ctl + CW_BAR + args.li * XCD_BAR_WORDS, F.MISC + 8);
#define IN(k) (lo <= (k) && (k) < hi)
#define SEAM(k) do { if (IN(k) && IN((k) + 1)) xcd_barrier(bar); } while (0)
    unsigned char* ws = args.ws;
    bf16* XB = (bf16*)(ws + WS_XB); float* H = (float*)(ws + WS_H); bf16* O = (bf16*)(ws + WS_O); bf16* Gb = (bf16*)(ws + WS_G); bf16* AP = (bf16*)(ws + WS_APRE);
    float* SS = (float*)(ws + WS_SSQ); constexpr size_t SSF = SSQ_SITE / 4;
    const int c = (int)blockIdx.x;

    if (IN(0)) { p0_prologue(F); } SEAM(0);
    if (IN(1)) {
        pg8::Gemm g{XB, (const bf16*)(ws + WS_WIN), MR, QKVC, DM}; pg8::StaticOrder S; S.init(MR, QKVC, F.G, c);
        pg8::EpiQKV E{(bf16*)(ws + WS_QKV), SS, (const float*)(ws + WS_ROPE), (const float*)(ws + WS_ROPE) + MR * 16};
        pg8::gemm_phase<pg8::EpiQKV, pg8::StaticOrder, PG8_ALIGN, PG8_SP2>(F.lds + RING_OFF, g, S, E);
    } SEAM(1);
    if (IN(2)) { p_kmean(F); } SEAM(2);
    if (IN(3)) { p_gate(F); } SEAM(3);
    if (IN(4)) { p_attn(F, (char*)lds + RING_OFF); } SEAM(4);
    if (IN(5)) { p_dilmerge(F);
#ifdef CHECK_ATTN
        xcd_barrier(bar); p_attn_naive(F, AP); xcd_barrier(bar);
        { unsigned bad = 0; for (size_t idx = (size_t)blockIdx.x * 512 + F.tid; idx < (size_t)MR * DM; idx += (size_t)F.G * 512) { const float a = bf1(O[idx]), b = bf1(AP[idx]); if (!(fabsf(a - b) <= 0.004f + 0.03f * fabsf(b))) ++bad; }
          if (bad) atomicAdd(F.ctl + 8, bad); }
#endif
    } SEAM(5);
    if (IN(6)) {
        pg8::Gemm g{O, (const bf16*)(ws + WS_WOUT), MR, DM, DM}; pg8::StaticOrder S; S.init(MR, DM, F.G, c);
        pg8::EpiRes E{F.x, H, XB, SS + 1 * SSF};
        pg8::gemm_phase<pg8::EpiRes, pg8::StaticOrder, PG8_ALIGN, PG8_SP2>(F.lds + RING_OFF, g, S, E);
    } SEAM(6);
    if (IN(7)) {
        pg8::Gemm g{XB, (const bf16*)(ws + WS_WUP), MR, F2, DM}; pg8::StaticOrder S; S.init(MR, F2, F.G, c);
        pg8::EpiUpConv E{Gb, SS + 1 * SSF, F.ffn_conv_w, F.ffn_conv_b, (float*)(ws + WS_TOP), (float*)(ws + WS_BOT), (LAS float*)(F.lds + XTRA_OFF)};
        pg8::gemm_phase<pg8::EpiUpConv, pg8::StaticOrder, true, PG8_SP2>(F.lds + RING_OFF, g, S, E);
    } SEAM(7);
    if (IN(8)) { p_convfix(F, 0); } SEAM(8);
    if (IN(9)) {
        pg8::Gemm g{Gb, (const bf16*)(ws + WS_WDOWN), MR, DM, DFF}; pg8::StaticOrder S; S.init(MR, DM, F.G, c);
        pg8::EpiRes E{H, H, XB, SS + 2 * SSF};
        pg8::gemm_phase<pg8::EpiRes, pg8::StaticOrder, PG8_ALIGN, PG8_SP2>(F.lds + RING_OFF, g, S, E);
    } SEAM(9);
    if (IN(10)) {
        pg8::Gemm g{XB, (const bf16*)(ws + WS_SGWIN), MR, 2 * DM, DM}; pg8::StaticOrder S; S.init(MR, 2 * DM, F.G, c);
        pg8::EpiSgIn E{(bf16*)(ws + WS_U), (bf16*)(ws + WS_V), SS + 2 * SSF, F.sg_b_in, (float*)(ws + WS_VSQ)};
        pg8::gemm_phase<pg8::EpiSgIn, pg8::StaticOrder, PG8_ALIGN, PG8_SP2>(F.lds + RING_OFF, g, S, E);
    } SEAM(10);
    if (IN(11)) { p_sgate_naive(F); } SEAM(11);
    if (IN(12)) {
        pg8::Gemm g{O, (const bf16*)(ws + WS_SGWOUT), MR, DM, DM}; pg8::StaticOrder S; S.init(MR, DM, F.G, c);
        pg8::EpiRes E{H, H, XB, SS + 3 * SSF};
        pg8::gemm_phase<pg8::EpiRes, pg8::StaticOrder, PG8_ALIGN, PG8_SP2>(F.lds + RING_OFF, g, S, E);
    } SEAM(12);
    if (IN(13)) {
        pg8::Gemm g{XB, (const bf16*)(ws + WS_WUP + WUP_L), MR, F2, DM}; pg8::StaticOrder S; S.init(MR, F2, F.G, c);
        pg8::EpiUpConv E{Gb, SS + 3 * SSF, F.ffn_conv_w + 3 * F2, F.ffn_conv_b + F2, (float*)(ws + WS_TOP), (float*)(ws + WS_BOT), (LAS float*)(F.lds + XTRA_OFF)};
        pg8::gemm_phase<pg8::EpiUpConv, pg8::StaticOrder, true, PG8_SP2>(F.lds + RING_OFF, g, S, E);
    } SEAM(13);
    if (IN(14)) { p_convfix(F, 1); } SEAM(14);
    if (IN(15)) {
        pg8::Gemm g{Gb, (const bf16*)(ws + WS_WDOWN + WDOWN_L), MR, DM, DFF}; pg8::StaticOrder S; S.init(MR, DM, F.G, c);
        pg8::EpiRes E{H, H, XB, SS + 4 * SSF};
        pg8::gemm_phase<pg8::EpiRes, pg8::StaticOrder, PG8_ALIGN, PG8_SP2>(F.lds + RING_OFF, g, S, E);
    } SEAM(15);
    if (IN(16)) { p_final(F); }
#undef IN
#undef SEAM
}

extern "C" void kernel_launch(void* const* d_in, const int* in_sizes, int n_in, void* d_out, int out_size, void* d_ws, size_t ws_size, hipStream_t stream) {
    static int grid = 0;
    if (grid == 0) {
        if (n_in != 19 || out_size != MR * DM || ws_size < WS_END) { fprintf(stderr, "kernel_launch: unexpected shapes (n_in %d, out %d, ws %zu); nothing launched\n", n_in, out_size, ws_size); grid = -1; return; }
        int dev = 0, cus = 0, per_cu = 0;
        if (hipGetDevice(&dev) != hipSuccess || hipDeviceGetAttribute(&cus, hipDeviceAttributeMultiprocessorCount, dev) != hipSuccess) { grid = -1; return; }
        if (hipFuncSetAttribute((const void*)mk_fwd, hipFuncAttributeMaxDynamicSharedMemorySize, LDS_BYTES) != hipSuccess) { fprintf(stderr, "kernel_launch: hipFuncSetAttribute failed\n"); grid = -1; return; }
        if (hipOccupancyMaxActiveBlocksPerMultiprocessor(&per_cu, (const void*)mk_fwd, NWAVES * 64, LDS_BYTES) != hipSuccess || per_cu < 1) fprintf(stderr, "kernel_launch: occupancy query reports %d\n", per_cu);
        (void)hipGetLastError();
        grid = cus;
    }
    if (grid < 0) return;
    if (hipMemsetAsync((char*)d_ws + WS_CTL, 0, CTL_ZERO_BYTES, stream) != hipSuccess) return;
    Args a{};
    for (int i = 0; i < 19; ++i) a.in[i] = d_in[i];
    a.out = (float*)d_out; a.ws = (unsigned char*)d_ws; a.pad = 0;
    if (MK_N_LAUNCHES == 1) {
        a.ph_lo = 0; a.ph_hi = N_PHASES; a.li = 0;
        hipLaunchKernelGGL(mk_fwd, dim3(grid), dim3(NWAVES * 64), LDS_BYTES, stream, a);
    } else {
        for (int p = 0; p < N_PHASES; ++p) { a.ph_lo = p; a.ph_hi = p + 1; a.li = 0; hipLaunchKernelGGL(mk_fwd, dim3(grid), dim3(NWAVES * 64), LDS_BYTES, stream, a); }
    }
}
```

```cpp
#include <hip/hip_runtime.h>
#include <cstdio>
#include <cstdint>
#ifndef MK_N_LAUNCHES
#define MK_N_LAUNCHES 1
#endif
namespace pg8 {
#define PG8_LAS __attribute__((address_space(3)))
typedef unsigned short bf16_t;
typedef short bf16x8 __attribute__((ext_vector_type(8)));
typedef float f32x4 __attribute__((ext_vector_type(4)));
typedef unsigned u32x4 __attribute__((ext_vector_type(4)));
constexpr int BM = 256, BK = 64, HALF = 128, HTB = HALF * BK * 2  , STAGE_BYTES = 8 * HTB, NXCD = 8, WGM = 8;

__host__ __device__ __forceinline__ int lds_byte(int r, int c) { const int st = (r >> 4) * 2 + (c >> 5), rr = r & 15, cc = c & 31, ob = rr * 64 + cc * 2; return st * 1024 + (ob ^ (((ob >> 9) & 1) << 5)); }
__host__ __device__ __forceinline__ void stage_rc(int b, int& R, int& C) { const int st = b / 1024, sb = b % 1024, swz = sb ^ (((sb >> 9) & 1) << 5); R = (st >> 1) * 16 + swz / 64; C = (st & 1) * 32 + (swz % 64) / 2; }
__host__ __device__ __forceinline__ int perm32(int rho) { const int n = rho >> 4, i = rho & 15; return 8 * (i >> 2) + 4 * n + (i & 3); }

struct Unit { int pm, pn; };
struct Gemm { const bf16_t* A; const bf16_t* Bt; int M, N, K; };

struct StaticOrder {
    int nM, nN, nwg, G, c;
    __host__ __device__ void init(int M, int N, int G_, int c_) { nM = M / BM; nN = N / BM; nwg = nM * nN; G = G_; c = c_; }
    __host__ __device__ bool next(int i, Unit& u) const {
        const long L = (long)i * G + c; if (L >= nwg) return false;
        int wgid = (int)L; { const int q = nwg / NXCD, r = nwg % NXCD, xcd = wgid % NXCD, off = wgid / NXCD; wgid = (xcd < r ? xcd * (q + 1) : r * (q + 1) + (xcd - r) * q) + off; }
        const int nig = WGM * nN, gid = wgid / nig, fm = gid * WGM, gsz = (nM - fm) < WGM ? (nM - fm) : WGM;
        u.pm = fm + ((wgid % nig) % gsz); u.pn = (wgid % nig) / gsz; return true;
    }
    __device__ __forceinline__ void a_ready(const Unit&) const {}
    __device__ __forceinline__ void done(const Unit&) const {}
};
__device__ __forceinline__ unsigned cvt_pk_bf16(float lo, float hi) { unsigned r; asm volatile("v_cvt_pk_bf16_f32 %0, %1, %2" : "=v"(r) : "v"(lo), "v"(hi)); return r; }
typedef float f32x2 __attribute__((ext_vector_type(2)));
__device__ __forceinline__ f32x2 gelu_pk(f32x2 v) {
    const f32x2 av = __builtin_elementwise_abs(v), d = av * 0.2316418882f + 1.0f;
    f32x2 t; t.x = __builtin_amdgcn_rcpf(d.x); t.y = __builtin_amdgcn_rcpf(d.y);
    f32x2 q = t * 0.5307027145f + (-0.7265760135f); q = q * t + 0.7107068705f; q = q * t + (-0.142248368f); q = q * t + 0.127414796f; q = q * t;
    const f32x2 s = (v * v) * (-0.72134752044f);
    f32x2 e; e.x = __builtin_amdgcn_exp2f(s.x); e.y = __builtin_amdgcn_exp2f(s.y);
    const f32x2 m = v * (q * e), r = v - m;
    f32x2 o; o.x = v.x < 0.f ? m.x : r.x; o.y = v.y < 0.f ? m.y : r.y; return o;
}
typedef unsigned u32x2 __attribute__((ext_vector_type(2)));
__device__ __forceinline__ float rstd_from_ss(const float* ss, int r) { return 1.0f / sqrtf(ss[r] * (1.0f / 4096.0f) + 1e-5f); }

struct EpiQKV {
    static constexpr bool PERM = false, AFTER_DRAIN = false;
    bf16_t* qkv; const float* ss; const float* ropec; const float* ropes; float* km;
    __device__ __forceinline__ void operator()(const f32x4 (&acc)[2][2][4][2], const Unit& u, int wr, int wc, int fr, int fq) const {
        const int row0 = u.pm * BM + wr * 64 + fr;
        const bool kmu = u.pn >= 24 && u.pn < 36;
        f32x4 cs[2][2];
#pragma unroll
        for (int bj = 0; bj < 2; ++bj)
#pragma unroll
            for (int n = 0; n < 2; ++n) cs[bj][n] = (f32x4){0.f, 0.f, 0.f, 0.f};
#pragma unroll
        for (int ai = 0; ai < 2; ++ai)
#pragma unroll
            for (int m = 0; m < 4; ++m) {
                const int r = row0 + ai * HALF + m * 16;
                const float rs = rstd_from_ss(ss, r);
                const int b = r >> 12, s = r & 4095;
                f32x4 cz = (f32x4){1.f, 1.f, 1.f, 1.f}, sn = (f32x4){0.f, 0.f, 0.f, 0.f};
                if (wc == 0) { cz = *(const f32x4*)(ropec + (size_t)r * 16 + 4 * fq); sn = *(const f32x4*)(ropes + (size_t)r * 16 + 4 * fq); }
#pragma unroll
                for (int bj = 0; bj < 2; ++bj) {
                    const int colh = 2 * u.pn + bj, which = colh / 48, head = colh - which * 48;
                    bf16_t* dst = qkv + ((size_t)((which * 2 + b) * 48 + head) * 4096 + s) * 128 + wc * 32 + 4 * fq;
                    f32x4 v0 = acc[ai][bj][m][0] * rs, v1 = acc[ai][bj][m][1] * rs;
                    if (which < 2 && wc == 0) { const f32x4 n0 = v0 * cz - v1 * sn, n1 = v1 * cz + v0 * sn; v0 = n0; v1 = n1; }
                    if (kmu) { cs[bj][0] += v0; cs[bj][1] += v1; }
                    u32x2 w0, w1; w0.x = cvt_pk_bf16(v0[0], v0[1]); w0.y = cvt_pk_bf16(v0[2], v0[3]); w1.x = cvt_pk_bf16(v1[0], v1[1]); w1.y = cvt_pk_bf16(v1[2], v1[3]);
                    *(u32x2*)(dst) = w0; *(u32x2*)(dst + 16) = w1;
                }
                asm volatile("" ::: "memory");
            }
        if (kmu) {
            const int b = u.pm >> 4, blk = u.pm & 15;
#pragma unroll
            for (int bj = 0; bj < 2; ++bj) {
                const int head = 2 * u.pn + bj - 48;
                float* dst = km + ((size_t)((b * 24 + head) * 16 + blk)) * 128 + wc * 32 + 4 * fq;
#pragma unroll
                for (int n = 0; n < 2; ++n)
#pragma unroll
                    for (int j = 0; j < 4; ++j) {
                        float v = cs[bj][n][j];
                        v += __shfl_xor(v, 1); v += __shfl_xor(v, 2); v += __shfl_xor(v, 4); v += __shfl_xor(v, 8);
                        if (fr == 0) atomicAdd(dst + 16 * n + j, v * (1.0f / 256.0f));
                    }
            }
        }
    }
};

struct EpiRes {
    static constexpr bool PERM = false, AFTER_DRAIN = false;
    const float* hin; float* hout; bf16_t* xb; float* ss;
    __device__ __forceinline__ void operator()(const f32x4 (&acc)[2][2][4][2], const Unit& u, int wr, int wc, int fr, int fq) const {
        const int row0 = u.pm * BM + wr * 64 + fr, col0 = u.pn * BM + wc * 32 + 4 * fq;
#pragma unroll
        for (int ai = 0; ai < 2; ++ai)
#pragma unroll
            for (int m = 0; m < 4; ++m) {
                const int r = row0 + ai * HALF + m * 16; const size_t off = (size_t)r * 4096 + col0;
                float sq = 0.f;
#pragma unroll
                for (int bj = 0; bj < 2; ++bj)
#pragma unroll
                    for (int n = 0; n < 2; ++n) {
                        const f32x4 h = *(const f32x4*)(hin + off + bj * HALF + n * 16) + acc[ai][bj][m][n];
                        *(f32x4*)(hout + off + bj * HALF + n * 16) = h;
                        u32x2 w; w.x = cvt_pk_bf16(h[0], h[1]); w.y = cvt_pk_bf16(h[2], h[3]);
                        *(u32x2*)(xb + off + bj * HALF + n * 16) = w;
                        sq += (h[0] * h[0] + h[1] * h[1]) + (h[2] * h[2] + h[3] * h[3]);
                    }
                sq += __shfl_xor(sq, 16); sq += __shfl_xor(sq, 32);
                if (fq == 0) atomicAdd(ss + r, sq);
                asm volatile("" ::: "memory");
            }
    }
};

struct EpiUpPre {
    static constexpr bool PERM = true, AFTER_DRAIN = false;
    bf16_t* apre; const float* ss;
    __device__ __forceinline__ void operator()(const f32x4 (&acc)[2][2][4][2], const Unit& u, int wr, int wc, int fr, int fq) const {
        const int row0 = u.pm * BM + wr * 64 + fr, col0 = u.pn * 128 + wc * 32 + 8 * fq;
#pragma unroll
        for (int ai = 0; ai < 2; ++ai)
#pragma unroll
            for (int m = 0; m < 4; ++m) {
                const int r = row0 + ai * HALF + m * 16;
                const float rs = rstd_from_ss(ss, r);
                bf16_t* rowp = apre + (size_t)r * 28672 + col0;
#pragma unroll
                for (int bj = 0; bj < 2; ++bj) {
                    const f32x4 v0 = acc[ai][bj][m][0] * rs, v1 = acc[ai][bj][m][1] * rs;
                    u32x4 w; w.x = cvt_pk_bf16(v0[0], v0[1]); w.y = cvt_pk_bf16(v0[2], v0[3]); w.z = cvt_pk_bf16(v1[0], v1[1]); w.w = cvt_pk_bf16(v1[2], v1[3]);
                    *(u32x4*)(rowp + bj * 14336) = w;
                }
                asm volatile("" ::: "memory");
            }
    }
};

struct EpiSgIn {
    static constexpr bool PERM = true, AFTER_DRAIN = false;
    bf16_t* U; bf16_t* V; const float* ss; const float* bias; float* vs;
    __device__ __forceinline__ void operator()(const f32x4 (&acc)[2][2][4][2], const Unit& u, int wr, int wc, int fr, int fq) const {
        const int row0 = u.pm * BM + wr * 64 + fr, gcol0 = u.pn * BM + wc * 32 + 8 * fq;
        const bool isv = u.pn >= 16;
        bf16_t* base = isv ? V : U; const int col0 = isv ? gcol0 - 4096 : gcol0;
        f32x4 bv[2][2];
#pragma unroll
        for (int bj = 0; bj < 2; ++bj)
#pragma unroll
            for (int n = 0; n < 2; ++n) bv[bj][n] = *(const f32x4*)(bias + gcol0 + bj * HALF + 4 * n);
#pragma unroll
        for (int ai = 0; ai < 2; ++ai)
#pragma unroll
            for (int m = 0; m < 4; ++m) {
                const int r = row0 + ai * HALF + m * 16;
                const float rs = rstd_from_ss(ss, r);
                bf16_t* rowp = base + (size_t)r * 4096 + col0;
                float s1 = 0.f, s2 = 0.f;
#pragma unroll
                for (int bj = 0; bj < 2; ++bj) {
                    f32x4 v0 = acc[ai][bj][m][0] * rs + bv[bj][0], v1 = acc[ai][bj][m][1] * rs + bv[bj][1];
                    const f32x2 a = gelu_pk((f32x2){v0[0], v0[1]}), b = gelu_pk((f32x2){v0[2], v0[3]}), c = gelu_pk((f32x2){v1[0], v1[1]}), d = gelu_pk((f32x2){v1[2], v1[3]});
                    s1 += (a.x + a.y) + (b.x + b.y) + (c.x + c.y) + (d.x + d.y);
                    s2 += (a.x * a.x + a.y * a.y) + (b.x * b.x + b.y * b.y) + (c.x * c.x + c.y * c.y) + (d.x * d.x + d.y * d.y);
                    u32x4 w; w.x = cvt_pk_bf16(a.x, a.y); w.y = cvt_pk_bf16(b.x, b.y); w.z = cvt_pk_bf16(c.x, c.y); w.w = cvt_pk_bf16(d.x, d.y);
                    *(u32x4*)(rowp + bj * HALF) = w;
                }
                if (isv) {
                    s1 += __shfl_xor(s1, 16); s1 += __shfl_xor(s1, 32); s2 += __shfl_xor(s2, 16); s2 += __shfl_xor(s2, 32);
                    if (fq == 0) { atomicAdd(vs + 2 * r, s1); atomicAdd(vs + 2 * r + 1, s2); }
                }
                asm volatile("" ::: "memory");
            }
    }
};

#define PG8_DPP(oldv, srcv, ctrl) __builtin_bit_cast(float, __builtin_amdgcn_update_dpp(__builtin_bit_cast(int, (float)(oldv)), __builtin_bit_cast(int, (float)(srcv)), (ctrl), 0xf, 0xf, false))
struct EpiUpConv {
    static constexpr bool PERM = true, AFTER_DRAIN = false;
    bf16_t* G; const float* ss; const float* cw; const float* cb; float* top; float* bot; PG8_LAS float* xch;
    __device__ __forceinline__ static float silu(float x) { return x * __builtin_amdgcn_rcpf(1.0f + __builtin_amdgcn_exp2f(-1.4426950408889634f * x)); }
    __device__ __forceinline__ void operator()(const f32x4 (&acc)[2][2][4][2], const Unit& u, int wr, int wc, int fr, int fq) const {
        const int row0 = u.pm * BM + wr * 64 + fr, colg = u.pn * 128 + wc * 32 + 8 * fq;
        float rs[2][4];
#pragma unroll
        for (int ai = 0; ai < 2; ++ai)
#pragma unroll
            for (int m = 0; m < 4; ++m) rs[ai][m] = rstd_from_ss(ss, row0 + ai * HALF + m * 16);
#pragma unroll
        for (int ai = 0; ai < 2; ++ai)
#pragma unroll
            for (int bj = 0; bj < 2; ++bj)
#pragma unroll
                for (int n = 0; n < 2; ++n) {
                    const f32x4 v = acc[ai][bj][3][n] * rs[ai][3];
                    if (fr >= 14) {
                        *(PG8_LAS f32x4*)(xch + ((((((ai * 2 + wr) * 4 + wc) * 2 + bj) * 2 + n) * 4 + fq) * 2 + (fr - 14)) * 4) = v;
                        if (ai == 1 && wr == 1) *(f32x4*)(bot + ((size_t)(u.pm * 2 + (fr - 14)) * 28672) + bj * 14336 + colg + 4 * n) = v;
                    }
                }
        if (wr == 0 && fr < 2) {
#pragma unroll
            for (int bj = 0; bj < 2; ++bj)
#pragma unroll
                for (int n = 0; n < 2; ++n) *(f32x4*)(top + ((size_t)(u.pm * 2 + fr) * 28672) + bj * 14336 + colg + 4 * n) = acc[0][bj][0][n] * rs[0][0];
        }
        asm volatile("s_waitcnt lgkmcnt(0)" ::: "memory"); __builtin_amdgcn_s_barrier(); asm volatile("" ::: "memory");
#pragma unroll
        for (int n = 0; n < 2; ++n) {
            f32x4 w0[2], w1[2], w2[2], cbv[2];
#pragma unroll
            for (int bj = 0; bj < 2; ++bj) { const int off = bj * 14336 + colg + 4 * n;
                w0[bj] = *(const f32x4*)(cw + off); w1[bj] = *(const f32x4*)(cw + 28672 + off); w2[bj] = *(const f32x4*)(cw + 2 * 28672 + off); cbv[bj] = *(const f32x4*)(cb + off); }
#pragma unroll
            for (int ai = 0; ai < 2; ++ai) {
                f32x4 prev[2];
                const bool has = !(ai == 0 && wr == 0);
                const int pai = wr == 1 ? ai : 0, pwr = wr == 1 ? 0 : 1;
#pragma unroll
                for (int bj = 0; bj < 2; ++bj) {
                    prev[bj] = (f32x4){0.f, 0.f, 0.f, 0.f};
                    if (has && fr >= 14) prev[bj] = *(const PG8_LAS f32x4*)(xch + ((((((pai * 2 + pwr) * 4 + wc) * 2 + bj) * 2 + n) * 4 + fq) * 2 + (fr - 14)) * 4);
                }
#pragma unroll
                for (int m = 0; m < 4; ++m) {
                    f32x4 cv[2];
#pragma unroll
                    for (int bj = 0; bj < 2; ++bj) {
                        const f32x4 cur = acc[ai][bj][m][n] * rs[ai][m];
#pragma unroll
                        for (int j = 0; j < 4; ++j) {
                            const float r1 = PG8_DPP(0.f, prev[bj][j], 0x121), r2 = PG8_DPP(0.f, prev[bj][j], 0x122);
                            const float p1 = PG8_DPP(r1, cur[j], 0x111), p2 = PG8_DPP(r2, cur[j], 0x112);
                            cv[bj][j] = cbv[bj][j] + w0[bj][j] * p2 + w1[bj][j] * p1 + w2[bj][j] * cur[j];
                        }
                        prev[bj] = cur;
                    }
                    u32x2 w; w.x = cvt_pk_bf16(silu(cv[0][0]) * cv[1][0], silu(cv[0][1]) * cv[1][1]); w.y = cvt_pk_bf16(silu(cv[0][2]) * cv[1][2], silu(cv[0][3]) * cv[1][3]);
                    *(u32x2*)(G + (size_t)(row0 + ai * HALF + m * 16) * 14336 + colg + 4 * n) = w;
                    asm volatile("" ::: "memory");
                }
            }
            asm volatile("" ::: "memory");
        }
    }
};
template <class Epi, class Sched, bool ALIGN_EPI = false, bool SP2 = false>
__device__ __forceinline__ void gemm_phase(PG8_LAS unsigned char* lds, const Gemm g, const Sched& S, const Epi& E) {
    const int tid = threadIdx.x, wid = __builtin_amdgcn_readfirstlane(tid >> 6), lane = tid & 63, wr = wid >> 2, wc = wid & 3, fr = lane & 15, fq = lane >> 4;
    const int K = g.K, nt = K / BK;
    unsigned voffA[2], voffB[2];
#pragma unroll
    for (int i = 0; i < 2; ++i) { int R, C; stage_rc(tid * 16 + i * 8192, R, C); const int Rb = Epi::PERM ? ((R & ~31) + perm32(R & 31)) : R;
        voffA[i] = (unsigned)(R * K + C) * 2u; voffB[i] = (unsigned)(Rb * K + C) * 2u; }
    const size_t kstep = (size_t)(BK * 2);
    const size_t hstep = (size_t)HALF * K * 2;
    const size_t tstep = 2 * hstep;
    const unsigned ldsw = (unsigned)wid * 1024u;
    const int aoff = lds_byte(wr * 64 + fr, fq * 8), boff = lds_byte(wc * 32 + fr, fq * 8);
#define PG8_SA(b, h) (((b) * 2 + (h)) * HTB)
#define PG8_SB(b, h) ((4 + (b) * 2 + (h)) * HTB)
#define PG8_STAGE(bufoff, gbase, voff) do { _Pragma("unroll") for (int _i = 0; _i < 2; ++_i) \
        __builtin_amdgcn_global_load_lds((const unsigned*)((const char*)(gbase) + (voff)[_i]), (PG8_LAS unsigned*)(lds + (bufoff) + ldsw + _i * 8192), 16, 0, 0); } while (0)
#define PG8_LDA(dst, b, h) do { _Pragma("unroll") for (int m = 0; m < 4; ++m) _Pragma("unroll") for (int k = 0; k < 2; ++k) dst[m][k] = *(const PG8_LAS bf16x8*)(lds + PG8_SA(b, h) + aoff + m * 2048 + k * 1024); } while (0)
#define PG8_LDB(dst, b, h) do { _Pragma("unroll") for (int n = 0; n < 2; ++n) _Pragma("unroll") for (int k = 0; k < 2; ++k) dst[n][k] = *(const PG8_LAS bf16x8*)(lds + PG8_SB(b, h) + boff + n * 2048 + k * 1024); } while (0)
#define PG8_MMA(ai, bj, At, Bt) do { __builtin_amdgcn_s_setprio(1); _Pragma("unroll") for (int m = 0; m < 4; ++m) _Pragma("unroll") for (int n = 0; n < 2; ++n) _Pragma("unroll") for (int k = 0; k < 2; ++k) \
        acc[ai][bj][m][n] = __builtin_amdgcn_mfma_f32_16x16x32_bf16(Bt[n][k], At[m][k], acc[ai][bj][m][n], 0, 0, 0); __builtin_amdgcn_s_setprio(0); } while (0)
#define PG8_WAIT_V(n) asm volatile("s_waitcnt vmcnt(" #n ")" ::: "memory")
#define PG8_WAIT_L(n) asm volatile("s_waitcnt lgkmcnt(" #n ")" ::: "memory")
#define PG8_BAR __builtin_amdgcn_s_barrier()
#define PG8_SCHED __builtin_amdgcn_sched_barrier(0)
    Unit cur, nxt; int ui = 0;
    if (!S.next(0, cur)) return;
    f32x4 acc[2][2][4][2];
#pragma unroll
    for (int a = 0; a < 2; ++a)
#pragma unroll
        for (int b = 0; b < 2; ++b)
#pragma unroll
            for (int m = 0; m < 4; ++m)
#pragma unroll
                for (int n = 0; n < 2; ++n) acc[a][b][m][n] = (f32x4){0.f, 0.f, 0.f, 0.f};
    bf16x8 At[4][2], B0[2][2], B1[2][2];
    const char* cA = (const char*)g.A + (size_t)cur.pm * tstep; const char* cB = (const char*)g.Bt + (size_t)cur.pn * tstep;
    S.a_ready(cur);
    if constexpr (SP2) {
        PG8_STAGE(PG8_SB(0, 0), cB, voffB); PG8_STAGE(PG8_SB(0, 1), cB + hstep, voffB); PG8_STAGE(PG8_SA(0, 0), cA, voffA); PG8_STAGE(PG8_SA(0, 1), cA + hstep, voffA);
        if (wr == 1) PG8_BAR;
        PG8_WAIT_V(2); PG8_BAR;
        PG8_STAGE(PG8_SB(1, 0), cB + kstep, voffB); PG8_STAGE(PG8_SA(1, 0), cA + kstep, voffA); PG8_STAGE(PG8_SB(1, 1), cB + hstep + kstep, voffB);
        PG8_WAIT_V(6); PG8_BAR;
    } else {
        PG8_STAGE(PG8_SB(0, 0), cB, voffB); PG8_STAGE(PG8_SA(0, 0), cA, voffA); PG8_STAGE(PG8_SB(0, 1), cB + hstep, voffB); PG8_STAGE(PG8_SA(0, 1), cA + hstep, voffA);
        if (wr == 1) PG8_BAR;
        PG8_WAIT_V(4); PG8_BAR;
        PG8_STAGE(PG8_SB(1, 0), cB + kstep, voffB); PG8_STAGE(PG8_SA(1, 0), cA + kstep, voffA); PG8_STAGE(PG8_SB(1, 1), cB + hstep + kstep, voffB);
        PG8_WAIT_V(6); PG8_BAR;
    }
    for (;;) {
        const bool has_next = S.next(ui + 1, nxt);
        const char* nA = has_next ? (const char*)g.A + (size_t)nxt.pm * tstep : cA; const char* nB = has_next ? (const char*)g.Bt + (size_t)nxt.pn * tstep : cB;
        for (int t = 0; t < nt; t += 2) {
            const bool last = (t == nt - 2);
            const char* a1 = cA + (size_t)(t + 1) * kstep;
            const char* a2 = last ? nA : cA + (size_t)(t + 2) * kstep; const char* b2 = last ? nB : cB + (size_t)(t + 2) * kstep;
            const char* a3 = a2 + kstep; const char* b3 = b2 + kstep;
            if (last && has_next) S.a_ready(nxt);
            if constexpr (SP2) {
            PG8_LDB(B0, 0, 0); PG8_LDB(B1, 0, 1); PG8_SCHED; PG8_LDA(At, 0, 0); PG8_STAGE(PG8_SA(1, 1), a1 + hstep, voffA);
            PG8_WAIT_V(8); PG8_WAIT_L(0); PG8_BAR; PG8_MMA(0, 0, At, B0); PG8_MMA(0, 1, At, B1); PG8_BAR; PG8_SCHED;
            PG8_LDA(At, 0, 1); PG8_STAGE(PG8_SB(0, 0), b2, voffB); PG8_STAGE(PG8_SB(0, 1), b2 + hstep, voffB); PG8_STAGE(PG8_SA(0, 0), a2, voffA);
            PG8_WAIT_V(8); PG8_WAIT_L(0); PG8_BAR; PG8_MMA(1, 0, At, B0); PG8_MMA(1, 1, At, B1); PG8_BAR; PG8_SCHED;
            PG8_LDB(B0, 1, 0); PG8_LDB(B1, 1, 1); PG8_SCHED; PG8_LDA(At, 1, 0); PG8_STAGE(PG8_SA(0, 1), a2 + hstep, voffA);
            PG8_WAIT_V(8); PG8_WAIT_L(0); PG8_BAR; PG8_MMA(0, 0, At, B0); PG8_MMA(0, 1, At, B1); PG8_BAR; PG8_SCHED;
            PG8_LDA(At, 1, 1); PG8_STAGE(PG8_SB(1, 0), b3, voffB); PG8_STAGE(PG8_SB(1, 1), b3 + hstep, voffB); PG8_STAGE(PG8_SA(1, 0), a3, voffA);
            PG8_WAIT_V(8); PG8_WAIT_L(0); PG8_BAR; PG8_MMA(1, 0, At, B0); PG8_MMA(1, 1, At, B1); PG8_BAR; PG8_SCHED;
            } else {
            PG8_LDB(B0, 0, 0); PG8_SCHED; PG8_LDA(At, 0, 0); PG8_STAGE(PG8_SA(1, 1), a1 + hstep, voffA);
            PG8_WAIT_L(8); PG8_BAR; PG8_WAIT_L(0); PG8_MMA(0, 0, At, B0); PG8_BAR; PG8_SCHED;
            PG8_LDB(B1, 0, 1); PG8_STAGE(PG8_SB(0, 0), b2, voffB);
            PG8_BAR; PG8_WAIT_L(0); PG8_MMA(0, 1, At, B1); PG8_BAR;
            PG8_LDA(At, 0, 1); PG8_STAGE(PG8_SA(0, 0), a2, voffA);
            PG8_BAR; PG8_WAIT_L(0); PG8_MMA(1, 0, At, B0); PG8_BAR; PG8_SCHED;
            PG8_STAGE(PG8_SB(0, 1), b2 + hstep, voffB);
            PG8_WAIT_V(6); PG8_BAR; PG8_MMA(1, 1, At, B1); PG8_BAR;
            PG8_LDB(B0, 1, 0); PG8_SCHED; PG8_LDA(At, 1, 0); PG8_STAGE(PG8_SA(0, 1), a2 + hstep, voffA);
            PG8_WAIT_L(8); PG8_BAR; PG8_WAIT_L(0); PG8_MMA(0, 0, At, B0); PG8_BAR; PG8_SCHED;
            PG8_LDB(B1, 1, 1); PG8_STAGE(PG8_SB(1, 0), b3, voffB);
            PG8_BAR; PG8_WAIT_L(0); PG8_MMA(0, 1, At, B1); PG8_BAR;
            PG8_LDA(At, 1, 1); PG8_STAGE(PG8_SA(1, 0), a3, voffA);
            PG8_BAR; PG8_WAIT_L(0); PG8_MMA(1, 0, At, B0); PG8_BAR; PG8_SCHED;
            PG8_STAGE(PG8_SB(1, 1), b3 + hstep, voffB);
            PG8_WAIT_V(6); PG8_BAR; PG8_MMA(1, 1, At, B1); PG8_BAR;
            }
        }
        if constexpr (ALIGN_EPI) { if (wr == 0) PG8_BAR; }
        if constexpr (!Epi::AFTER_DRAIN) { E(acc, cur, wr, wc, fr, fq); S.done(cur); }
        if (!has_next) break;
#pragma unroll
        for (int a = 0; a < 2; ++a)
#pragma unroll
            for (int b = 0; b < 2; ++b)
#pragma unroll
                for (int m = 0; m < 4; ++m)
#pragma unroll
                    for (int n = 0; n < 2; ++n) acc[a][b][m][n] = (f32x4){0.f, 0.f, 0.f, 0.f};
        cur = nxt; cA = nA; cB = nB; ++ui;
        if constexpr (ALIGN_EPI) { if (wr == 1) PG8_BAR; }
    }
    PG8_WAIT_V(0);
    if constexpr (!ALIGN_EPI) { if (wr == 0) PG8_BAR; }
    PG8_BAR;
    if constexpr (Epi::AFTER_DRAIN) { E.fused(acc, cur, wr, wc, fr, fq, lds, wid, lane); S.done(cur); }
#undef PG8_SA
#undef PG8_SB
#undef PG8_STAGE
#undef PG8_LDA
#undef PG8_LDB
#undef PG8_MMA
#undef PG8_WAIT_V
#undef PG8_WAIT_L
#undef PG8_BAR
#undef PG8_SCHED
}
}
#ifndef PG8_SP2
#define PG8_SP2 true
#endif
#ifndef PG8_ALIGN
#define PG8_ALIGN true
#endif
constexpr int NWAVES = 8;
constexpr int NB = 2, NS = 4096, DM = 4096, MR = NB * NS;
constexpr int NHQ = 48, NHA = 24, HD = 128, QKVC = 3 * NHQ * HD;
constexpr int DFF = 14336, F2 = 2 * DFF;
constexpr float ATT_SCALE = 0.08838834764831845f;
constexpr float NORM_EPS = 1e-5f;
constexpr size_t MiB = 1u << 20;
constexpr size_t WS_CTL = 0, CTL_ZERO_BYTES = 1 * MiB;
constexpr size_t WS_SSQ = 256 * 1024, SSQ_SITE = 32 * 1024;
constexpr size_t WS_VSQ = 512 * 1024;
constexpr size_t WS_ROPE = 1 * MiB;
constexpr size_t WS_KMEAN = 576 * 1024;
constexpr size_t WS_SS = 3 * MiB, SS_SITE = 2 * MiB;
constexpr size_t WS_VS = 13 * MiB;
constexpr size_t WS_SEL = 18 * MiB;
constexpr size_t WS_LSE = 20 * MiB;
constexpr size_t WS_WIN = 32 * MiB;
constexpr size_t WS_WOUT = 176 * MiB;
constexpr size_t WS_SGWIN = 208 * MiB;
constexpr size_t WS_SGWOUT = 272 * MiB;
constexpr size_t WS_WUP = 304 * MiB, WUP_L = 224 * MiB;
constexpr size_t WS_WDOWN = 752 * MiB, WDOWN_L = 112 * MiB;
constexpr size_t WS_XB = 976 * MiB;
constexpr size_t WS_H = 1040 * MiB;
constexpr size_t WS_QKV = 1168 * MiB;
constexpr size_t WS_U = WS_QKV, WS_V = WS_QKV + 64 * MiB;
constexpr size_t WS_O = 1456 * MiB;
constexpr size_t WS_G = 1520 * MiB;
constexpr size_t WS_DO = WS_G;
constexpr size_t WS_APRE = 1744 * MiB;
constexpr size_t WS_TOP = WS_APRE + 128 * MiB, WS_BOT = WS_APRE + 136 * MiB;
constexpr size_t WS_END = 2192 * MiB;
constexpr int RING_OFF = 0, RING_BYTES = 131072;
constexpr int SCR_BYTES = 133120;
constexpr int LDSCTL_OFF = SCR_BYTES, MISC_OFF = LDSCTL_OFF + 320;
constexpr int XTRA_OFF = SCR_BYTES + 1024;
constexpr int LDS_BYTES = 147456;
static_assert(MISC_OFF + 128 <= XTRA_OFF, "LDS map");
constexpr int CW_TMO = 0, CW_BAR = 4096;

#define GAS __attribute__((address_space(1)))
#define LAS __attribute__((address_space(3)))
typedef unsigned short bf16;
typedef unsigned v4u __attribute__((ext_vector_type(4)));
typedef unsigned v2u __attribute__((ext_vector_type(2)));
typedef float f32x4 __attribute__((ext_vector_type(4)));
typedef float f32x2 __attribute__((ext_vector_type(2)));
#define LDS_WAIT() asm volatile("s_waitcnt lgkmcnt(0)" ::: "memory")
#define VM_WAIT() asm volatile("s_waitcnt vmcnt(0)" ::: "memory")
__device__ __forceinline__ unsigned f2bf(float f) { unsigned u = __builtin_bit_cast(unsigned, f); return (u + 0x7fffu + ((u >> 16) & 1u)) >> 16; }
__device__ __forceinline__ unsigned pk2(float lo, float hi) { return f2bf(lo) | (f2bf(hi) << 16); }
__device__ __forceinline__ float bflo(unsigned w) { return __builtin_bit_cast(float, w << 16); }
__device__ __forceinline__ float bfhi(unsigned w) { return __builtin_bit_cast(float, w & 0xffff0000u); }
__device__ __forceinline__ float bf1(bf16 h) { return __builtin_bit_cast(float, (unsigned)h << 16); }
namespace att {
typedef unsigned short bf16;
typedef short bf16x8 __attribute__((ext_vector_type(8)));
typedef short s16x4 __attribute__((ext_vector_type(4)));
typedef float f32x16 __attribute__((ext_vector_type(16)));
typedef float f32x4 __attribute__((ext_vector_type(4)));
typedef unsigned u32x4 __attribute__((ext_vector_type(4)));
template <class A, class Bt> struct same_t { static constexpr bool v = false; };
template <class A> struct same_t<A, A> { static constexpr bool v = true; };
constexpr int D = 128;
constexpr float SCALE = 0.08838834764831845f, THR = 8.f;
constexpr int NW = 8, QBLK = 32, KVBLK = 64, QB = NW * QBLK;
constexpr int SHM_V = KVBLK * D * 2, SHM_K = KVBLK * D * 2;
constexpr int ATT_LDS_BYTES = 2 * SHM_V + 2 * SHM_K + NW * 64 * 4;
#define KSWZ(row, colB) ((row) * 256 + ((colB) ^ (((row) & 7) << 4)))
#define SBAR() __builtin_amdgcn_sched_barrier(0)
__device__ __forceinline__ int v_st(int k, int c) { const int kk = (k & ~0xC) | ((k & 4) << 1) | ((k & 8) >> 1); return ((kk >> 3) * 4 + (c >> 5)) * 512 + ((kk & 7) * 32 + (c & 31)) * 2; }
__device__ __forceinline__ int v_rd_base(int lane) { return ((lane & 3) << 3) | (((lane >> 2) & 3) << 6) | (((lane >> 4) & 1) << 5) | (((lane >> 5) & 1) << 8); }
constexpr int v_rd_off(int d0, int ks, int half) { return d0 * 512 + ks * 4096 + half * 2048; }
__device__ __forceinline__ int crow(int r, int hi) { return (r & 3) + 8 * (r >> 2) + 4 * hi; }
__device__ __forceinline__ unsigned cvtpk(float lo, float hi) {
    unsigned r; asm volatile("v_cvt_pk_bf16_f32 %0, %1, %2" : "=v"(r) : "v"(lo), "v"(hi)); return r;
}
__device__ __forceinline__ bf16x8 pack8(f32x4 a, f32x4 b) {
    u32x4 w = {cvtpk(a[0], a[1]), cvtpk(a[2], a[3]), cvtpk(b[0], b[1]), cvtpk(b[2], b[3])};
    return *reinterpret_cast<bf16x8*>(&w);
}
template <class T> __device__ __forceinline__ bf16x8 load8(const T* p) {
    if constexpr (same_t<T, float>::v) { return pack8(*(const f32x4*)p, *(const f32x4*)(p + 4)); }
    else { return *reinterpret_cast<const bf16x8*>(p); }
}
__device__ __forceinline__ void mask_tile(f32x16& p0, f32x16& p1, int dq, unsigned W) {
    const float NEG = -__builtin_inff();
#pragma unroll
    for (int r = 0; r < 16; ++r) {
        const int c = (r & 3) + 8 * (r >> 2);
        if ((unsigned)(dq - c) >= W) p0[r] = NEG;
        if ((unsigned)(dq - c - 32) >= W) p1[r] = NEG;
    }
}
__device__ __forceinline__ void partialSM(f32x16& p0, f32x16& p1, float& m_reg, float& mn, float& alpha) {
    float pmax = p0[0]; for (int r = 1; r < 16; ++r) pmax = fmaxf(pmax, p0[r]); for (int r = 0; r < 16; ++r) pmax = fmaxf(pmax, p1[r]);
    { auto rr = __builtin_amdgcn_permlane32_swap(__float_as_uint(pmax), __float_as_uint(pmax), false, false);
      pmax = fmaxf(__uint_as_float(rr[0]), __uint_as_float(rr[1])); }
    constexpr float C2 = 1.4426950408889634f * SCALE;
    if (__builtin_expect(__all((pmax - m_reg) * SCALE <= THR), 1)) { mn = m_reg; alpha = 1.f; }
    else { mn = fmaxf(m_reg, pmax); alpha = __builtin_amdgcn_exp2f((m_reg - mn) * C2); m_reg = mn; }
    const float mnL = -mn * C2;
    for (int r = 0; r < 16; ++r) p0[r] = fmaf(p0[r], C2, mnL); for (int r = 0; r < 16; ++r) p1[r] = fmaf(p1[r], C2, mnL);
    for (int r = 0; r < 16; ++r) p0[r] = __builtin_amdgcn_exp2f(p0[r]);
}
__device__ __forceinline__ void finishSM(f32x16& p0, f32x16& p1, float alpha, float& l_reg, bf16x8& pa0, bf16x8& pa1, bf16x8& pa2, bf16x8& pa3) {
    for (int r = 0; r < 16; ++r) p1[r] = __builtin_amdgcn_exp2f(p1[r]);
    float ps = 0; for (int r = 0; r < 16; ++r) ps += p0[r]; for (int r = 0; r < 16; ++r) ps += p1[r];
    { auto rr = __builtin_amdgcn_permlane32_swap(__float_as_uint(ps), __float_as_uint(ps), false, false);
      ps = __uint_as_float(rr[0]) + __uint_as_float(rr[1]); }
    l_reg = l_reg * alpha + ps;
#define PK4(P, B_, OUT) do { unsigned a0 = cvtpk(P[B_+0], P[B_+1]), a1 = cvtpk(P[B_+2], P[B_+3]);                          \
        unsigned b0 = cvtpk(P[B_+4], P[B_+5]), b1 = cvtpk(P[B_+6], P[B_+7]);                                             \
        auto r0 = __builtin_amdgcn_permlane32_swap(a0, b0, false, false); auto r1 = __builtin_amdgcn_permlane32_swap(a1, b1, false, false); \
        u32x4 w = {r0[0], r1[0], r0[1], r1[1]}; OUT = *reinterpret_cast<bf16x8*>(&w); } while (0)
    PK4(p0, 0, pa0); PK4(p0, 8, pa1); PK4(p1, 0, pa2); PK4(p1, 8, pa3);
#undef PK4
}
template <int KB, bool SK>
__device__ __forceinline__ void qkt(f32x16& p0, f32x16& p1, const char* K_lds, int r32, int hi, const bf16x8* qr, bool act) {
    if (SK && !act) { const float NEG = -__builtin_inff();
#pragma unroll
        for (int r = 0; r < 16; ++r) { p0[r] = NEG; p1[r] = NEG; } return; }
    p0 = f32x16{}; p1 = f32x16{};
    const char* kb[4];
#pragma unroll
    for (int dd = 0; dd < 4; ++dd) kb[dd] = K_lds + KB * SHM_K + KSWZ(r32, (dd * 16 + hi * 8) * 2);
#pragma unroll
    for (int d0 = 0; d0 < 8; ++d0) { const char* a = kb[d0 & 3] + (d0 >> 2) * 128;
        bf16x8 b0 = *reinterpret_cast<const bf16x8*>(a);
        bf16x8 b1 = *reinterpret_cast<const bf16x8*>(a + 32 * 256);
        p0 = __builtin_amdgcn_mfma_f32_32x32x16_bf16(b0, qr[d0], p0, 0, 0, 0);
        p1 = __builtin_amdgcn_mfma_f32_32x32x16_bf16(b1, qr[d0], p1, 0, 0, 0); }
}
template <int VB, bool SK>
__device__ __forceinline__ void pv_tile(f32x16* o, int vb0, bf16x8 pa0, bf16x8 pa1, bf16x8 pa2, bf16x8 pa3, bool act) {
    if (SK && !act) return;
#define TRRD(dst, off) asm volatile("ds_read_b64_tr_b16 %0, %1 offset:%2" : "=&v"(dst) : "v"(vb0), "i"(off) : "memory")
#define PV_D0(d0) do { s16x4 l0, l1, l2, l3, h0, h1, h2, h3; constexpr int b_ = VB * SHM_V + v_rd_off(d0, 0, 0);     \
        TRRD(l0, b_); TRRD(h0, b_ + 2048); TRRD(l1, b_ + 4096); TRRD(h1, b_ + 6144); TRRD(l2, b_ + 8192); TRRD(h2, b_ + 10240); TRRD(l3, b_ + 12288); TRRD(h3, b_ + 14336); \
        asm volatile("s_waitcnt lgkmcnt(0)" ::: "memory"); SBAR();                 \
        o[d0] = __builtin_amdgcn_mfma_f32_32x32x16_bf16(pa0, (bf16x8){l0[0], l0[1], l0[2], l0[3], h0[0], h0[1], h0[2], h0[3]}, o[d0], 0, 0, 0);   \
        o[d0] = __builtin_amdgcn_mfma_f32_32x32x16_bf16(pa1, (bf16x8){l1[0], l1[1], l1[2], l1[3], h1[0], h1[1], h1[2], h1[3]}, o[d0], 0, 0, 0);   \
        o[d0] = __builtin_amdgcn_mfma_f32_32x32x16_bf16(pa2, (bf16x8){l2[0], l2[1], l2[2], l2[3], h2[0], h2[1], h2[2], h2[3]}, o[d0], 0, 0, 0);   \
        o[d0] = __builtin_amdgcn_mfma_f32_32x32x16_bf16(pa3, (bf16x8){l3[0], l3[1], l3[2], l3[3], h3[0], h3[1], h3[2], h3[3]}, o[d0], 0, 0, 0); } while (0)
    PV_D0(0); PV_D0(1); PV_D0(2); PV_D0(3);
#undef PV_D0
#undef TRRD
}

template <class TIn, class TOut> struct BlockRef { const TIn* Q; const TIn* K; const TIn* V; TOut* O; int P0; const __attribute__((address_space(3))) unsigned short* sel; float* L; };
template <class TIn> struct Seam {
    bf16x8 qr[8];
    bf16x8 st_v0, st_v1, st_k0, st_k1; f32x4 sf0, sf1, sf2, sf3;
    f32x4 tq[16];
};
__device__ __forceinline__ int swa_jlo(int P0, int W) { const int lowk = P0 - W + 1; return lowk > 0 ? lowk / KVBLK : 0; }
#define ROW(p, k0, rr) ((p) + (size_t)((k0) + (rr)) * rs_ + sc)
#define ROWN(p, k0, rr) ((p) + (size_t)((k0) + (rr)) * rsn_ + sc)
#define VMW() asm volatile("s_waitcnt vmcnt(0)" ::: "memory")
#define VMWN(n) asm volatile("s_waitcnt vmcnt(%0)" :: "i"(n) : "memory")
#define SLOAD_H(Kp, Vp, k0) do { S.st_v0 = load8<TIn>(ROW(Vp, k0, sr)); S.st_v1 = load8<TIn>(ROW(Vp, k0, 32 + sr));              \
                         S.st_k0 = load8<TIn>(ROW(Kp, k0, sr)); S.st_k1 = load8<TIn>(ROW(Kp, k0, 32 + sr)); } while (0)
#define SLOAD_HN(Kp, Vp, k0) do { S.st_v0 = load8<TIn>(ROWN(Vp, k0, sr)); S.st_v1 = load8<TIn>(ROWN(Vp, k0, 32 + sr));              \
                         S.st_k0 = load8<TIn>(ROWN(Kp, k0, sr)); S.st_k1 = load8<TIn>(ROWN(Kp, k0, 32 + sr)); } while (0)
#define SWRITE_HK(bf) do { *(bf16x8*)(K_lds + (bf) * SHM_K + kws) = S.st_k0; *(bf16x8*)(K_lds + (bf) * SHM_K + kws + 32 * 256) = S.st_k1; } while (0)
#define SWRITE_HV(bf) do { *(bf16x8*)(V_lds + (bf) * SHM_V + vst0) = S.st_v0; *(bf16x8*)(V_lds + (bf) * SHM_V + vst1) = S.st_v1; } while (0)
#define SWRITE_H(bf) do { SWRITE_HV(bf); SWRITE_HK(bf); } while (0)
#define SLOAD_F(p, k0) do { S.sf0 = *(const f32x4*)ROW(p, k0, sr); S.sf1 = *(const f32x4*)(ROW(p, k0, sr) + 4);                \
                            S.sf2 = *(const f32x4*)ROW(p, k0, 32 + sr); S.sf3 = *(const f32x4*)(ROW(p, k0, 32 + sr) + 4); } while (0)
#define SWRITE_KF(bf) do { *(bf16x8*)(K_lds + (bf) * SHM_K + kws) = pack8(S.sf0, S.sf1); *(bf16x8*)(K_lds + (bf) * SHM_K + kws + 32 * 256) = pack8(S.sf2, S.sf3); } while (0)
#define SWRITE_VF(bf) do { *(bf16x8*)(V_lds + (bf) * SHM_V + vst0) = pack8(S.sf0, S.sf1); *(bf16x8*)(V_lds + (bf) * SHM_V + vst1) = pack8(S.sf2, S.sf3); } while (0)
template <class TIn, class TOut, int RSC, int W>
__device__ __forceinline__ void causal_swa_prime(const BlockRef<TIn, TOut>& cur, char* lds, Seam<TIn>& S) {
    constexpr bool F32 = same_t<TIn, float>::v;
    int tid_ = threadIdx.x; asm volatile("" : "+v"(tid_));
    const int tid = tid_, wid = __builtin_amdgcn_readfirstlane(tid >> 6), lane = tid & 63, r32 = lane & 31, hi = lane >> 5;
    const int sr = tid >> 4, sc = (tid & 15) * 8, kws = KSWZ(sr, sc * 2); char* K_lds = lds + 2 * SHM_V;
    const int kb0 = swa_jlo(cur.P0, W) * KVBLK; constexpr int rs_ = RSC;
    for (int d0 = 0; d0 < 8; ++d0) S.qr[d0] = load8<TIn>(cur.Q + (size_t)(wid * QBLK + r32) * rs_ + d0 * 16 + hi * 8);
    if constexpr (F32) { SLOAD_F((const float*)cur.K, kb0); VMW(); SWRITE_KF(0); SBAR(); SLOAD_F((const float*)cur.V, kb0); }
    else { SLOAD_H(cur.K, cur.V, kb0); VMW(); SWRITE_HK(0); }
    __syncthreads();
}
template <class TIn, class TOut, bool SKP, int MODE, int RSC, int RSN, int OSC, int W, int WN, int skv>
__device__ __forceinline__ void causal_swa_block(const BlockRef<TIn, TOut>& cur, const BlockRef<TIn, TOut>& nxt, char* lds, Seam<TIn>& S) {
    constexpr bool F32 = same_t<TIn, float>::v; static_assert(!F32, "bf16 inputs only in this build");
    constexpr int rs_ = RSC, rsn_ = RSN, os_ = OSC;
    int tid_ = threadIdx.x; asm volatile("" : "+v"(tid_));
    const int tid = tid_, wid = __builtin_amdgcn_readfirstlane(tid >> 6), lane = tid & 63, r32 = lane & 31, hi = lane >> 5;
    const int j_lo = swa_jlo(cur.P0, W);
    int j_hi = (cur.P0 + QB - 1) / KVBLK + 1; if (j_hi > skv / KVBLK) j_hi = skv / KVBLK;
    const int NT = j_hi - j_lo;
    const int kbn = swa_jlo(nxt.P0, WN) * KVBLK;
    const int qlo = cur.P0 + wid * QBLK, qm = qlo + r32 - 4 * hi;
    char* V_lds = lds; char* K_lds = lds + 2 * SHM_V;
    float* ws = (float*)(lds + 2 * SHM_V + 2 * SHM_K) + wid * 64; float* li_l = ws, * al_l = ws + 32;
    float m_reg = -1e30f, l_reg = 0; f32x16 o[4] = {};
    unsigned selm = 0u; if constexpr (MODE == 0) selm = cur.sel[wid * QBLK + r32];
    const int sr = tid >> 4, sc = (tid & 15) * 8, vst0 = v_st(sr, sc), vst1 = v_st(32 + sr, sc), kws = KSWZ(sr, sc * 2);
    const int vb0 = (int)(uintptr_t)V_lds + v_rd_base(lane);
    const TIn* Kh = cur.K; const TIn* Vh = cur.V;
#define RESC(a) do { if (__any((a) < 1.f)) { if (hi == 0) al_l[r32] = (a); asm volatile("s_waitcnt lgkmcnt(0)" ::: "memory");              \
                     for (int d_ = 0; d_ < 4; ++d_) for (int r = 0; r < 16; ++r) o[d_][r] *= al_l[crow(r, hi)]; } } while (0)
#define KBASE(t) ((j_lo + (t)) * KVBLK)
#define ACT(t) (KBASE(t) <= qlo + QBLK - 1 && KBASE(t) + KVBLK - 1 >= qlo - W + 1)
#define MASKT(P0_, P1_, t) do { const int kb_ = KBASE(t); if ((!SK || ACT(t)) && (kb_ + KVBLK - 1 > qlo || kb_ <= qlo + QBLK - 1 - W)) mask_tile(P0_, P1_, qm - kb_, (unsigned)W); \
        if constexpr (MODE == 0) { if (kb_ < cur.P0) { const bool dead_ = ((selm >> (kb_ >> 8)) & 1u) == 0u; const float NEG_ = -__builtin_inff(); \
            _Pragma("unroll") for (int r_ = 0; r_ < 16; ++r_) { P0_[r_] = dead_ ? NEG_ : P0_[r_]; P1_[r_] = dead_ ? NEG_ : P1_[r_]; } } } } while (0)
    constexpr int NQL = F32 ? 16 : 8;
    constexpr bool SK = SKP && !F32;
#define SEAM_K0() do { VMWN(NQL); if constexpr (F32) { SWRITE_KF(0); SBAR(); SLOAD_F((const float*)nxt.V, kbn); } else { SWRITE_HK(0); } SBAR(); } while (0)
    f32x16 pA0, pA1, pB0, pB1; float mnA, mnB, alA, alB; bf16x8 pa0, pa1, pa2, pa3;
    if constexpr (F32) { VMW(); SWRITE_VF(0); SBAR(); } else { SWRITE_HV(0); SBAR(); }
    if (NT > 1) { if constexpr (F32) SLOAD_F((const float*)Kh, KBASE(1)); else SLOAD_H(Kh, Vh, KBASE(1)); }
    SBAR(); qkt<0, SK>(pA0, pA1, K_lds, r32, hi, S.qr, ACT(0));
    if constexpr (F32) { if (NT > 1) { VMW(); SWRITE_KF(1); SBAR(); SLOAD_F((const float*)Vh, KBASE(1)); } }
    MASKT(pA0, pA1, 0); partialSM(pA0, pA1, m_reg, mnA, alA);
    if (NT > 1) { VMW(); if constexpr (F32) { SWRITE_VF(1); SBAR(); if (NT > 2) SLOAD_F((const float*)Kh, KBASE(2)); } else SWRITE_H(1); }
    __syncthreads();
#define HALF_STEP(PX0, PX1, mnX, alX, PY0, PY1, alY, t, KB, VB, SB) do {                                                      \
        SBAR(); qkt<KB, SK>(PX0, PX1, K_lds, r32, hi, S.qr, ACT(t));                                             \
        finishSM(PY0, PY1, alY, l_reg, pa0, pa1, pa2, pa3); SBAR();                                                           \
        if ((t) + 1 < NT) { if constexpr (F32) { VMW(); SWRITE_KF(SB); SBAR(); SLOAD_F((const float*)Vh, KBASE((t) + 1)); }  \
                            else { SLOAD_H(Kh, Vh, KBASE((t) + 1)); } SBAR(); }                                               \
        pv_tile<VB, SK>(o, vb0, pa0, pa1, pa2, pa3, ACT((t) - 1)); MASKT(PX0, PX1, (t)); partialSM(PX0, PX1, m_reg, mnX, alX);                                        \
        __syncthreads();                                                                                                      \
        if ((t) + 1 < NT) { VMW(); if constexpr (F32) { SWRITE_VF(SB); SBAR(); if ((t) + 2 < NT) SLOAD_F((const float*)Kh, KBASE((t) + 2)); } \
                            else { SWRITE_H(SB); } }                                                                          \
        RESC(alX); __syncthreads(); } while (0)
    for (int t = 1; t + 1 < NT; t += 2) {
        HALF_STEP(pB0, pB1, mnB, alB, pA0, pA1, alA, t, 1, 0, 0);
        HALF_STEP(pA0, pA1, mnA, alA, pB0, pB1, alB, t + 1, 0, 1, 1);
    }
    const bool even = (NT & 1) == 0;
    if (even) { SBAR(); qkt<1, SK>(pB0, pB1, K_lds, r32, hi, S.qr, ACT(NT - 1)); SBAR(); }
#define QROW(e) (nxt.Q + (size_t)(wid * QBLK + r32) * rsn_ + ((e) >> 1) * 16 + hi * 8 + ((e) & 1) * 4)
    if constexpr (F32) { SLOAD_F((const float*)nxt.K, kbn); SBAR();
#pragma unroll
        for (int e = 0; e < 8; ++e) S.tq[e] = *(const f32x4*)QROW(e); }
    else { SLOAD_HN(nxt.K, nxt.V, kbn); SBAR();
#pragma unroll
        for (int d0 = 0; d0 < 8; ++d0) S.qr[d0] = load8<TIn>(nxt.Q + (size_t)(wid * QBLK + r32) * rsn_ + d0 * 16 + hi * 8); }
    SBAR();
    finishSM(pA0, pA1, alA, l_reg, pa0, pa1, pa2, pa3); SBAR();
    if constexpr (F32) {
#pragma unroll
        for (int e = 8; e < 16; ++e) S.tq[e] = *(const f32x4*)QROW(e); SBAR(); }
#undef QROW
    pv_tile<0, SK>(o, vb0, pa0, pa1, pa2, pa3, ACT(even ? NT - 2 : NT - 1));
    if (even) { MASKT(pB0, pB1, NT - 1); partialSM(pB0, pB1, m_reg, mnB, alB); __syncthreads(); RESC(alB);
        finishSM(pB0, pB1, alB, l_reg, pa0, pa1, pa2, pa3); SBAR(); pv_tile<1, SK>(o, vb0, pa0, pa1, pa2, pa3, ACT(NT - 1)); }
    SBAR(); SEAM_K0();
    if (hi == 0) li_l[r32] = l_reg; asm volatile("s_waitcnt lgkmcnt(0)" ::: "memory");
    if constexpr (MODE == 1) { if (hi == 0) cur.L[(size_t)(wid * QBLK + r32) * (RSC / 128 * 24)] = m_reg * SCALE + __logf(l_reg); }
    float rli[16];
#pragma unroll
    for (int r = 0; r < 16; ++r) rli[r] = __builtin_amdgcn_rcpf(li_l[crow(r, hi)]);
    TOut* Ow = cur.O + (size_t)(wid * QBLK) * os_;
#pragma unroll
    for (int r = 0; r < 16; ++r) { const int orow = crow(r, hi);
#pragma unroll
        for (int d0 = 0; d0 < 4; ++d0) { const float v = o[d0][r] * rli[r];
            if constexpr (same_t<TOut, float>::v) { Ow[(size_t)orow * os_ + d0 * 32 + r32] = v; }
            else { const float vn = __shfl_xor(v, 1);
                   if ((r32 & 1) == 0) *(unsigned*)(Ow + (size_t)orow * os_ + d0 * 32 + r32) = cvtpk(v, vn); } } }
    if constexpr (F32) {
#pragma unroll
        for (int d0 = 0; d0 < 8; ++d0) S.qr[d0] = pack8(S.tq[2 * d0], S.tq[2 * d0 + 1]); }
    __syncthreads();
#undef RESC
#undef KBASE
#undef ACT
#undef MASKT
#undef SEAM_K0
#undef HALF_STEP
}
#undef ROW
#undef ROWN
#undef SLOAD_HN
#undef VMW
#undef VMWN
#undef SLOAD_H
#undef SWRITE_HK
#undef SWRITE_HV
#undef SWRITE_H
#undef SLOAD_F
#undef SWRITE_KF
#undef SWRITE_VF
}
#define XB_TMO      128
#define XB_XCNT(j)  (256  + 64 * (j))
#define XB_XSUB(j)  (1280 + 64 * (j))
#define XB_XGEN(j)  (2304 + 64 * (j))
#define XB_TOP      3328
#define XB_TOPGEN   3392
#define XCD_BAR_WORDS 3456
#define XB_SPIN_CAP (1u << 18)

__device__ __forceinline__ unsigned xb_ld(unsigned* p)              { return __hip_atomic_load(p, __ATOMIC_RELAXED, __HIP_MEMORY_SCOPE_AGENT); }
__device__ __forceinline__ unsigned xb_add(unsigned* p, unsigned v) { return __hip_atomic_fetch_add(p, v, __ATOMIC_RELAXED, __HIP_MEMORY_SCOPE_AGENT); }
__device__ __forceinline__ unsigned xb_xcc_id() { return (unsigned)__builtin_amdgcn_s_getreg((3 << 11) | 20) & 0xFu; }
#define XB_SPIN(cond, bar) do { unsigned _sp = 0; while (cond) { __builtin_amdgcn_s_sleep(1); \
    if ((++_sp & 255u) == 0u) { if (xb_ld(&(bar)[XB_TMO])) break; if (_sp > XB_SPIN_CAP) { atomicAdd(&(bar)[XB_TMO], 1u); break; } } } } while (0)

struct XcdBarrier {
    unsigned* bar; unsigned x;
    volatile LAS unsigned* st;
};

__device__ __forceinline__ XcdBarrier xcd_barrier_post(unsigned* bar, volatile LAS unsigned* st) {
    XcdBarrier b; b.bar = bar; b.x = xb_xcc_id(); b.st = st;
    if (threadIdx.x == 0) (void)xb_add(&bar[XB_XCNT(b.x)], 1u);
    return b;
}
__device__ __forceinline__ void xcd_barrier_complete(unsigned* bar, unsigned x, unsigned& nloc, unsigned& nx) {
    const unsigned G = gridDim.x * gridDim.y * gridDim.z;
    unsigned sum, cnt, mine, sp = 0u;
    for (;;) {
        sum = 0u; cnt = 0u; mine = 0u;
#pragma unroll
        for (unsigned j = 0; j < 16; ++j) { const unsigned c = xb_ld(&bar[XB_XCNT(j)]); sum += c; cnt += (c > 0u) ? 1u : 0u; mine = (j == x) ? c : mine; }
        if (sum == G) break;
        __builtin_amdgcn_s_sleep(1);
        if ((++sp & 255u) == 0u) { if (xb_ld(&bar[XB_TMO])) break; if (sp > XB_SPIN_CAP) { atomicAdd(&bar[XB_TMO], 1u); break; } }
    }
    nloc = mine > 0u ? mine : 1u; nx = cnt > 0u ? cnt : 1u;
}

__device__ __forceinline__ void xcd_barrier(const XcdBarrier& b) {
    asm volatile("s_waitcnt vmcnt(0)" ::: "memory");
    __syncthreads();
    if (threadIdx.x == 0) {
        unsigned* bar = b.bar;
        __builtin_amdgcn_s_waitcnt(0);
        unsigned nloc = b.st[0], nx = b.st[1];
        if (nloc == 0u) { xcd_barrier_complete(bar, b.x, nloc, nx); b.st[0] = nloc; b.st[1] = nx; }
        const unsigned old = xb_add(&bar[XB_XSUB(b.x)], 1u);
        const unsigned gen = old / nloc;
        if (old + 1u == (gen + 1u) * nloc) {
            __builtin_amdgcn_fence(__ATOMIC_RELEASE, "agent");
            asm volatile("s_waitcnt vmcnt(0)" ::: "memory");
            const unsigned og = xb_add(&bar[XB_TOP], 1u);
            const unsigned tg = og / nx;
            if (og + 1u == (tg + 1u) * nx) xb_add(&bar[XB_TOPGEN], 1u);
            else XB_SPIN(xb_ld(&bar[XB_TOPGEN]) == tg, bar);
            __builtin_amdgcn_fence(__ATOMIC_ACQUIRE, "agent");
            xb_add(&bar[XB_XGEN(b.x)], 1u);
            asm volatile("s_waitcnt vmcnt(0)" ::: "memory");
        } else {
            XB_SPIN(xb_ld(&bar[XB_XGEN(b.x)]) == gen, bar);
            __builtin_amdgcn_fence(__ATOMIC_ACQUIRE, "agent");
            asm volatile("s_waitcnt vmcnt(0)" ::: "memory");
        }
    }
    __syncthreads();
}
struct Frame {
    LAS unsigned char* lds;
    volatile LAS unsigned* MISC;
    unsigned* ctl;
    int tid, lane, wave, G, gw, NGW;
    unsigned char* ws;
    const float* x; const int* pos;
    const float *attn_norm, *attn_w_in, *attn_w_out, *sg_norm, *sg_w_in, *sg_b_in, *sg_v_gain, *sg_v_bias, *sg_w_s, *sg_b_s, *sg_w_out, *ffn_norm, *ffn_w_up, *ffn_conv_w, *ffn_conv_b, *ffn_w_down, *final_norm;
    float* out;
};
__device__ __forceinline__ float wave_sum(float v) {
#pragma unroll
    for (int o = 1; o < 64; o <<= 1) v += __shfl_xor(v, o);
    return v;
}
__device__ __forceinline__ float wave_max(float v) {
#pragma unroll
    for (int o = 1; o < 64; o <<= 1) v = fmaxf(v, __shfl_xor(v, o));
    return v;
}
__device__ __forceinline__ float ss_rstd(const float* ss, int r) { return pg8::rstd_from_ss(ss, r); }

struct MapId { __device__ __forceinline__ int operator()(int n) const { return n; } };
struct MapUp { __device__ __forceinline__ int operator()(int n) const { return n < DFF ? ((n >> 7) << 8) + (n & 127) : (((n - DFF) >> 7) << 8) + 128 + ((n - DFF) & 127); } };
template <class RowMap>
__device__ __forceinline__ void transpose_item(const float* W, int K, int N, const float* gain, bf16* WT, RowMap rm, LAS float* scr, int item, int lane) {
    const int nblk = N / 64, kb = item / nblk, nb = item - kb * nblk, k0 = 64 * kb, n0 = 64 * nb;
    const int lr = lane >> 4, lc = (lane & 15) * 4;
    f32x4 v[16];
#pragma unroll
    for (int i = 0; i < 16; ++i) v[i] = *(const f32x4*)(W + (size_t)(k0 + 4 * i + lr) * N + n0 + lc);
#pragma unroll
    for (int i = 0; i < 16; ++i) { const int kk = 4 * i + lr; f32x4 x = v[i]; if (gain) x = x * gain[k0 + kk]; LAS float* d = scr + kk * 65 + lc; d[0] = x[0]; d[1] = x[1]; d[2] = x[2]; d[3] = x[3]; }
    LDS_WAIT(); asm volatile("" ::: "memory");
    const int c = lane & 7;
#pragma unroll
    for (int j = 0; j < 8; ++j) { const int n = (lane >> 3) + 8 * j; const LAS float* s = scr + (8 * c) * 65 + n;
        v4u o; o.x = pk2(s[0 * 65], s[1 * 65]); o.y = pk2(s[2 * 65], s[3 * 65]); o.z = pk2(s[4 * 65], s[5 * 65]); o.w = pk2(s[6 * 65], s[7 * 65]);
        *(v4u*)(WT + (size_t)rm(n0 + n) * K + k0 + 8 * c) = o; }
    LDS_WAIT(); asm volatile("" ::: "memory");
}
__device__ __forceinline__ void sincos_d(double a, double& sn, double& cs) {
    const double n = __builtin_rint(a * 0.15915494309189535);
    const double r = a - n * 6.283185307179586;
    const double r2 = r * r;
    double ts = r, tc = 1.0, s = r, c = 1.0;
#pragma unroll
    for (int k = 1; k <= 15; ++k) { tc = -tc * r2 / (double)((2 * k - 1) * (2 * k)); ts = -ts * r2 / (double)((2 * k) * (2 * k + 1)); c += tc; s += ts; }
    sn = s; cs = c;
}
__device__ __forceinline__ void p0_prologue(Frame& F) {
    LAS float* scr = (LAS float*)(F.lds + RING_OFF + F.wave * 16640);
    constexpr int I_WIN = 64 * (QKVC / 64), I_SQ = 64 * (DM / 64), I_SGIN = 64 * (2 * DM / 64), I_UP = 64 * (F2 / 64), I_DN = (DFF / 64) * (DM / 64);
    constexpr int NITEMS = I_WIN + 2 * I_SQ + I_SGIN + 2 * I_UP + 2 * I_DN;
    for (int it = F.gw; it < NITEMS; it += F.NGW) {
        int r = it;
        if (r < I_WIN) { transpose_item(F.attn_w_in, DM, QKVC, F.attn_norm, (bf16*)(F.ws + WS_WIN), MapId(), scr, r, F.lane); continue; } r -= I_WIN;
        if (r < I_SQ) { transpose_item(F.attn_w_out, DM, DM, nullptr, (bf16*)(F.ws + WS_WOUT), MapId(), scr, r, F.lane); continue; } r -= I_SQ;
        if (r < I_SGIN) { transpose_item(F.sg_w_in, DM, 2 * DM, F.sg_norm, (bf16*)(F.ws + WS_SGWIN), MapId(), scr, r, F.lane); continue; } r -= I_SGIN;
        if (r < I_SQ) { transpose_item(F.sg_w_out, DM, DM, nullptr, (bf16*)(F.ws + WS_SGWOUT), MapId(), scr, r, F.lane); continue; } r -= I_SQ;
        if (r < I_UP) { transpose_item(F.ffn_w_up, DM, F2, F.ffn_norm, (bf16*)(F.ws + WS_WUP), MapUp(), scr, r, F.lane); continue; } r -= I_UP;
        if (r < I_UP) { transpose_item(F.ffn_w_up + (size_t)DM * F2, DM, F2, F.ffn_norm + DM, (bf16*)(F.ws + WS_WUP + WUP_L), MapUp(), scr, r, F.lane); continue; } r -= I_UP;
        if (r < I_DN) { transpose_item(F.ffn_w_down, DFF, DM, nullptr, (bf16*)(F.ws + WS_WDOWN), MapId(), scr, r, F.lane); continue; } r -= I_DN;
        transpose_item(F.ffn_w_down + (size_t)DFF * DM, DFF, DM, nullptr, (bf16*)(F.ws + WS_WDOWN + WDOWN_L), MapId(), scr, r, F.lane);
    }
    bf16* XB = (bf16*)(F.ws + WS_XB); float* SS0 = (float*)(F.ws + WS_SSQ);
    for (int m = F.gw; m < MR; m += F.NGW) {
        const f32x4* xr = (const f32x4*)(F.x + (size_t)m * DM) + F.lane;
        v2u* o8 = (v2u*)(XB + (size_t)m * DM) + F.lane;
        float sq = 0.f;
#pragma unroll
        for (int j = 0; j < 16; ++j) { const f32x4 v = xr[64 * j]; sq += (v[0] * v[0] + v[1] * v[1]) + (v[2] * v[2] + v[3] * v[3]); v2u w; w.x = pk2(v[0], v[1]); w.y = pk2(v[2], v[3]); o8[64 * j] = w; }
        sq = wave_sum(sq);
        if (F.lane == 0) SS0[m] = sq;
    }
    float* rc = (float*)(F.ws + WS_ROPE); float* rs = rc + MR * 16;
    for (int idx = F.gw * 64 + F.lane; idx < MR * 16; idx += F.NGW * 64) {
        const int r = idx >> 4, i = idx & 15;
        double invd = 1.0;
        for (int k = 0; k < i; ++k) invd *= 0.44036660267178046;
        const float inv = (float)invd;
        const float ang = (float)F.pos[r] * inv;
        double sn, cs; sincos_d((double)ang, sn, cs);
        rc[idx] = (float)cs; rs[idx] = (float)sn;
    }
}

__device__ __forceinline__ void p_kmean(Frame& F) {
    const bf16* QKV = (const bf16*)(F.ws + WS_QKV); float* KM = (float*)(F.ws + WS_KMEAN);
    LAS float* red = (LAS float*)(F.lds + RING_OFF);
    for (int item = blockIdx.x; item < NB * NHA * 16; item += F.G) {
        const int j = item & 15, bh = item >> 4, b = bh / NHA, h = bh - b * NHA;
        const bf16* kb = QKV + ((size_t)((1 * 2 + b) * NHQ + h) * NS + 256 * j) * HD;
        const int d = F.tid & 127, part = F.tid >> 7;
        float s = 0.f;
        for (int i = 0; i < 64; ++i) s += bf1(kb[(size_t)(part * 64 + i) * HD + d]);
        red[part * 128 + d] = s;
        __syncthreads();
        if (F.tid < 128) KM[(size_t)item * 128 + F.tid] = (red[F.tid] + red[128 + F.tid] + red[256 + F.tid] + red[384 + F.tid]) * (1.0f / 256.0f);
        __syncthreads();
    }
}

__device__ __forceinline__ float dot128(const LAS float* qs, const bf16* krow) {
    float s = 0.f;
#pragma unroll 4
    for (int c = 0; c < 16; ++c) {
        const v4u kv = *(const v4u*)(krow + 8 * c); const LAS float* q8 = qs + 8 * c;
        s += q8[0] * bflo(kv.x) + q8[1] * bfhi(kv.x) + q8[2] * bflo(kv.y) + q8[3] * bfhi(kv.y) + q8[4] * bflo(kv.z) + q8[5] * bfhi(kv.z) + q8[6] * bflo(kv.w) + q8[7] * bfhi(kv.w);
    }
    return s;
}
__device__ __forceinline__ void p_attn_naive(Frame& F, bf16* O) {
    const bf16* QKV = (const bf16*)(F.ws + WS_QKV); const float* KM = (const float*)(F.ws + WS_KMEAN);
    LAS float* qs = (LAS float*)(F.lds + RING_OFF + F.wave * 8192);
    LAS float* ps = qs + 128;
    const int lane = F.lane;
    constexpr int NMOBA = NB * NHA * NS, NDIL = NB * 8 * NS;
    const float NEG = -__builtin_inff();
    for (int task = F.gw; task < NMOBA + NDIL; task += F.NGW) {
        if (task < NMOBA) {
            const int b = task / (NHA * NS), rem = task - b * (NHA * NS), h = rem >> 12, t = rem & 4095;
            const bf16* qrow = QKV + ((size_t)((0 * 2 + b) * NHQ + h) * NS + t) * HD;
            const bf16* Kb = QKV + (size_t)((1 * 2 + b) * NHQ + h) * NS * HD;
            const bf16* Vb = QKV + (size_t)((2 * 2 + b) * NHQ + h) * NS * HD;
            { const unsigned w = *(const unsigned*)(qrow + 2 * lane); qs[2 * lane] = bflo(w); qs[2 * lane + 1] = bfhi(w); }
            LDS_WAIT(); asm volatile("" ::: "memory");
            const int qb = t >> 8, tin = t & 255;
            float g = NEG;
            if (lane < qb) { const float* km = KM + ((size_t)((b * NHA + h) * 16 + lane)) * 128; float s = 0.f; for (int d = 0; d < 128; ++d) s += qs[d] * km[d]; g = s; }
            unsigned selmask = 0u;
            if (qb <= 3) selmask = (1u << qb) - 1u;
            else {
#pragma unroll
                for (int rd = 0; rd < 3; ++rd) {
                    float best = g; int bi = lane;
#pragma unroll
                    for (int o = 1; o < 64; o <<= 1) { const float ob = __shfl_xor(best, o); const int oi = __shfl_xor(bi, o); if (ob > best || (ob == best && oi < bi)) { best = ob; bi = oi; } }
                    selmask |= 1u << bi; if (lane == bi) g = NEG;
                }
            }
            float sc[4][4]; int jsel[3];
            unsigned mk = selmask;
#pragma unroll
            for (int sl = 0; sl < 3; ++sl) {
                int j = -1; if (mk) { j = __builtin_ctz(mk); mk &= mk - 1u; }
                jsel[sl] = j;
#pragma unroll
                for (int c = 0; c < 4; ++c) sc[sl][c] = (j >= 0) ? ATT_SCALE * dot128(qs, Kb + (size_t)(256 * j + lane + 64 * c) * HD) : NEG;
            }
#pragma unroll
            for (int c = 0; c < 4; ++c) { const int i = lane + 64 * c; sc[3][c] = (i <= tin) ? ATT_SCALE * dot128(qs, Kb + (size_t)(256 * qb + i) * HD) : NEG; }
            float mx = NEG;
#pragma unroll
            for (int sl = 0; sl < 4; ++sl)
#pragma unroll
                for (int c = 0; c < 4; ++c) mx = fmaxf(mx, sc[sl][c]);
            mx = wave_max(mx);
            float sum = 0.f;
#pragma unroll
            for (int sl = 0; sl < 4; ++sl)
#pragma unroll
                for (int c = 0; c < 4; ++c) { sc[sl][c] = __expf(sc[sl][c] - mx); sum += sc[sl][c]; }
            sum = wave_sum(sum);
            const float inv = 1.0f / sum;
#pragma unroll
            for (int sl = 0; sl < 4; ++sl)
#pragma unroll
                for (int c = 0; c < 4; ++c) ps[sl * 256 + lane + 64 * c] = sc[sl][c] * inv;
            LDS_WAIT(); asm volatile("" ::: "memory");
            float o0 = 0.f, o1 = 0.f;
#pragma unroll
            for (int sl = 0; sl < 3; ++sl) {
                if (jsel[sl] >= 0) { const bf16* vb = Vb + (size_t)(256 * jsel[sl]) * HD + 2 * lane;
                    for (int i = 0; i < 256; ++i) { const float p = ps[sl * 256 + i]; const unsigned w = *(const unsigned*)(vb + (size_t)i * HD); o0 += p * bflo(w); o1 += p * bfhi(w); } }
            }
            { const bf16* vb = Vb + (size_t)(256 * qb) * HD + 2 * lane;
              for (int i = 0; i <= tin; ++i) { const float p = ps[3 * 256 + i]; const unsigned w = *(const unsigned*)(vb + (size_t)i * HD); o0 += p * bflo(w); o1 += p * bfhi(w); } }
            *(unsigned*)(O + (size_t)(b * NS + t) * DM + h * HD + 2 * lane) = pk2(o0, o1);
            LDS_WAIT(); asm volatile("" ::: "memory");
        } else {
            const int td = task - NMOBA, b = td / (8 * NS), rem = td - b * (8 * NS), hh = rem >> 12, t = rem & 4095;
            float lse[3], og0[3], og1[3];
#pragma unroll
            for (int g = 0; g < 3; ++g) {
                const int head = NHA + g * 8 + hh, dil = g == 0 ? 1 : (g == 1 ? 4 : 16);
                const bf16* qrow = QKV + ((size_t)((0 * 2 + b) * NHQ + head) * NS + t) * HD;
                const bf16* Kb = QKV + (size_t)((1 * 2 + b) * NHQ + head) * NS * HD;
                const bf16* Vb = QKV + (size_t)((2 * 2 + b) * NHQ + head) * NS * HD;
                { const unsigned w = *(const unsigned*)(qrow + 2 * lane); qs[2 * lane] = bflo(w); qs[2 * lane + 1] = bfhi(w); }
                LDS_WAIT(); asm volatile("" ::: "memory");
                float sc[3];
#pragma unroll
                for (int c = 0; c < 3; ++c) { const int m = lane + 64 * c; const int kp = t - m * dil; sc[c] = (m <= 128 && kp >= 0) ? ATT_SCALE * dot128(qs, Kb + (size_t)kp * HD) : NEG; }
                float mx = wave_max(fmaxf(fmaxf(sc[0], sc[1]), sc[2]));
                float e0 = __expf(sc[0] - mx), e1 = __expf(sc[1] - mx), e2 = __expf(sc[2] - mx);
                const float sum = wave_sum(e0 + e1 + e2), inv = 1.0f / sum;
                lse[g] = mx + __logf(sum);
                ps[lane] = e0 * inv; ps[lane + 64] = e1 * inv; if (lane == 0) ps[128] = e2 * inv;
                LDS_WAIT(); asm volatile("" ::: "memory");
                const int nb = t / dil, nk = (nb < 128 ? nb : 128) + 1;
                float o0 = 0.f, o1 = 0.f;
                for (int m = 0; m < nk; ++m) { const float p = ps[m]; const unsigned w = *(const unsigned*)(Vb + (size_t)(t - m * dil) * HD + 2 * lane); o0 += p * bflo(w); o1 += p * bfhi(w); }
                og0[g] = o0; og1[g] = o1;
                LDS_WAIT(); asm volatile("" ::: "memory");
            }
            const float ml = fmaxf(fmaxf(lse[0], lse[1]), lse[2]);
            const float w0 = __expf(lse[0] - ml), w1 = __expf(lse[1] - ml), w2 = __expf(lse[2] - ml), wi = 1.0f / (w0 + w1 + w2);
            const float r0 = (w0 * og0[0] + w1 * og0[1] + w2 * og0[2]) * wi, r1 = (w0 * og1[0] + w1 * og1[1] + w2 * og1[2]) * wi;
            *(unsigned*)(O + (size_t)(b * NS + t) * DM + (NHA + hh) * HD + 2 * lane) = pk2(r0, r1);
        }
    }
}

__device__ __forceinline__ float silu_f(float x) { return x / (1.0f + __expf(-x)); }
__device__ __forceinline__ void unpack8(const v4u w, float (&f)[8]) { f[0] = bflo(w.x); f[1] = bfhi(w.x); f[2] = bflo(w.y); f[3] = bfhi(w.y); f[4] = bflo(w.z); f[5] = bfhi(w.z); f[6] = bflo(w.w); f[7] = bfhi(w.w); }
__device__ __forceinline__ void p_conv(Frame& F, int layer) {
    const bf16* AP = (const bf16*)(F.ws + WS_APRE); bf16* Gb = (bf16*)(F.ws + WS_G);
    const float* cw = F.ffn_conv_w + (size_t)layer * 3 * F2; const float* cb = F.ffn_conv_b + (size_t)layer * F2;
    constexpr int C8 = DFF / 8;
    const size_t total = (size_t)MR * C8;
    for (size_t idx = (size_t)blockIdx.x * 512 + F.tid; idx < total; idx += (size_t)F.G * 512) {
        const int r = (int)(idx / C8), j0 = (int)(idx - (size_t)r * C8) * 8, s = r & 4095;
        float cg[8], cu[8];
#pragma unroll
        for (int e = 0; e < 8; ++e) { cg[e] = cb[j0 + e]; cu[e] = cb[DFF + j0 + e]; }
#pragma unroll
        for (int tp = 0; tp < 3; ++tp) {
            const int back = 2 - tp;
            if (s >= back) {
                float ag[8], au[8];
                unpack8(*(const v4u*)(AP + (size_t)(r - back) * F2 + j0), ag);
                unpack8(*(const v4u*)(AP + (size_t)(r - back) * F2 + DFF + j0), au);
#pragma unroll
                for (int e = 0; e < 8; ++e) { cg[e] += cw[(size_t)tp * F2 + j0 + e] * ag[e]; cu[e] += cw[(size_t)tp * F2 + DFF + j0 + e] * au[e]; }
            }
        }
        v4u o; o.x = pk2(silu_f(cg[0]) * cu[0], silu_f(cg[1]) * cu[1]); o.y = pk2(silu_f(cg[2]) * cu[2], silu_f(cg[3]) * cu[3]);
        o.z = pk2(silu_f(cg[4]) * cu[4], silu_f(cg[5]) * cu[5]); o.w = pk2(silu_f(cg[6]) * cu[6], silu_f(cg[7]) * cu[7]);
        *(v4u*)(Gb + (size_t)r * DFF + j0) = o;
    }
}

__device__ __forceinline__ void p_sgate_naive(Frame& F) {
    const bf16* U = (const bf16*)(F.ws + WS_U); const bf16* V = (const bf16*)(F.ws + WS_V); const float* VS = (const float*)(F.ws + WS_VSQ); bf16* GT = (bf16*)(F.ws + WS_O);
    LAS float* vn = (LAS float*)(F.lds + RING_OFF);
    LAS float* wsl = vn + 128 * 128;
    LAS float* rstat = (LAS float*)(F.lds + XTRA_OFF);
    for (int item = blockIdx.x; item < 64 * 32; item += F.G) {
        const int bc = item >> 5, g = item & 31, r0 = bc * 128;
        if (F.tid < 128) {
            const float s1 = VS[2 * (r0 + F.tid)], s2 = VS[2 * (r0 + F.tid) + 1];
            const float mean = s1 * (1.0f / 4096.0f), var = s2 * (1.0f / 4096.0f) - mean * mean;
            rstat[2 * F.tid] = mean; rstat[2 * F.tid + 1] = 1.0f / sqrtf(var + NORM_EPS);
        }
        __syncthreads();
        for (int idx = F.tid; idx < 128 * 128; idx += 512) {
            const int s = idx >> 7, d = idx & 127, col = g * 128 + d;
            const float v = bf1(V[(size_t)(r0 + s) * DM + col]);
            vn[idx] = (v - rstat[2 * s]) * rstat[2 * s + 1] * F.sg_v_gain[col] + F.sg_v_bias[col];
            wsl[idx] = F.sg_w_s[(size_t)g * 16384 + idx];
        }
        __syncthreads();
        for (int idx = F.tid; idx < 128 * 128; idx += 512) {
            const int t = idx >> 7, d = idx & 127;
            float a = 0.f;
            for (int s = 0; s <= t; ++s) a += wsl[t * 128 + s] * vn[s * 128 + d];
            const float f = a + F.sg_b_s[g * 128 + t];
            const size_t o = (size_t)(r0 + t) * DM + g * 128 + d;
            GT[o] = (bf16)f2bf(bf1(U[o]) * f);
        }
        __syncthreads();
    }
}

__device__ __forceinline__ void p_final(Frame& F) {
    const float* H = (const float*)(F.ws + WS_H); const float* SS4 = (const float*)(F.ws + WS_SSQ + 4 * SSQ_SITE);
#ifdef CHECK_ATTN
    const unsigned nbad = __hip_atomic_load(F.ctl + 8, __ATOMIC_RELAXED, __HIP_MEMORY_SCOPE_AGENT);
#endif
    for (int m = F.gw; m < MR; m += F.NGW) {
        float rs = ss_rstd(SS4, m);
#ifdef CHECK_ATTN
        if (nbad > CHECK_ATTN) rs = __builtin_nanf("");
#endif
        const f32x4* hr = (const f32x4*)(H + (size_t)m * DM) + F.lane; const f32x4* gr = (const f32x4*)F.final_norm + F.lane;
        f32x4* orow = (f32x4*)(F.out + (size_t)m * DM) + F.lane;
#pragma unroll 4
        for (int j = 0; j < 16; ++j) orow[64 * j] = hr[64 * j] * rs * gr[64 * j];
    }
}
__device__ __forceinline__ unsigned moba_select(const LAS float* km, const bf16* qrow, int qb) {
    const float NEG = -__builtin_inff();
    if (qb <= 3) return (1u << qb) - 1u;
    float g[16];
#pragma unroll
    for (int j = 0; j < 16; ++j) g[j] = 0.f;
#pragma unroll 1
    for (int c = 0; c < 16; ++c) {
        float q8[8]; unpack8(*(const v4u*)(qrow + 8 * c), q8);
#pragma unroll
        for (int j = 0; j < 16; ++j) {
            const f32x4 k0 = *(const LAS f32x4*)(km + j * 128 + 8 * c), k1 = *(const LAS f32x4*)(km + j * 128 + 8 * c + 4);
            g[j] += q8[0] * k0[0] + q8[1] * k0[1] + q8[2] * k0[2] + q8[3] * k0[3] + q8[4] * k1[0] + q8[5] * k1[1] + q8[6] * k1[2] + q8[7] * k1[3];
        }
    }
#pragma unroll
    for (int j = 0; j < 16; ++j) if (j >= qb) g[j] = NEG;
    unsigned sel = 0u;
#pragma unroll
    for (int rd = 0; rd < 3; ++rd) {
        float best = NEG; unsigned bi = 0u;
#pragma unroll
        for (int j = 0; j < 16; ++j) { const bool take = (((sel >> j) & 1u) == 0u) && (g[j] > best); best = take ? g[j] : best; bi = take ? (unsigned)j : bi; }
        sel |= 1u << bi;
    }
    return sel;
}

typedef att::BlockRef<bf16, bf16> ABR;
#ifndef DIL_SK
#define DIL_SK false
#endif
constexpr int ATT_SEL_OFF = 69632, ATT_KM_OFF = 73728;
__device__ __forceinline__ void moba_unit(int vc, int i, int& bh, int& qb) {
    const int grp = vc >> 4, a = vc & 15;
    const unsigned long long PB = 0x24310cbfed5a9687ull, PC = 0x6579b13024c8aedfull;
    qb = i == 0 ? a : (i == 1 ? (int)((PB >> (4 * a)) & 15ull) : (int)((PC >> (4 * a)) & 15ull));
    bh = 3 * grp + i;
}
__device__ __forceinline__ ABR moba_ref(const Frame& F, int vc, int i, const LAS unsigned short* selL) {
    int bh, qb; moba_unit(vc, i, bh, qb);
    const int b = bh / NHA, h = bh - NHA * b;
    const bf16* QKV = (const bf16*)(F.ws + WS_QKV);
    ABR r;
    r.Q = QKV + ((size_t)((0 * 2 + b) * NHQ + h) * NS + 256 * qb) * HD;
    r.K = QKV + (size_t)((1 * 2 + b) * NHQ + h) * NS * HD;
    r.V = QKV + (size_t)((2 * 2 + b) * NHQ + h) * NS * HD;
    r.O = (bf16*)(F.ws + WS_O) + (size_t)(b * NS + 256 * qb) * DM + h * HD;
    r.P0 = 256 * qb;
    r.sel = selL + 256 * i; r.L = nullptr;
    return r;
}
__device__ __forceinline__ ABR dil_ref(const Frame& F, int vc, int g) {
    const int bhh = vc >> 4, b = bhh >> 3, hh = bhh & 7, lo = vc & 15;
    const int dil = g == 0 ? 1 : (g == 1 ? 4 : 16);
    const int res = g == 0 ? 0 : (g == 1 ? (lo >> 2) : lo), blk = g == 0 ? lo : (g == 1 ? (lo & 3) : 0);
    const int head = NHA + 8 * g + hh, pos0 = res + dil * 256 * blk;
    const bf16* QKV = (const bf16*)(F.ws + WS_QKV);
    ABR r;
    r.Q = QKV + ((size_t)((0 * 2 + b) * NHQ + head) * NS + pos0) * HD;
    r.K = QKV + ((size_t)((1 * 2 + b) * NHQ + head) * NS + res) * HD;
    r.V = QKV + ((size_t)((2 * 2 + b) * NHQ + head) * NS + res) * HD;
    r.O = (bf16*)(F.ws + WS_DO) + (size_t)(b * NS + pos0) * 3072 + g * 1024 + hh * HD;
    r.P0 = 256 * blk;
    r.sel = nullptr; r.L = (float*)(F.ws + WS_LSE) + (size_t)(b * NS + pos0) * 24 + g * 8 + hh;
    return r;
}
__device__ __forceinline__ void p_attn(Frame& F, char* lds) {
    for (int vc = blockIdx.x; vc < 256; vc += F.G) {
#ifndef NO_MOBA
        {
            const bf16* QKVq = (const bf16*)(F.ws + WS_QKV); const float* KM = (const float*)(F.ws + WS_KMEAN);
            LAS float* kmL = (LAS float*)(F.lds + RING_OFF + ATT_KM_OFF); LAS unsigned short* selW = (LAS unsigned short*)(F.lds + RING_OFF + ATT_SEL_OFF);
            const LAS unsigned short* selL = selW;
#ifndef NO_GATEPRE
            for (int idx = F.tid; idx < 3 * 2048; idx += 512) { int bh, qb; moba_unit(vc, idx >> 11, bh, qb); kmL[idx] = KM[(size_t)bh * 2048 + (idx & 2047)]; }
            __syncthreads();
            for (int qi = F.tid; qi < 768; qi += 512) { int bh, qb; moba_unit(vc, qi >> 8, bh, qb); const int b = bh / NHA, h = bh - NHA * b;
                selW[qi] = (unsigned short)moba_select(kmL + (qi >> 8) * 2048, QKVq + ((size_t)((0 * 2 + b) * NHQ + h) * NS + 256 * qb + (qi & 255)) * HD, qb); }
            __syncthreads();
#endif
            asm volatile("" ::: "memory");
            int vcb = vc; asm volatile("" : "+s"(vcb));
            att::Seam<bf16> S;
            constexpr int WM = 1 << 30;
            ABR cur = moba_ref(F, vcb, 0, selL);
            att::causal_swa_prime<bf16, bf16, 128, WM>(cur, lds, S);
            for (int i = 0; i < 3; ++i) {
                const ABR nxt = moba_ref(F, vcb, i < 2 ? i + 1 : 2, selL);
                att::causal_swa_block<bf16, bf16, false, 0, 128, 128, DM, WM, WM, NS>(cur, nxt, lds, S);
                cur = nxt;
            }
        }
#endif
    }
    for (int vc = blockIdx.x; vc < 256; vc += F.G) {
#ifndef NO_DIL
        {
            att::Seam<bf16> S;
            const ABR r0 = dil_ref(F, vc, 0), r1 = dil_ref(F, vc, 1), r2 = dil_ref(F, vc, 2);
            att::causal_swa_prime<bf16, bf16, 128, 129>(r0, lds, S);
            att::causal_swa_block<bf16, bf16, DIL_SK, 1, 128, 512, 3072, 129, 129, NS>(r0, r1, lds, S);
            att::causal_swa_block<bf16, bf16, DIL_SK, 1, 512, 2048, 4 * 3072, 129, 129, NS / 4>(r1, r2, lds, S);
            att::causal_swa_block<bf16, bf16, DIL_SK, 1, 2048, 2048, 16 * 3072, 129, 129, NS / 16>(r2, r2, lds, S);
        }
#endif
    }
}
__device__ __forceinline__ void p_dilmerge(Frame& F) {
    const bf16* DO = (const bf16*)(F.ws + WS_DO); const float* LSE = (const float*)(F.ws + WS_LSE); bf16* O = (bf16*)(F.ws + WS_O);
    const size_t total = (size_t)MR * 8 * 16;
    for (size_t idx = (size_t)blockIdx.x * 512 + F.tid; idx < total; idx += (size_t)F.G * 512) {
        const int r = (int)(idx >> 7), hh = (int)(idx >> 4) & 7, c8 = (int)idx & 15;
        const float l0 = LSE[(size_t)r * 24 + hh], l1 = LSE[(size_t)r * 24 + 8 + hh], l2 = LSE[(size_t)r * 24 + 16 + hh];
        const float ml = fmaxf(fmaxf(l0, l1), l2);
        float w0 = __expf(l0 - ml), w1 = __expf(l1 - ml), w2 = __expf(l2 - ml); const float wi = 1.0f / (w0 + w1 + w2); w0 *= wi; w1 *= wi; w2 *= wi;
        float a0[8], a1[8], a2[8];
        unpack8(*(const v4u*)(DO + (size_t)r * 3072 + hh * HD + c8 * 8), a0);
        unpack8(*(const v4u*)(DO + (size_t)r * 3072 + 1024 + hh * HD + c8 * 8), a1);
        unpack8(*(const v4u*)(DO + (size_t)r * 3072 + 2048 + hh * HD + c8 * 8), a2);
        float o[8];
#pragma unroll
        for (int e = 0; e < 8; ++e) o[e] = w0 * a0[e] + w1 * a1[e] + w2 * a2[e];
        v4u w; w.x = pk2(o[0], o[1]); w.y = pk2(o[2], o[3]); w.z = pk2(o[4], o[5]); w.w = pk2(o[6], o[7]);
        *(v4u*)(O + (size_t)r * DM + (NHA + hh) * HD + c8 * 8) = w;
    }
}
__device__ __forceinline__ void p_convfix(Frame& F, int layer) {
    const float* top = (const float*)(F.ws + WS_TOP); const float* bot = (const float*)(F.ws + WS_BOT); bf16* Gb = (bf16*)(F.ws + WS_G);
    const float* cw = F.ffn_conv_w + (size_t)layer * 3 * F2; const float* cb = F.ffn_conv_b + (size_t)layer * F2;
    constexpr int C4 = DFF / 4, NIT = 30 * C4;
    for (int idx = blockIdx.x * 512 + F.tid; idx < NIT; idx += F.G * 512) {
        const int pmi = idx / C4, j0 = (idx - pmi * C4) * 4, pm = pmi + 1 + (pmi >= 15 ? 1 : 0);
        f32x4 c0[2], c1[2];
#pragma unroll
        for (int bj = 0; bj < 2; ++bj) {
            const int col = bj * DFF + j0;
            const f32x4 w0 = *(const f32x4*)(cw + col), w1 = *(const f32x4*)(cw + F2 + col), w2 = *(const f32x4*)(cw + 2 * F2 + col), bb = *(const f32x4*)(cb + col);
            const f32x4 am2 = *(const f32x4*)(bot + (size_t)((pm - 1) * 2 + 0) * F2 + col), am1 = *(const f32x4*)(bot + (size_t)((pm - 1) * 2 + 1) * F2 + col);
            const f32x4 a0 = *(const f32x4*)(top + (size_t)(pm * 2 + 0) * F2 + col), a1 = *(const f32x4*)(top + (size_t)(pm * 2 + 1) * F2 + col);
            c0[bj] = bb + w0 * am2 + w1 * am1 + w2 * a0;
            c1[bj] = bb + w0 * am1 + w1 * a0 + w2 * a1;
        }
        v2u o0, o1;
        o0.x = pk2(silu_f(c0[0][0]) * c0[1][0], silu_f(c0[0][1]) * c0[1][1]); o0.y = pk2(silu_f(c0[0][2]) * c0[1][2], silu_f(c0[0][3]) * c0[1][3]);
        o1.x = pk2(silu_f(c1[0][0]) * c1[1][0], silu_f(c1[0][1]) * c1[1][1]); o1.y = pk2(silu_f(c1[0][2]) * c1[1][2], silu_f(c1[0][3]) * c1[1][3]);
        *(v2u*)(Gb + (size_t)(pm * 256) * DFF + j0) = o0;
        *(v2u*)(Gb + (size_t)(pm * 256 + 1) * DFF + j0) = o1;
    }
}

__device__ __forceinline__ void p_sgate(Frame& F) {
    typedef short bf16x8 __attribute__((ext_vector_type(8))); typedef float f32x16 __attribute__((ext_vector_type(16)));
    const bf16* U = (const bf16*)(F.ws + WS_U); const bf16* V = (const bf16*)(F.ws + WS_V); const float* VS = (const float*)(F.ws + WS_VSQ); bf16* GT = (bf16*)(F.ws + WS_O);
    constexpr int PT = 136;
    LAS bf16* Wc = (LAS bf16*)(F.lds + RING_OFF);
    LAS bf16* vnT = Wc + 128 * PT;
    LAS float* rstat = (LAS float*)(F.lds + RING_OFF + 2 * 128 * PT * 2);
    const int lane = F.lane, r32 = lane & 31, hi = lane >> 5, tb = F.wave >> 1, dh = F.wave & 1;
    int gcur = -1;
    for (int item = blockIdx.x; item < 64 * 32; item += F.G) {
        const int g = item & 31, bc = item >> 5, r0 = bc * 128;
        if (g != gcur) {
            for (int idx = F.tid; idx < 128 * 32; idx += 512) { const int t = idx >> 5, s4 = (idx & 31) * 4;
                const f32x4 w = *(const f32x4*)(F.sg_w_s + (size_t)g * 16384 + t * 128 + s4);
                v2u o; o.x = pk2(s4 <= t ? w[0] : 0.f, s4 + 1 <= t ? w[1] : 0.f); o.y = pk2(s4 + 2 <= t ? w[2] : 0.f, s4 + 3 <= t ? w[3] : 0.f);
                *(LAS v2u*)(Wc + t * PT + s4) = o; }
            gcur = g;
        }
        if (F.tid < 128) { const float s1 = VS[2 * (r0 + F.tid)], s2 = VS[2 * (r0 + F.tid) + 1];
            const float mean = s1 * (1.0f / 4096.0f), var = s2 * (1.0f / 4096.0f) - mean * mean;
            rstat[2 * F.tid] = mean; rstat[2 * F.tid + 1] = 1.0f / sqrtf(var + NORM_EPS); }
        __syncthreads();
        { const int d8 = (F.tid & 15) * 8, col = g * 128 + d8;
          float gn[8], bs[8];
#pragma unroll
          for (int e = 0; e < 8; ++e) { gn[e] = F.sg_v_gain[col + e]; bs[e] = F.sg_v_bias[col + e]; }
          for (int s = F.tid >> 4; s < 128; s += 32) {
              float v8[8]; unpack8(*(const v4u*)(V + (size_t)(r0 + s) * DM + col), v8);
              const float mean = rstat[2 * s], rstd = rstat[2 * s + 1];
#pragma unroll
              for (int e = 0; e < 8; ++e) vnT[(d8 + e) * PT + s] = (bf16)f2bf((v8[e] - mean) * rstd * gn[e] + bs[e]);
          } }
        __syncthreads();
        f32x16 acc0 = {}, acc1 = {};
        const LAS bf16* ap = Wc + (32 * tb + r32) * PT + 8 * hi;
        const LAS bf16* bp0 = vnT + (64 * dh + r32) * PT + 8 * hi, * bp1 = bp0 + 32 * PT;
        for (int ks = 0; ks < 2 * tb + 2; ++ks) {
            const bf16x8 a = *(const LAS bf16x8*)(ap + 16 * ks), b0 = *(const LAS bf16x8*)(bp0 + 16 * ks), b1 = *(const LAS bf16x8*)(bp1 + 16 * ks);
            acc0 = __builtin_amdgcn_mfma_f32_32x32x16_bf16(a, b0, acc0, 0, 0, 0);
            acc1 = __builtin_amdgcn_mfma_f32_32x32x16_bf16(a, b1, acc1, 0, 0, 0);
        }
#pragma unroll
        for (int i = 0; i < 16; ++i) {
            const int t = 32 * tb + (i & 3) + 8 * (i >> 2) + 4 * hi;
            const float bsv = F.sg_b_s[g * 128 + t];
            const size_t o = (size_t)(r0 + t) * DM + g * 128 + 64 * dh + r32;
            GT[o] = (bf16)f2bf(bf1(U[o]) * (acc0[i] + bsv));
            GT[o + 32] = (bf16)f2bf(bf1(U[o + 32]) * (acc1[i] + bsv));
        }
        __syncthreads();
    }
}
constexpr int N_PHASES = 15;
struct Args { const void* in[19]; float* out; unsigned char* ws; int ph_lo, ph_hi, li, pad; };
__global__ void __launch_bounds__(NWAVES * 64, 2) mk_fwd(Args args) {
    extern __shared__ __attribute__((aligned(16))) unsigned char lds[];
    Frame F;
    F.lds = (LAS unsigned char*)lds;
    F.MISC = (volatile LAS unsigned*)(F.lds + MISC_OFF);
    F.tid = threadIdx.x; F.lane = F.tid & 63; F.wave = __builtin_amdgcn_readfirstlane(F.tid >> 6);
    F.G = gridDim.x; F.gw = blockIdx.x * NWAVES + F.wave; F.NGW = F.G * NWAVES;
    F.ws = args.ws; F.ctl = (unsigned*)(args.ws + WS_CTL);
    F.x = (const float*)args.in[0]; F.pos = (const int*)args.in[1];
    F.attn_norm = (const float*)args.in[2]; F.attn_w_in = (const float*)args.in[3]; F.attn_w_out = (const float*)args.in[4];
    F.sg_norm = (const float*)args.in[5]; F.sg_w_in = (const float*)args.in[6]; F.sg_b_in = (const float*)args.in[7]; F.sg_v_gain = (const float*)args.in[8]; F.sg_v_bias = (const float*)args.in[9];
    F.sg_w_s = (const float*)args.in[10]; F.sg_b_s = (const float*)args.in[11]; F.sg_w_out = (const float*)args.in[12];
    F.ffn_norm = (const float*)args.in[13]; F.ffn_w_up = (const float*)args.in[14]; F.ffn_conv_w = (const float*)args.in[15]; F.ffn_conv_b = (const float*)args.in[16]; F.ffn_w_down = (const float*)args.in[17];
    F.final_norm = (const float*)args.in[18]; F.out = args.out;
    for (int u = F.tid; u < (XTRA_OFF - LDSCTL_OFF) / 4; u += NWAVES * 64) ((LAS unsigned*)(F.lds + LDSCTL_OFF))[u] = 0u;
    __syncthreads();
    const int lo = args.ph_lo, hi = args.ph_hi;
    XcdBarrier bar; bar.bar = F.ctl + CW_BAR + args.li * XCD_BAR_WORDS; bar.x = 0; bar.st = nullptr;
    if (hi - lo > 1) bar = xcd_barrier_post(F.ctl + CW_BAR + args.li * XCD_BAR_WORDS, F.MISC + 8);
#define IN(k) (lo <= (k) && (k) < hi)
#define SEAM(k) do { if (IN(k) && IN((k) + 1)) xcd_barrier(bar); } while (0)
    unsigned char* ws = args.ws;
    bf16* XB = (bf16*)(ws + WS_XB); float* H = (float*)(ws + WS_H); bf16* O = (bf16*)(ws + WS_O); bf16* Gb = (bf16*)(ws + WS_G); bf16* AP = (bf16*)(ws + WS_APRE);
    float* SS = (float*)(ws + WS_SSQ); constexpr size_t SSF = SSQ_SITE / 4;
    const int c = (int)blockIdx.x;

    if (IN(0)) { p0_prologue(F); } SEAM(0);
    if (IN(1)) {
        pg8::Gemm g{XB, (const bf16*)(ws + WS_WIN), MR, QKVC, DM}; pg8::StaticOrder S; S.init(MR, QKVC, F.G, c);
        pg8::EpiQKV E{(bf16*)(ws + WS_QKV), SS, (const float*)(ws + WS_ROPE), (const float*)(ws + WS_ROPE) + MR * 16, (float*)(ws + WS_KMEAN)};
        pg8::gemm_phase<pg8::EpiQKV, pg8::StaticOrder, PG8_ALIGN, PG8_SP2>(F.lds + RING_OFF, g, S, E);
    } SEAM(1);
    if (IN(2)) { p_attn(F, (char*)lds + RING_OFF); } SEAM(2);
    if (IN(3)) { p_dilmerge(F);
#ifdef CHECK_ATTN
        xcd_barrier(bar); p_attn_naive(F, AP); xcd_barrier(bar);
        { unsigned bad = 0; for (size_t idx = (size_t)blockIdx.x * 512 + F.tid; idx < (size_t)MR * DM; idx += (size_t)F.G * 512) { const float a = bf1(O[idx]), b = bf1(AP[idx]); if (!(fabsf(a - b) <= 0.004f + 0.03f * fabsf(b))) ++bad; }
          if (bad) atomicAdd(F.ctl + 8, bad); }
#endif
    } SEAM(3);
    if (IN(4)) {
        pg8::Gemm g{O, (const bf16*)(ws + WS_WOUT), MR, DM, DM}; pg8::StaticOrder S; S.init(MR, DM, F.G, c);
        pg8::EpiRes E{F.x, H, XB, SS + 1 * SSF};
        pg8::gemm_phase<pg8::EpiRes, pg8::StaticOrder, PG8_ALIGN, PG8_SP2>(F.lds + RING_OFF, g, S, E);
    } SEAM(4);
    if (IN(5)) {
        pg8::Gemm g{XB, (const bf16*)(ws + WS_WUP), MR, F2, DM}; pg8::StaticOrder S; S.init(MR, F2, F.G, c);
        pg8::EpiUpConv E{Gb, SS + 1 * SSF, F.ffn_conv_w, F.ffn_conv_b, (float*)(ws + WS_TOP), (float*)(ws + WS_BOT), (LAS float*)(F.lds + XTRA_OFF)};
        pg8::gemm_phase<pg8::EpiUpConv, pg8::StaticOrder, true, PG8_SP2>(F.lds + RING_OFF, g, S, E);
    } SEAM(5);
    if (IN(6)) { p_convfix(F, 0); } SEAM(6);
    if (IN(7)) {
        pg8::Gemm g{Gb, (const bf16*)(ws + WS_WDOWN), MR, DM, DFF}; pg8::StaticOrder S; S.init(MR, DM, F.G, c);
        pg8::EpiRes E{H, H, XB, SS + 2 * SSF};
        pg8::gemm_phase<pg8::EpiRes, pg8::StaticOrder, PG8_ALIGN, PG8_SP2>(F.lds + RING_OFF, g, S, E);
    } SEAM(7);
    if (IN(8)) {
        pg8::Gemm g{XB, (const bf16*)(ws + WS_SGWIN), MR, 2 * DM, DM}; pg8::StaticOrder S; S.init(MR, 2 * DM, F.G, c);
        pg8::EpiSgIn E{(bf16*)(ws + WS_U), (bf16*)(ws + WS_V), SS + 2 * SSF, F.sg_b_in, (float*)(ws + WS_VSQ)};
        pg8::gemm_phase<pg8::EpiSgIn, pg8::StaticOrder, PG8_ALIGN, PG8_SP2>(F.lds + RING_OFF, g, S, E);
    } SEAM(8);
    if (IN(9)) { p_sgate(F); } SEAM(9);
    if (IN(10)) {
        pg8::Gemm g{O, (const bf16*)(ws + WS_SGWOUT), MR, DM, DM}; pg8::StaticOrder S; S.init(MR, DM, F.G, c);
        pg8::EpiRes E{H, H, XB, SS + 3 * SSF};
        pg8::gemm_phase<pg8::EpiRes, pg8::StaticOrder, PG8_ALIGN, PG8_SP2>(F.lds + RING_OFF, g, S, E);
    } SEAM(10);
    if (IN(11)) {
        pg8::Gemm g{XB, (const bf16*)(ws + WS_WUP + WUP_L), MR, F2, DM}; pg8::StaticOrder S; S.init(MR, F2, F.G, c);
        pg8::EpiUpConv E{Gb, SS + 3 * SSF, F.ffn_conv_w + 3 * F2, F.ffn_conv_b + F2, (float*)(ws + WS_TOP), (float*)(ws + WS_BOT), (LAS float*)(F.lds + XTRA_OFF)};
        pg8::gemm_phase<pg8::EpiUpConv, pg8::StaticOrder, true, PG8_SP2>(F.lds + RING_OFF, g, S, E);
    } SEAM(11);
    if (IN(12)) { p_convfix(F, 1); } SEAM(12);
    if (IN(13)) {
        pg8::Gemm g{Gb, (const bf16*)(ws + WS_WDOWN + WDOWN_L), MR, DM, DFF}; pg8::StaticOrder S; S.init(MR, DM, F.G, c);
        pg8::EpiRes E{H, H, XB, SS + 4 * SSF};
        pg8::gemm_phase<pg8::EpiRes, pg8::StaticOrder, PG8_ALIGN, PG8_SP2>(F.lds + RING_OFF, g, S, E);
    } SEAM(13);
    if (IN(14)) { p_final(F); }
#undef IN
#undef SEAM
}

extern "C" void kernel_launch(void* const* d_in, const int* in_sizes, int n_in, void* d_out, int out_size, void* d_ws, size_t ws_size, hipStream_t stream) {
    static int grid = 0;
    if (grid == 0) {
        if (n_in != 19 || out_size != MR * DM || ws_size < WS_END) { fprintf(stderr, "kernel_launch: unexpected shapes (n_in %d, out %d, ws %zu); nothing launched\n", n_in, out_size, ws_size); grid = -1; return; }
        int dev = 0, cus = 0, per_cu = 0;
        if (hipGetDevice(&dev) != hipSuccess || hipDeviceGetAttribute(&cus, hipDeviceAttributeMultiprocessorCount, dev) != hipSuccess) { grid = -1; return; }
        if (hipFuncSetAttribute((const void*)mk_fwd, hipFuncAttributeMaxDynamicSharedMemorySize, LDS_BYTES) != hipSuccess) { fprintf(stderr, "kernel_launch: hipFuncSetAttribute failed\n"); grid = -1; return; }
        if (hipOccupancyMaxActiveBlocksPerMultiprocessor(&per_cu, (const void*)mk_fwd, NWAVES * 64, LDS_BYTES) != hipSuccess || per_cu < 1) fprintf(stderr, "kernel_launch: occupancy query reports %d\n", per_cu);
        (void)hipGetLastError();
        grid = cus;
    }
    if (grid < 0) return;
    if (hipMemsetAsync((char*)d_ws + WS_CTL, 0, CTL_ZERO_BYTES, stream) != hipSuccess) return;
    Args a{};
    for (int i = 0; i < 19; ++i) a.in[i] = d_in[i];
    a.out = (float*)d_out; a.ws = (unsigned char*)d_ws; a.pad = 0;
    if (MK_N_LAUNCHES == 1) {
        a.ph_lo = 0; a.ph_hi = N_PHASES; a.li = 0;
        hipLaunchKernelGGL(mk_fwd, dim3(grid), dim3(NWAVES * 64), LDS_BYTES, stream, a);
    } else {
        for (int p = 0; p < N_PHASES; ++p) { a.ph_lo = p; a.ph_hi = p + 1; a.li = 0; hipLaunchKernelGGL(mk_fwd, dim3(grid), dim3(NWAVES * 64), LDS_BYTES, stream, a);
#ifdef PROBE_MASK
            if ((PROBE_MASK >> p) & 1) hipLaunchKernelGGL(mk_fwd, dim3(grid), dim3(NWAVES * 64), LDS_BYTES, stream, a);
#endif
        }
    }
}
```

```cpp
#include <hip/hip_runtime.h>
#include <cstdio>
#include <cstdint>
#ifndef MK_N_LAUNCHES
#define MK_N_LAUNCHES 1
#endif
namespace pg8 {
#define PG8_LAS __attribute__((address_space(3)))
typedef unsigned short bf16_t;
typedef short bf16x8 __attribute__((ext_vector_type(8)));
typedef float f32x4 __attribute__((ext_vector_type(4)));
typedef unsigned u32x4 __attribute__((ext_vector_type(4)));
constexpr int BM = 256, BK = 64, HALF = 128, HTB = HALF * BK * 2  , STAGE_BYTES = 8 * HTB, NXCD = 8, WGM = 8;

__host__ __device__ __forceinline__ int lds_byte(int r, int c) { const int st = (r >> 4) * 2 + (c >> 5), rr = r & 15, cc = c & 31, ob = rr * 64 + cc * 2; return st * 1024 + (ob ^ (((ob >> 9) & 1) << 5)); }
__host__ __device__ __forceinline__ void stage_rc(int b, int& R, int& C) { const int st = b / 1024, sb = b % 1024, swz = sb ^ (((sb >> 9) & 1) << 5); R = (st >> 1) * 16 + swz / 64; C = (st & 1) * 32 + (swz % 64) / 2; }
__host__ __device__ __forceinline__ int perm32(int rho) { const int n = rho >> 4, i = rho & 15; return 8 * (i >> 2) + 4 * n + (i & 3); }

struct Unit { int pm, pn; };
struct Gemm { const bf16_t* A; const bf16_t* Bt; int M, N, K; };

struct StaticOrder {
    int nM, nN, nwg, G, c;
    __host__ __device__ void init(int M, int N, int G_, int c_) { nM = M / BM; nN = N / BM; nwg = nM * nN; G = G_; c = c_; }
    __host__ __device__ bool next(int i, Unit& u) const {
        const long L = (long)i * G + c; if (L >= nwg) return false;
        int wgid = (int)L; { const int q = nwg / NXCD, r = nwg % NXCD, xcd = wgid % NXCD, off = wgid / NXCD; wgid = (xcd < r ? xcd * (q + 1) : r * (q + 1) + (xcd - r) * q) + off; }
        const int nig = WGM * nN, gid = wgid / nig, fm = gid * WGM, gsz = (nM - fm) < WGM ? (nM - fm) : WGM;
        u.pm = fm + ((wgid % nig) % gsz); u.pn = (wgid % nig) / gsz; return true;
    }
    __device__ __forceinline__ void a_ready(const Unit&) const {}
    __device__ __forceinline__ void done(const Unit&) const {}
};
__device__ __forceinline__ unsigned cvt_pk_bf16(float lo, float hi) { unsigned r; asm volatile("v_cvt_pk_bf16_f32 %0, %1, %2" : "=v"(r) : "v"(lo), "v"(hi)); return r; }
typedef float f32x2 __attribute__((ext_vector_type(2)));
__device__ __forceinline__ f32x2 gelu_pk(f32x2 v) {
    const f32x2 av = __builtin_elementwise_abs(v), d = av * 0.2316418882f + 1.0f;
    f32x2 t; t.x = __builtin_amdgcn_rcpf(d.x); t.y = __builtin_amdgcn_rcpf(d.y);
    f32x2 q = t * 0.5307027145f + (-0.7265760135f); q = q * t + 0.7107068705f; q = q * t + (-0.142248368f); q = q * t + 0.127414796f; q = q * t;
    const f32x2 s = (v * v) * (-0.72134752044f);
    f32x2 e; e.x = __builtin_amdgcn_exp2f(s.x); e.y = __builtin_amdgcn_exp2f(s.y);
    const f32x2 m = v * (q * e), r = v - m;
    f32x2 o; o.x = v.x < 0.f ? m.x : r.x; o.y = v.y < 0.f ? m.y : r.y; return o;
}
typedef unsigned u32x2 __attribute__((ext_vector_type(2)));
__device__ __forceinline__ float rstd_from_ss(const float* ss, int r) { return 1.0f / sqrtf(ss[r] * (1.0f / 4096.0f) + 1e-5f); }

struct EpiQKV {
    static constexpr bool PERM = false, AFTER_DRAIN = false;
    bf16_t* qkv; const float* ss; const float* ropec; const float* ropes; float* km;
    __device__ __forceinline__ void operator()(const f32x4 (&acc)[2][2][4][2], const Unit& u, int wr, int wc, int fr, int fq) const {
        const int row0 = u.pm * BM + wr * 64 + fr;
        const bool kmu = u.pn >= 24 && u.pn < 36;
        const bool rot = wc == 0 && u.pn < 48;
        f32x4 cs[2][2];
#pragma unroll
        for (int bj = 0; bj < 2; ++bj)
#pragma unroll
            for (int n = 0; n < 2; ++n) cs[bj][n] = (f32x4){0.f, 0.f, 0.f, 0.f};
#pragma unroll
        for (int ai = 0; ai < 2; ++ai) {
            float rs[4]; f32x4 cz[4], sn[4];
#pragma unroll
            for (int m = 0; m < 4; ++m) { const int r = row0 + ai * HALF + m * 16; rs[m] = ss[r];
                cz[m] = (f32x4){1.f, 1.f, 1.f, 1.f}; sn[m] = (f32x4){0.f, 0.f, 0.f, 0.f};
                if (rot) { cz[m] = *(const f32x4*)(ropec + (size_t)r * 16 + 4 * fq); sn[m] = *(const f32x4*)(ropes + (size_t)r * 16 + 4 * fq); } }
#pragma unroll
            for (int m = 0; m < 4; ++m) {
                const int r = row0 + ai * HALF + m * 16;
                const float rsv = 1.0f / sqrtf(rs[m] * (1.0f / 4096.0f) + 1e-5f);
                const int b = r >> 12, s = r & 4095;
#pragma unroll
                for (int bj = 0; bj < 2; ++bj) {
                    const int colh = 2 * u.pn + bj, which = colh / 48, head = colh - which * 48;
                    bf16_t* dst = qkv + ((size_t)((which * 2 + b) * 48 + head) * 4096 + s) * 128 + wc * 32 + 4 * fq;
                    f32x4 v0 = acc[ai][bj][m][0] * rsv, v1 = acc[ai][bj][m][1] * rsv;
                    if (rot) { const f32x4 n0 = v0 * cz[m] - v1 * sn[m], n1 = v1 * cz[m] + v0 * sn[m]; v0 = n0; v1 = n1; }
                    if (kmu) { cs[bj][0] += v0; cs[bj][1] += v1; }
                    u32x2 w0, w1; w0.x = cvt_pk_bf16(v0[0], v0[1]); w0.y = cvt_pk_bf16(v0[2], v0[3]); w1.x = cvt_pk_bf16(v1[0], v1[1]); w1.y = cvt_pk_bf16(v1[2], v1[3]);
                    *(u32x2*)(dst) = w0; *(u32x2*)(dst + 16) = w1;
                }
            }
            asm volatile("" ::: "memory");
        }
        if (kmu) {
            const int b = u.pm >> 4, blk = u.pm & 15;
#pragma unroll
            for (int bj = 0; bj < 2; ++bj) {
                const int head = 2 * u.pn + bj - 48;
                float* dst = km + ((size_t)((b * 24 + head) * 16 + blk)) * 128 + wc * 32 + 4 * fq;
#pragma unroll
                for (int n = 0; n < 2; ++n)
#pragma unroll
                    for (int j = 0; j < 4; ++j) {
                        float v = cs[bj][n][j];
                        v += __shfl_xor(v, 1); v += __shfl_xor(v, 2); v += __shfl_xor(v, 4); v += __shfl_xor(v, 8);
                        if (fr == 0) atomicAdd(dst + 16 * n + j, v * (1.0f / 256.0f));
                    }
            }
        }
    }
};

struct EpiRes {
    static constexpr bool PERM = false, AFTER_DRAIN = false;
    const float* hin; float* hout; bf16_t* xb; float* ss;
    __device__ __forceinline__ void operator()(const f32x4 (&acc)[2][2][4][2], const Unit& u, int wr, int wc, int fr, int fq) const {
        const int row0 = u.pm * BM + wr * 64 + fr, col0 = u.pn * BM + wc * 32 + 4 * fq;
#pragma unroll
        for (int ai = 0; ai < 2; ++ai) {
            f32x4 h[4][2][2];
#pragma unroll
            for (int m = 0; m < 4; ++m)
#pragma unroll
                for (int bj = 0; bj < 2; ++bj)
#pragma unroll
                    for (int n = 0; n < 2; ++n) h[m][bj][n] = *(const f32x4*)(hin + (size_t)(row0 + ai * HALF + m * 16) * 4096 + col0 + bj * HALF + n * 16);
#pragma unroll
            for (int m = 0; m < 4; ++m) {
                const int r = row0 + ai * HALF + m * 16; const size_t off = (size_t)r * 4096 + col0;
                float sq = 0.f;
#pragma unroll
                for (int bj = 0; bj < 2; ++bj)
#pragma unroll
                    for (int n = 0; n < 2; ++n) {
                        const f32x4 hv = h[m][bj][n] + acc[ai][bj][m][n];
                        *(f32x4*)(hout + off + bj * HALF + n * 16) = hv;
                        u32x2 w; w.x = cvt_pk_bf16(hv[0], hv[1]); w.y = cvt_pk_bf16(hv[2], hv[3]);
                        *(u32x2*)(xb + off + bj * HALF + n * 16) = w;
                        sq += (hv[0] * hv[0] + hv[1] * hv[1]) + (hv[2] * hv[2] + hv[3] * hv[3]);
                    }
                sq += __shfl_xor(sq, 16); sq += __shfl_xor(sq, 32);
                if (fq == 0) atomicAdd(ss + r, sq);
            }
            asm volatile("" ::: "memory");
        }
    }
};

struct EpiUpPre {
    static constexpr bool PERM = true, AFTER_DRAIN = false;
    bf16_t* apre; const float* ss;
    __device__ __forceinline__ void operator()(const f32x4 (&acc)[2][2][4][2], const Unit& u, int wr, int wc, int fr, int fq) const {
        const int row0 = u.pm * BM + wr * 64 + fr, col0 = u.pn * 128 + wc * 32 + 8 * fq;
#pragma unroll
        for (int ai = 0; ai < 2; ++ai)
#pragma unroll
            for (int m = 0; m < 4; ++m) {
                const int r = row0 + ai * HALF + m * 16;
                const float rs = rstd_from_ss(ss, r);
                bf16_t* rowp = apre + (size_t)r * 28672 + col0;
#pragma unroll
                for (int bj = 0; bj < 2; ++bj) {
                    const f32x4 v0 = acc[ai][bj][m][0] * rs, v1 = acc[ai][bj][m][1] * rs;
                    u32x4 w; w.x = cvt_pk_bf16(v0[0], v0[1]); w.y = cvt_pk_bf16(v0[2], v0[3]); w.z = cvt_pk_bf16(v1[0], v1[1]); w.w = cvt_pk_bf16(v1[2], v1[3]);
                    *(u32x4*)(rowp + bj * 14336) = w;
                }
                asm volatile("" ::: "memory");
            }
    }
};

struct EpiSgIn {
    static constexpr bool PERM = true, AFTER_DRAIN = false;
    bf16_t* U; bf16_t* V; const float* ss; const float* bias; float* vs;
    __device__ __forceinline__ void operator()(const f32x4 (&acc)[2][2][4][2], const Unit& u, int wr, int wc, int fr, int fq) const {
        const int row0 = u.pm * BM + wr * 64 + fr, gcol0 = u.pn * BM + wc * 32 + 8 * fq;
        const bool isv = u.pn >= 16;
        bf16_t* base = isv ? V : U; const int col0 = isv ? gcol0 - 4096 : gcol0;
        f32x4 bv[2][2];
#pragma unroll
        for (int bj = 0; bj < 2; ++bj)
#pragma unroll
            for (int n = 0; n < 2; ++n) bv[bj][n] = *(const f32x4*)(bias + gcol0 + bj * HALF + 4 * n);
        float rsq[2][4];
#pragma unroll
        for (int ai = 0; ai < 2; ++ai)
#pragma unroll
            for (int m = 0; m < 4; ++m) rsq[ai][m] = ss[row0 + ai * HALF + m * 16];
#pragma unroll
        for (int ai = 0; ai < 2; ++ai)
#pragma unroll
            for (int m = 0; m < 4; ++m) {
                const int r = row0 + ai * HALF + m * 16;
                const float rs = 1.0f / sqrtf(rsq[ai][m] * (1.0f / 4096.0f) + 1e-5f);
                bf16_t* rowp = base + (size_t)r * 4096 + col0;
                float s1 = 0.f, s2 = 0.f;
#pragma unroll
                for (int bj = 0; bj < 2; ++bj) {
                    f32x4 v0 = acc[ai][bj][m][0] * rs + bv[bj][0], v1 = acc[ai][bj][m][1] * rs + bv[bj][1];
                    const f32x2 a = gelu_pk((f32x2){v0[0], v0[1]}), b = gelu_pk((f32x2){v0[2], v0[3]}), c = gelu_pk((f32x2){v1[0], v1[1]}), d = gelu_pk((f32x2){v1[2], v1[3]});
                    s1 += (a.x + a.y) + (b.x + b.y) + (c.x + c.y) + (d.x + d.y);
                    s2 += (a.x * a.x + a.y * a.y) + (b.x * b.x + b.y * b.y) + (c.x * c.x + c.y * c.y) + (d.x * d.x + d.y * d.y);
                    u32x4 w; w.x = cvt_pk_bf16(a.x, a.y); w.y = cvt_pk_bf16(b.x, b.y); w.z = cvt_pk_bf16(c.x, c.y); w.w = cvt_pk_bf16(d.x, d.y);
                    *(u32x4*)(rowp + bj * HALF) = w;
                }
                if (isv) {
                    s1 += __shfl_xor(s1, 16); s1 += __shfl_xor(s1, 32); s2 += __shfl_xor(s2, 16); s2 += __shfl_xor(s2, 32);
                    if (fq == 0) { atomicAdd(vs + 2 * r, s1); atomicAdd(vs + 2 * r + 1, s2); }
                }
            }
    }
};

#define PG8_DPP(oldv, srcv, ctrl) __builtin_bit_cast(float, __builtin_amdgcn_update_dpp(__builtin_bit_cast(int, (float)(oldv)), __builtin_bit_cast(int, (float)(srcv)), (ctrl), 0xf, 0xf, false))
struct EpiUpConv {
    static constexpr bool PERM = true, AFTER_DRAIN = false;
    bf16_t* G; const float* ss; const float* cw; const float* cb; float* top; float* bot; PG8_LAS float* xch;
    __device__ __forceinline__ static float silu(float x) { return x * __builtin_amdgcn_rcpf(1.0f + __builtin_amdgcn_exp2f(-1.4426950408889634f * x)); }
    __device__ __forceinline__ void operator()(const f32x4 (&acc)[2][2][4][2], const Unit& u, int wr, int wc, int fr, int fq) const {
        const int row0 = u.pm * BM + wr * 64 + fr, colg = u.pn * 128 + wc * 32 + 8 * fq;
        float rs[2][4];
#pragma unroll
        for (int ai = 0; ai < 2; ++ai)
#pragma unroll
            for (int m = 0; m < 4; ++m) rs[ai][m] = ss[row0 + ai * HALF + m * 16];
        PG8_LAS float* wl = xch + 2048;
        { const int t = (int)threadIdx.x, arr = t >> 7, c2 = (t & 127) * 2, gcol = (c2 < 128 ? 0 : 14336 - 128) + u.pn * 128 + c2;
          const f32x2 wv = *(const f32x2*)((arr < 3 ? cw + arr * 28672 : cb) + gcol);
          *(PG8_LAS f32x2*)(wl + arr * 256 + c2) = wv; }
#pragma unroll
        for (int ai = 0; ai < 2; ++ai)
#pragma unroll
            for (int m = 0; m < 4; ++m) rs[ai][m] = 1.0f / sqrtf(rs[ai][m] * (1.0f / 4096.0f) + 1e-5f);
#pragma unroll
        for (int ai = 0; ai < 2; ++ai)
#pragma unroll
            for (int bj = 0; bj < 2; ++bj)
#pragma unroll
                for (int n = 0; n < 2; ++n) {
                    const f32x4 v = acc[ai][bj][3][n] * rs[ai][3];
                    if (fr >= 14) {
                        *(PG8_LAS f32x4*)(xch + ((((((ai * 2 + wr) * 4 + wc) * 2 + bj) * 2 + n) * 4 + fq) * 2 + (fr - 14)) * 4) = v;
                        if (ai == 1 && wr == 1) *(f32x4*)(bot + ((size_t)(u.pm * 2 + (fr - 14)) * 28672) + bj * 14336 + colg + 4 * n) = v;
                    }
                }
        if (wr == 0 && fr < 2) {
#pragma unroll
            for (int bj = 0; bj < 2; ++bj)
#pragma unroll
                for (int n = 0; n < 2; ++n) *(f32x4*)(top + ((size_t)(u.pm * 2 + fr) * 28672) + bj * 14336 + colg + 4 * n) = acc[0][bj][0][n] * rs[0][0];
        }
        asm volatile("s_waitcnt lgkmcnt(0)" ::: "memory"); __builtin_amdgcn_s_barrier(); asm volatile("" ::: "memory");
#pragma unroll
        for (int n = 0; n < 2; ++n) {
            f32x4 w0[2], w1[2], w2[2], cbv[2];
#pragma unroll
            for (int bj = 0; bj < 2; ++bj) { const int lc = bj * 128 + wc * 32 + 8 * fq + 4 * n;
                w0[bj] = *(const PG8_LAS f32x4*)(wl + lc); w1[bj] = *(const PG8_LAS f32x4*)(wl + 256 + lc); w2[bj] = *(const PG8_LAS f32x4*)(wl + 512 + lc); cbv[bj] = *(const PG8_LAS f32x4*)(wl + 768 + lc); }
#pragma unroll
            for (int ai = 0; ai < 2; ++ai) {
                f32x4 prev[2];
                const bool has = !(ai == 0 && wr == 0);
                const int pai = wr == 1 ? ai : 0, pwr = wr == 1 ? 0 : 1;
#pragma unroll
                for (int bj = 0; bj < 2; ++bj) {
                    prev[bj] = (f32x4){0.f, 0.f, 0.f, 0.f};
                    if (has && fr >= 14) prev[bj] = *(const PG8_LAS f32x4*)(xch + ((((((pai * 2 + pwr) * 4 + wc) * 2 + bj) * 2 + n) * 4 + fq) * 2 + (fr - 14)) * 4);
                }
#pragma unroll
                for (int m = 0; m < 4; ++m) {
                    f32x4 cv[2];
#pragma unroll
                    for (int bj = 0; bj < 2; ++bj) {
                        const f32x4 cur = acc[ai][bj][m][n] * rs[ai][m];
#pragma unroll
                        for (int j = 0; j < 4; ++j) {
                            const float r1 = PG8_DPP(0.f, prev[bj][j], 0x121), r2 = PG8_DPP(0.f, prev[bj][j], 0x122);
                            const float p1 = PG8_DPP(r1, cur[j], 0x111), p2 = PG8_DPP(r2, cur[j], 0x112);
                            cv[bj][j] = cbv[bj][j] + w0[bj][j] * p2 + w1[bj][j] * p1 + w2[bj][j] * cur[j];
                        }
                        prev[bj] = cur;
                    }
                    u32x2 w; w.x = cvt_pk_bf16(silu(cv[0][0]) * cv[1][0], silu(cv[0][1]) * cv[1][1]); w.y = cvt_pk_bf16(silu(cv[0][2]) * cv[1][2], silu(cv[0][3]) * cv[1][3]);
                    *(u32x2*)(G + (size_t)(row0 + ai * HALF + m * 16) * 14336 + colg + 4 * n) = w;
                    asm volatile("" ::: "memory");
                }
            }
            asm volatile("" ::: "memory");
        }
    }
};
template <class Epi, class Sched, bool ALIGN_EPI = false, bool SP2 = false>
__device__ __forceinline__ void gemm_phase(PG8_LAS unsigned char* lds, const Gemm g, const Sched& S, const Epi& E) {
    const int tid = threadIdx.x, wid = __builtin_amdgcn_readfirstlane(tid >> 6), lane = tid & 63, wr = wid >> 2, wc = wid & 3, fr = lane & 15, fq = lane >> 4;
    const int K = g.K, nt = K / BK;
    unsigned voffA[2], voffB[2];
#pragma unroll
    for (int i = 0; i < 2; ++i) { int R, C; stage_rc(tid * 16 + i * 8192, R, C); const int Rb = Epi::PERM ? ((R & ~31) + perm32(R & 31)) : R;
        voffA[i] = (unsigned)(R * K + C) * 2u; voffB[i] = (unsigned)(Rb * K + C) * 2u; }
    const size_t kstep = (size_t)(BK * 2);
    const size_t hstep = (size_t)HALF * K * 2;
    const size_t tstep = 2 * hstep;
    const unsigned ldsw = (unsigned)wid * 1024u;
    const int aoff = lds_byte(wr * 64 + fr, fq * 8), boff = lds_byte(wc * 32 + fr, fq * 8);
#define PG8_SA(b, h) (((b) * 2 + (h)) * HTB)
#define PG8_SB(b, h) ((4 + (b) * 2 + (h)) * HTB)
#define PG8_STAGE(bufoff, gbase, voff) do { _Pragma("unroll") for (int _i = 0; _i < 2; ++_i) \
        __builtin_amdgcn_global_load_lds((const unsigned*)((const char*)(gbase) + (voff)[_i]), (PG8_LAS unsigned*)(lds + (bufoff) + ldsw + _i * 8192), 16, 0, 0); } while (0)
#define PG8_LDA(dst, b, h) do { _Pragma("unroll") for (int m = 0; m < 4; ++m) _Pragma("unroll") for (int k = 0; k < 2; ++k) dst[m][k] = *(const PG8_LAS bf16x8*)(lds + PG8_SA(b, h) + aoff + m * 2048 + k * 1024); } while (0)
#define PG8_LDB(dst, b, h) do { _Pragma("unroll") for (int n = 0; n < 2; ++n) _Pragma("unroll") for (int k = 0; k < 2; ++k) dst[n][k] = *(const PG8_LAS bf16x8*)(lds + PG8_SB(b, h) + boff + n * 2048 + k * 1024); } while (0)
#define PG8_MMA(ai, bj, At, Bt) do { __builtin_amdgcn_s_setprio(1); _Pragma("unroll") for (int m = 0; m < 4; ++m) _Pragma("unroll") for (int n = 0; n < 2; ++n) _Pragma("unroll") for (int k = 0; k < 2; ++k) \
        acc[ai][bj][m][n] = __builtin_amdgcn_mfma_f32_16x16x32_bf16(Bt[n][k], At[m][k], acc[ai][bj][m][n], 0, 0, 0); __builtin_amdgcn_s_setprio(0); } while (0)
#define PG8_WAIT_V(n) asm volatile("s_waitcnt vmcnt(" #n ")" ::: "memory")
#define PG8_WAIT_L(n) asm volatile("s_waitcnt lgkmcnt(" #n ")" ::: "memory")
#define PG8_BAR __builtin_amdgcn_s_barrier()
#define PG8_SCHED __builtin_amdgcn_sched_barrier(0)
    Unit cur, nxt; int ui = 0;
    if (!S.next(0, cur)) return;
    f32x4 acc[2][2][4][2];
#pragma unroll
    for (int a = 0; a < 2; ++a)
#pragma unroll
        for (int b = 0; b < 2; ++b)
#pragma unroll
            for (int m = 0; m < 4; ++m)
#pragma unroll
                for (int n = 0; n < 2; ++n) acc[a][b][m][n] = (f32x4){0.f, 0.f, 0.f, 0.f};
    bf16x8 At[4][2], B0[2][2], B1[2][2];
    const char* cA = (const char*)g.A + (size_t)cur.pm * tstep; const char* cB = (const char*)g.Bt + (size_t)cur.pn * tstep;
    S.a_ready(cur);
    if constexpr (SP2) {
        PG8_STAGE(PG8_SB(0, 0), cB, voffB); PG8_STAGE(PG8_SB(0, 1), cB + hstep, voffB); PG8_STAGE(PG8_SA(0, 0), cA, voffA); PG8_STAGE(PG8_SA(0, 1), cA + hstep, voffA);
        if (wr == 1) PG8_BAR;
        PG8_WAIT_V(2); PG8_BAR;
        PG8_STAGE(PG8_SB(1, 0), cB + kstep, voffB); PG8_STAGE(PG8_SA(1, 0), cA + kstep, voffA); PG8_STAGE(PG8_SB(1, 1), cB + hstep + kstep, voffB);
        PG8_WAIT_V(6); PG8_BAR;
    } else {
        PG8_STAGE(PG8_SB(0, 0), cB, voffB); PG8_STAGE(PG8_SA(0, 0), cA, voffA); PG8_STAGE(PG8_SB(0, 1), cB + hstep, voffB); PG8_STAGE(PG8_SA(0, 1), cA + hstep, voffA);
        if (wr == 1) PG8_BAR;
        PG8_WAIT_V(4); PG8_BAR;
        PG8_STAGE(PG8_SB(1, 0), cB + kstep, voffB); PG8_STAGE(PG8_SA(1, 0), cA + kstep, voffA); PG8_STAGE(PG8_SB(1, 1), cB + hstep + kstep, voffB);
        PG8_WAIT_V(6); PG8_BAR;
    }
    for (;;) {
        const bool has_next = S.next(ui + 1, nxt);
        const char* nA = has_next ? (const char*)g.A + (size_t)nxt.pm * tstep : cA; const char* nB = has_next ? (const char*)g.Bt + (size_t)nxt.pn * tstep : cB;
        for (int t = 0; t < nt; t += 2) {
            const bool last = (t == nt - 2);
            const char* a1 = cA + (size_t)(t + 1) * kstep;
            const char* a2 = last ? nA : cA + (size_t)(t + 2) * kstep; const char* b2 = last ? nB : cB + (size_t)(t + 2) * kstep;
            const char* a3 = a2 + kstep; const char* b3 = b2 + kstep;
            if (last && has_next) S.a_ready(nxt);
            if constexpr (SP2) {
            PG8_LDB(B0, 0, 0); PG8_LDB(B1, 0, 1); PG8_SCHED; PG8_LDA(At, 0, 0); PG8_STAGE(PG8_SA(1, 1), a1 + hstep, voffA);
            PG8_WAIT_V(8); PG8_WAIT_L(0); PG8_BAR; PG8_MMA(0, 0, At, B0); PG8_MMA(0, 1, At, B1); PG8_BAR; PG8_SCHED;
            PG8_LDA(At, 0, 1); PG8_STAGE(PG8_SB(0, 0), b2, voffB); PG8_STAGE(PG8_SB(0, 1), b2 + hstep, voffB); PG8_STAGE(PG8_SA(0, 0), a2, voffA);
            PG8_WAIT_V(8); PG8_WAIT_L(0); PG8_BAR; PG8_MMA(1, 0, At, B0); PG8_MMA(1, 1, At, B1); PG8_BAR; PG8_SCHED;
            PG8_LDB(B0, 1, 0); PG8_LDB(B1, 1, 1); PG8_SCHED; PG8_LDA(At, 1, 0); PG8_STAGE(PG8_SA(0, 1), a2 + hstep, voffA);
            PG8_WAIT_V(8); PG8_WAIT_L(0); PG8_BAR; PG8_MMA(0, 0, At, B0); PG8_MMA(0, 1, At, B1); PG8_BAR; PG8_SCHED;
            PG8_LDA(At, 1, 1); PG8_STAGE(PG8_SB(1, 0), b3, voffB); PG8_STAGE(PG8_SB(1, 1), b3 + hstep, voffB); PG8_STAGE(PG8_SA(1, 0), a3, voffA);
            PG8_WAIT_V(8); PG8_WAIT_L(0); PG8_BAR; PG8_MMA(1, 0, At, B0); PG8_MMA(1, 1, At, B1); PG8_BAR; PG8_SCHED;
            } else {
            PG8_LDB(B0, 0, 0); PG8_SCHED; PG8_LDA(At, 0, 0); PG8_STAGE(PG8_SA(1, 1), a1 + hstep, voffA);
            PG8_WAIT_L(8); PG8_BAR; PG8_WAIT_L(0); PG8_MMA(0, 0, At, B0); PG8_BAR; PG8_SCHED;
            PG8_LDB(B1, 0, 1); PG8_STAGE(PG8_SB(0, 0), b2, voffB);
            PG8_BAR; PG8_WAIT_L(0); PG8_MMA(0, 1, At, B1); PG8_BAR;
            PG8_LDA(At, 0, 1); PG8_STAGE(PG8_SA(0, 0), a2, voffA);
            PG8_BAR; PG8_WAIT_L(0); PG8_MMA(1, 0, At, B0); PG8_BAR; PG8_SCHED;
            PG8_STAGE(PG8_SB(0, 1), b2 + hstep, voffB);
            PG8_WAIT_V(6); PG8_BAR; PG8_MMA(1, 1, At, B1); PG8_BAR;
            PG8_LDB(B0, 1, 0); PG8_SCHED; PG8_LDA(At, 1, 0); PG8_STAGE(PG8_SA(0, 1), a2 + hstep, voffA);
            PG8_WAIT_L(8); PG8_BAR; PG8_WAIT_L(0); PG8_MMA(0, 0, At, B0); PG8_BAR; PG8_SCHED;
            PG8_LDB(B1, 1, 1); PG8_STAGE(PG8_SB(1, 0), b3, voffB);
            PG8_BAR; PG8_WAIT_L(0); PG8_MMA(0, 1, At, B1); PG8_BAR;
            PG8_LDA(At, 1, 1); PG8_STAGE(PG8_SA(1, 0), a3, voffA);
            PG8_BAR; PG8_WAIT_L(0); PG8_MMA(1, 0, At, B0); PG8_BAR; PG8_SCHED;
            PG8_STAGE(PG8_SB(1, 1), b3 + hstep, voffB);
            PG8_WAIT_V(6); PG8_BAR; PG8_MMA(1, 1, At, B1); PG8_BAR;
            }
        }
        if constexpr (ALIGN_EPI) { if (wr == 0) PG8_BAR; }
        if constexpr (!Epi::AFTER_DRAIN) { E(acc, cur, wr, wc, fr, fq); S.done(cur); }
        if (!has_next) break;
#pragma unroll
        for (int a = 0; a < 2; ++a)
#pragma unroll
            for (int b = 0; b < 2; ++b)
#pragma unroll
                for (int m = 0; m < 4; ++m)
#pragma unroll
                    for (int n = 0; n < 2; ++n) acc[a][b][m][n] = (f32x4){0.f, 0.f, 0.f, 0.f};
        cur = nxt; cA = nA; cB = nB; ++ui;
        if constexpr (ALIGN_EPI) { if (wr == 1) PG8_BAR; }
    }
    PG8_WAIT_V(0);
    if constexpr (!ALIGN_EPI) { if (wr == 0) PG8_BAR; }
    PG8_BAR;
    if constexpr (Epi::AFTER_DRAIN) { E.fused(acc, cur, wr, wc, fr, fq, lds, wid, lane); S.done(cur); }
#undef PG8_SA
#undef PG8_SB
#undef PG8_STAGE
#undef PG8_LDA
#undef PG8_LDB
#undef PG8_MMA
#undef PG8_WAIT_V
#undef PG8_WAIT_L
#undef PG8_BAR
#undef PG8_SCHED
}
}
#ifndef PG8_SP2
#define PG8_SP2 true
#endif
#ifndef PG8_ALIGN
#define PG8_ALIGN true
#endif
constexpr int NWAVES = 8;
constexpr int NB = 2, NS = 4096, DM = 4096, MR = NB * NS;
constexpr int NHQ = 48, NHA = 24, HD = 128, QKVC = 3 * NHQ * HD;
constexpr int DFF = 14336, F2 = 2 * DFF;
constexpr float ATT_SCALE = 0.08838834764831845f;
constexpr float NORM_EPS = 1e-5f;
constexpr size_t MiB = 1u << 20;
constexpr size_t WS_CTL = 0, CTL_ZERO_BYTES = 1 * MiB;
constexpr size_t WS_SSQ = 256 * 1024, SSQ_SITE = 32 * 1024;
constexpr size_t WS_VSQ = 512 * 1024;
constexpr size_t WS_ROPE = 1 * MiB;
constexpr size_t WS_KMEAN = 576 * 1024;
constexpr size_t WS_SS = 3 * MiB, SS_SITE = 2 * MiB;
constexpr size_t WS_VS = 13 * MiB;
constexpr size_t WS_SEL = 18 * MiB;
constexpr size_t WS_LSE = 20 * MiB;
constexpr size_t WS_WIN = 32 * MiB;
constexpr size_t WS_WOUT = 176 * MiB;
constexpr size_t WS_SGWIN = 208 * MiB;
constexpr size_t WS_SGWOUT = 272 * MiB;
constexpr size_t WS_WUP = 304 * MiB, WUP_L = 224 * MiB;
constexpr size_t WS_WDOWN = 752 * MiB, WDOWN_L = 112 * MiB;
constexpr size_t WS_XB = 976 * MiB;
constexpr size_t WS_H = 1040 * MiB;
constexpr size_t WS_QKV = 1168 * MiB;
constexpr size_t WS_U = WS_QKV, WS_V = WS_QKV + 64 * MiB;
constexpr size_t WS_O = 1456 * MiB;
constexpr size_t WS_G = 1520 * MiB;
constexpr size_t WS_DO = WS_G;
constexpr size_t WS_APRE = 1744 * MiB;
constexpr size_t WS_TOP = WS_APRE + 128 * MiB, WS_BOT = WS_APRE + 136 * MiB;
constexpr size_t WS_END = 2192 * MiB;
constexpr int RING_OFF = 0, RING_BYTES = 131072;
constexpr int SCR_BYTES = 133120;
constexpr int LDSCTL_OFF = SCR_BYTES, MISC_OFF = LDSCTL_OFF + 320;
constexpr int XTRA_OFF = SCR_BYTES + 1024;
constexpr int LDS_BYTES = 147456;
static_assert(MISC_OFF + 128 <= XTRA_OFF, "LDS map");
constexpr int CW_TMO = 0, CW_BAR = 4096;

#define GAS __attribute__((address_space(1)))
#define LAS __attribute__((address_space(3)))
typedef unsigned short bf16;
typedef unsigned v4u __attribute__((ext_vector_type(4)));
typedef unsigned v2u __attribute__((ext_vector_type(2)));
typedef float f32x4 __attribute__((ext_vector_type(4)));
typedef float f32x2 __attribute__((ext_vector_type(2)));
#define LDS_WAIT() asm volatile("s_waitcnt lgkmcnt(0)" ::: "memory")
#define VM_WAIT() asm volatile("s_waitcnt vmcnt(0)" ::: "memory")
__device__ __forceinline__ unsigned f2bf(float f) { unsigned u = __builtin_bit_cast(unsigned, f); return (u + 0x7fffu + ((u >> 16) & 1u)) >> 16; }
__device__ __forceinline__ unsigned pk2(float lo, float hi) { return f2bf(lo) | (f2bf(hi) << 16); }
__device__ __forceinline__ float bflo(unsigned w) { return __builtin_bit_cast(float, w << 16); }
__device__ __forceinline__ float bfhi(unsigned w) { return __builtin_bit_cast(float, w & 0xffff0000u); }
__device__ __forceinline__ float bf1(bf16 h) { return __builtin_bit_cast(float, (unsigned)h << 16); }
namespace att {
typedef unsigned short bf16;
typedef short bf16x8 __attribute__((ext_vector_type(8)));
typedef short s16x4 __attribute__((ext_vector_type(4)));
typedef float f32x16 __attribute__((ext_vector_type(16)));
typedef float f32x4 __attribute__((ext_vector_type(4)));
typedef unsigned u32x4 __attribute__((ext_vector_type(4)));
template <class A, class Bt> struct same_t { static constexpr bool v = false; };
template <class A> struct same_t<A, A> { static constexpr bool v = true; };
constexpr int D = 128;
constexpr float SCALE = 0.08838834764831845f, THR = 8.f;
constexpr int NW = 8, QBLK = 32, KVBLK = 64, QB = NW * QBLK;
constexpr int SHM_V = KVBLK * D * 2, SHM_K = KVBLK * D * 2;
constexpr int ATT_LDS_BYTES = 2 * SHM_V + 2 * SHM_K + NW * 64 * 4;
#define KSWZ(row, colB) ((row) * 256 + ((colB) ^ (((row) & 7) << 4)))
#define SBAR() __builtin_amdgcn_sched_barrier(0)
__device__ __forceinline__ int v_st(int k, int c) { const int kk = (k & ~0xC) | ((k & 4) << 1) | ((k & 8) >> 1); return ((kk >> 3) * 4 + (c >> 5)) * 512 + ((kk & 7) * 32 + (c & 31)) * 2; }
__device__ __forceinline__ int v_rd_base(int lane) { return ((lane & 3) << 3) | (((lane >> 2) & 3) << 6) | (((lane >> 4) & 1) << 5) | (((lane >> 5) & 1) << 8); }
constexpr int v_rd_off(int d0, int ks, int half) { return d0 * 512 + ks * 4096 + half * 2048; }
__device__ __forceinline__ int crow(int r, int hi) { return (r & 3) + 8 * (r >> 2) + 4 * hi; }
__device__ __forceinline__ unsigned cvtpk(float lo, float hi) {
    unsigned r; asm volatile("v_cvt_pk_bf16_f32 %0, %1, %2" : "=v"(r) : "v"(lo), "v"(hi)); return r;
}
__device__ __forceinline__ bf16x8 pack8(f32x4 a, f32x4 b) {
    u32x4 w = {cvtpk(a[0], a[1]), cvtpk(a[2], a[3]), cvtpk(b[0], b[1]), cvtpk(b[2], b[3])};
    return *reinterpret_cast<bf16x8*>(&w);
}
template <class T> __device__ __forceinline__ bf16x8 load8(const T* p) {
    if constexpr (same_t<T, float>::v) { return pack8(*(const f32x4*)p, *(const f32x4*)(p + 4)); }
    else { return *reinterpret_cast<const bf16x8*>(p); }
}
__device__ __forceinline__ void mask_tile(f32x16& p0, f32x16& p1, int dq, unsigned W) {
    const float NEG = -__builtin_inff();
#pragma unroll
    for (int r = 0; r < 16; ++r) {
        const int c = (r & 3) + 8 * (r >> 2);
        if ((unsigned)(dq - c) >= W) p0[r] = NEG;
        if ((unsigned)(dq - c - 32) >= W) p1[r] = NEG;
    }
}
__device__ __forceinline__ void partialSM(f32x16& p0, f32x16& p1, float& m_reg, float& mn, float& alpha) {
    float pmax = p0[0]; for (int r = 1; r < 16; ++r) pmax = fmaxf(pmax, p0[r]); for (int r = 0; r < 16; ++r) pmax = fmaxf(pmax, p1[r]);
    { auto rr = __builtin_amdgcn_permlane32_swap(__float_as_uint(pmax), __float_as_uint(pmax), false, false);
      pmax = fmaxf(__uint_as_float(rr[0]), __uint_as_float(rr[1])); }
    constexpr float C2 = 1.4426950408889634f * SCALE;
    if (__builtin_expect(__all((pmax - m_reg) * SCALE <= THR), 1)) { mn = m_reg; alpha = 1.f; }
    else { mn = fmaxf(m_reg, pmax); alpha = __builtin_amdgcn_exp2f((m_reg - mn) * C2); m_reg = mn; }
    const float mnL = -mn * C2;
    for (int r = 0; r < 16; ++r) p0[r] = fmaf(p0[r], C2, mnL); for (int r = 0; r < 16; ++r) p1[r] = fmaf(p1[r], C2, mnL);
    for (int r = 0; r < 16; ++r) p0[r] = __builtin_amdgcn_exp2f(p0[r]);
}
__device__ __forceinline__ void finishSM(f32x16& p0, f32x16& p1, float alpha, float& l_reg, bf16x8& pa0, bf16x8& pa1, bf16x8& pa2, bf16x8& pa3) {
    for (int r = 0; r < 16; ++r) p1[r] = __builtin_amdgcn_exp2f(p1[r]);
    float ps = 0; for (int r = 0; r < 16; ++r) ps += p0[r]; for (int r = 0; r < 16; ++r) ps += p1[r];
    { auto rr = __builtin_amdgcn_permlane32_swap(__float_as_uint(ps), __float_as_uint(ps), false, false);
      ps = __uint_as_float(rr[0]) + __uint_as_float(rr[1]); }
    l_reg = l_reg * alpha + ps;
#define PK4(P, B_, OUT) do { unsigned a0 = cvtpk(P[B_+0], P[B_+1]), a1 = cvtpk(P[B_+2], P[B_+3]);                          \
        unsigned b0 = cvtpk(P[B_+4], P[B_+5]), b1 = cvtpk(P[B_+6], P[B_+7]);                                             \
        auto r0 = __builtin_amdgcn_permlane32_swap(a0, b0, false, false); auto r1 = __builtin_amdgcn_permlane32_swap(a1, b1, false, false); \
        u32x4 w = {r0[0], r1[0], r0[1], r1[1]}; OUT = *reinterpret_cast<bf16x8*>(&w); } while (0)
    PK4(p0, 0, pa0); PK4(p0, 8, pa1); PK4(p1, 0, pa2); PK4(p1, 8, pa3);
#undef PK4
}
template <int KB, bool SK>
__device__ __forceinline__ void qkt(f32x16& p0, f32x16& p1, const char* K_lds, int r32, int hi, const bf16x8* qr, bool act) {
    if (SK && !act) { const float NEG = -__builtin_inff();
#pragma unroll
        for (int r = 0; r < 16; ++r) { p0[r] = NEG; p1[r] = NEG; } return; }
    p0 = f32x16{}; p1 = f32x16{};
    const char* kb[4];
#pragma unroll
    for (int dd = 0; dd < 4; ++dd) kb[dd] = K_lds + KB * SHM_K + KSWZ(r32, (dd * 16 + hi * 8) * 2);
#pragma unroll
    for (int d0 = 0; d0 < 8; ++d0) { const char* a = kb[d0 & 3] + (d0 >> 2) * 128;
        bf16x8 b0 = *reinterpret_cast<const bf16x8*>(a);
        bf16x8 b1 = *reinterpret_cast<const bf16x8*>(a + 32 * 256);
        p0 = __builtin_amdgcn_mfma_f32_32x32x16_bf16(b0, qr[d0], p0, 0, 0, 0);
        p1 = __builtin_amdgcn_mfma_f32_32x32x16_bf16(b1, qr[d0], p1, 0, 0, 0); }
}
template <int VB, bool SK>
__device__ __forceinline__ void pv_tile(f32x16* o, int vb0, bf16x8 pa0, bf16x8 pa1, bf16x8 pa2, bf16x8 pa3, bool act) {
    if (SK && !act) return;
#define TRRD(dst, off) asm volatile("ds_read_b64_tr_b16 %0, %1 offset:%2" : "=&v"(dst) : "v"(vb0), "i"(off) : "memory")
#define PV_D0(d0) do { s16x4 l0, l1, l2, l3, h0, h1, h2, h3; constexpr int b_ = VB * SHM_V + v_rd_off(d0, 0, 0);     \
        TRRD(l0, b_); TRRD(h0, b_ + 2048); TRRD(l1, b_ + 4096); TRRD(h1, b_ + 6144); TRRD(l2, b_ + 8192); TRRD(h2, b_ + 10240); TRRD(l3, b_ + 12288); TRRD(h3, b_ + 14336); \
        asm volatile("s_waitcnt lgkmcnt(0)" ::: "memory"); SBAR();                 \
        o[d0] = __builtin_amdgcn_mfma_f32_32x32x16_bf16(pa0, (bf16x8){l0[0], l0[1], l0[2], l0[3], h0[0], h0[1], h0[2], h0[3]}, o[d0], 0, 0, 0);   \
        o[d0] = __builtin_amdgcn_mfma_f32_32x32x16_bf16(pa1, (bf16x8){l1[0], l1[1], l1[2], l1[3], h1[0], h1[1], h1[2], h1[3]}, o[d0], 0, 0, 0);   \
        o[d0] = __builtin_amdgcn_mfma_f32_32x32x16_bf16(pa2, (bf16x8){l2[0], l2[1], l2[2], l2[3], h2[0], h2[1], h2[2], h2[3]}, o[d0], 0, 0, 0);   \
        o[d0] = __builtin_amdgcn_mfma_f32_32x32x16_bf16(pa3, (bf16x8){l3[0], l3[1], l3[2], l3[3], h3[0], h3[1], h3[2], h3[3]}, o[d0], 0, 0, 0); } while (0)
    PV_D0(0); PV_D0(1); PV_D0(2); PV_D0(3);
#undef PV_D0
#undef TRRD
}

template <class TIn, class TOut> struct BlockRef { const TIn* Q; const TIn* K; const TIn* V; TOut* O; int P0; const __attribute__((address_space(3))) unsigned short* sel; float* L; };
template <class TIn> struct Seam {
    bf16x8 qr[8];
    bf16x8 st_v0, st_v1, st_k0, st_k1; f32x4 sf0, sf1, sf2, sf3;
    f32x4 tq[16];
};
__device__ __forceinline__ int swa_jlo(int P0, int W) { const int lowk = P0 - W + 1; return lowk > 0 ? lowk / KVBLK : 0; }
#define ROW(p, k0, rr) ((p) + (size_t)((k0) + (rr)) * rs_ + sc)
#define ROWN(p, k0, rr) ((p) + (size_t)((k0) + (rr)) * rsn_ + sc)
#define VMW() asm volatile("s_waitcnt vmcnt(0)" ::: "memory")
#define VMWN(n) asm volatile("s_waitcnt vmcnt(%0)" :: "i"(n) : "memory")
#define SLOAD_H(Kp, Vp, k0) do { S.st_v0 = load8<TIn>(ROW(Vp, k0, sr)); S.st_v1 = load8<TIn>(ROW(Vp, k0, 32 + sr));              \
                         S.st_k0 = load8<TIn>(ROW(Kp, k0, sr)); S.st_k1 = load8<TIn>(ROW(Kp, k0, 32 + sr)); } while (0)
#define SLOAD_HN(Kp, Vp, k0) do { S.st_v0 = load8<TIn>(ROWN(Vp, k0, sr)); S.st_v1 = load8<TIn>(ROWN(Vp, k0, 32 + sr));              \
                         S.st_k0 = load8<TIn>(ROWN(Kp, k0, sr)); S.st_k1 = load8<TIn>(ROWN(Kp, k0, 32 + sr)); } while (0)
#define SWRITE_HK(bf) do { *(bf16x8*)(K_lds + (bf) * SHM_K + kws) = S.st_k0; *(bf16x8*)(K_lds + (bf) * SHM_K + kws + 32 * 256) = S.st_k1; } while (0)
#define SWRITE_HV(bf) do { *(bf16x8*)(V_lds + (bf) * SHM_V + vst0) = S.st_v0; *(bf16x8*)(V_lds + (bf) * SHM_V + vst1) = S.st_v1; } while (0)
#define SWRITE_H(bf) do { SWRITE_HV(bf); SWRITE_HK(bf); } while (0)
#define SLOAD_F(p, k0) do { S.sf0 = *(const f32x4*)ROW(p, k0, sr); S.sf1 = *(const f32x4*)(ROW(p, k0, sr) + 4);                \
                            S.sf2 = *(const f32x4*)ROW(p, k0, 32 + sr); S.sf3 = *(const f32x4*)(ROW(p, k0, 32 + sr) + 4); } while (0)
#define SWRITE_KF(bf) do { *(bf16x8*)(K_lds + (bf) * SHM_K + kws) = pack8(S.sf0, S.sf1); *(bf16x8*)(K_lds + (bf) * SHM_K + kws + 32 * 256) = pack8(S.sf2, S.sf3); } while (0)
#define SWRITE_VF(bf) do { *(bf16x8*)(V_lds + (bf) * SHM_V + vst0) = pack8(S.sf0, S.sf1); *(bf16x8*)(V_lds + (bf) * SHM_V + vst1) = pack8(S.sf2, S.sf3); } while (0)
template <class TIn, class TOut, int RSC, int W>
__device__ __forceinline__ void causal_swa_prime(const BlockRef<TIn, TOut>& cur, char* lds, Seam<TIn>& S) {
    constexpr bool F32 = same_t<TIn, float>::v;
    int tid_ = threadIdx.x; asm volatile("" : "+v"(tid_));
    const int tid = tid_, wid = __builtin_amdgcn_readfirstlane(tid >> 6), lane = tid & 63, r32 = lane & 31, hi = lane >> 5;
    const int sr = tid >> 4, sc = (tid & 15) * 8, kws = KSWZ(sr, sc * 2); char* K_lds = lds + 2 * SHM_V;
    const int kb0 = swa_jlo(cur.P0, W) * KVBLK; constexpr int rs_ = RSC;
    for (int d0 = 0; d0 < 8; ++d0) S.qr[d0] = load8<TIn>(cur.Q + (size_t)(wid * QBLK + r32) * rs_ + d0 * 16 + hi * 8);
    if constexpr (F32) { SLOAD_F((const float*)cur.K, kb0); VMW(); SWRITE_KF(0); SBAR(); SLOAD_F((const float*)cur.V, kb0); }
    else { SLOAD_H(cur.K, cur.V, kb0); VMW(); SWRITE_HK(0); }
    __syncthreads();
}
template <class TIn, class TOut, bool SKP, int MODE, int RSC, int RSN, int OSC, int W, int WN, int skv>
__device__ __forceinline__ void causal_swa_block(const BlockRef<TIn, TOut>& cur, const BlockRef<TIn, TOut>& nxt, char* lds, Seam<TIn>& S) {
    constexpr bool F32 = same_t<TIn, float>::v; static_assert(!F32, "bf16 inputs only in this build");
    constexpr int rs_ = RSC, rsn_ = RSN, os_ = OSC;
    int tid_ = threadIdx.x; asm volatile("" : "+v"(tid_));
    const int tid = tid_, wid = __builtin_amdgcn_readfirstlane(tid >> 6), lane = tid & 63, r32 = lane & 31, hi = lane >> 5;
    const int j_lo = swa_jlo(cur.P0, W);
    int j_hi = (cur.P0 + QB - 1) / KVBLK + 1; if (j_hi > skv / KVBLK) j_hi = skv / KVBLK;
    const int NT = j_hi - j_lo;
    const int kbn = swa_jlo(nxt.P0, WN) * KVBLK;
    const int qlo = cur.P0 + wid * QBLK, qm = qlo + r32 - 4 * hi;
    char* V_lds = lds; char* K_lds = lds + 2 * SHM_V;
    float* ws = (float*)(lds + 2 * SHM_V + 2 * SHM_K) + wid * 64; float* li_l = ws, * al_l = ws + 32;
    float m_reg = -1e30f, l_reg = 0; f32x16 o[4] = {};
    unsigned selm = 0u; if constexpr (MODE == 0) selm = cur.sel[wid * QBLK + r32];
    const int sr = tid >> 4, sc = (tid & 15) * 8, vst0 = v_st(sr, sc), vst1 = v_st(32 + sr, sc), kws = KSWZ(sr, sc * 2);
    const int vb0 = (int)(uintptr_t)V_lds + v_rd_base(lane);
    const TIn* Kh = cur.K; const TIn* Vh = cur.V;
#define RESC(a) do { if (__any((a) < 1.f)) { if (hi == 0) al_l[r32] = (a); asm volatile("s_waitcnt lgkmcnt(0)" ::: "memory");              \
                     for (int d_ = 0; d_ < 4; ++d_) for (int r = 0; r < 16; ++r) o[d_][r] *= al_l[crow(r, hi)]; } } while (0)
#define KBASE(t) ((j_lo + (t)) * KVBLK)
#define ACT(t) (KBASE(t) <= qlo + QBLK - 1 && KBASE(t) + KVBLK - 1 >= qlo - W + 1)
#define MASKT(P0_, P1_, t) do { const int kb_ = KBASE(t); if ((!SK || ACT(t)) && (kb_ + KVBLK - 1 > qlo || kb_ <= qlo + QBLK - 1 - W)) mask_tile(P0_, P1_, qm - kb_, (unsigned)W); \
        if constexpr (MODE == 0) { if (kb_ < cur.P0) { const bool dead_ = ((selm >> (kb_ >> 8)) & 1u) == 0u; const float NEG_ = -__builtin_inff(); \
            _Pragma("unroll") for (int r_ = 0; r_ < 16; ++r_) { P0_[r_] = dead_ ? NEG_ : P0_[r_]; P1_[r_] = dead_ ? NEG_ : P1_[r_]; } } } } while (0)
    constexpr int NQL = F32 ? 16 : 8;
    constexpr bool SK = SKP && !F32;
#define SEAM_K0() do { VMWN(NQL); if constexpr (F32) { SWRITE_KF(0); SBAR(); SLOAD_F((const float*)nxt.V, kbn); } else { SWRITE_HK(0); } SBAR(); } while (0)
    f32x16 pA0, pA1, pB0, pB1; float mnA, mnB, alA, alB; bf16x8 pa0, pa1, pa2, pa3;
    if constexpr (F32) { VMW(); SWRITE_VF(0); SBAR(); } else { SWRITE_HV(0); SBAR(); }
    if (NT > 1) { if constexpr (F32) SLOAD_F((const float*)Kh, KBASE(1)); else SLOAD_H(Kh, Vh, KBASE(1)); }
    SBAR(); qkt<0, SK>(pA0, pA1, K_lds, r32, hi, S.qr, ACT(0));
    if constexpr (F32) { if (NT > 1) { VMW(); SWRITE_KF(1); SBAR(); SLOAD_F((const float*)Vh, KBASE(1)); } }
    MASKT(pA0, pA1, 0); partialSM(pA0, pA1, m_reg, mnA, alA);
    if (NT > 1) { VMW(); if constexpr (F32) { SWRITE_VF(1); SBAR(); if (NT > 2) SLOAD_F((const float*)Kh, KBASE(2)); } else SWRITE_H(1); }
    __syncthreads();
#define HALF_STEP(PX0, PX1, mnX, alX, PY0, PY1, alY, t, KB, VB, SB) do {                                                      \
        SBAR(); qkt<KB, SK>(PX0, PX1, K_lds, r32, hi, S.qr, ACT(t));                                             \
        finishSM(PY0, PY1, alY, l_reg, pa0, pa1, pa2, pa3); SBAR();                                                           \
        if ((t) + 1 < NT) { if constexpr (F32) { VMW(); SWRITE_KF(SB); SBAR(); SLOAD_F((const float*)Vh, KBASE((t) + 1)); }  \
                            else { SLOAD_H(Kh, Vh, KBASE((t) + 1)); } SBAR(); }                                               \
        pv_tile<VB, SK>(o, vb0, pa0, pa1, pa2, pa3, ACT((t) - 1)); MASKT(PX0, PX1, (t)); partialSM(PX0, PX1, m_reg, mnX, alX);                                        \
        __syncthreads();                                                                                                      \
        if ((t) + 1 < NT) { VMW(); if constexpr (F32) { SWRITE_VF(SB); SBAR(); if ((t) + 2 < NT) SLOAD_F((const float*)Kh, KBASE((t) + 2)); } \
                            else { SWRITE_H(SB); } }                                                                          \
        RESC(alX); __syncthreads(); } while (0)
    for (int t = 1; t + 1 < NT; t += 2) {
        HALF_STEP(pB0, pB1, mnB, alB, pA0, pA1, alA, t, 1, 0, 0);
        HALF_STEP(pA0, pA1, mnA, alA, pB0, pB1, alB, t + 1, 0, 1, 1);
    }
    const bool even = (NT & 1) == 0;
    if (even) { SBAR(); qkt<1, SK>(pB0, pB1, K_lds, r32, hi, S.qr, ACT(NT - 1)); SBAR(); }
#define QROW(e) (nxt.Q + (size_t)(wid * QBLK + r32) * rsn_ + ((e) >> 1) * 16 + hi * 8 + ((e) & 1) * 4)
    if constexpr (F32) { SLOAD_F((const float*)nxt.K, kbn); SBAR();
#pragma unroll
        for (int e = 0; e < 8; ++e) S.tq[e] = *(const f32x4*)QROW(e); }
    else { SLOAD_HN(nxt.K, nxt.V, kbn); SBAR();
#pragma unroll
        for (int d0 = 0; d0 < 8; ++d0) S.qr[d0] = load8<TIn>(nxt.Q + (size_t)(wid * QBLK + r32) * rsn_ + d0 * 16 + hi * 8); }
    SBAR();
    finishSM(pA0, pA1, alA, l_reg, pa0, pa1, pa2, pa3); SBAR();
    if constexpr (F32) {
#pragma unroll
        for (int e = 8; e < 16; ++e) S.tq[e] = *(const f32x4*)QROW(e); SBAR(); }
#undef QROW
    pv_tile<0, SK>(o, vb0, pa0, pa1, pa2, pa3, ACT(even ? NT - 2 : NT - 1));
    if (even) { MASKT(pB0, pB1, NT - 1); partialSM(pB0, pB1, m_reg, mnB, alB); __syncthreads(); RESC(alB);
        finishSM(pB0, pB1, alB, l_reg, pa0, pa1, pa2, pa3); SBAR(); pv_tile<1, SK>(o, vb0, pa0, pa1, pa2, pa3, ACT(NT - 1)); }
    SBAR(); SEAM_K0();
    if (hi == 0) li_l[r32] = l_reg; asm volatile("s_waitcnt lgkmcnt(0)" ::: "memory");
    if constexpr (MODE == 1) { if (hi == 0) cur.L[(size_t)(wid * QBLK + r32) * (RSC / 128 * 24)] = m_reg * SCALE + __logf(l_reg); }
    float rli[16];
#pragma unroll
    for (int r = 0; r < 16; ++r) rli[r] = __builtin_amdgcn_rcpf(li_l[crow(r, hi)]);
    TOut* Ow = cur.O + (size_t)(wid * QBLK) * os_;
#pragma unroll
    for (int r = 0; r < 16; ++r) { const int orow = crow(r, hi);
#pragma unroll
        for (int d0 = 0; d0 < 4; ++d0) { const float v = o[d0][r] * rli[r];
            if constexpr (same_t<TOut, float>::v) { Ow[(size_t)orow * os_ + d0 * 32 + r32] = v; }
            else { const float vn = __shfl_xor(v, 1);
                   if ((r32 & 1) == 0) *(unsigned*)(Ow + (size_t)orow * os_ + d0 * 32 + r32) = cvtpk(v, vn); } } }
    if constexpr (F32) {
#pragma unroll
        for (int d0 = 0; d0 < 8; ++d0) S.qr[d0] = pack8(S.tq[2 * d0], S.tq[2 * d0 + 1]); }
    __syncthreads();
#undef RESC
#undef KBASE
#undef ACT
#undef MASKT
#undef SEAM_K0
#undef HALF_STEP
}
#undef ROW
#undef ROWN
#undef SLOAD_HN
#undef VMW
#undef VMWN
#undef SLOAD_H
#undef SWRITE_HK
#undef SWRITE_HV
#undef SWRITE_H
#undef SLOAD_F
#undef SWRITE_KF
#undef SWRITE_VF
}
#define XB_TMO      128
#define XB_XCNT(j)  (256  + 64 * (j))
#define XB_XSUB(j)  (1280 + 64 * (j))
#define XB_XGEN(j)  (2304 + 64 * (j))
#define XB_TOP      3328
#define XB_TOPGEN   3392
#define XCD_BAR_WORDS 3456
#define XB_SPIN_CAP (1u << 18)

__device__ __forceinline__ unsigned xb_ld(unsigned* p)              { return __hip_atomic_load(p, __ATOMIC_RELAXED, __HIP_MEMORY_SCOPE_AGENT); }
__device__ __forceinline__ unsigned xb_add(unsigned* p, unsigned v) { return __hip_atomic_fetch_add(p, v, __ATOMIC_RELAXED, __HIP_MEMORY_SCOPE_AGENT); }
__device__ __forceinline__ unsigned xb_xcc_id() { return (unsigned)__builtin_amdgcn_s_getreg((3 << 11) | 20) & 0xFu; }
#define XB_SPIN(cond, bar) do { unsigned _sp = 0; while (cond) { __builtin_amdgcn_s_sleep(1); \
    if ((++_sp & 255u) == 0u) { if (xb_ld(&(bar)[XB_TMO])) break; if (_sp > XB_SPIN_CAP) { atomicAdd(&(bar)[XB_TMO], 1u); break; } } } } while (0)

struct XcdBarrier {
    unsigned* bar; unsigned x;
    volatile LAS unsigned* st;
};

__device__ __forceinline__ XcdBarrier xcd_barrier_post(unsigned* bar, volatile LAS unsigned* st) {
    XcdBarrier b; b.bar = bar; b.x = xb_xcc_id(); b.st = st;
    if (threadIdx.x == 0) (void)xb_add(&bar[XB_XCNT(b.x)], 1u);
    return b;
}
__device__ __forceinline__ void xcd_barrier_complete(unsigned* bar, unsigned x, unsigned& nloc, unsigned& nx) {
    const unsigned G = gridDim.x * gridDim.y * gridDim.z;
    unsigned sum, cnt, mine, sp = 0u;
    for (;;) {
        sum = 0u; cnt = 0u; mine = 0u;
#pragma unroll
        for (unsigned j = 0; j < 16; ++j) { const unsigned c = xb_ld(&bar[XB_XCNT(j)]); sum += c; cnt += (c > 0u) ? 1u : 0u; mine = (j == x) ? c : mine; }
        if (sum == G) break;
        __builtin_amdgcn_s_sleep(1);
        if ((++sp & 255u) == 0u) { if (xb_ld(&bar[XB_TMO])) break; if (sp > XB_SPIN_CAP) { atomicAdd(&bar[XB_TMO], 1u); break; } }
    }
    nloc = mine > 0u ? mine : 1u; nx = cnt > 0u ? cnt : 1u;
}

__device__ __forceinline__ void xcd_barrier(const XcdBarrier& b) {
    asm volatile("s_waitcnt vmcnt(0)" ::: "memory");
    __syncthreads();
    if (threadIdx.x == 0) {
        unsigned* bar = b.bar;
        __builtin_amdgcn_s_waitcnt(0);
        unsigned nloc = b.st[0], nx = b.st[1];
        if (nloc == 0u) { xcd_barrier_complete(bar, b.x, nloc, nx); b.st[0] = nloc; b.st[1] = nx; }
        const unsigned old = xb_add(&bar[XB_XSUB(b.x)], 1u);
        const unsigned gen = old / nloc;
        if (old + 1u == (gen + 1u) * nloc) {
            __builtin_amdgcn_fence(__ATOMIC_RELEASE, "agent");
            asm volatile("s_waitcnt vmcnt(0)" ::: "memory");
            const unsigned og = xb_add(&bar[XB_TOP], 1u);
            const unsigned tg = og / nx;
            if (og + 1u == (tg + 1u) * nx) xb_add(&bar[XB_TOPGEN], 1u);
            else XB_SPIN(xb_ld(&bar[XB_TOPGEN]) == tg, bar);
            __builtin_amdgcn_fence(__ATOMIC_ACQUIRE, "agent");
            xb_add(&bar[XB_XGEN(b.x)], 1u);
            asm volatile("s_waitcnt vmcnt(0)" ::: "memory");
        } else {
            XB_SPIN(xb_ld(&bar[XB_XGEN(b.x)]) == gen, bar);
            __builtin_amdgcn_fence(__ATOMIC_ACQUIRE, "agent");
            asm volatile("s_waitcnt vmcnt(0)" ::: "memory");
        }
    }
    __syncthreads();
}
struct Frame {
    LAS unsigned char* lds;
    volatile LAS unsigned* MISC;
    unsigned* ctl;
    int tid, lane, wave, G, gw, NGW;
    unsigned char* ws;
    const float* x; const int* pos;
    const float *attn_norm, *attn_w_in, *attn_w_out, *sg_norm, *sg_w_in, *sg_b_in, *sg_v_gain, *sg_v_bias, *sg_w_s, *sg_b_s, *sg_w_out, *ffn_norm, *ffn_w_up, *ffn_conv_w, *ffn_conv_b, *ffn_w_down, *final_norm;
    float* out;
};
__device__ __forceinline__ float wave_sum(float v) {
#pragma unroll
    for (int o = 1; o < 64; o <<= 1) v += __shfl_xor(v, o);
    return v;
}
__device__ __forceinline__ float wave_max(float v) {
#pragma unroll
    for (int o = 1; o < 64; o <<= 1) v = fmaxf(v, __shfl_xor(v, o));
    return v;
}
__device__ __forceinline__ float ss_rstd(const float* ss, int r) { return pg8::rstd_from_ss(ss, r); }

struct MapId { __device__ __forceinline__ int operator()(int n) const { return n; } };
struct MapUp { __device__ __forceinline__ int operator()(int n) const { return n < DFF ? ((n >> 7) << 8) + (n & 127) : (((n - DFF) >> 7) << 8) + 128 + ((n - DFF) & 127); } };
template <class RowMap>
__device__ __forceinline__ void transpose_item(const float* W, int K, int N, const float* gain, bf16* WT, RowMap rm, LAS float* scr, int item, int lane) {
    const int nblk = N / 64, kb = item / nblk, nb = item - kb * nblk, k0 = 64 * kb, n0 = 64 * nb;
    const int lr = lane >> 4, lc = (lane & 15) * 4;
    f32x4 v[16];
#pragma unroll
    for (int i = 0; i < 16; ++i) v[i] = *(const f32x4*)(W + (size_t)(k0 + 4 * i + lr) * N + n0 + lc);
#pragma unroll
    for (int i = 0; i < 16; ++i) { const int kk = 4 * i + lr; f32x4 x = v[i]; if (gain) x = x * gain[k0 + kk]; LAS float* d = scr + kk * 65 + lc; d[0] = x[0]; d[1] = x[1]; d[2] = x[2]; d[3] = x[3]; }
    LDS_WAIT(); asm volatile("" ::: "memory");
    const int c = lane & 7;
#pragma unroll
    for (int j = 0; j < 8; ++j) { const int n = (lane >> 3) + 8 * j; const LAS float* s = scr + (8 * c) * 65 + n;
        v4u o; o.x = pk2(s[0 * 65], s[1 * 65]); o.y = pk2(s[2 * 65], s[3 * 65]); o.z = pk2(s[4 * 65], s[5 * 65]); o.w = pk2(s[6 * 65], s[7 * 65]);
        *(v4u*)(WT + (size_t)rm(n0 + n) * K + k0 + 8 * c) = o; }
    LDS_WAIT(); asm volatile("" ::: "memory");
}
__device__ __forceinline__ void sincos_d(double a, double& sn, double& cs) {
    const double n = __builtin_rint(a * 0.15915494309189535);
    const double r = a - n * 6.283185307179586;
    const double r2 = r * r;
    double ts = r, tc = 1.0, s = r, c = 1.0;
#pragma unroll
    for (int k = 1; k <= 15; ++k) { tc = -tc * r2 / (double)((2 * k - 1) * (2 * k)); ts = -ts * r2 / (double)((2 * k) * (2 * k + 1)); c += tc; s += ts; }
    sn = s; cs = c;
}
__device__ __forceinline__ void p0_prologue(Frame& F) {
    LAS float* scr = (LAS float*)(F.lds + RING_OFF + F.wave * 16640);
    constexpr int I_WIN = 64 * (QKVC / 64), I_SQ = 64 * (DM / 64), I_SGIN = 64 * (2 * DM / 64), I_UP = 64 * (F2 / 64), I_DN = (DFF / 64) * (DM / 64);
    constexpr int NITEMS = I_WIN + 2 * I_SQ + I_SGIN + 2 * I_UP + 2 * I_DN;
    for (int it = F.gw; it < NITEMS; it += F.NGW) {
        int r = it;
        if (r < I_WIN) { transpose_item(F.attn_w_in, DM, QKVC, F.attn_norm, (bf16*)(F.ws + WS_WIN), MapId(), scr, r, F.lane); continue; } r -= I_WIN;
        if (r < I_SQ) { transpose_item(F.attn_w_out, DM, DM, nullptr, (bf16*)(F.ws + WS_WOUT), MapId(), scr, r, F.lane); continue; } r -= I_SQ;
        if (r < I_SGIN) { transpose_item(F.sg_w_in, DM, 2 * DM, F.sg_norm, (bf16*)(F.ws + WS_SGWIN), MapId(), scr, r, F.lane); continue; } r -= I_SGIN;
        if (r < I_SQ) { transpose_item(F.sg_w_out, DM, DM, nullptr, (bf16*)(F.ws + WS_SGWOUT), MapId(), scr, r, F.lane); continue; } r -= I_SQ;
        if (r < I_UP) { transpose_item(F.ffn_w_up, DM, F2, F.ffn_norm, (bf16*)(F.ws + WS_WUP), MapUp(), scr, r, F.lane); continue; } r -= I_UP;
        if (r < I_UP) { transpose_item(F.ffn_w_up + (size_t)DM * F2, DM, F2, F.ffn_norm + DM, (bf16*)(F.ws + WS_WUP + WUP_L), MapUp(), scr, r, F.lane); continue; } r -= I_UP;
        if (r < I_DN) { transpose_item(F.ffn_w_down, DFF, DM, nullptr, (bf16*)(F.ws + WS_WDOWN), MapId(), scr, r, F.lane); continue; } r -= I_DN;
        transpose_item(F.ffn_w_down + (size_t)DFF * DM, DFF, DM, nullptr, (bf16*)(F.ws + WS_WDOWN + WDOWN_L), MapId(), scr, r, F.lane);
    }
    bf16* XB = (bf16*)(F.ws + WS_XB); float* SS0 = (float*)(F.ws + WS_SSQ);
    for (int m = F.gw; m < MR; m += F.NGW) {
        const f32x4* xr = (const f32x4*)(F.x + (size_t)m * DM) + F.lane;
        v2u* o8 = (v2u*)(XB + (size_t)m * DM) + F.lane;
        float sq = 0.f;
#pragma unroll
        for (int j = 0; j < 16; ++j) { const f32x4 v = xr[64 * j]; sq += (v[0] * v[0] + v[1] * v[1]) + (v[2] * v[2] + v[3] * v[3]); v2u w; w.x = pk2(v[0], v[1]); w.y = pk2(v[2], v[3]); o8[64 * j] = w; }
        sq = wave_sum(sq);
        if (F.lane == 0) SS0[m] = sq;
    }
    float* rc = (float*)(F.ws + WS_ROPE); float* rs = rc + MR * 16;
    for (int idx = F.gw * 64 + F.lane; idx < MR * 16; idx += F.NGW * 64) {
        const int r = idx >> 4, i = idx & 15;
        double invd = 1.0;
        for (int k = 0; k < i; ++k) invd *= 0.44036660267178046;
        const float inv = (float)invd;
        const float ang = (float)F.pos[r] * inv;
        double sn, cs; sincos_d((double)ang, sn, cs);
        rc[idx] = (float)cs; rs[idx] = (float)sn;
    }
}

__device__ __forceinline__ void p_kmean(Frame& F) {
    const bf16* QKV = (const bf16*)(F.ws + WS_QKV); float* KM = (float*)(F.ws + WS_KMEAN);
    LAS float* red = (LAS float*)(F.lds + RING_OFF);
    for (int item = blockIdx.x; item < NB * NHA * 16; item += F.G) {
        const int j = item & 15, bh = item >> 4, b = bh / NHA, h = bh - b * NHA;
        const bf16* kb = QKV + ((size_t)((1 * 2 + b) * NHQ + h) * NS + 256 * j) * HD;
        const int d = F.tid & 127, part = F.tid >> 7;
        float s = 0.f;
        for (int i = 0; i < 64; ++i) s += bf1(kb[(size_t)(part * 64 + i) * HD + d]);
        red[part * 128 + d] = s;
        __syncthreads();
        if (F.tid < 128) KM[(size_t)item * 128 + F.tid] = (red[F.tid] + red[128 + F.tid] + red[256 + F.tid] + red[384 + F.tid]) * (1.0f / 256.0f);
        __syncthreads();
    }
}

__device__ __forceinline__ float dot128(const LAS float* qs, const bf16* krow) {
    float s = 0.f;
#pragma unroll 4
    for (int c = 0; c < 16; ++c) {
        const v4u kv = *(const v4u*)(krow + 8 * c); const LAS float* q8 = qs + 8 * c;
        s += q8[0] * bflo(kv.x) + q8[1] * bfhi(kv.x) + q8[2] * bflo(kv.y) + q8[3] * bfhi(kv.y) + q8[4] * bflo(kv.z) + q8[5] * bfhi(kv.z) + q8[6] * bflo(kv.w) + q8[7] * bfhi(kv.w);
    }
    return s;
}
__device__ __forceinline__ void p_attn_naive(Frame& F, bf16* O) {
    const bf16* QKV = (const bf16*)(F.ws + WS_QKV); const float* KM = (const float*)(F.ws + WS_KMEAN);
    LAS float* qs = (LAS float*)(F.lds + RING_OFF + F.wave * 8192);
    LAS float* ps = qs + 128;
    const int lane = F.lane;
    constexpr int NMOBA = NB * NHA * NS, NDIL = NB * 8 * NS;
    const float NEG = -__builtin_inff();
    for (int task = F.gw; task < NMOBA + NDIL; task += F.NGW) {
        if (task < NMOBA) {
            const int b = task / (NHA * NS), rem = task - b * (NHA * NS), h = rem >> 12, t = rem & 4095;
            const bf16* qrow = QKV + ((size_t)((0 * 2 + b) * NHQ + h) * NS + t) * HD;
            const bf16* Kb = QKV + (size_t)((1 * 2 + b) * NHQ + h) * NS * HD;
            const bf16* Vb = QKV + (size_t)((2 * 2 + b) * NHQ + h) * NS * HD;
            { const unsigned w = *(const unsigned*)(qrow + 2 * lane); qs[2 * lane] = bflo(w); qs[2 * lane + 1] = bfhi(w); }
            LDS_WAIT(); asm volatile("" ::: "memory");
            const int qb = t >> 8, tin = t & 255;
            float g = NEG;
            if (lane < qb) { const float* km = KM + ((size_t)((b * NHA + h) * 16 + lane)) * 128; float s = 0.f; for (int d = 0; d < 128; ++d) s += qs[d] * km[d]; g = s; }
            unsigned selmask = 0u;
            if (qb <= 3) selmask = (1u << qb) - 1u;
            else {
#pragma unroll
                for (int rd = 0; rd < 3; ++rd) {
                    float best = g; int bi = lane;
#pragma unroll
                    for (int o = 1; o < 64; o <<= 1) { const float ob = __shfl_xor(best, o); const int oi = __shfl_xor(bi, o); if (ob > best || (ob == best && oi < bi)) { best = ob; bi = oi; } }
                    selmask |= 1u << bi; if (lane == bi) g = NEG;
                }
            }
            float sc[4][4]; int jsel[3];
            unsigned mk = selmask;
#pragma unroll
            for (int sl = 0; sl < 3; ++sl) {
                int j = -1; if (mk) { j = __builtin_ctz(mk); mk &= mk - 1u; }
                jsel[sl] = j;
#pragma unroll
                for (int c = 0; c < 4; ++c) sc[sl][c] = (j >= 0) ? ATT_SCALE * dot128(qs, Kb + (size_t)(256 * j + lane + 64 * c) * HD) : NEG;
            }
#pragma unroll
            for (int c = 0; c < 4; ++c) { const int i = lane + 64 * c; sc[3][c] = (i <= tin) ? ATT_SCALE * dot128(qs, Kb + (size_t)(256 * qb + i) * HD) : NEG; }
            float mx = NEG;
#pragma unroll
            for (int sl = 0; sl < 4; ++sl)
#pragma unroll
                for (int c = 0; c < 4; ++c) mx = fmaxf(mx, sc[sl][c]);
            mx = wave_max(mx);
            float sum = 0.f;
#pragma unroll
            for (int sl = 0; sl < 4; ++sl)
#pragma unroll
                for (int c = 0; c < 4; ++c) { sc[sl][c] = __expf(sc[sl][c] - mx); sum += sc[sl][c]; }
            sum = wave_sum(sum);
            const float inv = 1.0f / sum;
#pragma unroll
            for (int sl = 0; sl < 4; ++sl)
#pragma unroll
                for (int c = 0; c < 4; ++c) ps[sl * 256 + lane + 64 * c] = sc[sl][c] * inv;
            LDS_WAIT(); asm volatile("" ::: "memory");
            float o0 = 0.f, o1 = 0.f;
#pragma unroll
            for (int sl = 0; sl < 3; ++sl) {
                if (jsel[sl] >= 0) { const bf16* vb = Vb + (size_t)(256 * jsel[sl]) * HD + 2 * lane;
                    for (int i = 0; i < 256; ++i) { const float p = ps[sl * 256 + i]; const unsigned w = *(const unsigned*)(vb + (size_t)i * HD); o0 += p * bflo(w); o1 += p * bfhi(w); } }
            }
            { const bf16* vb = Vb + (size_t)(256 * qb) * HD + 2 * lane;
              for (int i = 0; i <= tin; ++i) { const float p = ps[3 * 256 + i]; const unsigned w = *(const unsigned*)(vb + (size_t)i * HD); o0 += p * bflo(w); o1 += p * bfhi(w); } }
            *(unsigned*)(O + (size_t)(b * NS + t) * DM + h * HD + 2 * lane) = pk2(o0, o1);
            LDS_WAIT(); asm volatile("" ::: "memory");
        } else {
            const int td = task - NMOBA, b = td / (8 * NS), rem = td - b * (8 * NS), hh = rem >> 12, t = rem & 4095;
            float lse[3], og0[3], og1[3];
#pragma unroll
            for (int g = 0; g < 3; ++g) {
                const int head = NHA + g * 8 + hh, dil = g == 0 ? 1 : (g == 1 ? 4 : 16);
                const bf16* qrow = QKV + ((size_t)((0 * 2 + b) * NHQ + head) * NS + t) * HD;
                const bf16* Kb = QKV + (size_t)((1 * 2 + b) * NHQ + head) * NS * HD;
                const bf16* Vb = QKV + (size_t)((2 * 2 + b) * NHQ + head) * NS * HD;
                { const unsigned w = *(const unsigned*)(qrow + 2 * lane); qs[2 * lane] = bflo(w); qs[2 * lane + 1] = bfhi(w); }
                LDS_WAIT(); asm volatile("" ::: "memory");
                float sc[3];
#pragma unroll
                for (int c = 0; c < 3; ++c) { const int m = lane + 64 * c; const int kp = t - m * dil; sc[c] = (m <= 128 && kp >= 0) ? ATT_SCALE * dot128(qs, Kb + (size_t)kp * HD) : NEG; }
                float mx = wave_max(fmaxf(fmaxf(sc[0], sc[1]), sc[2]));
                float e0 = __expf(sc[0] - mx), e1 = __expf(sc[1] - mx), e2 = __expf(sc[2] - mx);
                const float sum = wave_sum(e0 + e1 + e2), inv = 1.0f / sum;
                lse[g] = mx + __logf(sum);
                ps[lane] = e0 * inv; ps[lane + 64] = e1 * inv; if (lane == 0) ps[128] = e2 * inv;
                LDS_WAIT(); asm volatile("" ::: "memory");
                const int nb = t / dil, nk = (nb < 128 ? nb : 128) + 1;
                float o0 = 0.f, o1 = 0.f;
                for (int m = 0; m < nk; ++m) { const float p = ps[m]; const unsigned w = *(const unsigned*)(Vb + (size_t)(t - m * dil) * HD + 2 * lane); o0 += p * bflo(w); o1 += p * bfhi(w); }
                og0[g] = o0; og1[g] = o1;
                LDS_WAIT(); asm volatile("" ::: "memory");
            }
            const float ml = fmaxf(fmaxf(lse[0], lse[1]), lse[2]);
            const float w0 = __expf(lse[0] - ml), w1 = __expf(lse[1] - ml), w2 = __expf(lse[2] - ml), wi = 1.0f / (w0 + w1 + w2);
            const float r0 = (w0 * og0[0] + w1 * og0[1] + w2 * og0[2]) * wi, r1 = (w0 * og1[0] + w1 * og1[1] + w2 * og1[2]) * wi;
            *(unsigned*)(O + (size_t)(b * NS + t) * DM + (NHA + hh) * HD + 2 * lane) = pk2(r0, r1);
        }
    }
}

__device__ __forceinline__ float silu_f(float x) { return x / (1.0f + __expf(-x)); }
__device__ __forceinline__ void unpack8(const v4u w, float (&f)[8]) { f[0] = bflo(w.x); f[1] = bfhi(w.x); f[2] = bflo(w.y); f[3] = bfhi(w.y); f[4] = bflo(w.z); f[5] = bfhi(w.z); f[6] = bflo(w.w); f[7] = bfhi(w.w); }
__device__ __forceinline__ void p_conv(Frame& F, int layer) {
    const bf16* AP = (const bf16*)(F.ws + WS_APRE); bf16* Gb = (bf16*)(F.ws + WS_G);
    const float* cw = F.ffn_conv_w + (size_t)layer * 3 * F2; const float* cb = F.ffn_conv_b + (size_t)layer * F2;
    constexpr int C8 = DFF / 8;
    const size_t total = (size_t)MR * C8;
    for (size_t idx = (size_t)blockIdx.x * 512 + F.tid; idx < total; idx += (size_t)F.G * 512) {
        const int r = (int)(idx / C8), j0 = (int)(idx - (size_t)r * C8) * 8, s = r & 4095;
        float cg[8], cu[8];
#pragma unroll
        for (int e = 0; e < 8; ++e) { cg[e] = cb[j0 + e]; cu[e] = cb[DFF + j0 + e]; }
#pragma unroll
        for (int tp = 0; tp < 3; ++tp) {
            const int back = 2 - tp;
            if (s >= back) {
                float ag[8], au[8];
                unpack8(*(const v4u*)(AP + (size_t)(r - back) * F2 + j0), ag);
                unpack8(*(const v4u*)(AP + (size_t)(r - back) * F2 + DFF + j0), au);
#pragma unroll
                for (int e = 0; e < 8; ++e) { cg[e] += cw[(size_t)tp * F2 + j0 + e] * ag[e]; cu[e] += cw[(size_t)tp * F2 + DFF + j0 + e] * au[e]; }
            }
        }
        v4u o; o.x = pk2(silu_f(cg[0]) * cu[0], silu_f(cg[1]) * cu[1]); o.y = pk2(silu_f(cg[2]) * cu[2], silu_f(cg[3]) * cu[3]);
        o.z = pk2(silu_f(cg[4]) * cu[4], silu_f(cg[5]) * cu[5]); o.w = pk2(silu_f(cg[6]) * cu[6], silu_f(cg[7]) * cu[7]);
        *(v4u*)(Gb + (size_t)r * DFF + j0) = o;
    }
}

__device__ __forceinline__ void p_sgate_naive(Frame& F) {
    const bf16* U = (const bf16*)(F.ws + WS_U); const bf16* V = (const bf16*)(F.ws + WS_V); const float* VS = (const float*)(F.ws + WS_VSQ); bf16* GT = (bf16*)(F.ws + WS_O);
    LAS float* vn = (LAS float*)(F.lds + RING_OFF);
    LAS float* wsl = vn + 128 * 128;
    LAS float* rstat = (LAS float*)(F.lds + XTRA_OFF);
    for (int item = blockIdx.x; item < 64 * 32; item += F.G) {
        const int bc = item >> 5, g = item & 31, r0 = bc * 128;
        if (F.tid < 128) {
            const float s1 = VS[2 * (r0 + F.tid)], s2 = VS[2 * (r0 + F.tid) + 1];
            const float mean = s1 * (1.0f / 4096.0f), var = s2 * (1.0f / 4096.0f) - mean * mean;
            rstat[2 * F.tid] = mean; rstat[2 * F.tid + 1] = 1.0f / sqrtf(var + NORM_EPS);
        }
        __syncthreads();
        for (int idx = F.tid; idx < 128 * 128; idx += 512) {
            const int s = idx >> 7, d = idx & 127, col = g * 128 + d;
            const float v = bf1(V[(size_t)(r0 + s) * DM + col]);
            vn[idx] = (v - rstat[2 * s]) * rstat[2 * s + 1] * F.sg_v_gain[col] + F.sg_v_bias[col];
            wsl[idx] = F.sg_w_s[(size_t)g * 16384 + idx];
        }
        __syncthreads();
        for (int idx = F.tid; idx < 128 * 128; idx += 512) {
            const int t = idx >> 7, d = idx & 127;
            float a = 0.f;
            for (int s = 0; s <= t; ++s) a += wsl[t * 128 + s] * vn[s * 128 + d];
            const float f = a + F.sg_b_s[g * 128 + t];
            const size_t o = (size_t)(r0 + t) * DM + g * 128 + d;
            GT[o] = (bf16)f2bf(bf1(U[o]) * f);
        }
        __syncthreads();
    }
}

__device__ __forceinline__ void p_final(Frame& F) {
    const float* H = (const float*)(F.ws + WS_H); const float* SS4 = (const float*)(F.ws + WS_SSQ + 4 * SSQ_SITE);
#ifdef CHECK_ATTN
    const unsigned nbad = __hip_atomic_load(F.ctl + 8, __ATOMIC_RELAXED, __HIP_MEMORY_SCOPE_AGENT);
#endif
    for (int m = F.gw; m < MR; m += F.NGW) {
        float rs = ss_rstd(SS4, m);
#ifdef CHECK_ATTN
        if (nbad > CHECK_ATTN) rs = __builtin_nanf("");
#endif
        const f32x4* hr = (const f32x4*)(H + (size_t)m * DM) + F.lane; const f32x4* gr = (const f32x4*)F.final_norm + F.lane;
        f32x4* orow = (f32x4*)(F.out + (size_t)m * DM) + F.lane;
#pragma unroll 4
        for (int j = 0; j < 16; ++j) orow[64 * j] = hr[64 * j] * rs * gr[64 * j];
    }
}
__device__ __forceinline__ unsigned moba_select(const LAS float* km, const bf16* qrow, int qb) {
    const float NEG = -__builtin_inff();
    if (qb <= 3) return (1u << qb) - 1u;
    float g[16];
#pragma unroll
    for (int j = 0; j < 16; ++j) g[j] = 0.f;
#pragma unroll 1
    for (int c = 0; c < 16; ++c) {
        float q8[8]; unpack8(*(const v4u*)(qrow + 8 * c), q8);
#pragma unroll
        for (int j = 0; j < 16; ++j) {
            const f32x4 k0 = *(const LAS f32x4*)(km + j * 128 + 8 * c), k1 = *(const LAS f32x4*)(km + j * 128 + 8 * c + 4);
            g[j] += q8[0] * k0[0] + q8[1] * k0[1] + q8[2] * k0[2] + q8[3] * k0[3] + q8[4] * k1[0] + q8[5] * k1[1] + q8[6] * k1[2] + q8[7] * k1[3];
        }
    }
#pragma unroll
    for (int j = 0; j < 16; ++j) if (j >= qb) g[j] = NEG;
    unsigned sel = 0u;
#pragma unroll
    for (int rd = 0; rd < 3; ++rd) {
        float best = NEG; unsigned bi = 0u;
#pragma unroll
        for (int j = 0; j < 16; ++j) { const bool take = (((sel >> j) & 1u) == 0u) && (g[j] > best); best = take ? g[j] : best; bi = take ? (unsigned)j : bi; }
        sel |= 1u << bi;
    }
    return sel;
}

typedef att::BlockRef<bf16, bf16> ABR;
#ifndef DIL_SK
#define DIL_SK false
#endif
constexpr int ATT_SEL_OFF = 69632, ATT_KM_OFF = 73728;
__device__ __forceinline__ void moba_unit(int vc, int i, int& bh, int& qb) {
    const int grp = vc >> 4, a = vc & 15;
    const unsigned long long PB = 0x24310cbfed5a9687ull, PC = 0x6579b13024c8aedfull;
    qb = i == 0 ? a : (i == 1 ? (int)((PB >> (4 * a)) & 15ull) : (int)((PC >> (4 * a)) & 15ull));
    bh = 3 * grp + i;
}
__device__ __forceinline__ ABR moba_ref(const Frame& F, int vc, int i, const LAS unsigned short* selL) {
    int bh, qb; moba_unit(vc, i, bh, qb);
    const int b = bh / NHA, h = bh - NHA * b;
    const bf16* QKV = (const bf16*)(F.ws + WS_QKV);
    ABR r;
    r.Q = QKV + ((size_t)((0 * 2 + b) * NHQ + h) * NS + 256 * qb) * HD;
    r.K = QKV + (size_t)((1 * 2 + b) * NHQ + h) * NS * HD;
    r.V = QKV + (size_t)((2 * 2 + b) * NHQ + h) * NS * HD;
    r.O = (bf16*)(F.ws + WS_O) + (size_t)(b * NS + 256 * qb) * DM + h * HD;
    r.P0 = 256 * qb;
    r.sel = selL + 256 * i; r.L = nullptr;
    return r;
}
__device__ __forceinline__ ABR dil_ref(const Frame& F, int vc, int g) {
    const int bhh = vc >> 4, b = bhh >> 3, hh = bhh & 7, lo = vc & 15;
    const int dil = g == 0 ? 1 : (g == 1 ? 4 : 16);
    const int res = g == 0 ? 0 : (g == 1 ? (lo >> 2) : lo), blk = g == 0 ? lo : (g == 1 ? (lo & 3) : 0);
    const int head = NHA + 8 * g + hh, pos0 = res + dil * 256 * blk;
    const bf16* QKV = (const bf16*)(F.ws + WS_QKV);
    ABR r;
    r.Q = QKV + ((size_t)((0 * 2 + b) * NHQ + head) * NS + pos0) * HD;
    r.K = QKV + ((size_t)((1 * 2 + b) * NHQ + head) * NS + res) * HD;
    r.V = QKV + ((size_t)((2 * 2 + b) * NHQ + head) * NS + res) * HD;
    r.O = (bf16*)(F.ws + WS_DO) + (size_t)(b * NS + pos0) * 3072 + g * 1024 + hh * HD;
    r.P0 = 256 * blk;
    r.sel = nullptr; r.L = (float*)(F.ws + WS_LSE) + (size_t)(b * NS + pos0) * 24 + g * 8 + hh;
    return r;
}
__device__ __forceinline__ void p_attn(Frame& F, char* lds) {
    for (int vc = blockIdx.x; vc < 256; vc += F.G) {
#ifndef NO_MOBA
        {
            const bf16* QKVq = (const bf16*)(F.ws + WS_QKV); const float* KM = (const float*)(F.ws + WS_KMEAN);
            LAS float* kmL = (LAS float*)(F.lds + RING_OFF + ATT_KM_OFF); LAS unsigned short* selW = (LAS unsigned short*)(F.lds + RING_OFF + ATT_SEL_OFF);
            const LAS unsigned short* selL = selW;
#ifndef NO_GATEPRE
            for (int idx = F.tid; idx < 3 * 2048; idx += 512) { int bh, qb; moba_unit(vc, idx >> 11, bh, qb); kmL[idx] = KM[(size_t)bh * 2048 + (idx & 2047)]; }
            __syncthreads();
            for (int qi = F.tid; qi < 768; qi += 512) { int bh, qb; moba_unit(vc, qi >> 8, bh, qb); const int b = bh / NHA, h = bh - NHA * b;
                selW[qi] = (unsigned short)moba_select(kmL + (qi >> 8) * 2048, QKVq + ((size_t)((0 * 2 + b) * NHQ + h) * NS + 256 * qb + (qi & 255)) * HD, qb); }
            __syncthreads();
#endif
            asm volatile("" ::: "memory");
            int vcb = vc; asm volatile("" : "+s"(vcb));
            att::Seam<bf16> S;
            constexpr int WM = 1 << 30;
            ABR cur = moba_ref(F, vcb, 0, selL);
            att::causal_swa_prime<bf16, bf16, 128, WM>(cur, lds, S);
            for (int i = 0; i < 3; ++i) {
                const ABR nxt = moba_ref(F, vcb, i < 2 ? i + 1 : 2, selL);
                att::causal_swa_block<bf16, bf16, false, 0, 128, 128, DM, WM, WM, NS>(cur, nxt, lds, S);
                cur = nxt;
            }
        }
#endif
    }
    for (int vc = blockIdx.x; vc < 256; vc += F.G) {
#ifndef NO_DIL
        {
            att::Seam<bf16> S;
            const ABR r0 = dil_ref(F, vc, 0), r1 = dil_ref(F, vc, 1), r2 = dil_ref(F, vc, 2);
            att::causal_swa_prime<bf16, bf16, 128, 129>(r0, lds, S);
            att::causal_swa_block<bf16, bf16, DIL_SK, 1, 128, 512, 3072, 129, 129, NS>(r0, r1, lds, S);
            att::causal_swa_block<bf16, bf16, DIL_SK, 1, 512, 2048, 4 * 3072, 129, 129, NS / 4>(r1, r2, lds, S);
            att::causal_swa_block<bf16, bf16, DIL_SK, 1, 2048, 2048, 16 * 3072, 129, 129, NS / 16>(r2, r2, lds, S);
        }
#endif
    }
}
__device__ __forceinline__ void p_dilmerge(Frame& F) {
    const bf16* DO = (const bf16*)(F.ws + WS_DO); const float* LSE = (const float*)(F.ws + WS_LSE); bf16* O = (bf16*)(F.ws + WS_O);
    const size_t total = (size_t)MR * 8 * 16;
    for (size_t idx = (size_t)blockIdx.x * 512 + F.tid; idx < total; idx += (size_t)F.G * 512) {
        const int r = (int)(idx >> 7), hh = (int)(idx >> 4) & 7, c8 = (int)idx & 15;
        const float l0 = LSE[(size_t)r * 24 + hh], l1 = LSE[(size_t)r * 24 + 8 + hh], l2 = LSE[(size_t)r * 24 + 16 + hh];
        const float ml = fmaxf(fmaxf(l0, l1), l2);
        float w0 = __expf(l0 - ml), w1 = __expf(l1 - ml), w2 = __expf(l2 - ml); const float wi = 1.0f / (w0 + w1 + w2); w0 *= wi; w1 *= wi; w2 *= wi;
        float a0[8], a1[8], a2[8];
        unpack8(*(const v4u*)(DO + (size_t)r * 3072 + hh * HD + c8 * 8), a0);
        unpack8(*(const v4u*)(DO + (size_t)r * 3072 + 1024 + hh * HD + c8 * 8), a1);
        unpack8(*(const v4u*)(DO + (size_t)r * 3072 + 2048 + hh * HD + c8 * 8), a2);
        float o[8];
#pragma unroll
        for (int e = 0; e < 8; ++e) o[e] = w0 * a0[e] + w1 * a1[e] + w2 * a2[e];
        v4u w; w.x = pk2(o[0], o[1]); w.y = pk2(o[2], o[3]); w.z = pk2(o[4], o[5]); w.w = pk2(o[6], o[7]);
        *(v4u*)(O + (size_t)r * DM + (NHA + hh) * HD + c8 * 8) = w;
    }
}
__device__ __forceinline__ void p_convfix(Frame& F, int layer) {
    const float* top = (const float*)(F.ws + WS_TOP); const float* bot = (const float*)(F.ws + WS_BOT); bf16* Gb = (bf16*)(F.ws + WS_G);
    const float* cw = F.ffn_conv_w + (size_t)layer * 3 * F2; const float* cb = F.ffn_conv_b + (size_t)layer * F2;
    constexpr int C4 = DFF / 4, NIT = 30 * C4;
    for (int idx = blockIdx.x * 512 + F.tid; idx < NIT; idx += F.G * 512) {
        const int pmi = idx / C4, j0 = (idx - pmi * C4) * 4, pm = pmi + 1 + (pmi >= 15 ? 1 : 0);
        f32x4 c0[2], c1[2];
#pragma unroll
        for (int bj = 0; bj < 2; ++bj) {
            const int col = bj * DFF + j0;
            const f32x4 w0 = *(const f32x4*)(cw + col), w1 = *(const f32x4*)(cw + F2 + col), w2 = *(const f32x4*)(cw + 2 * F2 + col), bb = *(const f32x4*)(cb + col);
            const f32x4 am2 = *(const f32x4*)(bot + (size_t)((pm - 1) * 2 + 0) * F2 + col), am1 = *(const f32x4*)(bot + (size_t)((pm - 1) * 2 + 1) * F2 + col);
            const f32x4 a0 = *(const f32x4*)(top + (size_t)(pm * 2 + 0) * F2 + col), a1 = *(const f32x4*)(top + (size_t)(pm * 2 + 1) * F2 + col);
            c0[bj] = bb + w0 * am2 + w1 * am1 + w2 * a0;
            c1[bj] = bb + w0 * am1 + w1 * a0 + w2 * a1;
        }
        v2u o0, o1;
        o0.x = pk2(silu_f(c0[0][0]) * c0[1][0], silu_f(c0[0][1]) * c0[1][1]); o0.y = pk2(silu_f(c0[0][2]) * c0[1][2], silu_f(c0[0][3]) * c0[1][3]);
        o1.x = pk2(silu_f(c1[0][0]) * c1[1][0], silu_f(c1[0][1]) * c1[1][1]); o1.y = pk2(silu_f(c1[0][2]) * c1[1][2], silu_f(c1[0][3]) * c1[1][3]);
        *(v2u*)(Gb + (size_t)(pm * 256) * DFF + j0) = o0;
        *(v2u*)(Gb + (size_t)(pm * 256 + 1) * DFF + j0) = o1;
    }
}

__device__ __forceinline__ void p_sgate(Frame& F) {
    typedef short bf16x8 __attribute__((ext_vector_type(8))); typedef float f32x16 __attribute__((ext_vector_type(16)));
    const bf16* U = (const bf16*)(F.ws + WS_U); const bf16* V = (const bf16*)(F.ws + WS_V); const float* VS = (const float*)(F.ws + WS_VSQ); bf16* GT = (bf16*)(F.ws + WS_O);
    constexpr int PT = 136;
    LAS bf16* Wc = (LAS bf16*)(F.lds + RING_OFF);
    LAS bf16* vnT = Wc + 128 * PT;
    LAS float* rstat = (LAS float*)(F.lds + RING_OFF + 2 * 128 * PT * 2);
    const int lane = F.lane, r32 = lane & 31, hi = lane >> 5, tb = F.wave >> 1, dh = F.wave & 1;
    int gcur = -1;
    for (int item = blockIdx.x; item < 64 * 32; item += F.G) {
        const int g = item & 31, bc = item >> 5, r0 = bc * 128;
        if (g != gcur) {
            for (int idx = F.tid; idx < 128 * 32; idx += 512) { const int t = idx >> 5, s4 = (idx & 31) * 4;
                const f32x4 w = *(const f32x4*)(F.sg_w_s + (size_t)g * 16384 + t * 128 + s4);
                v2u o; o.x = pk2(s4 <= t ? w[0] : 0.f, s4 + 1 <= t ? w[1] : 0.f); o.y = pk2(s4 + 2 <= t ? w[2] : 0.f, s4 + 3 <= t ? w[3] : 0.f);
                *(LAS v2u*)(Wc + t * PT + s4) = o; }
            gcur = g;
        }
        if (F.tid < 128) { const float s1 = VS[2 * (r0 + F.tid)], s2 = VS[2 * (r0 + F.tid) + 1];
            const float mean = s1 * (1.0f / 4096.0f), var = s2 * (1.0f / 4096.0f) - mean * mean;
            rstat[2 * F.tid] = mean; rstat[2 * F.tid + 1] = 1.0f / sqrtf(var + NORM_EPS); }
        __syncthreads();
        { const int d8 = (F.tid & 15) * 8, col = g * 128 + d8;
          float gn[8], bs[8];
#pragma unroll
          for (int e = 0; e < 8; ++e) { gn[e] = F.sg_v_gain[col + e]; bs[e] = F.sg_v_bias[col + e]; }
          for (int s = F.tid >> 4; s < 128; s += 32) {
              float v8[8]; unpack8(*(const v4u*)(V + (size_t)(r0 + s) * DM + col), v8);
              const float mean = rstat[2 * s], rstd = rstat[2 * s + 1];
#pragma unroll
              for (int e = 0; e < 8; ++e) vnT[(d8 + e) * PT + s] = (bf16)f2bf((v8[e] - mean) * rstd * gn[e] + bs[e]);
          } }
        __syncthreads();
        f32x16 acc0 = {}, acc1 = {};
        const LAS bf16* ap = Wc + (32 * tb + r32) * PT + 8 * hi;
        const LAS bf16* bp0 = vnT + (64 * dh + r32) * PT + 8 * hi, * bp1 = bp0 + 32 * PT;
        for (int ks = 0; ks < 2 * tb + 2; ++ks) {
            const bf16x8 a = *(const LAS bf16x8*)(ap + 16 * ks), b0 = *(const LAS bf16x8*)(bp0 + 16 * ks), b1 = *(const LAS bf16x8*)(bp1 + 16 * ks);
            acc0 = __builtin_amdgcn_mfma_f32_32x32x16_bf16(a, b0, acc0, 0, 0, 0);
            acc1 = __builtin_amdgcn_mfma_f32_32x32x16_bf16(a, b1, acc1, 0, 0, 0);
        }
#pragma unroll
        for (int i = 0; i < 16; ++i) {
            const int t = 32 * tb + (i & 3) + 8 * (i >> 2) + 4 * hi;
            const float bsv = F.sg_b_s[g * 128 + t];
            const size_t o = (size_t)(r0 + t) * DM + g * 128 + 64 * dh + r32;
            GT[o] = (bf16)f2bf(bf1(U[o]) * (acc0[i] + bsv));
            GT[o + 32] = (bf16)f2bf(bf1(U[o + 32]) * (acc1[i] + bsv));
        }
        __syncthreads();
    }
}
constexpr int N_PHASES = 15;
struct Args { const void* in[19]; float* out; unsigned char* ws; int ph_lo, ph_hi, li, pad; };
__global__ void __launch_bounds__(NWAVES * 64, 2) mk_fwd(Args args) {
    extern __shared__ __attribute__((aligned(16))) unsigned char lds[];
    Frame F;
    F.lds = (LAS unsigned char*)lds;
    F.MISC = (volatile LAS unsigned*)(F.lds + MISC_OFF);
    F.tid = threadIdx.x; F.lane = F.tid & 63; F.wave = __builtin_amdgcn_readfirstlane(F.tid >> 6);
    F.G = gridDim.x; F.gw = blockIdx.x * NWAVES + F.wave; F.NGW = F.G * NWAVES;
    F.ws = args.ws; F.ctl = (unsigned*)(args.ws + WS_CTL);
    F.x = (const float*)args.in[0]; F.pos = (const int*)args.in[1];
    F.attn_norm = (const float*)args.in[2]; F.attn_w_in = (const float*)args.in[3]; F.attn_w_out = (const float*)args.in[4];
    F.sg_norm = (const float*)args.in[5]; F.sg_w_in = (const float*)args.in[6]; F.sg_b_in = (const float*)args.in[7]; F.sg_v_gain = (const float*)args.in[8]; F.sg_v_bias = (const float*)args.in[9];
    F.sg_w_s = (const float*)args.in[10]; F.sg_b_s = (const float*)args.in[11]; F.sg_w_out = (const float*)args.in[12];
    F.ffn_norm = (const float*)args.in[13]; F.ffn_w_up = (const float*)args.in[14]; F.ffn_conv_w = (const float*)args.in[15]; F.ffn_conv_b = (const float*)args.in[16]; F.ffn_w_down = (const float*)args.in[17];
    F.final_norm = (const float*)args.in[18]; F.out = args.out;
    for (int u = F.tid; u < (XTRA_OFF - LDSCTL_OFF) / 4; u += NWAVES * 64) ((LAS unsigned*)(F.lds + LDSCTL_OFF))[u] = 0u;
    __syncthreads();
    const int lo = args.ph_lo, hi = args.ph_hi;
    XcdBarrier bar; bar.bar = F.ctl + CW_BAR + args.li * XCD_BAR_WORDS; bar.x = 0; bar.st = nullptr;
    if (hi - lo > 1) bar = xcd_barrier_post(F.ctl + CW_BAR + args.li * XCD_BAR_WORDS, F.MISC + 8);
#define IN(k) (lo <= (k) && (k) < hi)
#define SEAM(k) do { if (IN(k) && IN((k) + 1)) xcd_barrier(bar); } while (0)
    unsigned char* ws = args.ws;
    bf16* XB = (bf16*)(ws + WS_XB); float* H = (float*)(ws + WS_H); bf16* O = (bf16*)(ws + WS_O); bf16* Gb = (bf16*)(ws + WS_G); bf16* AP = (bf16*)(ws + WS_APRE);
    float* SS = (float*)(ws + WS_SSQ); constexpr size_t SSF = SSQ_SITE / 4;
    const int c = (int)blockIdx.x;

    if (IN(0)) { p0_prologue(F); } SEAM(0);
    if (IN(1)) {
        pg8::Gemm g{XB, (const bf16*)(ws + WS_WIN), MR, QKVC, DM}; pg8::StaticOrder S; S.init(MR, QKVC, F.G, c);
        pg8::EpiQKV E{(bf16*)(ws + WS_QKV), SS, (const float*)(ws + WS_ROPE), (const float*)(ws + WS_ROPE) + MR * 16, (float*)(ws + WS_KMEAN)};
        pg8::gemm_phase<pg8::EpiQKV, pg8::StaticOrder, PG8_ALIGN, PG8_SP2>(F.lds + RING_OFF, g, S, E);
    } SEAM(1);
    if (IN(2)) { p_attn(F, (char*)lds + RING_OFF); } SEAM(2);
    if (IN(3)) { p_dilmerge(F);
#ifdef CHECK_ATTN
        xcd_barrier(bar); p_attn_naive(F, AP); xcd_barrier(bar);
        { unsigned bad = 0; for (size_t idx = (size_t)blockIdx.x * 512 + F.tid; idx < (size_t)MR * DM; idx += (size_t)F.G * 512) { const float a = bf1(O[idx]), b = bf1(AP[idx]); if (!(fabsf(a - b) <= 0.004f + 0.03f * fabsf(b))) ++bad; }
          if (bad) atomicAdd(F.ctl + 8, bad); }
#endif
    } SEAM(3);
    if (IN(4)) {
        pg8::Gemm g{O, (const bf16*)(ws + WS_WOUT), MR, DM, DM}; pg8::StaticOrder S; S.init(MR, DM, F.G, c);
        pg8::EpiRes E{F.x, H, XB, SS + 1 * SSF};
        pg8::gemm_phase<pg8::EpiRes, pg8::StaticOrder, PG8_ALIGN, PG8_SP2>(F.lds + RING_OFF, g, S, E);
    } SEAM(4);
    if (IN(5)) {
        pg8::Gemm g{XB, (const bf16*)(ws + WS_WUP), MR, F2, DM}; pg8::StaticOrder S; S.init(MR, F2, F.G, c);
        pg8::EpiUpConv E{Gb, SS + 1 * SSF, F.ffn_conv_w, F.ffn_conv_b, (float*)(ws + WS_TOP), (float*)(ws + WS_BOT), (LAS float*)(F.lds + XTRA_OFF)};
        pg8::gemm_phase<pg8::EpiUpConv, pg8::StaticOrder, true, PG8_SP2>(F.lds + RING_OFF, g, S, E);
    } SEAM(5);
    if (IN(6)) { p_convfix(F, 0); } SEAM(6);
    if (IN(7)) {
        pg8::Gemm g{Gb, (const bf16*)(ws + WS_WDOWN), MR, DM, DFF}; pg8::StaticOrder S; S.init(MR, DM, F.G, c);
        pg8::EpiRes E{H, H, XB, SS + 2 * SSF};
        pg8::gemm_phase<pg8::EpiRes, pg8::StaticOrder, PG8_ALIGN, PG8_SP2>(F.lds + RING_OFF, g, S, E);
    } SEAM(7);
    if (IN(8)) {
        pg8::Gemm g{XB, (const bf16*)(ws + WS_SGWIN), MR, 2 * DM, DM}; pg8::StaticOrder S; S.init(MR, 2 * DM, F.G, c);
        pg8::EpiSgIn E{(bf16*)(ws + WS_U), (bf16*)(ws + WS_V), SS + 2 * SSF, F.sg_b_in, (float*)(ws + WS_VSQ)};
        pg8::gemm_phase<pg8::EpiSgIn, pg8::StaticOrder, PG8_ALIGN, PG8_SP2>(F.lds + RING_OFF, g, S, E);
    } SEAM(8);
    if (IN(9)) { p_sgate(F); } SEAM(9);
    if (IN(10)) {
        pg8::Gemm g{O, (const bf16*)(ws + WS_SGWOUT), MR, DM, DM}; pg8::StaticOrder S; S.init(MR, DM, F.G, c);
        pg8::EpiRes E{H, H, XB, SS + 3 * SSF};
        pg8::gemm_phase<pg8::EpiRes, pg8::StaticOrder, PG8_ALIGN, PG8_SP2>(F.lds + RING_OFF, g, S, E);
    } SEAM(10);
    if (IN(11)) {
        pg8::Gemm g{XB, (const bf16*)(ws + WS_WUP + WUP_L), MR, F2, DM}; pg8::StaticOrder S; S.init(MR, F2, F.G, c);
        pg8::EpiUpConv E{Gb, SS + 3 * SSF, F.ffn_conv_w + 3 * F2, F.ffn_conv_b + F2, (float*)(ws + WS_TOP), (float*)(ws + WS_BOT), (LAS float*)(F.lds + XTRA_OFF)};
        pg8::gemm_phase<pg8::EpiUpConv, pg8::StaticOrder, true, PG8_SP2>(F.lds + RING_OFF, g, S, E);
    } SEAM(11);
    if (IN(12)) { p_convfix(F, 1); } SEAM(12);
    if (IN(13)) {
        pg8::Gemm g{Gb, (const bf16*)(ws + WS_WDOWN + WDOWN_L), MR, DM, DFF}; pg8::StaticOrder S; S.init(MR, DM, F.G, c);
        pg8::EpiRes E{H, H, XB, SS + 4 * SSF};
        pg8::gemm_phase<pg8::EpiRes, pg8::StaticOrder, PG8_ALIGN, PG8_SP2>(F.lds + RING_OFF, g, S, E);
    } SEAM(13);
    if (IN(14)) { p_final(F); }
#undef IN
#undef SEAM
}

extern "C" void kernel_launch(void* const* d_in, const int* in_sizes, int n_in, void* d_out, int out_size, void* d_ws, size_t ws_size, hipStream_t stream) {
    static int grid = 0;
    if (grid == 0) {
        if (n_in != 19 || out_size != MR * DM || ws_size < WS_END) { fprintf(stderr, "kernel_launch: unexpected shapes (n_in %d, out %d, ws %zu); nothing launched\n", n_in, out_size, ws_size); grid = -1; return; }
        int dev = 0, cus = 0, per_cu = 0;
        if (hipGetDevice(&dev) != hipSuccess || hipDeviceGetAttribute(&cus, hipDeviceAttributeMultiprocessorCount, dev) != hipSuccess) { grid = -1; return; }
        if (hipFuncSetAttribute((const void*)mk_fwd, hipFuncAttributeMaxDynamicSharedMemorySize, LDS_BYTES) != hipSuccess) { fprintf(stderr, "kernel_launch: hipFuncSetAttribute failed\n"); grid = -1; return; }
        if (hipOccupancyMaxActiveBlocksPerMultiprocessor(&per_cu, (const void*)mk_fwd, NWAVES * 64, LDS_BYTES) != hipSuccess || per_cu < 1) fprintf(stderr, "kernel_launch: occupancy query reports %d\n", per_cu);
        (void)hipGetLastError();
        grid = cus;
    }
    if (grid < 0) return;
    if (hipMemsetAsync((char*)d_ws + WS_CTL, 0, CTL_ZERO_BYTES, stream) != hipSuccess) return;
    Args a{};
    for (int i = 0; i < 19; ++i) a.in[i] = d_in[i];
    a.out = (float*)d_out; a.ws = (unsigned char*)d_ws; a.pad = 0;
    if (MK_N_LAUNCHES == 1) {
        a.ph_lo = 0; a.ph_hi = N_PHASES; a.li = 0;
        hipLaunchKernelGGL(mk_fwd, dim3(grid), dim3(NWAVES * 64), LDS_BYTES, stream, a);
    } else {
        for (int p = 0; p < N_PHASES; ++p) { a.ph_lo = p; a.ph_hi = p + 1; a.li = 0; hipLaunchKernelGGL(mk_fwd, dim3(grid), dim3(NWAVES * 64), LDS_BYTES, stream, a);
#ifdef PROBE_MASK
            if ((PROBE_MASK >> p) & 1) hipLaunchKernelGGL(mk_fwd, dim3(grid), dim3(NWAVES * 64), LDS_BYTES, stream, a);
#endif
        }
    }
}
```

```cpp
#include <hip/hip_runtime.h>
#include <cstdio>
#include <cstdint>
#ifndef MK_N_LAUNCHES
#define MK_N_LAUNCHES 1
#endif
namespace pg8 {
#define PG8_LAS __attribute__((address_space(3)))
typedef unsigned short bf16_t;
typedef short bf16x8 __attribute__((ext_vector_type(8)));
typedef float f32x4 __attribute__((ext_vector_type(4)));
typedef unsigned u32x4 __attribute__((ext_vector_type(4)));
constexpr int BM = 256, BK = 64, HALF = 128, HTB = HALF * BK * 2  , STAGE_BYTES = 8 * HTB, NXCD = 8, WGM = 8;

__host__ __device__ __forceinline__ int lds_byte(int r, int c) { const int st = (r >> 4) * 2 + (c >> 5), rr = r & 15, cc = c & 31, ob = rr * 64 + cc * 2; return st * 1024 + (ob ^ (((ob >> 9) & 1) << 5)); }
__host__ __device__ __forceinline__ void stage_rc(int b, int& R, int& C) { const int st = b / 1024, sb = b % 1024, swz = sb ^ (((sb >> 9) & 1) << 5); R = (st >> 1) * 16 + swz / 64; C = (st & 1) * 32 + (swz % 64) / 2; }
__host__ __device__ __forceinline__ int perm32(int rho) { const int n = rho >> 4, i = rho & 15; return 8 * (i >> 2) + 4 * n + (i & 3); }

struct Unit { int pm, pn; };
struct Gemm { const bf16_t* A; const bf16_t* Bt; int M, N, K; };

struct StaticOrder {
    int nM, nN, nwg, G, c, same;
    __host__ __device__ void init(int M, int N, int G_, int c_) { nM = M / BM; nN = N / BM; nwg = nM * nN; G = G_; c = c_; same = -1; }
    __host__ __device__ bool next(int i, Unit& u) const {
        const long L = (long)i * G + c; if (L >= nwg) return false;
        int wgid = (int)L; { const int q = nwg / NXCD, r = nwg % NXCD, xcd = wgid % NXCD, off = wgid / NXCD; wgid = (xcd < r ? xcd * (q + 1) : r * (q + 1) + (xcd - r) * q) + off; }
        const int nig = WGM * nN, gid = wgid / nig, fm = gid * WGM, gsz = (nM - fm) < WGM ? (nM - fm) : WGM;
        u.pm = fm + ((wgid % nig) % gsz); u.pn = (wgid % nig) / gsz; u.pm &= same; u.pn &= same; return true;
    }
    __device__ __forceinline__ void a_ready(const Unit&) const {}
    __device__ __forceinline__ void done(const Unit&) const {}
};
__device__ __forceinline__ unsigned cvt_pk_bf16(float lo, float hi) { unsigned r; asm volatile("v_cvt_pk_bf16_f32 %0, %1, %2" : "=v"(r) : "v"(lo), "v"(hi)); return r; }
typedef float f32x2 __attribute__((ext_vector_type(2)));
__device__ __forceinline__ f32x2 gelu_pk(f32x2 v) {
    const f32x2 av = __builtin_elementwise_abs(v), d = av * 0.2316418882f + 1.0f;
    f32x2 t; t.x = __builtin_amdgcn_rcpf(d.x); t.y = __builtin_amdgcn_rcpf(d.y);
    f32x2 q = t * 0.5307027145f + (-0.7265760135f); q = q * t + 0.7107068705f; q = q * t + (-0.142248368f); q = q * t + 0.127414796f; q = q * t;
    const f32x2 s = (v * v) * (-0.72134752044f);
    f32x2 e; e.x = __builtin_amdgcn_exp2f(s.x); e.y = __builtin_amdgcn_exp2f(s.y);
    const f32x2 m = v * (q * e), r = v - m;
    f32x2 o; o.x = v.x < 0.f ? m.x : r.x; o.y = v.y < 0.f ? m.y : r.y; return o;
}
typedef unsigned u32x2 __attribute__((ext_vector_type(2)));
typedef int i32x4 __attribute__((ext_vector_type(4)));
template <bool I8> struct AccT { typedef f32x4 type; };
template <> struct AccT<true> { typedef i32x4 type; };
__device__ __forceinline__ f32x4 tof(f32x4 a) { return a; }
__device__ __forceinline__ f32x4 tof(i32x4 a) { return (f32x4){(float)a[0], (float)a[1], (float)a[2], (float)a[3]}; }
__device__ __forceinline__ float rstd_from_ss(const float* ss, int r) { return 1.0f / sqrtf(ss[r] * (1.0f / 4096.0f) + 1e-5f); }

struct EpiQKV {
    static constexpr bool PERM = false, AFTER_DRAIN = false, I8 = false;
    bf16_t* qkv; const float* ss; const float* ropec; const float* ropes; float* km;
    __device__ __forceinline__ void operator()(const f32x4 (&acc)[2][2][4][2], const Unit& u, int wr, int wc, int fr, int fq) const {
        const int row0 = u.pm * BM + wr * 64 + fr;
        const bool kmu = u.pn >= 24 && u.pn < 36;
        const bool rot = wc == 0 && u.pn < 48;
        f32x4 cs[2][2];
#pragma unroll
        for (int bj = 0; bj < 2; ++bj)
#pragma unroll
            for (int n = 0; n < 2; ++n) cs[bj][n] = (f32x4){0.f, 0.f, 0.f, 0.f};
#pragma unroll
        for (int ai = 0; ai < 2; ++ai) {
            float rs[4]; f32x4 cz[4], sn[4];
#pragma unroll
            for (int m = 0; m < 4; ++m) { const int r = row0 + ai * HALF + m * 16; rs[m] = ss[r];
                cz[m] = (f32x4){1.f, 1.f, 1.f, 1.f}; sn[m] = (f32x4){0.f, 0.f, 0.f, 0.f};
                if (rot) { cz[m] = *(const f32x4*)(ropec + (size_t)r * 16 + 4 * fq); sn[m] = *(const f32x4*)(ropes + (size_t)r * 16 + 4 * fq); } }
#pragma unroll
            for (int m = 0; m < 4; ++m) {
                const int r = row0 + ai * HALF + m * 16;
                const float rsv = 1.0f / sqrtf(rs[m] * (1.0f / 4096.0f) + 1e-5f);
                const int b = r >> 12, s = r & 4095;
#pragma unroll
                for (int bj = 0; bj < 2; ++bj) {
                    const int colh = 2 * u.pn + bj, which = colh / 48, head = colh - which * 48;
                    bf16_t* dst = qkv + ((size_t)((which * 2 + b) * 48 + head) * 4096 + s) * 128 + wc * 32 + 4 * fq;
                    f32x4 v0 = acc[ai][bj][m][0] * rsv, v1 = acc[ai][bj][m][1] * rsv;
                    if (rot) { const f32x4 n0 = v0 * cz[m] - v1 * sn[m], n1 = v1 * cz[m] + v0 * sn[m]; v0 = n0; v1 = n1; }
                    if (kmu) { cs[bj][0] += v0; cs[bj][1] += v1; }
                    u32x2 w0, w1; w0.x = cvt_pk_bf16(v0[0], v0[1]); w0.y = cvt_pk_bf16(v0[2], v0[3]); w1.x = cvt_pk_bf16(v1[0], v1[1]); w1.y = cvt_pk_bf16(v1[2], v1[3]);
                    *(u32x2*)(dst) = w0; *(u32x2*)(dst + 16) = w1;
                }
            }
            asm volatile("" ::: "memory");
        }
        if (kmu) {
            const int b = u.pm >> 4, blk = u.pm & 15;
#pragma unroll
            for (int bj = 0; bj < 2; ++bj) {
                const int head = 2 * u.pn + bj - 48;
                float* dst = km + ((size_t)((b * 24 + head) * 16 + blk)) * 128 + wc * 32 + 4 * fq;
#pragma unroll
                for (int n = 0; n < 2; ++n)
#pragma unroll
                    for (int j = 0; j < 4; ++j) {
                        float v = cs[bj][n][j];
                        v += __shfl_xor(v, 1); v += __shfl_xor(v, 2); v += __shfl_xor(v, 4); v += __shfl_xor(v, 8);
                        if (fr == 0) atomicAdd(dst + 16 * n + j, v * (1.0f / 256.0f));
                    }
            }
        }
    }
};

struct EpiRes {
    static constexpr bool PERM = false, AFTER_DRAIN = false, I8 = false;
    const float* hin; float* hout; bf16_t* xb; float* ss;
    __device__ __forceinline__ void operator()(const f32x4 (&acc)[2][2][4][2], const Unit& u, int wr, int wc, int fr, int fq) const {
        const int row0 = u.pm * BM + wr * 64 + fr, col0 = u.pn * BM + wc * 32 + 4 * fq;
#pragma unroll
        for (int ai = 0; ai < 2; ++ai) {
            f32x4 h[4][2][2];
#pragma unroll
            for (int m = 0; m < 4; ++m)
#pragma unroll
                for (int bj = 0; bj < 2; ++bj)
#pragma unroll
                    for (int n = 0; n < 2; ++n) h[m][bj][n] = *(const f32x4*)(hin + (size_t)(row0 + ai * HALF + m * 16) * 4096 + col0 + bj * HALF + n * 16);
#pragma unroll
            for (int m = 0; m < 4; ++m) {
                const int r = row0 + ai * HALF + m * 16; const size_t off = (size_t)r * 4096 + col0;
                float sq = 0.f;
#pragma unroll
                for (int bj = 0; bj < 2; ++bj)
#pragma unroll
                    for (int n = 0; n < 2; ++n) {
                        const f32x4 hv = h[m][bj][n] + acc[ai][bj][m][n];
                        *(f32x4*)(hout + off + bj * HALF + n * 16) = hv;
                        u32x2 w; w.x = cvt_pk_bf16(hv[0], hv[1]); w.y = cvt_pk_bf16(hv[2], hv[3]);
                        *(u32x2*)(xb + off + bj * HALF + n * 16) = w;
                        sq += (hv[0] * hv[0] + hv[1] * hv[1]) + (hv[2] * hv[2] + hv[3] * hv[3]);
                    }
                sq += __shfl_xor(sq, 16); sq += __shfl_xor(sq, 32);
                if (fq == 0) atomicAdd(ss + r, sq);
            }
            asm volatile("" ::: "memory");
        }
    }
};

struct EpiUpPre {
    static constexpr bool PERM = true, AFTER_DRAIN = false, I8 = false;
    bf16_t* apre; const float* ss;
    __device__ __forceinline__ void operator()(const f32x4 (&acc)[2][2][4][2], const Unit& u, int wr, int wc, int fr, int fq) const {
        const int row0 = u.pm * BM + wr * 64 + fr, col0 = u.pn * 128 + wc * 32 + 8 * fq;
#pragma unroll
        for (int ai = 0; ai < 2; ++ai)
#pragma unroll
            for (int m = 0; m < 4; ++m) {
                const int r = row0 + ai * HALF + m * 16;
                const float rs = rstd_from_ss(ss, r);
                bf16_t* rowp = apre + (size_t)r * 28672 + col0;
#pragma unroll
                for (int bj = 0; bj < 2; ++bj) {
                    const f32x4 v0 = acc[ai][bj][m][0] * rs, v1 = acc[ai][bj][m][1] * rs;
                    u32x4 w; w.x = cvt_pk_bf16(v0[0], v0[1]); w.y = cvt_pk_bf16(v0[2], v0[3]); w.z = cvt_pk_bf16(v1[0], v1[1]); w.w = cvt_pk_bf16(v1[2], v1[3]);
                    *(u32x4*)(rowp + bj * 14336) = w;
                }
                asm volatile("" ::: "memory");
            }
    }
};

struct EpiSgIn {
    static constexpr bool PERM = true, AFTER_DRAIN = false, I8 = false;
    bf16_t* U; bf16_t* V; const float* ss; const float* bias; float* vs;
    __device__ __forceinline__ void operator()(const f32x4 (&acc)[2][2][4][2], const Unit& u, int wr, int wc, int fr, int fq) const {
        const int row0 = u.pm * BM + wr * 64 + fr, gcol0 = u.pn * BM + wc * 32 + 8 * fq;
        const bool isv = u.pn >= 16;
        bf16_t* base = isv ? V : U; const int col0 = isv ? gcol0 - 4096 : gcol0;
        f32x4 bv[2][2];
#pragma unroll
        for (int bj = 0; bj < 2; ++bj)
#pragma unroll
            for (int n = 0; n < 2; ++n) bv[bj][n] = *(const f32x4*)(bias + gcol0 + bj * HALF + 4 * n);
        float rsq[2][4];
#pragma unroll
        for (int ai = 0; ai < 2; ++ai)
#pragma unroll
            for (int m = 0; m < 4; ++m) rsq[ai][m] = ss[row0 + ai * HALF + m * 16];
#pragma unroll
        for (int ai = 0; ai < 2; ++ai)
#pragma unroll
            for (int m = 0; m < 4; ++m) {
                const int r = row0 + ai * HALF + m * 16;
                const float rs = 1.0f / sqrtf(rsq[ai][m] * (1.0f / 4096.0f) + 1e-5f);
                bf16_t* rowp = base + (size_t)r * 4096 + col0;
                float s1 = 0.f, s2 = 0.f;
#pragma unroll
                for (int bj = 0; bj < 2; ++bj) {
                    f32x4 v0 = acc[ai][bj][m][0] * rs + bv[bj][0], v1 = acc[ai][bj][m][1] * rs + bv[bj][1];
                    const f32x2 a = gelu_pk((f32x2){v0[0], v0[1]}), b = gelu_pk((f32x2){v0[2], v0[3]}), c = gelu_pk((f32x2){v1[0], v1[1]}), d = gelu_pk((f32x2){v1[2], v1[3]});
                    s1 += (a.x + a.y) + (b.x + b.y) + (c.x + c.y) + (d.x + d.y);
                    s2 += (a.x * a.x + a.y * a.y) + (b.x * b.x + b.y * b.y) + (c.x * c.x + c.y * c.y) + (d.x * d.x + d.y * d.y);
                    u32x4 w; w.x = cvt_pk_bf16(a.x, a.y); w.y = cvt_pk_bf16(b.x, b.y); w.z = cvt_pk_bf16(c.x, c.y); w.w = cvt_pk_bf16(d.x, d.y);
                    *(u32x4*)(rowp + bj * HALF) = w;
                }
                if (isv) {
                    s1 += __shfl_xor(s1, 16); s1 += __shfl_xor(s1, 32); s2 += __shfl_xor(s2, 16); s2 += __shfl_xor(s2, 32);
                    if (fq == 0) { atomicAdd(vs + 2 * r, s1); atomicAdd(vs + 2 * r + 1, s2); }
                }
            }
    }
};

#define PG8_DPP(oldv, srcv, ctrl) __builtin_bit_cast(float, __builtin_amdgcn_update_dpp(__builtin_bit_cast(int, (float)(oldv)), __builtin_bit_cast(int, (float)(srcv)), (ctrl), 0xf, 0xf, false))
template <bool Q8> struct EpiUpConvT {
    static constexpr bool PERM = true, AFTER_DRAIN = false, I8 = Q8;
    typedef typename AccT<Q8>::type acc_t;
    bf16_t* G; const float* ss; const float* cw; const float* cb; float* top; float* bot; PG8_LAS float* xch; const float* sa; const float* sw;
    __device__ __forceinline__ static float silu(float x) { return x * __builtin_amdgcn_rcpf(1.0f + __builtin_amdgcn_exp2f(-1.4426950408889634f * x)); }
    __device__ __forceinline__ void operator()(const acc_t (&acc)[2][2][4][2], const Unit& u, int wr, int wc, int fr_in, int fq_in) const {
        int fr = fr_in, fq = fq_in; asm volatile("" : "+v"(fr), "+v"(fq));
        const int row0 = u.pm * BM + wr * 64 + fr, colg = u.pn * 128 + wc * 32 + 8 * fq;
        float rs[2][4];
#pragma unroll
        for (int ai = 0; ai < 2; ++ai)
#pragma unroll
            for (int m = 0; m < 4; ++m) rs[ai][m] = ss[row0 + ai * HALF + m * 16];
        float sar[2][4];
#pragma unroll
        for (int ai = 0; ai < 2; ++ai)
#pragma unroll
            for (int m = 0; m < 4; ++m) sar[ai][m] = Q8 ? sa[row0 + ai * HALF + m * 16] : 1.0f;

        PG8_LAS float* wl = xch + 2048;
        { const int t = (wr * 4 + wc) * 64 + fq * 16 + fr, arr = t >> 7, c2 = (t & 127) * 2, gcol = (c2 < 128 ? 0 : 14336 - 128) + u.pn * 128 + c2;
          const f32x2 wv = *(const f32x2*)((arr < 3 ? cw + arr * 28672 : cb) + gcol);
          *(PG8_LAS f32x2*)(wl + arr * 256 + c2) = wv;
          if (Q8 && t < 128) *(PG8_LAS f32x2*)(wl + 1024 + 2 * t) = *(const f32x2*)(sw + u.pn * 256 + 2 * t); }
#pragma unroll
        for (int ai = 0; ai < 2; ++ai)
#pragma unroll
            for (int m = 0; m < 4; ++m) rs[ai][m] = sar[ai][m] / sqrtf(rs[ai][m] * (1.0f / 4096.0f) + 1e-5f);
#pragma unroll
        for (int ai = 0; ai < 2; ++ai)
#pragma unroll
            for (int bj = 0; bj < 2; ++bj)
#pragma unroll
                for (int n = 0; n < 2; ++n) {
                    const f32x4 v = tof(acc[ai][bj][3][n]) * rs[ai][3];
                    if (fr >= 14) {
                        *(PG8_LAS f32x4*)(xch + ((((((ai * 2 + wr) * 4 + wc) * 2 + bj) * 2 + n) * 4 + fq) * 2 + (fr - 14)) * 4) = v;
                        if (ai == 1 && wr == 1) { f32x4 vs = v; if (Q8) vs = vs * *(const f32x4*)(sw + u.pn * 256 + bj * 128 + wc * 32 + 8 * fq + 4 * n);
                            *(f32x4*)(bot + ((size_t)(u.pm * 2 + (fr - 14)) * 28672) + bj * 14336 + colg + 4 * n) = vs; }
                    }
                }
        if (wr == 0 && fr < 2) {
#pragma unroll
            for (int bj = 0; bj < 2; ++bj)
#pragma unroll
                for (int n = 0; n < 2; ++n) { f32x4 vs = tof(acc[0][bj][0][n]) * rs[0][0]; if (Q8) vs = vs * *(const f32x4*)(sw + u.pn * 256 + bj * 128 + wc * 32 + 8 * fq + 4 * n);
                    *(f32x4*)(top + ((size_t)(u.pm * 2 + fr) * 28672) + bj * 14336 + colg + 4 * n) = vs; }
        }
        asm volatile("s_waitcnt lgkmcnt(0)" ::: "memory"); __builtin_amdgcn_s_barrier(); asm volatile("" ::: "memory");
#pragma unroll
        for (int n = 0; n < 2; ++n) {
            f32x4 w0[2], w1[2], w2[2], cbv[2];
#pragma unroll
            for (int bj = 0; bj < 2; ++bj) { const int lc = bj * 128 + wc * 32 + 8 * fq + 4 * n;
                w0[bj] = *(const PG8_LAS f32x4*)(wl + lc); w1[bj] = *(const PG8_LAS f32x4*)(wl + 256 + lc); w2[bj] = *(const PG8_LAS f32x4*)(wl + 512 + lc); cbv[bj] = *(const PG8_LAS f32x4*)(wl + 768 + lc);
                if (Q8) { const f32x4 sc = *(const PG8_LAS f32x4*)(wl + 1024 + lc); w0[bj] = w0[bj] * sc; w1[bj] = w1[bj] * sc; w2[bj] = w2[bj] * sc; } }
#pragma unroll
            for (int ai = 0; ai < 2; ++ai) {
                f32x4 prev[2];
                const bool has = !(ai == 0 && wr == 0);
                const int pai = wr == 1 ? ai : 0, pwr = wr == 1 ? 0 : 1;
#pragma unroll
                for (int bj = 0; bj < 2; ++bj) {
                    prev[bj] = (f32x4){0.f, 0.f, 0.f, 0.f};
                    if (has && fr >= 14) prev[bj] = *(const PG8_LAS f32x4*)(xch + ((((((pai * 2 + pwr) * 4 + wc) * 2 + bj) * 2 + n) * 4 + fq) * 2 + (fr - 14)) * 4);
                }
#pragma unroll
                for (int m = 0; m < 4; ++m) {
                    f32x4 cv[2];
#pragma unroll
                    for (int bj = 0; bj < 2; ++bj) {
                        const f32x4 cur = tof(acc[ai][bj][m][n]) * rs[ai][m];
#pragma unroll
                        for (int j = 0; j < 4; ++j) {
                            const float r1 = PG8_DPP(0.f, prev[bj][j], 0x121), r2 = PG8_DPP(0.f, prev[bj][j], 0x122);
                            const float p1 = PG8_DPP(r1, cur[j], 0x111), p2 = PG8_DPP(r2, cur[j], 0x112);
                            cv[bj][j] = cbv[bj][j] + w0[bj][j] * p2 + w1[bj][j] * p1 + w2[bj][j] * cur[j];
                        }
                        prev[bj] = cur;
                    }
                    u32x2 w; w.x = cvt_pk_bf16(silu(cv[0][0]) * cv[1][0], silu(cv[0][1]) * cv[1][1]); w.y = cvt_pk_bf16(silu(cv[0][2]) * cv[1][2], silu(cv[0][3]) * cv[1][3]);
                    *(u32x2*)(G + (size_t)(row0 + ai * HALF + m * 16) * 14336 + colg + 4 * n) = w;
                    asm volatile("" ::: "memory");
                }
            }
            asm volatile("" ::: "memory");
        }
    }
};

typedef EpiUpConvT<false> EpiUpConv;
typedef EpiUpConvT<true> EpiUpConv8;
struct EpiNull {
    static constexpr bool PERM = true, AFTER_DRAIN = false, I8 = false;
    float* sink; int never;
    __device__ __forceinline__ void operator()(const f32x4 (&acc)[2][2][4][2], const Unit& u, int wr, int wc, int fr, int fq) const {
        if (never == 12345) {
#pragma unroll
            for (int ai = 0; ai < 2; ++ai)
#pragma unroll
                for (int bj = 0; bj < 2; ++bj)
#pragma unroll
                    for (int m = 0; m < 4; ++m)
#pragma unroll
                        for (int n = 0; n < 2; ++n) *(f32x4*)(sink + ((((ai * 2 + bj) * 4 + m) * 2 + n) * 512 + threadIdx.x) * 4) = acc[ai][bj][m][n];
        }
    }
};
__device__ __forceinline__ f32x4 mma16(bf16x8 a, bf16x8 b, f32x4 c) { return __builtin_amdgcn_mfma_f32_16x16x32_bf16(a, b, c, 0, 0, 0); }
__device__ __forceinline__ i32x4 mma16(bf16x8 a, bf16x8 b, i32x4 c) { return __builtin_amdgcn_mfma_i32_16x16x64_i8(__builtin_bit_cast(i32x4, a), __builtin_bit_cast(i32x4, b), c, 0, 0, 0); }
template <class Epi, class Sched, bool ALIGN_EPI = false, bool SP2 = false>
__device__ __forceinline__ void gemm_phase(PG8_LAS unsigned char* lds, const Gemm g, const Sched& S, const Epi& E) {
    constexpr bool I8 = Epi::I8;
    typedef typename AccT<I8>::type acc_t;
    const int tid = threadIdx.x, wid = __builtin_amdgcn_readfirstlane(tid >> 6), lane = tid & 63, wr = wid >> 2, wc = wid & 3, fr = lane & 15, fq = lane >> 4;
    const int K = g.K, nt = K / BK;
    unsigned voffA[2], voffB[2];
#pragma unroll
    for (int i = 0; i < 2; ++i) { int R, C; stage_rc(tid * 16 + i * 8192, R, C); const int Rb = Epi::PERM ? ((R & ~31) + perm32(R & 31)) : R;
        voffA[i] = (unsigned)(R * K + C) * 2u; voffB[i] = (unsigned)(Rb * K + C) * 2u; }
    const size_t kstep = (size_t)(BK * 2);
    const size_t hstep = (size_t)HALF * K * 2;
    const size_t tstep = 2 * hstep;
    const unsigned ldsw = (unsigned)wid * 1024u;
    const int aoff = lds_byte(wr * 64 + fr, fq * 8), boff = lds_byte(wc * 32 + fr, fq * 8);
#define PG8_SA(b, h) (((b) * 2 + (h)) * HTB)
#define PG8_SB(b, h) ((4 + (b) * 2 + (h)) * HTB)
#define PG8_STAGE(bufoff, gbase, voff) do { _Pragma("unroll") for (int _i = 0; _i < 2; ++_i) \
        __builtin_amdgcn_global_load_lds((const unsigned*)((const char*)(gbase) + (voff)[_i]), (PG8_LAS unsigned*)(lds + (bufoff) + ldsw + _i * 8192), 16, 0, 0); } while (0)
#define PG8_LDA(dst, b, h) do { _Pragma("unroll") for (int m = 0; m < 4; ++m) _Pragma("unroll") for (int k = 0; k < 2; ++k) dst[m][k] = *(const PG8_LAS bf16x8*)(lds + PG8_SA(b, h) + aoff + m * 2048 + k * 1024); } while (0)
#define PG8_LDB(dst, b, h) do { _Pragma("unroll") for (int n = 0; n < 2; ++n) _Pragma("unroll") for (int k = 0; k < 2; ++k) dst[n][k] = *(const PG8_LAS bf16x8*)(lds + PG8_SB(b, h) + boff + n * 2048 + k * 1024); } while (0)
#define PG8_MMA(ai, bj, At, Bt) do { __builtin_amdgcn_s_setprio(1); _Pragma("unroll") for (int m = 0; m < 4; ++m) _Pragma("unroll") for (int n = 0; n < 2; ++n) _Pragma("unroll") for (int k = 0; k < 2; ++k) \
        acc[ai][bj][m][n] = mma16(Bt[n][k], At[m][k], acc[ai][bj][m][n]); __builtin_amdgcn_s_setprio(0); } while (0)
#define PG8_WAIT_V(n) asm volatile("s_waitcnt vmcnt(" #n ")" ::: "memory")
#define PG8_WAIT_L(n) asm volatile("s_waitcnt lgkmcnt(" #n ")" ::: "memory")
#define PG8_BAR __builtin_amdgcn_s_barrier()
#define PG8_SCHED __builtin_amdgcn_sched_barrier(0)
    Unit cur, nxt; int ui = 0;
    if (!S.next(0, cur)) return;
    acc_t acc[2][2][4][2];
#pragma unroll
    for (int a = 0; a < 2; ++a)
#pragma unroll
        for (int b = 0; b < 2; ++b)
#pragma unroll
            for (int m = 0; m < 4; ++m)
#pragma unroll
                for (int n = 0; n < 2; ++n) acc[a][b][m][n] = acc_t{};
    bf16x8 At[4][2], B0[2][2], B1[2][2];
    const char* cA = (const char*)g.A + (size_t)cur.pm * tstep; const char* cB = (const char*)g.Bt + (size_t)cur.pn * tstep;
    S.a_ready(cur);
    if constexpr (SP2) {
        PG8_STAGE(PG8_SB(0, 0), cB, voffB); PG8_STAGE(PG8_SB(0, 1), cB + hstep, voffB); PG8_STAGE(PG8_SA(0, 0), cA, voffA); PG8_STAGE(PG8_SA(0, 1), cA + hstep, voffA);
        if (wr == 1) PG8_BAR;
        PG8_WAIT_V(2); PG8_BAR;
        PG8_STAGE(PG8_SB(1, 0), cB + kstep, voffB); PG8_STAGE(PG8_SA(1, 0), cA + kstep, voffA); PG8_STAGE(PG8_SB(1, 1), cB + hstep + kstep, voffB);
        PG8_WAIT_V(6); PG8_BAR;
    } else {
        PG8_STAGE(PG8_SB(0, 0), cB, voffB); PG8_STAGE(PG8_SA(0, 0), cA, voffA); PG8_STAGE(PG8_SB(0, 1), cB + hstep, voffB); PG8_STAGE(PG8_SA(0, 1), cA + hstep, voffA);
        if (wr == 1) PG8_BAR;
        PG8_WAIT_V(4); PG8_BAR;
        PG8_STAGE(PG8_SB(1, 0), cB + kstep, voffB); PG8_STAGE(PG8_SA(1, 0), cA + kstep, voffA); PG8_STAGE(PG8_SB(1, 1), cB + hstep + kstep, voffB);
        PG8_WAIT_V(6); PG8_BAR;
    }
    for (;;) {
        const bool has_next = S.next(ui + 1, nxt);
        const char* nA = has_next ? (const char*)g.A + (size_t)nxt.pm * tstep : cA; const char* nB = has_next ? (const char*)g.Bt + (size_t)nxt.pn * tstep : cB;
        for (int t = 0; t < nt; t += 2) {
            const bool last = (t == nt - 2);
            const char* a1 = cA + (size_t)(t + 1) * kstep;
            const char* a2 = last ? nA : cA + (size_t)(t + 2) * kstep; const char* b2 = last ? nB : cB + (size_t)(t + 2) * kstep;
            const char* a3 = a2 + kstep; const char* b3 = b2 + kstep;
            if (last && has_next) S.a_ready(nxt);
            if constexpr (SP2) {
            PG8_LDB(B0, 0, 0); PG8_LDB(B1, 0, 1); PG8_SCHED; PG8_LDA(At, 0, 0); PG8_STAGE(PG8_SA(1, 1), a1 + hstep, voffA);
            PG8_WAIT_V(8); PG8_WAIT_L(0); PG8_BAR; PG8_MMA(0, 0, At, B0); PG8_MMA(0, 1, At, B1); PG8_BAR; PG8_SCHED;
            PG8_LDA(At, 0, 1); PG8_STAGE(PG8_SB(0, 0), b2, voffB); PG8_STAGE(PG8_SB(0, 1), b2 + hstep, voffB); PG8_STAGE(PG8_SA(0, 0), a2, voffA);
            PG8_WAIT_V(8); PG8_WAIT_L(0); PG8_BAR; PG8_MMA(1, 0, At, B0); PG8_MMA(1, 1, At, B1); PG8_BAR; PG8_SCHED;
            PG8_LDB(B0, 1, 0); PG8_LDB(B1, 1, 1); PG8_SCHED; PG8_LDA(At, 1, 0); PG8_STAGE(PG8_SA(0, 1), a2 + hstep, voffA);
            PG8_WAIT_V(8); PG8_WAIT_L(0); PG8_BAR; PG8_MMA(0, 0, At, B0); PG8_MMA(0, 1, At, B1); PG8_BAR; PG8_SCHED;
            PG8_LDA(At, 1, 1); PG8_STAGE(PG8_SB(1, 0), b3, voffB); PG8_STAGE(PG8_SB(1, 1), b3 + hstep, voffB); PG8_STAGE(PG8_SA(1, 0), a3, voffA);
            PG8_WAIT_V(8); PG8_WAIT_L(0); PG8_BAR; PG8_MMA(1, 0, At, B0); PG8_MMA(1, 1, At, B1); PG8_BAR; PG8_SCHED;
            } else {
            PG8_LDB(B0, 0, 0); PG8_SCHED; PG8_LDA(At, 0, 0); PG8_STAGE(PG8_SA(1, 1), a1 + hstep, voffA);
            PG8_WAIT_L(8); PG8_BAR; PG8_WAIT_L(0); PG8_MMA(0, 0, At, B0); PG8_BAR; PG8_SCHED;
            PG8_LDB(B1, 0, 1); PG8_STAGE(PG8_SB(0, 0), b2, voffB);
            PG8_BAR; PG8_WAIT_L(0); PG8_MMA(0, 1, At, B1); PG8_BAR;
            PG8_LDA(At, 0, 1); PG8_STAGE(PG8_SA(0, 0), a2, voffA);
            PG8_BAR; PG8_WAIT_L(0); PG8_MMA(1, 0, At, B0); PG8_BAR; PG8_SCHED;
            PG8_STAGE(PG8_SB(0, 1), b2 + hstep, voffB);
            PG8_WAIT_V(6); PG8_BAR; PG8_MMA(1, 1, At, B1); PG8_BAR;
            PG8_LDB(B0, 1, 0); PG8_SCHED; PG8_LDA(At, 1, 0); PG8_STAGE(PG8_SA(0, 1), a2 + hstep, voffA);
            PG8_WAIT_L(8); PG8_BAR; PG8_WAIT_L(0); PG8_MMA(0, 0, At, B0); PG8_BAR; PG8_SCHED;
            PG8_LDB(B1, 1, 1); PG8_STAGE(PG8_SB(1, 0), b3, voffB);
            PG8_BAR; PG8_WAIT_L(0); PG8_MMA(0, 1, At, B1); PG8_BAR;
            PG8_LDA(At, 1, 1); PG8_STAGE(PG8_SA(1, 0), a3, voffA);
            PG8_BAR; PG8_WAIT_L(0); PG8_MMA(1, 0, At, B0); PG8_BAR; PG8_SCHED;
            PG8_STAGE(PG8_SB(1, 1), b3 + hstep, voffB);
            PG8_WAIT_V(6); PG8_BAR; PG8_MMA(1, 1, At, B1); PG8_BAR;
            }
        }
        if constexpr (ALIGN_EPI) { if (wr == 0) PG8_BAR; }
        if constexpr (!Epi::AFTER_DRAIN) { E(acc, cur, wr, wc, fr, fq); S.done(cur); }
        if (!has_next) break;
#pragma unroll
        for (int a = 0; a < 2; ++a)
#pragma unroll
            for (int b = 0; b < 2; ++b)
#pragma unroll
                for (int m = 0; m < 4; ++m)
#pragma unroll
                    for (int n = 0; n < 2; ++n) acc[a][b][m][n] = acc_t{};
        cur = nxt; cA = nA; cB = nB; ++ui;
        if constexpr (ALIGN_EPI) { if (wr == 1) PG8_BAR; }
    }
    PG8_WAIT_V(0);
    if constexpr (!ALIGN_EPI) { if (wr == 0) PG8_BAR; }
    PG8_BAR;
    if constexpr (Epi::AFTER_DRAIN) { E.fused(acc, cur, wr, wc, fr, fq, lds, wid, lane); S.done(cur); }
#undef PG8_SA
#undef PG8_SB
#undef PG8_STAGE
#undef PG8_LDA
#undef PG8_LDB
#undef PG8_MMA
#undef PG8_WAIT_V
#undef PG8_WAIT_L
#undef PG8_BAR
#undef PG8_SCHED
}
}
#ifndef PG8_SP2
#define PG8_SP2 true
#endif
#ifndef PG8_ALIGN
#define PG8_ALIGN true
#endif
constexpr int NWAVES = 8;
constexpr int NB = 2, NS = 4096, DM = 4096, MR = NB * NS;
constexpr int NHQ = 48, NHA = 24, HD = 128, QKVC = 3 * NHQ * HD;
constexpr int DFF = 14336, F2 = 2 * DFF;
constexpr float ATT_SCALE = 0.08838834764831845f;
constexpr float NORM_EPS = 1e-5f;
constexpr size_t MiB = 1u << 20;
constexpr size_t WS_CTL = 0, CTL_ZERO_BYTES = 2 * MiB;
constexpr size_t WS_SSQ = 256 * 1024, SSQ_SITE = 32 * 1024;
constexpr size_t WS_VSQ = 512 * 1024;
constexpr size_t WS_AMAX = 1 * MiB;
constexpr int AM_WIN = 0, AM_WOUT = 18432, AM_SGWIN = 22528, AM_WUP = 30720, AM_END = 30720 + 2 * 28672;
constexpr size_t WS_SW = 3 * MiB;
constexpr size_t WS_SAH = 4 * MiB;
constexpr size_t WS_ROPE = 2 * MiB;
constexpr size_t WS_KMEAN = 576 * 1024;
constexpr size_t WS_SS = 3 * MiB, SS_SITE = 2 * MiB;
constexpr size_t WS_VS = 13 * MiB;
constexpr size_t WS_SEL = 18 * MiB;
constexpr size_t WS_LSE = 20 * MiB;
constexpr size_t WS_WIN = 32 * MiB;
constexpr size_t WS_WOUT = 176 * MiB;
constexpr size_t WS_SGWIN = 208 * MiB;
constexpr size_t WS_SGWOUT = 272 * MiB;
constexpr size_t WS_WUP = 304 * MiB, WUP_L = 224 * MiB;
constexpr size_t WS_WDOWN = 752 * MiB, WDOWN_L = 112 * MiB;
constexpr size_t WS_XB = 976 * MiB;
constexpr size_t WS_H = 1040 * MiB;
constexpr size_t WS_QKV = 1168 * MiB;
constexpr size_t WS_U = WS_QKV, WS_V = WS_QKV + 64 * MiB;
constexpr size_t WS_O = 1456 * MiB;
constexpr size_t WS_G = 1520 * MiB;
constexpr size_t WS_DO = WS_G;
constexpr size_t WS_APRE = 1744 * MiB;
constexpr size_t WS_TOP = WS_APRE + 128 * MiB, WS_BOT = WS_APRE + 136 * MiB;
constexpr size_t WS_WUP8 = 2192 * MiB, WUP8_L = 112 * MiB;
constexpr size_t WS_HQ8 = 2416 * MiB;
constexpr size_t WS_END = 2448 * MiB;
constexpr int RING_OFF = 0, RING_BYTES = 131072;
constexpr int SCR_BYTES = 133120;
constexpr int LDSCTL_OFF = SCR_BYTES, MISC_OFF = LDSCTL_OFF + 320;
constexpr int XTRA_OFF = SCR_BYTES + 1024;
constexpr int LDS_BYTES = 147456;
static_assert(MISC_OFF + 128 <= XTRA_OFF, "LDS map");
constexpr int CW_TMO = 0, CW_BAR = 4096;

#define GAS __attribute__((address_space(1)))
#define LAS __attribute__((address_space(3)))
typedef unsigned short bf16;
typedef unsigned v4u __attribute__((ext_vector_type(4)));
typedef unsigned v2u __attribute__((ext_vector_type(2)));
typedef float f32x4 __attribute__((ext_vector_type(4)));
typedef float f32x2 __attribute__((ext_vector_type(2)));
#define LDS_WAIT() asm volatile("s_waitcnt lgkmcnt(0)" ::: "memory")
#define VM_WAIT() asm volatile("s_waitcnt vmcnt(0)" ::: "memory")
__device__ __forceinline__ unsigned f2bf(float f) { unsigned u = __builtin_bit_cast(unsigned, f); return (u + 0x7fffu + ((u >> 16) & 1u)) >> 16; }
__device__ __forceinline__ unsigned pk2(float lo, float hi) { return f2bf(lo) | (f2bf(hi) << 16); }
__device__ __forceinline__ float bflo(unsigned w) { return __builtin_bit_cast(float, w << 16); }
__device__ __forceinline__ float bfhi(unsigned w) { return __builtin_bit_cast(float, w & 0xffff0000u); }
__device__ __forceinline__ float bf1(bf16 h) { return __builtin_bit_cast(float, (unsigned)h << 16); }
namespace att {
typedef unsigned short bf16;
typedef short bf16x8 __attribute__((ext_vector_type(8)));
typedef short s16x4 __attribute__((ext_vector_type(4)));
typedef float f32x16 __attribute__((ext_vector_type(16)));
typedef float f32x4 __attribute__((ext_vector_type(4)));
typedef unsigned u32x4 __attribute__((ext_vector_type(4)));
template <class A, class Bt> struct same_t { static constexpr bool v = false; };
template <class A> struct same_t<A, A> { static constexpr bool v = true; };
constexpr int D = 128;
constexpr float SCALE = 0.08838834764831845f, THR = 8.f;
constexpr int NW = 8, QBLK = 32, KVBLK = 64, QB = NW * QBLK;
constexpr int SHM_V = KVBLK * D * 2, SHM_K = KVBLK * D * 2;
constexpr int ATT_LDS_BYTES = 2 * SHM_V + 2 * SHM_K + NW * 64 * 4;
#define KSWZ(row, colB) ((row) * 256 + ((colB) ^ (((row) & 7) << 4)))
#define SBAR() __builtin_amdgcn_sched_barrier(0)
__device__ __forceinline__ int v_st(int k, int c) { const int kk = (k & ~0xC) | ((k & 4) << 1) | ((k & 8) >> 1); return ((kk >> 3) * 4 + (c >> 5)) * 512 + ((kk & 7) * 32 + (c & 31)) * 2; }
__device__ __forceinline__ int v_rd_base(int lane) { return ((lane & 3) << 3) | (((lane >> 2) & 3) << 6) | (((lane >> 4) & 1) << 5) | (((lane >> 5) & 1) << 8); }
constexpr int v_rd_off(int d0, int ks, int half) { return d0 * 512 + ks * 4096 + half * 2048; }
__device__ __forceinline__ int crow(int r, int hi) { return (r & 3) + 8 * (r >> 2) + 4 * hi; }
__device__ __forceinline__ unsigned cvtpk(float lo, float hi) {
    unsigned r; asm volatile("v_cvt_pk_bf16_f32 %0, %1, %2" : "=v"(r) : "v"(lo), "v"(hi)); return r;
}
__device__ __forceinline__ bf16x8 pack8(f32x4 a, f32x4 b) {
    u32x4 w = {cvtpk(a[0], a[1]), cvtpk(a[2], a[3]), cvtpk(b[0], b[1]), cvtpk(b[2], b[3])};
    return *reinterpret_cast<bf16x8*>(&w);
}
template <class T> __device__ __forceinline__ bf16x8 load8(const T* p) {
    if constexpr (same_t<T, float>::v) { return pack8(*(const f32x4*)p, *(const f32x4*)(p + 4)); }
    else { return *reinterpret_cast<const bf16x8*>(p); }
}
__device__ __forceinline__ void mask_tile(f32x16& p0, f32x16& p1, int dq, unsigned W) {
    const float NEG = -__builtin_inff();
#pragma unroll
    for (int r = 0; r < 16; ++r) {
        const int c = (r & 3) + 8 * (r >> 2);
        if ((unsigned)(dq - c) >= W) p0[r] = NEG;
        if ((unsigned)(dq - c - 32) >= W) p1[r] = NEG;
    }
}
__device__ __forceinline__ void partialSM(f32x16& p0, f32x16& p1, float& m_reg, float& mn, float& alpha) {
    float pmax = p0[0]; for (int r = 1; r < 16; ++r) pmax = fmaxf(pmax, p0[r]); for (int r = 0; r < 16; ++r) pmax = fmaxf(pmax, p1[r]);
    { auto rr = __builtin_amdgcn_permlane32_swap(__float_as_uint(pmax), __float_as_uint(pmax), false, false);
      pmax = fmaxf(__uint_as_float(rr[0]), __uint_as_float(rr[1])); }
    constexpr float C2 = 1.4426950408889634f * SCALE;
    if (__builtin_expect(__all((pmax - m_reg) * SCALE <= THR), 1)) { mn = m_reg; alpha = 1.f; }
    else { mn = fmaxf(m_reg, pmax); alpha = __builtin_amdgcn_exp2f((m_reg - mn) * C2); m_reg = mn; }
    const float mnL = -mn * C2;
    for (int r = 0; r < 16; ++r) p0[r] = fmaf(p0[r], C2, mnL); for (int r = 0; r < 16; ++r) p1[r] = fmaf(p1[r], C2, mnL);
    for (int r = 0; r < 16; ++r) p0[r] = __builtin_amdgcn_exp2f(p0[r]);
}
__device__ __forceinline__ void finishSM(f32x16& p0, f32x16& p1, float alpha, float& l_reg, bf16x8& pa0, bf16x8& pa1, bf16x8& pa2, bf16x8& pa3) {
    for (int r = 0; r < 16; ++r) p1[r] = __builtin_amdgcn_exp2f(p1[r]);
    float ps = 0; for (int r = 0; r < 16; ++r) ps += p0[r]; for (int r = 0; r < 16; ++r) ps += p1[r];
    { auto rr = __builtin_amdgcn_permlane32_swap(__float_as_uint(ps), __float_as_uint(ps), false, false);
      ps = __uint_as_float(rr[0]) + __uint_as_float(rr[1]); }
    l_reg = l_reg * alpha + ps;
#define PK4(P, B_, OUT) do { unsigned a0 = cvtpk(P[B_+0], P[B_+1]), a1 = cvtpk(P[B_+2], P[B_+3]);                          \
        unsigned b0 = cvtpk(P[B_+4], P[B_+5]), b1 = cvtpk(P[B_+6], P[B_+7]);                                             \
        auto r0 = __builtin_amdgcn_permlane32_swap(a0, b0, false, false); auto r1 = __builtin_amdgcn_permlane32_swap(a1, b1, false, false); \
        u32x4 w = {r0[0], r1[0], r0[1], r1[1]}; OUT = *reinterpret_cast<bf16x8*>(&w); } while (0)
    PK4(p0, 0, pa0); PK4(p0, 8, pa1); PK4(p1, 0, pa2); PK4(p1, 8, pa3);
#undef PK4
}
template <int KB, bool SK>
__device__ __forceinline__ void qkt(f32x16& p0, f32x16& p1, const char* K_lds, int r32, int hi, const bf16x8* qr, bool act) {
    if (SK && !act) { const float NEG = -__builtin_inff();
#pragma unroll
        for (int r = 0; r < 16; ++r) { p0[r] = NEG; p1[r] = NEG; } return; }
    p0 = f32x16{}; p1 = f32x16{};
    const char* kb[4];
#pragma unroll
    for (int dd = 0; dd < 4; ++dd) kb[dd] = K_lds + KB * SHM_K + KSWZ(r32, (dd * 16 + hi * 8) * 2);
#pragma unroll
    for (int d0 = 0; d0 < 8; ++d0) { const char* a = kb[d0 & 3] + (d0 >> 2) * 128;
        bf16x8 b0 = *reinterpret_cast<const bf16x8*>(a);
        bf16x8 b1 = *reinterpret_cast<const bf16x8*>(a + 32 * 256);
        p0 = __builtin_amdgcn_mfma_f32_32x32x16_bf16(b0, qr[d0], p0, 0, 0, 0);
        p1 = __builtin_amdgcn_mfma_f32_32x32x16_bf16(b1, qr[d0], p1, 0, 0, 0); }
}
template <int VB, bool SK>
__device__ __forceinline__ void pv_tile(f32x16* o, int vb0, bf16x8 pa0, bf16x8 pa1, bf16x8 pa2, bf16x8 pa3, bool act) {
    if (SK && !act) return;
#define TRRD(dst, off) asm volatile("ds_read_b64_tr_b16 %0, %1 offset:%2" : "=&v"(dst) : "v"(vb0), "i"(off) : "memory")
#define PV_D0(d0) do { s16x4 l0, l1, l2, l3, h0, h1, h2, h3; constexpr int b_ = VB * SHM_V + v_rd_off(d0, 0, 0);     \
        TRRD(l0, b_); TRRD(h0, b_ + 2048); TRRD(l1, b_ + 4096); TRRD(h1, b_ + 6144); TRRD(l2, b_ + 8192); TRRD(h2, b_ + 10240); TRRD(l3, b_ + 12288); TRRD(h3, b_ + 14336); \
        asm volatile("s_waitcnt lgkmcnt(0)" ::: "memory"); SBAR();                 \
        o[d0] = __builtin_amdgcn_mfma_f32_32x32x16_bf16(pa0, (bf16x8){l0[0], l0[1], l0[2], l0[3], h0[0], h0[1], h0[2], h0[3]}, o[d0], 0, 0, 0);   \
        o[d0] = __builtin_amdgcn_mfma_f32_32x32x16_bf16(pa1, (bf16x8){l1[0], l1[1], l1[2], l1[3], h1[0], h1[1], h1[2], h1[3]}, o[d0], 0, 0, 0);   \
        o[d0] = __builtin_amdgcn_mfma_f32_32x32x16_bf16(pa2, (bf16x8){l2[0], l2[1], l2[2], l2[3], h2[0], h2[1], h2[2], h2[3]}, o[d0], 0, 0, 0);   \
        o[d0] = __builtin_amdgcn_mfma_f32_32x32x16_bf16(pa3, (bf16x8){l3[0], l3[1], l3[2], l3[3], h3[0], h3[1], h3[2], h3[3]}, o[d0], 0, 0, 0); } while (0)
    PV_D0(0); PV_D0(1); PV_D0(2); PV_D0(3);
#undef PV_D0
#undef TRRD
}

template <class TIn, class TOut> struct BlockRef { const TIn* Q; const TIn* K; const TIn* V; TOut* O; int P0; const __attribute__((address_space(3))) unsigned short* sel; float* L; };
template <class TIn> struct Seam {
    bf16x8 qr[8];
    bf16x8 st_v0, st_v1, st_k0, st_k1; f32x4 sf0, sf1, sf2, sf3;
    f32x4 tq[16];
};
__device__ __forceinline__ int swa_jlo(int P0, int W) { const int lowk = P0 - W + 1; return lowk > 0 ? lowk / KVBLK : 0; }
#define ROW(p, k0, rr) ((p) + (size_t)((k0) + (rr)) * rs_ + sc)
#define ROWN(p, k0, rr) ((p) + (size_t)((k0) + (rr)) * rsn_ + sc)
#define VMW() asm volatile("s_waitcnt vmcnt(0)" ::: "memory")
#define VMWN(n) asm volatile("s_waitcnt vmcnt(%0)" :: "i"(n) : "memory")
#define SLOAD_H(Kp, Vp, k0) do { S.st_v0 = load8<TIn>(ROW(Vp, k0, sr)); S.st_v1 = load8<TIn>(ROW(Vp, k0, 32 + sr));              \
                         S.st_k0 = load8<TIn>(ROW(Kp, k0, sr)); S.st_k1 = load8<TIn>(ROW(Kp, k0, 32 + sr)); } while (0)
#define SLOAD_HN(Kp, Vp, k0) do { S.st_v0 = load8<TIn>(ROWN(Vp, k0, sr)); S.st_v1 = load8<TIn>(ROWN(Vp, k0, 32 + sr));              \
                         S.st_k0 = load8<TIn>(ROWN(Kp, k0, sr)); S.st_k1 = load8<TIn>(ROWN(Kp, k0, 32 + sr)); } while (0)
#define SWRITE_HK(bf) do { *(bf16x8*)(K_lds + (bf) * SHM_K + kws) = S.st_k0; *(bf16x8*)(K_lds + (bf) * SHM_K + kws + 32 * 256) = S.st_k1; } while (0)
#define SWRITE_HV(bf) do { *(bf16x8*)(V_lds + (bf) * SHM_V + vst0) = S.st_v0; *(bf16x8*)(V_lds + (bf) * SHM_V + vst1) = S.st_v1; } while (0)
#define SWRITE_H(bf) do { SWRITE_HV(bf); SWRITE_HK(bf); } while (0)
#define SLOAD_F(p, k0) do { S.sf0 = *(const f32x4*)ROW(p, k0, sr); S.sf1 = *(const f32x4*)(ROW(p, k0, sr) + 4);                \
                            S.sf2 = *(const f32x4*)ROW(p, k0, 32 + sr); S.sf3 = *(const f32x4*)(ROW(p, k0, 32 + sr) + 4); } while (0)
#define SWRITE_KF(bf) do { *(bf16x8*)(K_lds + (bf) * SHM_K + kws) = pack8(S.sf0, S.sf1); *(bf16x8*)(K_lds + (bf) * SHM_K + kws + 32 * 256) = pack8(S.sf2, S.sf3); } while (0)
#define SWRITE_VF(bf) do { *(bf16x8*)(V_lds + (bf) * SHM_V + vst0) = pack8(S.sf0, S.sf1); *(bf16x8*)(V_lds + (bf) * SHM_V + vst1) = pack8(S.sf2, S.sf3); } while (0)
template <class TIn, class TOut, int RSC, int W>
__device__ __forceinline__ void causal_swa_prime(const BlockRef<TIn, TOut>& cur, char* lds, Seam<TIn>& S) {
    constexpr bool F32 = same_t<TIn, float>::v;
    int tid_ = threadIdx.x; asm volatile("" : "+v"(tid_));
    const int tid = tid_, wid = __builtin_amdgcn_readfirstlane(tid >> 6), lane = tid & 63, r32 = lane & 31, hi = lane >> 5;
    const int sr = tid >> 4, sc = (tid & 15) * 8, kws = KSWZ(sr, sc * 2); char* K_lds = lds + 2 * SHM_V;
    const int kb0 = swa_jlo(cur.P0, W) * KVBLK; constexpr int rs_ = RSC;
    for (int d0 = 0; d0 < 8; ++d0) S.qr[d0] = load8<TIn>(cur.Q + (size_t)(wid * QBLK + r32) * rs_ + d0 * 16 + hi * 8);
    if constexpr (F32) { SLOAD_F((const float*)cur.K, kb0); VMW(); SWRITE_KF(0); SBAR(); SLOAD_F((const float*)cur.V, kb0); }
    else { SLOAD_H(cur.K, cur.V, kb0); VMW(); SWRITE_HK(0); }
    __syncthreads();
}
template <class TIn, class TOut, bool SKP, int MODE, int RSC, int RSN, int OSC, int W, int WN, int skv>
__device__ __forceinline__ void causal_swa_block(const BlockRef<TIn, TOut>& cur, const BlockRef<TIn, TOut>& nxt, char* lds, Seam<TIn>& S) {
    constexpr bool F32 = same_t<TIn, float>::v; static_assert(!F32, "bf16 inputs only in this build");
    constexpr int rs_ = RSC, rsn_ = RSN, os_ = OSC;
    int tid_ = threadIdx.x; asm volatile("" : "+v"(tid_));
    const int tid = tid_, wid = __builtin_amdgcn_readfirstlane(tid >> 6), lane = tid & 63, r32 = lane & 31, hi = lane >> 5;
    const int j_lo = swa_jlo(cur.P0, W);
    int j_hi = (cur.P0 + QB - 1) / KVBLK + 1; if (j_hi > skv / KVBLK) j_hi = skv / KVBLK;
    const int NT = j_hi - j_lo;
    const int kbn = swa_jlo(nxt.P0, WN) * KVBLK;
    const int qlo = cur.P0 + wid * QBLK, qm = qlo + r32 - 4 * hi;
    char* V_lds = lds; char* K_lds = lds + 2 * SHM_V;
    float* ws = (float*)(lds + 2 * SHM_V + 2 * SHM_K) + wid * 64; float* li_l = ws, * al_l = ws + 32;
    float m_reg = -1e30f, l_reg = 0; f32x16 o[4] = {};
    unsigned selm = 0u; if constexpr (MODE == 0) selm = cur.sel[wid * QBLK + r32];
    const int sr = tid >> 4, sc = (tid & 15) * 8, vst0 = v_st(sr, sc), vst1 = v_st(32 + sr, sc), kws = KSWZ(sr, sc * 2);
    const int vb0 = (int)(uintptr_t)V_lds + v_rd_base(lane);
    const TIn* Kh = cur.K; const TIn* Vh = cur.V;
#define RESC(a) do { if (__any((a) < 1.f)) { if (hi == 0) al_l[r32] = (a); asm volatile("s_waitcnt lgkmcnt(0)" ::: "memory");              \
                     for (int d_ = 0; d_ < 4; ++d_) for (int r = 0; r < 16; ++r) o[d_][r] *= al_l[crow(r, hi)]; } } while (0)
#define KBASE(t) ((j_lo + (t)) * KVBLK)
#define ACT(t) (KBASE(t) <= qlo + QBLK - 1 && KBASE(t) + KVBLK - 1 >= qlo - W + 1)
#define MASKT(P0_, P1_, t) do { const int kb_ = KBASE(t); if ((!SK || ACT(t)) && (kb_ + KVBLK - 1 > qlo || kb_ <= qlo + QBLK - 1 - W)) mask_tile(P0_, P1_, qm - kb_, (unsigned)W); \
        if constexpr (MODE == 0) { if (kb_ < cur.P0) { const bool dead_ = ((selm >> (kb_ >> 8)) & 1u) == 0u; const float NEG_ = -__builtin_inff(); \
            _Pragma("unroll") for (int r_ = 0; r_ < 16; ++r_) { P0_[r_] = dead_ ? NEG_ : P0_[r_]; P1_[r_] = dead_ ? NEG_ : P1_[r_]; } } } } while (0)
    constexpr int NQL = F32 ? 16 : 8;
    constexpr bool SK = SKP && !F32;
#define SEAM_K0() do { VMWN(NQL); if constexpr (F32) { SWRITE_KF(0); SBAR(); SLOAD_F((const float*)nxt.V, kbn); } else { SWRITE_HK(0); } SBAR(); } while (0)
    f32x16 pA0, pA1, pB0, pB1; float mnA, mnB, alA, alB; bf16x8 pa0, pa1, pa2, pa3;
    if constexpr (F32) { VMW(); SWRITE_VF(0); SBAR(); } else { SWRITE_HV(0); SBAR(); }
    if (NT > 1) { if constexpr (F32) SLOAD_F((const float*)Kh, KBASE(1)); else SLOAD_H(Kh, Vh, KBASE(1)); }
    SBAR(); qkt<0, SK>(pA0, pA1, K_lds, r32, hi, S.qr, ACT(0));
    if constexpr (F32) { if (NT > 1) { VMW(); SWRITE_KF(1); SBAR(); SLOAD_F((const float*)Vh, KBASE(1)); } }
    MASKT(pA0, pA1, 0); partialSM(pA0, pA1, m_reg, mnA, alA);
    if (NT > 1) { VMW(); if constexpr (F32) { SWRITE_VF(1); SBAR(); if (NT > 2) SLOAD_F((const float*)Kh, KBASE(2)); } else SWRITE_H(1); }
    __syncthreads();
#define HALF_STEP(PX0, PX1, mnX, alX, PY0, PY1, alY, t, KB, VB, SB) do {                                                      \
        SBAR(); qkt<KB, SK>(PX0, PX1, K_lds, r32, hi, S.qr, ACT(t));                                             \
        finishSM(PY0, PY1, alY, l_reg, pa0, pa1, pa2, pa3); SBAR();                                                           \
        if ((t) + 1 < NT) { if constexpr (F32) { VMW(); SWRITE_KF(SB); SBAR(); SLOAD_F((const float*)Vh, KBASE((t) + 1)); }  \
                            else { SLOAD_H(Kh, Vh, KBASE((t) + 1)); } SBAR(); }                                               \
        pv_tile<VB, SK>(o, vb0, pa0, pa1, pa2, pa3, ACT((t) - 1)); MASKT(PX0, PX1, (t)); partialSM(PX0, PX1, m_reg, mnX, alX);                                        \
        __syncthreads();                                                                                                      \
        if ((t) + 1 < NT) { VMW(); if constexpr (F32) { SWRITE_VF(SB); SBAR(); if ((t) + 2 < NT) SLOAD_F((const float*)Kh, KBASE((t) + 2)); } \
                            else { SWRITE_H(SB); } }                                                                          \
        RESC(alX); __syncthreads(); } while (0)
    for (int t = 1; t + 1 < NT; t += 2) {
        HALF_STEP(pB0, pB1, mnB, alB, pA0, pA1, alA, t, 1, 0, 0);
        HALF_STEP(pA0, pA1, mnA, alA, pB0, pB1, alB, t + 1, 0, 1, 1);
    }
    const bool even = (NT & 1) == 0;
    if (even) { SBAR(); qkt<1, SK>(pB0, pB1, K_lds, r32, hi, S.qr, ACT(NT - 1)); SBAR(); }
#define QROW(e) (nxt.Q + (size_t)(wid * QBLK + r32) * rsn_ + ((e) >> 1) * 16 + hi * 8 + ((e) & 1) * 4)
    if constexpr (F32) { SLOAD_F((const float*)nxt.K, kbn); SBAR();
#pragma unroll
        for (int e = 0; e < 8; ++e) S.tq[e] = *(const f32x4*)QROW(e); }
    else { SLOAD_HN(nxt.K, nxt.V, kbn); SBAR();
#pragma unroll
        for (int d0 = 0; d0 < 8; ++d0) S.qr[d0] = load8<TIn>(nxt.Q + (size_t)(wid * QBLK + r32) * rsn_ + d0 * 16 + hi * 8); }
    SBAR();
    finishSM(pA0, pA1, alA, l_reg, pa0, pa1, pa2, pa3); SBAR();
    if constexpr (F32) {
#pragma unroll
        for (int e = 8; e < 16; ++e) S.tq[e] = *(const f32x4*)QROW(e); SBAR(); }
#undef QROW
    pv_tile<0, SK>(o, vb0, pa0, pa1, pa2, pa3, ACT(even ? NT - 2 : NT - 1));
    if (even) { MASKT(pB0, pB1, NT - 1); partialSM(pB0, pB1, m_reg, mnB, alB); __syncthreads(); RESC(alB);
        finishSM(pB0, pB1, alB, l_reg, pa0, pa1, pa2, pa3); SBAR(); pv_tile<1, SK>(o, vb0, pa0, pa1, pa2, pa3, ACT(NT - 1)); }
    SBAR(); SEAM_K0();
    if (hi == 0) li_l[r32] = l_reg; asm volatile("s_waitcnt lgkmcnt(0)" ::: "memory");
    if constexpr (MODE == 1) { if (hi == 0) cur.L[(size_t)(wid * QBLK + r32) * (RSC / 128 * 24)] = m_reg * SCALE + __logf(l_reg); }
    float rli[16];
#pragma unroll
    for (int r = 0; r < 16; ++r) rli[r] = __builtin_amdgcn_rcpf(li_l[crow(r, hi)]);
    TOut* Ow = cur.O + (size_t)(wid * QBLK) * os_;
#pragma unroll
    for (int r = 0; r < 16; ++r) { const int orow = crow(r, hi);
#pragma unroll
        for (int d0 = 0; d0 < 4; ++d0) { const float v = o[d0][r] * rli[r];
            if constexpr (same_t<TOut, float>::v) { Ow[(size_t)orow * os_ + d0 * 32 + r32] = v; }
            else { const float vn = __shfl_xor(v, 1);
                   if ((r32 & 1) == 0) *(unsigned*)(Ow + (size_t)orow * os_ + d0 * 32 + r32) = cvtpk(v, vn); } } }
    if constexpr (F32) {
#pragma unroll
        for (int d0 = 0; d0 < 8; ++d0) S.qr[d0] = pack8(S.tq[2 * d0], S.tq[2 * d0 + 1]); }
    __syncthreads();
#undef RESC
#undef KBASE
#undef ACT
#undef MASKT
#undef SEAM_K0
#undef HALF_STEP
}
#undef ROW
#undef ROWN
#undef SLOAD_HN
#undef VMW
#undef VMWN
#undef SLOAD_H
#undef SWRITE_HK
#undef SWRITE_HV
#undef SWRITE_H
#undef SLOAD_F
#undef SWRITE_KF
#undef SWRITE_VF
}
#define XB_TMO      128
#define XB_XCNT(j)  (256  + 64 * (j))
#define XB_XSUB(j)  (1280 + 64 * (j))
#define XB_XGEN(j)  (2304 + 64 * (j))
#define XB_TOP      3328
#define XB_TOPGEN   3392
#define XCD_BAR_WORDS 3456
#define XB_SPIN_CAP (1u << 18)

__device__ __forceinline__ unsigned xb_ld(unsigned* p)              { return __hip_atomic_load(p, __ATOMIC_RELAXED, __HIP_MEMORY_SCOPE_AGENT); }
__device__ __forceinline__ unsigned xb_add(unsigned* p, unsigned v) { return __hip_atomic_fetch_add(p, v, __ATOMIC_RELAXED, __HIP_MEMORY_SCOPE_AGENT); }
__device__ __forceinline__ unsigned xb_xcc_id() { return (unsigned)__builtin_amdgcn_s_getreg((3 << 11) | 20) & 0xFu; }
#define XB_SPIN(cond, bar) do { unsigned _sp = 0; while (cond) { __builtin_amdgcn_s_sleep(1); \
    if ((++_sp & 255u) == 0u) { if (xb_ld(&(bar)[XB_TMO])) break; if (_sp > XB_SPIN_CAP) { atomicAdd(&(bar)[XB_TMO], 1u); break; } } } } while (0)

struct XcdBarrier {
    unsigned* bar; unsigned x;
    volatile LAS unsigned* st;
};

__device__ __forceinline__ XcdBarrier xcd_barrier_post(unsigned* bar, volatile LAS unsigned* st) {
    XcdBarrier b; b.bar = bar; b.x = xb_xcc_id(); b.st = st;
    if (threadIdx.x == 0) (void)xb_add(&bar[XB_XCNT(b.x)], 1u);
    return b;
}
__device__ __forceinline__ void xcd_barrier_complete(unsigned* bar, unsigned x, unsigned& nloc, unsigned& nx) {
    const unsigned G = gridDim.x * gridDim.y * gridDim.z;
    unsigned sum, cnt, mine, sp = 0u;
    for (;;) {
        sum = 0u; cnt = 0u; mine = 0u;
#pragma unroll
        for (unsigned j = 0; j < 16; ++j) { const unsigned c = xb_ld(&bar[XB_XCNT(j)]); sum += c; cnt += (c > 0u) ? 1u : 0u; mine = (j == x) ? c : mine; }
        if (sum == G) break;
        __builtin_amdgcn_s_sleep(1);
        if ((++sp & 255u) == 0u) { if (xb_ld(&bar[XB_TMO])) break; if (sp > XB_SPIN_CAP) { atomicAdd(&bar[XB_TMO], 1u); break; } }
    }
    nloc = mine > 0u ? mine : 1u; nx = cnt > 0u ? cnt : 1u;
}

__device__ __forceinline__ void xcd_barrier(const XcdBarrier& b) {
    asm volatile("s_waitcnt vmcnt(0)" ::: "memory");
    __syncthreads();
    if (threadIdx.x == 0) {
        unsigned* bar = b.bar;
        __builtin_amdgcn_s_waitcnt(0);
        unsigned nloc = b.st[0], nx = b.st[1];
        if (nloc == 0u) { xcd_barrier_complete(bar, b.x, nloc, nx); b.st[0] = nloc; b.st[1] = nx; }
        const unsigned old = xb_add(&bar[XB_XSUB(b.x)], 1u);
        const unsigned gen = old / nloc;
        if (old + 1u == (gen + 1u) * nloc) {
            __builtin_amdgcn_fence(__ATOMIC_RELEASE, "agent");
            asm volatile("s_waitcnt vmcnt(0)" ::: "memory");
            const unsigned og = xb_add(&bar[XB_TOP], 1u);
            const unsigned tg = og / nx;
            if (og + 1u == (tg + 1u) * nx) xb_add(&bar[XB_TOPGEN], 1u);
            else XB_SPIN(xb_ld(&bar[XB_TOPGEN]) == tg, bar);
            __builtin_amdgcn_fence(__ATOMIC_ACQUIRE, "agent");
            xb_add(&bar[XB_XGEN(b.x)], 1u);
            asm volatile("s_waitcnt vmcnt(0)" ::: "memory");
        } else {
            XB_SPIN(xb_ld(&bar[XB_XGEN(b.x)]) == gen, bar);
            __builtin_amdgcn_fence(__ATOMIC_ACQUIRE, "agent");
            asm volatile("s_waitcnt vmcnt(0)" ::: "memory");
        }
    }
    __syncthreads();
}
struct Frame {
    LAS unsigned char* lds;
    volatile LAS unsigned* MISC;
    unsigned* ctl;
    int tid, lane, wave, G, gw, NGW;
    unsigned char* ws;
    const float* x; const int* pos;
    const float *attn_norm, *attn_w_in, *attn_w_out, *sg_norm, *sg_w_in, *sg_b_in, *sg_v_gain, *sg_v_bias, *sg_w_s, *sg_b_s, *sg_w_out, *ffn_norm, *ffn_w_up, *ffn_conv_w, *ffn_conv_b, *ffn_w_down, *final_norm;
    float* out;
};
__device__ __forceinline__ float wave_sum(float v) {
#pragma unroll
    for (int o = 1; o < 64; o <<= 1) v += __shfl_xor(v, o);
    return v;
}
__device__ __forceinline__ float wave_max(float v) {
#pragma unroll
    for (int o = 1; o < 64; o <<= 1) v = fmaxf(v, __shfl_xor(v, o));
    return v;
}
__device__ __forceinline__ float ss_rstd(const float* ss, int r) { return pg8::rstd_from_ss(ss, r); }

struct MapId { __device__ __forceinline__ int operator()(int n) const { return n; } };
struct MapUp { __device__ __forceinline__ int operator()(int n) const { return n < DFF ? ((n >> 7) << 8) + (n & 127) : (((n - DFF) >> 7) << 8) + 128 + ((n - DFF) & 127); } };
template <class RowMap>
__device__ __forceinline__ void transpose_item(const float* W, int K, int N, const float* gain, bf16* WT, RowMap rm, LAS float* scr, int item, int lane, unsigned* amax = nullptr) {
    const int nblk = N / 64, kb = item / nblk, nb = item - kb * nblk, k0 = 64 * kb, n0 = 64 * nb;
    const int lr = lane >> 4, lc = (lane & 15) * 4;
    f32x4 v[16];
#pragma unroll
    for (int i = 0; i < 16; ++i) v[i] = *(const f32x4*)(W + (size_t)(k0 + 4 * i + lr) * N + n0 + lc);
#pragma unroll
    for (int i = 0; i < 16; ++i) { const int kk = 4 * i + lr; f32x4 x = v[i]; if (gain) x = x * gain[k0 + kk]; LAS float* d = scr + kk * 65 + lc; d[0] = x[0]; d[1] = x[1]; d[2] = x[2]; d[3] = x[3]; }
    LDS_WAIT(); asm volatile("" ::: "memory");
    const int c = lane & 7;
#pragma unroll
    for (int j = 0; j < 8; ++j) { const int n = (lane >> 3) + 8 * j; const LAS float* s = scr + (8 * c) * 65 + n;
        v4u o; o.x = pk2(s[0 * 65], s[1 * 65]); o.y = pk2(s[2 * 65], s[3 * 65]); o.z = pk2(s[4 * 65], s[5 * 65]); o.w = pk2(s[6 * 65], s[7 * 65]);
        *(v4u*)(WT + (size_t)rm(n0 + n) * K + k0 + 8 * c) = o;
        if (amax) {
            float mx = fmaxf(fmaxf(fmaxf(fabsf(s[0 * 65]), fabsf(s[1 * 65])), fmaxf(fabsf(s[2 * 65]), fabsf(s[3 * 65]))), fmaxf(fmaxf(fabsf(s[4 * 65]), fabsf(s[5 * 65])), fmaxf(fabsf(s[6 * 65]), fabsf(s[7 * 65]))));
            mx = fmaxf(mx, __shfl_xor(mx, 1)); mx = fmaxf(mx, __shfl_xor(mx, 2)); mx = fmaxf(mx, __shfl_xor(mx, 4));
            if (c == 0) atomicMax(amax + rm(n0 + n), __builtin_bit_cast(unsigned, mx));
        } }
    LDS_WAIT(); asm volatile("" ::: "memory");
}
__device__ __forceinline__ void sincos_d(double a, double& sn, double& cs) {
    const double n = __builtin_rint(a * 0.15915494309189535);
    const double r = a - n * 6.283185307179586;
    const double r2 = r * r;
    double ts = r, tc = 1.0, s = r, c = 1.0;
#pragma unroll
    for (int k = 1; k <= 15; ++k) { tc = -tc * r2 / (double)((2 * k - 1) * (2 * k)); ts = -ts * r2 / (double)((2 * k) * (2 * k + 1)); c += tc; s += ts; }
    sn = s; cs = c;
}
__device__ __forceinline__ void p0_prologue(Frame& F) {
    LAS float* scr = (LAS float*)(F.lds + RING_OFF + F.wave * 16640);
    constexpr int I_WIN = 64 * (QKVC / 64), I_SQ = 64 * (DM / 64), I_SGIN = 64 * (2 * DM / 64), I_UP = 64 * (F2 / 64), I_DN = (DFF / 64) * (DM / 64);
    constexpr int NITEMS = I_WIN + 2 * I_SQ + I_SGIN + 2 * I_UP + 2 * I_DN;
    for (int it = F.gw; it < NITEMS; it += F.NGW) {
        int r = it;
        if (r < I_WIN) { transpose_item(F.attn_w_in, DM, QKVC, F.attn_norm, (bf16*)(F.ws + WS_WIN), MapId(), scr, r, F.lane); continue; } r -= I_WIN;
        if (r < I_SQ) { transpose_item(F.attn_w_out, DM, DM, nullptr, (bf16*)(F.ws + WS_WOUT), MapId(), scr, r, F.lane); continue; } r -= I_SQ;
        if (r < I_SGIN) { transpose_item(F.sg_w_in, DM, 2 * DM, F.sg_norm, (bf16*)(F.ws + WS_SGWIN), MapId(), scr, r, F.lane); continue; } r -= I_SGIN;
        if (r < I_SQ) { transpose_item(F.sg_w_out, DM, DM, nullptr, (bf16*)(F.ws + WS_SGWOUT), MapId(), scr, r, F.lane); continue; } r -= I_SQ;
        if (r < I_UP) { transpose_item(F.ffn_w_up, DM, F2, F.ffn_norm, (bf16*)(F.ws + WS_WUP), MapUp(), scr, r, F.lane, (unsigned*)(F.ws + WS_AMAX) + AM_WUP); continue; } r -= I_UP;
        if (r < I_UP) { transpose_item(F.ffn_w_up + (size_t)DM * F2, DM, F2, F.ffn_norm + DM, (bf16*)(F.ws + WS_WUP + WUP_L), MapUp(), scr, r, F.lane, (unsigned*)(F.ws + WS_AMAX) + AM_WUP + F2); continue; } r -= I_UP;
        if (r < I_DN) { transpose_item(F.ffn_w_down, DFF, DM, nullptr, (bf16*)(F.ws + WS_WDOWN), MapId(), scr, r, F.lane); continue; } r -= I_DN;
        transpose_item(F.ffn_w_down + (size_t)DFF * DM, DFF, DM, nullptr, (bf16*)(F.ws + WS_WDOWN + WDOWN_L), MapId(), scr, r, F.lane);
    }
    bf16* XB = (bf16*)(F.ws + WS_XB); float* SS0 = (float*)(F.ws + WS_SSQ);
    for (int m = F.gw; m < MR; m += F.NGW) {
        const f32x4* xr = (const f32x4*)(F.x + (size_t)m * DM) + F.lane;
        v2u* o8 = (v2u*)(XB + (size_t)m * DM) + F.lane;
        float sq = 0.f;
#pragma unroll
        for (int j = 0; j < 16; ++j) { const f32x4 v = xr[64 * j]; sq += (v[0] * v[0] + v[1] * v[1]) + (v[2] * v[2] + v[3] * v[3]); v2u w; w.x = pk2(v[0], v[1]); w.y = pk2(v[2], v[3]); o8[64 * j] = w; }
        sq = wave_sum(sq);
        if (F.lane == 0) SS0[m] = sq;
    }
    float* rc = (float*)(F.ws + WS_ROPE); float* rs = rc + MR * 16;
    for (int idx = F.gw * 64 + F.lane; idx < MR * 16; idx += F.NGW * 64) {
        const int r = idx >> 4, i = idx & 15;
        double invd = 1.0;
        for (int k = 0; k < i; ++k) invd *= 0.44036660267178046;
        const float inv = (float)invd;
        const float ang = (float)F.pos[r] * inv;
        double sn, cs; sincos_d((double)ang, sn, cs);
        rc[idx] = (float)cs; rs[idx] = (float)sn;
    }
}

__device__ __forceinline__ void p_kmean(Frame& F) {
    const bf16* QKV = (const bf16*)(F.ws + WS_QKV); float* KM = (float*)(F.ws + WS_KMEAN);
    LAS float* red = (LAS float*)(F.lds + RING_OFF);
    for (int item = blockIdx.x; item < NB * NHA * 16; item += F.G) {
        const int j = item & 15, bh = item >> 4, b = bh / NHA, h = bh - b * NHA;
        const bf16* kb = QKV + ((size_t)((1 * 2 + b) * NHQ + h) * NS + 256 * j) * HD;
        const int d = F.tid & 127, part = F.tid >> 7;
        float s = 0.f;
        for (int i = 0; i < 64; ++i) s += bf1(kb[(size_t)(part * 64 + i) * HD + d]);
        red[part * 128 + d] = s;
        __syncthreads();
        if (F.tid < 128) KM[(size_t)item * 128 + F.tid] = (red[F.tid] + red[128 + F.tid] + red[256 + F.tid] + red[384 + F.tid]) * (1.0f / 256.0f);
        __syncthreads();
    }
}

__device__ __forceinline__ float dot128(const LAS float* qs, const bf16* krow) {
    float s = 0.f;
#pragma unroll 4
    for (int c = 0; c < 16; ++c) {
        const v4u kv = *(const v4u*)(krow + 8 * c); const LAS float* q8 = qs + 8 * c;
        s += q8[0] * bflo(kv.x) + q8[1] * bfhi(kv.x) + q8[2] * bflo(kv.y) + q8[3] * bfhi(kv.y) + q8[4] * bflo(kv.z) + q8[5] * bfhi(kv.z) + q8[6] * bflo(kv.w) + q8[7] * bfhi(kv.w);
    }
    return s;
}
__device__ __forceinline__ void p_attn_naive(Frame& F, bf16* O) {
    const bf16* QKV = (const bf16*)(F.ws + WS_QKV); const float* KM = (const float*)(F.ws + WS_KMEAN);
    LAS float* qs = (LAS float*)(F.lds + RING_OFF + F.wave * 8192);
    LAS float* ps = qs + 128;
    const int lane = F.lane;
    constexpr int NMOBA = NB * NHA * NS, NDIL = NB * 8 * NS;
    const float NEG = -__builtin_inff();
    for (int task = F.gw; task < NMOBA + NDIL; task += F.NGW) {
        if (task < NMOBA) {
            const int b = task / (NHA * NS), rem = task - b * (NHA * NS), h = rem >> 12, t = rem & 4095;
            const bf16* qrow = QKV + ((size_t)((0 * 2 + b) * NHQ + h) * NS + t) * HD;
            const bf16* Kb = QKV + (size_t)((1 * 2 + b) * NHQ + h) * NS * HD;
            const bf16* Vb = QKV + (size_t)((2 * 2 + b) * NHQ + h) * NS * HD;
            { const unsigned w = *(const unsigned*)(qrow + 2 * lane); qs[2 * lane] = bflo(w); qs[2 * lane + 1] = bfhi(w); }
            LDS_WAIT(); asm volatile("" ::: "memory");
            const int qb = t >> 8, tin = t & 255;
            float g = NEG;
            if (lane < qb) { const float* km = KM + ((size_t)((b * NHA + h) * 16 + lane)) * 128; float s = 0.f; for (int d = 0; d < 128; ++d) s += qs[d] * km[d]; g = s; }
            unsigned selmask = 0u;
            if (qb <= 3) selmask = (1u << qb) - 1u;
            else {
#pragma unroll
                for (int rd = 0; rd < 3; ++rd) {
                    float best = g; int bi = lane;
#pragma unroll
                    for (int o = 1; o < 64; o <<= 1) { const float ob = __shfl_xor(best, o); const int oi = __shfl_xor(bi, o); if (ob > best || (ob == best && oi < bi)) { best = ob; bi = oi; } }
                    selmask |= 1u << bi; if (lane == bi) g = NEG;
                }
            }
            float sc[4][4]; int jsel[3];
            unsigned mk = selmask;
#pragma unroll
            for (int sl = 0; sl < 3; ++sl) {
                int j = -1; if (mk) { j = __builtin_ctz(mk); mk &= mk - 1u; }
                jsel[sl] = j;
#pragma unroll
                for (int c = 0; c < 4; ++c) sc[sl][c] = (j >= 0) ? ATT_SCALE * dot128(qs, Kb + (size_t)(256 * j + lane + 64 * c) * HD) : NEG;
            }
#pragma unroll
            for (int c = 0; c < 4; ++c) { const int i = lane + 64 * c; sc[3][c] = (i <= tin) ? ATT_SCALE * dot128(qs, Kb + (size_t)(256 * qb + i) * HD) : NEG; }
            float mx = NEG;
#pragma unroll
            for (int sl = 0; sl < 4; ++sl)
#pragma unroll
                for (int c = 0; c < 4; ++c) mx = fmaxf(mx, sc[sl][c]);
            mx = wave_max(mx);
            float sum = 0.f;
#pragma unroll
            for (int sl = 0; sl < 4; ++sl)
#pragma unroll
                for (int c = 0; c < 4; ++c) { sc[sl][c] = __expf(sc[sl][c] - mx); sum += sc[sl][c]; }
            sum = wave_sum(sum);
            const float inv = 1.0f / sum;
#pragma unroll
            for (int sl = 0; sl < 4; ++sl)
#pragma unroll
                for (int c = 0; c < 4; ++c) ps[sl * 256 + lane + 64 * c] = sc[sl][c] * inv;
            LDS_WAIT(); asm volatile("" ::: "memory");
            float o0 = 0.f, o1 = 0.f;
#pragma unroll
            for (int sl = 0; sl < 3; ++sl) {
                if (jsel[sl] >= 0) { const bf16* vb = Vb + (size_t)(256 * jsel[sl]) * HD + 2 * lane;
                    for (int i = 0; i < 256; ++i) { const float p = ps[sl * 256 + i]; const unsigned w = *(const unsigned*)(vb + (size_t)i * HD); o0 += p * bflo(w); o1 += p * bfhi(w); } }
            }
            { const bf16* vb = Vb + (size_t)(256 * qb) * HD + 2 * lane;
              for (int i = 0; i <= tin; ++i) { const float p = ps[3 * 256 + i]; const unsigned w = *(const unsigned*)(vb + (size_t)i * HD); o0 += p * bflo(w); o1 += p * bfhi(w); } }
            *(unsigned*)(O + (size_t)(b * NS + t) * DM + h * HD + 2 * lane) = pk2(o0, o1);
            LDS_WAIT(); asm volatile("" ::: "memory");
        } else {
            const int td = task - NMOBA, b = td / (8 * NS), rem = td - b * (8 * NS), hh = rem >> 12, t = rem & 4095;
            float lse[3], og0[3], og1[3];
#pragma unroll
            for (int g = 0; g < 3; ++g) {
                const int head = NHA + g * 8 + hh, dil = g == 0 ? 1 : (g == 1 ? 4 : 16);
                const bf16* qrow = QKV + ((size_t)((0 * 2 + b) * NHQ + head) * NS + t) * HD;
                const bf16* Kb = QKV + (size_t)((1 * 2 + b) * NHQ + head) * NS * HD;
                const bf16* Vb = QKV + (size_t)((2 * 2 + b) * NHQ + head) * NS * HD;
                { const unsigned w = *(const unsigned*)(qrow + 2 * lane); qs[2 * lane] = bflo(w); qs[2 * lane + 1] = bfhi(w); }
                LDS_WAIT(); asm volatile("" ::: "memory");
                float sc[3];
#pragma unroll
                for (int c = 0; c < 3; ++c) { const int m = lane + 64 * c; const int kp = t - m * dil; sc[c] = (m <= 128 && kp >= 0) ? ATT_SCALE * dot128(qs, Kb + (size_t)kp * HD) : NEG; }
                float mx = wave_max(fmaxf(fmaxf(sc[0], sc[1]), sc[2]));
                float e0 = __expf(sc[0] - mx), e1 = __expf(sc[1] - mx), e2 = __expf(sc[2] - mx);
                const float sum = wave_sum(e0 + e1 + e2), inv = 1.0f / sum;
                lse[g] = mx + __logf(sum);
                ps[lane] = e0 * inv; ps[lane + 64] = e1 * inv; if (lane == 0) ps[128] = e2 * inv;
                LDS_WAIT(); asm volatile("" ::: "memory");
                const int nb = t / dil, nk = (nb < 128 ? nb : 128) + 1;
                float o0 = 0.f, o1 = 0.f;
                for (int m = 0; m < nk; ++m) { const float p = ps[m]; const unsigned w = *(const unsigned*)(Vb + (size_t)(t - m * dil) * HD + 2 * lane); o0 += p * bflo(w); o1 += p * bfhi(w); }
                og0[g] = o0; og1[g] = o1;
                LDS_WAIT(); asm volatile("" ::: "memory");
            }
            const float ml = fmaxf(fmaxf(lse[0], lse[1]), lse[2]);
            const float w0 = __expf(lse[0] - ml), w1 = __expf(lse[1] - ml), w2 = __expf(lse[2] - ml), wi = 1.0f / (w0 + w1 + w2);
            const float r0 = (w0 * og0[0] + w1 * og0[1] + w2 * og0[2]) * wi, r1 = (w0 * og1[0] + w1 * og1[1] + w2 * og1[2]) * wi;
            *(unsigned*)(O + (size_t)(b * NS + t) * DM + (NHA + hh) * HD + 2 * lane) = pk2(r0, r1);
        }
    }
}

__device__ __forceinline__ float silu_f(float x) { return x / (1.0f + __expf(-x)); }
__device__ __forceinline__ void unpack8(const v4u w, float (&f)[8]) { f[0] = bflo(w.x); f[1] = bfhi(w.x); f[2] = bflo(w.y); f[3] = bfhi(w.y); f[4] = bflo(w.z); f[5] = bfhi(w.z); f[6] = bflo(w.w); f[7] = bfhi(w.w); }
__device__ __forceinline__ void p_conv(Frame& F, int layer) {
    const bf16* AP = (const bf16*)(F.ws + WS_APRE); bf16* Gb = (bf16*)(F.ws + WS_G);
    const float* cw = F.ffn_conv_w + (size_t)layer * 3 * F2; const float* cb = F.ffn_conv_b + (size_t)layer * F2;
    constexpr int C8 = DFF / 8;
    const size_t total = (size_t)MR * C8;
    for (size_t idx = (size_t)blockIdx.x * 512 + F.tid; idx < total; idx += (size_t)F.G * 512) {
        const int r = (int)(idx / C8), j0 = (int)(idx - (size_t)r * C8) * 8, s = r & 4095;
        float cg[8], cu[8];
#pragma unroll
        for (int e = 0; e < 8; ++e) { cg[e] = cb[j0 + e]; cu[e] = cb[DFF + j0 + e]; }
#pragma unroll
        for (int tp = 0; tp < 3; ++tp) {
            const int back = 2 - tp;
            if (s >= back) {
                float ag[8], au[8];
                unpack8(*(const v4u*)(AP + (size_t)(r - back) * F2 + j0), ag);
                unpack8(*(const v4u*)(AP + (size_t)(r - back) * F2 + DFF + j0), au);
#pragma unroll
                for (int e = 0; e < 8; ++e) { cg[e] += cw[(size_t)tp * F2 + j0 + e] * ag[e]; cu[e] += cw[(size_t)tp * F2 + DFF + j0 + e] * au[e]; }
            }
        }
        v4u o; o.x = pk2(silu_f(cg[0]) * cu[0], silu_f(cg[1]) * cu[1]); o.y = pk2(silu_f(cg[2]) * cu[2], silu_f(cg[3]) * cu[3]);
        o.z = pk2(silu_f(cg[4]) * cu[4], silu_f(cg[5]) * cu[5]); o.w = pk2(silu_f(cg[6]) * cu[6], silu_f(cg[7]) * cu[7]);
        *(v4u*)(Gb + (size_t)r * DFF + j0) = o;
    }
}

__device__ __forceinline__ void p_sgate_naive(Frame& F) {
    const bf16* U = (const bf16*)(F.ws + WS_U); const bf16* V = (const bf16*)(F.ws + WS_V); const float* VS = (const float*)(F.ws + WS_VSQ); bf16* GT = (bf16*)(F.ws + WS_O);
    LAS float* vn = (LAS float*)(F.lds + RING_OFF);
    LAS float* wsl = vn + 128 * 128;
    LAS float* rstat = (LAS float*)(F.lds + XTRA_OFF);
    for (int item = blockIdx.x; item < 64 * 32; item += F.G) {
        const int bc = item >> 5, g = item & 31, r0 = bc * 128;
        if (F.tid < 128) {
            const float s1 = VS[2 * (r0 + F.tid)], s2 = VS[2 * (r0 + F.tid) + 1];
            const float mean = s1 * (1.0f / 4096.0f), var = s2 * (1.0f / 4096.0f) - mean * mean;
            rstat[2 * F.tid] = mean; rstat[2 * F.tid + 1] = 1.0f / sqrtf(var + NORM_EPS);
        }
        __syncthreads();
        for (int idx = F.tid; idx < 128 * 128; idx += 512) {
            const int s = idx >> 7, d = idx & 127, col = g * 128 + d;
            const float v = bf1(V[(size_t)(r0 + s) * DM + col]);
            vn[idx] = (v - rstat[2 * s]) * rstat[2 * s + 1] * F.sg_v_gain[col] + F.sg_v_bias[col];
            wsl[idx] = F.sg_w_s[(size_t)g * 16384 + idx];
        }
        __syncthreads();
        for (int idx = F.tid; idx < 128 * 128; idx += 512) {
            const int t = idx >> 7, d = idx & 127;
            float a = 0.f;
            for (int s = 0; s <= t; ++s) a += wsl[t * 128 + s] * vn[s * 128 + d];
            const float f = a + F.sg_b_s[g * 128 + t];
            const size_t o = (size_t)(r0 + t) * DM + g * 128 + d;
            GT[o] = (bf16)f2bf(bf1(U[o]) * f);
        }
        __syncthreads();
    }
}

__device__ __forceinline__ void p_final(Frame& F) {
    const float* H = (const float*)(F.ws + WS_H); const float* SS4 = (const float*)(F.ws + WS_SSQ + 4 * SSQ_SITE);
#ifdef CHECK_ATTN
    const unsigned nbad = __hip_atomic_load(F.ctl + 8, __ATOMIC_RELAXED, __HIP_MEMORY_SCOPE_AGENT);
#endif
    for (int m = F.gw; m < MR; m += F.NGW) {
        float rs = ss_rstd(SS4, m);
#ifdef CHECK_ATTN
        if (nbad > CHECK_ATTN) rs = __builtin_nanf("");
#endif
        const f32x4* hr = (const f32x4*)(H + (size_t)m * DM) + F.lane; const f32x4* gr = (const f32x4*)F.final_norm + F.lane;
        f32x4* orow = (f32x4*)(F.out + (size_t)m * DM) + F.lane;
#pragma unroll 4
        for (int j = 0; j < 16; ++j) orow[64 * j] = hr[64 * j] * rs * gr[64 * j];
    }
}

__device__ __forceinline__ unsigned q8(float x, float inv) { int q = (int)__builtin_rintf(x * inv); q = q > 127 ? 127 : (q < -127 ? -127 : q); return (unsigned)q & 0xffu; }
__device__ __forceinline__ void quant_weight_rows(Frame& F, const bf16* src, signed char* dst, const unsigned* amax, float* scale, int N) {
    for (int n = F.gw; n < N; n += F.NGW) {
        const float am = __builtin_bit_cast(float, amax[n]), inv = am > 0.f ? 127.0f / am : 0.f;
        if (F.lane == 0) scale[n] = am * (1.0f / 127.0f);
        const v4u* s = (const v4u*)(src + (size_t)n * DM) + F.lane; v2u* d = (v2u*)(dst + (size_t)n * DM) + F.lane;
#pragma unroll
        for (int i = 0; i < 8; ++i) { float v[8]; unpack8(s[64 * i], v);
            v2u o; o.x = q8(v[0], inv) | (q8(v[1], inv) << 8) | (q8(v[2], inv) << 16) | (q8(v[3], inv) << 24); o.y = q8(v[4], inv) | (q8(v[5], inv) << 8) | (q8(v[6], inv) << 16) | (q8(v[7], inv) << 24);
            d[64 * i] = o; }
    }
}
__device__ __forceinline__ void quant_act_rows(Frame& F, const float* src, signed char* dst, float* scale) {
    for (int m = F.gw; m < MR; m += F.NGW) {
        const f32x4* s = (const f32x4*)(src + (size_t)m * DM) + F.lane; unsigned* d = (unsigned*)(dst + (size_t)m * DM) + F.lane;
        f32x4 v[16]; float am = 0.f;
#pragma unroll
        for (int j = 0; j < 16; ++j) { v[j] = s[64 * j]; am = fmaxf(am, fmaxf(fmaxf(fabsf(v[j][0]), fabsf(v[j][1])), fmaxf(fabsf(v[j][2]), fabsf(v[j][3])))); }
        am = wave_max(am);
        const float inv = am > 0.f ? 127.0f / am : 0.f;
        if (F.lane == 0) scale[m] = am * (1.0f / 127.0f);
#pragma unroll
        for (int j = 0; j < 16; ++j) d[64 * j] = q8(v[j][0], inv) | (q8(v[j][1], inv) << 8) | (q8(v[j][2], inv) << 16) | (q8(v[j][3], inv) << 24);
    }
}
__device__ __forceinline__ unsigned moba_select(const LAS float* km, const bf16* qrow, int qb) {
    const float NEG = -__builtin_inff();
    if (qb <= 3) return (1u << qb) - 1u;
    float g[16];
#pragma unroll
    for (int j = 0; j < 16; ++j) g[j] = 0.f;
#pragma unroll 1
    for (int c = 0; c < 16; ++c) {
        float q8[8]; unpack8(*(const v4u*)(qrow + 8 * c), q8);
#pragma unroll
        for (int j = 0; j < 16; ++j) {
            const f32x4 k0 = *(const LAS f32x4*)(km + j * 128 + 8 * c), k1 = *(const LAS f32x4*)(km + j * 128 + 8 * c + 4);
            g[j] += q8[0] * k0[0] + q8[1] * k0[1] + q8[2] * k0[2] + q8[3] * k0[3] + q8[4] * k1[0] + q8[5] * k1[1] + q8[6] * k1[2] + q8[7] * k1[3];
        }
    }
#pragma unroll
    for (int j = 0; j < 16; ++j) if (j >= qb) g[j] = NEG;
    unsigned sel = 0u;
#pragma unroll
    for (int rd = 0; rd < 3; ++rd) {
        float best = NEG; unsigned bi = 0u;
#pragma unroll
        for (int j = 0; j < 16; ++j) { const bool take = (((sel >> j) & 1u) == 0u) && (g[j] > best); best = take ? g[j] : best; bi = take ? (unsigned)j : bi; }
        sel |= 1u << bi;
    }
    return sel;
}

typedef att::BlockRef<bf16, bf16> ABR;
#ifndef DIL_SK
#define DIL_SK false
#endif
constexpr int ATT_SEL_OFF = 69632, ATT_KM_OFF = 73728;
__device__ __forceinline__ void moba_unit(int vc, int i, int& bh, int& qb) {
    const int grp = vc >> 4, a = vc & 15;
    const unsigned long long PB = 0x24310cbfed5a9687ull, PC = 0x6579b13024c8aedfull;
    qb = i == 0 ? a : (i == 1 ? (int)((PB >> (4 * a)) & 15ull) : (int)((PC >> (4 * a)) & 15ull));
    bh = 3 * grp + i;
}
__device__ __forceinline__ ABR moba_ref(const Frame& F, int vc, int i, const LAS unsigned short* selL) {
    int bh, qb; moba_unit(vc, i, bh, qb);
    const int b = bh / NHA, h = bh - NHA * b;
    const bf16* QKV = (const bf16*)(F.ws + WS_QKV);
    ABR r;
    r.Q = QKV + ((size_t)((0 * 2 + b) * NHQ + h) * NS + 256 * qb) * HD;
    r.K = QKV + (size_t)((1 * 2 + b) * NHQ + h) * NS * HD;
    r.V = QKV + (size_t)((2 * 2 + b) * NHQ + h) * NS * HD;
    r.O = (bf16*)(F.ws + WS_O) + (size_t)(b * NS + 256 * qb) * DM + h * HD;
    r.P0 = 256 * qb;
    r.sel = selL + 256 * i; r.L = nullptr;
    return r;
}
__device__ __forceinline__ ABR dil_ref(const Frame& F, int vc, int g) {
    const int bhh = vc >> 4, b = bhh >> 3, hh = bhh & 7, lo = vc & 15;
    const int dil = g == 0 ? 1 : (g == 1 ? 4 : 16);
    const int res = g == 0 ? 0 : (g == 1 ? (lo >> 2) : lo), blk = g == 0 ? lo : (g == 1 ? (lo & 3) : 0);
    const int head = NHA + 8 * g + hh, pos0 = res + dil * 256 * blk;
    const bf16* QKV = (const bf16*)(F.ws + WS_QKV);
    ABR r;
    r.Q = QKV + ((size_t)((0 * 2 + b) * NHQ + head) * NS + pos0) * HD;
    r.K = QKV + ((size_t)((1 * 2 + b) * NHQ + head) * NS + res) * HD;
    r.V = QKV + ((size_t)((2 * 2 + b) * NHQ + head) * NS + res) * HD;
    r.O = (bf16*)(F.ws + WS_DO) + (size_t)(b * NS + pos0) * 3072 + g * 1024 + hh * HD;
    r.P0 = 256 * blk;
    r.sel = nullptr; r.L = (float*)(F.ws + WS_LSE) + (size_t)(b * NS + pos0) * 24 + g * 8 + hh;
    return r;
}
__device__ __forceinline__ void p_attn(Frame& F, char* lds) {
    for (int vc = blockIdx.x; vc < 256; vc += F.G) {
#ifndef NO_MOBA
        {
            const bf16* QKVq = (const bf16*)(F.ws + WS_QKV); const float* KM = (const float*)(F.ws + WS_KMEAN);
            LAS float* kmL = (LAS float*)(F.lds + RING_OFF + ATT_KM_OFF); LAS unsigned short* selW = (LAS unsigned short*)(F.lds + RING_OFF + ATT_SEL_OFF);
            const LAS unsigned short* selL = selW;
#ifndef NO_GATEPRE
            for (int idx = F.tid; idx < 3 * 2048; idx += 512) { int bh, qb; moba_unit(vc, idx >> 11, bh, qb); kmL[idx] = KM[(size_t)bh * 2048 + (idx & 2047)]; }
            __syncthreads();
            for (int qi = F.tid; qi < 768; qi += 512) { int bh, qb; moba_unit(vc, qi >> 8, bh, qb); const int b = bh / NHA, h = bh - NHA * b;
                selW[qi] = (unsigned short)moba_select(kmL + (qi >> 8) * 2048, QKVq + ((size_t)((0 * 2 + b) * NHQ + h) * NS + 256 * qb + (qi & 255)) * HD, qb); }
            __syncthreads();
#endif
            asm volatile("" ::: "memory");
            int vcb = vc; asm volatile("" : "+s"(vcb));
            att::Seam<bf16> S;
            constexpr int WM = 1 << 30;
            ABR cur = moba_ref(F, vcb, 0, selL);
            att::causal_swa_prime<bf16, bf16, 128, WM>(cur, lds, S);
            for (int i = 0; i < 3; ++i) {
                const ABR nxt = moba_ref(F, vcb, i < 2 ? i + 1 : 2, selL);
                att::causal_swa_block<bf16, bf16, false, 0, 128, 128, DM, WM, WM, NS>(cur, nxt, lds, S);
                cur = nxt;
            }
        }
#endif
    }
    for (int vc = blockIdx.x; vc < 256; vc += F.G) {
#ifndef NO_DIL
        {
            att::Seam<bf16> S;
            const ABR r0 = dil_ref(F, vc, 0), r1 = dil_ref(F, vc, 1), r2 = dil_ref(F, vc, 2);
            att::causal_swa_prime<bf16, bf16, 128, 129>(r0, lds, S);
            att::causal_swa_block<bf16, bf16, DIL_SK, 1, 128, 512, 3072, 129, 129, NS>(r0, r1, lds, S);
            att::causal_swa_block<bf16, bf16, DIL_SK, 1, 512, 2048, 4 * 3072, 129, 129, NS / 4>(r1, r2, lds, S);
            att::causal_swa_block<bf16, bf16, DIL_SK, 1, 2048, 2048, 16 * 3072, 129, 129, NS / 16>(r2, r2, lds, S);
        }
#endif
    }
}
__device__ __forceinline__ void p_dilmerge(Frame& F) {
    const bf16* DO = (const bf16*)(F.ws + WS_DO); const float* LSE = (const float*)(F.ws + WS_LSE); bf16* O = (bf16*)(F.ws + WS_O);
    const size_t total = (size_t)MR * 8 * 16;
    for (size_t idx = (size_t)blockIdx.x * 512 + F.tid; idx < total; idx += (size_t)F.G * 512) {
        const int r = (int)(idx >> 7), hh = (int)(idx >> 4) & 7, c8 = (int)idx & 15;
        const float l0 = LSE[(size_t)r * 24 + hh], l1 = LSE[(size_t)r * 24 + 8 + hh], l2 = LSE[(size_t)r * 24 + 16 + hh];
        const float ml = fmaxf(fmaxf(l0, l1), l2);
        float w0 = __expf(l0 - ml), w1 = __expf(l1 - ml), w2 = __expf(l2 - ml); const float wi = 1.0f / (w0 + w1 + w2); w0 *= wi; w1 *= wi; w2 *= wi;
        float a0[8], a1[8], a2[8];
        unpack8(*(const v4u*)(DO + (size_t)r * 3072 + hh * HD + c8 * 8), a0);
        unpack8(*(const v4u*)(DO + (size_t)r * 3072 + 1024 + hh * HD + c8 * 8), a1);
        unpack8(*(const v4u*)(DO + (size_t)r * 3072 + 2048 + hh * HD + c8 * 8), a2);
        float o[8];
#pragma unroll
        for (int e = 0; e < 8; ++e) o[e] = w0 * a0[e] + w1 * a1[e] + w2 * a2[e];
        v4u w; w.x = pk2(o[0], o[1]); w.y = pk2(o[2], o[3]); w.z = pk2(o[4], o[5]); w.w = pk2(o[6], o[7]);
        *(v4u*)(O + (size_t)r * DM + (NHA + hh) * HD + c8 * 8) = w;
    }
}
__device__ __forceinline__ void p_convfix(Frame& F, int layer) {
    const float* top = (const float*)(F.ws + WS_TOP); const float* bot = (const float*)(F.ws + WS_BOT); bf16* Gb = (bf16*)(F.ws + WS_G);
    const float* cw = F.ffn_conv_w + (size_t)layer * 3 * F2; const float* cb = F.ffn_conv_b + (size_t)layer * F2;
    constexpr int C4 = DFF / 4, NIT = 30 * C4;
    for (int idx = blockIdx.x * 512 + F.tid; idx < NIT; idx += F.G * 512) {
        const int pmi = idx / C4, j0 = (idx - pmi * C4) * 4, pm = pmi + 1 + (pmi >= 15 ? 1 : 0);
        f32x4 c0[2], c1[2];
#pragma unroll
        for (int bj = 0; bj < 2; ++bj) {
            const int col = bj * DFF + j0;
            const f32x4 w0 = *(const f32x4*)(cw + col), w1 = *(const f32x4*)(cw + F2 + col), w2 = *(const f32x4*)(cw + 2 * F2 + col), bb = *(const f32x4*)(cb + col);
            const f32x4 am2 = *(const f32x4*)(bot + (size_t)((pm - 1) * 2 + 0) * F2 + col), am1 = *(const f32x4*)(bot + (size_t)((pm - 1) * 2 + 1) * F2 + col);
            const f32x4 a0 = *(const f32x4*)(top + (size_t)(pm * 2 + 0) * F2 + col), a1 = *(const f32x4*)(top + (size_t)(pm * 2 + 1) * F2 + col);
            c0[bj] = bb + w0 * am2 + w1 * am1 + w2 * a0;
            c1[bj] = bb + w0 * am1 + w1 * a0 + w2 * a1;
        }
        v2u o0, o1;
        o0.x = pk2(silu_f(c0[0][0]) * c0[1][0], silu_f(c0[0][1]) * c0[1][1]); o0.y = pk2(silu_f(c0[0][2]) * c0[1][2], silu_f(c0[0][3]) * c0[1][3]);
        o1.x = pk2(silu_f(c1[0][0]) * c1[1][0], silu_f(c1[0][1]) * c1[1][1]); o1.y = pk2(silu_f(c1[0][2]) * c1[1][2], silu_f(c1[0][3]) * c1[1][3]);
        *(v2u*)(Gb + (size_t)(pm * 256) * DFF + j0) = o0;
        *(v2u*)(Gb + (size_t)(pm * 256 + 1) * DFF + j0) = o1;
    }
}

__device__ __forceinline__ void p_sgate(Frame& F) {
    typedef short bf16x8 __attribute__((ext_vector_type(8))); typedef float f32x16 __attribute__((ext_vector_type(16)));
    const bf16* U = (const bf16*)(F.ws + WS_U); const bf16* V = (const bf16*)(F.ws + WS_V); const float* VS = (const float*)(F.ws + WS_VSQ); bf16* GT = (bf16*)(F.ws + WS_O);
    constexpr int PT = 136;
    LAS bf16* Wc = (LAS bf16*)(F.lds + RING_OFF);
    LAS bf16* vnT = Wc + 128 * PT;
    LAS float* rstat = (LAS float*)(F.lds + RING_OFF + 2 * 128 * PT * 2);
    const int lane = F.lane, r32 = lane & 31, hi = lane >> 5, tb = F.wave >> 1, dh = F.wave & 1;
    int gcur = -1;
    for (int item = blockIdx.x; item < 64 * 32; item += F.G) {
        const int g = item & 31, bc = item >> 5, r0 = bc * 128;
        if (g != gcur) {
            for (int idx = F.tid; idx < 128 * 32; idx += 512) { const int t = idx >> 5, s4 = (idx & 31) * 4;
                const f32x4 w = *(const f32x4*)(F.sg_w_s + (size_t)g * 16384 + t * 128 + s4);
                v2u o; o.x = pk2(s4 <= t ? w[0] : 0.f, s4 + 1 <= t ? w[1] : 0.f); o.y = pk2(s4 + 2 <= t ? w[2] : 0.f, s4 + 3 <= t ? w[3] : 0.f);
                *(LAS v2u*)(Wc + t * PT + s4) = o; }
            gcur = g;
        }
        if (F.tid < 128) { const float s1 = VS[2 * (r0 + F.tid)], s2 = VS[2 * (r0 + F.tid) + 1];
            const float mean = s1 * (1.0f / 4096.0f), var = s2 * (1.0f / 4096.0f) - mean * mean;
            rstat[2 * F.tid] = mean; rstat[2 * F.tid + 1] = 1.0f / sqrtf(var + NORM_EPS); }
        __syncthreads();
        { const int d8 = (F.tid & 15) * 8, col = g * 128 + d8;
          float gn[8], bs[8];
#pragma unroll
          for (int e = 0; e < 8; ++e) { gn[e] = F.sg_v_gain[col + e]; bs[e] = F.sg_v_bias[col + e]; }
          for (int s = F.tid >> 4; s < 128; s += 32) {
              float v8[8]; unpack8(*(const v4u*)(V + (size_t)(r0 + s) * DM + col), v8);
              const float mean = rstat[2 * s], rstd = rstat[2 * s + 1];
#pragma unroll
              for (int e = 0; e < 8; ++e) vnT[(d8 + e) * PT + s] = (bf16)f2bf((v8[e] - mean) * rstd * gn[e] + bs[e]);
          } }
        __syncthreads();
        f32x16 acc0 = {}, acc1 = {};
        const LAS bf16* ap = Wc + (32 * tb + r32) * PT + 8 * hi;
        const LAS bf16* bp0 = vnT + (64 * dh + r32) * PT + 8 * hi, * bp1 = bp0 + 32 * PT;
        for (int ks = 0; ks < 2 * tb + 2; ++ks) {
            const bf16x8 a = *(const LAS bf16x8*)(ap + 16 * ks), b0 = *(const LAS bf16x8*)(bp0 + 16 * ks), b1 = *(const LAS bf16x8*)(bp1 + 16 * ks);
            acc0 = __builtin_amdgcn_mfma_f32_32x32x16_bf16(a, b0, acc0, 0, 0, 0);
            acc1 = __builtin_amdgcn_mfma_f32_32x32x16_bf16(a, b1, acc1, 0, 0, 0);
        }
#pragma unroll
        for (int i = 0; i < 16; ++i) {
            const int t = 32 * tb + (i & 3) + 8 * (i >> 2) + 4 * hi;
            const float bsv = F.sg_b_s[g * 128 + t];
            const size_t o = (size_t)(r0 + t) * DM + g * 128 + 64 * dh + r32;
            GT[o] = (bf16)f2bf(bf1(U[o]) * (acc0[i] + bsv));
            GT[o + 32] = (bf16)f2bf(bf1(U[o + 32]) * (acc1[i] + bsv));
        }
        __syncthreads();
    }
}
constexpr int N_PHASES = 17;
struct Args { const void* in[19]; float* out; unsigned char* ws; int ph_lo, ph_hi, li, pad; };
__global__ void __launch_bounds__(NWAVES * 64, 2) mk_fwd(Args args) {
    extern __shared__ __attribute__((aligned(16))) unsigned char lds[];
    Frame F;
    F.lds = (LAS unsigned char*)lds;
    F.MISC = (volatile LAS unsigned*)(F.lds + MISC_OFF);
    F.tid = threadIdx.x; F.lane = F.tid & 63; F.wave = __builtin_amdgcn_readfirstlane(F.tid >> 6);
    F.G = gridDim.x; F.gw = blockIdx.x * NWAVES + F.wave; F.NGW = F.G * NWAVES;
    F.ws = args.ws; F.ctl = (unsigned*)(args.ws + WS_CTL);
    F.x = (const float*)args.in[0]; F.pos = (const int*)args.in[1];
    F.attn_norm = (const float*)args.in[2]; F.attn_w_in = (const float*)args.in[3]; F.attn_w_out = (const float*)args.in[4];
    F.sg_norm = (const float*)args.in[5]; F.sg_w_in = (const float*)args.in[6]; F.sg_b_in = (const float*)args.in[7]; F.sg_v_gain = (const float*)args.in[8]; F.sg_v_bias = (const float*)args.in[9];
    F.sg_w_s = (const float*)args.in[10]; F.sg_b_s = (const float*)args.in[11]; F.sg_w_out = (const float*)args.in[12];
    F.ffn_norm = (const float*)args.in[13]; F.ffn_w_up = (const float*)args.in[14]; F.ffn_conv_w = (const float*)args.in[15]; F.ffn_conv_b = (const float*)args.in[16]; F.ffn_w_down = (const float*)args.in[17];
    F.final_norm = (const float*)args.in[18]; F.out = args.out;
    for (int u = F.tid; u < (XTRA_OFF - LDSCTL_OFF) / 4; u += NWAVES * 64) ((LAS unsigned*)(F.lds + LDSCTL_OFF))[u] = 0u;
    __syncthreads();
    const int lo = args.ph_lo, hi = args.ph_hi;
    XcdBarrier bar; bar.bar = F.ctl + CW_BAR + args.li * XCD_BAR_WORDS; bar.x = 0; bar.st = nullptr;
    if (hi - lo > 1) bar = xcd_barrier_post(F.ctl + CW_BAR + args.li * XCD_BAR_WORDS, F.MISC + 8);
#define IN(k) (lo <= (k) && (k) < hi)
#define SEAM(k) do { if (IN(k) && IN((k) + 1)) xcd_barrier(bar); } while (0)
    unsigned char* ws = args.ws;
    bf16* XB = (bf16*)(ws + WS_XB); float* H = (float*)(ws + WS_H); bf16* O = (bf16*)(ws + WS_O); bf16* Gb = (bf16*)(ws + WS_G); bf16* AP = (bf16*)(ws + WS_APRE);
    float* SS = (float*)(ws + WS_SSQ); constexpr size_t SSF = SSQ_SITE / 4;
    const int c = (int)blockIdx.x;

    if (IN(0)) { p0_prologue(F); } SEAM(0);
    if (IN(1)) {
        pg8::Gemm g{XB, (const bf16*)(ws + WS_WIN), MR, QKVC, DM}; pg8::StaticOrder S; S.init(MR, QKVC, F.G, c);
        pg8::EpiQKV E{(bf16*)(ws + WS_QKV), SS, (const float*)(ws + WS_ROPE), (const float*)(ws + WS_ROPE) + MR * 16, (float*)(ws + WS_KMEAN)};
        pg8::gemm_phase<pg8::EpiQKV, pg8::StaticOrder, PG8_ALIGN, PG8_SP2>(F.lds + RING_OFF, g, S, E);
    } SEAM(1);
    if (IN(2)) { p_attn(F, (char*)lds + RING_OFF); } SEAM(2);
    if (IN(3)) { p_dilmerge(F);
#ifdef CHECK_ATTN
        xcd_barrier(bar); p_attn_naive(F, AP); xcd_barrier(bar);
        { unsigned bad = 0; for (size_t idx = (size_t)blockIdx.x * 512 + F.tid; idx < (size_t)MR * DM; idx += (size_t)F.G * 512) { const float a = bf1(O[idx]), b = bf1(AP[idx]); if (!(fabsf(a - b) <= 0.004f + 0.03f * fabsf(b))) ++bad; }
          if (bad) atomicAdd(F.ctl + 8, bad); }
#endif
        quant_weight_rows(F, (const bf16*)(ws + WS_WUP), (signed char*)(ws + WS_WUP8), (const unsigned*)(ws + WS_AMAX) + AM_WUP, (float*)(ws + WS_SW) + AM_WUP, F2);
        quant_weight_rows(F, (const bf16*)(ws + WS_WUP + WUP_L), (signed char*)(ws + WS_WUP8 + WUP8_L), (const unsigned*)(ws + WS_AMAX) + AM_WUP + F2, (float*)(ws + WS_SW) + AM_WUP + F2, F2);
    } SEAM(3);
    if (IN(4)) {
        pg8::Gemm g{O, (const bf16*)(ws + WS_WOUT), MR, DM, DM}; pg8::StaticOrder S; S.init(MR, DM, F.G, c);
        pg8::EpiRes E{F.x, H, XB, SS + 1 * SSF};
        pg8::gemm_phase<pg8::EpiRes, pg8::StaticOrder, PG8_ALIGN, PG8_SP2>(F.lds + RING_OFF, g, S, E);
    } SEAM(4);
    if (IN(5)) { quant_act_rows(F, H, (signed char*)(ws + WS_HQ8), (float*)(ws + WS_SAH)); } SEAM(5);
    if (IN(6)) {
        pg8::Gemm g{(const bf16*)(ws + WS_HQ8), (const bf16*)(ws + WS_WUP8), MR, F2, DM / 2}; pg8::StaticOrder S; S.init(MR, F2, F.G, c);
        pg8::EpiUpConv8 E{Gb, SS + 1 * SSF, F.ffn_conv_w, F.ffn_conv_b, (float*)(ws + WS_TOP), (float*)(ws + WS_BOT), (LAS float*)(F.lds + XTRA_OFF), (const float*)(ws + WS_SAH), (const float*)(ws + WS_SW) + AM_WUP};
        pg8::gemm_phase<pg8::EpiUpConv8, pg8::StaticOrder, true, PG8_SP2>(F.lds + RING_OFF, g, S, E);
    } SEAM(6);
    if (IN(7)) { p_convfix(F, 0); } SEAM(7);
    if (IN(8)) {
        pg8::Gemm g{Gb, (const bf16*)(ws + WS_WDOWN), MR, DM, DFF}; pg8::StaticOrder S; S.init(MR, DM, F.G, c);
        pg8::EpiRes E{H, H, XB, SS + 2 * SSF};
        pg8::gemm_phase<pg8::EpiRes, pg8::StaticOrder, PG8_ALIGN, PG8_SP2>(F.lds + RING_OFF, g, S, E);
    } SEAM(8);
    if (IN(9)) {
        pg8::Gemm g{XB, (const bf16*)(ws + WS_SGWIN), MR, 2 * DM, DM}; pg8::StaticOrder S; S.init(MR, 2 * DM, F.G, c);
        pg8::EpiSgIn E{(bf16*)(ws + WS_U), (bf16*)(ws + WS_V), SS + 2 * SSF, F.sg_b_in, (float*)(ws + WS_VSQ)};
        pg8::gemm_phase<pg8::EpiSgIn, pg8::StaticOrder, PG8_ALIGN, PG8_SP2>(F.lds + RING_OFF, g, S, E);
    } SEAM(9);
    if (IN(10)) { p_sgate(F); } SEAM(10);
    if (IN(11)) {
        pg8::Gemm g{O, (const bf16*)(ws + WS_SGWOUT), MR, DM, DM}; pg8::StaticOrder S; S.init(MR, DM, F.G, c);
        pg8::EpiRes E{H, H, XB, SS + 3 * SSF};
        pg8::gemm_phase<pg8::EpiRes, pg8::StaticOrder, PG8_ALIGN, PG8_SP2>(F.lds + RING_OFF, g, S, E);
    } SEAM(11);
    if (IN(12)) { quant_act_rows(F, H, (signed char*)(ws + WS_HQ8), (float*)(ws + WS_SAH)); } SEAM(12);
    if (IN(13)) {
        pg8::Gemm g{(const bf16*)(ws + WS_HQ8), (const bf16*)(ws + WS_WUP8 + WUP8_L), MR, F2, DM / 2}; pg8::StaticOrder S; S.init(MR, F2, F.G, c);
        pg8::EpiUpConv8 E{Gb, SS + 3 * SSF, F.ffn_conv_w + 3 * F2, F.ffn_conv_b + F2, (float*)(ws + WS_TOP), (float*)(ws + WS_BOT), (LAS float*)(F.lds + XTRA_OFF), (const float*)(ws + WS_SAH), (const float*)(ws + WS_SW) + AM_WUP + F2};
        pg8::gemm_phase<pg8::EpiUpConv8, pg8::StaticOrder, true, PG8_SP2>(F.lds + RING_OFF, g, S, E);
    } SEAM(13);
    if (IN(14)) { p_convfix(F, 1); } SEAM(14);
    if (IN(15)) {
        pg8::Gemm g{Gb, (const bf16*)(ws + WS_WDOWN + WDOWN_L), MR, DM, DFF}; pg8::StaticOrder S; S.init(MR, DM, F.G, c);
        pg8::EpiRes E{H, H, XB, SS + 4 * SSF};
        pg8::gemm_phase<pg8::EpiRes, pg8::StaticOrder, PG8_ALIGN, PG8_SP2>(F.lds + RING_OFF, g, S, E);
    } SEAM(15);
    if (IN(16)) { p_final(F); }
#undef IN
#undef SEAM
}

extern "C" void kernel_launch(void* const* d_in, const int* in_sizes, int n_in, void* d_out, int out_size, void* d_ws, size_t ws_size, hipStream_t stream) {
    static int grid = 0;
    if (grid == 0) {
        if (n_in != 19 || out_size != MR * DM || ws_size < WS_END) { fprintf(stderr, "kernel_launch: unexpected shapes (n_in %d, out %d, ws %zu); nothing launched\n", n_in, out_size, ws_size); grid = -1; return; }
        int dev = 0, cus = 0, per_cu = 0;
        if (hipGetDevice(&dev) != hipSuccess || hipDeviceGetAttribute(&cus, hipDeviceAttributeMultiprocessorCount, dev) != hipSuccess) { grid = -1; return; }
        if (hipFuncSetAttribute((const void*)mk_fwd, hipFuncAttributeMaxDynamicSharedMemorySize, LDS_BYTES) != hipSuccess) { fprintf(stderr, "kernel_launch: hipFuncSetAttribute failed\n"); grid = -1; return; }
        if (hipOccupancyMaxActiveBlocksPerMultiprocessor(&per_cu, (const void*)mk_fwd, NWAVES * 64, LDS_BYTES) != hipSuccess || per_cu < 1) fprintf(stderr, "kernel_launch: occupancy query reports %d\n", per_cu);
        (void)hipGetLastError();
        grid = cus;
    }
    if (grid < 0) return;
    if (hipMemsetAsync((char*)d_ws + WS_CTL, 0, CTL_ZERO_BYTES, stream) != hipSuccess) return;
    Args a{};
    for (int i = 0; i < 19; ++i) a.in[i] = d_in[i];
    a.out = (float*)d_out; a.ws = (unsigned char*)d_ws; a.pad = 0;
    if (MK_N_LAUNCHES == 1) {
        a.ph_lo = 0; a.ph_hi = N_PHASES; a.li = 0;
        hipLaunchKernelGGL(mk_fwd, dim3(grid), dim3(NWAVES * 64), LDS_BYTES, stream, a);
    } else {
        for (int p = 0; p < N_PHASES; ++p) { a.ph_lo = p; a.ph_hi = p + 1; a.li = 0; hipLaunchKernelGGL(mk_fwd, dim3(grid), dim3(NWAVES * 64), LDS_BYTES, stream, a);
#ifdef PROBE_MASK
            if ((PROBE_MASK >> p) & 1) hipLaunchKernelGGL(mk_fwd, dim3(grid), dim3(NWAVES * 64), LDS_BYTES, stream, a);
#endif
        }
    }
}
```

```cpp
#include <hip/hip_runtime.h>
#include <cstdio>
#include <cstdint>
#ifndef MK_N_LAUNCHES
#define MK_N_LAUNCHES 1
#endif
namespace pg8 {
#define PG8_LAS __attribute__((address_space(3)))
typedef unsigned short bf16_t;
typedef short bf16x8 __attribute__((ext_vector_type(8)));
typedef float f32x4 __attribute__((ext_vector_type(4)));
typedef unsigned u32x4 __attribute__((ext_vector_type(4)));
constexpr int BM = 256, BK = 64, HALF = 128, HTB = HALF * BK * 2  , STAGE_BYTES = 8 * HTB, NXCD = 8, WGM = 8;

__host__ __device__ __forceinline__ int lds_byte(int r, int c) { const int st = (r >> 4) * 2 + (c >> 5), rr = r & 15, cc = c & 31, ob = rr * 64 + cc * 2; return st * 1024 + (ob ^ (((ob >> 9) & 1) << 5)); }
__host__ __device__ __forceinline__ void stage_rc(int b, int& R, int& C) { const int st = b / 1024, sb = b % 1024, swz = sb ^ (((sb >> 9) & 1) << 5); R = (st >> 1) * 16 + swz / 64; C = (st & 1) * 32 + (swz % 64) / 2; }
__host__ __device__ __forceinline__ int perm32(int rho) { const int n = rho >> 4, i = rho & 15; return 8 * (i >> 2) + 4 * n + (i & 3); }

struct Unit { int pm, pn; };
struct Gemm { const bf16_t* A; const bf16_t* Bt; int M, N, K; };

struct StaticOrder {
    int nM, nN, nwg, G, c, same;
    __host__ __device__ void init(int M, int N, int G_, int c_) { nM = M / BM; nN = N / BM; nwg = nM * nN; G = G_; c = c_; same = -1; }
    __host__ __device__ bool next(int i, Unit& u) const {
        const long L = (long)i * G + c; if (L >= nwg) return false;
        int wgid = (int)L; { const int q = nwg / NXCD, r = nwg % NXCD, xcd = wgid % NXCD, off = wgid / NXCD; wgid = (xcd < r ? xcd * (q + 1) : r * (q + 1) + (xcd - r) * q) + off; }
        const int nig = WGM * nN, gid = wgid / nig, fm = gid * WGM, gsz = (nM - fm) < WGM ? (nM - fm) : WGM;
        u.pm = fm + ((wgid % nig) % gsz); u.pn = (wgid % nig) / gsz; u.pm &= same; u.pn &= same; return true;
    }
    __device__ __forceinline__ void a_ready(const Unit&) const {}
    __device__ __forceinline__ void done(const Unit&) const {}
};
__device__ __forceinline__ unsigned cvt_pk_bf16(float lo, float hi) { unsigned r; asm volatile("v_cvt_pk_bf16_f32 %0, %1, %2" : "=v"(r) : "v"(lo), "v"(hi)); return r; }
typedef float f32x2 __attribute__((ext_vector_type(2)));
__device__ __forceinline__ f32x2 gelu_pk(f32x2 v) {
    const f32x2 av = __builtin_elementwise_abs(v), d = av * 0.2316418882f + 1.0f;
    f32x2 t; t.x = __builtin_amdgcn_rcpf(d.x); t.y = __builtin_amdgcn_rcpf(d.y);
    f32x2 q = t * 0.5307027145f + (-0.7265760135f); q = q * t + 0.7107068705f; q = q * t + (-0.142248368f); q = q * t + 0.127414796f; q = q * t;
    const f32x2 s = (v * v) * (-0.72134752044f);
    f32x2 e; e.x = __builtin_amdgcn_exp2f(s.x); e.y = __builtin_amdgcn_exp2f(s.y);
    const f32x2 m = v * (q * e), r = v - m;
    f32x2 o; o.x = v.x < 0.f ? m.x : r.x; o.y = v.y < 0.f ? m.y : r.y; return o;
}
typedef unsigned u32x2 __attribute__((ext_vector_type(2)));
typedef int i32x4 __attribute__((ext_vector_type(4)));
template <bool I8> struct AccT { typedef f32x4 type; };
template <> struct AccT<true> { typedef i32x4 type; };
__device__ __forceinline__ f32x4 tof(f32x4 a) { return a; }
__device__ __forceinline__ f32x4 tof(i32x4 a) { return (f32x4){(float)a[0], (float)a[1], (float)a[2], (float)a[3]}; }
__device__ __forceinline__ float rstd_from_ss(const float* ss, int r) { return 1.0f / sqrtf(ss[r] * (1.0f / 4096.0f) + 1e-5f); }

template <bool Q8> struct EpiQKVT {
    static constexpr bool PERM = false, AFTER_DRAIN = false, I8 = Q8;
    typedef typename AccT<Q8>::type acc_t;
    bf16_t* qkv; const float* ss; const float* ropec; const float* ropes; float* km; const float* sa; const float* sw;
    __device__ __forceinline__ void operator()(const acc_t (&acc)[2][2][4][2], const Unit& u, int wr, int wc, int fr_in, int fq_in) const {
        int fr = fr_in, fq = fq_in; asm volatile("" : "+v"(fr), "+v"(fq));
        const int row0 = u.pm * BM + wr * 64 + fr;
        f32x4 swv[2][2];
#pragma unroll
        for (int bj = 0; bj < 2; ++bj)
#pragma unroll
            for (int n = 0; n < 2; ++n) swv[bj][n] = Q8 ? *(const f32x4*)(sw + u.pn * BM + bj * HALF + wc * 32 + 16 * n + 4 * fq) : (f32x4){1.f, 1.f, 1.f, 1.f};
        const bool kmu = u.pn >= 24 && u.pn < 36;
        const bool rot = wc == 0 && u.pn < 48;
        f32x4 cs[2][2];
#pragma unroll
        for (int bj = 0; bj < 2; ++bj)
#pragma unroll
            for (int n = 0; n < 2; ++n) cs[bj][n] = (f32x4){0.f, 0.f, 0.f, 0.f};
#pragma unroll
        for (int ai = 0; ai < 2; ++ai) {
            float rs[4]; f32x4 cz[4], sn[4];
            float sar[4];
#pragma unroll
            for (int m = 0; m < 4; ++m) sar[m] = Q8 ? sa[row0 + ai * HALF + m * 16] : 1.0f;
#pragma unroll
            for (int m = 0; m < 4; ++m) { const int r = row0 + ai * HALF + m * 16; rs[m] = ss[r];
                cz[m] = (f32x4){1.f, 1.f, 1.f, 1.f}; sn[m] = (f32x4){0.f, 0.f, 0.f, 0.f};
                if (rot) { cz[m] = *(const f32x4*)(ropec + (size_t)r * 16 + 4 * fq); sn[m] = *(const f32x4*)(ropes + (size_t)r * 16 + 4 * fq); } }
#pragma unroll
            for (int m = 0; m < 4; ++m) {
                const int r = row0 + ai * HALF + m * 16;
                const float rsv = sar[m] / sqrtf(rs[m] * (1.0f / 4096.0f) + 1e-5f);
                const int b = r >> 12, s = r & 4095;
#pragma unroll
                for (int bj = 0; bj < 2; ++bj) {
                    const int colh = 2 * u.pn + bj, which = colh / 48, head = colh - which * 48;
                    bf16_t* dst = qkv + ((size_t)((which * 2 + b) * 48 + head) * 4096 + s) * 128 + wc * 32 + 4 * fq;
                    f32x4 v0 = tof(acc[ai][bj][m][0]) * rsv, v1 = tof(acc[ai][bj][m][1]) * rsv;
                    if (Q8) { v0 = v0 * swv[bj][0]; v1 = v1 * swv[bj][1]; }
                    if (rot) { const f32x4 n0 = v0 * cz[m] - v1 * sn[m], n1 = v1 * cz[m] + v0 * sn[m]; v0 = n0; v1 = n1; }
                    if (kmu) { cs[bj][0] += v0; cs[bj][1] += v1; }
                    u32x2 w0, w1; w0.x = cvt_pk_bf16(v0[0], v0[1]); w0.y = cvt_pk_bf16(v0[2], v0[3]); w1.x = cvt_pk_bf16(v1[0], v1[1]); w1.y = cvt_pk_bf16(v1[2], v1[3]);
                    *(u32x2*)(dst) = w0; *(u32x2*)(dst + 16) = w1;
                }
            }
            asm volatile("" ::: "memory");
        }
        if (kmu) {
            const int b = u.pm >> 4, blk = u.pm & 15;
#pragma unroll
            for (int bj = 0; bj < 2; ++bj) {
                const int head = 2 * u.pn + bj - 48;
                float* dst = km + ((size_t)((b * 24 + head) * 16 + blk)) * 128 + wc * 32 + 4 * fq;
#pragma unroll
                for (int n = 0; n < 2; ++n)
#pragma unroll
                    for (int j = 0; j < 4; ++j) {
                        float v = cs[bj][n][j];
                        v += __shfl_xor(v, 1); v += __shfl_xor(v, 2); v += __shfl_xor(v, 4); v += __shfl_xor(v, 8);
                        if (fr == 0) atomicAdd(dst + 16 * n + j, v * (1.0f / 256.0f));
                    }
            }
        }
    }
};
typedef EpiQKVT<false> EpiQKV;
typedef EpiQKVT<true> EpiQKV8;

struct EpiRes {
    static constexpr bool PERM = false, AFTER_DRAIN = false, I8 = false;
    const float* hin; float* hout; bf16_t* xb; float* ss;
    __device__ __forceinline__ void operator()(const f32x4 (&acc)[2][2][4][2], const Unit& u, int wr, int wc, int fr, int fq) const {
        const int row0 = u.pm * BM + wr * 64 + fr, col0 = u.pn * BM + wc * 32 + 4 * fq;
#pragma unroll
        for (int ai = 0; ai < 2; ++ai) {
            f32x4 h[4][2][2];
#pragma unroll
            for (int m = 0; m < 4; ++m)
#pragma unroll
                for (int bj = 0; bj < 2; ++bj)
#pragma unroll
                    for (int n = 0; n < 2; ++n) h[m][bj][n] = *(const f32x4*)(hin + (size_t)(row0 + ai * HALF + m * 16) * 4096 + col0 + bj * HALF + n * 16);
#pragma unroll
            for (int m = 0; m < 4; ++m) {
                const int r = row0 + ai * HALF + m * 16; const size_t off = (size_t)r * 4096 + col0;
                float sq = 0.f;
#pragma unroll
                for (int bj = 0; bj < 2; ++bj)
#pragma unroll
                    for (int n = 0; n < 2; ++n) {
                        const f32x4 hv = h[m][bj][n] + acc[ai][bj][m][n];
                        *(f32x4*)(hout + off + bj * HALF + n * 16) = hv;
                        u32x2 w; w.x = cvt_pk_bf16(hv[0], hv[1]); w.y = cvt_pk_bf16(hv[2], hv[3]);
                        *(u32x2*)(xb + off + bj * HALF + n * 16) = w;
                        sq += (hv[0] * hv[0] + hv[1] * hv[1]) + (hv[2] * hv[2] + hv[3] * hv[3]);
                    }
                sq += __shfl_xor(sq, 16); sq += __shfl_xor(sq, 32);
                if (fq == 0) atomicAdd(ss + r, sq);
            }
            asm volatile("" ::: "memory");
        }
    }
};

struct EpiUpPre {
    static constexpr bool PERM = true, AFTER_DRAIN = false, I8 = false;
    bf16_t* apre; const float* ss;
    __device__ __forceinline__ void operator()(const f32x4 (&acc)[2][2][4][2], const Unit& u, int wr, int wc, int fr, int fq) const {
        const int row0 = u.pm * BM + wr * 64 + fr, col0 = u.pn * 128 + wc * 32 + 8 * fq;
#pragma unroll
        for (int ai = 0; ai < 2; ++ai)
#pragma unroll
            for (int m = 0; m < 4; ++m) {
                const int r = row0 + ai * HALF + m * 16;
                const float rs = rstd_from_ss(ss, r);
                bf16_t* rowp = apre + (size_t)r * 28672 + col0;
#pragma unroll
                for (int bj = 0; bj < 2; ++bj) {
                    const f32x4 v0 = acc[ai][bj][m][0] * rs, v1 = acc[ai][bj][m][1] * rs;
                    u32x4 w; w.x = cvt_pk_bf16(v0[0], v0[1]); w.y = cvt_pk_bf16(v0[2], v0[3]); w.z = cvt_pk_bf16(v1[0], v1[1]); w.w = cvt_pk_bf16(v1[2], v1[3]);
                    *(u32x4*)(rowp + bj * 14336) = w;
                }
                asm volatile("" ::: "memory");
            }
    }
};

struct EpiSgIn {
    static constexpr bool PERM = true, AFTER_DRAIN = false, I8 = false;
    bf16_t* U; bf16_t* V; const float* ss; const float* bias; float* vs;
    __device__ __forceinline__ void operator()(const f32x4 (&acc)[2][2][4][2], const Unit& u, int wr, int wc, int fr, int fq) const {
        const int row0 = u.pm * BM + wr * 64 + fr, gcol0 = u.pn * BM + wc * 32 + 8 * fq;
        const bool isv = u.pn >= 16;
        bf16_t* base = isv ? V : U; const int col0 = isv ? gcol0 - 4096 : gcol0;
        f32x4 bv[2][2];
#pragma unroll
        for (int bj = 0; bj < 2; ++bj)
#pragma unroll
            for (int n = 0; n < 2; ++n) bv[bj][n] = *(const f32x4*)(bias + gcol0 + bj * HALF + 4 * n);
        float rsq[2][4];
#pragma unroll
        for (int ai = 0; ai < 2; ++ai)
#pragma unroll
            for (int m = 0; m < 4; ++m) rsq[ai][m] = ss[row0 + ai * HALF + m * 16];
#pragma unroll
        for (int ai = 0; ai < 2; ++ai)
#pragma unroll
            for (int m = 0; m < 4; ++m) {
                const int r = row0 + ai * HALF + m * 16;
                const float rs = 1.0f / sqrtf(rsq[ai][m] * (1.0f / 4096.0f) + 1e-5f);
                bf16_t* rowp = base + (size_t)r * 4096 + col0;
                float s1 = 0.f, s2 = 0.f;
#pragma unroll
                for (int bj = 0; bj < 2; ++bj) {
                    f32x4 v0 = acc[ai][bj][m][0] * rs + bv[bj][0], v1 = acc[ai][bj][m][1] * rs + bv[bj][1];
                    const f32x2 a = gelu_pk((f32x2){v0[0], v0[1]}), b = gelu_pk((f32x2){v0[2], v0[3]}), c = gelu_pk((f32x2){v1[0], v1[1]}), d = gelu_pk((f32x2){v1[2], v1[3]});
                    s1 += (a.x + a.y) + (b.x + b.y) + (c.x + c.y) + (d.x + d.y);
                    s2 += (a.x * a.x + a.y * a.y) + (b.x * b.x + b.y * b.y) + (c.x * c.x + c.y * c.y) + (d.x * d.x + d.y * d.y);
                    u32x4 w; w.x = cvt_pk_bf16(a.x, a.y); w.y = cvt_pk_bf16(b.x, b.y); w.z = cvt_pk_bf16(c.x, c.y); w.w = cvt_pk_bf16(d.x, d.y);
                    *(u32x4*)(rowp + bj * HALF) = w;
                }
                if (isv) {
                    s1 += __shfl_xor(s1, 16); s1 += __shfl_xor(s1, 32); s2 += __shfl_xor(s2, 16); s2 += __shfl_xor(s2, 32);
                    if (fq == 0) { atomicAdd(vs + 2 * r, s1); atomicAdd(vs + 2 * r + 1, s2); }
                }
            }
    }
};

#define PG8_DPP(oldv, srcv, ctrl) __builtin_bit_cast(float, __builtin_amdgcn_update_dpp(__builtin_bit_cast(int, (float)(oldv)), __builtin_bit_cast(int, (float)(srcv)), (ctrl), 0xf, 0xf, false))
template <bool Q8> struct EpiUpConvT {
    static constexpr bool PERM = true, AFTER_DRAIN = false, I8 = Q8;
    typedef typename AccT<Q8>::type acc_t;
    bf16_t* G; const float* ss; const float* cw; const float* cb; float* top; float* bot; PG8_LAS float* xch; const float* sa; const float* sw;
    __device__ __forceinline__ static float silu(float x) { return x * __builtin_amdgcn_rcpf(1.0f + __builtin_amdgcn_exp2f(-1.4426950408889634f * x)); }
    __device__ __forceinline__ void operator()(const acc_t (&acc)[2][2][4][2], const Unit& u, int wr, int wc, int fr_in, int fq_in) const {
        int fr = fr_in, fq = fq_in; asm volatile("" : "+v"(fr), "+v"(fq));
        const int row0 = u.pm * BM + wr * 64 + fr, colg = u.pn * 128 + wc * 32 + 8 * fq;
        float rs[2][4];
#pragma unroll
        for (int ai = 0; ai < 2; ++ai)
#pragma unroll
            for (int m = 0; m < 4; ++m) rs[ai][m] = ss[row0 + ai * HALF + m * 16];
        float sar[2][4];
#pragma unroll
        for (int ai = 0; ai < 2; ++ai)
#pragma unroll
            for (int m = 0; m < 4; ++m) sar[ai][m] = Q8 ? sa[row0 + ai * HALF + m * 16] : 1.0f;

        PG8_LAS float* wl = xch + 2048;
        { const int t = (wr * 4 + wc) * 64 + fq * 16 + fr, arr = t >> 7, c2 = (t & 127) * 2, gcol = (c2 < 128 ? 0 : 14336 - 128) + u.pn * 128 + c2;
          const f32x2 wv = *(const f32x2*)((arr < 3 ? cw + arr * 28672 : cb) + gcol);
          *(PG8_LAS f32x2*)(wl + arr * 256 + c2) = wv;
          if (Q8 && t < 128) *(PG8_LAS f32x2*)(wl + 1024 + 2 * t) = *(const f32x2*)(sw + u.pn * 256 + 2 * t); }
#pragma unroll
        for (int ai = 0; ai < 2; ++ai)
#pragma unroll
            for (int m = 0; m < 4; ++m) rs[ai][m] = sar[ai][m] / sqrtf(rs[ai][m] * (1.0f / 4096.0f) + 1e-5f);
#pragma unroll
        for (int ai = 0; ai < 2; ++ai)
#pragma unroll
            for (int bj = 0; bj < 2; ++bj)
#pragma unroll
                for (int n = 0; n < 2; ++n) {
                    const f32x4 v = tof(acc[ai][bj][3][n]) * rs[ai][3];
                    if (fr >= 14) {
                        *(PG8_LAS f32x4*)(xch + ((((((ai * 2 + wr) * 4 + wc) * 2 + bj) * 2 + n) * 4 + fq) * 2 + (fr - 14)) * 4) = v;
                        if (ai == 1 && wr == 1) { f32x4 vs = v; if (Q8) vs = vs * *(const f32x4*)(sw + u.pn * 256 + bj * 128 + wc * 32 + 8 * fq + 4 * n);
                            *(f32x4*)(bot + ((size_t)(u.pm * 2 + (fr - 14)) * 28672) + bj * 14336 + colg + 4 * n) = vs; }
                    }
                }
        if (wr == 0 && fr < 2) {
#pragma unroll
            for (int bj = 0; bj < 2; ++bj)
#pragma unroll
                for (int n = 0; n < 2; ++n) { f32x4 vs = tof(acc[0][bj][0][n]) * rs[0][0]; if (Q8) vs = vs * *(const f32x4*)(sw + u.pn * 256 + bj * 128 + wc * 32 + 8 * fq + 4 * n);
                    *(f32x4*)(top + ((size_t)(u.pm * 2 + fr) * 28672) + bj * 14336 + colg + 4 * n) = vs; }
        }
        asm volatile("s_waitcnt lgkmcnt(0)" ::: "memory"); __builtin_amdgcn_s_barrier(); asm volatile("" ::: "memory");
#pragma unroll
        for (int n = 0; n < 2; ++n) {
            f32x4 w0[2], w1[2], w2[2], cbv[2];
#pragma unroll
            for (int bj = 0; bj < 2; ++bj) { const int lc = bj * 128 + wc * 32 + 8 * fq + 4 * n;
                w0[bj] = *(const PG8_LAS f32x4*)(wl + lc); w1[bj] = *(const PG8_LAS f32x4*)(wl + 256 + lc); w2[bj] = *(const PG8_LAS f32x4*)(wl + 512 + lc); cbv[bj] = *(const PG8_LAS f32x4*)(wl + 768 + lc);
                if (Q8) { const f32x4 sc = *(const PG8_LAS f32x4*)(wl + 1024 + lc); w0[bj] = w0[bj] * sc; w1[bj] = w1[bj] * sc; w2[bj] = w2[bj] * sc; } }
#pragma unroll
            for (int ai = 0; ai < 2; ++ai) {
                f32x4 prev[2];
                const bool has = !(ai == 0 && wr == 0);
                const int pai = wr == 1 ? ai : 0, pwr = wr == 1 ? 0 : 1;
#pragma unroll
                for (int bj = 0; bj < 2; ++bj) {
                    prev[bj] = (f32x4){0.f, 0.f, 0.f, 0.f};
                    if (has && fr >= 14) prev[bj] = *(const PG8_LAS f32x4*)(xch + ((((((pai * 2 + pwr) * 4 + wc) * 2 + bj) * 2 + n) * 4 + fq) * 2 + (fr - 14)) * 4);
                }
#pragma unroll
                for (int m = 0; m < 4; ++m) {
                    f32x4 cv[2];
#pragma unroll
                    for (int bj = 0; bj < 2; ++bj) {
                        const f32x4 cur = tof(acc[ai][bj][m][n]) * rs[ai][m];
#pragma unroll
                        for (int j = 0; j < 4; ++j) {
                            const float r1 = PG8_DPP(0.f, prev[bj][j], 0x121), r2 = PG8_DPP(0.f, prev[bj][j], 0x122);
                            const float p1 = PG8_DPP(r1, cur[j], 0x111), p2 = PG8_DPP(r2, cur[j], 0x112);
                            cv[bj][j] = cbv[bj][j] + w0[bj][j] * p2 + w1[bj][j] * p1 + w2[bj][j] * cur[j];
                        }
                        prev[bj] = cur;
                    }
                    u32x2 w; w.x = cvt_pk_bf16(silu(cv[0][0]) * cv[1][0], silu(cv[0][1]) * cv[1][1]); w.y = cvt_pk_bf16(silu(cv[0][2]) * cv[1][2], silu(cv[0][3]) * cv[1][3]);
                    *(u32x2*)(G + (size_t)(row0 + ai * HALF + m * 16) * 14336 + colg + 4 * n) = w;
                    asm volatile("" ::: "memory");
                }
            }
            asm volatile("" ::: "memory");
        }
    }
};

typedef EpiUpConvT<false> EpiUpConv;
typedef EpiUpConvT<true> EpiUpConv8;
struct EpiNull {
    static constexpr bool PERM = true, AFTER_DRAIN = false, I8 = false;
    float* sink; int never;
    __device__ __forceinline__ void operator()(const f32x4 (&acc)[2][2][4][2], const Unit& u, int wr, int wc, int fr, int fq) const {
        if (never == 12345) {
#pragma unroll
            for (int ai = 0; ai < 2; ++ai)
#pragma unroll
                for (int bj = 0; bj < 2; ++bj)
#pragma unroll
                    for (int m = 0; m < 4; ++m)
#pragma unroll
                        for (int n = 0; n < 2; ++n) *(f32x4*)(sink + ((((ai * 2 + bj) * 4 + m) * 2 + n) * 512 + threadIdx.x) * 4) = acc[ai][bj][m][n];
        }
    }
};
__device__ __forceinline__ f32x4 mma16(bf16x8 a, bf16x8 b, f32x4 c) { return __builtin_amdgcn_mfma_f32_16x16x32_bf16(a, b, c, 0, 0, 0); }
__device__ __forceinline__ i32x4 mma16(bf16x8 a, bf16x8 b, i32x4 c) { return __builtin_amdgcn_mfma_i32_16x16x64_i8(__builtin_bit_cast(i32x4, a), __builtin_bit_cast(i32x4, b), c, 0, 0, 0); }
template <class Epi, class Sched, bool ALIGN_EPI = false, bool SP2 = false>
__device__ __forceinline__ void gemm_phase(PG8_LAS unsigned char* lds, const Gemm g, const Sched& S, const Epi& E) {
    constexpr bool I8 = Epi::I8;
    typedef typename AccT<I8>::type acc_t;
    const int tid = threadIdx.x, wid = __builtin_amdgcn_readfirstlane(tid >> 6), lane = tid & 63, wr = wid >> 2, wc = wid & 3, fr = lane & 15, fq = lane >> 4;
    const int K = g.K, nt = K / BK;
    unsigned voffA[2], voffB[2];
#pragma unroll
    for (int i = 0; i < 2; ++i) { int R, C; stage_rc(tid * 16 + i * 8192, R, C); const int Rb = Epi::PERM ? ((R & ~31) + perm32(R & 31)) : R;
        voffA[i] = (unsigned)(R * K + C) * 2u; voffB[i] = (unsigned)(Rb * K + C) * 2u; }
    const size_t kstep = (size_t)(BK * 2);
    const size_t hstep = (size_t)HALF * K * 2;
    const size_t tstep = 2 * hstep;
    const unsigned ldsw = (unsigned)wid * 1024u;
    const int aoff = lds_byte(wr * 64 + fr, fq * 8), boff = lds_byte(wc * 32 + fr, fq * 8);
#define PG8_SA(b, h) (((b) * 2 + (h)) * HTB)
#define PG8_SB(b, h) ((4 + (b) * 2 + (h)) * HTB)
#define PG8_STAGE(bufoff, gbase, voff) do { _Pragma("unroll") for (int _i = 0; _i < 2; ++_i) \
        __builtin_amdgcn_global_load_lds((const unsigned*)((const char*)(gbase) + (voff)[_i]), (PG8_LAS unsigned*)(lds + (bufoff) + ldsw + _i * 8192), 16, 0, 0); } while (0)
#define PG8_LDA(dst, b, h) do { _Pragma("unroll") for (int m = 0; m < 4; ++m) _Pragma("unroll") for (int k = 0; k < 2; ++k) dst[m][k] = *(const PG8_LAS bf16x8*)(lds + PG8_SA(b, h) + aoff + m * 2048 + k * 1024); } while (0)
#define PG8_LDB(dst, b, h) do { _Pragma("unroll") for (int n = 0; n < 2; ++n) _Pragma("unroll") for (int k = 0; k < 2; ++k) dst[n][k] = *(const PG8_LAS bf16x8*)(lds + PG8_SB(b, h) + boff + n * 2048 + k * 1024); } while (0)
#define PG8_MMA(ai, bj, At, Bt) do { __builtin_amdgcn_s_setprio(1); _Pragma("unroll") for (int m = 0; m < 4; ++m) _Pragma("unroll") for (int n = 0; n < 2; ++n) _Pragma("unroll") for (int k = 0; k < 2; ++k) \
        acc[ai][bj][m][n] = mma16(Bt[n][k], At[m][k], acc[ai][bj][m][n]); __builtin_amdgcn_s_setprio(0); } while (0)
#define PG8_WAIT_V(n) asm volatile("s_waitcnt vmcnt(" #n ")" ::: "memory")
#define PG8_WAIT_L(n) asm volatile("s_waitcnt lgkmcnt(" #n ")" ::: "memory")
#define PG8_BAR __builtin_amdgcn_s_barrier()
#define PG8_SCHED __builtin_amdgcn_sched_barrier(0)
    Unit cur, nxt; int ui = 0;
    if (!S.next(0, cur)) return;
    acc_t acc[2][2][4][2];
#pragma unroll
    for (int a = 0; a < 2; ++a)
#pragma unroll
        for (int b = 0; b < 2; ++b)
#pragma unroll
            for (int m = 0; m < 4; ++m)
#pragma unroll
                for (int n = 0; n < 2; ++n) acc[a][b][m][n] = acc_t{};
    bf16x8 At[4][2], B0[2][2], B1[2][2];
    const char* cA = (const char*)g.A + (size_t)cur.pm * tstep; const char* cB = (const char*)g.Bt + (size_t)cur.pn * tstep;
    S.a_ready(cur);
    if constexpr (SP2) {
        PG8_STAGE(PG8_SB(0, 0), cB, voffB); PG8_STAGE(PG8_SB(0, 1), cB + hstep, voffB); PG8_STAGE(PG8_SA(0, 0), cA, voffA); PG8_STAGE(PG8_SA(0, 1), cA + hstep, voffA);
        if (wr == 1) PG8_BAR;
        PG8_WAIT_V(2); PG8_BAR;
        PG8_STAGE(PG8_SB(1, 0), cB + kstep, voffB); PG8_STAGE(PG8_SA(1, 0), cA + kstep, voffA); PG8_STAGE(PG8_SB(1, 1), cB + hstep + kstep, voffB);
        PG8_WAIT_V(6); PG8_BAR;
    } else {
        PG8_STAGE(PG8_SB(0, 0), cB, voffB); PG8_STAGE(PG8_SA(0, 0), cA, voffA); PG8_STAGE(PG8_SB(0, 1), cB + hstep, voffB); PG8_STAGE(PG8_SA(0, 1), cA + hstep, voffA);
        if (wr == 1) PG8_BAR;
        PG8_WAIT_V(4); PG8_BAR;
        PG8_STAGE(PG8_SB(1, 0), cB + kstep, voffB); PG8_STAGE(PG8_SA(1, 0), cA + kstep, voffA); PG8_STAGE(PG8_SB(1, 1), cB + hstep + kstep, voffB);
        PG8_WAIT_V(6); PG8_BAR;
    }
    for (;;) {
        const bool has_next = S.next(ui + 1, nxt);
        const char* nA = has_next ? (const char*)g.A + (size_t)nxt.pm * tstep : cA; const char* nB = has_next ? (const char*)g.Bt + (size_t)nxt.pn * tstep : cB;
        for (int t = 0; t < nt; t += 2) {
            const bool last = (t == nt - 2);
            const char* a1 = cA + (size_t)(t + 1) * kstep;
            const char* a2 = last ? nA : cA + (size_t)(t + 2) * kstep; const char* b2 = last ? nB : cB + (size_t)(t + 2) * kstep;
            const char* a3 = a2 + kstep; const char* b3 = b2 + kstep;
            if (last && has_next) S.a_ready(nxt);
            if constexpr (SP2) {
            PG8_LDB(B0, 0, 0); PG8_LDB(B1, 0, 1); PG8_SCHED; PG8_LDA(At, 0, 0); PG8_STAGE(PG8_SA(1, 1), a1 + hstep, voffA);
            PG8_WAIT_V(8); PG8_WAIT_L(0); PG8_BAR; PG8_MMA(0, 0, At, B0); PG8_MMA(0, 1, At, B1); PG8_BAR; PG8_SCHED;
            PG8_LDA(At, 0, 1); PG8_STAGE(PG8_SB(0, 0), b2, voffB); PG8_STAGE(PG8_SB(0, 1), b2 + hstep, voffB); PG8_STAGE(PG8_SA(0, 0), a2, voffA);
            PG8_WAIT_V(8); PG8_WAIT_L(0); PG8_BAR; PG8_MMA(1, 0, At, B0); PG8_MMA(1, 1, At, B1); PG8_BAR; PG8_SCHED;
            PG8_LDB(B0, 1, 0); PG8_LDB(B1, 1, 1); PG8_SCHED; PG8_LDA(At, 1, 0); PG8_STAGE(PG8_SA(0, 1), a2 + hstep, voffA);
            PG8_WAIT_V(8); PG8_WAIT_L(0); PG8_BAR; PG8_MMA(0, 0, At, B0); PG8_MMA(0, 1, At, B1); PG8_BAR; PG8_SCHED;
            PG8_LDA(At, 1, 1); PG8_STAGE(PG8_SB(1, 0), b3, voffB); PG8_STAGE(PG8_SB(1, 1), b3 + hstep, voffB); PG8_STAGE(PG8_SA(1, 0), a3, voffA);
            PG8_WAIT_V(8); PG8_WAIT_L(0); PG8_BAR; PG8_MMA(1, 0, At, B0); PG8_MMA(1, 1, At, B1); PG8_BAR; PG8_SCHED;
            } else {
            PG8_LDB(B0, 0, 0); PG8_SCHED; PG8_LDA(At, 0, 0); PG8_STAGE(PG8_SA(1, 1), a1 + hstep, voffA);
            PG8_WAIT_L(8); PG8_BAR; PG8_WAIT_L(0); PG8_MMA(0, 0, At, B0); PG8_BAR; PG8_SCHED;
            PG8_LDB(B1, 0, 1); PG8_STAGE(PG8_SB(0, 0), b2, voffB);
            PG8_BAR; PG8_WAIT_L(0); PG8_MMA(0, 1, At, B1); PG8_BAR;
            PG8_LDA(At, 0, 1); PG8_STAGE(PG8_SA(0, 0), a2, voffA);
            PG8_BAR; PG8_WAIT_L(0); PG8_MMA(1, 0, At, B0); PG8_BAR; PG8_SCHED;
            PG8_STAGE(PG8_SB(0, 1), b2 + hstep, voffB);
            PG8_WAIT_V(6); PG8_BAR; PG8_MMA(1, 1, At, B1); PG8_BAR;
            PG8_LDB(B0, 1, 0); PG8_SCHED; PG8_LDA(At, 1, 0); PG8_STAGE(PG8_SA(0, 1), a2 + hstep, voffA);
            PG8_WAIT_L(8); PG8_BAR; PG8_WAIT_L(0); PG8_MMA(0, 0, At, B0); PG8_BAR; PG8_SCHED;
            PG8_LDB(B1, 1, 1); PG8_STAGE(PG8_SB(1, 0), b3, voffB);
            PG8_BAR; PG8_WAIT_L(0); PG8_MMA(0, 1, At, B1); PG8_BAR;
            PG8_LDA(At, 1, 1); PG8_STAGE(PG8_SA(1, 0), a3, voffA);
            PG8_BAR; PG8_WAIT_L(0); PG8_MMA(1, 0, At, B0); PG8_BAR; PG8_SCHED;
            PG8_STAGE(PG8_SB(1, 1), b3 + hstep, voffB);
            PG8_WAIT_V(6); PG8_BAR; PG8_MMA(1, 1, At, B1); PG8_BAR;
            }
        }
        if constexpr (ALIGN_EPI) { if (wr == 0) PG8_BAR; }
        if constexpr (!Epi::AFTER_DRAIN) { E(acc, cur, wr, wc, fr, fq); S.done(cur); }
        if (!has_next) break;
#pragma unroll
        for (int a = 0; a < 2; ++a)
#pragma unroll
            for (int b = 0; b < 2; ++b)
#pragma unroll
                for (int m = 0; m < 4; ++m)
#pragma unroll
                    for (int n = 0; n < 2; ++n) acc[a][b][m][n] = acc_t{};
        cur = nxt; cA = nA; cB = nB; ++ui;
        if constexpr (ALIGN_EPI) { if (wr == 1) PG8_BAR; }
    }
    PG8_WAIT_V(0);
    if constexpr (!ALIGN_EPI) { if (wr == 0) PG8_BAR; }
    PG8_BAR;
    if constexpr (Epi::AFTER_DRAIN) { E.fused(acc, cur, wr, wc, fr, fq, lds, wid, lane); S.done(cur); }
#undef PG8_SA
#undef PG8_SB
#undef PG8_STAGE
#undef PG8_LDA
#undef PG8_LDB
#undef PG8_MMA
#undef PG8_WAIT_V
#undef PG8_WAIT_L
#undef PG8_BAR
#undef PG8_SCHED
}
}
#ifndef PG8_SP2
#define PG8_SP2 true
#endif
#ifndef PG8_ALIGN
#define PG8_ALIGN true
#endif
constexpr int NWAVES = 8;
constexpr int NB = 2, NS = 4096, DM = 4096, MR = NB * NS;
constexpr int NHQ = 48, NHA = 24, HD = 128, QKVC = 3 * NHQ * HD;
constexpr int DFF = 14336, F2 = 2 * DFF;
constexpr float ATT_SCALE = 0.08838834764831845f;
constexpr float NORM_EPS = 1e-5f;
constexpr size_t MiB = 1u << 20;
constexpr size_t WS_CTL = 0, CTL_ZERO_BYTES = 2 * MiB;
constexpr size_t WS_SSQ = 256 * 1024, SSQ_SITE = 32 * 1024;
constexpr size_t WS_VSQ = 512 * 1024;
constexpr size_t WS_AMAX = 1 * MiB;
constexpr int AM_WIN = 0, AM_WOUT = 18432, AM_SGWIN = 22528, AM_WUP = 30720, AM_END = 30720 + 2 * 28672;
constexpr size_t WS_SW = 3 * MiB;
constexpr size_t WS_SAH = 4 * MiB;
constexpr size_t WS_ROPE = 2 * MiB;
constexpr size_t WS_KMEAN = 576 * 1024;
constexpr size_t WS_SS = 3 * MiB, SS_SITE = 2 * MiB;
constexpr size_t WS_VS = 13 * MiB;
constexpr size_t WS_SEL = 18 * MiB;
constexpr size_t WS_LSE = 20 * MiB;
constexpr size_t WS_WIN = 32 * MiB;
constexpr size_t WS_WOUT = 176 * MiB;
constexpr size_t WS_SGWIN = 208 * MiB;
constexpr size_t WS_SGWOUT = 272 * MiB;
constexpr size_t WS_WUP = 304 * MiB, WUP_L = 224 * MiB;
constexpr size_t WS_WDOWN = 752 * MiB, WDOWN_L = 112 * MiB;
constexpr size_t WS_XB = 976 * MiB;
constexpr size_t WS_H = 1040 * MiB;
constexpr size_t WS_QKV = 1168 * MiB;
constexpr size_t WS_U = WS_QKV, WS_V = WS_QKV + 64 * MiB;
constexpr size_t WS_O = 1456 * MiB;
constexpr size_t WS_G = 1520 * MiB;
constexpr size_t WS_DO = WS_G;
constexpr size_t WS_APRE = 1744 * MiB;
constexpr size_t WS_TOP = WS_APRE + 128 * MiB, WS_BOT = WS_APRE + 136 * MiB;
constexpr size_t WS_WUP8 = 2192 * MiB, WUP8_L = 112 * MiB;
constexpr size_t WS_HQ8 = 2416 * MiB;
constexpr size_t WS_WIN8 = 2448 * MiB;
constexpr size_t WS_END = 2520 * MiB;
constexpr int RING_OFF = 0, RING_BYTES = 131072;
constexpr int SCR_BYTES = 133120;
constexpr int LDSCTL_OFF = SCR_BYTES, MISC_OFF = LDSCTL_OFF + 320;
constexpr int XTRA_OFF = SCR_BYTES + 1024;
constexpr int LDS_BYTES = 147456;
static_assert(MISC_OFF + 128 <= XTRA_OFF, "LDS map");
constexpr int CW_TMO = 0, CW_BAR = 4096;

#define GAS __attribute__((address_space(1)))
#define LAS __attribute__((address_space(3)))
typedef unsigned short bf16;
typedef unsigned v4u __attribute__((ext_vector_type(4)));
typedef unsigned v2u __attribute__((ext_vector_type(2)));
typedef float f32x4 __attribute__((ext_vector_type(4)));
typedef float f32x2 __attribute__((ext_vector_type(2)));
#define LDS_WAIT() asm volatile("s_waitcnt lgkmcnt(0)" ::: "memory")
#define VM_WAIT() asm volatile("s_waitcnt vmcnt(0)" ::: "memory")
__device__ __forceinline__ unsigned f2bf(float f) { unsigned u = __builtin_bit_cast(unsigned, f); return (u + 0x7fffu + ((u >> 16) & 1u)) >> 16; }
__device__ __forceinline__ unsigned pk2(float lo, float hi) { return f2bf(lo) | (f2bf(hi) << 16); }
__device__ __forceinline__ float bflo(unsigned w) { return __builtin_bit_cast(float, w << 16); }
__device__ __forceinline__ float bfhi(unsigned w) { return __builtin_bit_cast(float, w & 0xffff0000u); }
__device__ __forceinline__ float bf1(bf16 h) { return __builtin_bit_cast(float, (unsigned)h << 16); }
namespace att {
typedef unsigned short bf16;
typedef short bf16x8 __attribute__((ext_vector_type(8)));
typedef short s16x4 __attribute__((ext_vector_type(4)));
typedef float f32x16 __attribute__((ext_vector_type(16)));
typedef float f32x4 __attribute__((ext_vector_type(4)));
typedef unsigned u32x4 __attribute__((ext_vector_type(4)));
template <class A, class Bt> struct same_t { static constexpr bool v = false; };
template <class A> struct same_t<A, A> { static constexpr bool v = true; };
constexpr int D = 128;
constexpr float SCALE = 0.08838834764831845f, THR = 8.f;
constexpr int NW = 8, QBLK = 32, KVBLK = 64, QB = NW * QBLK;
constexpr int SHM_V = KVBLK * D * 2, SHM_K = KVBLK * D * 2;
constexpr int ATT_LDS_BYTES = 2 * SHM_V + 2 * SHM_K + NW * 64 * 4;
#define KSWZ(row, colB) ((row) * 256 + ((colB) ^ (((row) & 7) << 4)))
#define SBAR() __builtin_amdgcn_sched_barrier(0)
__device__ __forceinline__ int v_st(int k, int c) { const int kk = (k & ~0xC) | ((k & 4) << 1) | ((k & 8) >> 1); return ((kk >> 3) * 4 + (c >> 5)) * 512 + ((kk & 7) * 32 + (c & 31)) * 2; }
__device__ __forceinline__ int v_rd_base(int lane) { return ((lane & 3) << 3) | (((lane >> 2) & 3) << 6) | (((lane >> 4) & 1) << 5) | (((lane >> 5) & 1) << 8); }
constexpr int v_rd_off(int d0, int ks, int half) { return d0 * 512 + ks * 4096 + half * 2048; }
__device__ __forceinline__ int crow(int r, int hi) { return (r & 3) + 8 * (r >> 2) + 4 * hi; }
__device__ __forceinline__ unsigned cvtpk(float lo, float hi) {
    unsigned r; asm volatile("v_cvt_pk_bf16_f32 %0, %1, %2" : "=v"(r) : "v"(lo), "v"(hi)); return r;
}
__device__ __forceinline__ bf16x8 pack8(f32x4 a, f32x4 b) {
    u32x4 w = {cvtpk(a[0], a[1]), cvtpk(a[2], a[3]), cvtpk(b[0], b[1]), cvtpk(b[2], b[3])};
    return *reinterpret_cast<bf16x8*>(&w);
}
template <class T> __device__ __forceinline__ bf16x8 load8(const T* p) {
    if constexpr (same_t<T, float>::v) { return pack8(*(const f32x4*)p, *(const f32x4*)(p + 4)); }
    else { return *reinterpret_cast<const bf16x8*>(p); }
}
__device__ __forceinline__ void mask_tile(f32x16& p0, f32x16& p1, int dq, unsigned W) {
    const float NEG = -__builtin_inff();
#pragma unroll
    for (int r = 0; r < 16; ++r) {
        const int c = (r & 3) + 8 * (r >> 2);
        if ((unsigned)(dq - c) >= W) p0[r] = NEG;
        if ((unsigned)(dq - c - 32) >= W) p1[r] = NEG;
    }
}
__device__ __forceinline__ void partialSM(f32x16& p0, f32x16& p1, float& m_reg, float& mn, float& alpha) {
    float pmax = p0[0]; for (int r = 1; r < 16; ++r) pmax = fmaxf(pmax, p0[r]); for (int r = 0; r < 16; ++r) pmax = fmaxf(pmax, p1[r]);
    { auto rr = __builtin_amdgcn_permlane32_swap(__float_as_uint(pmax), __float_as_uint(pmax), false, false);
      pmax = fmaxf(__uint_as_float(rr[0]), __uint_as_float(rr[1])); }
    constexpr float C2 = 1.4426950408889634f * SCALE;
    if (__builtin_expect(__all((pmax - m_reg) * SCALE <= THR), 1)) { mn = m_reg; alpha = 1.f; }
    else { mn = fmaxf(m_reg, pmax); alpha = __builtin_amdgcn_exp2f((m_reg - mn) * C2); m_reg = mn; }
    const float mnL = -mn * C2;
    for (int r = 0; r < 16; ++r) p0[r] = fmaf(p0[r], C2, mnL); for (int r = 0; r < 16; ++r) p1[r] = fmaf(p1[r], C2, mnL);
    for (int r = 0; r < 16; ++r) p0[r] = __builtin_amdgcn_exp2f(p0[r]);
}
__device__ __forceinline__ void finishSM(f32x16& p0, f32x16& p1, float alpha, float& l_reg, bf16x8& pa0, bf16x8& pa1, bf16x8& pa2, bf16x8& pa3) {
    for (int r = 0; r < 16; ++r) p1[r] = __builtin_amdgcn_exp2f(p1[r]);
    float ps = 0; for (int r = 0; r < 16; ++r) ps += p0[r]; for (int r = 0; r < 16; ++r) ps += p1[r];
    { auto rr = __builtin_amdgcn_permlane32_swap(__float_as_uint(ps), __float_as_uint(ps), false, false);
      ps = __uint_as_float(rr[0]) + __uint_as_float(rr[1]); }
    l_reg = l_reg * alpha + ps;
#define PK4(P, B_, OUT) do { unsigned a0 = cvtpk(P[B_+0], P[B_+1]), a1 = cvtpk(P[B_+2], P[B_+3]);                          \
        unsigned b0 = cvtpk(P[B_+4], P[B_+5]), b1 = cvtpk(P[B_+6], P[B_+7]);                                             \
        auto r0 = __builtin_amdgcn_permlane32_swap(a0, b0, false, false); auto r1 = __builtin_amdgcn_permlane32_swap(a1, b1, false, false); \
        u32x4 w = {r0[0], r1[0], r0[1], r1[1]}; OUT = *reinterpret_cast<bf16x8*>(&w); } while (0)
    PK4(p0, 0, pa0); PK4(p0, 8, pa1); PK4(p1, 0, pa2); PK4(p1, 8, pa3);
#undef PK4
}
template <int KB, bool SK>
__device__ __forceinline__ void qkt(f32x16& p0, f32x16& p1, const char* K_lds, int r32, int hi, const bf16x8* qr, bool act) {
    if (SK && !act) { const float NEG = -__builtin_inff();
#pragma unroll
        for (int r = 0; r < 16; ++r) { p0[r] = NEG; p1[r] = NEG; } return; }
    p0 = f32x16{}; p1 = f32x16{};
    const char* kb[4];
#pragma unroll
    for (int dd = 0; dd < 4; ++dd) kb[dd] = K_lds + KB * SHM_K + KSWZ(r32, (dd * 16 + hi * 8) * 2);
#pragma unroll
    for (int d0 = 0; d0 < 8; ++d0) { const char* a = kb[d0 & 3] + (d0 >> 2) * 128;
        bf16x8 b0 = *reinterpret_cast<const bf16x8*>(a);
        bf16x8 b1 = *reinterpret_cast<const bf16x8*>(a + 32 * 256);
        p0 = __builtin_amdgcn_mfma_f32_32x32x16_bf16(b0, qr[d0], p0, 0, 0, 0);
        p1 = __builtin_amdgcn_mfma_f32_32x32x16_bf16(b1, qr[d0], p1, 0, 0, 0); }
}
template <int VB, bool SK>
__device__ __forceinline__ void pv_tile(f32x16* o, int vb0, bf16x8 pa0, bf16x8 pa1, bf16x8 pa2, bf16x8 pa3, bool act) {
    if (SK && !act) return;
#define TRRD(dst, off) asm volatile("ds_read_b64_tr_b16 %0, %1 offset:%2" : "=&v"(dst) : "v"(vb0), "i"(off) : "memory")
#define PV_D0(d0) do { s16x4 l0, l1, l2, l3, h0, h1, h2, h3; constexpr int b_ = VB * SHM_V + v_rd_off(d0, 0, 0);     \
        TRRD(l0, b_); TRRD(h0, b_ + 2048); TRRD(l1, b_ + 4096); TRRD(h1, b_ + 6144); TRRD(l2, b_ + 8192); TRRD(h2, b_ + 10240); TRRD(l3, b_ + 12288); TRRD(h3, b_ + 14336); \
        asm volatile("s_waitcnt lgkmcnt(0)" ::: "memory"); SBAR();                 \
        o[d0] = __builtin_amdgcn_mfma_f32_32x32x16_bf16(pa0, (bf16x8){l0[0], l0[1], l0[2], l0[3], h0[0], h0[1], h0[2], h0[3]}, o[d0], 0, 0, 0);   \
        o[d0] = __builtin_amdgcn_mfma_f32_32x32x16_bf16(pa1, (bf16x8){l1[0], l1[1], l1[2], l1[3], h1[0], h1[1], h1[2], h1[3]}, o[d0], 0, 0, 0);   \
        o[d0] = __builtin_amdgcn_mfma_f32_32x32x16_bf16(pa2, (bf16x8){l2[0], l2[1], l2[2], l2[3], h2[0], h2[1], h2[2], h2[3]}, o[d0], 0, 0, 0);   \
        o[d0] = __builtin_amdgcn_mfma_f32_32x32x16_bf16(pa3, (bf16x8){l3[0], l3[1], l3[2], l3[3], h3[0], h3[1], h3[2], h3[3]}, o[d0], 0, 0, 0); } while (0)
    PV_D0(0); PV_D0(1); PV_D0(2); PV_D0(3);
#undef PV_D0
#undef TRRD
}

template <class TIn, class TOut> struct BlockRef { const TIn* Q; const TIn* K; const TIn* V; TOut* O; int P0; const __attribute__((address_space(3))) unsigned short* sel; float* L; };
template <class TIn> struct Seam {
    bf16x8 qr[8];
    bf16x8 st_v0, st_v1, st_k0, st_k1; f32x4 sf0, sf1, sf2, sf3;
    f32x4 tq[16];
};
__device__ __forceinline__ int swa_jlo(int P0, int W) { const int lowk = P0 - W + 1; return lowk > 0 ? lowk / KVBLK : 0; }
#define ROW(p, k0, rr) ((p) + (size_t)((k0) + (rr)) * rs_ + sc)
#define ROWN(p, k0, rr) ((p) + (size_t)((k0) + (rr)) * rsn_ + sc)
#define VMW() asm volatile("s_waitcnt vmcnt(0)" ::: "memory")
#define VMWN(n) asm volatile("s_waitcnt vmcnt(%0)" :: "i"(n) : "memory")
#define SLOAD_H(Kp, Vp, k0) do { S.st_v0 = load8<TIn>(ROW(Vp, k0, sr)); S.st_v1 = load8<TIn>(ROW(Vp, k0, 32 + sr));              \
                         S.st_k0 = load8<TIn>(ROW(Kp, k0, sr)); S.st_k1 = load8<TIn>(ROW(Kp, k0, 32 + sr)); } while (0)
#define SLOAD_HN(Kp, Vp, k0) do { S.st_v0 = load8<TIn>(ROWN(Vp, k0, sr)); S.st_v1 = load8<TIn>(ROWN(Vp, k0, 32 + sr));              \
                         S.st_k0 = load8<TIn>(ROWN(Kp, k0, sr)); S.st_k1 = load8<TIn>(ROWN(Kp, k0, 32 + sr)); } while (0)
#define SWRITE_HK(bf) do { *(bf16x8*)(K_lds + (bf) * SHM_K + kws) = S.st_k0; *(bf16x8*)(K_lds + (bf) * SHM_K + kws + 32 * 256) = S.st_k1; } while (0)
#define SWRITE_HV(bf) do { *(bf16x8*)(V_lds + (bf) * SHM_V + vst0) = S.st_v0; *(bf16x8*)(V_lds + (bf) * SHM_V + vst1) = S.st_v1; } while (0)
#define SWRITE_H(bf) do { SWRITE_HV(bf); SWRITE_HK(bf); } while (0)
#define SLOAD_F(p, k0) do { S.sf0 = *(const f32x4*)ROW(p, k0, sr); S.sf1 = *(const f32x4*)(ROW(p, k0, sr) + 4);                \
                            S.sf2 = *(const f32x4*)ROW(p, k0, 32 + sr); S.sf3 = *(const f32x4*)(ROW(p, k0, 32 + sr) + 4); } while (0)
#define SWRITE_KF(bf) do { *(bf16x8*)(K_lds + (bf) * SHM_K + kws) = pack8(S.sf0, S.sf1); *(bf16x8*)(K_lds + (bf) * SHM_K + kws + 32 * 256) = pack8(S.sf2, S.sf3); } while (0)
#define SWRITE_VF(bf) do { *(bf16x8*)(V_lds + (bf) * SHM_V + vst0) = pack8(S.sf0, S.sf1); *(bf16x8*)(V_lds + (bf) * SHM_V + vst1) = pack8(S.sf2, S.sf3); } while (0)
template <class TIn, class TOut, int RSC, int W>
__device__ __forceinline__ void causal_swa_prime(const BlockRef<TIn, TOut>& cur, char* lds, Seam<TIn>& S) {
    constexpr bool F32 = same_t<TIn, float>::v;
    int tid_ = threadIdx.x; asm volatile("" : "+v"(tid_));
    const int tid = tid_, wid = __builtin_amdgcn_readfirstlane(tid >> 6), lane = tid & 63, r32 = lane & 31, hi = lane >> 5;
    const int sr = tid >> 4, sc = (tid & 15) * 8, kws = KSWZ(sr, sc * 2); char* K_lds = lds + 2 * SHM_V;
    const int kb0 = swa_jlo(cur.P0, W) * KVBLK; constexpr int rs_ = RSC;
    for (int d0 = 0; d0 < 8; ++d0) S.qr[d0] = load8<TIn>(cur.Q + (size_t)(wid * QBLK + r32) * rs_ + d0 * 16 + hi * 8);
    if constexpr (F32) { SLOAD_F((const float*)cur.K, kb0); VMW(); SWRITE_KF(0); SBAR(); SLOAD_F((const float*)cur.V, kb0); }
    else { SLOAD_H(cur.K, cur.V, kb0); VMW(); SWRITE_HK(0); }
    __syncthreads();
}
template <class TIn, class TOut, bool SKP, int MODE, int RSC, int RSN, int OSC, int W, int WN, int skv>
__device__ __forceinline__ void causal_swa_block(const BlockRef<TIn, TOut>& cur, const BlockRef<TIn, TOut>& nxt, char* lds, Seam<TIn>& S) {
    constexpr bool F32 = same_t<TIn, float>::v; static_assert(!F32, "bf16 inputs only in this build");
    constexpr int rs_ = RSC, rsn_ = RSN, os_ = OSC;
    int tid_ = threadIdx.x; asm volatile("" : "+v"(tid_));
    const int tid = tid_, wid = __builtin_amdgcn_readfirstlane(tid >> 6), lane = tid & 63, r32 = lane & 31, hi = lane >> 5;
    const int j_lo = swa_jlo(cur.P0, W);
    int j_hi = (cur.P0 + QB - 1) / KVBLK + 1; if (j_hi > skv / KVBLK) j_hi = skv / KVBLK;
    const int NT = j_hi - j_lo;
    const int kbn = swa_jlo(nxt.P0, WN) * KVBLK;
    const int qlo = cur.P0 + wid * QBLK, qm = qlo + r32 - 4 * hi;
    char* V_lds = lds; char* K_lds = lds + 2 * SHM_V;
    float* ws = (float*)(lds + 2 * SHM_V + 2 * SHM_K) + wid * 64; float* li_l = ws, * al_l = ws + 32;
    float m_reg = -1e30f, l_reg = 0; f32x16 o[4] = {};
    unsigned selm = 0u; if constexpr (MODE == 0) selm = cur.sel[wid * QBLK + r32];
    const int sr = tid >> 4, sc = (tid & 15) * 8, vst0 = v_st(sr, sc), vst1 = v_st(32 + sr, sc), kws = KSWZ(sr, sc * 2);
    const int vb0 = (int)(uintptr_t)V_lds + v_rd_base(lane);
    const TIn* Kh = cur.K; const TIn* Vh = cur.V;
#define RESC(a) do { if (__any((a) < 1.f)) { if (hi == 0) al_l[r32] = (a); asm volatile("s_waitcnt lgkmcnt(0)" ::: "memory");              \
                     for (int d_ = 0; d_ < 4; ++d_) for (int r = 0; r < 16; ++r) o[d_][r] *= al_l[crow(r, hi)]; } } while (0)
#define KBASE(t) ((j_lo + (t)) * KVBLK)
#define ACT(t) (KBASE(t) <= qlo + QBLK - 1 && KBASE(t) + KVBLK - 1 >= qlo - W + 1)
#define MASKT(P0_, P1_, t) do { const int kb_ = KBASE(t); if ((!SK || ACT(t)) && (kb_ + KVBLK - 1 > qlo || kb_ <= qlo + QBLK - 1 - W)) mask_tile(P0_, P1_, qm - kb_, (unsigned)W); \
        if constexpr (MODE == 0) { if (kb_ < cur.P0) { const bool dead_ = ((selm >> (kb_ >> 8)) & 1u) == 0u; const float NEG_ = -__builtin_inff(); \
            _Pragma("unroll") for (int r_ = 0; r_ < 16; ++r_) { P0_[r_] = dead_ ? NEG_ : P0_[r_]; P1_[r_] = dead_ ? NEG_ : P1_[r_]; } } } } while (0)
    constexpr int NQL = F32 ? 16 : 8;
    constexpr bool SK = SKP && !F32;
#define SEAM_K0() do { VMWN(NQL); if constexpr (F32) { SWRITE_KF(0); SBAR(); SLOAD_F((const float*)nxt.V, kbn); } else { SWRITE_HK(0); } SBAR(); } while (0)
    f32x16 pA0, pA1, pB0, pB1; float mnA, mnB, alA, alB; bf16x8 pa0, pa1, pa2, pa3;
    if constexpr (F32) { VMW(); SWRITE_VF(0); SBAR(); } else { SWRITE_HV(0); SBAR(); }
    if (NT > 1) { if constexpr (F32) SLOAD_F((const float*)Kh, KBASE(1)); else SLOAD_H(Kh, Vh, KBASE(1)); }
    SBAR(); qkt<0, SK>(pA0, pA1, K_lds, r32, hi, S.qr, ACT(0));
    if constexpr (F32) { if (NT > 1) { VMW(); SWRITE_KF(1); SBAR(); SLOAD_F((const float*)Vh, KBASE(1)); } }
    MASKT(pA0, pA1, 0); partialSM(pA0, pA1, m_reg, mnA, alA);
    if (NT > 1) { VMW(); if constexpr (F32) { SWRITE_VF(1); SBAR(); if (NT > 2) SLOAD_F((const float*)Kh, KBASE(2)); } else SWRITE_H(1); }
    __syncthreads();
#define HALF_STEP(PX0, PX1, mnX, alX, PY0, PY1, alY, t, KB, VB, SB) do {                                                      \
        SBAR(); qkt<KB, SK>(PX0, PX1, K_lds, r32, hi, S.qr, ACT(t));                                             \
        finishSM(PY0, PY1, alY, l_reg, pa0, pa1, pa2, pa3); SBAR();                                                           \
        if ((t) + 1 < NT) { if constexpr (F32) { VMW(); SWRITE_KF(SB); SBAR(); SLOAD_F((const float*)Vh, KBASE((t) + 1)); }  \
                            else { SLOAD_H(Kh, Vh, KBASE((t) + 1)); } SBAR(); }                                               \
        pv_tile<VB, SK>(o, vb0, pa0, pa1, pa2, pa3, ACT((t) - 1)); MASKT(PX0, PX1, (t)); partialSM(PX0, PX1, m_reg, mnX, alX);                                        \
        __syncthreads();                                                                                                      \
        if ((t) + 1 < NT) { VMW(); if constexpr (F32) { SWRITE_VF(SB); SBAR(); if ((t) + 2 < NT) SLOAD_F((const float*)Kh, KBASE((t) + 2)); } \
                            else { SWRITE_H(SB); } }                                                                          \
        RESC(alX); __syncthreads(); } while (0)
    for (int t = 1; t + 1 < NT; t += 2) {
        HALF_STEP(pB0, pB1, mnB, alB, pA0, pA1, alA, t, 1, 0, 0);
        HALF_STEP(pA0, pA1, mnA, alA, pB0, pB1, alB, t + 1, 0, 1, 1);
    }
    const bool even = (NT & 1) == 0;
    if (even) { SBAR(); qkt<1, SK>(pB0, pB1, K_lds, r32, hi, S.qr, ACT(NT - 1)); SBAR(); }
#define QROW(e) (nxt.Q + (size_t)(wid * QBLK + r32) * rsn_ + ((e) >> 1) * 16 + hi * 8 + ((e) & 1) * 4)
    if constexpr (F32) { SLOAD_F((const float*)nxt.K, kbn); SBAR();
#pragma unroll
        for (int e = 0; e < 8; ++e) S.tq[e] = *(const f32x4*)QROW(e); }
    else { SLOAD_HN(nxt.K, nxt.V, kbn); SBAR();
#pragma unroll
        for (int d0 = 0; d0 < 8; ++d0) S.qr[d0] = load8<TIn>(nxt.Q + (size_t)(wid * QBLK + r32) * rsn_ + d0 * 16 + hi * 8); }
    SBAR();
    finishSM(pA0, pA1, alA, l_reg, pa0, pa1, pa2, pa3); SBAR();
    if constexpr (F32) {
#pragma unroll
        for (int e = 8; e < 16; ++e) S.tq[e] = *(const f32x4*)QROW(e); SBAR(); }
#undef QROW
    pv_tile<0, SK>(o, vb0, pa0, pa1, pa2, pa3, ACT(even ? NT - 2 : NT - 1));
    if (even) { MASKT(pB0, pB1, NT - 1); partialSM(pB0, pB1, m_reg, mnB, alB); __syncthreads(); RESC(alB);
        finishSM(pB0, pB1, alB, l_reg, pa0, pa1, pa2, pa3); SBAR(); pv_tile<1, SK>(o, vb0, pa0, pa1, pa2, pa3, ACT(NT - 1)); }
    SBAR(); SEAM_K0();
    if (hi == 0) li_l[r32] = l_reg; asm volatile("s_waitcnt lgkmcnt(0)" ::: "memory");
    if constexpr (MODE == 1) { if (hi == 0) cur.L[(size_t)(wid * QBLK + r32) * (RSC / 128 * 24)] = m_reg * SCALE + __logf(l_reg); }
    float rli[16];
#pragma unroll
    for (int r = 0; r < 16; ++r) rli[r] = __builtin_amdgcn_rcpf(li_l[crow(r, hi)]);
    TOut* Ow = cur.O + (size_t)(wid * QBLK) * os_;
#pragma unroll
    for (int r = 0; r < 16; ++r) { const int orow = crow(r, hi);
#pragma unroll
        for (int d0 = 0; d0 < 4; ++d0) { const float v = o[d0][r] * rli[r];
            if constexpr (same_t<TOut, float>::v) { Ow[(size_t)orow * os_ + d0 * 32 + r32] = v; }
            else { const float vn = __shfl_xor(v, 1);
                   if ((r32 & 1) == 0) *(unsigned*)(Ow + (size_t)orow * os_ + d0 * 32 + r32) = cvtpk(v, vn); } } }
    if constexpr (F32) {
#pragma unroll
        for (int d0 = 0; d0 < 8; ++d0) S.qr[d0] = pack8(S.tq[2 * d0], S.tq[2 * d0 + 1]); }
    __syncthreads();
#undef RESC
#undef KBASE
#undef ACT
#undef MASKT
#undef SEAM_K0
#undef HALF_STEP
}
#undef ROW
#undef ROWN
#undef SLOAD_HN
#undef VMW
#undef VMWN
#undef SLOAD_H
#undef SWRITE_HK
#undef SWRITE_HV
#undef SWRITE_H
#undef SLOAD_F
#undef SWRITE_KF
#undef SWRITE_VF
}
#define XB_TMO      128
#define XB_XCNT(j)  (256  + 64 * (j))
#define XB_XSUB(j)  (1280 + 64 * (j))
#define XB_XGEN(j)  (2304 + 64 * (j))
#define XB_TOP      3328
#define XB_TOPGEN   3392
#define XCD_BAR_WORDS 3456
#define XB_SPIN_CAP (1u << 18)

__device__ __forceinline__ unsigned xb_ld(unsigned* p)              { return __hip_atomic_load(p, __ATOMIC_RELAXED, __HIP_MEMORY_SCOPE_AGENT); }
__device__ __forceinline__ unsigned xb_add(unsigned* p, unsigned v) { return __hip_atomic_fetch_add(p, v, __ATOMIC_RELAXED, __HIP_MEMORY_SCOPE_AGENT); }
__device__ __forceinline__ unsigned xb_xcc_id() { return (unsigned)__builtin_amdgcn_s_getreg((3 << 11) | 20) & 0xFu; }
#define XB_SPIN(cond, bar) do { unsigned _sp = 0; while (cond) { __builtin_amdgcn_s_sleep(1); \
    if ((++_sp & 255u) == 0u) { if (xb_ld(&(bar)[XB_TMO])) break; if (_sp > XB_SPIN_CAP) { atomicAdd(&(bar)[XB_TMO], 1u); break; } } } } while (0)

struct XcdBarrier {
    unsigned* bar; unsigned x;
    volatile LAS unsigned* st;
};

__device__ __forceinline__ XcdBarrier xcd_barrier_post(unsigned* bar, volatile LAS unsigned* st) {
    XcdBarrier b; b.bar = bar; b.x = xb_xcc_id(); b.st = st;
    if (threadIdx.x == 0) (void)xb_add(&bar[XB_XCNT(b.x)], 1u);
    return b;
}
__device__ __forceinline__ void xcd_barrier_complete(unsigned* bar, unsigned x, unsigned& nloc, unsigned& nx) {
    const unsigned G = gridDim.x * gridDim.y * gridDim.z;
    unsigned sum, cnt, mine, sp = 0u;
    for (;;) {
        sum = 0u; cnt = 0u; mine = 0u;
#pragma unroll
        for (unsigned j = 0; j < 16; ++j) { const unsigned c = xb_ld(&bar[XB_XCNT(j)]); sum += c; cnt += (c > 0u) ? 1u : 0u; mine = (j == x) ? c : mine; }
        if (sum == G) break;
        __builtin_amdgcn_s_sleep(1);
        if ((++sp & 255u) == 0u) { if (xb_ld(&bar[XB_TMO])) break; if (sp > XB_SPIN_CAP) { atomicAdd(&bar[XB_TMO], 1u); break; } }
    }
    nloc = mine > 0u ? mine : 1u; nx = cnt > 0u ? cnt : 1u;
}

__device__ __forceinline__ void xcd_barrier(const XcdBarrier& b) {
    asm volatile("s_waitcnt vmcnt(0)" ::: "memory");
    __syncthreads();
    if (threadIdx.x == 0) {
        unsigned* bar = b.bar;
        __builtin_amdgcn_s_waitcnt(0);
        unsigned nloc = b.st[0], nx = b.st[1];
        if (nloc == 0u) { xcd_barrier_complete(bar, b.x, nloc, nx); b.st[0] = nloc; b.st[1] = nx; }
        const unsigned old = xb_add(&bar[XB_XSUB(b.x)], 1u);
        const unsigned gen = old / nloc;
        if (old + 1u == (gen + 1u) * nloc) {
            __builtin_amdgcn_fence(__ATOMIC_RELEASE, "agent");
            asm volatile("s_waitcnt vmcnt(0)" ::: "memory");
            const unsigned og = xb_add(&bar[XB_TOP], 1u);
            const unsigned tg = og / nx;
            if (og + 1u == (tg + 1u) * nx) xb_add(&bar[XB_TOPGEN], 1u);
            else XB_SPIN(xb_ld(&bar[XB_TOPGEN]) == tg, bar);
            __builtin_amdgcn_fence(__ATOMIC_ACQUIRE, "agent");
            xb_add(&bar[XB_XGEN(b.x)], 1u);
            asm volatile("s_waitcnt vmcnt(0)" ::: "memory");
        } else {
            XB_SPIN(xb_ld(&bar[XB_XGEN(b.x)]) == gen, bar);
            __builtin_amdgcn_fence(__ATOMIC_ACQUIRE, "agent");
            asm volatile("s_waitcnt vmcnt(0)" ::: "memory");
        }
    }
    __syncthreads();
}
struct Frame {
    LAS unsigned char* lds;
    volatile LAS unsigned* MISC;
    unsigned* ctl;
    int tid, lane, wave, G, gw, NGW;
    unsigned char* ws;
    const float* x; const int* pos;
    const float *attn_norm, *attn_w_in, *attn_w_out, *sg_norm, *sg_w_in, *sg_b_in, *sg_v_gain, *sg_v_bias, *sg_w_s, *sg_b_s, *sg_w_out, *ffn_norm, *ffn_w_up, *ffn_conv_w, *ffn_conv_b, *ffn_w_down, *final_norm;
    float* out;
};
__device__ __forceinline__ float wave_sum(float v) {
#pragma unroll
    for (int o = 1; o < 64; o <<= 1) v += __shfl_xor(v, o);
    return v;
}
__device__ __forceinline__ float wave_max(float v) {
#pragma unroll
    for (int o = 1; o < 64; o <<= 1) v = fmaxf(v, __shfl_xor(v, o));
    return v;
}
__device__ __forceinline__ float ss_rstd(const float* ss, int r) { return pg8::rstd_from_ss(ss, r); }

__device__ __forceinline__ unsigned q8(float x, float inv) { int q = (int)__builtin_rintf(x * inv); q = q > 127 ? 127 : (q < -127 ? -127 : q); return (unsigned)q & 0xffu; }
struct MapId { __device__ __forceinline__ int operator()(int n) const { return n; } };
struct MapUp { __device__ __forceinline__ int operator()(int n) const { return n < DFF ? ((n >> 7) << 8) + (n & 127) : (((n - DFF) >> 7) << 8) + 128 + ((n - DFF) & 127); } };
template <class RowMap>
__device__ __forceinline__ void transpose_item(const float* W, int K, int N, const float* gain, bf16* WT, RowMap rm, LAS float* scr, int item, int lane, unsigned* amax = nullptr) {
    const int nblk = N / 64, kb = item / nblk, nb = item - kb * nblk, k0 = 64 * kb, n0 = 64 * nb;
    const int lr = lane >> 4, lc = (lane & 15) * 4;
    f32x4 v[16];
#pragma unroll
    for (int i = 0; i < 16; ++i) v[i] = *(const f32x4*)(W + (size_t)(k0 + 4 * i + lr) * N + n0 + lc);
#pragma unroll
    for (int i = 0; i < 16; ++i) { const int kk = 4 * i + lr; f32x4 x = v[i]; if (gain) x = x * gain[k0 + kk]; LAS float* d = scr + kk * 65 + lc; d[0] = x[0]; d[1] = x[1]; d[2] = x[2]; d[3] = x[3]; }
    LDS_WAIT(); asm volatile("" ::: "memory");
    const int c = lane & 7;
#pragma unroll
    for (int j = 0; j < 8; ++j) { const int n = (lane >> 3) + 8 * j; const LAS float* s = scr + (8 * c) * 65 + n;
        v4u o; o.x = pk2(s[0 * 65], s[1 * 65]); o.y = pk2(s[2 * 65], s[3 * 65]); o.z = pk2(s[4 * 65], s[5 * 65]); o.w = pk2(s[6 * 65], s[7 * 65]);
        *(v4u*)(WT + (size_t)rm(n0 + n) * K + k0 + 8 * c) = o;
        if (amax) {
            float mx = fmaxf(fmaxf(fmaxf(fabsf(s[0 * 65]), fabsf(s[1 * 65])), fmaxf(fabsf(s[2 * 65]), fabsf(s[3 * 65]))), fmaxf(fmaxf(fabsf(s[4 * 65]), fabsf(s[5 * 65])), fmaxf(fabsf(s[6 * 65]), fabsf(s[7 * 65]))));
            mx = fmaxf(mx, __shfl_xor(mx, 1)); mx = fmaxf(mx, __shfl_xor(mx, 2)); mx = fmaxf(mx, __shfl_xor(mx, 4));
            if (c == 0) atomicMax(amax + rm(n0 + n), __builtin_bit_cast(unsigned, mx));
        } }
    LDS_WAIT(); asm volatile("" ::: "memory");
}
__device__ __forceinline__ void sincos_d(double a, double& sn, double& cs) {
    const double n = __builtin_rint(a * 0.15915494309189535);
    const double r = a - n * 6.283185307179586;
    const double r2 = r * r;
    double ts = r, tc = 1.0, s = r, c = 1.0;
#pragma unroll
    for (int k = 1; k <= 15; ++k) { tc = -tc * r2 / (double)((2 * k - 1) * (2 * k)); ts = -ts * r2 / (double)((2 * k) * (2 * k + 1)); c += tc; s += ts; }
    sn = s; cs = c;
}
__device__ __forceinline__ void p0_prologue(Frame& F) {
    LAS float* scr = (LAS float*)(F.lds + RING_OFF + F.wave * 16640);
    constexpr int I_WIN = 64 * (QKVC / 64), I_SQ = 64 * (DM / 64), I_SGIN = 64 * (2 * DM / 64), I_UP = 64 * (F2 / 64), I_DN = (DFF / 64) * (DM / 64);
    constexpr int NITEMS = I_WIN + 2 * I_SQ + I_SGIN + 2 * I_UP + 2 * I_DN;
    for (int it = F.gw; it < NITEMS; it += F.NGW) {
        int r = it;
        if (r < I_WIN) { transpose_item(F.attn_w_in, DM, QKVC, F.attn_norm, (bf16*)(F.ws + WS_WIN), MapId(), scr, r, F.lane, (unsigned*)(F.ws + WS_AMAX) + AM_WIN); continue; } r -= I_WIN;
        if (r < I_SQ) { transpose_item(F.attn_w_out, DM, DM, nullptr, (bf16*)(F.ws + WS_WOUT), MapId(), scr, r, F.lane); continue; } r -= I_SQ;
        if (r < I_SGIN) { transpose_item(F.sg_w_in, DM, 2 * DM, F.sg_norm, (bf16*)(F.ws + WS_SGWIN), MapId(), scr, r, F.lane); continue; } r -= I_SGIN;
        if (r < I_SQ) { transpose_item(F.sg_w_out, DM, DM, nullptr, (bf16*)(F.ws + WS_SGWOUT), MapId(), scr, r, F.lane); continue; } r -= I_SQ;
        if (r < I_UP) { transpose_item(F.ffn_w_up, DM, F2, F.ffn_norm, (bf16*)(F.ws + WS_WUP), MapUp(), scr, r, F.lane, (unsigned*)(F.ws + WS_AMAX) + AM_WUP); continue; } r -= I_UP;
        if (r < I_UP) { transpose_item(F.ffn_w_up + (size_t)DM * F2, DM, F2, F.ffn_norm + DM, (bf16*)(F.ws + WS_WUP + WUP_L), MapUp(), scr, r, F.lane, (unsigned*)(F.ws + WS_AMAX) + AM_WUP + F2); continue; } r -= I_UP;
        if (r < I_DN) { transpose_item(F.ffn_w_down, DFF, DM, nullptr, (bf16*)(F.ws + WS_WDOWN), MapId(), scr, r, F.lane); continue; } r -= I_DN;
        transpose_item(F.ffn_w_down + (size_t)DFF * DM, DFF, DM, nullptr, (bf16*)(F.ws + WS_WDOWN + WDOWN_L), MapId(), scr, r, F.lane);
    }
    { float* SS0 = (float*)(F.ws + WS_SSQ); signed char* XQ = (signed char*)(F.ws + WS_HQ8); float* SA = (float*)(F.ws + WS_SAH);
      for (int m = F.gw; m < MR; m += F.NGW) {
        const f32x4* xr = (const f32x4*)(F.x + (size_t)m * DM) + F.lane; unsigned* d = (unsigned*)(XQ + (size_t)m * DM) + F.lane;
        f32x4 v[16]; float sq = 0.f, am = 0.f;
#pragma unroll
        for (int j = 0; j < 16; ++j) { v[j] = xr[64 * j]; sq += (v[j][0] * v[j][0] + v[j][1] * v[j][1]) + (v[j][2] * v[j][2] + v[j][3] * v[j][3]);
            am = fmaxf(am, fmaxf(fmaxf(fabsf(v[j][0]), fabsf(v[j][1])), fmaxf(fabsf(v[j][2]), fabsf(v[j][3])))); }
        sq = wave_sum(sq); am = wave_max(am);
        const float inv = am > 0.f ? 127.0f / am : 0.f;
        if (F.lane == 0) { SS0[m] = sq; SA[m] = am * (1.0f / 127.0f); }
#pragma unroll
        for (int j = 0; j < 16; ++j) d[64 * j] = q8(v[j][0], inv) | (q8(v[j][1], inv) << 8) | (q8(v[j][2], inv) << 16) | (q8(v[j][3], inv) << 24);
      } }
    float* rc = (float*)(F.ws + WS_ROPE); float* rs = rc + MR * 16;
    for (int idx = F.gw * 64 + F.lane; idx < MR * 16; idx += F.NGW * 64) {
        const int r = idx >> 4, i = idx & 15;
        double invd = 1.0;
        for (int k = 0; k < i; ++k) invd *= 0.44036660267178046;
        const float inv = (float)invd;
        const float ang = (float)F.pos[r] * inv;
        double sn, cs; sincos_d((double)ang, sn, cs);
        rc[idx] = (float)cs; rs[idx] = (float)sn;
    }
}

__device__ __forceinline__ void p_kmean(Frame& F) {
    const bf16* QKV = (const bf16*)(F.ws + WS_QKV); float* KM = (float*)(F.ws + WS_KMEAN);
    LAS float* red = (LAS float*)(F.lds + RING_OFF);
    for (int item = blockIdx.x; item < NB * NHA * 16; item += F.G) {
        const int j = item & 15, bh = item >> 4, b = bh / NHA, h = bh - b * NHA;
        const bf16* kb = QKV + ((size_t)((1 * 2 + b) * NHQ + h) * NS + 256 * j) * HD;
        const int d = F.tid & 127, part = F.tid >> 7;
        float s = 0.f;
        for (int i = 0; i < 64; ++i) s += bf1(kb[(size_t)(part * 64 + i) * HD + d]);
        red[part * 128 + d] = s;
        __syncthreads();
        if (F.tid < 128) KM[(size_t)item * 128 + F.tid] = (red[F.tid] + red[128 + F.tid] + red[256 + F.tid] + red[384 + F.tid]) * (1.0f / 256.0f);
        __syncthreads();
    }
}

__device__ __forceinline__ float dot128(const LAS float* qs, const bf16* krow) {
    float s = 0.f;
#pragma unroll 4
    for (int c = 0; c < 16; ++c) {
        const v4u kv = *(const v4u*)(krow + 8 * c); const LAS float* q8 = qs + 8 * c;
        s += q8[0] * bflo(kv.x) + q8[1] * bfhi(kv.x) + q8[2] * bflo(kv.y) + q8[3] * bfhi(kv.y) + q8[4] * bflo(kv.z) + q8[5] * bfhi(kv.z) + q8[6] * bflo(kv.w) + q8[7] * bfhi(kv.w);
    }
    return s;
}
__device__ __forceinline__ void p_attn_naive(Frame& F, bf16* O) {
    const bf16* QKV = (const bf16*)(F.ws + WS_QKV); const float* KM = (const float*)(F.ws + WS_KMEAN);
    LAS float* qs = (LAS float*)(F.lds + RING_OFF + F.wave * 8192);
    LAS float* ps = qs + 128;
    const int lane = F.lane;
    constexpr int NMOBA = NB * NHA * NS, NDIL = NB * 8 * NS;
    const float NEG = -__builtin_inff();
    for (int task = F.gw; task < NMOBA + NDIL; task += F.NGW) {
        if (task < NMOBA) {
            const int b = task / (NHA * NS), rem = task - b * (NHA * NS), h = rem >> 12, t = rem & 4095;
            const bf16* qrow = QKV + ((size_t)((0 * 2 + b) * NHQ + h) * NS + t) * HD;
            const bf16* Kb = QKV + (size_t)((1 * 2 + b) * NHQ + h) * NS * HD;
            const bf16* Vb = QKV + (size_t)((2 * 2 + b) * NHQ + h) * NS * HD;
            { const unsigned w = *(const unsigned*)(qrow + 2 * lane); qs[2 * lane] = bflo(w); qs[2 * lane + 1] = bfhi(w); }
            LDS_WAIT(); asm volatile("" ::: "memory");
            const int qb = t >> 8, tin = t & 255;
            float g = NEG;
            if (lane < qb) { const float* km = KM + ((size_t)((b * NHA + h) * 16 + lane)) * 128; float s = 0.f; for (int d = 0; d < 128; ++d) s += qs[d] * km[d]; g = s; }
            unsigned selmask = 0u;
            if (qb <= 3) selmask = (1u << qb) - 1u;
            else {
#pragma unroll
                for (int rd = 0; rd < 3; ++rd) {
                    float best = g; int bi = lane;
#pragma unroll
                    for (int o = 1; o < 64; o <<= 1) { const float ob = __shfl_xor(best, o); const int oi = __shfl_xor(bi, o); if (ob > best || (ob == best && oi < bi)) { best = ob; bi = oi; } }
                    selmask |= 1u << bi; if (lane == bi) g = NEG;
                }
            }
            float sc[4][4]; int jsel[3];
            unsigned mk = selmask;
#pragma unroll
            for (int sl = 0; sl < 3; ++sl) {
                int j = -1; if (mk) { j = __builtin_ctz(mk); mk &= mk - 1u; }
                jsel[sl] = j;
#pragma unroll
                for (int c = 0; c < 4; ++c) sc[sl][c] = (j >= 0) ? ATT_SCALE * dot128(qs, Kb + (size_t)(256 * j + lane + 64 * c) * HD) : NEG;
            }
#pragma unroll
            for (int c = 0; c < 4; ++c) { const int i = lane + 64 * c; sc[3][c] = (i <= tin) ? ATT_SCALE * dot128(qs, Kb + (size_t)(256 * qb + i) * HD) : NEG; }
            float mx = NEG;
#pragma unroll
            for (int sl = 0; sl < 4; ++sl)
#pragma unroll
                for (int c = 0; c < 4; ++c) mx = fmaxf(mx, sc[sl][c]);
            mx = wave_max(mx);
            float sum = 0.f;
#pragma unroll
            for (int sl = 0; sl < 4; ++sl)
#pragma unroll
                for (int c = 0; c < 4; ++c) { sc[sl][c] = __expf(sc[sl][c] - mx); sum += sc[sl][c]; }
            sum = wave_sum(sum);
            const float inv = 1.0f / sum;
#pragma unroll
            for (int sl = 0; sl < 4; ++sl)
#pragma unroll
                for (int c = 0; c < 4; ++c) ps[sl * 256 + lane + 64 * c] = sc[sl][c] * inv;
            LDS_WAIT(); asm volatile("" ::: "memory");
            float o0 = 0.f, o1 = 0.f;
#pragma unroll
            for (int sl = 0; sl < 3; ++sl) {
                if (jsel[sl] >= 0) { const bf16* vb = Vb + (size_t)(256 * jsel[sl]) * HD + 2 * lane;
                    for (int i = 0; i < 256; ++i) { const float p = ps[sl * 256 + i]; const unsigned w = *(const unsigned*)(vb + (size_t)i * HD); o0 += p * bflo(w); o1 += p * bfhi(w); } }
            }
            { const bf16* vb = Vb + (size_t)(256 * qb) * HD + 2 * lane;
              for (int i = 0; i <= tin; ++i) { const float p = ps[3 * 256 + i]; const unsigned w = *(const unsigned*)(vb + (size_t)i * HD); o0 += p * bflo(w); o1 += p * bfhi(w); } }
            *(unsigned*)(O + (size_t)(b * NS + t) * DM + h * HD + 2 * lane) = pk2(o0, o1);
            LDS_WAIT(); asm volatile("" ::: "memory");
        } else {
            const int td = task - NMOBA, b = td / (8 * NS), rem = td - b * (8 * NS), hh = rem >> 12, t = rem & 4095;
            float lse[3], og0[3], og1[3];
#pragma unroll
            for (int g = 0; g < 3; ++g) {
                const int head = NHA + g * 8 + hh, dil = g == 0 ? 1 : (g == 1 ? 4 : 16);
                const bf16* qrow = QKV + ((size_t)((0 * 2 + b) * NHQ + head) * NS + t) * HD;
                const bf16* Kb = QKV + (size_t)((1 * 2 + b) * NHQ + head) * NS * HD;
                const bf16* Vb = QKV + (size_t)((2 * 2 + b) * NHQ + head) * NS * HD;
                { const unsigned w = *(const unsigned*)(qrow + 2 * lane); qs[2 * lane] = bflo(w); qs[2 * lane + 1] = bfhi(w); }
                LDS_WAIT(); asm volatile("" ::: "memory");
                float sc[3];
#pragma unroll
                for (int c = 0; c < 3; ++c) { const int m = lane + 64 * c; const int kp = t - m * dil; sc[c] = (m <= 128 && kp >= 0) ? ATT_SCALE * dot128(qs, Kb + (size_t)kp * HD) : NEG; }
                float mx = wave_max(fmaxf(fmaxf(sc[0], sc[1]), sc[2]));
                float e0 = __expf(sc[0] - mx), e1 = __expf(sc[1] - mx), e2 = __expf(sc[2] - mx);
                const float sum = wave_sum(e0 + e1 + e2), inv = 1.0f / sum;
                lse[g] = mx + __logf(sum);
                ps[lane] = e0 * inv; ps[lane + 64] = e1 * inv; if (lane == 0) ps[128] = e2 * inv;
                LDS_WAIT(); asm volatile("" ::: "memory");
                const int nb = t / dil, nk = (nb < 128 ? nb : 128) + 1;
                float o0 = 0.f, o1 = 0.f;
                for (int m = 0; m < nk; ++m) { const float p = ps[m]; const unsigned w = *(const unsigned*)(Vb + (size_t)(t - m * dil) * HD + 2 * lane); o0 += p * bflo(w); o1 += p * bfhi(w); }
                og0[g] = o0; og1[g] = o1;
                LDS_WAIT(); asm volatile("" ::: "memory");
            }
            const float ml = fmaxf(fmaxf(lse[0], lse[1]), lse[2]);
            const float w0 = __expf(lse[0] - ml), w1 = __expf(lse[1] - ml), w2 = __expf(lse[2] - ml), wi = 1.0f / (w0 + w1 + w2);
            const float r0 = (w0 * og0[0] + w1 * og0[1] + w2 * og0[2]) * wi, r1 = (w0 * og1[0] + w1 * og1[1] + w2 * og1[2]) * wi;
            *(unsigned*)(O + (size_t)(b * NS + t) * DM + (NHA + hh) * HD + 2 * lane) = pk2(r0, r1);
        }
    }
}

__device__ __forceinline__ float silu_f(float x) { return x / (1.0f + __expf(-x)); }
__device__ __forceinline__ void unpack8(const v4u w, float (&f)[8]) { f[0] = bflo(w.x); f[1] = bfhi(w.x); f[2] = bflo(w.y); f[3] = bfhi(w.y); f[4] = bflo(w.z); f[5] = bfhi(w.z); f[6] = bflo(w.w); f[7] = bfhi(w.w); }
__device__ __forceinline__ void p_conv(Frame& F, int layer) {
    const bf16* AP = (const bf16*)(F.ws + WS_APRE); bf16* Gb = (bf16*)(F.ws + WS_G);
    const float* cw = F.ffn_conv_w + (size_t)layer * 3 * F2; const float* cb = F.ffn_conv_b + (size_t)layer * F2;
    constexpr int C8 = DFF / 8;
    const size_t total = (size_t)MR * C8;
    for (size_t idx = (size_t)blockIdx.x * 512 + F.tid; idx < total; idx += (size_t)F.G * 512) {
        const int r = (int)(idx / C8), j0 = (int)(idx - (size_t)r * C8) * 8, s = r & 4095;
        float cg[8], cu[8];
#pragma unroll
        for (int e = 0; e < 8; ++e) { cg[e] = cb[j0 + e]; cu[e] = cb[DFF + j0 + e]; }
#pragma unroll
        for (int tp = 0; tp < 3; ++tp) {
            const int back = 2 - tp;
            if (s >= back) {
                float ag[8], au[8];
                unpack8(*(const v4u*)(AP + (size_t)(r - back) * F2 + j0), ag);
                unpack8(*(const v4u*)(AP + (size_t)(r - back) * F2 + DFF + j0), au);
#pragma unroll
                for (int e = 0; e < 8; ++e) { cg[e] += cw[(size_t)tp * F2 + j0 + e] * ag[e]; cu[e] += cw[(size_t)tp * F2 + DFF + j0 + e] * au[e]; }
            }
        }
        v4u o; o.x = pk2(silu_f(cg[0]) * cu[0], silu_f(cg[1]) * cu[1]); o.y = pk2(silu_f(cg[2]) * cu[2], silu_f(cg[3]) * cu[3]);
        o.z = pk2(silu_f(cg[4]) * cu[4], silu_f(cg[5]) * cu[5]); o.w = pk2(silu_f(cg[6]) * cu[6], silu_f(cg[7]) * cu[7]);
        *(v4u*)(Gb + (size_t)r * DFF + j0) = o;
    }
}

__device__ __forceinline__ void p_sgate_naive(Frame& F) {
    const bf16* U = (const bf16*)(F.ws + WS_U); const bf16* V = (const bf16*)(F.ws + WS_V); const float* VS = (const float*)(F.ws + WS_VSQ); bf16* GT = (bf16*)(F.ws + WS_O);
    LAS float* vn = (LAS float*)(F.lds + RING_OFF);
    LAS float* wsl = vn + 128 * 128;
    LAS float* rstat = (LAS float*)(F.lds + XTRA_OFF);
    for (int item = blockIdx.x; item < 64 * 32; item += F.G) {
        const int bc = item >> 5, g = item & 31, r0 = bc * 128;
        if (F.tid < 128) {
            const float s1 = VS[2 * (r0 + F.tid)], s2 = VS[2 * (r0 + F.tid) + 1];
            const float mean = s1 * (1.0f / 4096.0f), var = s2 * (1.0f / 4096.0f) - mean * mean;
            rstat[2 * F.tid] = mean; rstat[2 * F.tid + 1] = 1.0f / sqrtf(var + NORM_EPS);
        }
        __syncthreads();
        for (int idx = F.tid; idx < 128 * 128; idx += 512) {
            const int s = idx >> 7, d = idx & 127, col = g * 128 + d;
            const float v = bf1(V[(size_t)(r0 + s) * DM + col]);
            vn[idx] = (v - rstat[2 * s]) * rstat[2 * s + 1] * F.sg_v_gain[col] + F.sg_v_bias[col];
            wsl[idx] = F.sg_w_s[(size_t)g * 16384 + idx];
        }
        __syncthreads();
        for (int idx = F.tid; idx < 128 * 128; idx += 512) {
            const int t = idx >> 7, d = idx & 127;
            float a = 0.f;
            for (int s = 0; s <= t; ++s) a += wsl[t * 128 + s] * vn[s * 128 + d];
            const float f = a + F.sg_b_s[g * 128 + t];
            const size_t o = (size_t)(r0 + t) * DM + g * 128 + d;
            GT[o] = (bf16)f2bf(bf1(U[o]) * f);
        }
        __syncthreads();
    }
}

__device__ __forceinline__ void p_final(Frame& F) {
    const float* H = (const float*)(F.ws + WS_H); const float* SS4 = (const float*)(F.ws + WS_SSQ + 4 * SSQ_SITE);
#ifdef CHECK_ATTN
    const unsigned nbad = __hip_atomic_load(F.ctl + 8, __ATOMIC_RELAXED, __HIP_MEMORY_SCOPE_AGENT);
#endif
    for (int m = F.gw; m < MR; m += F.NGW) {
        float rs = ss_rstd(SS4, m);
#ifdef CHECK_ATTN
        if (nbad > CHECK_ATTN) rs = __builtin_nanf("");
#endif
        const f32x4* hr = (const f32x4*)(H + (size_t)m * DM) + F.lane; const f32x4* gr = (const f32x4*)F.final_norm + F.lane;
        f32x4* orow = (f32x4*)(F.out + (size_t)m * DM) + F.lane;
#pragma unroll 4
        for (int j = 0; j < 16; ++j) orow[64 * j] = hr[64 * j] * rs * gr[64 * j];
    }
}

__device__ __forceinline__ void quant_weight_rows(Frame& F, const bf16* src, signed char* dst, const unsigned* amax, float* scale, int N) {
    for (int n = F.gw; n < N; n += F.NGW) {
        const float am = __builtin_bit_cast(float, amax[n]), inv = am > 0.f ? 127.0f / am : 0.f;
        if (F.lane == 0) scale[n] = am * (1.0f / 127.0f);
        const v4u* s = (const v4u*)(src + (size_t)n * DM) + F.lane; v2u* d = (v2u*)(dst + (size_t)n * DM) + F.lane;
#pragma unroll
        for (int i = 0; i < 8; ++i) { float v[8]; unpack8(s[64 * i], v);
            v2u o; o.x = q8(v[0], inv) | (q8(v[1], inv) << 8) | (q8(v[2], inv) << 16) | (q8(v[3], inv) << 24); o.y = q8(v[4], inv) | (q8(v[5], inv) << 8) | (q8(v[6], inv) << 16) | (q8(v[7], inv) << 24);
            d[64 * i] = o; }
    }
}
__device__ __forceinline__ void quant_act_rows(Frame& F, const float* src, signed char* dst, float* scale) {
    for (int m = F.gw; m < MR; m += F.NGW) {
        const f32x4* s = (const f32x4*)(src + (size_t)m * DM) + F.lane; unsigned* d = (unsigned*)(dst + (size_t)m * DM) + F.lane;
        f32x4 v[16]; float am = 0.f;
#pragma unroll
        for (int j = 0; j < 16; ++j) { v[j] = s[64 * j]; am = fmaxf(am, fmaxf(fmaxf(fabsf(v[j][0]), fabsf(v[j][1])), fmaxf(fabsf(v[j][2]), fabsf(v[j][3])))); }
        am = wave_max(am);
        const float inv = am > 0.f ? 127.0f / am : 0.f;
        if (F.lane == 0) scale[m] = am * (1.0f / 127.0f);
#pragma unroll
        for (int j = 0; j < 16; ++j) d[64 * j] = q8(v[j][0], inv) | (q8(v[j][1], inv) << 8) | (q8(v[j][2], inv) << 16) | (q8(v[j][3], inv) << 24);
    }
}
__device__ __forceinline__ unsigned moba_select(const LAS float* km, const bf16* qrow, int qb) {
    const float NEG = -__builtin_inff();
    if (qb <= 3) return (1u << qb) - 1u;
    float g[16];
#pragma unroll
    for (int j = 0; j < 16; ++j) g[j] = 0.f;
#pragma unroll 1
    for (int c = 0; c < 16; ++c) {
        float q8[8]; unpack8(*(const v4u*)(qrow + 8 * c), q8);
#pragma unroll
        for (int j = 0; j < 16; ++j) {
            const f32x4 k0 = *(const LAS f32x4*)(km + j * 128 + 8 * c), k1 = *(const LAS f32x4*)(km + j * 128 + 8 * c + 4);
            g[j] += q8[0] * k0[0] + q8[1] * k0[1] + q8[2] * k0[2] + q8[3] * k0[3] + q8[4] * k1[0] + q8[5] * k1[1] + q8[6] * k1[2] + q8[7] * k1[3];
        }
    }
#pragma unroll
    for (int j = 0; j < 16; ++j) if (j >= qb) g[j] = NEG;
    unsigned sel = 0u;
#pragma unroll
    for (int rd = 0; rd < 3; ++rd) {
        float best = NEG; unsigned bi = 0u;
#pragma unroll
        for (int j = 0; j < 16; ++j) { const bool take = (((sel >> j) & 1u) == 0u) && (g[j] > best); best = take ? g[j] : best; bi = take ? (unsigned)j : bi; }
        sel |= 1u << bi;
    }
    return sel;
}

typedef att::BlockRef<bf16, bf16> ABR;
#ifndef DIL_SK
#define DIL_SK false
#endif
constexpr int ATT_SEL_OFF = 69632, ATT_KM_OFF = 73728;
__device__ __forceinline__ void moba_unit(int vc, int i, int& bh, int& qb) {
    const int grp = vc >> 4, a = vc & 15;
    const unsigned long long PB = 0x24310cbfed5a9687ull, PC = 0x6579b13024c8aedfull;
    qb = i == 0 ? a : (i == 1 ? (int)((PB >> (4 * a)) & 15ull) : (int)((PC >> (4 * a)) & 15ull));
    bh = 3 * grp + i;
}
__device__ __forceinline__ ABR moba_ref(const Frame& F, int vc, int i, const LAS unsigned short* selL) {
    int bh, qb; moba_unit(vc, i, bh, qb);
    const int b = bh / NHA, h = bh - NHA * b;
    const bf16* QKV = (const bf16*)(F.ws + WS_QKV);
    ABR r;
    r.Q = QKV + ((size_t)((0 * 2 + b) * NHQ + h) * NS + 256 * qb) * HD;
    r.K = QKV + (size_t)((1 * 2 + b) * NHQ + h) * NS * HD;
    r.V = QKV + (size_t)((2 * 2 + b) * NHQ + h) * NS * HD;
    r.O = (bf16*)(F.ws + WS_O) + (size_t)(b * NS + 256 * qb) * DM + h * HD;
    r.P0 = 256 * qb;
    r.sel = selL + 256 * i; r.L = nullptr;
    return r;
}
__device__ __forceinline__ ABR dil_ref(const Frame& F, int vc, int g) {
    const int bhh = vc >> 4, b = bhh >> 3, hh = bhh & 7, lo = vc & 15;
    const int dil = g == 0 ? 1 : (g == 1 ? 4 : 16);
    const int res = g == 0 ? 0 : (g == 1 ? (lo >> 2) : lo), blk = g == 0 ? lo : (g == 1 ? (lo & 3) : 0);
    const int head = NHA + 8 * g + hh, pos0 = res + dil * 256 * blk;
    const bf16* QKV = (const bf16*)(F.ws + WS_QKV);
    ABR r;
    r.Q = QKV + ((size_t)((0 * 2 + b) * NHQ + head) * NS + pos0) * HD;
    r.K = QKV + ((size_t)((1 * 2 + b) * NHQ + head) * NS + res) * HD;
    r.V = QKV + ((size_t)((2 * 2 + b) * NHQ + head) * NS + res) * HD;
    r.O = (bf16*)(F.ws + WS_DO) + (size_t)(b * NS + pos0) * 3072 + g * 1024 + hh * HD;
    r.P0 = 256 * blk;
    r.sel = nullptr; r.L = (float*)(F.ws + WS_LSE) + (size_t)(b * NS + pos0) * 24 + g * 8 + hh;
    return r;
}
__device__ __forceinline__ void p_attn(Frame& F, char* lds) {
    for (int vc = blockIdx.x; vc < 256; vc += F.G) {
#ifndef NO_MOBA
        {
            const bf16* QKVq = (const bf16*)(F.ws + WS_QKV); const float* KM = (const float*)(F.ws + WS_KMEAN);
            LAS float* kmL = (LAS float*)(F.lds + RING_OFF + ATT_KM_OFF); LAS unsigned short* selW = (LAS unsigned short*)(F.lds + RING_OFF + ATT_SEL_OFF);
            const LAS unsigned short* selL = selW;
#ifndef NO_GATEPRE
            for (int idx = F.tid; idx < 3 * 2048; idx += 512) { int bh, qb; moba_unit(vc, idx >> 11, bh, qb); kmL[idx] = KM[(size_t)bh * 2048 + (idx & 2047)]; }
            __syncthreads();
            for (int qi = F.tid; qi < 768; qi += 512) { int bh, qb; moba_unit(vc, qi >> 8, bh, qb); const int b = bh / NHA, h = bh - NHA * b;
                selW[qi] = (unsigned short)moba_select(kmL + (qi >> 8) * 2048, QKVq + ((size_t)((0 * 2 + b) * NHQ + h) * NS + 256 * qb + (qi & 255)) * HD, qb); }
            __syncthreads();
#endif
            asm volatile("" ::: "memory");
            int vcb = vc; asm volatile("" : "+s"(vcb));
            att::Seam<bf16> S;
            constexpr int WM = 1 << 30;
            ABR cur = moba_ref(F, vcb, 0, selL);
            att::causal_swa_prime<bf16, bf16, 128, WM>(cur, lds, S);
            for (int i = 0; i < 3; ++i) {
                const ABR nxt = moba_ref(F, vcb, i < 2 ? i + 1 : 2, selL);
                att::causal_swa_block<bf16, bf16, false, 0, 128, 128, DM, WM, WM, NS>(cur, nxt, lds, S);
                cur = nxt;
            }
        }
#endif
    }
    for (int vc = blockIdx.x; vc < 256; vc += F.G) {
#ifndef NO_DIL
        {
            att::Seam<bf16> S;
            const ABR r0 = dil_ref(F, vc, 0), r1 = dil_ref(F, vc, 1), r2 = dil_ref(F, vc, 2);
            att::causal_swa_prime<bf16, bf16, 128, 129>(r0, lds, S);
            att::causal_swa_block<bf16, bf16, DIL_SK, 1, 128, 512, 3072, 129, 129, NS>(r0, r1, lds, S);
            att::causal_swa_block<bf16, bf16, DIL_SK, 1, 512, 2048, 4 * 3072, 129, 129, NS / 4>(r1, r2, lds, S);
            att::causal_swa_block<bf16, bf16, DIL_SK, 1, 2048, 2048, 16 * 3072, 129, 129, NS / 16>(r2, r2, lds, S);
        }
#endif
    }
}
__device__ __forceinline__ void p_dilmerge(Frame& F) {
    const bf16* DO = (const bf16*)(F.ws + WS_DO); const float* LSE = (const float*)(F.ws + WS_LSE); bf16* O = (bf16*)(F.ws + WS_O);
    const size_t total = (size_t)MR * 8 * 16;
    for (size_t idx = (size_t)blockIdx.x * 512 + F.tid; idx < total; idx += (size_t)F.G * 512) {
        const int r = (int)(idx >> 7), hh = (int)(idx >> 4) & 7, c8 = (int)idx & 15;
        const float l0 = LSE[(size_t)r * 24 + hh], l1 = LSE[(size_t)r * 24 + 8 + hh], l2 = LSE[(size_t)r * 24 + 16 + hh];
        const float ml = fmaxf(fmaxf(l0, l1), l2);
        float w0 = __expf(l0 - ml), w1 = __expf(l1 - ml), w2 = __expf(l2 - ml); const float wi = 1.0f / (w0 + w1 + w2); w0 *= wi; w1 *= wi; w2 *= wi;
        float a0[8], a1[8], a2[8];
        unpack8(*(const v4u*)(DO + (size_t)r * 3072 + hh * HD + c8 * 8), a0);
        unpack8(*(const v4u*)(DO + (size_t)r * 3072 + 1024 + hh * HD + c8 * 8), a1);
        unpack8(*(const v4u*)(DO + (size_t)r * 3072 + 2048 + hh * HD + c8 * 8), a2);
        float o[8];
#pragma unroll
        for (int e = 0; e < 8; ++e) o[e] = w0 * a0[e] + w1 * a1[e] + w2 * a2[e];
        v4u w; w.x = pk2(o[0], o[1]); w.y = pk2(o[2], o[3]); w.z = pk2(o[4], o[5]); w.w = pk2(o[6], o[7]);
        *(v4u*)(O + (size_t)r * DM + (NHA + hh) * HD + c8 * 8) = w;
    }
}
__device__ __forceinline__ void p_convfix(Frame& F, int layer) {
    const float* top = (const float*)(F.ws + WS_TOP); const float* bot = (const float*)(F.ws + WS_BOT); bf16* Gb = (bf16*)(F.ws + WS_G);
    const float* cw = F.ffn_conv_w + (size_t)layer * 3 * F2; const float* cb = F.ffn_conv_b + (size_t)layer * F2;
    constexpr int C4 = DFF / 4, NIT = 30 * C4;
    for (int idx = blockIdx.x * 512 + F.tid; idx < NIT; idx += F.G * 512) {
        const int pmi = idx / C4, j0 = (idx - pmi * C4) * 4, pm = pmi + 1 + (pmi >= 15 ? 1 : 0);
        f32x4 c0[2], c1[2];
#pragma unroll
        for (int bj = 0; bj < 2; ++bj) {
            const int col = bj * DFF + j0;
            const f32x4 w0 = *(const f32x4*)(cw + col), w1 = *(const f32x4*)(cw + F2 + col), w2 = *(const f32x4*)(cw + 2 * F2 + col), bb = *(const f32x4*)(cb + col);
            const f32x4 am2 = *(const f32x4*)(bot + (size_t)((pm - 1) * 2 + 0) * F2 + col), am1 = *(const f32x4*)(bot + (size_t)((pm - 1) * 2 + 1) * F2 + col);
            const f32x4 a0 = *(const f32x4*)(top + (size_t)(pm * 2 + 0) * F2 + col), a1 = *(const f32x4*)(top + (size_t)(pm * 2 + 1) * F2 + col);
            c0[bj] = bb + w0 * am2 + w1 * am1 + w2 * a0;
            c1[bj] = bb + w0 * am1 + w1 * a0 + w2 * a1;
        }
        v2u o0, o1;
        o0.x = pk2(silu_f(c0[0][0]) * c0[1][0], silu_f(c0[0][1]) * c0[1][1]); o0.y = pk2(silu_f(c0[0][2]) * c0[1][2], silu_f(c0[0][3]) * c0[1][3]);
        o1.x = pk2(silu_f(c1[0][0]) * c1[1][0], silu_f(c1[0][1]) * c1[1][1]); o1.y = pk2(silu_f(c1[0][2]) * c1[1][2], silu_f(c1[0][3]) * c1[1][3]);
        *(v2u*)(Gb + (size_t)(pm * 256) * DFF + j0) = o0;
        *(v2u*)(Gb + (size_t)(pm * 256 + 1) * DFF + j0) = o1;
    }
}

__device__ __forceinline__ void p_sgate(Frame& F) {
    typedef short bf16x8 __attribute__((ext_vector_type(8))); typedef float f32x16 __attribute__((ext_vector_type(16)));
    const bf16* U = (const bf16*)(F.ws + WS_U); const bf16* V = (const bf16*)(F.ws + WS_V); const float* VS = (const float*)(F.ws + WS_VSQ); bf16* GT = (bf16*)(F.ws + WS_O);
    constexpr int PT = 136;
    LAS bf16* Wc = (LAS bf16*)(F.lds + RING_OFF);
    LAS bf16* vnT = Wc + 128 * PT;
    LAS float* rstat = (LAS float*)(F.lds + RING_OFF + 2 * 128 * PT * 2);
    const int lane = F.lane, r32 = lane & 31, hi = lane >> 5, tb = F.wave >> 1, dh = F.wave & 1;
    int gcur = -1;
    for (int item = blockIdx.x; item < 64 * 32; item += F.G) {
        const int g = item & 31, bc = item >> 5, r0 = bc * 128;
        if (g != gcur) {
            for (int idx = F.tid; idx < 128 * 32; idx += 512) { const int t = idx >> 5, s4 = (idx & 31) * 4;
                const f32x4 w = *(const f32x4*)(F.sg_w_s + (size_t)g * 16384 + t * 128 + s4);
                v2u o; o.x = pk2(s4 <= t ? w[0] : 0.f, s4 + 1 <= t ? w[1] : 0.f); o.y = pk2(s4 + 2 <= t ? w[2] : 0.f, s4 + 3 <= t ? w[3] : 0.f);
                *(LAS v2u*)(Wc + t * PT + s4) = o; }
            gcur = g;
        }
        if (F.tid < 128) { const float s1 = VS[2 * (r0 + F.tid)], s2 = VS[2 * (r0 + F.tid) + 1];
            const float mean = s1 * (1.0f / 4096.0f), var = s2 * (1.0f / 4096.0f) - mean * mean;
            rstat[2 * F.tid] = mean; rstat[2 * F.tid + 1] = 1.0f / sqrtf(var + NORM_EPS); }
        __syncthreads();
        { const int d8 = (F.tid & 15) * 8, col = g * 128 + d8;
          float gn[8], bs[8];
#pragma unroll
          for (int e = 0; e < 8; ++e) { gn[e] = F.sg_v_gain[col + e]; bs[e] = F.sg_v_bias[col + e]; }
          for (int s = F.tid >> 4; s < 128; s += 32) {
              float v8[8]; unpack8(*(const v4u*)(V + (size_t)(r0 + s) * DM + col), v8);
              const float mean = rstat[2 * s], rstd = rstat[2 * s + 1];
#pragma unroll
              for (int e = 0; e < 8; ++e) vnT[(d8 + e) * PT + s] = (bf16)f2bf((v8[e] - mean) * rstd * gn[e] + bs[e]);
          } }
        __syncthreads();
        f32x16 acc0 = {}, acc1 = {};
        const LAS bf16* ap = Wc + (32 * tb + r32) * PT + 8 * hi;
        const LAS bf16* bp0 = vnT + (64 * dh + r32) * PT + 8 * hi, * bp1 = bp0 + 32 * PT;
        for (int ks = 0; ks < 2 * tb + 2; ++ks) {
            const bf16x8 a = *(const LAS bf16x8*)(ap + 16 * ks), b0 = *(const LAS bf16x8*)(bp0 + 16 * ks), b1 = *(const LAS bf16x8*)(bp1 + 16 * ks);
            acc0 = __builtin_amdgcn_mfma_f32_32x32x16_bf16(a, b0, acc0, 0, 0, 0);
            acc1 = __builtin_amdgcn_mfma_f32_32x32x16_bf16(a, b1, acc1, 0, 0, 0);
        }
#pragma unroll
        for (int i = 0; i < 16; ++i) {
            const int t = 32 * tb + (i & 3) + 8 * (i >> 2) + 4 * hi;
            const float bsv = F.sg_b_s[g * 128 + t];
            const size_t o = (size_t)(r0 + t) * DM + g * 128 + 64 * dh + r32;
            GT[o] = (bf16)f2bf(bf1(U[o]) * (acc0[i] + bsv));
            GT[o + 32] = (bf16)f2bf(bf1(U[o + 32]) * (acc1[i] + bsv));
        }
        __syncthreads();
    }
}
constexpr int N_PHASES = 18;
struct Args { const void* in[19]; float* out; unsigned char* ws; int ph_lo, ph_hi, li, pad; };
__global__ void __launch_bounds__(NWAVES * 64, 2) mk_fwd(Args args) {
    extern __shared__ __attribute__((aligned(16))) unsigned char lds[];
    Frame F;
    F.lds = (LAS unsigned char*)lds;
    F.MISC = (volatile LAS unsigned*)(F.lds + MISC_OFF);
    F.tid = threadIdx.x; F.lane = F.tid & 63; F.wave = __builtin_amdgcn_readfirstlane(F.tid >> 6);
    F.G = gridDim.x; F.gw = blockIdx.x * NWAVES + F.wave; F.NGW = F.G * NWAVES;
    F.ws = args.ws; F.ctl = (unsigned*)(args.ws + WS_CTL);
    F.x = (const float*)args.in[0]; F.pos = (const int*)args.in[1];
    F.attn_norm = (const float*)args.in[2]; F.attn_w_in = (const float*)args.in[3]; F.attn_w_out = (const float*)args.in[4];
    F.sg_norm = (const float*)args.in[5]; F.sg_w_in = (const float*)args.in[6]; F.sg_b_in = (const float*)args.in[7]; F.sg_v_gain = (const float*)args.in[8]; F.sg_v_bias = (const float*)args.in[9];
    F.sg_w_s = (const float*)args.in[10]; F.sg_b_s = (const float*)args.in[11]; F.sg_w_out = (const float*)args.in[12];
    F.ffn_norm = (const float*)args.in[13]; F.ffn_w_up = (const float*)args.in[14]; F.ffn_conv_w = (const float*)args.in[15]; F.ffn_conv_b = (const float*)args.in[16]; F.ffn_w_down = (const float*)args.in[17];
    F.final_norm = (const float*)args.in[18]; F.out = args.out;
    for (int u = F.tid; u < (XTRA_OFF - LDSCTL_OFF) / 4; u += NWAVES * 64) ((LAS unsigned*)(F.lds + LDSCTL_OFF))[u] = 0u;
    __syncthreads();
    const int lo = args.ph_lo, hi = args.ph_hi;
    XcdBarrier bar; bar.bar = F.ctl + CW_BAR + args.li * XCD_BAR_WORDS; bar.x = 0; bar.st = nullptr;
    if (hi - lo > 1) bar = xcd_barrier_post(F.ctl + CW_BAR + args.li * XCD_BAR_WORDS, F.MISC + 8);
#define IN(k) (lo <= (k) && (k) < hi)
#define SEAM(k) do { if (IN(k) && IN((k) + 1)) xcd_barrier(bar); } while (0)
    unsigned char* ws = args.ws;
    bf16* XB = (bf16*)(ws + WS_XB); float* H = (float*)(ws + WS_H); bf16* O = (bf16*)(ws + WS_O); bf16* Gb = (bf16*)(ws + WS_G); bf16* AP = (bf16*)(ws + WS_APRE);
    float* SS = (float*)(ws + WS_SSQ); constexpr size_t SSF = SSQ_SITE / 4;
    const int c = (int)blockIdx.x;

    if (IN(0)) { p0_prologue(F); } SEAM(0);
    if (IN(1)) { quant_weight_rows(F, (const bf16*)(ws + WS_WIN), (signed char*)(ws + WS_WIN8), (const unsigned*)(ws + WS_AMAX) + AM_WIN, (float*)(ws + WS_SW) + AM_WIN, QKVC); } SEAM(1);
    if (IN(2)) {
        pg8::Gemm g{(const bf16*)(ws + WS_HQ8), (const bf16*)(ws + WS_WIN8), MR, QKVC, DM / 2}; pg8::StaticOrder S; S.init(MR, QKVC, F.G, c);
        pg8::EpiQKV8 E{(bf16*)(ws + WS_QKV), SS, (const float*)(ws + WS_ROPE), (const float*)(ws + WS_ROPE) + MR * 16, (float*)(ws + WS_KMEAN), (const float*)(ws + WS_SAH), (const float*)(ws + WS_SW) + AM_WIN};
        pg8::gemm_phase<pg8::EpiQKV8, pg8::StaticOrder, PG8_ALIGN, PG8_SP2>(F.lds + RING_OFF, g, S, E);
    } SEAM(2);
    if (IN(3)) { p_attn(F, (char*)lds + RING_OFF); } SEAM(3);
    if (IN(4)) { p_dilmerge(F);
#ifdef CHECK_ATTN
        xcd_barrier(bar); p_attn_naive(F, AP); xcd_barrier(bar);
        { unsigned bad = 0; for (size_t idx = (size_t)blockIdx.x * 512 + F.tid; idx < (size_t)MR * DM; idx += (size_t)F.G * 512) { const float a = bf1(O[idx]), b = bf1(AP[idx]); if (!(fabsf(a - b) <= 0.004f + 0.03f * fabsf(b))) ++bad; }
          if (bad) atomicAdd(F.ctl + 8, bad); }
#endif
        quant_weight_rows(F, (const bf16*)(ws + WS_WUP), (signed char*)(ws + WS_WUP8), (const unsigned*)(ws + WS_AMAX) + AM_WUP, (float*)(ws + WS_SW) + AM_WUP, F2);
        quant_weight_rows(F, (const bf16*)(ws + WS_WUP + WUP_L), (signed char*)(ws + WS_WUP8 + WUP8_L), (const unsigned*)(ws + WS_AMAX) + AM_WUP + F2, (float*)(ws + WS_SW) + AM_WUP + F2, F2);
    } SEAM(4);
    if (IN(5)) {
        pg8::Gemm g{O, (const bf16*)(ws + WS_WOUT), MR, DM, DM}; pg8::StaticOrder S; S.init(MR, DM, F.G, c);
        pg8::EpiRes E{F.x, H, XB, SS + 1 * SSF};
        pg8::gemm_phase<pg8::EpiRes, pg8::StaticOrder, PG8_ALIGN, PG8_SP2>(F.lds + RING_OFF, g, S, E);
    } SEAM(5);
    if (IN(6)) { quant_act_rows(F, H, (signed char*)(ws + WS_HQ8), (float*)(ws + WS_SAH)); } SEAM(6);
    if (IN(7)) {
        pg8::Gemm g{(const bf16*)(ws + WS_HQ8), (const bf16*)(ws + WS_WUP8), MR, F2, DM / 2}; pg8::StaticOrder S; S.init(MR, F2, F.G, c);
        pg8::EpiUpConv8 E{Gb, SS + 1 * SSF, F.ffn_conv_w, F.ffn_conv_b, (float*)(ws + WS_TOP), (float*)(ws + WS_BOT), (LAS float*)(F.lds + XTRA_OFF), (const float*)(ws + WS_SAH), (const float*)(ws + WS_SW) + AM_WUP};
        pg8::gemm_phase<pg8::EpiUpConv8, pg8::StaticOrder, true, PG8_SP2>(F.lds + RING_OFF, g, S, E);
    } SEAM(7);
    if (IN(8)) { p_convfix(F, 0); } SEAM(8);
    if (IN(9)) {
        pg8::Gemm g{Gb, (const bf16*)(ws + WS_WDOWN), MR, DM, DFF}; pg8::StaticOrder S; S.init(MR, DM, F.G, c);
        pg8::EpiRes E{H, H, XB, SS + 2 * SSF};
        pg8::gemm_phase<pg8::EpiRes, pg8::StaticOrder, PG8_ALIGN, PG8_SP2>(F.lds + RING_OFF, g, S, E);
    } SEAM(9);
    if (IN(10)) {
        pg8::Gemm g{XB, (const bf16*)(ws + WS_SGWIN), MR, 2 * DM, DM}; pg8::StaticOrder S; S.init(MR, 2 * DM, F.G, c);
        pg8::EpiSgIn E{(bf16*)(ws + WS_U), (bf16*)(ws + WS_V), SS + 2 * SSF, F.sg_b_in, (float*)(ws + WS_VSQ)};
        pg8::gemm_phase<pg8::EpiSgIn, pg8::StaticOrder, PG8_ALIGN, PG8_SP2>(F.lds + RING_OFF, g, S, E);
    } SEAM(10);
    if (IN(11)) { p_sgate(F); } SEAM(11);
    if (IN(12)) {
        pg8::Gemm g{O, (const bf16*)(ws + WS_SGWOUT), MR, DM, DM}; pg8::StaticOrder S; S.init(MR, DM, F.G, c);
        pg8::EpiRes E{H, H, XB, SS + 3 * SSF};
        pg8::gemm_phase<pg8::EpiRes, pg8::StaticOrder, PG8_ALIGN, PG8_SP2>(F.lds + RING_OFF, g, S, E);
    } SEAM(12);
    if (IN(13)) { quant_act_rows(F, H, (signed char*)(ws + WS_HQ8), (float*)(ws + WS_SAH)); } SEAM(13);
    if (IN(14)) {
        pg8::Gemm g{(const bf16*)(ws + WS_HQ8), (const bf16*)(ws + WS_WUP8 + WUP8_L), MR, F2, DM / 2}; pg8::StaticOrder S; S.init(MR, F2, F.G, c);
        pg8::EpiUpConv8 E{Gb, SS + 3 * SSF, F.ffn_conv_w + 3 * F2, F.ffn_conv_b + F2, (float*)(ws + WS_TOP), (float*)(ws + WS_BOT), (LAS float*)(F.lds + XTRA_OFF), (const float*)(ws + WS_SAH), (const float*)(ws + WS_SW) + AM_WUP + F2};
        pg8::gemm_phase<pg8::EpiUpConv8, pg8::StaticOrder, true, PG8_SP2>(F.lds + RING_OFF, g, S, E);
    } SEAM(14);
    if (IN(15)) { p_convfix(F, 1); } SEAM(15);
    if (IN(16)) {
        pg8::Gemm g{Gb, (const bf16*)(ws + WS_WDOWN + WDOWN_L), MR, DM, DFF}; pg8::StaticOrder S; S.init(MR, DM, F.G, c);
        pg8::EpiRes E{H, H, XB, SS + 4 * SSF};
        pg8::gemm_phase<pg8::EpiRes, pg8::StaticOrder, PG8_ALIGN, PG8_SP2>(F.lds + RING_OFF, g, S, E);
    } SEAM(16);
    if (IN(17)) { p_final(F); }
#undef IN
#undef SEAM
}

extern "C" void kernel_launch(void* const* d_in, const int* in_sizes, int n_in, void* d_out, int out_size, void* d_ws, size_t ws_size, hipStream_t stream) {
    static int grid = 0;
    if (grid == 0) {
        if (n_in != 19 || out_size != MR * DM || ws_size < WS_END) { fprintf(stderr, "kernel_launch: unexpected shapes (n_in %d, out %d, ws %zu); nothing launched\n", n_in, out_size, ws_size); grid = -1; return; }
        int dev = 0, cus = 0, per_cu = 0;
        if (hipGetDevice(&dev) != hipSuccess || hipDeviceGetAttribute(&cus, hipDeviceAttributeMultiprocessorCount, dev) != hipSuccess) { grid = -1; return; }
        if (hipFuncSetAttribute((const void*)mk_fwd, hipFuncAttributeMaxDynamicSharedMemorySize, LDS_BYTES) != hipSuccess) { fprintf(stderr, "kernel_launch: hipFuncSetAttribute failed\n"); grid = -1; return; }
        if (hipOccupancyMaxActiveBlocksPerMultiprocessor(&per_cu, (const void*)mk_fwd, NWAVES * 64, LDS_BYTES) != hipSuccess || per_cu < 1) fprintf(stderr, "kernel_launch: occupancy query reports %d\n", per_cu);
        (void)hipGetLastError();
        grid = cus;
    }
    if (grid < 0) return;
    if (hipMemsetAsync((char*)d_ws + WS_CTL, 0, CTL_ZERO_BYTES, stream) != hipSuccess) return;
    Args a{};
    for (int i = 0; i < 19; ++i) a.in[i] = d_in[i];
    a.out = (float*)d_out; a.ws = (unsigned char*)d_ws; a.pad = 0;
    if (MK_N_LAUNCHES == 1) {
        a.ph_lo = 0; a.ph_hi = N_PHASES; a.li = 0;
        hipLaunchKernelGGL(mk_fwd, dim3(grid), dim3(NWAVES * 64), LDS_BYTES, stream, a);
    } else {
        for (int p = 0; p < N_PHASES; ++p) { a.ph_lo = p; a.ph_hi = p + 1; a.li = 0; hipLaunchKernelGGL(mk_fwd, dim3(grid), dim3(NWAVES * 64), LDS_BYTES, stream, a);
#ifdef PROBE_MASK
            if ((PROBE_MASK >> p) & 1) hipLaunchKernelGGL(mk_fwd, dim3(grid), dim3(NWAVES * 64), LDS_BYTES, stream, a);
#endif
        }
    }
}
```

```cpp
#include <hip/hip_runtime.h>
#include <cstdio>
#include <cstdint>
#ifndef MK_N_LAUNCHES
#define MK_N_LAUNCHES 1
#endif
namespace pg8 {
#define PG8_LAS __attribute__((address_space(3)))
typedef unsigned short bf16_t;
typedef short bf16x8 __attribute__((ext_vector_type(8)));
typedef float f32x4 __attribute__((ext_vector_type(4)));
typedef unsigned u32x4 __attribute__((ext_vector_type(4)));
constexpr int BM = 256, BK = 64, HALF = 128, HTB = HALF * BK * 2  , STAGE_BYTES = 8 * HTB, NXCD = 8, WGM = 8;

__host__ __device__ __forceinline__ int lds_byte(int r, int c) { const int st = (r >> 4) * 2 + (c >> 5), rr = r & 15, cc = c & 31, ob = rr * 64 + cc * 2; return st * 1024 + (ob ^ (((ob >> 9) & 1) << 5)); }
__host__ __device__ __forceinline__ void stage_rc(int b, int& R, int& C) { const int st = b / 1024, sb = b % 1024, swz = sb ^ (((sb >> 9) & 1) << 5); R = (st >> 1) * 16 + swz / 64; C = (st & 1) * 32 + (swz % 64) / 2; }
__host__ __device__ __forceinline__ int perm32(int rho) { const int n = rho >> 4, i = rho & 15; return 8 * (i >> 2) + 4 * n + (i & 3); }

struct Unit { int pm, pn; };
struct Gemm { const bf16_t* A; const bf16_t* Bt; int M, N, K; };

struct StaticOrder {
    int nM, nN, nwg, G, c, same;
    __host__ __device__ void init(int M, int N, int G_, int c_) { nM = M / BM; nN = N / BM; nwg = nM * nN; G = G_; c = c_; same = -1; }
    __host__ __device__ bool next(int i, Unit& u) const {
        const long L = (long)i * G + c; if (L >= nwg) return false;
        int wgid = (int)L; { const int q = nwg / NXCD, r = nwg % NXCD, xcd = wgid % NXCD, off = wgid / NXCD; wgid = (xcd < r ? xcd * (q + 1) : r * (q + 1) + (xcd - r) * q) + off; }
        const int nig = WGM * nN, gid = wgid / nig, fm = gid * WGM, gsz = (nM - fm) < WGM ? (nM - fm) : WGM;
        u.pm = fm + ((wgid % nig) % gsz); u.pn = (wgid % nig) / gsz; u.pm &= same; u.pn &= same; return true;
    }
    __device__ __forceinline__ void a_ready(const Unit&) const {}
    __device__ __forceinline__ void done(const Unit&) const {}
};
__device__ __forceinline__ unsigned cvt_pk_bf16(float lo, float hi) { unsigned r; asm volatile("v_cvt_pk_bf16_f32 %0, %1, %2" : "=v"(r) : "v"(lo), "v"(hi)); return r; }
typedef float f32x2 __attribute__((ext_vector_type(2)));
__device__ __forceinline__ f32x2 gelu_pk(f32x2 v) {
    const f32x2 av = __builtin_elementwise_abs(v), d = av * 0.2316418882f + 1.0f;
    f32x2 t; t.x = __builtin_amdgcn_rcpf(d.x); t.y = __builtin_amdgcn_rcpf(d.y);
    f32x2 q = t * 0.5307027145f + (-0.7265760135f); q = q * t + 0.7107068705f; q = q * t + (-0.142248368f); q = q * t + 0.127414796f; q = q * t;
    const f32x2 s = (v * v) * (-0.72134752044f);
    f32x2 e; e.x = __builtin_amdgcn_exp2f(s.x); e.y = __builtin_amdgcn_exp2f(s.y);
    const f32x2 Q = q * e;
    f32x2 mx; mx.x = __builtin_fmaxf(v.x, 0.f); mx.y = __builtin_fmaxf(v.y, 0.f);
    return mx - av * Q;
}
typedef unsigned u32x2 __attribute__((ext_vector_type(2)));
typedef int i32x4 __attribute__((ext_vector_type(4)));
__device__ __forceinline__ unsigned long long fx20(float x) { return (unsigned long long)(long long)__builtin_rintf(x * 1048576.0f); }
__device__ __forceinline__ float unfx20(unsigned long long v) { return (float)(long long)v * (1.0f / 1048576.0f); }
template <bool I8> struct AccT { typedef f32x4 type; };
template <> struct AccT<true> { typedef i32x4 type; };
__device__ __forceinline__ f32x4 tof(f32x4 a) { return a; }
__device__ __forceinline__ f32x4 tof(i32x4 a) { return (f32x4){(float)a[0], (float)a[1], (float)a[2], (float)a[3]}; }
__device__ __forceinline__ float rstd_from_ss(const float* ss, int r) { return 1.0f / sqrtf(ss[r] * (1.0f / 4096.0f) + 1e-5f); }

template <bool Q8> struct EpiQKVT {
    static constexpr bool PERM = false, AFTER_DRAIN = false, I8 = Q8, APERM = false;
    typedef typename AccT<Q8>::type acc_t;
    bf16_t* qkv; const float* ss; const float* ropec; const float* ropes; float* km; const float* sa; const float* sw;
    __device__ __forceinline__ void operator()(const acc_t (&acc)[2][2][4][2], const Unit& u, int wr, int wc, int fr_in, int fq_in) const {
        int fr = fr_in, fq = fq_in; asm volatile("" : "+v"(fr), "+v"(fq));
        const int row0 = u.pm * BM + wr * 64 + fr;
        f32x4 swv[2][2];
#pragma unroll
        for (int bj = 0; bj < 2; ++bj)
#pragma unroll
            for (int n = 0; n < 2; ++n) swv[bj][n] = Q8 ? *(const f32x4*)(sw + u.pn * BM + bj * HALF + wc * 32 + 16 * n + 4 * fq) : (f32x4){1.f, 1.f, 1.f, 1.f};
        const bool kmu = u.pn >= 24 && u.pn < 36;
        const bool rot = wc == 0 && u.pn < 48;
        f32x4 cs[2][2];
#pragma unroll
        for (int bj = 0; bj < 2; ++bj)
#pragma unroll
            for (int n = 0; n < 2; ++n) cs[bj][n] = (f32x4){0.f, 0.f, 0.f, 0.f};
#pragma unroll
        for (int ai = 0; ai < 2; ++ai) {
            float rs[4]; f32x4 cz[4], sn[4];
            float sar[4];
#pragma unroll
            for (int m = 0; m < 4; ++m) sar[m] = Q8 ? sa[row0 + ai * HALF + m * 16] : 1.0f;
#pragma unroll
            for (int m = 0; m < 4; ++m) { const int r = row0 + ai * HALF + m * 16; rs[m] = ss[r];
                cz[m] = (f32x4){1.f, 1.f, 1.f, 1.f}; sn[m] = (f32x4){0.f, 0.f, 0.f, 0.f};
                if (rot) { cz[m] = *(const f32x4*)(ropec + (size_t)r * 16 + 4 * fq); sn[m] = *(const f32x4*)(ropes + (size_t)r * 16 + 4 * fq); } }
#pragma unroll
            for (int m = 0; m < 4; ++m) {
                const int r = row0 + ai * HALF + m * 16;
                const float rsv = sar[m] / sqrtf(rs[m] * (1.0f / 4096.0f) + 1e-5f);
                const int b = r >> 12, s = r & 4095;
#pragma unroll
                for (int bj = 0; bj < 2; ++bj) {
                    const int colh = 2 * u.pn + bj, which = colh / 48, head = colh - which * 48;
                    bf16_t* dst = qkv + ((size_t)((which * 2 + b) * 48 + head) * 4096 + s) * 128 + wc * 32 + 4 * fq;
                    f32x4 v0 = tof(acc[ai][bj][m][0]) * rsv, v1 = tof(acc[ai][bj][m][1]) * rsv;
                    if (Q8) { v0 = v0 * swv[bj][0]; v1 = v1 * swv[bj][1]; }
                    if (rot) { const f32x4 n0 = v0 * cz[m] - v1 * sn[m], n1 = v1 * cz[m] + v0 * sn[m]; v0 = n0; v1 = n1; }
                    if (kmu) { cs[bj][0] += v0; cs[bj][1] += v1; }
                    u32x2 w0, w1; w0.x = cvt_pk_bf16(v0[0], v0[1]); w0.y = cvt_pk_bf16(v0[2], v0[3]); w1.x = cvt_pk_bf16(v1[0], v1[1]); w1.y = cvt_pk_bf16(v1[2], v1[3]);
                    *(u32x2*)(dst) = w0; *(u32x2*)(dst + 16) = w1;
                }
            }
            asm volatile("" ::: "memory");
        }
        if (kmu) {
            const int b = u.pm >> 4, blk = u.pm & 15;
#pragma unroll
            for (int bj = 0; bj < 2; ++bj) {
                const int head = 2 * u.pn + bj - 48;
                float* dst = km + ((size_t)((b * 24 + head) * 16 + blk)) * 128 + wc * 32 + 4 * fq;
#pragma unroll
                for (int n = 0; n < 2; ++n)
#pragma unroll
                    for (int j = 0; j < 4; ++j) {
                        float v = cs[bj][n][j];
                        v += __shfl_xor(v, 1); v += __shfl_xor(v, 2); v += __shfl_xor(v, 4); v += __shfl_xor(v, 8);
                        if (fr == 0) atomicAdd(dst + 16 * n + j, v * (1.0f / 256.0f));
                    }
            }
        }
    }
};
typedef EpiQKVT<false> EpiQKV;
typedef EpiQKVT<true> EpiQKV8;

__device__ __forceinline__ f32x4 bf4a(u32x4 w) { return (f32x4){__builtin_bit_cast(float, w.x << 16), __builtin_bit_cast(float, w.x & 0xffff0000u), __builtin_bit_cast(float, w.y << 16), __builtin_bit_cast(float, w.y & 0xffff0000u)}; }
__device__ __forceinline__ f32x4 bf4b(u32x4 w) { return (f32x4){__builtin_bit_cast(float, w.z << 16), __builtin_bit_cast(float, w.z & 0xffff0000u), __builtin_bit_cast(float, w.w << 16), __builtin_bit_cast(float, w.w & 0xffff0000u)}; }
template <bool HF32, bool Q8, bool WST> struct EpiResT {
    static constexpr bool PERM = true, AFTER_DRAIN = false, I8 = Q8, APERM = false;
    typedef typename AccT<Q8>::type acc_t;
    const void* hin; bf16_t* hout; float* ss; const float* sa; const float* sw;
    __device__ __forceinline__ void operator()(const acc_t (&acc)[2][2][4][2], const Unit& u, int wr, int wc, int fr_in, int fq_in) const {
        int fr = fr_in, fq = fq_in; asm volatile("" : "+v"(fr), "+v"(fq));
        const int row0 = u.pm * BM + wr * 64 + fr, col0 = u.pn * BM + wc * 32 + 8 * fq;
        f32x4 swv[2][2];
#pragma unroll
        for (int bj = 0; bj < 2; ++bj)
#pragma unroll
            for (int n = 0; n < 2; ++n) swv[bj][n] = Q8 ? *(const f32x4*)(sw + col0 + bj * HALF + 4 * n) : (f32x4){1.f, 1.f, 1.f, 1.f};
        constexpr int MB = HF32 ? 2 : 4;
#pragma unroll
        for (int ai = 0; ai < 2; ++ai)
#pragma unroll
            for (int mb = 0; mb < 4; mb += MB) {
                f32x4 h[MB][2][2]; float sar[MB];
#pragma unroll
                for (int mi = 0; mi < MB; ++mi) { sar[mi] = Q8 ? sa[row0 + ai * HALF + (mb + mi) * 16] : 1.0f;
                    const size_t off = (size_t)(row0 + ai * HALF + (mb + mi) * 16) * 4096 + col0;
#pragma unroll
                    for (int bj = 0; bj < 2; ++bj) {
                        if (HF32) { h[mi][bj][0] = *(const f32x4*)((const float*)hin + off + bj * HALF); h[mi][bj][1] = *(const f32x4*)((const float*)hin + off + bj * HALF + 4); }
                        else { const u32x4 w = *(const u32x4*)((const bf16_t*)hin + off + bj * HALF); h[mi][bj][0] = bf4a(w); h[mi][bj][1] = bf4b(w); }
                    } }
#pragma unroll
                for (int mi = 0; mi < MB; ++mi) {
                    const int m = mb + mi, r = row0 + ai * HALF + m * 16; const size_t off = (size_t)r * 4096 + col0;
                    float sq = 0.f;
#pragma unroll
                    for (int bj = 0; bj < 2; ++bj) {
                        const f32x4 v0 = Q8 ? h[mi][bj][0] + tof(acc[ai][bj][m][0]) * swv[bj][0] * sar[mi] : h[mi][bj][0] + tof(acc[ai][bj][m][0]);
                        const f32x4 v1 = Q8 ? h[mi][bj][1] + tof(acc[ai][bj][m][1]) * swv[bj][1] * sar[mi] : h[mi][bj][1] + tof(acc[ai][bj][m][1]);
                        u32x4 w; w.x = cvt_pk_bf16(v0[0], v0[1]); w.y = cvt_pk_bf16(v0[2], v0[3]); w.z = cvt_pk_bf16(v1[0], v1[1]); w.w = cvt_pk_bf16(v1[2], v1[3]);
                        *(u32x4*)(hout + off + bj * HALF) = w;
                        sq += ((v0[0] * v0[0] + v0[1] * v0[1]) + (v0[2] * v0[2] + v0[3] * v0[3])) + ((v1[0] * v1[0] + v1[1] * v1[1]) + (v1[2] * v1[2] + v1[3] * v1[3]));
                    }
                    if (WST) { sq += __shfl_xor(sq, 16); sq += __shfl_xor(sq, 32);
                        if (fq == 0) atomicAdd((unsigned long long*)ss + r, fx20(sq)); }
                }
                asm volatile("" ::: "memory");
            }
    }
};
typedef EpiResT<false, false, true> EpiRes;
typedef EpiResT<false, false, false> EpiResNX;
typedef EpiResT<true, true, false> EpiResX8;

struct EpiUpPre {
    static constexpr bool PERM = true, AFTER_DRAIN = false, I8 = false, APERM = false;
    bf16_t* apre; const float* ss;
    __device__ __forceinline__ void operator()(const f32x4 (&acc)[2][2][4][2], const Unit& u, int wr, int wc, int fr, int fq) const {
        const int row0 = u.pm * BM + wr * 64 + fr, col0 = u.pn * 128 + wc * 32 + 8 * fq;
#pragma unroll
        for (int ai = 0; ai < 2; ++ai)
#pragma unroll
            for (int m = 0; m < 4; ++m) {
                const int r = row0 + ai * HALF + m * 16;
                const float rs = rstd_from_ss(ss, r);
                bf16_t* rowp = apre + (size_t)r * 28672 + col0;
#pragma unroll
                for (int bj = 0; bj < 2; ++bj) {
                    const f32x4 v0 = acc[ai][bj][m][0] * rs, v1 = acc[ai][bj][m][1] * rs;
                    u32x4 w; w.x = cvt_pk_bf16(v0[0], v0[1]); w.y = cvt_pk_bf16(v0[2], v0[3]); w.z = cvt_pk_bf16(v1[0], v1[1]); w.w = cvt_pk_bf16(v1[2], v1[3]);
                    *(u32x4*)(rowp + bj * 14336) = w;
                }
                asm volatile("" ::: "memory");
            }
    }
};

struct EpiSgIn {
    static constexpr bool PERM = true, AFTER_DRAIN = false, I8 = false, APERM = false;
    bf16_t* U; bf16_t* V; const float* ss; const float* bias; float* vs;
    __device__ __forceinline__ void operator()(const f32x4 (&acc)[2][2][4][2], const Unit& u, int wr, int wc, int fr, int fq) const {
        const int row0 = u.pm * BM + wr * 64 + fr, gcol0 = u.pn * BM + wc * 32 + 8 * fq;
        const bool isv = u.pn >= 16;
        bf16_t* base = isv ? V : U; const int col0 = isv ? gcol0 - 4096 : gcol0;
        f32x4 bv[2][2];
#pragma unroll
        for (int bj = 0; bj < 2; ++bj)
#pragma unroll
            for (int n = 0; n < 2; ++n) bv[bj][n] = *(const f32x4*)(bias + gcol0 + bj * HALF + 4 * n);
        float rsq[2][4];
#pragma unroll
        for (int ai = 0; ai < 2; ++ai)
#pragma unroll
            for (int m = 0; m < 4; ++m) rsq[ai][m] = unfx20(((const unsigned long long*)ss)[row0 + ai * HALF + m * 16]);
#pragma unroll
        for (int ai = 0; ai < 2; ++ai)
#pragma unroll
            for (int m = 0; m < 4; ++m) {
                const int r = row0 + ai * HALF + m * 16;
                const float rs = 1.0f / sqrtf(rsq[ai][m] * (1.0f / 4096.0f) + 1e-5f);
                bf16_t* rowp = base + (size_t)r * 4096 + col0;
                float s1 = 0.f, s2 = 0.f;
#pragma unroll
                for (int bj = 0; bj < 2; ++bj) {
                    f32x4 v0 = acc[ai][bj][m][0] * rs + bv[bj][0], v1 = acc[ai][bj][m][1] * rs + bv[bj][1];
                    const f32x2 a = gelu_pk((f32x2){v0[0], v0[1]}), b = gelu_pk((f32x2){v0[2], v0[3]}), c = gelu_pk((f32x2){v1[0], v1[1]}), d = gelu_pk((f32x2){v1[2], v1[3]});
                    if (isv) {
                        s1 += (a.x + a.y) + (b.x + b.y) + (c.x + c.y) + (d.x + d.y);
                        s2 += (a.x * a.x + a.y * a.y) + (b.x * b.x + b.y * b.y) + (c.x * c.x + c.y * c.y) + (d.x * d.x + d.y * d.y); }
                    u32x4 w; w.x = cvt_pk_bf16(a.x, a.y); w.y = cvt_pk_bf16(b.x, b.y); w.z = cvt_pk_bf16(c.x, c.y); w.w = cvt_pk_bf16(d.x, d.y);
                    *(u32x4*)(rowp + bj * HALF) = w;
                }
                if (isv) {
                    s1 += __shfl_xor(s1, 16); s1 += __shfl_xor(s1, 32); s2 += __shfl_xor(s2, 16); s2 += __shfl_xor(s2, 32);
                    if (fq == 0) { atomicAdd((unsigned long long*)vs + 2 * r, fx20(s1)); atomicAdd((unsigned long long*)vs + 2 * r + 1, fx20(s2)); }
                }
            }
    }
};

#define PG8_DPP(oldv, srcv, ctrl) __builtin_bit_cast(float, __builtin_amdgcn_update_dpp(__builtin_bit_cast(int, (float)(oldv)), __builtin_bit_cast(int, (float)(srcv)), (ctrl), 0xf, 0xf, false))
template <bool Q8> struct EpiUpConvT {
    static constexpr bool PERM = true, APERM = true, AFTER_DRAIN = false, I8 = Q8;
    typedef typename AccT<Q8>::type acc_t;
    bf16_t* G; const float* ss; const float* cw; const float* cb; float* top; float* bot; PG8_LAS float* xch; const float* sa; const float* sw;
    __device__ __forceinline__ static float silu(float x) { return x * __builtin_amdgcn_rcpf(1.0f + __builtin_amdgcn_exp2f(-1.4426950408889634f * x)); }
    __device__ __forceinline__ void operator()(const acc_t (&acc)[2][2][4][2], const Unit& u, int wr, int wc, int fr_in, int fq_in) const {
        int fr = fr_in, fq = fq_in; asm volatile("" : "+v"(fr), "+v"(fq));
        const int rb0 = u.pm * BM + wr * 64 + 4 * fr, colg = u.pn * 128 + wc * 32 + 8 * fq;
        f32x4 rsv[2];
#pragma unroll
        for (int ai = 0; ai < 2; ++ai) { const f32x4 s = *(const f32x4*)(ss + rb0 + ai * HALF);
            f32x4 r; r[0] = 1.0f / sqrtf(s[0] * (1.0f / 4096.0f) + 1e-5f); r[1] = 1.0f / sqrtf(s[1] * (1.0f / 4096.0f) + 1e-5f); r[2] = 1.0f / sqrtf(s[2] * (1.0f / 4096.0f) + 1e-5f); r[3] = 1.0f / sqrtf(s[3] * (1.0f / 4096.0f) + 1e-5f);
            if (Q8) r = r * *(const f32x4*)(sa + rb0 + ai * HALF);
            rsv[ai] = r; }
        PG8_LAS float* wl = xch + 2048;
        { const int t = (wr * 4 + wc) * 64 + fq * 16 + fr, arr = t >> 7, c2 = (t & 127) * 2, gcol = (c2 < 128 ? 0 : 14336 - 128) + u.pn * 128 + c2;
          const f32x2 wv = *(const f32x2*)((arr < 3 ? cw + arr * 28672 : cb) + gcol);
          *(PG8_LAS f32x2*)(wl + arr * 256 + c2) = wv;
          if (Q8 && t < 128) *(PG8_LAS f32x2*)(wl + 1024 + 2 * t) = *(const f32x2*)(sw + u.pn * 256 + 2 * t); }
#pragma unroll
        for (int ai = 0; ai < 2; ++ai)
#pragma unroll
            for (int bj = 0; bj < 2; ++bj)
#pragma unroll
                for (int n = 0; n < 2; ++n) {
                    if (fr == 15) {
#pragma unroll
                        for (int m = 2; m < 4; ++m) { const f32x4 v = tof(acc[ai][bj][m][n]) * rsv[ai][m];
                            *(PG8_LAS f32x4*)(xch + ((((((ai * 2 + wr) * 4 + wc) * 2 + bj) * 2 + n) * 4 + fq) * 2 + (m - 2)) * 4) = v;
                            if (ai == 1 && wr == 1) { f32x4 vs = v; if (Q8) vs = vs * *(const f32x4*)(sw + u.pn * 256 + bj * 128 + wc * 32 + 8 * fq + 4 * n);
                                *(f32x4*)(bot + ((size_t)(u.pm * 2 + (m - 2)) * 28672) + bj * 14336 + colg + 4 * n) = vs; } }
                    }
                    if (ai == 0 && wr == 0 && fr == 0) {
#pragma unroll
                        for (int m = 0; m < 2; ++m) { f32x4 vs = tof(acc[0][bj][m][n]) * rsv[0][m]; if (Q8) vs = vs * *(const f32x4*)(sw + u.pn * 256 + bj * 128 + wc * 32 + 8 * fq + 4 * n);
                            *(f32x4*)(top + ((size_t)(u.pm * 2 + m) * 28672) + bj * 14336 + colg + 4 * n) = vs; }
                    }
                }
        asm volatile("s_waitcnt lgkmcnt(0)" ::: "memory"); __builtin_amdgcn_s_barrier(); asm volatile("" ::: "memory");
#pragma unroll
        for (int n = 0; n < 2; ++n) {
            f32x4 w0[2], w1[2], w2[2], cbv[2];
#pragma unroll
            for (int bj = 0; bj < 2; ++bj) { const int lc = bj * 128 + wc * 32 + 8 * fq + 4 * n;
                w0[bj] = *(const PG8_LAS f32x4*)(wl + lc); w1[bj] = *(const PG8_LAS f32x4*)(wl + 256 + lc); w2[bj] = *(const PG8_LAS f32x4*)(wl + 512 + lc); cbv[bj] = *(const PG8_LAS f32x4*)(wl + 768 + lc);
                if (Q8) { const f32x4 sc = *(const PG8_LAS f32x4*)(wl + 1024 + lc); w0[bj] = w0[bj] * sc; w1[bj] = w1[bj] * sc; w2[bj] = w2[bj] * sc; }
                const float ks = bj == 0 ? 1.4426950408889634f : 0.6931471805599453f;
                w0[bj] = w0[bj] * ks; w1[bj] = w1[bj] * ks; w2[bj] = w2[bj] * ks; cbv[bj] = cbv[bj] * ks; }
#pragma unroll
            for (int ai = 0; ai < 2; ++ai) {
                const bool has = !(ai == 0 && wr == 0);
                const int pai = wr == 1 ? ai : 0, pwr = wr == 1 ? 0 : 1;
                f32x4 cv[2][4];
#pragma unroll
                for (int bj = 0; bj < 2; ++bj) {
                    f32x4 hm2 = (f32x4){0.f, 0.f, 0.f, 0.f}, hm1 = hm2;
                    if (has && fr == 0) { const PG8_LAS float* hp = xch + ((((((pai * 2 + pwr) * 4 + wc) * 2 + bj) * 2 + n) * 4 + fq) * 2) * 4; hm2 = *(const PG8_LAS f32x4*)(hp); hm1 = *(const PG8_LAS f32x4*)(hp + 4); }
                    const f32x4 a0 = tof(acc[ai][bj][0][n]) * rsv[ai][0], a1 = tof(acc[ai][bj][1][n]) * rsv[ai][1], a2 = tof(acc[ai][bj][2][n]) * rsv[ai][2], a3 = tof(acc[ai][bj][3][n]) * rsv[ai][3];
                    f32x4 s3, s2;
#pragma unroll
                    for (int j = 0; j < 4; ++j) { s3[j] = PG8_DPP(hm1[j], a3[j], 0x111); s2[j] = PG8_DPP(hm2[j], a2[j], 0x111); }
                    cv[bj][0] = cbv[bj] + w2[bj] * a0 + w1[bj] * s3 + w0[bj] * s2;
                    cv[bj][1] = cbv[bj] + w2[bj] * a1 + w1[bj] * a0 + w0[bj] * s3;
                    cv[bj][2] = cbv[bj] + w2[bj] * a2 + w1[bj] * a1 + w0[bj] * a0;
                    cv[bj][3] = cbv[bj] + w2[bj] * a3 + w1[bj] * a2 + w0[bj] * a1;
                }
#pragma unroll
                for (int m = 0; m < 4; ++m) {
                    const f32x4 gu = cv[0][m] * cv[1][m];
                    f32x4 d; d[0] = __builtin_amdgcn_exp2f(-cv[0][m][0]); d[1] = __builtin_amdgcn_exp2f(-cv[0][m][1]); d[2] = __builtin_amdgcn_exp2f(-cv[0][m][2]); d[3] = __builtin_amdgcn_exp2f(-cv[0][m][3]);
                    d = d + 1.0f;
                    f32x4 r; r[0] = __builtin_amdgcn_rcpf(d[0]); r[1] = __builtin_amdgcn_rcpf(d[1]); r[2] = __builtin_amdgcn_rcpf(d[2]); r[3] = __builtin_amdgcn_rcpf(d[3]);
                    const f32x4 o = gu * r;
                    u32x2 w; w.x = cvt_pk_bf16(o[0], o[1]); w.y = cvt_pk_bf16(o[2], o[3]);
                    *(u32x2*)(G + (size_t)(rb0 + ai * HALF + m) * 14336 + colg + 4 * n) = w;
                }
                asm volatile("" ::: "memory");
            }
        }
    }
};
typedef EpiUpConvT<false> EpiUpConv;
typedef EpiUpConvT<true> EpiUpConv8;
struct EpiNull {
    static constexpr bool PERM = true, AFTER_DRAIN = false, I8 = false, APERM = false;
    float* sink; int never;
    __device__ __forceinline__ void operator()(const f32x4 (&acc)[2][2][4][2], const Unit& u, int wr, int wc, int fr, int fq) const {
        if (never == 12345) {
#pragma unroll
            for (int ai = 0; ai < 2; ++ai)
#pragma unroll
                for (int bj = 0; bj < 2; ++bj)
#pragma unroll
                    for (int m = 0; m < 4; ++m)
#pragma unroll
                        for (int n = 0; n < 2; ++n) *(f32x4*)(sink + ((((ai * 2 + bj) * 4 + m) * 2 + n) * 512 + threadIdx.x) * 4) = acc[ai][bj][m][n];
        }
    }
};
__device__ __forceinline__ f32x4 mma16(bf16x8 a, bf16x8 b, f32x4 c) { return __builtin_amdgcn_mfma_f32_16x16x32_bf16(a, b, c, 0, 0, 0); }
__device__ __forceinline__ i32x4 mma16(bf16x8 a, bf16x8 b, i32x4 c) { return __builtin_amdgcn_mfma_i32_16x16x64_i8(__builtin_bit_cast(i32x4, a), __builtin_bit_cast(i32x4, b), c, 0, 0, 0); }
template <class Epi, class Sched, bool ALIGN_EPI = false, bool SP2 = false>
__device__ __forceinline__ void gemm_phase(PG8_LAS unsigned char* lds, const Gemm g, const Sched& S, const Epi& E, const int wave_id) {
    constexpr bool I8 = Epi::I8;
    typedef typename AccT<I8>::type acc_t;
    const int lane = (int)__builtin_amdgcn_mbcnt_hi(~0u, __builtin_amdgcn_mbcnt_lo(~0u, 0u)), wid = wave_id, tid = wid * 64 + lane, wr = wid >> 2, wc = wid & 3, fr = lane & 15, fq = lane >> 4;
    const int K = g.K, nt = K / BK;
    unsigned voffA[2], voffB[2];
#pragma unroll
    for (int i = 0; i < 2; ++i) { int R, C; stage_rc(tid * 16 + i * 8192, R, C); const int Rb = Epi::PERM ? ((R & ~31) + perm32(R & 31)) : R;
        const int Ra = Epi::APERM ? ((R & ~63) + 4 * (R & 15) + ((R & 63) >> 4)) : R;
        voffA[i] = (unsigned)(Ra * K + C) * 2u; voffB[i] = (unsigned)(Rb * K + C) * 2u; }
    const size_t kstep = (size_t)(BK * 2);
    const size_t hstep = (size_t)HALF * K * 2;
    const size_t tstep = 2 * hstep;
    const unsigned ldsw = (unsigned)wid * 1024u;
    const int aoff = lds_byte(wr * 64 + fr, fq * 8), boff = lds_byte(wc * 32 + fr, fq * 8);
#define PG8_SA(b, h) (((b) * 2 + (h)) * HTB)
#define PG8_SB(b, h) ((4 + (b) * 2 + (h)) * HTB)
#define PG8_STAGE(bufoff, gbase, voff) do { _Pragma("unroll") for (int _i = 0; _i < 2; ++_i) \
        __builtin_amdgcn_global_load_lds((const unsigned*)((const char*)(gbase) + (voff)[_i]), (PG8_LAS unsigned*)(lds + (bufoff) + ldsw + _i * 8192), 16, 0, 0); } while (0)
#define PG8_LDA(dst, b, h) do { _Pragma("unroll") for (int m = 0; m < 4; ++m) _Pragma("unroll") for (int k = 0; k < 2; ++k) dst[m][k] = *(const PG8_LAS bf16x8*)(lds + PG8_SA(b, h) + aoff + m * 2048 + k * 1024); } while (0)
#define PG8_LDB(dst, b, h) do { _Pragma("unroll") for (int n = 0; n < 2; ++n) _Pragma("unroll") for (int k = 0; k < 2; ++k) dst[n][k] = *(const PG8_LAS bf16x8*)(lds + PG8_SB(b, h) + boff + n * 2048 + k * 1024); } while (0)
#define PG8_MMA(ai, bj, At, Bt) do { __builtin_amdgcn_s_setprio(1); _Pragma("unroll") for (int m = 0; m < 4; ++m) _Pragma("unroll") for (int n = 0; n < 2; ++n) _Pragma("unroll") for (int k = 0; k < 2; ++k) \
        acc[ai][bj][m][n] = mma16(Bt[n][k], At[m][k], acc[ai][bj][m][n]); __builtin_amdgcn_s_setprio(0); } while (0)
#define PG8_WAIT_V(n) asm volatile("s_waitcnt vmcnt(" #n ")" ::: "memory")
#define PG8_WAIT_L(n) asm volatile("s_waitcnt lgkmcnt(" #n ")" ::: "memory")
#define PG8_BAR __builtin_amdgcn_s_barrier()
#define PG8_SCHED __builtin_amdgcn_sched_barrier(0)
    Unit cur, nxt; int ui = 0;
    if (!S.next(0, cur)) return;
    acc_t acc[2][2][4][2];
#pragma unroll
    for (int a = 0; a < 2; ++a)
#pragma unroll
        for (int b = 0; b < 2; ++b)
#pragma unroll
            for (int m = 0; m < 4; ++m)
#pragma unroll
                for (int n = 0; n < 2; ++n) acc[a][b][m][n] = acc_t{};
    bf16x8 At[4][2], B0[2][2], B1[2][2];
    const char* cA = (const char*)g.A + (size_t)cur.pm * tstep; const char* cB = (const char*)g.Bt + (size_t)cur.pn * tstep;
    S.a_ready(cur);
    if constexpr (SP2) {
        PG8_STAGE(PG8_SB(0, 0), cB, voffB); PG8_STAGE(PG8_SB(0, 1), cB + hstep, voffB); PG8_STAGE(PG8_SA(0, 0), cA, voffA); PG8_STAGE(PG8_SA(0, 1), cA + hstep, voffA);
        if (wr == 1) PG8_BAR;
        PG8_WAIT_V(2); PG8_BAR;
        PG8_STAGE(PG8_SB(1, 0), cB + kstep, voffB); PG8_STAGE(PG8_SA(1, 0), cA + kstep, voffA); PG8_STAGE(PG8_SB(1, 1), cB + hstep + kstep, voffB);
        PG8_WAIT_V(6); PG8_BAR;
    } else {
        PG8_STAGE(PG8_SB(0, 0), cB, voffB); PG8_STAGE(PG8_SA(0, 0), cA, voffA); PG8_STAGE(PG8_SB(0, 1), cB + hstep, voffB); PG8_STAGE(PG8_SA(0, 1), cA + hstep, voffA);
        if (wr == 1) PG8_BAR;
        PG8_WAIT_V(4); PG8_BAR;
        PG8_STAGE(PG8_SB(1, 0), cB + kstep, voffB); PG8_STAGE(PG8_SA(1, 0), cA + kstep, voffA); PG8_STAGE(PG8_SB(1, 1), cB + hstep + kstep, voffB);
        PG8_WAIT_V(6); PG8_BAR;
    }
    for (;;) {
        const bool has_next = S.next(ui + 1, nxt);
        const char* nA = has_next ? (const char*)g.A + (size_t)nxt.pm * tstep : cA; const char* nB = has_next ? (const char*)g.Bt + (size_t)nxt.pn * tstep : cB;
        for (int t = 0; t < nt; t += 2) {
            const bool last = (t == nt - 2);
            const char* a1 = cA + (size_t)(t + 1) * kstep;
            const char* a2 = last ? nA : cA + (size_t)(t + 2) * kstep; const char* b2 = last ? nB : cB + (size_t)(t + 2) * kstep;
            const char* a3 = a2 + kstep; const char* b3 = b2 + kstep;
            if (last && has_next) S.a_ready(nxt);
            if constexpr (SP2) {
            PG8_LDB(B0, 0, 0); PG8_LDB(B1, 0, 1); PG8_SCHED; PG8_LDA(At, 0, 0); PG8_STAGE(PG8_SA(1, 1), a1 + hstep, voffA);
            PG8_WAIT_V(8); PG8_WAIT_L(0); PG8_BAR; PG8_MMA(0, 0, At, B0); PG8_MMA(0, 1, At, B1); PG8_BAR; PG8_SCHED;
            PG8_LDA(At, 0, 1); PG8_STAGE(PG8_SB(0, 0), b2, voffB); PG8_STAGE(PG8_SB(0, 1), b2 + hstep, voffB); PG8_STAGE(PG8_SA(0, 0), a2, voffA);
            PG8_WAIT_V(8); PG8_WAIT_L(0); PG8_BAR; PG8_MMA(1, 0, At, B0); PG8_MMA(1, 1, At, B1); PG8_BAR; PG8_SCHED;
            PG8_LDB(B0, 1, 0); PG8_LDB(B1, 1, 1); PG8_SCHED; PG8_LDA(At, 1, 0); PG8_STAGE(PG8_SA(0, 1), a2 + hstep, voffA);
            PG8_WAIT_V(8); PG8_WAIT_L(0); PG8_BAR; PG8_MMA(0, 0, At, B0); PG8_MMA(0, 1, At, B1); PG8_BAR; PG8_SCHED;
            PG8_LDA(At, 1, 1); PG8_STAGE(PG8_SB(1, 0), b3, voffB); PG8_STAGE(PG8_SB(1, 1), b3 + hstep, voffB); PG8_STAGE(PG8_SA(1, 0), a3, voffA);
            PG8_WAIT_V(8); PG8_WAIT_L(0); PG8_BAR; PG8_MMA(1, 0, At, B0); PG8_MMA(1, 1, At, B1); PG8_BAR; PG8_SCHED;
            } else {
            PG8_LDB(B0, 0, 0); PG8_SCHED; PG8_LDA(At, 0, 0); PG8_STAGE(PG8_SA(1, 1), a1 + hstep, voffA);
            PG8_WAIT_L(8); PG8_BAR; PG8_WAIT_L(0); PG8_MMA(0, 0, At, B0); PG8_BAR; PG8_SCHED;
            PG8_LDB(B1, 0, 1); PG8_STAGE(PG8_SB(0, 0), b2, voffB);
            PG8_BAR; PG8_WAIT_L(0); PG8_MMA(0, 1, At, B1); PG8_BAR;
            PG8_LDA(At, 0, 1); PG8_STAGE(PG8_SA(0, 0), a2, voffA);
            PG8_BAR; PG8_WAIT_L(0); PG8_MMA(1, 0, At, B0); PG8_BAR; PG8_SCHED;
            PG8_STAGE(PG8_SB(0, 1), b2 + hstep, voffB);
            PG8_WAIT_V(6); PG8_BAR; PG8_MMA(1, 1, At, B1); PG8_BAR;
            PG8_LDB(B0, 1, 0); PG8_SCHED; PG8_LDA(At, 1, 0); PG8_STAGE(PG8_SA(0, 1), a2 + hstep, voffA);
            PG8_WAIT_L(8); PG8_BAR; PG8_WAIT_L(0); PG8_MMA(0, 0, At, B0); PG8_BAR; PG8_SCHED;
            PG8_LDB(B1, 1, 1); PG8_STAGE(PG8_SB(1, 0), b3, voffB);
            PG8_BAR; PG8_WAIT_L(0); PG8_MMA(0, 1, At, B1); PG8_BAR;
            PG8_LDA(At, 1, 1); PG8_STAGE(PG8_SA(1, 0), a3, voffA);
            PG8_BAR; PG8_WAIT_L(0); PG8_MMA(1, 0, At, B0); PG8_BAR; PG8_SCHED;
            PG8_STAGE(PG8_SB(1, 1), b3 + hstep, voffB);
            PG8_WAIT_V(6); PG8_BAR; PG8_MMA(1, 1, At, B1); PG8_BAR;
            }
        }
        if constexpr (ALIGN_EPI) { if (wr == 0) PG8_BAR; }
        if constexpr (!Epi::AFTER_DRAIN) { E(acc, cur, wr, wc, fr, fq); S.done(cur); }
        if (!has_next) break;
#pragma unroll
        for (int a = 0; a < 2; ++a)
#pragma unroll
            for (int b = 0; b < 2; ++b)
#pragma unroll
                for (int m = 0; m < 4; ++m)
#pragma unroll
                    for (int n = 0; n < 2; ++n) acc[a][b][m][n] = acc_t{};
        cur = nxt; cA = nA; cB = nB; ++ui;
        if constexpr (ALIGN_EPI) { if (wr == 1) PG8_BAR; }
    }
    PG8_WAIT_V(0);
    if constexpr (!ALIGN_EPI) { if (wr == 0) PG8_BAR; }
    PG8_BAR;
    if constexpr (Epi::AFTER_DRAIN) { E.fused(acc, cur, wr, wc, fr, fq, lds, wid, lane); S.done(cur); }
#undef PG8_SA
#undef PG8_SB
#undef PG8_STAGE
#undef PG8_LDA
#undef PG8_LDB
#undef PG8_MMA
#undef PG8_WAIT_V
#undef PG8_WAIT_L
#undef PG8_BAR
#undef PG8_SCHED
}
}
#ifndef PG8_SP2
#define PG8_SP2 true
#endif
#ifndef PG8_ALIGN
#define PG8_ALIGN true
#endif
constexpr int NWAVES = 8;
constexpr int NB = 2, NS = 4096, DM = 4096, MR = NB * NS;
constexpr int NHQ = 48, NHA = 24, HD = 128, QKVC = 3 * NHQ * HD;
constexpr int DFF = 14336, F2 = 2 * DFF;
constexpr float ATT_SCALE = 0.08838834764831845f;
constexpr float NORM_EPS = 1e-5f;
constexpr size_t MiB = 1u << 20;
constexpr size_t WS_CTL = 0, CTL_ZERO_BYTES = 2 * MiB;
constexpr size_t WS_SSQ = 256 * 1024, SSQ_SITE = 32 * 1024;
constexpr size_t WS_VSQ = 512 * 1024;
constexpr size_t WS_AMAX = 1 * MiB;
constexpr int AM_WIN = 0, AM_WOUT = 18432, AM_SGWIN = 22528, AM_WUP = 30720, AM_SGWOUT = 30720 + 2 * 28672, AM_END = AM_SGWOUT + 4096;
constexpr size_t WS_SW = 3 * MiB;
constexpr size_t WS_SSX = 1536 * 1024;
constexpr size_t WS_VSX = 1664 * 1024;
constexpr size_t WS_SAH = 4 * MiB;
constexpr size_t WS_ROPE = 2 * MiB;
constexpr size_t WS_KMEAN = 576 * 1024;
constexpr size_t WS_SS = 3 * MiB, SS_SITE = 2 * MiB;
constexpr size_t WS_VS = 13 * MiB;
constexpr size_t WS_SEL = 18 * MiB;
constexpr size_t WS_LSE = 20 * MiB;
constexpr size_t WS_WIN = 32 * MiB;
constexpr size_t WS_WOUT = 176 * MiB;
constexpr size_t WS_SGWIN = 208 * MiB;
constexpr size_t WS_SGWOUT = 272 * MiB;
constexpr size_t WS_WUP = 304 * MiB, WUP_L = 224 * MiB;
constexpr size_t WS_WDOWN = 752 * MiB, WDOWN_L = 112 * MiB;
constexpr size_t WS_XB = 976 * MiB;
constexpr size_t WS_H = 1040 * MiB;
constexpr size_t WS_QKV = 1168 * MiB;
constexpr size_t WS_U = WS_QKV, WS_V = WS_QKV + 64 * MiB;
constexpr size_t WS_O = 1456 * MiB;
constexpr size_t WS_G = 1520 * MiB;
constexpr size_t WS_DO = WS_G;
constexpr size_t WS_APRE = 1744 * MiB;
constexpr size_t WS_TOP = WS_APRE + 128 * MiB, WS_BOT = WS_APRE + 136 * MiB;
constexpr size_t WS_WUP8 = 2192 * MiB, WUP8_L = 112 * MiB;
constexpr size_t WS_HQ8 = 2416 * MiB;
constexpr size_t WS_WIN8 = 2448 * MiB;
constexpr size_t WS_WOUT8 = 2520 * MiB, WS_SGWOUT8 = 2536 * MiB;
constexpr size_t WS_OQ8 = 2552 * MiB;
constexpr size_t WS_SAO = WS_SAH + 65536, WS_SAO2 = WS_SAH + 131072;
constexpr size_t WS_END = 2584 * MiB;
constexpr int RING_OFF = 0, RING_BYTES = 131072;
constexpr int SCR_BYTES = 133120;
constexpr int LDSCTL_OFF = SCR_BYTES, MISC_OFF = LDSCTL_OFF + 320;
constexpr int XTRA_OFF = SCR_BYTES + 1024;
constexpr int LDS_BYTES = 147456;
static_assert(MISC_OFF + 128 <= XTRA_OFF, "LDS map");
constexpr int CW_TMO = 0, CW_BAR = 4096;

#define GAS __attribute__((address_space(1)))
#define LAS __attribute__((address_space(3)))
typedef unsigned short bf16;
typedef unsigned v4u __attribute__((ext_vector_type(4)));
typedef unsigned v2u __attribute__((ext_vector_type(2)));
typedef float f32x4 __attribute__((ext_vector_type(4)));
typedef float f32x2 __attribute__((ext_vector_type(2)));
#define LDS_WAIT() asm volatile("s_waitcnt lgkmcnt(0)" ::: "memory")
#define VM_WAIT() asm volatile("s_waitcnt vmcnt(0)" ::: "memory")
__device__ __forceinline__ unsigned f2bf(float f) { unsigned u = __builtin_bit_cast(unsigned, f); return (u + 0x7fffu + ((u >> 16) & 1u)) >> 16; }
__device__ __forceinline__ unsigned pk2(float lo, float hi) { return f2bf(lo) | (f2bf(hi) << 16); }
__device__ __forceinline__ float bflo(unsigned w) { return __builtin_bit_cast(float, w << 16); }
__device__ __forceinline__ float bfhi(unsigned w) { return __builtin_bit_cast(float, w & 0xffff0000u); }
__device__ __forceinline__ float bf1(bf16 h) { return __builtin_bit_cast(float, (unsigned)h << 16); }
namespace att {
typedef unsigned short bf16;
typedef short bf16x8 __attribute__((ext_vector_type(8)));
typedef short s16x4 __attribute__((ext_vector_type(4)));
typedef float f32x16 __attribute__((ext_vector_type(16)));
typedef float f32x4 __attribute__((ext_vector_type(4)));
typedef unsigned u32x4 __attribute__((ext_vector_type(4)));
template <class A, class Bt> struct same_t { static constexpr bool v = false; };
template <class A> struct same_t<A, A> { static constexpr bool v = true; };
constexpr int D = 128;
constexpr float SCALE = 0.08838834764831845f, THR = 8.f;
constexpr int NW = 8, QBLK = 32, KVBLK = 64, QB = NW * QBLK;
constexpr int SHM_V = KVBLK * D * 2, SHM_K = KVBLK * D * 2;
constexpr int ATT_LDS_BYTES = 2 * SHM_V + 2 * SHM_K + NW * 64 * 4;
#define KSWZ(row, colB) ((row) * 256 + ((colB) ^ (((row) & 7) << 4)))
#define SBAR() __builtin_amdgcn_sched_barrier(0)
__device__ __forceinline__ int v_st(int k, int c) { const int kk = (k & ~0xC) | ((k & 4) << 1) | ((k & 8) >> 1); return ((kk >> 3) * 4 + (c >> 5)) * 512 + ((kk & 7) * 32 + (c & 31)) * 2; }
__device__ __forceinline__ int v_rd_base(int lane) { return ((lane & 3) << 3) | (((lane >> 2) & 3) << 6) | (((lane >> 4) & 1) << 5) | (((lane >> 5) & 1) << 8); }
constexpr int v_rd_off(int d0, int ks, int half) { return d0 * 512 + ks * 4096 + half * 2048; }
__device__ __forceinline__ int crow(int r, int hi) { return (r & 3) + 8 * (r >> 2) + 4 * hi; }
__device__ __forceinline__ unsigned cvtpk(float lo, float hi) {
    unsigned r; asm volatile("v_cvt_pk_bf16_f32 %0, %1, %2" : "=v"(r) : "v"(lo), "v"(hi)); return r;
}
__device__ __forceinline__ bf16x8 pack8(f32x4 a, f32x4 b) {
    u32x4 w = {cvtpk(a[0], a[1]), cvtpk(a[2], a[3]), cvtpk(b[0], b[1]), cvtpk(b[2], b[3])};
    return *reinterpret_cast<bf16x8*>(&w);
}
template <class T> __device__ __forceinline__ bf16x8 load8(const T* p) {
    if constexpr (same_t<T, float>::v) { return pack8(*(const f32x4*)p, *(const f32x4*)(p + 4)); }
    else { return *reinterpret_cast<const bf16x8*>(p); }
}
__device__ __forceinline__ void mask_tile(f32x16& p0, f32x16& p1, int dq, unsigned W) {
    const float NEG = -__builtin_inff();
#pragma unroll
    for (int r = 0; r < 16; ++r) {
        const int c = (r & 3) + 8 * (r >> 2);
        if ((unsigned)(dq - c) >= W) p0[r] = NEG;
        if ((unsigned)(dq - c - 32) >= W) p1[r] = NEG;
    }
}
__device__ __forceinline__ void partialSM(f32x16& p0, f32x16& p1, float& m_reg, float& mn, float& alpha, bool dead = false) {
    float pmax = p0[0]; for (int r = 1; r < 16; ++r) pmax = fmaxf(pmax, p0[r]); for (int r = 0; r < 16; ++r) pmax = fmaxf(pmax, p1[r]);
    { auto rr = __builtin_amdgcn_permlane32_swap(__float_as_uint(pmax), __float_as_uint(pmax), false, false);
      pmax = fmaxf(__uint_as_float(rr[0]), __uint_as_float(rr[1])); }
    if (dead) pmax = -__builtin_inff();
    constexpr float C2 = 1.4426950408889634f * SCALE;
    if (__builtin_expect(__all((pmax - m_reg) * SCALE <= THR), 1)) { mn = m_reg; alpha = 1.f; }
    else { mn = fmaxf(m_reg, pmax); alpha = __builtin_amdgcn_exp2f((m_reg - mn) * C2); m_reg = mn; }
    const float mnL = dead ? -__builtin_inff() : -mn * C2;
    for (int r = 0; r < 16; ++r) p0[r] = fmaf(p0[r], C2, mnL); for (int r = 0; r < 16; ++r) p1[r] = fmaf(p1[r], C2, mnL);
    for (int r = 0; r < 16; ++r) p0[r] = __builtin_amdgcn_exp2f(p0[r]);
}
__device__ __forceinline__ void finishSM(f32x16& p0, f32x16& p1, float alpha, float& l_reg, bf16x8& pa0, bf16x8& pa1, bf16x8& pa2, bf16x8& pa3) {
    for (int r = 0; r < 16; ++r) p1[r] = __builtin_amdgcn_exp2f(p1[r]);
    float ps = 0; for (int r = 0; r < 16; ++r) ps += p0[r]; for (int r = 0; r < 16; ++r) ps += p1[r];
    { auto rr = __builtin_amdgcn_permlane32_swap(__float_as_uint(ps), __float_as_uint(ps), false, false);
      ps = __uint_as_float(rr[0]) + __uint_as_float(rr[1]); }
    l_reg = l_reg * alpha + ps;
#define PK4(P, B_, OUT) do { unsigned a0 = cvtpk(P[B_+0], P[B_+1]), a1 = cvtpk(P[B_+2], P[B_+3]);                          \
        unsigned b0 = cvtpk(P[B_+4], P[B_+5]), b1 = cvtpk(P[B_+6], P[B_+7]);                                             \
        auto r0 = __builtin_amdgcn_permlane32_swap(a0, b0, false, false); auto r1 = __builtin_amdgcn_permlane32_swap(a1, b1, false, false); \
        u32x4 w = {r0[0], r1[0], r0[1], r1[1]}; OUT = *reinterpret_cast<bf16x8*>(&w); } while (0)
    PK4(p0, 0, pa0); PK4(p0, 8, pa1); PK4(p1, 0, pa2); PK4(p1, 8, pa3);
#undef PK4
}
template <int KB, bool SK>
__device__ __forceinline__ void qkt(f32x16& p0, f32x16& p1, const char* K_lds, int r32, int hi, const bf16x8* qr, bool act) {
    if (SK && !act) { const float NEG = -__builtin_inff();
#pragma unroll
        for (int r = 0; r < 16; ++r) { p0[r] = NEG; p1[r] = NEG; } return; }
    p0 = f32x16{}; p1 = f32x16{};
    const char* kb[4];
#pragma unroll
    for (int dd = 0; dd < 4; ++dd) kb[dd] = K_lds + KB * SHM_K + KSWZ(r32, (dd * 16 + hi * 8) * 2);
#pragma unroll
    for (int d0 = 0; d0 < 8; ++d0) { const char* a = kb[d0 & 3] + (d0 >> 2) * 128;
        bf16x8 b0 = *reinterpret_cast<const bf16x8*>(a);
        bf16x8 b1 = *reinterpret_cast<const bf16x8*>(a + 32 * 256);
        p0 = __builtin_amdgcn_mfma_f32_32x32x16_bf16(b0, qr[d0], p0, 0, 0, 0);
        p1 = __builtin_amdgcn_mfma_f32_32x32x16_bf16(b1, qr[d0], p1, 0, 0, 0); }
}
template <int VB, bool SK>
__device__ __forceinline__ void pv_tile(f32x16* o, int vb0, bf16x8 pa0, bf16x8 pa1, bf16x8 pa2, bf16x8 pa3, bool act) {
    if (SK && !act) return;
#define TRRD(dst, off) asm volatile("ds_read_b64_tr_b16 %0, %1 offset:%2" : "=&v"(dst) : "v"(vb0), "i"(off) : "memory")
#define PV_D0(d0) do { s16x4 l0, l1, l2, l3, h0, h1, h2, h3; constexpr int b_ = VB * SHM_V + v_rd_off(d0, 0, 0);     \
        TRRD(l0, b_); TRRD(h0, b_ + 2048); TRRD(l1, b_ + 4096); TRRD(h1, b_ + 6144); TRRD(l2, b_ + 8192); TRRD(h2, b_ + 10240); TRRD(l3, b_ + 12288); TRRD(h3, b_ + 14336); \
        asm volatile("s_waitcnt lgkmcnt(0)" ::: "memory"); SBAR();                 \
        o[d0] = __builtin_amdgcn_mfma_f32_32x32x16_bf16(pa0, (bf16x8){l0[0], l0[1], l0[2], l0[3], h0[0], h0[1], h0[2], h0[3]}, o[d0], 0, 0, 0);   \
        o[d0] = __builtin_amdgcn_mfma_f32_32x32x16_bf16(pa1, (bf16x8){l1[0], l1[1], l1[2], l1[3], h1[0], h1[1], h1[2], h1[3]}, o[d0], 0, 0, 0);   \
        o[d0] = __builtin_amdgcn_mfma_f32_32x32x16_bf16(pa2, (bf16x8){l2[0], l2[1], l2[2], l2[3], h2[0], h2[1], h2[2], h2[3]}, o[d0], 0, 0, 0);   \
        o[d0] = __builtin_amdgcn_mfma_f32_32x32x16_bf16(pa3, (bf16x8){l3[0], l3[1], l3[2], l3[3], h3[0], h3[1], h3[2], h3[3]}, o[d0], 0, 0, 0); } while (0)
    PV_D0(0); PV_D0(1); PV_D0(2); PV_D0(3);
#undef PV_D0
#undef TRRD
}

template <class TIn, class TOut> struct BlockRef { const TIn* Q; const TIn* K; const TIn* V; TOut* O; int P0; const __attribute__((address_space(3))) unsigned short* sel; float* L; };
template <class TIn> struct Seam {
    bf16x8 qr[8];
    bf16x8 st_v0, st_v1, st_k0, st_k1; f32x4 sf0, sf1, sf2, sf3;
    f32x4 tq[16];
};
__device__ __forceinline__ int swa_jlo(int P0, int W) { const int lowk = P0 - W + 1; return lowk > 0 ? lowk / KVBLK : 0; }
#define ROW(p, k0, rr) ((p) + (size_t)((k0) + (rr)) * rs_ + sc)
#define ROWN(p, k0, rr) ((p) + (size_t)((k0) + (rr)) * rsn_ + sc)
#define VMW() asm volatile("s_waitcnt vmcnt(0)" ::: "memory")
#define VMWN(n) asm volatile("s_waitcnt vmcnt(%0)" :: "i"(n) : "memory")
#define SLOAD_H(Kp, Vp, k0) do { S.st_v0 = load8<TIn>(ROW(Vp, k0, sr)); S.st_v1 = load8<TIn>(ROW(Vp, k0, 32 + sr));              \
                         S.st_k0 = load8<TIn>(ROW(Kp, k0, sr)); S.st_k1 = load8<TIn>(ROW(Kp, k0, 32 + sr)); } while (0)
#define SLOAD_HN(Kp, Vp, k0) do { S.st_v0 = load8<TIn>(ROWN(Vp, k0, sr)); S.st_v1 = load8<TIn>(ROWN(Vp, k0, 32 + sr));              \
                         S.st_k0 = load8<TIn>(ROWN(Kp, k0, sr)); S.st_k1 = load8<TIn>(ROWN(Kp, k0, 32 + sr)); } while (0)
#define SWRITE_HK(bf) do { *(bf16x8*)(K_lds + (bf) * SHM_K + kws) = S.st_k0; *(bf16x8*)(K_lds + (bf) * SHM_K + kws + 32 * 256) = S.st_k1; } while (0)
#define SWRITE_HV(bf) do { *(bf16x8*)(V_lds + (bf) * SHM_V + vst0) = S.st_v0; *(bf16x8*)(V_lds + (bf) * SHM_V + vst1) = S.st_v1; } while (0)
#define SWRITE_H(bf) do { SWRITE_HV(bf); SWRITE_HK(bf); } while (0)
#define SLOAD_F(p, k0) do { S.sf0 = *(const f32x4*)ROW(p, k0, sr); S.sf1 = *(const f32x4*)(ROW(p, k0, sr) + 4);                \
                            S.sf2 = *(const f32x4*)ROW(p, k0, 32 + sr); S.sf3 = *(const f32x4*)(ROW(p, k0, 32 + sr) + 4); } while (0)
#define SWRITE_KF(bf) do { *(bf16x8*)(K_lds + (bf) * SHM_K + kws) = pack8(S.sf0, S.sf1); *(bf16x8*)(K_lds + (bf) * SHM_K + kws + 32 * 256) = pack8(S.sf2, S.sf3); } while (0)
#define SWRITE_VF(bf) do { *(bf16x8*)(V_lds + (bf) * SHM_V + vst0) = pack8(S.sf0, S.sf1); *(bf16x8*)(V_lds + (bf) * SHM_V + vst1) = pack8(S.sf2, S.sf3); } while (0)
template <class TIn, class TOut, int RSC, int W>
__device__ __forceinline__ void causal_swa_prime(const BlockRef<TIn, TOut>& cur, char* lds, Seam<TIn>& S) {
    constexpr bool F32 = same_t<TIn, float>::v;
    int tid_ = threadIdx.x; asm volatile("" : "+v"(tid_));
    const int tid = tid_, wid = __builtin_amdgcn_readfirstlane(tid >> 6), lane = tid & 63, r32 = lane & 31, hi = lane >> 5;
    const int sr = tid >> 4, sc = (tid & 15) * 8, kws = KSWZ(sr, sc * 2); char* K_lds = lds + 2 * SHM_V;
    const int kb0 = swa_jlo(cur.P0, W) * KVBLK; constexpr int rs_ = RSC;
    for (int d0 = 0; d0 < 8; ++d0) S.qr[d0] = load8<TIn>(cur.Q + (size_t)(wid * QBLK + r32) * rs_ + d0 * 16 + hi * 8);
    if constexpr (F32) { SLOAD_F((const float*)cur.K, kb0); VMW(); SWRITE_KF(0); SBAR(); SLOAD_F((const float*)cur.V, kb0); }
    else { SLOAD_H(cur.K, cur.V, kb0); VMW(); SWRITE_HK(0); }
    __syncthreads();
}
template <class TIn, class TOut, bool SKP, int MODE, int RSC, int RSN, int OSC, int W, int WN, int skv>
__device__ __forceinline__ void causal_swa_block(const BlockRef<TIn, TOut>& cur, const BlockRef<TIn, TOut>& nxt, char* lds, Seam<TIn>& S) {
    constexpr bool F32 = same_t<TIn, float>::v; static_assert(!F32, "bf16 inputs only in this build");
    constexpr int rs_ = RSC, rsn_ = RSN, os_ = OSC;
    int tid_ = threadIdx.x; asm volatile("" : "+v"(tid_));
    const int tid = tid_, wid = __builtin_amdgcn_readfirstlane(tid >> 6), lane = tid & 63, r32 = lane & 31, hi = lane >> 5;
    const int j_lo = swa_jlo(cur.P0, W);
    int j_hi = (cur.P0 + QB - 1) / KVBLK + 1; if (j_hi > skv / KVBLK) j_hi = skv / KVBLK;
    const int NT = j_hi - j_lo;
    const int kbn = swa_jlo(nxt.P0, WN) * KVBLK;
    const int qlo = cur.P0 + wid * QBLK, qm = qlo + r32 - 4 * hi;
    char* V_lds = lds; char* K_lds = lds + 2 * SHM_V;
    float* ws = (float*)(lds + 2 * SHM_V + 2 * SHM_K) + wid * 64; float* li_l = ws, * al_l = ws + 32;
    float m_reg = -1e30f, l_reg = 0; f32x16 o[4] = {};
    unsigned selm = 0u; if constexpr (MODE == 0) selm = cur.sel[wid * QBLK + r32];
    bool deadq = false;
    const int sr = tid >> 4, sc = (tid & 15) * 8, vst0 = v_st(sr, sc), vst1 = v_st(32 + sr, sc), kws = KSWZ(sr, sc * 2);
    const int vb0 = (int)(uintptr_t)V_lds + v_rd_base(lane);
    const TIn* Kh = cur.K; const TIn* Vh = cur.V;
#define RESC(a) do { if (__any((a) < 1.f)) { if (hi == 0) al_l[r32] = (a); asm volatile("s_waitcnt lgkmcnt(0)" ::: "memory");              \
                     for (int d_ = 0; d_ < 4; ++d_) for (int r = 0; r < 16; ++r) o[d_][r] *= al_l[crow(r, hi)]; } } while (0)
#define KBASE(t) ((j_lo + (t)) * KVBLK)
#define ACT(t) (KBASE(t) <= qlo + QBLK - 1 && KBASE(t) + KVBLK - 1 >= qlo - W + 1)
#define MASKT(P0_, P1_, t) do { const int kb_ = KBASE(t); if ((!SK || ACT(t)) && (kb_ + KVBLK - 1 > qlo || kb_ <= qlo + QBLK - 1 - W)) mask_tile(P0_, P1_, qm - kb_, (unsigned)W); \
        if constexpr (MODE == 0) { deadq = (kb_ < cur.P0) && (((selm >> (kb_ >> 8)) & 1u) == 0u); } } while (0)
    constexpr int NQL = F32 ? 16 : 8;
    constexpr bool SK = SKP && !F32;
#define SEAM_K0() do { VMWN(NQL); if constexpr (F32) { SWRITE_KF(0); SBAR(); SLOAD_F((const float*)nxt.V, kbn); } else { SWRITE_HK(0); } SBAR(); } while (0)
    f32x16 pA0, pA1, pB0, pB1; float mnA, mnB, alA, alB; bf16x8 pa0, pa1, pa2, pa3;
    if constexpr (F32) { VMW(); SWRITE_VF(0); SBAR(); } else { SWRITE_HV(0); SBAR(); }
    if (NT > 1) { if constexpr (F32) SLOAD_F((const float*)Kh, KBASE(1)); else SLOAD_H(Kh, Vh, KBASE(1)); }
    SBAR(); qkt<0, SK>(pA0, pA1, K_lds, r32, hi, S.qr, ACT(0));
    if constexpr (F32) { if (NT > 1) { VMW(); SWRITE_KF(1); SBAR(); SLOAD_F((const float*)Vh, KBASE(1)); } }
    MASKT(pA0, pA1, 0); partialSM(pA0, pA1, m_reg, mnA, alA, deadq);
    if (NT > 1) { VMW(); if constexpr (F32) { SWRITE_VF(1); SBAR(); if (NT > 2) SLOAD_F((const float*)Kh, KBASE(2)); } else SWRITE_H(1); }
    __syncthreads();
#define HALF_STEP(PX0, PX1, mnX, alX, PY0, PY1, alY, t, KB, VB, SB) do {                                                      \
        SBAR(); qkt<KB, SK>(PX0, PX1, K_lds, r32, hi, S.qr, ACT(t));                                             \
        finishSM(PY0, PY1, alY, l_reg, pa0, pa1, pa2, pa3); SBAR();                                                           \
        if ((t) + 1 < NT) { if constexpr (F32) { VMW(); SWRITE_KF(SB); SBAR(); SLOAD_F((const float*)Vh, KBASE((t) + 1)); }  \
                            else { SLOAD_H(Kh, Vh, KBASE((t) + 1)); } SBAR(); }                                               \
        pv_tile<VB, SK>(o, vb0, pa0, pa1, pa2, pa3, ACT((t) - 1)); MASKT(PX0, PX1, (t)); partialSM(PX0, PX1, m_reg, mnX, alX, deadq);                                        \
        __syncthreads();                                                                                                      \
        if ((t) + 1 < NT) { VMW(); if constexpr (F32) { SWRITE_VF(SB); SBAR(); if ((t) + 2 < NT) SLOAD_F((const float*)Kh, KBASE((t) + 2)); } \
                            else { SWRITE_H(SB); } }                                                                          \
        RESC(alX); __syncthreads(); } while (0)
    for (int t = 1; t + 1 < NT; t += 2) {
        HALF_STEP(pB0, pB1, mnB, alB, pA0, pA1, alA, t, 1, 0, 0);
        HALF_STEP(pA0, pA1, mnA, alA, pB0, pB1, alB, t + 1, 0, 1, 1);
    }
    const bool even = (NT & 1) == 0;
    if (even) { SBAR(); qkt<1, SK>(pB0, pB1, K_lds, r32, hi, S.qr, ACT(NT - 1)); SBAR(); }
#define QROW(e) (nxt.Q + (size_t)(wid * QBLK + r32) * rsn_ + ((e) >> 1) * 16 + hi * 8 + ((e) & 1) * 4)
    if constexpr (F32) { SLOAD_F((const float*)nxt.K, kbn); SBAR();
#pragma unroll
        for (int e = 0; e < 8; ++e) S.tq[e] = *(const f32x4*)QROW(e); }
    else { SLOAD_HN(nxt.K, nxt.V, kbn); SBAR();
#pragma unroll
        for (int d0 = 0; d0 < 8; ++d0) S.qr[d0] = load8<TIn>(nxt.Q + (size_t)(wid * QBLK + r32) * rsn_ + d0 * 16 + hi * 8); }
    SBAR();
    finishSM(pA0, pA1, alA, l_reg, pa0, pa1, pa2, pa3); SBAR();
    if constexpr (F32) {
#pragma unroll
        for (int e = 8; e < 16; ++e) S.tq[e] = *(const f32x4*)QROW(e); SBAR(); }
#undef QROW
    pv_tile<0, SK>(o, vb0, pa0, pa1, pa2, pa3, ACT(even ? NT - 2 : NT - 1));
    if (even) { MASKT(pB0, pB1, NT - 1); partialSM(pB0, pB1, m_reg, mnB, alB, deadq); __syncthreads(); RESC(alB);
        finishSM(pB0, pB1, alB, l_reg, pa0, pa1, pa2, pa3); SBAR(); pv_tile<1, SK>(o, vb0, pa0, pa1, pa2, pa3, ACT(NT - 1)); }
    SBAR(); SEAM_K0();
    if (hi == 0) li_l[r32] = l_reg; asm volatile("s_waitcnt lgkmcnt(0)" ::: "memory");
    if constexpr (MODE == 1) { if (hi == 0) cur.L[(size_t)(wid * QBLK + r32) * (RSC / 128 * 24)] = m_reg * SCALE + __logf(l_reg); }
    float rli[16];
#pragma unroll
    for (int r = 0; r < 16; ++r) rli[r] = __builtin_amdgcn_rcpf(li_l[crow(r, hi)]);
    TOut* Ow = cur.O + (size_t)(wid * QBLK) * os_;
#pragma unroll
    for (int r = 0; r < 16; ++r) { const int orow = crow(r, hi);
#pragma unroll
        for (int d0 = 0; d0 < 4; ++d0) { const float v = o[d0][r] * rli[r];
            if constexpr (same_t<TOut, float>::v) { Ow[(size_t)orow * os_ + d0 * 32 + r32] = v; }
            else { const float vn = __shfl_xor(v, 1);
                   if ((r32 & 1) == 0) *(unsigned*)(Ow + (size_t)orow * os_ + d0 * 32 + r32) = cvtpk(v, vn); } } }
    if constexpr (F32) {
#pragma unroll
        for (int d0 = 0; d0 < 8; ++d0) S.qr[d0] = pack8(S.tq[2 * d0], S.tq[2 * d0 + 1]); }
    __syncthreads();
#undef RESC
#undef KBASE
#undef ACT
#undef MASKT
#undef SEAM_K0
#undef HALF_STEP
}
#undef ROW
#undef ROWN
#undef SLOAD_HN
#undef VMW
#undef VMWN
#undef SLOAD_H
#undef SWRITE_HK
#undef SWRITE_HV
#undef SWRITE_H
#undef SLOAD_F
#undef SWRITE_KF
#undef SWRITE_VF
}
#define XB_TMO      128
#define XB_XCNT(j)  (256  + 64 * (j))
#define XB_XSUB(j)  (1280 + 64 * (j))
#define XB_XGEN(j)  (2304 + 64 * (j))
#define XB_TOP      3328
#define XB_TOPGEN   3392
#define XCD_BAR_WORDS 3456
#define XB_SPIN_CAP (1u << 18)

__device__ __forceinline__ unsigned xb_ld(unsigned* p)              { return __hip_atomic_load(p, __ATOMIC_RELAXED, __HIP_MEMORY_SCOPE_AGENT); }
__device__ __forceinline__ unsigned xb_add(unsigned* p, unsigned v) { return __hip_atomic_fetch_add(p, v, __ATOMIC_RELAXED, __HIP_MEMORY_SCOPE_AGENT); }
__device__ __forceinline__ unsigned xb_xcc_id() { return (unsigned)__builtin_amdgcn_s_getreg((3 << 11) | 20) & 0xFu; }
#define XB_SPIN(cond, bar) do { unsigned _sp = 0; while (cond) { __builtin_amdgcn_s_sleep(1); \
    if ((++_sp & 255u) == 0u) { if (xb_ld(&(bar)[XB_TMO])) break; if (_sp > XB_SPIN_CAP) { atomicAdd(&(bar)[XB_TMO], 1u); break; } } } } while (0)

struct XcdBarrier {
    unsigned* bar; unsigned x;
    volatile LAS unsigned* st;
};

__device__ __forceinline__ XcdBarrier xcd_barrier_post(unsigned* bar, volatile LAS unsigned* st) {
    XcdBarrier b; b.bar = bar; b.x = xb_xcc_id(); b.st = st;
    if (threadIdx.x == 0) (void)xb_add(&bar[XB_XCNT(b.x)], 1u);
    return b;
}
__device__ __forceinline__ void xcd_barrier_complete(unsigned* bar, unsigned x, unsigned& nloc, unsigned& nx) {
    const unsigned G = gridDim.x * gridDim.y * gridDim.z;
    unsigned sum, cnt, mine, sp = 0u;
    for (;;) {
        sum = 0u; cnt = 0u; mine = 0u;
#pragma unroll
        for (unsigned j = 0; j < 16; ++j) { const unsigned c = xb_ld(&bar[XB_XCNT(j)]); sum += c; cnt += (c > 0u) ? 1u : 0u; mine = (j == x) ? c : mine; }
        if (sum == G) break;
        __builtin_amdgcn_s_sleep(1);
        if ((++sp & 255u) == 0u) { if (xb_ld(&bar[XB_TMO])) break; if (sp > XB_SPIN_CAP) { atomicAdd(&bar[XB_TMO], 1u); break; } }
    }
    nloc = mine > 0u ? mine : 1u; nx = cnt > 0u ? cnt : 1u;
}

__device__ __forceinline__ void xcd_barrier(const XcdBarrier& b) {
    asm volatile("s_waitcnt vmcnt(0)" ::: "memory");
    __syncthreads();
    if (threadIdx.x == 0) {
        unsigned* bar = b.bar;
        __builtin_amdgcn_s_waitcnt(0);
        unsigned nloc = b.st[0], nx = b.st[1];
        if (nloc == 0u) { xcd_barrier_complete(bar, b.x, nloc, nx); b.st[0] = nloc; b.st[1] = nx; }
        const unsigned old = xb_add(&bar[XB_XSUB(b.x)], 1u);
        const unsigned gen = old / nloc;
        if (old + 1u == (gen + 1u) * nloc) {
            __builtin_amdgcn_fence(__ATOMIC_RELEASE, "agent");
            asm volatile("s_waitcnt vmcnt(0)" ::: "memory");
            const unsigned og = xb_add(&bar[XB_TOP], 1u);
            const unsigned tg = og / nx;
            if (og + 1u == (tg + 1u) * nx) xb_add(&bar[XB_TOPGEN], 1u);
            else XB_SPIN(xb_ld(&bar[XB_TOPGEN]) == tg, bar);
            __builtin_amdgcn_fence(__ATOMIC_ACQUIRE, "agent");
            xb_add(&bar[XB_XGEN(b.x)], 1u);
            asm volatile("s_waitcnt vmcnt(0)" ::: "memory");
        } else {
            XB_SPIN(xb_ld(&bar[XB_XGEN(b.x)]) == gen, bar);
            __builtin_amdgcn_fence(__ATOMIC_ACQUIRE, "agent");
            asm volatile("s_waitcnt vmcnt(0)" ::: "memory");
        }
    }
    __syncthreads();
}
struct Frame {
    LAS unsigned char* lds;
    volatile LAS unsigned* MISC;
    unsigned* ctl;
    int wave, G, gw, NGW;
    unsigned char* ws;
    const float* x; const int* pos;
    const float *attn_norm, *attn_w_in, *attn_w_out, *sg_norm, *sg_w_in, *sg_b_in, *sg_v_gain, *sg_v_bias, *sg_w_s, *sg_b_s, *sg_w_out, *ffn_norm, *ffn_w_up, *ffn_conv_w, *ffn_conv_b, *ffn_w_down, *final_norm;
    float* out;
};
#define LANE_ID() ((int)__builtin_amdgcn_mbcnt_hi(~0u, __builtin_amdgcn_mbcnt_lo(~0u, 0u)))
__device__ __forceinline__ float wave_sum(float v) {
#pragma unroll
    for (int o = 1; o < 64; o <<= 1) v += __shfl_xor(v, o);
    return v;
}
__device__ __forceinline__ float wave_max(float v) {
#pragma unroll
    for (int o = 1; o < 64; o <<= 1) v = fmaxf(v, __shfl_xor(v, o));
    return v;
}
__device__ __forceinline__ float ss_rstd(const float* ss, int r) { return pg8::rstd_from_ss(ss, r); }

__device__ __forceinline__ unsigned q8m(float x, float inv) { return __builtin_bit_cast(unsigned, __builtin_fmaf(x, inv, 12582912.0f)); }
__device__ __forceinline__ unsigned q8(float x, float inv) { return q8m(x, inv) & 0xffu; }
__device__ __forceinline__ unsigned q8x2(float a, float b, float inv) { return __builtin_amdgcn_perm(q8m(b, inv), q8m(a, inv), 0x0c0c0400u); }
__device__ __forceinline__ unsigned q8x4(float a, float b, float c, float d, float inv) { return __builtin_amdgcn_perm(q8m(b, inv), q8m(a, inv), 0x0c0c0400u) | __builtin_amdgcn_perm(q8m(d, inv), q8m(c, inv), 0x04000c0cu); }
__device__ __forceinline__ void unpack8(const v4u w, float (&f)[8]) { f[0] = bflo(w.x); f[1] = bfhi(w.x); f[2] = bflo(w.y); f[3] = bfhi(w.y); f[4] = bflo(w.z); f[5] = bfhi(w.z); f[6] = bflo(w.w); f[7] = bfhi(w.w); }
struct MapId { __device__ __forceinline__ int operator()(int n) const { return n; } };
struct MapUp { __device__ __forceinline__ int operator()(int n) const { return n < DFF ? ((n >> 7) << 8) + (n & 127) : (((n - DFF) >> 7) << 8) + 128 + ((n - DFF) & 127); } };
template <class RowMap>
__device__ __forceinline__ void transpose_item(const float* W, int K, int N, const float* gain, bf16* WT, RowMap rm, LAS float* scr, int item, int lane, unsigned* amax = nullptr) {
    const int nblk = N / 64, kb = item / nblk, nb = item - kb * nblk, k0 = 64 * kb, n0 = 64 * nb;
    const int lr = lane >> 4, lc = (lane & 15) * 4;
    f32x4 v[16];
#pragma unroll
    for (int i = 0; i < 16; ++i) v[i] = __builtin_nontemporal_load((const f32x4*)(W + (size_t)(k0 + 4 * i + lr) * N + n0 + lc));
#pragma unroll
    for (int i = 0; i < 16; ++i) { const int kk = 4 * i + lr; f32x4 x = v[i]; if (gain) x = x * gain[k0 + kk]; LAS float* d = scr + kk * 65 + lc; d[0] = x[0]; d[1] = x[1]; d[2] = x[2]; d[3] = x[3]; }
    LDS_WAIT(); asm volatile("" ::: "memory");
    const int c = lane & 7;
#pragma unroll
    for (int j = 0; j < 8; ++j) { const int n = (lane >> 3) + 8 * j; const LAS float* s = scr + (8 * c) * 65 + n;
        v4u o; o.x = pk2(s[0 * 65], s[1 * 65]); o.y = pk2(s[2 * 65], s[3 * 65]); o.z = pk2(s[4 * 65], s[5 * 65]); o.w = pk2(s[6 * 65], s[7 * 65]);
        *(v4u*)(WT + (size_t)rm(n0 + n) * K + k0 + 8 * c) = o;
        if (amax) {
            float mx = fmaxf(fmaxf(fmaxf(fabsf(s[0 * 65]), fabsf(s[1 * 65])), fmaxf(fabsf(s[2 * 65]), fabsf(s[3 * 65]))), fmaxf(fmaxf(fabsf(s[4 * 65]), fabsf(s[5 * 65])), fmaxf(fabsf(s[6 * 65]), fabsf(s[7 * 65]))));
            mx = fmaxf(mx, __shfl_xor(mx, 1)); mx = fmaxf(mx, __shfl_xor(mx, 2)); mx = fmaxf(mx, __shfl_xor(mx, 4));
            if (c == 0) atomicMax(amax + rm(n0 + n), __builtin_bit_cast(unsigned, mx));
        } }
    LDS_WAIT(); asm volatile("" ::: "memory");
}
__device__ __forceinline__ void sincos_d(double a, double& sn, double& cs) {
    const double n = __builtin_rint(a * 0.15915494309189535);
    const double r = a - n * 6.283185307179586;
    const double r2 = r * r;
    double ts = r, tc = 1.0, s = r, c = 1.0;
#pragma unroll
    for (int k = 1; k <= 15; ++k) { tc = -tc * r2 / (double)((2 * k - 1) * (2 * k)); ts = -ts * r2 / (double)((2 * k) * (2 * k + 1)); c += tc; s += ts; }
    sn = s; cs = c;
}
struct TItem { const float* W; const float* gain; bf16* WT; unsigned* amax; int K, N, mapup, k0, n0; };
__device__ __forceinline__ bool titem_decode(const Frame& F, int it, TItem& t) {
    constexpr int I_SQ = 64 * (DM / 64), I_SGIN = 64 * (2 * DM / 64), I_DN = (DFF / 64) * (DM / 64);
    constexpr int NITEMS = I_SGIN + I_SQ + 2 * I_DN;
    if (it >= NITEMS) return false;
    int r = it; t.mapup = 0; t.amax = nullptr; t.gain = nullptr; t.K = DM;
    if (r < I_SGIN) { t.W = F.sg_w_in; t.N = 2 * DM; t.gain = F.sg_norm; t.WT = (bf16*)(F.ws + WS_SGWIN); }
    else if ((r -= I_SGIN) < I_SQ) { t.W = F.sg_w_out; t.N = DM; t.WT = (bf16*)(F.ws + WS_SGWOUT); }
    else if ((r -= I_SQ) < I_DN) { t.W = F.ffn_w_down; t.N = DM; t.K = DFF; t.WT = (bf16*)(F.ws + WS_WDOWN); }
    else { r -= I_DN; t.W = F.ffn_w_down + (size_t)DFF * DM; t.N = DM; t.K = DFF; t.WT = (bf16*)(F.ws + WS_WDOWN + WDOWN_L); }
    const int nblk = t.N / 64, kb = r / nblk, nb = r - kb * nblk; t.k0 = 64 * kb; t.n0 = 64 * nb;
    return true;
}
__device__ __forceinline__ void titem_load(const TItem& t, f32x4 (&v)[16], int lane) {
    const int lr = lane >> 4, lc = (lane & 15) * 4;
#pragma unroll
    for (int i = 0; i < 16; ++i) v[i] = __builtin_nontemporal_load((const f32x4*)(t.W + (size_t)(t.k0 + 4 * i + lr) * t.N + t.n0 + lc));
}
__device__ __forceinline__ void titem_process(const TItem& t, const f32x4 (&v)[16], LAS float* scr, int lane) {
    const int lr = lane >> 4, lc = (lane & 15) * 4;
#pragma unroll
    for (int i = 0; i < 16; ++i) { const int kk = 4 * i + lr; f32x4 x = v[i]; if (t.gain) x = x * t.gain[t.k0 + kk]; LAS float* d = scr + kk * 65 + lc; d[0] = x[0]; d[1] = x[1]; d[2] = x[2]; d[3] = x[3]; }
    LDS_WAIT(); asm volatile("" ::: "memory");
    const int c = lane & 7;
#pragma unroll
    for (int j = 0; j < 8; ++j) { const int n = (lane >> 3) + 8 * j; const LAS float* s = scr + (8 * c) * 65 + n;
        const int nn = t.n0 + n, drow = t.mapup ? MapUp()(nn) : nn;
        v4u o; o.x = pg8::cvt_pk_bf16(s[0 * 65], s[1 * 65]); o.y = pg8::cvt_pk_bf16(s[2 * 65], s[3 * 65]); o.z = pg8::cvt_pk_bf16(s[4 * 65], s[5 * 65]); o.w = pg8::cvt_pk_bf16(s[6 * 65], s[7 * 65]);
        *(v4u*)(t.WT + (size_t)drow * t.K + t.k0 + 8 * c) = o;
        if (t.amax) {
            float mx = fmaxf(fmaxf(fmaxf(fabsf(s[0 * 65]), fabsf(s[1 * 65])), fmaxf(fabsf(s[2 * 65]), fabsf(s[3 * 65]))), fmaxf(fmaxf(fabsf(s[4 * 65]), fabsf(s[5 * 65])), fmaxf(fabsf(s[6 * 65]), fabsf(s[7 * 65]))));
            mx = fmaxf(mx, __shfl_xor(mx, 1)); mx = fmaxf(mx, __shfl_xor(mx, 2)); mx = fmaxf(mx, __shfl_xor(mx, 4));
            if (c == 0) atomicMax(t.amax + drow, __builtin_bit_cast(unsigned, mx));
        } }
    LDS_WAIT(); asm volatile("" ::: "memory");
}
__device__ __forceinline__ void qw_load(const bf16* src, int n, v4u (&v)[8]) {
    const v4u* s = (const v4u*)(src + (size_t)n * DM) + LANE_ID();
#pragma unroll
    for (int i = 0; i < 8; ++i) v[i] = s[64 * i];
}
__device__ __forceinline__ void qw_store(signed char* dst, const unsigned* amax, float* scale, int n, const v4u (&v)[8]) {
    const float am = __builtin_bit_cast(float, amax[n]), inv = am > 0.f ? 127.0f / am : 0.f;
    if (LANE_ID() == 0) scale[n] = am * (1.0f / 127.0f);
    v2u* d = (v2u*)(dst + (size_t)n * DM) + LANE_ID();
#pragma unroll
    for (int i = 0; i < 8; ++i) { float f[8]; unpack8(v[i], f);
        v2u o; o.x = q8(f[0], inv) | (q8(f[1], inv) << 8) | (q8(f[2], inv) << 16) | (q8(f[3], inv) << 24); o.y = q8(f[4], inv) | (q8(f[5], inv) << 8) | (q8(f[6], inv) << 16) | (q8(f[7], inv) << 24);
        d[64 * i] = o; }
}
__device__ __forceinline__ void quant_weight_rows(Frame& F, const bf16* src, signed char* dst, const unsigned* amax, float* scale, int N) {
    v4u a[8], b[8];
    int n = F.gw;
    if (n < N) qw_load(src, n, a);
    while (n < N) {
        const int n2 = n + F.NGW;
        if (n2 < N) qw_load(src, n2, b);
        qw_store(dst, amax, scale, n, a);
        if (n2 >= N) break;
        n = n2 + F.NGW;
        if (n < N) qw_load(src, n, a);
        qw_store(dst, amax, scale, n2, b);
    }
}
__device__ __forceinline__ void qa_load(const float* src, int m, f32x4 (&v)[16]) {
    const f32x4* s = (const f32x4*)(src + (size_t)m * DM) + LANE_ID();
#pragma unroll
    for (int j = 0; j < 16; ++j) v[j] = s[64 * j];
}
__device__ __forceinline__ void qa_store(signed char* dst, float* scale, float* ssq, int m, const f32x4 (&v)[16]) {
    unsigned* d = (unsigned*)(dst + (size_t)m * DM) + LANE_ID();
    float am = 0.f, sq = 0.f;
#pragma unroll
    for (int j = 0; j < 16; ++j) { am = fmaxf(am, fmaxf(fmaxf(fabsf(v[j][0]), fabsf(v[j][1])), fmaxf(fabsf(v[j][2]), fabsf(v[j][3]))));
        sq += (v[j][0] * v[j][0] + v[j][1] * v[j][1]) + (v[j][2] * v[j][2] + v[j][3] * v[j][3]); }
    am = wave_max(am); sq = wave_sum(sq);
    const float inv = am > 0.f ? 127.0f / am : 0.f;
    if (LANE_ID() == 0) { scale[m] = am * (1.0f / 127.0f); ssq[m] = sq; }
#pragma unroll
    for (int j = 0; j < 16; ++j) d[64 * j] = q8(v[j][0], inv) | (q8(v[j][1], inv) << 8) | (q8(v[j][2], inv) << 16) | (q8(v[j][3], inv) << 24);
}
__device__ __forceinline__ void quant_act_rows(Frame& F, const float* src, signed char* dst, float* scale, float* ssq) {
    f32x4 a[16], b[16];
    int m = F.gw;
    if (m < MR) qa_load(src, m, a);
    while (m < MR) {
        const int m2 = m + F.NGW;
        if (m2 < MR) qa_load(src, m2, b);
        qa_store(dst, scale, ssq, m, a);
        if (m2 >= MR) break;
        m = m2 + F.NGW;
        if (m < MR) qa_load(src, m, a);
        qa_store(dst, scale, ssq, m2, b);
    }
}
__device__ __forceinline__ void qh_store(signed char* dst, float* scale, float* ssq, int m, const v4u (&v)[8]) {
    v2u* d = (v2u*)(dst + (size_t)m * DM) + LANE_ID();
    float am = 0.f, sq = 0.f;
#pragma unroll
    for (int i = 0; i < 8; ++i) { float f[8]; unpack8(v[i], f);
#pragma unroll
        for (int e = 0; e < 8; ++e) { am = fmaxf(am, fabsf(f[e])); sq += f[e] * f[e]; } }
    am = wave_max(am); sq = wave_sum(sq);
    const float inv = am > 0.f ? 127.0f / am : 0.f;
    if (LANE_ID() == 0) { scale[m] = am * (1.0f / 127.0f); ssq[m] = sq; }
#pragma unroll
    for (int i = 0; i < 8; ++i) { float f[8]; unpack8(v[i], f);
        v2u o; o.x = q8(f[0], inv) | (q8(f[1], inv) << 8) | (q8(f[2], inv) << 16) | (q8(f[3], inv) << 24); o.y = q8(f[4], inv) | (q8(f[5], inv) << 8) | (q8(f[6], inv) << 16) | (q8(f[7], inv) << 24);
        d[64 * i] = o; }
}
__device__ __forceinline__ void quant_stream_rows(Frame& F, const bf16* src, signed char* dst, float* scale, float* ssq) {
    v4u a[8], b[8];
    int m = F.gw;
    if (m < MR) qw_load(src, m, a);
    while (m < MR) {
        const int m2 = m + F.NGW;
        if (m2 < MR) qw_load(src, m2, b);
        qh_store(dst, scale, ssq, m, a);
        if (m2 >= MR) break;
        m = m2 + F.NGW;
        if (m < MR) qw_load(src, m, a);
        qh_store(dst, scale, ssq, m2, b);
    }
}
constexpr int STRIP_RS = 8208;
constexpr int STRIP_RS8 = 4112;
struct SItem { const float* W; const float* gain; signed char* dst; float* sw; int N, n0, mapup; float gflag; };
__device__ __forceinline__ bool sitem_decode(const Frame& F, int s, SItem& t) {
    constexpr int S_WIN = QKVC / 32, S_SQ = DM / 32, S_UP = F2 / 32;
    if (s >= S_WIN + S_SQ + 2 * S_UP) return false;
    float* SW = (float*)(F.ws + WS_SW);
    int r = s; t.mapup = 0; t.gflag = 1.0f;
    if (r < S_WIN) { t.W = F.attn_w_in; t.N = QKVC; t.gain = F.attn_norm; t.dst = (signed char*)(F.ws + WS_WIN8); t.sw = SW + AM_WIN; }
    else if ((r -= S_WIN) < S_SQ) { t.W = F.attn_w_out; t.N = DM; t.gain = F.attn_norm; t.gflag = 0.0f; t.dst = (signed char*)(F.ws + WS_WOUT8); t.sw = SW + AM_WOUT; }
    else if ((r -= S_SQ) < S_UP) { t.W = F.ffn_w_up; t.N = F2; t.gain = F.ffn_norm; t.dst = (signed char*)(F.ws + WS_WUP8); t.sw = SW + AM_WUP; t.mapup = 1; }
    else { r -= S_UP; t.W = F.ffn_w_up + (size_t)DM * F2; t.N = F2; t.gain = F.ffn_norm + DM; t.dst = (signed char*)(F.ws + WS_WUP8 + WUP8_L); t.sw = SW + AM_WUP + F2; t.mapup = 1; }
    t.n0 = 32 * r;
    return true;
}
__device__ __forceinline__ void sbatch_load(const SItem& t, int h, f32x4 (&v)[16], f32x2 (&g)[4], int tid) {
    const int q = tid & 3, rr = tid >> 2;
    const unsigned voff = (unsigned)((2 * rr) * t.N + t.n0 + 8 * q) * 4u;
#pragma unroll
    for (int p = 0; p < 4; ++p) { const int kb = h * 1024 + p * 256;
        const char* b0 = (const char*)(t.W + (size_t)kb * t.N); const char* b1 = (const char*)(t.W + (size_t)(kb + 1) * t.N);
        v[4 * p] = *(const f32x4*)(b0 + voff); v[4 * p + 1] = *(const f32x4*)(b0 + voff + 16);
        v[4 * p + 2] = *(const f32x4*)(b1 + voff); v[4 * p + 3] = *(const f32x4*)(b1 + voff + 16);
        const f32x2 gv = *(const f32x2*)((const char*)(t.gain + kb) + (unsigned)(8 * rr));
        g[p] = gv; }
}
__device__ __forceinline__ void sbatch_park(int h, const f32x4 (&v)[16], const f32x2 (&g)[4], float gflag, LAS unsigned char* strip, v4u (&held)[16], float (&mx)[8], int tid) {
    const int q = tid & 3, rr = tid >> 2;
#pragma unroll
    for (int p = 0; p < 4; ++p) { const int k2 = h * 512 + p * 128 + rr;
        const f32x2 gg = g[p] * gflag + (1.0f - gflag);
        const f32x4 a0 = v[4 * p] * gg.x, b0 = v[4 * p + 1] * gg.x, a1 = v[4 * p + 2] * gg.y, b1 = v[4 * p + 3] * gg.y;
#pragma unroll
        for (int j = 0; j < 4; ++j) { mx[j] = fmaxf(mx[j], fmaxf(fabsf(a0[j]), fabsf(a1[j]))); mx[4 + j] = fmaxf(mx[4 + j], fmaxf(fabsf(b0[j]), fabsf(b1[j])));
            *(LAS unsigned*)(strip + (4 * q + j) * STRIP_RS + k2 * 4) = pg8::cvt_pk_bf16(a0[j], a1[j]); }
        v4u hw; hw.x = pg8::cvt_pk_bf16(b0[0], b1[0]); hw.y = pg8::cvt_pk_bf16(b0[1], b1[1]); hw.z = pg8::cvt_pk_bf16(b0[2], b1[2]); hw.w = pg8::cvt_pk_bf16(b0[3], b1[3]);
        held[4 * h + p] = hw;
#pragma unroll
        for (int j = 0; j < 8; ++j) asm volatile("" : "+v"(mx[j]));
    }
}
__device__ __forceinline__ unsigned q8pair(unsigned w, float inv) { return q8x2(bflo(w), bfhi(w), inv); }
__device__ __forceinline__ unsigned q8quad(unsigned w0, unsigned w1, float inv) { return q8x4(bflo(w0), bfhi(w0), bflo(w1), bfhi(w1), inv); }
template <int MODE> __device__ __forceinline__ void p0_strips(Frame& F) {
    LAS unsigned char* strip = F.lds + RING_OFF;
    LAS unsigned* mxl = (LAS unsigned*)(F.lds + XTRA_OFF);
    const int lane = LANE_ID(); int tid = F.wave * 64 + lane;
    unsigned* ctr = F.ctl + 24;
    LAS unsigned* slot = (LAS unsigned*)(F.lds + XTRA_OFF + 256);
    if (tid < 64) mxl[tid] = 0u;
    if (tid == 0) { slot[0] = __hip_atomic_fetch_add(ctr, 1u, __ATOMIC_RELAXED, __HIP_MEMORY_SCOPE_AGENT); slot[1] = __hip_atomic_fetch_add(ctr, 1u, __ATOMIC_RELAXED, __HIP_MEMORY_SCOPE_AGENT); }
    __syncthreads();
    int s = __builtin_amdgcn_readfirstlane((int)slot[0]), sn = __builtin_amdgcn_readfirstlane((int)slot[1]);
    __syncthreads();
    SItem t; f32x4 va[16], vb[16]; f32x2 ga[4], gb[4];
    bool has = sitem_decode(F, s, t);
    if (has) { sbatch_load(t, 0, va, ga, tid); sbatch_load(t, 1, vb, gb, tid); }
    int par = 0;
    while (has) {
        float mx[8] = {0.f, 0.f, 0.f, 0.f, 0.f, 0.f, 0.f, 0.f};
        v4u held[16];
        asm volatile("" : "+v"(tid));
        unsigned pend = 0u;
        if (tid == 0) pend = __hip_atomic_fetch_add(ctr, 1u, __ATOMIC_RELAXED, __HIP_MEMORY_SCOPE_AGENT);
        sbatch_park(0, va, ga, t.gflag, strip, held, mx, tid); sbatch_load(t, 2, va, ga, tid); asm volatile("" ::: "memory");
        sbatch_park(1, vb, gb, t.gflag, strip, held, mx, tid); sbatch_load(t, 3, vb, gb, tid); asm volatile("" ::: "memory");
        SItem tn; const bool hn = sitem_decode(F, sn, tn);
        sbatch_park(2, va, ga, t.gflag, strip, held, mx, tid); if (hn) sbatch_load(tn, 0, va, ga, tid); asm volatile("" ::: "memory");
        sbatch_park(3, vb, gb, t.gflag, strip, held, mx, tid); if (hn) sbatch_load(tn, 1, vb, gb, tid); asm volatile("" ::: "memory");
#pragma unroll
        for (int j = 0; j < 8; ++j) { float m = mx[j]; m = fmaxf(m, __shfl_xor(m, 4)); m = fmaxf(m, __shfl_xor(m, 8)); m = fmaxf(m, __shfl_xor(m, 16)); m = fmaxf(m, __shfl_xor(m, 32));
            if ((lane >> 2) == 0) __hip_atomic_fetch_max((unsigned*)(mxl + par * 32 + (j >> 2) * 16 + 4 * (lane & 3) + (j & 3)), __builtin_bit_cast(unsigned, m), __ATOMIC_RELAXED, __HIP_MEMORY_SCOPE_WORKGROUP); }
        if (tid == 0) slot[0] = pend;
        __syncthreads();
        const int snn = __builtin_amdgcn_readfirstlane((int)slot[0]);
        if (tid < 32) mxl[(par ^ 1) * 32 + tid] = 0u;
        asm volatile("" : "+v"(tid));
#pragma unroll 4
        for (int r = 0; r < (MODE == 0 ? 16 : 0); ++r) {
            const float am = __builtin_bit_cast(float, mxl[par * 32 + r]), inv = am > 0.f ? 127.0f / am : 0.f;
            const v4u w = *(const LAS v4u*)(strip + r * STRIP_RS + tid * 16);
            v2u o; o.x = q8quad(w.x, w.y, inv); o.y = q8quad(w.z, w.w, inv);
            const int nn = t.n0 + 8 * (r >> 2) + (r & 3), drow = t.mapup ? MapUp()(nn) : nn;
            *(v2u*)(t.dst + (size_t)drow * DM + 8 * tid) = o;
            if (tid == 0) t.sw[drow] = am * (1.0f / 127.0f);
        }
        __syncthreads();
        asm volatile("" : "+v"(tid));
        if (MODE == 0) {
            const int q = tid & 3, rr = tid >> 2;
            float inv[4];
#pragma unroll
            for (int j = 0; j < 4; ++j) { const float am = __builtin_bit_cast(float, mxl[par * 32 + 16 + 4 * q + j]); inv[j] = am > 0.f ? 127.0f / am : 0.f; }
#pragma unroll
            for (int hp = 0; hp < 16; ++hp) { const int k = hp * 256 + 2 * rr;
                *(LAS unsigned short*)(strip + (4 * q + 0) * STRIP_RS8 + k) = (unsigned short)q8pair(held[hp].x, inv[0]);
                *(LAS unsigned short*)(strip + (4 * q + 1) * STRIP_RS8 + k) = (unsigned short)q8pair(held[hp].y, inv[1]);
                *(LAS unsigned short*)(strip + (4 * q + 2) * STRIP_RS8 + k) = (unsigned short)q8pair(held[hp].z, inv[2]);
                *(LAS unsigned short*)(strip + (4 * q + 3) * STRIP_RS8 + k) = (unsigned short)q8pair(held[hp].w, inv[3]); }
        }
        __syncthreads();
        asm volatile("" : "+v"(tid));
#pragma unroll 4
        for (int ps = 0; ps < (MODE == 0 ? 8 : 0); ++ps) { const int r = 2 * ps + (tid >> 8), tt = tid & 255;
            const v4u w = *(const LAS v4u*)(strip + r * STRIP_RS8 + tt * 16);
            const int nn = t.n0 + 8 * (r >> 2) + 4 + (r & 3), drow = t.mapup ? MapUp()(nn) : nn;
            *(v4u*)(t.dst + (size_t)drow * DM + 16 * tt) = w;
            if (tt == 0) t.sw[drow] = __builtin_bit_cast(float, mxl[par * 32 + 16 + r]) * (1.0f / 127.0f);
        }
        __syncthreads();
        t = tn; has = hn; s = sn; sn = snn; par ^= 1;
    }
}
__device__ __forceinline__ void p0_prologue(Frame& F) {
    LAS float* scr = (LAS float*)(F.lds + RING_OFF + F.wave * 16640);
    {
        const int lane = LANE_ID();
        TItem ta, tb; f32x4 va[16], vb[16];
#ifdef PROBE_TR2
        for (int rep = 0; rep < PROBE_TR2; ++rep) {
#else
        {
#endif
        int it = F.gw;
        bool ha = titem_decode(F, it, ta);
        if (ha) titem_load(ta, va, lane);
        while (ha) {
            const bool hb = titem_decode(F, it + F.NGW, tb);
            if (hb) titem_load(tb, vb, lane);
            titem_process(ta, va, scr, lane);
            if (!hb) break;
            it += 2 * F.NGW;
            ha = titem_decode(F, it, ta);
            if (ha) titem_load(ta, va, lane);
            titem_process(tb, vb, scr, lane);
        }
        }
    }
    quant_act_rows(F, F.x, (signed char*)(F.ws + WS_HQ8), (float*)(F.ws + WS_SAH), (float*)(F.ws + WS_SSQ));
    float* rc = (float*)(F.ws + WS_ROPE); float* rs = rc + MR * 16;
    for (int idx = F.gw * 64 + LANE_ID(); idx < MR * 16; idx += F.NGW * 64) {
        const int r = idx >> 4, i = idx & 15;
        double invd = 1.0;
        for (int k = 0; k < i; ++k) invd *= 0.44036660267178046;
        const float inv = (float)invd;
        const float ang = (float)F.pos[r] * inv;
        double sn, cs; sincos_d((double)ang, sn, cs);
        rc[idx] = (float)cs; rs[idx] = (float)sn;
    }
}

__device__ __forceinline__ void p_kmean(Frame& F) {
    const bf16* QKV = (const bf16*)(F.ws + WS_QKV); float* KM = (float*)(F.ws + WS_KMEAN);
    LAS float* red = (LAS float*)(F.lds + RING_OFF);
    for (int item = blockIdx.x; item < NB * NHA * 16; item += F.G) {
        const int j = item & 15, bh = item >> 4, b = bh / NHA, h = bh - b * NHA;
        const bf16* kb = QKV + ((size_t)((1 * 2 + b) * NHQ + h) * NS + 256 * j) * HD;
        const int d = (F.wave * 64 + LANE_ID()) & 127, part = (F.wave * 64 + LANE_ID()) >> 7;
        float s = 0.f;
        for (int i = 0; i < 64; ++i) s += bf1(kb[(size_t)(part * 64 + i) * HD + d]);
        red[part * 128 + d] = s;
        __syncthreads();
        if ((F.wave * 64 + LANE_ID()) < 128) KM[(size_t)item * 128 + (F.wave * 64 + LANE_ID())] = (red[(F.wave * 64 + LANE_ID())] + red[128 + (F.wave * 64 + LANE_ID())] + red[256 + (F.wave * 64 + LANE_ID())] + red[384 + (F.wave * 64 + LANE_ID())]) * (1.0f / 256.0f);
        __syncthreads();
    }
}

__device__ __forceinline__ float dot128(const LAS float* qs, const bf16* krow) {
    float s = 0.f;
#pragma unroll 4
    for (int c = 0; c < 16; ++c) {
        const v4u kv = *(const v4u*)(krow + 8 * c); const LAS float* q8 = qs + 8 * c;
        s += q8[0] * bflo(kv.x) + q8[1] * bfhi(kv.x) + q8[2] * bflo(kv.y) + q8[3] * bfhi(kv.y) + q8[4] * bflo(kv.z) + q8[5] * bfhi(kv.z) + q8[6] * bflo(kv.w) + q8[7] * bfhi(kv.w);
    }
    return s;
}
__device__ __forceinline__ void p_attn_naive(Frame& F, bf16* O) {
    const bf16* QKV = (const bf16*)(F.ws + WS_QKV); const float* KM = (const float*)(F.ws + WS_KMEAN);
    LAS float* qs = (LAS float*)(F.lds + RING_OFF + F.wave * 8192);
    LAS float* ps = qs + 128;
    const int lane = LANE_ID();
    constexpr int NMOBA = NB * NHA * NS, NDIL = NB * 8 * NS;
    const float NEG = -__builtin_inff();
    for (int task = F.gw; task < NMOBA + NDIL; task += F.NGW) {
        if (task < NMOBA) {
            const int b = task / (NHA * NS), rem = task - b * (NHA * NS), h = rem >> 12, t = rem & 4095;
            const bf16* qrow = QKV + ((size_t)((0 * 2 + b) * NHQ + h) * NS + t) * HD;
            const bf16* Kb = QKV + (size_t)((1 * 2 + b) * NHQ + h) * NS * HD;
            const bf16* Vb = QKV + (size_t)((2 * 2 + b) * NHQ + h) * NS * HD;
            { const unsigned w = *(const unsigned*)(qrow + 2 * lane); qs[2 * lane] = bflo(w); qs[2 * lane + 1] = bfhi(w); }
            LDS_WAIT(); asm volatile("" ::: "memory");
            const int qb = t >> 8, tin = t & 255;
            float g = NEG;
            if (lane < qb) { const float* km = KM + ((size_t)((b * NHA + h) * 16 + lane)) * 128; float s = 0.f; for (int d = 0; d < 128; ++d) s += qs[d] * km[d]; g = s; }
            unsigned selmask = 0u;
            if (qb <= 3) selmask = (1u << qb) - 1u;
            else {
#pragma unroll
                for (int rd = 0; rd < 3; ++rd) {
                    float best = g; int bi = lane;
#pragma unroll
                    for (int o = 1; o < 64; o <<= 1) { const float ob = __shfl_xor(best, o); const int oi = __shfl_xor(bi, o); if (ob > best || (ob == best && oi < bi)) { best = ob; bi = oi; } }
                    selmask |= 1u << bi; if (lane == bi) g = NEG;
                }
            }
            float sc[4][4]; int jsel[3];
            unsigned mk = selmask;
#pragma unroll
            for (int sl = 0; sl < 3; ++sl) {
                int j = -1; if (mk) { j = __builtin_ctz(mk); mk &= mk - 1u; }
                jsel[sl] = j;
#pragma unroll
                for (int c = 0; c < 4; ++c) sc[sl][c] = (j >= 0) ? ATT_SCALE * dot128(qs, Kb + (size_t)(256 * j + lane + 64 * c) * HD) : NEG;
            }
#pragma unroll
            for (int c = 0; c < 4; ++c) { const int i = lane + 64 * c; sc[3][c] = (i <= tin) ? ATT_SCALE * dot128(qs, Kb + (size_t)(256 * qb + i) * HD) : NEG; }
            float mx = NEG;
#pragma unroll
            for (int sl = 0; sl < 4; ++sl)
#pragma unroll
                for (int c = 0; c < 4; ++c) mx = fmaxf(mx, sc[sl][c]);
            mx = wave_max(mx);
            float sum = 0.f;
#pragma unroll
            for (int sl = 0; sl < 4; ++sl)
#pragma unroll
                for (int c = 0; c < 4; ++c) { sc[sl][c] = __expf(sc[sl][c] - mx); sum += sc[sl][c]; }
            sum = wave_sum(sum);
            const float inv = 1.0f / sum;
#pragma unroll
            for (int sl = 0; sl < 4; ++sl)
#pragma unroll
                for (int c = 0; c < 4; ++c) ps[sl * 256 + lane + 64 * c] = sc[sl][c] * inv;
            LDS_WAIT(); asm volatile("" ::: "memory");
            float o0 = 0.f, o1 = 0.f;
#pragma unroll
            for (int sl = 0; sl < 3; ++sl) {
                if (jsel[sl] >= 0) { const bf16* vb = Vb + (size_t)(256 * jsel[sl]) * HD + 2 * lane;
                    for (int i = 0; i < 256; ++i) { const float p = ps[sl * 256 + i]; const unsigned w = *(const unsigned*)(vb + (size_t)i * HD); o0 += p * bflo(w); o1 += p * bfhi(w); } }
            }
            { const bf16* vb = Vb + (size_t)(256 * qb) * HD + 2 * lane;
              for (int i = 0; i <= tin; ++i) { const float p = ps[3 * 256 + i]; const unsigned w = *(const unsigned*)(vb + (size_t)i * HD); o0 += p * bflo(w); o1 += p * bfhi(w); } }
            *(unsigned*)(O + (size_t)(b * NS + t) * DM + h * HD + 2 * lane) = pk2(o0, o1);
            LDS_WAIT(); asm volatile("" ::: "memory");
        } else {
            const int td = task - NMOBA, b = td / (8 * NS), rem = td - b * (8 * NS), hh = rem >> 12, t = rem & 4095;
            float lse[3], og0[3], og1[3];
#pragma unroll
            for (int g = 0; g < 3; ++g) {
                const int head = NHA + g * 8 + hh, dil = g == 0 ? 1 : (g == 1 ? 4 : 16);
                const bf16* qrow = QKV + ((size_t)((0 * 2 + b) * NHQ + head) * NS + t) * HD;
                const bf16* Kb = QKV + (size_t)((1 * 2 + b) * NHQ + head) * NS * HD;
                const bf16* Vb = QKV + (size_t)((2 * 2 + b) * NHQ + head) * NS * HD;
                { const unsigned w = *(const unsigned*)(qrow + 2 * lane); qs[2 * lane] = bflo(w); qs[2 * lane + 1] = bfhi(w); }
                LDS_WAIT(); asm volatile("" ::: "memory");
                float sc[3];
#pragma unroll
                for (int c = 0; c < 3; ++c) { const int m = lane + 64 * c; const int kp = t - m * dil; sc[c] = (m <= 128 && kp >= 0) ? ATT_SCALE * dot128(qs, Kb + (size_t)kp * HD) : NEG; }
                float mx = wave_max(fmaxf(fmaxf(sc[0], sc[1]), sc[2]));
                float e0 = __expf(sc[0] - mx), e1 = __expf(sc[1] - mx), e2 = __expf(sc[2] - mx);
                const float sum = wave_sum(e0 + e1 + e2), inv = 1.0f / sum;
                lse[g] = mx + __logf(sum);
                ps[lane] = e0 * inv; ps[lane + 64] = e1 * inv; if (lane == 0) ps[128] = e2 * inv;
                LDS_WAIT(); asm volatile("" ::: "memory");
                const int nb = t / dil, nk = (nb < 128 ? nb : 128) + 1;
                float o0 = 0.f, o1 = 0.f;
                for (int m = 0; m < nk; ++m) { const float p = ps[m]; const unsigned w = *(const unsigned*)(Vb + (size_t)(t - m * dil) * HD + 2 * lane); o0 += p * bflo(w); o1 += p * bfhi(w); }
                og0[g] = o0; og1[g] = o1;
                LDS_WAIT(); asm volatile("" ::: "memory");
            }
            const float ml = fmaxf(fmaxf(lse[0], lse[1]), lse[2]);
            const float w0 = __expf(lse[0] - ml), w1 = __expf(lse[1] - ml), w2 = __expf(lse[2] - ml), wi = 1.0f / (w0 + w1 + w2);
            const float r0 = (w0 * og0[0] + w1 * og0[1] + w2 * og0[2]) * wi, r1 = (w0 * og1[0] + w1 * og1[1] + w2 * og1[2]) * wi;
            *(unsigned*)(O + (size_t)(b * NS + t) * DM + (NHA + hh) * HD + 2 * lane) = pk2(r0, r1);
        }
    }
}

__device__ __forceinline__ float silu_f(float x) { return x / (1.0f + __expf(-x)); }
__device__ __forceinline__ void p_conv(Frame& F, int layer) {
    const bf16* AP = (const bf16*)(F.ws + WS_APRE); bf16* Gb = (bf16*)(F.ws + WS_G);
    const float* cw = F.ffn_conv_w + (size_t)layer * 3 * F2; const float* cb = F.ffn_conv_b + (size_t)layer * F2;
    constexpr int C8 = DFF / 8;
    const size_t total = (size_t)MR * C8;
    for (size_t idx = (size_t)blockIdx.x * 512 + (F.wave * 64 + LANE_ID()); idx < total; idx += (size_t)F.G * 512) {
        const int r = (int)(idx / C8), j0 = (int)(idx - (size_t)r * C8) * 8, s = r & 4095;
        float cg[8], cu[8];
#pragma unroll
        for (int e = 0; e < 8; ++e) { cg[e] = cb[j0 + e]; cu[e] = cb[DFF + j0 + e]; }
#pragma unroll
        for (int tp = 0; tp < 3; ++tp) {
            const int back = 2 - tp;
            if (s >= back) {
                float ag[8], au[8];
                unpack8(*(const v4u*)(AP + (size_t)(r - back) * F2 + j0), ag);
                unpack8(*(const v4u*)(AP + (size_t)(r - back) * F2 + DFF + j0), au);
#pragma unroll
                for (int e = 0; e < 8; ++e) { cg[e] += cw[(size_t)tp * F2 + j0 + e] * ag[e]; cu[e] += cw[(size_t)tp * F2 + DFF + j0 + e] * au[e]; }
            }
        }
        v4u o; o.x = pk2(silu_f(cg[0]) * cu[0], silu_f(cg[1]) * cu[1]); o.y = pk2(silu_f(cg[2]) * cu[2], silu_f(cg[3]) * cu[3]);
        o.z = pk2(silu_f(cg[4]) * cu[4], silu_f(cg[5]) * cu[5]); o.w = pk2(silu_f(cg[6]) * cu[6], silu_f(cg[7]) * cu[7]);
        *(v4u*)(Gb + (size_t)r * DFF + j0) = o;
    }
}

__device__ __forceinline__ void p_sgate_naive(Frame& F) {
    const bf16* U = (const bf16*)(F.ws + WS_U); const bf16* V = (const bf16*)(F.ws + WS_V); const float* VS = (const float*)(F.ws + WS_VSQ); bf16* GT = (bf16*)(F.ws + WS_O);
    LAS float* vn = (LAS float*)(F.lds + RING_OFF);
    LAS float* wsl = vn + 128 * 128;
    LAS float* rstat = (LAS float*)(F.lds + XTRA_OFF);
    for (int item = blockIdx.x; item < 64 * 32; item += F.G) {
        const int bc = item >> 5, g = item & 31, r0 = bc * 128;
        if ((F.wave * 64 + LANE_ID()) < 128) {
            const float s1 = VS[2 * (r0 + (F.wave * 64 + LANE_ID()))], s2 = VS[2 * (r0 + (F.wave * 64 + LANE_ID())) + 1];
            const float mean = s1 * (1.0f / 4096.0f), var = s2 * (1.0f / 4096.0f) - mean * mean;
            rstat[2 * (F.wave * 64 + LANE_ID())] = mean; rstat[2 * (F.wave * 64 + LANE_ID()) + 1] = 1.0f / sqrtf(var + NORM_EPS);
        }
        __syncthreads();
        for (int idx = (F.wave * 64 + LANE_ID()); idx < 128 * 128; idx += 512) {
            const int s = idx >> 7, d = idx & 127, col = g * 128 + d;
            const float v = bf1(V[(size_t)(r0 + s) * DM + col]);
            vn[idx] = (v - rstat[2 * s]) * rstat[2 * s + 1] * F.sg_v_gain[col] + F.sg_v_bias[col];
            wsl[idx] = F.sg_w_s[(size_t)g * 16384 + idx];
        }
        __syncthreads();
        for (int idx = (F.wave * 64 + LANE_ID()); idx < 128 * 128; idx += 512) {
            const int t = idx >> 7, d = idx & 127;
            float a = 0.f;
            for (int s = 0; s <= t; ++s) a += wsl[t * 128 + s] * vn[s * 128 + d];
            const float f = a + F.sg_b_s[g * 128 + t];
            const size_t o = (size_t)(r0 + t) * DM + g * 128 + d;
            GT[o] = (bf16)f2bf(bf1(U[o]) * f);
        }
        __syncthreads();
    }
}

__device__ __forceinline__ void pf_store(Frame& F, int m, const v4u (&v)[8]) {
    const f32x4* gr = (const f32x4*)F.final_norm + 2 * LANE_ID(); f32x4* orow = (f32x4*)(F.out + (size_t)m * DM) + 2 * LANE_ID();
    float sq = 0.f;
#pragma unroll
    for (int i = 0; i < 8; ++i) { float f[8]; unpack8(v[i], f);
#pragma unroll
        for (int e = 0; e < 8; ++e) sq += f[e] * f[e]; }
    sq = wave_sum(sq);
    float rs = 1.0f / sqrtf(sq * (1.0f / 4096.0f) + NORM_EPS);
#ifdef CHECK_ATTN
    if (__hip_atomic_load(F.ctl + 8, __ATOMIC_RELAXED, __HIP_MEMORY_SCOPE_AGENT) > CHECK_ATTN) rs = __builtin_nanf("");
#endif
#pragma unroll
    for (int i = 0; i < 8; ++i) { float f[8]; unpack8(v[i], f);
        orow[128 * i] = (f32x4){f[0], f[1], f[2], f[3]} * rs * gr[128 * i]; orow[128 * i + 1] = (f32x4){f[4], f[5], f[6], f[7]} * rs * gr[128 * i + 1]; }
}
__device__ __forceinline__ void p_final(Frame& F) {
    const bf16* H = (const bf16*)(F.ws + WS_XB);
    v4u a[8], b[8];
    int m = F.gw;
    if (m < MR) qw_load(H, m, a);
    while (m < MR) {
        const int m2 = m + F.NGW;
        if (m2 < MR) qw_load(H, m2, b);
        pf_store(F, m, a);
        if (m2 >= MR) break;
        m = m2 + F.NGW;
        if (m < MR) qw_load(H, m, a);
        pf_store(F, m2, b);
    }
}

__device__ __forceinline__ void quant_bf16_rows(Frame& F, const bf16* src, signed char* dst, float* scale) {
    for (int m = F.gw; m < MR; m += F.NGW) {
        const v4u* s = (const v4u*)(src + (size_t)m * DM) + LANE_ID(); v2u* d = (v2u*)(dst + (size_t)m * DM) + LANE_ID();
        v4u v[8]; float am = 0.f;
#pragma unroll
        for (int i = 0; i < 8; ++i) { v[i] = s[64 * i]; float f[8]; unpack8(v[i], f);
#pragma unroll
            for (int e = 0; e < 8; ++e) am = fmaxf(am, fabsf(f[e])); }
        am = wave_max(am);
        const float inv = am > 0.f ? 127.0f / am : 0.f;
        if (LANE_ID() == 0) scale[m] = am * (1.0f / 127.0f);
#pragma unroll
        for (int i = 0; i < 8; ++i) { float f[8]; unpack8(v[i], f);
            v2u o; o.x = q8(f[0], inv) | (q8(f[1], inv) << 8) | (q8(f[2], inv) << 16) | (q8(f[3], inv) << 24); o.y = q8(f[4], inv) | (q8(f[5], inv) << 8) | (q8(f[6], inv) << 16) | (q8(f[7], inv) << 24);
            d[64 * i] = o; }
    }
}
__device__ __forceinline__ unsigned moba_select(const LAS float* km, const bf16* qrow, int qb) {
    const float NEG = -__builtin_inff();
    if (qb <= 3) return (1u << qb) - 1u;
    float g[16];
#pragma unroll
    for (int j = 0; j < 16; ++j) g[j] = 0.f;
#pragma unroll 1
    for (int c = 0; c < 16; ++c) {
        float q8[8]; unpack8(*(const v4u*)(qrow + 8 * c), q8);
#pragma unroll
        for (int j = 0; j < 16; ++j) {
            const f32x4 k0 = *(const LAS f32x4*)(km + j * 128 + 8 * c), k1 = *(const LAS f32x4*)(km + j * 128 + 8 * c + 4);
            g[j] += q8[0] * k0[0] + q8[1] * k0[1] + q8[2] * k0[2] + q8[3] * k0[3] + q8[4] * k1[0] + q8[5] * k1[1] + q8[6] * k1[2] + q8[7] * k1[3];
        }
    }
#pragma unroll
    for (int j = 0; j < 16; ++j) if (j >= qb) g[j] = NEG;
    unsigned sel = 0u;
#pragma unroll
    for (int rd = 0; rd < 3; ++rd) {
        float best = NEG; unsigned bi = 0u;
#pragma unroll
        for (int j = 0; j < 16; ++j) { const bool take = (((sel >> j) & 1u) == 0u) && (g[j] > best); best = take ? g[j] : best; bi = take ? (unsigned)j : bi; }
        sel |= 1u << bi;
    }
    return sel;
}

typedef att::BlockRef<bf16, bf16> ABR;
#ifndef DIL_SK
#define DIL_SK false
#endif
constexpr int ATT_SEL_OFF = 69632, ATT_KM_OFF = 73728;
__device__ __forceinline__ void moba_unit(int vc, int i, int& bh, int& qb) {
    const int grp = vc >> 4, a = vc & 15;
    const unsigned long long PB = 0x24310cbfed5a9687ull, PC = 0x6579b13024c8aedfull;
    qb = i == 0 ? a : (i == 1 ? (int)((PB >> (4 * a)) & 15ull) : (int)((PC >> (4 * a)) & 15ull));
    bh = 3 * grp + i;
}
__device__ __forceinline__ ABR moba_ref(const Frame& F, int vc, int i, const LAS unsigned short* selL) {
    int bh, qb; moba_unit(vc, i, bh, qb);
    const int b = bh / NHA, h = bh - NHA * b;
    const bf16* QKV = (const bf16*)(F.ws + WS_QKV);
    ABR r;
    r.Q = QKV + ((size_t)((0 * 2 + b) * NHQ + h) * NS + 256 * qb) * HD;
    r.K = QKV + (size_t)((1 * 2 + b) * NHQ + h) * NS * HD;
    r.V = QKV + (size_t)((2 * 2 + b) * NHQ + h) * NS * HD;
    r.O = (bf16*)(F.ws + WS_O) + (size_t)(b * NS + 256 * qb) * DM + h * HD;
    r.P0 = 256 * qb;
    r.sel = selL + 256 * i; r.L = nullptr;
    return r;
}
__device__ __forceinline__ ABR dil_ref(const Frame& F, int vc, int g) {
    const int bhh = vc >> 4, b = bhh >> 3, hh = bhh & 7, lo = vc & 15;
    const int dil = g == 0 ? 1 : (g == 1 ? 4 : 16);
    const int res = g == 0 ? 0 : (g == 1 ? (lo >> 2) : lo), blk = g == 0 ? lo : (g == 1 ? (lo & 3) : 0);
    const int head = NHA + 8 * g + hh, pos0 = res + dil * 256 * blk;
    const bf16* QKV = (const bf16*)(F.ws + WS_QKV);
    ABR r;
    r.Q = QKV + ((size_t)((0 * 2 + b) * NHQ + head) * NS + pos0) * HD;
    r.K = QKV + ((size_t)((1 * 2 + b) * NHQ + head) * NS + res) * HD;
    r.V = QKV + ((size_t)((2 * 2 + b) * NHQ + head) * NS + res) * HD;
    r.O = (bf16*)(F.ws + WS_DO) + (size_t)(b * NS + pos0) * 3072 + g * 1024 + hh * HD;
    r.P0 = 256 * blk;
    r.sel = nullptr; r.L = (float*)(F.ws + WS_LSE) + (size_t)(b * NS + pos0) * 24 + g * 8 + hh;
    return r;
}
__device__ __forceinline__ void p_attn(Frame& F, char* lds) {
#define ATT_VC(bx) ((F.G % 8 == 0 && F.G == 256) ? (((bx) & 7) * 32 + ((bx) >> 3)) : (bx))
    for (int vb = blockIdx.x; vb < 256; vb += F.G) { const int vc = ATT_VC(vb);
#ifndef NO_MOBA
        {
            const bf16* QKVq = (const bf16*)(F.ws + WS_QKV); const float* KM = (const float*)(F.ws + WS_KMEAN);
            LAS float* kmL = (LAS float*)(F.lds + RING_OFF + ATT_KM_OFF); LAS unsigned short* selW = (LAS unsigned short*)(F.lds + RING_OFF + ATT_SEL_OFF);
            const LAS unsigned short* selL = selW;
#ifndef NO_GATEPRE
            for (int idx = (F.wave * 64 + LANE_ID()); idx < 3 * 2048; idx += 512) { int bh, qb; moba_unit(vc, idx >> 11, bh, qb); kmL[idx] = KM[(size_t)bh * 2048 + (idx & 2047)]; }
            __syncthreads();
            for (int qi = (F.wave * 64 + LANE_ID()); qi < 768; qi += 512) { int bh, qb; moba_unit(vc, qi >> 8, bh, qb); const int b = bh / NHA, h = bh - NHA * b;
                selW[qi] = (unsigned short)moba_select(kmL + (qi >> 8) * 2048, QKVq + ((size_t)((0 * 2 + b) * NHQ + h) * NS + 256 * qb + (qi & 255)) * HD, qb); }
            __syncthreads();
#endif
            asm volatile("" ::: "memory");
            int vcb = vc; asm volatile("" : "+s"(vcb));
            att::Seam<bf16> S;
            constexpr int WM = 1 << 30;
            ABR cur = moba_ref(F, vcb, 0, selL);
            att::causal_swa_prime<bf16, bf16, 128, WM>(cur, lds, S);
            for (int i = 0; i < 3; ++i) {
                const ABR nxt = moba_ref(F, vcb, i < 2 ? i + 1 : 2, selL);
                att::causal_swa_block<bf16, bf16, false, 0, 128, 128, DM, WM, WM, NS>(cur, nxt, lds, S);
                cur = nxt;
            }
        }
#endif
    }
    for (int vb = blockIdx.x; vb < 256; vb += F.G) { const int vc = ATT_VC(vb);
#ifndef NO_DIL
        {
            att::Seam<bf16> S;
            const ABR r0 = dil_ref(F, vc, 0), r1 = dil_ref(F, vc, 1), r2 = dil_ref(F, vc, 2);
            att::causal_swa_prime<bf16, bf16, 128, 129>(r0, lds, S);
            att::causal_swa_block<bf16, bf16, DIL_SK, 1, 128, 512, 3072, 129, 129, NS>(r0, r1, lds, S);
            att::causal_swa_block<bf16, bf16, DIL_SK, 1, 512, 2048, 4 * 3072, 129, 129, NS / 4>(r1, r2, lds, S);
            att::causal_swa_block<bf16, bf16, DIL_SK, 1, 2048, 2048, 16 * 3072, 129, 129, NS / 16>(r2, r2, lds, S);
        }
#endif
    }
}
__device__ __forceinline__ void p_dilmerge(Frame& F) {
    const bf16* DO = (const bf16*)(F.ws + WS_DO); const float* LSE = (const float*)(F.ws + WS_LSE); const bf16* O = (const bf16*)(F.ws + WS_O);
    signed char* OQ = (signed char*)(F.ws + WS_OQ8); float* SAO = (float*)(F.ws + WS_SAO);
    const int lane = LANE_ID();
    for (int r = F.gw; r < MR; r += F.NGW) {
        float v[64];
        if (lane < 48) {
#pragma unroll
            for (int i = 0; i < 8; ++i) { float f[8]; unpack8(*(const v4u*)(O + (size_t)r * DM + 64 * lane + 8 * i), f);
#pragma unroll
                for (int e = 0; e < 8; ++e) v[8 * i + e] = f[e]; }
        } else {
            const int hh = (lane - 48) >> 1, c0 = ((lane - 48) & 1) * 64;
            const float l0 = LSE[(size_t)r * 24 + hh], l1 = LSE[(size_t)r * 24 + 8 + hh], l2 = LSE[(size_t)r * 24 + 16 + hh];
            const float ml = fmaxf(fmaxf(l0, l1), l2);
            float w0 = __expf(l0 - ml), w1 = __expf(l1 - ml), w2 = __expf(l2 - ml); const float wi = 1.0f / (w0 + w1 + w2); w0 *= wi; w1 *= wi; w2 *= wi;
            const bf16* d0 = DO + (size_t)r * 3072 + hh * HD + c0;
#pragma unroll
            for (int i = 0; i < 8; ++i) { float a0[8], a1[8], a2[8]; unpack8(*(const v4u*)(d0 + 8 * i), a0); unpack8(*(const v4u*)(d0 + 1024 + 8 * i), a1); unpack8(*(const v4u*)(d0 + 2048 + 8 * i), a2);
#pragma unroll
                for (int e = 0; e < 8; ++e) v[8 * i + e] = w0 * a0[e] + w1 * a1[e] + w2 * a2[e]; }
        }
        float am = 0.f;
#pragma unroll
        for (int i = 0; i < 64; ++i) am = fmaxf(am, fabsf(v[i]));
        am = wave_max(am);
        const float inv = am > 0.f ? 127.0f / am : 0.f;
        if (lane == 0) SAO[r] = am * (1.0f / 127.0f);
        v4u* d = (v4u*)(OQ + (size_t)r * DM + 64 * lane);
#pragma unroll
        for (int i = 0; i < 4; ++i) { v4u o;
            o.x = q8(v[16 * i + 0], inv) | (q8(v[16 * i + 1], inv) << 8) | (q8(v[16 * i + 2], inv) << 16) | (q8(v[16 * i + 3], inv) << 24);
            o.y = q8(v[16 * i + 4], inv) | (q8(v[16 * i + 5], inv) << 8) | (q8(v[16 * i + 6], inv) << 16) | (q8(v[16 * i + 7], inv) << 24);
            o.z = q8(v[16 * i + 8], inv) | (q8(v[16 * i + 9], inv) << 8) | (q8(v[16 * i + 10], inv) << 16) | (q8(v[16 * i + 11], inv) << 24);
            o.w = q8(v[16 * i + 12], inv) | (q8(v[16 * i + 13], inv) << 8) | (q8(v[16 * i + 14], inv) << 16) | (q8(v[16 * i + 15], inv) << 24);
            d[i] = o; }
    }
}
__device__ __forceinline__ void p_convfix(Frame& F, int layer) {
    const float* top = (const float*)(F.ws + WS_TOP); const float* bot = (const float*)(F.ws + WS_BOT); bf16* Gb = (bf16*)(F.ws + WS_G);
    const float* cw = F.ffn_conv_w + (size_t)layer * 3 * F2; const float* cb = F.ffn_conv_b + (size_t)layer * F2;
    constexpr int C4 = DFF / 4, NIT = 30 * C4;
    for (int idx = blockIdx.x * 512 + (F.wave * 64 + LANE_ID()); idx < NIT; idx += F.G * 512) {
        const int pmi = idx / C4, j0 = (idx - pmi * C4) * 4, pm = pmi + 1 + (pmi >= 15 ? 1 : 0);
        f32x4 c0[2], c1[2];
#pragma unroll
        for (int bj = 0; bj < 2; ++bj) {
            const int col = bj * DFF + j0;
            const f32x4 w0 = *(const f32x4*)(cw + col), w1 = *(const f32x4*)(cw + F2 + col), w2 = *(const f32x4*)(cw + 2 * F2 + col), bb = *(const f32x4*)(cb + col);
            const f32x4 am2 = *(const f32x4*)(bot + (size_t)((pm - 1) * 2 + 0) * F2 + col), am1 = *(const f32x4*)(bot + (size_t)((pm - 1) * 2 + 1) * F2 + col);
            const f32x4 a0 = *(const f32x4*)(top + (size_t)(pm * 2 + 0) * F2 + col), a1 = *(const f32x4*)(top + (size_t)(pm * 2 + 1) * F2 + col);
            c0[bj] = bb + w0 * am2 + w1 * am1 + w2 * a0;
            c1[bj] = bb + w0 * am1 + w1 * a0 + w2 * a1;
        }
        v2u o0, o1;
        o0.x = pk2(silu_f(c0[0][0]) * c0[1][0], silu_f(c0[0][1]) * c0[1][1]); o0.y = pk2(silu_f(c0[0][2]) * c0[1][2], silu_f(c0[0][3]) * c0[1][3]);
        o1.x = pk2(silu_f(c1[0][0]) * c1[1][0], silu_f(c1[0][1]) * c1[1][1]); o1.y = pk2(silu_f(c1[0][2]) * c1[1][2], silu_f(c1[0][3]) * c1[1][3]);
        *(v2u*)(Gb + (size_t)(pm * 256) * DFF + j0) = o0;
        *(v2u*)(Gb + (size_t)(pm * 256 + 1) * DFF + j0) = o1;
    }
}

__device__ __forceinline__ void sg_prefetch(const Frame& F, int item, v4u (&v)[4], v4u (&u)[4], unsigned long long (&st)[2]) {
    const bf16* U = (const bf16*)(F.ws + WS_U); const bf16* V = (const bf16*)(F.ws + WS_V); const unsigned long long* VS = (const unsigned long long*)(F.ws + WS_VSX);
    const int tid = F.wave * 64 + LANE_ID(), g = item & 31, r0 = (item >> 5) * 128, d8 = (tid & 15) * 8;
#pragma unroll
    for (int k = 0; k < 4; ++k) { const size_t o = (size_t)(r0 + (tid >> 4) + 32 * k) * DM + g * 128 + d8; v[k] = *(const v4u*)(V + o); u[k] = *(const v4u*)(U + o); }
    st[0] = 0ull; st[1] = 0ull;
    if (tid < 128) { st[0] = VS[2 * (size_t)(r0 + tid)]; st[1] = VS[2 * (size_t)(r0 + tid) + 1]; }
}
__device__ __forceinline__ void sg_item(Frame& F, int item, int& gcur, const v4u (&v)[4], const v4u (&u)[4], const unsigned long long (&st)[2]) {
    typedef short bf16x8 __attribute__((ext_vector_type(8))); typedef float f32x16 __attribute__((ext_vector_type(16)));
    bf16* GT = (bf16*)(F.ws + WS_O);
    constexpr int PT = 136;
    LAS bf16* Wc = (LAS bf16*)(F.lds + RING_OFF);
    LAS bf16* vnT = Wc + 128 * PT;
    LAS float* rstat = (LAS float*)(F.lds + RING_OFF + 2 * 128 * PT * 2);
    const int lane = LANE_ID(), tid = F.wave * 64 + lane, r32 = lane & 31, hi = lane >> 5, tb = F.wave >> 1, dh = F.wave & 1;
    const int g = item & 31, r0 = (item >> 5) * 128, d8 = (tid & 15) * 8, col = g * 128 + d8;
    if (g != gcur) {
        for (int idx = tid; idx < 128 * 32; idx += 512) { const int t = idx >> 5, s4 = (idx & 31) * 4;
            const f32x4 w = *(const f32x4*)(F.sg_w_s + (size_t)g * 16384 + t * 128 + s4);
            v2u o; o.x = pk2(s4 <= t ? w[0] : 0.f, s4 + 1 <= t ? w[1] : 0.f); o.y = pk2(s4 + 2 <= t ? w[2] : 0.f, s4 + 3 <= t ? w[3] : 0.f);
            *(LAS v2u*)(Wc + t * PT + s4) = o; }
        gcur = g;
    }
    float gn[8], bs[8];
#pragma unroll
    for (int e = 0; e < 8; ++e) { gn[e] = F.sg_v_gain[col + e]; bs[e] = F.sg_v_bias[col + e]; }
    if (tid < 128) { const float s1 = pg8::unfx20(st[0]), s2 = pg8::unfx20(st[1]);
        const float mean = s1 * (1.0f / 4096.0f), var = s2 * (1.0f / 4096.0f) - mean * mean;
        rstat[2 * tid] = mean; rstat[2 * tid + 1] = 1.0f / sqrtf(var + NORM_EPS); }
    __syncthreads();
#pragma unroll
    for (int k = 0; k < 4; ++k) { const int s = (tid >> 4) + 32 * k;
        float v8[8]; unpack8(v[k], v8);
        const float mean = rstat[2 * s], rstd = rstat[2 * s + 1];
#pragma unroll
        for (int e = 0; e < 8; ++e) vnT[(d8 + e) * PT + s] = (bf16)f2bf((v8[e] - mean) * rstd * gn[e] + bs[e]); }
    __syncthreads();
    f32x16 acc0 = {}, acc1 = {};
    const LAS bf16* ap = Wc + (32 * tb + r32) * PT + 8 * hi;
    const LAS bf16* bp0 = vnT + (64 * dh + r32) * PT + 8 * hi, * bp1 = bp0 + 32 * PT;
    for (int ks = 0; ks < 2 * tb + 2; ++ks) {
        const bf16x8 a = *(const LAS bf16x8*)(ap + 16 * ks), b0 = *(const LAS bf16x8*)(bp0 + 16 * ks), b1 = *(const LAS bf16x8*)(bp1 + 16 * ks);
        acc0 = __builtin_amdgcn_mfma_f32_32x32x16_bf16(a, b0, acc0, 0, 0, 0);
        acc1 = __builtin_amdgcn_mfma_f32_32x32x16_bf16(a, b1, acc1, 0, 0, 0);
    }
    __syncthreads();
    LAS float* ft = (LAS float*)(vnT);
#pragma unroll
    for (int i = 0; i < 16; ++i) {
        const int t = 32 * tb + (i & 3) + 8 * (i >> 2) + 4 * hi;
        const float bsv = F.sg_b_s[g * 128 + t];
        ft[t * 132 + 64 * dh + r32] = acc0[i] + bsv;
        ft[t * 132 + 64 * dh + 32 + r32] = acc1[i] + bsv;
    }
    __syncthreads();
#pragma unroll
    for (int k = 0; k < 4; ++k) {
        const int t = (tid >> 4) + 32 * k; const size_t o = (size_t)(r0 + t) * DM + col;
        float u8[8]; unpack8(u[k], u8);
        const f32x4 f0 = *(const LAS f32x4*)(ft + t * 132 + d8), f1 = *(const LAS f32x4*)(ft + t * 132 + d8 + 4);
        v4u w; w.x = pk2(u8[0] * f0[0], u8[1] * f0[1]); w.y = pk2(u8[2] * f0[2], u8[3] * f0[3]); w.z = pk2(u8[4] * f1[0], u8[5] * f1[1]); w.w = pk2(u8[6] * f1[2], u8[7] * f1[3]);
        *(v4u*)(GT + o) = w;
    }
    __syncthreads();
}
__device__ __forceinline__ void p_sgate(Frame& F) {
    constexpr int NIT = 64 * 32;
    v4u vA[4], uA[4], vB[4], uB[4]; unsigned long long sA[2], sB[2];
    int gcur = -1, item = blockIdx.x;
    if (item < NIT) sg_prefetch(F, item, vA, uA, sA);
    while (item < NIT) {
        const int item2 = item + F.G;
        if (item2 < NIT) sg_prefetch(F, item2, vB, uB, sB);
        sg_item(F, item, gcur, vA, uA, sA);
        if (item2 >= NIT) break;
        item = item2 + F.G;
        if (item < NIT) sg_prefetch(F, item, vA, uA, sA);
        sg_item(F, item2, gcur, vB, uB, sB);
    }
}
#ifdef PROBE_RES
constexpr int N_PHASES = 19;
#else
constexpr int N_PHASES = 18;
#endif
struct Args { const void* in[19]; float* out; unsigned char* ws; int ph_lo, ph_hi, li, pad; };
__global__ void __launch_bounds__(NWAVES * 64, 2) mk_fwd(Args args) {
    extern __shared__ __attribute__((aligned(16))) unsigned char lds[];
    Frame F;
    F.lds = (LAS unsigned char*)lds;
    F.MISC = (volatile LAS unsigned*)(F.lds + MISC_OFF);
    F.wave = __builtin_amdgcn_readfirstlane((int)threadIdx.x >> 6);
    F.G = gridDim.x; F.gw = blockIdx.x * NWAVES + F.wave; F.NGW = F.G * NWAVES;
    F.ws = args.ws; F.ctl = (unsigned*)(args.ws + WS_CTL);
    F.x = (const float*)args.in[0]; F.pos = (const int*)args.in[1];
    F.attn_norm = (const float*)args.in[2]; F.attn_w_in = (const float*)args.in[3]; F.attn_w_out = (const float*)args.in[4];
    F.sg_norm = (const float*)args.in[5]; F.sg_w_in = (const float*)args.in[6]; F.sg_b_in = (const float*)args.in[7]; F.sg_v_gain = (const float*)args.in[8]; F.sg_v_bias = (const float*)args.in[9];
    F.sg_w_s = (const float*)args.in[10]; F.sg_b_s = (const float*)args.in[11]; F.sg_w_out = (const float*)args.in[12];
    F.ffn_norm = (const float*)args.in[13]; F.ffn_w_up = (const float*)args.in[14]; F.ffn_conv_w = (const float*)args.in[15]; F.ffn_conv_b = (const float*)args.in[16]; F.ffn_w_down = (const float*)args.in[17];
    F.final_norm = (const float*)args.in[18]; F.out = args.out;
    for (int u = (int)threadIdx.x; u < (XTRA_OFF - LDSCTL_OFF) / 4; u += NWAVES * 64) ((LAS unsigned*)(F.lds + LDSCTL_OFF))[u] = 0u;
#ifdef DIAG_LDSZERO
    for (int u = (int)threadIdx.x; u < LDS_BYTES / 4; u += NWAVES * 64) ((LAS unsigned*)(F.lds))[u] = 0u;
#endif
    __syncthreads();
    const int lo = args.ph_lo, hi = args.ph_hi;
    XcdBarrier bar; bar.bar = F.ctl + CW_BAR + args.li * XCD_BAR_WORDS; bar.x = 0; bar.st = nullptr;
    if (hi - lo > 1) bar = xcd_barrier_post(F.ctl + CW_BAR + args.li * XCD_BAR_WORDS, F.MISC + 8);
#define IN(k) (lo <= (k) && (k) < hi)
#ifdef PROBE_SUM
    unsigned long long pt_acc = 0ull, pt_t0 = wall_clock64();
#define SEAM(k) do { if (IN(k) && IN((k) + 1)) xcd_barrier(bar); { const unsigned long long t_ = wall_clock64(); if ((PROBE_SUM >> (k)) & 1) pt_acc += t_ - pt_t0; pt_t0 = t_; } } while (0)
#elif defined(PROBE_IDLE)
    unsigned long long idle_acc = 0ull;
#define SEAM(k) do { if (IN(k) && IN((k) + 1)) { const unsigned long long tb_ = wall_clock64(); xcd_barrier(bar); if ((PROBE_IDLE >> (k)) & 1) idle_acc += wall_clock64() - tb_; } } while (0)
#else
#define SEAM(k) do { if (IN(k) && IN((k) + 1)) xcd_barrier(bar); } while (0)
#endif
    unsigned char* ws = args.ws;
    bf16* H = (bf16*)(ws + WS_XB); bf16* O = (bf16*)(ws + WS_O); bf16* Gb = (bf16*)(ws + WS_G); bf16* AP = (bf16*)(ws + WS_APRE);
    float* SS = (float*)(ws + WS_SSQ); constexpr size_t SSF = SSQ_SITE / 4;
    const int c = (int)blockIdx.x;

    if (IN(0)) {
        p0_prologue(F);
        p0_strips<0>(F);
    } SEAM(0);
    if (IN(2)) {
        pg8::Gemm g{(const bf16*)(ws + WS_HQ8), (const bf16*)(ws + WS_WIN8), MR, QKVC, DM / 2}; pg8::StaticOrder S; S.init(MR, QKVC, F.G, c);
        pg8::EpiQKV8 E{(bf16*)(ws + WS_QKV), SS, (const float*)(ws + WS_ROPE), (const float*)(ws + WS_ROPE) + MR * 16, (float*)(ws + WS_KMEAN), (const float*)(ws + WS_SAH), (const float*)(ws + WS_SW) + AM_WIN};
        pg8::gemm_phase<pg8::EpiQKV8, pg8::StaticOrder, PG8_ALIGN, PG8_SP2>(F.lds + RING_OFF, g, S, E, F.wave);
    } SEAM(2);
    if (IN(3)) { p_attn(F, (char*)lds + RING_OFF); } SEAM(3);
    if (IN(4)) { p_dilmerge(F);
#ifdef CHECK_ATTN
        xcd_barrier(bar); p_attn_naive(F, AP); xcd_barrier(bar);
        { unsigned bad = 0; const signed char* OQc = (const signed char*)(ws + WS_OQ8); const float* SAc = (const float*)(ws + WS_SAO);
          for (size_t idx = (size_t)blockIdx.x * 512 + (F.wave * 64 + LANE_ID()); idx < (size_t)MR * DM; idx += (size_t)F.G * 512) { const int col = (int)(idx & 4095); const size_t row = idx >> 12;
            const float b = bf1(AP[idx]), sc = SAc[row], a = col < 3072 ? bf1(O[idx]) : (float)OQc[idx] * sc;
            if (!(fabsf(a - b) <= 0.004f + 0.03f * fabsf(b) + (col < 3072 ? 0.f : sc))) ++bad; }
          if (bad) atomicAdd(F.ctl + 8, bad); }
#endif
    } SEAM(4);
    if (IN(5)) {
        pg8::Gemm g{(const bf16*)(ws + WS_OQ8), (const bf16*)(ws + WS_WOUT8), MR, DM, DM / 2}; pg8::StaticOrder S; S.init(MR, DM, F.G, c);
        pg8::EpiResX8 E{F.x, H, SS + 1 * SSF, (const float*)(ws + WS_SAO), (const float*)(ws + WS_SW) + AM_WOUT};
        pg8::gemm_phase<pg8::EpiResX8, pg8::StaticOrder, PG8_ALIGN, PG8_SP2>(F.lds + RING_OFF, g, S, E, F.wave);
    } SEAM(5);
    if (IN(6)) { quant_stream_rows(F, H, (signed char*)(ws + WS_HQ8), (float*)(ws + WS_SAH), SS + 1 * SSF); } SEAM(6);
    if (IN(7)) {
        pg8::Gemm g{(const bf16*)(ws + WS_HQ8), (const bf16*)(ws + WS_WUP8), MR, F2, DM / 2}; pg8::StaticOrder S; S.init(MR, F2, F.G, c);
        pg8::EpiUpConv8 E{Gb, SS + 1 * SSF, F.ffn_conv_w, F.ffn_conv_b, (float*)(ws + WS_TOP), (float*)(ws + WS_BOT), (LAS float*)(F.lds + XTRA_OFF), (const float*)(ws + WS_SAH), (const float*)(ws + WS_SW) + AM_WUP};
        pg8::gemm_phase<pg8::EpiUpConv8, pg8::StaticOrder, true, PG8_SP2>(F.lds + RING_OFF, g, S, E, F.wave);
    } SEAM(7);
    if (IN(8)) { p_convfix(F, 0); } SEAM(8);
    if (IN(9)) {
        pg8::Gemm g{Gb, (const bf16*)(ws + WS_WDOWN), MR, DM, DFF}; pg8::StaticOrder S; S.init(MR, DM, F.G, c);
        pg8::EpiRes E{H, H, (float*)(ws + WS_SSX), nullptr, nullptr};
        pg8::gemm_phase<pg8::EpiRes, pg8::StaticOrder, PG8_ALIGN, PG8_SP2>(F.lds + RING_OFF, g, S, E, F.wave);
    } SEAM(9);
    if (IN(10)) {
        pg8::Gemm g{H, (const bf16*)(ws + WS_SGWIN), MR, 2 * DM, DM}; pg8::StaticOrder S; S.init(MR, 2 * DM, F.G, c);
        pg8::EpiSgIn E{(bf16*)(ws + WS_U), (bf16*)(ws + WS_V), (const float*)(ws + WS_SSX), F.sg_b_in, (float*)(ws + WS_VSX)};
        pg8::gemm_phase<pg8::EpiSgIn, pg8::StaticOrder, PG8_ALIGN, PG8_SP2>(F.lds + RING_OFF, g, S, E, F.wave);
    } SEAM(10);
    if (IN(11)) { p_sgate(F); } SEAM(11);
    if (IN(12)) {
        pg8::Gemm g{O, (const bf16*)(ws + WS_SGWOUT), MR, DM, DM}; pg8::StaticOrder S; S.init(MR, DM, F.G, c);
        pg8::EpiResNX E{H, H, nullptr, nullptr, nullptr};
        pg8::gemm_phase<pg8::EpiResNX, pg8::StaticOrder, PG8_ALIGN, PG8_SP2>(F.lds + RING_OFF, g, S, E, F.wave);
    } SEAM(12);
    if (IN(13)) { quant_stream_rows(F, H, (signed char*)(ws + WS_HQ8), (float*)(ws + WS_SAH), SS + 3 * SSF); } SEAM(13);
    if (IN(14)) {
        pg8::Gemm g{(const bf16*)(ws + WS_HQ8), (const bf16*)(ws + WS_WUP8 + WUP8_L), MR, F2, DM / 2}; pg8::StaticOrder S; S.init(MR, F2, F.G, c);
        pg8::EpiUpConv8 E{Gb, SS + 3 * SSF, F.ffn_conv_w + 3 * F2, F.ffn_conv_b + F2, (float*)(ws + WS_TOP), (float*)(ws + WS_BOT), (LAS float*)(F.lds + XTRA_OFF), (const float*)(ws + WS_SAH), (const float*)(ws + WS_SW) + AM_WUP + F2};
        pg8::gemm_phase<pg8::EpiUpConv8, pg8::StaticOrder, true, PG8_SP2>(F.lds + RING_OFF, g, S, E, F.wave);
    } SEAM(14);
    if (IN(15)) { p_convfix(F, 1); } SEAM(15);
    if (IN(16)) {
        pg8::Gemm g{Gb, (const bf16*)(ws + WS_WDOWN + WDOWN_L), MR, DM, DFF}; pg8::StaticOrder S; S.init(MR, DM, F.G, c);
        pg8::EpiResNX E{H, H, nullptr, nullptr, nullptr};
        pg8::gemm_phase<pg8::EpiResNX, pg8::StaticOrder, PG8_ALIGN, PG8_SP2>(F.lds + RING_OFF, g, S, E, F.wave);
    } SEAM(16);
#ifdef PROBE_BAR
    if (hi - lo > 1) for (int i = 0; i < PROBE_BAR; ++i) xcd_barrier(bar);
#endif
    if (IN(17)) { p_final(F); }
#ifdef PROBE_SUM
    { const unsigned long long t_ = wall_clock64(); if ((PROBE_SUM >> 17) & 1) pt_acc += t_ - pt_t0;
      if (blockIdx.x == 0 && (F.wave * 64 + LANE_ID()) == 0) { const unsigned long long w1 = wall_clock64(); while (wall_clock64() - w1 < pt_acc) __builtin_amdgcn_s_sleep(8); } }
#endif
#ifdef PROBE_IDLE
    if (hi - lo > 1) {
        if ((F.wave * 64 + LANE_ID()) == 0) atomicAdd((unsigned long long*)(F.ctl + 16), idle_acc);
        xcd_barrier(bar);
        if (blockIdx.x == 0 && (F.wave * 64 + LANE_ID()) == 0) { const unsigned long long tot = __hip_atomic_load((unsigned long long*)(F.ctl + 16), __ATOMIC_RELAXED, __HIP_MEMORY_SCOPE_AGENT);
            const unsigned long long span = tot / F.G * PROBE_AMP; const unsigned long long w1 = wall_clock64(); while (wall_clock64() - w1 < span) __builtin_amdgcn_s_sleep(8); }
    }
#endif
#ifdef PROBE_RES
    if (IN(18)) {
#if PROBE_RES == 1
        pg8::Gemm g{Gb, (const bf16*)(ws + WS_WDOWN), MR, DM, DFF};
#else
        pg8::Gemm g{O, (const bf16*)(ws + WS_WOUT), MR, DM, DM};
#endif
        pg8::StaticOrder S; S.init(MR, DM, F.G, c);
        pg8::EpiRes E{H, (bf16*)(ws + WS_APRE), (float*)(ws + WS_APRE + 256 * MiB), nullptr, nullptr};
        pg8::gemm_phase<pg8::EpiRes, pg8::StaticOrder, PG8_ALIGN, PG8_SP2>(F.lds + RING_OFF, g, S, E, F.wave);
    }
#endif
#undef IN
#undef SEAM
}

extern "C" void kernel_launch(void* const* d_in, const int* in_sizes, int n_in, void* d_out, int out_size, void* d_ws, size_t ws_size, hipStream_t stream) {
    static int grid = 0;
    if (grid == 0) {
        if (n_in != 19 || out_size != MR * DM || ws_size < WS_END) { fprintf(stderr, "kernel_launch: unexpected shapes (n_in %d, out %d, ws %zu); nothing launched\n", n_in, out_size, ws_size); grid = -1; return; }
        int dev = 0, cus = 0, per_cu = 0;
        if (hipGetDevice(&dev) != hipSuccess || hipDeviceGetAttribute(&cus, hipDeviceAttributeMultiprocessorCount, dev) != hipSuccess) { grid = -1; return; }
        if (hipFuncSetAttribute((const void*)mk_fwd, hipFuncAttributeMaxDynamicSharedMemorySize, LDS_BYTES) != hipSuccess) { fprintf(stderr, "kernel_launch: hipFuncSetAttribute failed\n"); grid = -1; return; }
        if (hipOccupancyMaxActiveBlocksPerMultiprocessor(&per_cu, (const void*)mk_fwd, NWAVES * 64, LDS_BYTES) != hipSuccess || per_cu < 1) fprintf(stderr, "kernel_launch: occupancy query reports %d\n", per_cu);
        (void)hipGetLastError();
        grid = cus;
    }
    if (grid < 0) return;
    if (hipMemsetAsync((char*)d_ws + WS_CTL, 0, CTL_ZERO_BYTES, stream) != hipSuccess) return;
#ifdef DIAG_POISON
    (void)hipMemsetAsync((char*)d_ws + DIAG_POISON_LO, 0xAA, DIAG_POISON_HI - DIAG_POISON_LO, stream);
#endif
    Args a{};
    for (int i = 0; i < 19; ++i) a.in[i] = d_in[i];
    a.out = (float*)d_out; a.ws = (unsigned char*)d_ws; a.pad = 0;
    if (MK_N_LAUNCHES == 1) {
        a.ph_lo = 0; a.ph_hi = N_PHASES; a.li = 0;
        hipLaunchKernelGGL(mk_fwd, dim3(grid), dim3(NWAVES * 64), LDS_BYTES, stream, a);
    } else {
        for (int p = 0; p < N_PHASES; ++p) { a.ph_lo = p; a.ph_hi = p + 1; a.li = 0; hipLaunchKernelGGL(mk_fwd, dim3(grid), dim3(NWAVES * 64), LDS_BYTES, stream, a);
#ifdef PROBE_MASK
            if ((PROBE_MASK >> p) & 1) hipLaunchKernelGGL(mk_fwd, dim3(grid), dim3(NWAVES * 64), LDS_BYTES, stream, a);
#endif
        }
    }
}
```

```cpp
#include <hip/hip_runtime.h>
#include <cstdio>
#include <cstdint>
#ifndef MK_N_LAUNCHES
#define MK_N_LAUNCHES 1
#endif
namespace pg8 {
#define PG8_LAS __attribute__((address_space(3)))
typedef unsigned short bf16_t;
typedef short bf16x8 __attribute__((ext_vector_type(8)));
typedef float f32x4 __attribute__((ext_vector_type(4)));
typedef unsigned u32x4 __attribute__((ext_vector_type(4)));
constexpr int BM = 256, BK = 64, HALF = 128, HTB = HALF * BK * 2  , STAGE_BYTES = 8 * HTB, NXCD = 8, WGM = 8;

__host__ __device__ __forceinline__ int lds_byte(int r, int c) { const int st = (r >> 4) * 2 + (c >> 5), rr = r & 15, cc = c & 31, ob = rr * 64 + cc * 2; return st * 1024 + (ob ^ (((ob >> 9) & 1) << 5)); }
__host__ __device__ __forceinline__ void stage_rc(int b, int& R, int& C) { const int st = b / 1024, sb = b % 1024, swz = sb ^ (((sb >> 9) & 1) << 5); R = (st >> 1) * 16 + swz / 64; C = (st & 1) * 32 + (swz % 64) / 2; }
__host__ __device__ __forceinline__ int perm32(int rho) { const int n = rho >> 4, i = rho & 15; return 8 * (i >> 2) + 4 * n + (i & 3); }

struct Unit { int pm, pn; };
struct Gemm { const bf16_t* A; const bf16_t* Bt; int M, N, K; };

struct StaticOrder {
    int nM, nN, nwg, G, c, same;
    __host__ __device__ void init(int M, int N, int G_, int c_) { nM = M / BM; nN = N / BM; nwg = nM * nN; G = G_; c = c_; same = -1; }
    __host__ __device__ bool next(int i, Unit& u) const {
        const long L = (long)i * G + c; if (L >= nwg) return false;
        int wgid = (int)L; { const int q = nwg / NXCD, r = nwg % NXCD, xcd = wgid % NXCD, off = wgid / NXCD; wgid = (xcd < r ? xcd * (q + 1) : r * (q + 1) + (xcd - r) * q) + off; }
        const int nig = WGM * nN, gid = wgid / nig, fm = gid * WGM, gsz = (nM - fm) < WGM ? (nM - fm) : WGM;
        u.pm = fm + ((wgid % nig) % gsz); u.pn = (wgid % nig) / gsz; u.pm &= same; u.pn &= same; return true;
    }
    __device__ __forceinline__ void a_ready(const Unit&) const {}
    __device__ __forceinline__ void done(const Unit&) const {}
};
__device__ __forceinline__ unsigned cvt_pk_bf16(float lo, float hi) { unsigned r; asm volatile("v_cvt_pk_bf16_f32 %0, %1, %2" : "=v"(r) : "v"(lo), "v"(hi)); return r; }
typedef float f32x2 __attribute__((ext_vector_type(2)));
__device__ __forceinline__ f32x2 gelu_pk(f32x2 v) {
    const f32x2 av = __builtin_elementwise_abs(v), d = av * 0.2316418882f + 1.0f;
    f32x2 t; t.x = __builtin_amdgcn_rcpf(d.x); t.y = __builtin_amdgcn_rcpf(d.y);
    f32x2 q = t * 0.5307027145f + (-0.7265760135f); q = q * t + 0.7107068705f; q = q * t + (-0.142248368f); q = q * t + 0.127414796f; q = q * t;
    const f32x2 s = (v * v) * (-0.72134752044f);
    f32x2 e; e.x = __builtin_amdgcn_exp2f(s.x); e.y = __builtin_amdgcn_exp2f(s.y);
    const f32x2 m = v * (q * e), r = v - m;
    f32x2 o; o.x = v.x < 0.f ? m.x : r.x; o.y = v.y < 0.f ? m.y : r.y; return o;
}
typedef unsigned u32x2 __attribute__((ext_vector_type(2)));
typedef int i32x4 __attribute__((ext_vector_type(4)));
__device__ __forceinline__ unsigned long long fx20(float x) { return (unsigned long long)(long long)__builtin_rintf(x * 1048576.0f); }
__device__ __forceinline__ float unfx20(unsigned long long v) { return (float)(long long)v * (1.0f / 1048576.0f); }
template <bool I8> struct AccT { typedef f32x4 type; };
template <> struct AccT<true> { typedef i32x4 type; };
__device__ __forceinline__ f32x4 tof(f32x4 a) { return a; }
__device__ __forceinline__ f32x4 tof(i32x4 a) { return (f32x4){(float)a[0], (float)a[1], (float)a[2], (float)a[3]}; }
__device__ __forceinline__ float rstd_from_ss(const float* ss, int r) { return 1.0f / sqrtf(ss[r] * (1.0f / 4096.0f) + 1e-5f); }

template <bool Q8> struct EpiQKVT {
    static constexpr bool PERM = false, AFTER_DRAIN = false, I8 = Q8, APERM = false; static constexpr bool PREFETCH = false;
    typedef typename AccT<Q8>::type acc_t;
    bf16_t* qkv; const float* ss; const float* ropec; const float* ropes; float* km; const float* sa; const float* sw;
    __device__ __forceinline__ void operator()(const acc_t (&acc)[2][2][4][2], const Unit& u, int wr, int wc, int fr_in, int fq_in) const {
        int fr = fr_in, fq = fq_in; asm volatile("" : "+v"(fr), "+v"(fq));
        const int row0 = u.pm * BM + wr * 64 + fr;
        f32x4 swv[2][2];
#pragma unroll
        for (int bj = 0; bj < 2; ++bj)
#pragma unroll
            for (int n = 0; n < 2; ++n) swv[bj][n] = Q8 ? *(const f32x4*)(sw + u.pn * BM + bj * HALF + wc * 32 + 16 * n + 4 * fq) : (f32x4){1.f, 1.f, 1.f, 1.f};
        const bool kmu = u.pn >= 24 && u.pn < 36;
        const bool rot = wc == 0 && u.pn < 48;
        f32x4 cs[2][2];
#pragma unroll
        for (int bj = 0; bj < 2; ++bj)
#pragma unroll
            for (int n = 0; n < 2; ++n) cs[bj][n] = (f32x4){0.f, 0.f, 0.f, 0.f};
#pragma unroll
        for (int ai = 0; ai < 2; ++ai) {
            float rs[4]; f32x4 cz[4], sn[4];
            float sar[4];
#pragma unroll
            for (int m = 0; m < 4; ++m) sar[m] = Q8 ? sa[row0 + ai * HALF + m * 16] : 1.0f;
#pragma unroll
            for (int m = 0; m < 4; ++m) { const int r = row0 + ai * HALF + m * 16; rs[m] = ss[r];
                cz[m] = (f32x4){1.f, 1.f, 1.f, 1.f}; sn[m] = (f32x4){0.f, 0.f, 0.f, 0.f};
                if (rot) { cz[m] = *(const f32x4*)(ropec + (size_t)r * 16 + 4 * fq); sn[m] = *(const f32x4*)(ropes + (size_t)r * 16 + 4 * fq); } }
#pragma unroll
            for (int m = 0; m < 4; ++m) {
                const int r = row0 + ai * HALF + m * 16;
                const float rsv = sar[m] / sqrtf(rs[m] * (1.0f / 4096.0f) + 1e-5f);
                const int b = r >> 12, s = r & 4095;
#pragma unroll
                for (int bj = 0; bj < 2; ++bj) {
                    const int colh = 2 * u.pn + bj, which = colh / 48, head = colh - which * 48;
                    bf16_t* dst = qkv + ((size_t)((which * 2 + b) * 48 + head) * 4096 + s) * 128 + wc * 32 + 4 * fq;
                    f32x4 v0 = tof(acc[ai][bj][m][0]) * rsv, v1 = tof(acc[ai][bj][m][1]) * rsv;
                    if (Q8) { v0 = v0 * swv[bj][0]; v1 = v1 * swv[bj][1]; }
                    if (rot) { const f32x4 n0 = v0 * cz[m] - v1 * sn[m], n1 = v1 * cz[m] + v0 * sn[m]; v0 = n0; v1 = n1; }
                    if (kmu) { cs[bj][0] += v0; cs[bj][1] += v1; }
                    u32x2 w0, w1; w0.x = cvt_pk_bf16(v0[0], v0[1]); w0.y = cvt_pk_bf16(v0[2], v0[3]); w1.x = cvt_pk_bf16(v1[0], v1[1]); w1.y = cvt_pk_bf16(v1[2], v1[3]);
                    *(u32x2*)(dst) = w0; *(u32x2*)(dst + 16) = w1;
                }
            }
            asm volatile("" ::: "memory");
        }
        if (kmu) {
            const int b = u.pm >> 4, blk = u.pm & 15;
#pragma unroll
            for (int bj = 0; bj < 2; ++bj) {
                const int head = 2 * u.pn + bj - 48;
                float* dst = km + ((size_t)((b * 24 + head) * 16 + blk)) * 128 + wc * 32 + 4 * fq;
#pragma unroll
                for (int n = 0; n < 2; ++n)
#pragma unroll
                    for (int j = 0; j < 4; ++j) {
                        float v = cs[bj][n][j];
                        v += __shfl_xor(v, 1); v += __shfl_xor(v, 2); v += __shfl_xor(v, 4); v += __shfl_xor(v, 8);
                        if (fr == 0) atomicAdd(dst + 16 * n + j, v * (1.0f / 256.0f));
                    }
            }
        }
    }
};
typedef EpiQKVT<false> EpiQKV;
typedef EpiQKVT<true> EpiQKV8;

__device__ __forceinline__ f32x4 bf4a(u32x4 w) { return (f32x4){__builtin_bit_cast(float, w.x << 16), __builtin_bit_cast(float, w.x & 0xffff0000u), __builtin_bit_cast(float, w.y << 16), __builtin_bit_cast(float, w.y & 0xffff0000u)}; }
__device__ __forceinline__ f32x4 bf4b(u32x4 w) { return (f32x4){__builtin_bit_cast(float, w.z << 16), __builtin_bit_cast(float, w.z & 0xffff0000u), __builtin_bit_cast(float, w.w << 16), __builtin_bit_cast(float, w.w & 0xffff0000u)}; }
template <bool HF32, bool Q8, bool WST> struct EpiResT {
    static constexpr bool PERM = true, AFTER_DRAIN = false, I8 = Q8, APERM = false; static constexpr bool PREFETCH = false;
    typedef typename AccT<Q8>::type acc_t;
    const void* hin; bf16_t* hout; float* ss; const float* sa; const float* sw;
    __device__ __forceinline__ void operator()(const acc_t (&acc)[2][2][4][2], const Unit& u, int wr, int wc, int fr_in, int fq_in) const {
        int fr = fr_in, fq = fq_in; asm volatile("" : "+v"(fr), "+v"(fq));
        const int row0 = u.pm * BM + wr * 64 + fr, col0 = u.pn * BM + wc * 32 + 8 * fq;
        f32x4 swv[2][2];
#pragma unroll
        for (int bj = 0; bj < 2; ++bj)
#pragma unroll
            for (int n = 0; n < 2; ++n) swv[bj][n] = Q8 ? *(const f32x4*)(sw + col0 + bj * HALF + 4 * n) : (f32x4){1.f, 1.f, 1.f, 1.f};
        constexpr int MB = HF32 ? 2 : 4;
#pragma unroll
        for (int ai = 0; ai < 2; ++ai)
#pragma unroll
            for (int mb = 0; mb < 4; mb += MB) {
                f32x4 h[MB][2][2]; float sar[MB];
#pragma unroll
                for (int mi = 0; mi < MB; ++mi) { sar[mi] = Q8 ? sa[row0 + ai * HALF + (mb + mi) * 16] : 1.0f;
                    const size_t off = (size_t)(row0 + ai * HALF + (mb + mi) * 16) * 4096 + col0;
#pragma unroll
                    for (int bj = 0; bj < 2; ++bj) {
                        if (HF32) { h[mi][bj][0] = *(const f32x4*)((const float*)hin + off + bj * HALF); h[mi][bj][1] = *(const f32x4*)((const float*)hin + off + bj * HALF + 4); }
                        else { const u32x4 w = *(const u32x4*)((const bf16_t*)hin + off + bj * HALF); h[mi][bj][0] = bf4a(w); h[mi][bj][1] = bf4b(w); }
                    } }
#pragma unroll
                for (int mi = 0; mi < MB; ++mi) {
                    const int m = mb + mi, r = row0 + ai * HALF + m * 16; const size_t off = (size_t)r * 4096 + col0;
                    float sq = 0.f;
#pragma unroll
                    for (int bj = 0; bj < 2; ++bj) {
                        const f32x4 v0 = Q8 ? h[mi][bj][0] + tof(acc[ai][bj][m][0]) * swv[bj][0] * sar[mi] : h[mi][bj][0] + tof(acc[ai][bj][m][0]);
                        const f32x4 v1 = Q8 ? h[mi][bj][1] + tof(acc[ai][bj][m][1]) * swv[bj][1] * sar[mi] : h[mi][bj][1] + tof(acc[ai][bj][m][1]);
                        u32x4 w; w.x = cvt_pk_bf16(v0[0], v0[1]); w.y = cvt_pk_bf16(v0[2], v0[3]); w.z = cvt_pk_bf16(v1[0], v1[1]); w.w = cvt_pk_bf16(v1[2], v1[3]);
                        *(u32x4*)(hout + off + bj * HALF) = w;
                        sq += ((v0[0] * v0[0] + v0[1] * v0[1]) + (v0[2] * v0[2] + v0[3] * v0[3])) + ((v1[0] * v1[0] + v1[1] * v1[1]) + (v1[2] * v1[2] + v1[3] * v1[3]));
                    }
                    if (WST) { sq += __shfl_xor(sq, 16); sq += __shfl_xor(sq, 32);
                        if (fq == 0) atomicAdd((unsigned long long*)ss + r, fx20(sq)); }
                }
                asm volatile("" ::: "memory");
            }
    }
};
typedef EpiResT<false, false, true> EpiRes;
typedef EpiResT<false, false, false> EpiResNX;
typedef EpiResT<true, true, false> EpiResX8;

struct EpiUpPre {
    static constexpr bool PERM = true, AFTER_DRAIN = false, I8 = false, APERM = false; static constexpr bool PREFETCH = false;
    bf16_t* apre; const float* ss;
    __device__ __forceinline__ void operator()(const f32x4 (&acc)[2][2][4][2], const Unit& u, int wr, int wc, int fr, int fq) const {
        const int row0 = u.pm * BM + wr * 64 + fr, col0 = u.pn * 128 + wc * 32 + 8 * fq;
#pragma unroll
        for (int ai = 0; ai < 2; ++ai)
#pragma unroll
            for (int m = 0; m < 4; ++m) {
                const int r = row0 + ai * HALF + m * 16;
                const float rs = rstd_from_ss(ss, r);
                bf16_t* rowp = apre + (size_t)r * 28672 + col0;
#pragma unroll
                for (int bj = 0; bj < 2; ++bj) {
                    const f32x4 v0 = acc[ai][bj][m][0] * rs, v1 = acc[ai][bj][m][1] * rs;
                    u32x4 w; w.x = cvt_pk_bf16(v0[0], v0[1]); w.y = cvt_pk_bf16(v0[2], v0[3]); w.z = cvt_pk_bf16(v1[0], v1[1]); w.w = cvt_pk_bf16(v1[2], v1[3]);
                    *(u32x4*)(rowp + bj * 14336) = w;
                }
                asm volatile("" ::: "memory");
            }
    }
};

struct EpiSgIn {
    static constexpr bool PERM = true, AFTER_DRAIN = false, I8 = false, APERM = false; static constexpr bool PREFETCH = false;
    bf16_t* U; bf16_t* V; const float* ss; const float* bias; float* vs;
    __device__ __forceinline__ void operator()(const f32x4 (&acc)[2][2][4][2], const Unit& u, int wr, int wc, int fr, int fq) const {
        const int row0 = u.pm * BM + wr * 64 + fr, gcol0 = u.pn * BM + wc * 32 + 8 * fq;
        const bool isv = u.pn >= 16;
        bf16_t* base = isv ? V : U; const int col0 = isv ? gcol0 - 4096 : gcol0;
        f32x4 bv[2][2];
#pragma unroll
        for (int bj = 0; bj < 2; ++bj)
#pragma unroll
            for (int n = 0; n < 2; ++n) bv[bj][n] = *(const f32x4*)(bias + gcol0 + bj * HALF + 4 * n);
        float rsq[2][4];
#pragma unroll
        for (int ai = 0; ai < 2; ++ai)
#pragma unroll
            for (int m = 0; m < 4; ++m) rsq[ai][m] = unfx20(((const unsigned long long*)ss)[row0 + ai * HALF + m * 16]);
#pragma unroll
        for (int ai = 0; ai < 2; ++ai)
#pragma unroll
            for (int m = 0; m < 4; ++m) {
                const int r = row0 + ai * HALF + m * 16;
                const float rs = 1.0f / sqrtf(rsq[ai][m] * (1.0f / 4096.0f) + 1e-5f);
                bf16_t* rowp = base + (size_t)r * 4096 + col0;
                float s1 = 0.f, s2 = 0.f;
#pragma unroll
                for (int bj = 0; bj < 2; ++bj) {
                    f32x4 v0 = acc[ai][bj][m][0] * rs + bv[bj][0], v1 = acc[ai][bj][m][1] * rs + bv[bj][1];
                    const f32x2 a = gelu_pk((f32x2){v0[0], v0[1]}), b = gelu_pk((f32x2){v0[2], v0[3]}), c = gelu_pk((f32x2){v1[0], v1[1]}), d = gelu_pk((f32x2){v1[2], v1[3]});
                    s1 += (a.x + a.y) + (b.x + b.y) + (c.x + c.y) + (d.x + d.y);
                    s2 += (a.x * a.x + a.y * a.y) + (b.x * b.x + b.y * b.y) + (c.x * c.x + c.y * c.y) + (d.x * d.x + d.y * d.y);
                    u32x4 w; w.x = cvt_pk_bf16(a.x, a.y); w.y = cvt_pk_bf16(b.x, b.y); w.z = cvt_pk_bf16(c.x, c.y); w.w = cvt_pk_bf16(d.x, d.y);
                    *(u32x4*)(rowp + bj * HALF) = w;
                }
                if (isv) {
                    s1 += __shfl_xor(s1, 16); s1 += __shfl_xor(s1, 32); s2 += __shfl_xor(s2, 16); s2 += __shfl_xor(s2, 32);
                    if (fq == 0) { atomicAdd((unsigned long long*)vs + 2 * r, fx20(s1)); atomicAdd((unsigned long long*)vs + 2 * r + 1, fx20(s2)); }
                }
            }
    }
};

#define PG8_DPP(oldv, srcv, ctrl) __builtin_bit_cast(float, __builtin_amdgcn_update_dpp(__builtin_bit_cast(int, (float)(oldv)), __builtin_bit_cast(int, (float)(srcv)), (ctrl), 0xf, 0xf, false))
template <bool Q8> struct EpiUpConvT {
    static constexpr bool PERM = true, APERM = true, AFTER_DRAIN = false, I8 = Q8; static constexpr bool PREFETCH = true;
    typedef typename AccT<Q8>::type acc_t;
    bf16_t* G; const float* ss; const float* cw; const float* cb; float* top; float* bot; PG8_LAS float* xch; const float* sa; const float* sw;
    __device__ __forceinline__ static float silu(float x) { return x * __builtin_amdgcn_rcpf(1.0f + __builtin_amdgcn_exp2f(-1.4426950408889634f * x)); }
    __device__ __forceinline__ void prefetch(const Unit& u, int par, int wid, int lane) const {
        const int t = wid * 64 + lane, c = t & 255, gcol = (c < 128 ? 0 : 14336 - 128) + u.pn * 128 + c;
        PG8_LAS float* wl = xch + 2048 + par * 1280 + wid * 64; PG8_LAS float* rl = xch + 4608 + par * 512 + wid * 64;
        __builtin_amdgcn_global_load_lds((const unsigned*)(cw + (t >> 8) * 28672 + gcol), (PG8_LAS unsigned*)(wl), 4, 0, 0);
        __builtin_amdgcn_global_load_lds((const unsigned*)((t < 256 ? cw + 2 * 28672 : cb) + gcol), (PG8_LAS unsigned*)(wl + 512), 4, 0, 0);
        if (wid < 4) __builtin_amdgcn_global_load_lds((const unsigned*)(sw + u.pn * 256 + t), (PG8_LAS unsigned*)(wl + 1024), 4, 0, 0);
        __builtin_amdgcn_global_load_lds((const unsigned*)((t < 256 ? ss : sa) + u.pm * BM + c), (PG8_LAS unsigned*)(rl), 4, 0, 0);
    }
    __device__ __forceinline__ void operator()(const acc_t (&acc)[2][2][4][2], const Unit& u, int wr, int wc, int fr_in, int fq_in, int par) const {
        int fr = fr_in, fq = fq_in; asm volatile("" : "+v"(fr), "+v"(fq));
        const int rb0 = u.pm * BM + wr * 64 + 4 * fr, colg = u.pn * 128 + wc * 32 + 8 * fq;
        PG8_LAS float* wl = xch + 2048 + par * 1280;
        const PG8_LAS float* rl = xch + 4608 + par * 512 + wr * 64 + 4 * fr;
        f32x4 rsv[2];
#pragma unroll
        for (int ai = 0; ai < 2; ++ai) { const f32x4 s = *(const PG8_LAS f32x4*)(rl + ai * HALF);
            f32x4 r; r[0] = 1.0f / sqrtf(s[0] * (1.0f / 4096.0f) + 1e-5f); r[1] = 1.0f / sqrtf(s[1] * (1.0f / 4096.0f) + 1e-5f); r[2] = 1.0f / sqrtf(s[2] * (1.0f / 4096.0f) + 1e-5f); r[3] = 1.0f / sqrtf(s[3] * (1.0f / 4096.0f) + 1e-5f);
            if (Q8) r = r * *(const PG8_LAS f32x4*)(rl + 256 + ai * HALF);
            rsv[ai] = r; }
#pragma unroll
        for (int ai = 0; ai < 2; ++ai)
#pragma unroll
            for (int bj = 0; bj < 2; ++bj)
#pragma unroll
                for (int n = 0; n < 2; ++n) {
                    if (fr == 15) {
#pragma unroll
                        for (int m = 2; m < 4; ++m) { const f32x4 v = tof(acc[ai][bj][m][n]) * rsv[ai][m];
                            *(PG8_LAS f32x4*)(xch + ((((((ai * 2 + wr) * 4 + wc) * 2 + bj) * 2 + n) * 4 + fq) * 2 + (m - 2)) * 4) = v;
                            if (ai == 1 && wr == 1) { f32x4 vs = v; if (Q8) vs = vs * *(const f32x4*)(sw + u.pn * 256 + bj * 128 + wc * 32 + 8 * fq + 4 * n);
                                *(f32x4*)(bot + ((size_t)(u.pm * 2 + (m - 2)) * 28672) + bj * 14336 + colg + 4 * n) = vs; } }
                    }
                    if (ai == 0 && wr == 0 && fr == 0) {
#pragma unroll
                        for (int m = 0; m < 2; ++m) { f32x4 vs = tof(acc[0][bj][m][n]) * rsv[0][m]; if (Q8) vs = vs * *(const f32x4*)(sw + u.pn * 256 + bj * 128 + wc * 32 + 8 * fq + 4 * n);
                            *(f32x4*)(top + ((size_t)(u.pm * 2 + m) * 28672) + bj * 14336 + colg + 4 * n) = vs; }
                    }
                }
        asm volatile("s_waitcnt lgkmcnt(0)" ::: "memory"); __builtin_amdgcn_s_barrier(); asm volatile("" ::: "memory");
#pragma unroll
        for (int n = 0; n < 2; ++n) {
            f32x4 w0[2], w1[2], w2[2], cbv[2];
#pragma unroll
            for (int bj = 0; bj < 2; ++bj) { const int lc = bj * 128 + wc * 32 + 8 * fq + 4 * n;
                w0[bj] = *(const PG8_LAS f32x4*)(wl + lc); w1[bj] = *(const PG8_LAS f32x4*)(wl + 256 + lc); w2[bj] = *(const PG8_LAS f32x4*)(wl + 512 + lc); cbv[bj] = *(const PG8_LAS f32x4*)(wl + 768 + lc);
                if (Q8) { const f32x4 sc = *(const PG8_LAS f32x4*)(wl + 1024 + lc); w0[bj] = w0[bj] * sc; w1[bj] = w1[bj] * sc; w2[bj] = w2[bj] * sc; }
                const float ks = bj == 0 ? 1.4426950408889634f : 0.6931471805599453f;
                w0[bj] = w0[bj] * ks; w1[bj] = w1[bj] * ks; w2[bj] = w2[bj] * ks; cbv[bj] = cbv[bj] * ks; }
#pragma unroll
            for (int ai = 0; ai < 2; ++ai) {
                const bool has = !(ai == 0 && wr == 0);
                const int pai = wr == 1 ? ai : 0, pwr = wr == 1 ? 0 : 1;
                f32x4 cv[2][4];
#pragma unroll
                for (int bj = 0; bj < 2; ++bj) {
                    f32x4 hm2 = (f32x4){0.f, 0.f, 0.f, 0.f}, hm1 = hm2;
                    if (has && fr == 0) { const PG8_LAS float* hp = xch + ((((((pai * 2 + pwr) * 4 + wc) * 2 + bj) * 2 + n) * 4 + fq) * 2) * 4; hm2 = *(const PG8_LAS f32x4*)(hp); hm1 = *(const PG8_LAS f32x4*)(hp + 4); }
                    const f32x4 a0 = tof(acc[ai][bj][0][n]) * rsv[ai][0], a1 = tof(acc[ai][bj][1][n]) * rsv[ai][1], a2 = tof(acc[ai][bj][2][n]) * rsv[ai][2], a3 = tof(acc[ai][bj][3][n]) * rsv[ai][3];
                    f32x4 s3, s2;
#pragma unroll
                    for (int j = 0; j < 4; ++j) { s3[j] = PG8_DPP(hm1[j], a3[j], 0x111); s2[j] = PG8_DPP(hm2[j], a2[j], 0x111); }
                    cv[bj][0] = cbv[bj] + w2[bj] * a0 + w1[bj] * s3 + w0[bj] * s2;
                    cv[bj][1] = cbv[bj] + w2[bj] * a1 + w1[bj] * a0 + w0[bj] * s3;
                    cv[bj][2] = cbv[bj] + w2[bj] * a2 + w1[bj] * a1 + w0[bj] * a0;
                    cv[bj][3] = cbv[bj] + w2[bj] * a3 + w1[bj] * a2 + w0[bj] * a1;
                }
#pragma unroll
                for (int m = 0; m < 4; ++m) {
                    const f32x4 gu = cv[0][m] * cv[1][m];
                    f32x4 d; d[0] = __builtin_amdgcn_exp2f(-cv[0][m][0]); d[1] = __builtin_amdgcn_exp2f(-cv[0][m][1]); d[2] = __builtin_amdgcn_exp2f(-cv[0][m][2]); d[3] = __builtin_amdgcn_exp2f(-cv[0][m][3]);
                    d = d + 1.0f;
                    f32x4 r; r[0] = __builtin_amdgcn_rcpf(d[0]); r[1] = __builtin_amdgcn_rcpf(d[1]); r[2] = __builtin_amdgcn_rcpf(d[2]); r[3] = __builtin_amdgcn_rcpf(d[3]);
                    const f32x4 o = gu * r;
                    u32x2 w; w.x = cvt_pk_bf16(o[0], o[1]); w.y = cvt_pk_bf16(o[2], o[3]);
                    *(u32x2*)(G + (size_t)(rb0 + ai * HALF + m) * 14336 + colg + 4 * n) = w;
                }
                asm volatile("" ::: "memory");
            }
        }
    }
};
typedef EpiUpConvT<false> EpiUpConv;
typedef EpiUpConvT<true> EpiUpConv8;
struct EpiNull {
    static constexpr bool PERM = true, AFTER_DRAIN = false, I8 = false, APERM = false; static constexpr bool PREFETCH = false;
    float* sink; int never;
    __device__ __forceinline__ void operator()(const f32x4 (&acc)[2][2][4][2], const Unit& u, int wr, int wc, int fr, int fq) const {
        if (never == 12345) {
#pragma unroll
            for (int ai = 0; ai < 2; ++ai)
#pragma unroll
                for (int bj = 0; bj < 2; ++bj)
#pragma unroll
                    for (int m = 0; m < 4; ++m)
#pragma unroll
                        for (int n = 0; n < 2; ++n) *(f32x4*)(sink + ((((ai * 2 + bj) * 4 + m) * 2 + n) * 512 + threadIdx.x) * 4) = acc[ai][bj][m][n];
        }
    }
};
__device__ __forceinline__ f32x4 mma16(bf16x8 a, bf16x8 b, f32x4 c) { return __builtin_amdgcn_mfma_f32_16x16x32_bf16(a, b, c, 0, 0, 0); }
__device__ __forceinline__ i32x4 mma16(bf16x8 a, bf16x8 b, i32x4 c) { return __builtin_amdgcn_mfma_i32_16x16x64_i8(__builtin_bit_cast(i32x4, a), __builtin_bit_cast(i32x4, b), c, 0, 0, 0); }
template <class Epi, class Sched, bool ALIGN_EPI = false, bool SP2 = false>
__device__ __forceinline__ void gemm_phase(PG8_LAS unsigned char* lds, const Gemm g, const Sched& S, const Epi& E, const int wave_id) {
    constexpr bool I8 = Epi::I8;
    typedef typename AccT<I8>::type acc_t;
    const int lane = (int)__builtin_amdgcn_mbcnt_hi(~0u, __builtin_amdgcn_mbcnt_lo(~0u, 0u)), wid = wave_id, tid = wid * 64 + lane, wr = wid >> 2, wc = wid & 3, fr = lane & 15, fq = lane >> 4;
    const int K = g.K, nt = K / BK;
    unsigned voffA[2], voffB[2];
#pragma unroll
    for (int i = 0; i < 2; ++i) { int R, C; stage_rc(tid * 16 + i * 8192, R, C); const int Rb = Epi::PERM ? ((R & ~31) + perm32(R & 31)) : R;
        const int Ra = Epi::APERM ? ((R & ~63) + 4 * (R & 15) + ((R & 63) >> 4)) : R;
        voffA[i] = (unsigned)(Ra * K + C) * 2u; voffB[i] = (unsigned)(Rb * K + C) * 2u; }
    const size_t kstep = (size_t)(BK * 2);
    const size_t hstep = (size_t)HALF * K * 2;
    const size_t tstep = 2 * hstep;
    const unsigned ldsw = (unsigned)wid * 1024u;
    const int aoff = lds_byte(wr * 64 + fr, fq * 8), boff = lds_byte(wc * 32 + fr, fq * 8);
#define PG8_SA(b, h) (((b) * 2 + (h)) * HTB)
#define PG8_SB(b, h) ((4 + (b) * 2 + (h)) * HTB)
#define PG8_STAGE(bufoff, gbase, voff) do { _Pragma("unroll") for (int _i = 0; _i < 2; ++_i) \
        __builtin_amdgcn_global_load_lds((const unsigned*)((const char*)(gbase) + (voff)[_i]), (PG8_LAS unsigned*)(lds + (bufoff) + ldsw + _i * 8192), 16, 0, 0); } while (0)
#define PG8_LDA(dst, b, h) do { _Pragma("unroll") for (int m = 0; m < 4; ++m) _Pragma("unroll") for (int k = 0; k < 2; ++k) dst[m][k] = *(const PG8_LAS bf16x8*)(lds + PG8_SA(b, h) + aoff + m * 2048 + k * 1024); } while (0)
#define PG8_LDB(dst, b, h) do { _Pragma("unroll") for (int n = 0; n < 2; ++n) _Pragma("unroll") for (int k = 0; k < 2; ++k) dst[n][k] = *(const PG8_LAS bf16x8*)(lds + PG8_SB(b, h) + boff + n * 2048 + k * 1024); } while (0)
#define PG8_MMA(ai, bj, At, Bt) do { __builtin_amdgcn_s_setprio(1); _Pragma("unroll") for (int m = 0; m < 4; ++m) _Pragma("unroll") for (int n = 0; n < 2; ++n) _Pragma("unroll") for (int k = 0; k < 2; ++k) \
        acc[ai][bj][m][n] = mma16(Bt[n][k], At[m][k], acc[ai][bj][m][n]); __builtin_amdgcn_s_setprio(0); } while (0)
#define PG8_WAIT_V(n) asm volatile("s_waitcnt vmcnt(" #n ")" ::: "memory")
#define PG8_WAIT_L(n) asm volatile("s_waitcnt lgkmcnt(" #n ")" ::: "memory")
#define PG8_BAR __builtin_amdgcn_s_barrier()
#define PG8_SCHED __builtin_amdgcn_sched_barrier(0)
    Unit cur, nxt; int ui = 0;
    if (!S.next(0, cur)) return;
    acc_t acc[2][2][4][2];
#pragma unroll
    for (int a = 0; a < 2; ++a)
#pragma unroll
        for (int b = 0; b < 2; ++b)
#pragma unroll
            for (int m = 0; m < 4; ++m)
#pragma unroll
                for (int n = 0; n < 2; ++n) acc[a][b][m][n] = acc_t{};
    bf16x8 At[4][2], B0[2][2], B1[2][2];
    const char* cA = (const char*)g.A + (size_t)cur.pm * tstep; const char* cB = (const char*)g.Bt + (size_t)cur.pn * tstep;
    S.a_ready(cur);
    if constexpr (Epi::PREFETCH) E.prefetch(cur, 0, wid, lane);
    if constexpr (SP2) {
        PG8_STAGE(PG8_SB(0, 0), cB, voffB); PG8_STAGE(PG8_SB(0, 1), cB + hstep, voffB); PG8_STAGE(PG8_SA(0, 0), cA, voffA); PG8_STAGE(PG8_SA(0, 1), cA + hstep, voffA);
        if (wr == 1) PG8_BAR;
        PG8_WAIT_V(2); PG8_BAR;
        PG8_STAGE(PG8_SB(1, 0), cB + kstep, voffB); PG8_STAGE(PG8_SA(1, 0), cA + kstep, voffA); PG8_STAGE(PG8_SB(1, 1), cB + hstep + kstep, voffB);
        PG8_WAIT_V(6); PG8_BAR;
    } else {
        PG8_STAGE(PG8_SB(0, 0), cB, voffB); PG8_STAGE(PG8_SA(0, 0), cA, voffA); PG8_STAGE(PG8_SB(0, 1), cB + hstep, voffB); PG8_STAGE(PG8_SA(0, 1), cA + hstep, voffA);
        if (wr == 1) PG8_BAR;
        PG8_WAIT_V(4); PG8_BAR;
        PG8_STAGE(PG8_SB(1, 0), cB + kstep, voffB); PG8_STAGE(PG8_SA(1, 0), cA + kstep, voffA); PG8_STAGE(PG8_SB(1, 1), cB + hstep + kstep, voffB);
        PG8_WAIT_V(6); PG8_BAR;
    }
    for (;;) {
        const bool has_next = S.next(ui + 1, nxt);
        const char* nA = has_next ? (const char*)g.A + (size_t)nxt.pm * tstep : cA; const char* nB = has_next ? (const char*)g.Bt + (size_t)nxt.pn * tstep : cB;
        for (int t = 0; t < nt; t += 2) {
            const bool last = (t == nt - 2);
            const char* a1 = cA + (size_t)(t + 1) * kstep;
            const char* a2 = last ? nA : cA + (size_t)(t + 2) * kstep; const char* b2 = last ? nB : cB + (size_t)(t + 2) * kstep;
            const char* a3 = a2 + kstep; const char* b3 = b2 + kstep;
            if (last && has_next) S.a_ready(nxt);
            if constexpr (SP2) {
            PG8_LDB(B0, 0, 0); PG8_LDB(B1, 0, 1); PG8_SCHED; PG8_LDA(At, 0, 0); PG8_STAGE(PG8_SA(1, 1), a1 + hstep, voffA);
            PG8_WAIT_V(8); PG8_WAIT_L(0); PG8_BAR; PG8_MMA(0, 0, At, B0); PG8_MMA(0, 1, At, B1); PG8_BAR; PG8_SCHED;
            PG8_LDA(At, 0, 1); PG8_STAGE(PG8_SB(0, 0), b2, voffB); PG8_STAGE(PG8_SB(0, 1), b2 + hstep, voffB); PG8_STAGE(PG8_SA(0, 0), a2, voffA);
            PG8_WAIT_V(8); PG8_WAIT_L(0); PG8_BAR; PG8_MMA(1, 0, At, B0); PG8_MMA(1, 1, At, B1); PG8_BAR; PG8_SCHED;
            PG8_LDB(B0, 1, 0); PG8_LDB(B1, 1, 1); PG8_SCHED; PG8_LDA(At, 1, 0); PG8_STAGE(PG8_SA(0, 1), a2 + hstep, voffA);
            PG8_WAIT_V(8); PG8_WAIT_L(0); PG8_BAR; PG8_MMA(0, 0, At, B0); PG8_MMA(0, 1, At, B1); PG8_BAR; PG8_SCHED;
            PG8_LDA(At, 1, 1); PG8_STAGE(PG8_SB(1, 0), b3, voffB); PG8_STAGE(PG8_SB(1, 1), b3 + hstep, voffB); PG8_STAGE(PG8_SA(1, 0), a3, voffA);
            PG8_WAIT_V(8); PG8_WAIT_L(0); PG8_BAR; PG8_MMA(1, 0, At, B0); PG8_MMA(1, 1, At, B1); PG8_BAR; PG8_SCHED;
            } else {
            PG8_LDB(B0, 0, 0); PG8_SCHED; PG8_LDA(At, 0, 0); PG8_STAGE(PG8_SA(1, 1), a1 + hstep, voffA);
            PG8_WAIT_L(8); PG8_BAR; PG8_WAIT_L(0); PG8_MMA(0, 0, At, B0); PG8_BAR; PG8_SCHED;
            PG8_LDB(B1, 0, 1); PG8_STAGE(PG8_SB(0, 0), b2, voffB);
            PG8_BAR; PG8_WAIT_L(0); PG8_MMA(0, 1, At, B1); PG8_BAR;
            PG8_LDA(At, 0, 1); PG8_STAGE(PG8_SA(0, 0), a2, voffA);
            PG8_BAR; PG8_WAIT_L(0); PG8_MMA(1, 0, At, B0); PG8_BAR; PG8_SCHED;
            PG8_STAGE(PG8_SB(0, 1), b2 + hstep, voffB);
            PG8_WAIT_V(6); PG8_BAR; PG8_MMA(1, 1, At, B1); PG8_BAR;
            PG8_LDB(B0, 1, 0); PG8_SCHED; PG8_LDA(At, 1, 0); PG8_STAGE(PG8_SA(0, 1), a2 + hstep, voffA);
            PG8_WAIT_L(8); PG8_BAR; PG8_WAIT_L(0); PG8_MMA(0, 0, At, B0); PG8_BAR; PG8_SCHED;
            PG8_LDB(B1, 1, 1); PG8_STAGE(PG8_SB(1, 0), b3, voffB);
            PG8_BAR; PG8_WAIT_L(0); PG8_MMA(0, 1, At, B1); PG8_BAR;
            PG8_LDA(At, 1, 1); PG8_STAGE(PG8_SA(1, 0), a3, voffA);
            PG8_BAR; PG8_WAIT_L(0); PG8_MMA(1, 0, At, B0); PG8_BAR; PG8_SCHED;
            PG8_STAGE(PG8_SB(1, 1), b3 + hstep, voffB);
            PG8_WAIT_V(6); PG8_BAR; PG8_MMA(1, 1, At, B1); PG8_BAR;
            }
        }
        if constexpr (ALIGN_EPI) { if (wr == 0) PG8_BAR; }
        if constexpr (!Epi::AFTER_DRAIN) { if constexpr (Epi::PREFETCH) E(acc, cur, wr, wc, fr, fq, ui & 1); else E(acc, cur, wr, wc, fr, fq); S.done(cur); }
        if (!has_next) break;
#pragma unroll
        for (int a = 0; a < 2; ++a)
#pragma unroll
            for (int b = 0; b < 2; ++b)
#pragma unroll
                for (int m = 0; m < 4; ++m)
#pragma unroll
                    for (int n = 0; n < 2; ++n) acc[a][b][m][n] = acc_t{};
        cur = nxt; cA = nA; cB = nB; ++ui;
        if constexpr (Epi::PREFETCH) E.prefetch(cur, ui & 1, wid, lane);
        if constexpr (ALIGN_EPI) { if (wr == 1) PG8_BAR; }
    }
    PG8_WAIT_V(0);
    if constexpr (!ALIGN_EPI) { if (wr == 0) PG8_BAR; }
    PG8_BAR;
    if constexpr (Epi::AFTER_DRAIN) { E.fused(acc, cur, wr, wc, fr, fq, lds, wid, lane); S.done(cur); }
#undef PG8_SA
#undef PG8_SB
#undef PG8_STAGE
#undef PG8_LDA
#undef PG8_LDB
#undef PG8_MMA
#undef PG8_WAIT_V
#undef PG8_WAIT_L
#undef PG8_BAR
#undef PG8_SCHED
}
}
#ifndef PG8_SP2
#define PG8_SP2 true
#endif
#ifndef PG8_ALIGN
#define PG8_ALIGN true
#endif
constexpr int NWAVES = 8;
constexpr int NB = 2, NS = 4096, DM = 4096, MR = NB * NS;
constexpr int NHQ = 48, NHA = 24, HD = 128, QKVC = 3 * NHQ * HD;
constexpr int DFF = 14336, F2 = 2 * DFF;
constexpr float ATT_SCALE = 0.08838834764831845f;
constexpr float NORM_EPS = 1e-5f;
constexpr size_t MiB = 1u << 20;
constexpr size_t WS_CTL = 0, CTL_ZERO_BYTES = 2 * MiB;
constexpr size_t WS_SSQ = 256 * 1024, SSQ_SITE = 32 * 1024;
constexpr size_t WS_VSQ = 512 * 1024;
constexpr size_t WS_AMAX = 1 * MiB;
constexpr int AM_WIN = 0, AM_WOUT = 18432, AM_SGWIN = 22528, AM_WUP = 30720, AM_SGWOUT = 30720 + 2 * 28672, AM_END = AM_SGWOUT + 4096;
constexpr size_t WS_SW = 3 * MiB;
constexpr size_t WS_SSX = 1536 * 1024;
constexpr size_t WS_VSX = 1664 * 1024;
constexpr size_t WS_SAH = 4 * MiB;
constexpr size_t WS_ROPE = 2 * MiB;
constexpr size_t WS_KMEAN = 576 * 1024;
constexpr size_t WS_SS = 3 * MiB, SS_SITE = 2 * MiB;
constexpr size_t WS_VS = 13 * MiB;
constexpr size_t WS_SEL = 18 * MiB;
constexpr size_t WS_LSE = 20 * MiB;
constexpr size_t WS_WIN = 32 * MiB;
constexpr size_t WS_WOUT = 176 * MiB;
constexpr size_t WS_SGWIN = 208 * MiB;
constexpr size_t WS_SGWOUT = 272 * MiB;
constexpr size_t WS_WUP = 304 * MiB, WUP_L = 224 * MiB;
constexpr size_t WS_WDOWN = 752 * MiB, WDOWN_L = 112 * MiB;
constexpr size_t WS_XB = 976 * MiB;
constexpr size_t WS_H = 1040 * MiB;
constexpr size_t WS_QKV = 1168 * MiB;
constexpr size_t WS_U = WS_QKV, WS_V = WS_QKV + 64 * MiB;
constexpr size_t WS_O = 1456 * MiB;
constexpr size_t WS_G = 1520 * MiB;
constexpr size_t WS_DO = WS_G;
constexpr size_t WS_APRE = 1744 * MiB;
constexpr size_t WS_TOP = WS_APRE + 128 * MiB, WS_BOT = WS_APRE + 136 * MiB;
constexpr size_t WS_WUP8 = 2192 * MiB, WUP8_L = 112 * MiB;
constexpr size_t WS_HQ8 = 2416 * MiB;
constexpr size_t WS_WIN8 = 2448 * MiB;
constexpr size_t WS_WOUT8 = 2520 * MiB, WS_SGWOUT8 = 2536 * MiB;
constexpr size_t WS_OQ8 = 2552 * MiB;
constexpr size_t WS_SAO = WS_SAH + 65536, WS_SAO2 = WS_SAH + 131072;
constexpr size_t WS_END = 2584 * MiB;
constexpr int RING_OFF = 0, RING_BYTES = 131072;
constexpr int SCR_BYTES = 133120;
constexpr int LDSCTL_OFF = SCR_BYTES, MISC_OFF = LDSCTL_OFF + 320;
constexpr int XTRA_OFF = SCR_BYTES + 1024;
constexpr int LDS_BYTES = 163840;
static_assert(MISC_OFF + 128 <= XTRA_OFF, "LDS map");
constexpr int CW_TMO = 0, CW_BAR = 4096;

#define GAS __attribute__((address_space(1)))
#define LAS __attribute__((address_space(3)))
typedef unsigned short bf16;
typedef unsigned v4u __attribute__((ext_vector_type(4)));
typedef unsigned v2u __attribute__((ext_vector_type(2)));
typedef float f32x4 __attribute__((ext_vector_type(4)));
typedef float f32x2 __attribute__((ext_vector_type(2)));
#define LDS_WAIT() asm volatile("s_waitcnt lgkmcnt(0)" ::: "memory")
#define VM_WAIT() asm volatile("s_waitcnt vmcnt(0)" ::: "memory")
__device__ __forceinline__ unsigned f2bf(float f) { unsigned u = __builtin_bit_cast(unsigned, f); return (u + 0x7fffu + ((u >> 16) & 1u)) >> 16; }
__device__ __forceinline__ unsigned pk2(float lo, float hi) { return f2bf(lo) | (f2bf(hi) << 16); }
__device__ __forceinline__ float bflo(unsigned w) { return __builtin_bit_cast(float, w << 16); }
__device__ __forceinline__ float bfhi(unsigned w) { return __builtin_bit_cast(float, w & 0xffff0000u); }
__device__ __forceinline__ float bf1(bf16 h) { return __builtin_bit_cast(float, (unsigned)h << 16); }
namespace att {
typedef unsigned short bf16;
typedef short bf16x8 __attribute__((ext_vector_type(8)));
typedef short s16x4 __attribute__((ext_vector_type(4)));
typedef float f32x16 __attribute__((ext_vector_type(16)));
typedef float f32x4 __attribute__((ext_vector_type(4)));
typedef unsigned u32x4 __attribute__((ext_vector_type(4)));
template <class A, class Bt> struct same_t { static constexpr bool v = false; };
template <class A> struct same_t<A, A> { static constexpr bool v = true; };
constexpr int D = 128;
constexpr float SCALE = 0.08838834764831845f, THR = 8.f;
constexpr int NW = 8, QBLK = 32, KVBLK = 64, QB = NW * QBLK;
constexpr int SHM_V = KVBLK * D * 2, SHM_K = KVBLK * D * 2;
constexpr int ATT_LDS_BYTES = 2 * SHM_V + 2 * SHM_K + NW * 64 * 4;
#define KSWZ(row, colB) ((row) * 256 + ((colB) ^ (((row) & 7) << 4)))
#define SBAR() __builtin_amdgcn_sched_barrier(0)
__device__ __forceinline__ int v_st(int k, int c) { const int kk = (k & ~0xC) | ((k & 4) << 1) | ((k & 8) >> 1); return ((kk >> 3) * 4 + (c >> 5)) * 512 + ((kk & 7) * 32 + (c & 31)) * 2; }
__device__ __forceinline__ int v_rd_base(int lane) { return ((lane & 3) << 3) | (((lane >> 2) & 3) << 6) | (((lane >> 4) & 1) << 5) | (((lane >> 5) & 1) << 8); }
constexpr int v_rd_off(int d0, int ks, int half) { return d0 * 512 + ks * 4096 + half * 2048; }
__device__ __forceinline__ int crow(int r, int hi) { return (r & 3) + 8 * (r >> 2) + 4 * hi; }
__device__ __forceinline__ unsigned cvtpk(float lo, float hi) {
    unsigned r; asm volatile("v_cvt_pk_bf16_f32 %0, %1, %2" : "=v"(r) : "v"(lo), "v"(hi)); return r;
}
__device__ __forceinline__ bf16x8 pack8(f32x4 a, f32x4 b) {
    u32x4 w = {cvtpk(a[0], a[1]), cvtpk(a[2], a[3]), cvtpk(b[0], b[1]), cvtpk(b[2], b[3])};
    return *reinterpret_cast<bf16x8*>(&w);
}
template <class T> __device__ __forceinline__ bf16x8 load8(const T* p) {
    if constexpr (same_t<T, float>::v) { return pack8(*(const f32x4*)p, *(const f32x4*)(p + 4)); }
    else { return *reinterpret_cast<const bf16x8*>(p); }
}
__device__ __forceinline__ void mask_tile(f32x16& p0, f32x16& p1, int dq, unsigned W) {
    const float NEG = -__builtin_inff();
#pragma unroll
    for (int r = 0; r < 16; ++r) {
        const int c = (r & 3) + 8 * (r >> 2);
        if ((unsigned)(dq - c) >= W) p0[r] = NEG;
        if ((unsigned)(dq - c - 32) >= W) p1[r] = NEG;
    }
}
__device__ __forceinline__ void partialSM(f32x16& p0, f32x16& p1, float& m_reg, float& mn, float& alpha, bool dead = false) {
    float pmax = p0[0]; for (int r = 1; r < 16; ++r) pmax = fmaxf(pmax, p0[r]); for (int r = 0; r < 16; ++r) pmax = fmaxf(pmax, p1[r]);
    { auto rr = __builtin_amdgcn_permlane32_swap(__float_as_uint(pmax), __float_as_uint(pmax), false, false);
      pmax = fmaxf(__uint_as_float(rr[0]), __uint_as_float(rr[1])); }
    if (dead) pmax = -__builtin_inff();
    constexpr float C2 = 1.4426950408889634f * SCALE;
    if (__builtin_expect(__all((pmax - m_reg) * SCALE <= THR), 1)) { mn = m_reg; alpha = 1.f; }
    else { mn = fmaxf(m_reg, pmax); alpha = __builtin_amdgcn_exp2f((m_reg - mn) * C2); m_reg = mn; }
    const float mnL = dead ? -__builtin_inff() : -mn * C2;
    for (int r = 0; r < 16; ++r) p0[r] = fmaf(p0[r], C2, mnL); for (int r = 0; r < 16; ++r) p1[r] = fmaf(p1[r], C2, mnL);
    for (int r = 0; r < 16; ++r) p0[r] = __builtin_amdgcn_exp2f(p0[r]);
}
__device__ __forceinline__ void finishSM(f32x16& p0, f32x16& p1, float alpha, float& l_reg, bf16x8& pa0, bf16x8& pa1, bf16x8& pa2, bf16x8& pa3) {
    for (int r = 0; r < 16; ++r) p1[r] = __builtin_amdgcn_exp2f(p1[r]);
    float ps = 0; for (int r = 0; r < 16; ++r) ps += p0[r]; for (int r = 0; r < 16; ++r) ps += p1[r];
    { auto rr = __builtin_amdgcn_permlane32_swap(__float_as_uint(ps), __float_as_uint(ps), false, false);
      ps = __uint_as_float(rr[0]) + __uint_as_float(rr[1]); }
    l_reg = l_reg * alpha + ps;
#define PK4(P, B_, OUT) do { unsigned a0 = cvtpk(P[B_+0], P[B_+1]), a1 = cvtpk(P[B_+2], P[B_+3]);                          \
        unsigned b0 = cvtpk(P[B_+4], P[B_+5]), b1 = cvtpk(P[B_+6], P[B_+7]);                                             \
        auto r0 = __builtin_amdgcn_permlane32_swap(a0, b0, false, false); auto r1 = __builtin_amdgcn_permlane32_swap(a1, b1, false, false); \
        u32x4 w = {r0[0], r1[0], r0[1], r1[1]}; OUT = *reinterpret_cast<bf16x8*>(&w); } while (0)
    PK4(p0, 0, pa0); PK4(p0, 8, pa1); PK4(p1, 0, pa2); PK4(p1, 8, pa3);
#undef PK4
}
template <int KB, bool SK>
__device__ __forceinline__ void qkt(f32x16& p0, f32x16& p1, const char* K_lds, int r32, int hi, const bf16x8* qr, bool act) {
    if (SK && !act) { const float NEG = -__builtin_inff();
#pragma unroll
        for (int r = 0; r < 16; ++r) { p0[r] = NEG; p1[r] = NEG; } return; }
    p0 = f32x16{}; p1 = f32x16{};
    const char* kb[4];
#pragma unroll
    for (int dd = 0; dd < 4; ++dd) kb[dd] = K_lds + KB * SHM_K + KSWZ(r32, (dd * 16 + hi * 8) * 2);
#pragma unroll
    for (int d0 = 0; d0 < 8; ++d0) { const char* a = kb[d0 & 3] + (d0 >> 2) * 128;
        bf16x8 b0 = *reinterpret_cast<const bf16x8*>(a);
        bf16x8 b1 = *reinterpret_cast<const bf16x8*>(a + 32 * 256);
        p0 = __builtin_amdgcn_mfma_f32_32x32x16_bf16(b0, qr[d0], p0, 0, 0, 0);
        p1 = __builtin_amdgcn_mfma_f32_32x32x16_bf16(b1, qr[d0], p1, 0, 0, 0); }
}
template <int VB, bool SK>
__device__ __forceinline__ void pv_tile(f32x16* o, int vb0, bf16x8 pa0, bf16x8 pa1, bf16x8 pa2, bf16x8 pa3, bool act) {
    if (SK && !act) return;
#define TRRD(dst, off) asm volatile("ds_read_b64_tr_b16 %0, %1 offset:%2" : "=&v"(dst) : "v"(vb0), "i"(off) : "memory")
#define PV_D0(d0) do { s16x4 l0, l1, l2, l3, h0, h1, h2, h3; constexpr int b_ = VB * SHM_V + v_rd_off(d0, 0, 0);     \
        TRRD(l0, b_); TRRD(h0, b_ + 2048); TRRD(l1, b_ + 4096); TRRD(h1, b_ + 6144); TRRD(l2, b_ + 8192); TRRD(h2, b_ + 10240); TRRD(l3, b_ + 12288); TRRD(h3, b_ + 14336); \
        asm volatile("s_waitcnt lgkmcnt(0)" ::: "memory"); SBAR();                 \
        o[d0] = __builtin_amdgcn_mfma_f32_32x32x16_bf16(pa0, (bf16x8){l0[0], l0[1], l0[2], l0[3], h0[0], h0[1], h0[2], h0[3]}, o[d0], 0, 0, 0);   \
        o[d0] = __builtin_amdgcn_mfma_f32_32x32x16_bf16(pa1, (bf16x8){l1[0], l1[1], l1[2], l1[3], h1[0], h1[1], h1[2], h1[3]}, o[d0], 0, 0, 0);   \
        o[d0] = __builtin_amdgcn_mfma_f32_32x32x16_bf16(pa2, (bf16x8){l2[0], l2[1], l2[2], l2[3], h2[0], h2[1], h2[2], h2[3]}, o[d0], 0, 0, 0);   \
        o[d0] = __builtin_amdgcn_mfma_f32_32x32x16_bf16(pa3, (bf16x8){l3[0], l3[1], l3[2], l3[3], h3[0], h3[1], h3[2], h3[3]}, o[d0], 0, 0, 0); } while (0)
    PV_D0(0); PV_D0(1); PV_D0(2); PV_D0(3);
#undef PV_D0
#undef TRRD
}

template <class TIn, class TOut> struct BlockRef { const TIn* Q; const TIn* K; const TIn* V; TOut* O; int P0; const __attribute__((address_space(3))) unsigned short* sel; float* L; };
template <class TIn> struct Seam {
    bf16x8 qr[8];
    bf16x8 st_v0, st_v1, st_k0, st_k1; f32x4 sf0, sf1, sf2, sf3;
    f32x4 tq[16];
};
__device__ __forceinline__ int swa_jlo(int P0, int W) { const int lowk = P0 - W + 1; return lowk > 0 ? lowk / KVBLK : 0; }
#define ROW(p, k0, rr) ((p) + (size_t)((k0) + (rr)) * rs_ + sc)
#define ROWN(p, k0, rr) ((p) + (size_t)((k0) + (rr)) * rsn_ + sc)
#define VMW() asm volatile("s_waitcnt vmcnt(0)" ::: "memory")
#define VMWN(n) asm volatile("s_waitcnt vmcnt(%0)" :: "i"(n) : "memory")
#define SLOAD_H(Kp, Vp, k0) do { S.st_v0 = load8<TIn>(ROW(Vp, k0, sr)); S.st_v1 = load8<TIn>(ROW(Vp, k0, 32 + sr));              \
                         S.st_k0 = load8<TIn>(ROW(Kp, k0, sr)); S.st_k1 = load8<TIn>(ROW(Kp, k0, 32 + sr)); } while (0)
#define SLOAD_HN(Kp, Vp, k0) do { S.st_v0 = load8<TIn>(ROWN(Vp, k0, sr)); S.st_v1 = load8<TIn>(ROWN(Vp, k0, 32 + sr));              \
                         S.st_k0 = load8<TIn>(ROWN(Kp, k0, sr)); S.st_k1 = load8<TIn>(ROWN(Kp, k0, 32 + sr)); } while (0)
#define SWRITE_HK(bf) do { *(bf16x8*)(K_lds + (bf) * SHM_K + kws) = S.st_k0; *(bf16x8*)(K_lds + (bf) * SHM_K + kws + 32 * 256) = S.st_k1; } while (0)
#define SWRITE_HV(bf) do { *(bf16x8*)(V_lds + (bf) * SHM_V + vst0) = S.st_v0; *(bf16x8*)(V_lds + (bf) * SHM_V + vst1) = S.st_v1; } while (0)
#define SWRITE_H(bf) do { SWRITE_HV(bf); SWRITE_HK(bf); } while (0)
#define SLOAD_F(p, k0) do { S.sf0 = *(const f32x4*)ROW(p, k0, sr); S.sf1 = *(const f32x4*)(ROW(p, k0, sr) + 4);                \
                            S.sf2 = *(const f32x4*)ROW(p, k0, 32 + sr); S.sf3 = *(const f32x4*)(ROW(p, k0, 32 + sr) + 4); } while (0)
#define SWRITE_KF(bf) do { *(bf16x8*)(K_lds + (bf) * SHM_K + kws) = pack8(S.sf0, S.sf1); *(bf16x8*)(K_lds + (bf) * SHM_K + kws + 32 * 256) = pack8(S.sf2, S.sf3); } while (0)
#define SWRITE_VF(bf) do { *(bf16x8*)(V_lds + (bf) * SHM_V + vst0) = pack8(S.sf0, S.sf1); *(bf16x8*)(V_lds + (bf) * SHM_V + vst1) = pack8(S.sf2, S.sf3); } while (0)
template <class TIn, class TOut, int RSC, int W>
__device__ __forceinline__ void causal_swa_prime(const BlockRef<TIn, TOut>& cur, char* lds, Seam<TIn>& S) {
    constexpr bool F32 = same_t<TIn, float>::v;
    int tid_ = threadIdx.x; asm volatile("" : "+v"(tid_));
    const int tid = tid_, wid = __builtin_amdgcn_readfirstlane(tid >> 6), lane = tid & 63, r32 = lane & 31, hi = lane >> 5;
    const int sr = tid >> 4, sc = (tid & 15) * 8, kws = KSWZ(sr, sc * 2); char* K_lds = lds + 2 * SHM_V;
    const int kb0 = swa_jlo(cur.P0, W) * KVBLK; constexpr int rs_ = RSC;
    for (int d0 = 0; d0 < 8; ++d0) S.qr[d0] = load8<TIn>(cur.Q + (size_t)(wid * QBLK + r32) * rs_ + d0 * 16 + hi * 8);
    if constexpr (F32) { SLOAD_F((const float*)cur.K, kb0); VMW(); SWRITE_KF(0); SBAR(); SLOAD_F((const float*)cur.V, kb0); }
    else { SLOAD_H(cur.K, cur.V, kb0); VMW(); SWRITE_HK(0); }
    __syncthreads();
}
template <class TIn, class TOut, bool SKP, int MODE, int RSC, int RSN, int OSC, int W, int WN, int skv>
__device__ __forceinline__ void causal_swa_block(const BlockRef<TIn, TOut>& cur, const BlockRef<TIn, TOut>& nxt, char* lds, Seam<TIn>& S) {
    constexpr bool F32 = same_t<TIn, float>::v; static_assert(!F32, "bf16 inputs only in this build");
    constexpr int rs_ = RSC, rsn_ = RSN, os_ = OSC;
    int tid_ = threadIdx.x; asm volatile("" : "+v"(tid_));
    const int tid = tid_, wid = __builtin_amdgcn_readfirstlane(tid >> 6), lane = tid & 63, r32 = lane & 31, hi = lane >> 5;
    const int j_lo = swa_jlo(cur.P0, W);
    int j_hi = (cur.P0 + QB - 1) / KVBLK + 1; if (j_hi > skv / KVBLK) j_hi = skv / KVBLK;
    const int NT = j_hi - j_lo;
    const int kbn = swa_jlo(nxt.P0, WN) * KVBLK;
    const int qlo = cur.P0 + wid * QBLK, qm = qlo + r32 - 4 * hi;
    char* V_lds = lds; char* K_lds = lds + 2 * SHM_V;
    float* ws = (float*)(lds + 2 * SHM_V + 2 * SHM_K) + wid * 64; float* li_l = ws, * al_l = ws + 32;
    float m_reg = -1e30f, l_reg = 0; f32x16 o[4] = {};
    unsigned selm = 0u; if constexpr (MODE == 0) selm = cur.sel[wid * QBLK + r32];
    bool deadq = false;
    const int sr = tid >> 4, sc = (tid & 15) * 8, vst0 = v_st(sr, sc), vst1 = v_st(32 + sr, sc), kws = KSWZ(sr, sc * 2);
    const int vb0 = (int)(uintptr_t)V_lds + v_rd_base(lane);
    const TIn* Kh = cur.K; const TIn* Vh = cur.V;
#define RESC(a) do { if (__any((a) < 1.f)) { if (hi == 0) al_l[r32] = (a); asm volatile("s_waitcnt lgkmcnt(0)" ::: "memory");              \
                     for (int d_ = 0; d_ < 4; ++d_) for (int r = 0; r < 16; ++r) o[d_][r] *= al_l[crow(r, hi)]; } } while (0)
#define KBASE(t) ((j_lo + (t)) * KVBLK)
#define ACT(t) (KBASE(t) <= qlo + QBLK - 1 && KBASE(t) + KVBLK - 1 >= qlo - W + 1)
#define MASKT(P0_, P1_, t) do { const int kb_ = KBASE(t); if ((!SK || ACT(t)) && (kb_ + KVBLK - 1 > qlo || kb_ <= qlo + QBLK - 1 - W)) mask_tile(P0_, P1_, qm - kb_, (unsigned)W); \
        if constexpr (MODE == 0) { deadq = (kb_ < cur.P0) && (((selm >> (kb_ >> 8)) & 1u) == 0u); } } while (0)
    constexpr int NQL = F32 ? 16 : 8;
    constexpr bool SK = SKP && !F32;
#define SEAM_K0() do { VMWN(NQL); if constexpr (F32) { SWRITE_KF(0); SBAR(); SLOAD_F((const float*)nxt.V, kbn); } else { SWRITE_HK(0); } SBAR(); } while (0)
    f32x16 pA0, pA1, pB0, pB1; float mnA, mnB, alA, alB; bf16x8 pa0, pa1, pa2, pa3;
    if constexpr (F32) { VMW(); SWRITE_VF(0); SBAR(); } else { SWRITE_HV(0); SBAR(); }
    if (NT > 1) { if constexpr (F32) SLOAD_F((const float*)Kh, KBASE(1)); else SLOAD_H(Kh, Vh, KBASE(1)); }
    SBAR(); qkt<0, SK>(pA0, pA1, K_lds, r32, hi, S.qr, ACT(0));
    if constexpr (F32) { if (NT > 1) { VMW(); SWRITE_KF(1); SBAR(); SLOAD_F((const float*)Vh, KBASE(1)); } }
    MASKT(pA0, pA1, 0); partialSM(pA0, pA1, m_reg, mnA, alA, deadq);
    if (NT > 1) { VMW(); if constexpr (F32) { SWRITE_VF(1); SBAR(); if (NT > 2) SLOAD_F((const float*)Kh, KBASE(2)); } else SWRITE_H(1); }
    __syncthreads();
#define HALF_STEP(PX0, PX1, mnX, alX, PY0, PY1, alY, t, KB, VB, SB) do {                                                      \
        SBAR(); qkt<KB, SK>(PX0, PX1, K_lds, r32, hi, S.qr, ACT(t));                                             \
        finishSM(PY0, PY1, alY, l_reg, pa0, pa1, pa2, pa3); SBAR();                                                           \
        if ((t) + 1 < NT) { if constexpr (F32) { VMW(); SWRITE_KF(SB); SBAR(); SLOAD_F((const float*)Vh, KBASE((t) + 1)); }  \
                            else { SLOAD_H(Kh, Vh, KBASE((t) + 1)); } SBAR(); }                                               \
        pv_tile<VB, SK>(o, vb0, pa0, pa1, pa2, pa3, ACT((t) - 1)); MASKT(PX0, PX1, (t)); partialSM(PX0, PX1, m_reg, mnX, alX, deadq);                                        \
        __syncthreads();                                                                                                      \
        if ((t) + 1 < NT) { VMW(); if constexpr (F32) { SWRITE_VF(SB); SBAR(); if ((t) + 2 < NT) SLOAD_F((const float*)Kh, KBASE((t) + 2)); } \
                            else { SWRITE_H(SB); } }                                                                          \
        RESC(alX); __syncthreads(); } while (0)
    for (int t = 1; t + 1 < NT; t += 2) {
        HALF_STEP(pB0, pB1, mnB, alB, pA0, pA1, alA, t, 1, 0, 0);
        HALF_STEP(pA0, pA1, mnA, alA, pB0, pB1, alB, t + 1, 0, 1, 1);
    }
    const bool even = (NT & 1) == 0;
    if (even) { SBAR(); qkt<1, SK>(pB0, pB1, K_lds, r32, hi, S.qr, ACT(NT - 1)); SBAR(); }
#define QROW(e) (nxt.Q + (size_t)(wid * QBLK + r32) * rsn_ + ((e) >> 1) * 16 + hi * 8 + ((e) & 1) * 4)
    if constexpr (F32) { SLOAD_F((const float*)nxt.K, kbn); SBAR();
#pragma unroll
        for (int e = 0; e < 8; ++e) S.tq[e] = *(const f32x4*)QROW(e); }
    else { SLOAD_HN(nxt.K, nxt.V, kbn); SBAR();
#pragma unroll
        for (int d0 = 0; d0 < 8; ++d0) S.qr[d0] = load8<TIn>(nxt.Q + (size_t)(wid * QBLK + r32) * rsn_ + d0 * 16 + hi * 8); }
    SBAR();
    finishSM(pA0, pA1, alA, l_reg, pa0, pa1, pa2, pa3); SBAR();
    if constexpr (F32) {
#pragma unroll
        for (int e = 8; e < 16; ++e) S.tq[e] = *(const f32x4*)QROW(e); SBAR(); }
#undef QROW
    pv_tile<0, SK>(o, vb0, pa0, pa1, pa2, pa3, ACT(even ? NT - 2 : NT - 1));
    if (even) { MASKT(pB0, pB1, NT - 1); partialSM(pB0, pB1, m_reg, mnB, alB, deadq); __syncthreads(); RESC(alB);
        finishSM(pB0, pB1, alB, l_reg, pa0, pa1, pa2, pa3); SBAR(); pv_tile<1, SK>(o, vb0, pa0, pa1, pa2, pa3, ACT(NT - 1)); }
    SBAR(); SEAM_K0();
    if (hi == 0) li_l[r32] = l_reg; asm volatile("s_waitcnt lgkmcnt(0)" ::: "memory");
    if constexpr (MODE == 1) { if (hi == 0) cur.L[(size_t)(wid * QBLK + r32) * (RSC / 128 * 24)] = m_reg * SCALE + __logf(l_reg); }
    float rli[16];
#pragma unroll
    for (int r = 0; r < 16; ++r) rli[r] = __builtin_amdgcn_rcpf(li_l[crow(r, hi)]);
    TOut* Ow = cur.O + (size_t)(wid * QBLK) * os_;
#pragma unroll
    for (int r = 0; r < 16; ++r) { const int orow = crow(r, hi);
#pragma unroll
        for (int d0 = 0; d0 < 4; ++d0) { const float v = o[d0][r] * rli[r];
            if constexpr (same_t<TOut, float>::v) { Ow[(size_t)orow * os_ + d0 * 32 + r32] = v; }
            else { const float vn = __shfl_xor(v, 1);
                   if ((r32 & 1) == 0) *(unsigned*)(Ow + (size_t)orow * os_ + d0 * 32 + r32) = cvtpk(v, vn); } } }
    if constexpr (F32) {
#pragma unroll
        for (int d0 = 0; d0 < 8; ++d0) S.qr[d0] = pack8(S.tq[2 * d0], S.tq[2 * d0 + 1]); }
    __syncthreads();
#undef RESC
#undef KBASE
#undef ACT
#undef MASKT
#undef SEAM_K0
#undef HALF_STEP
}
#undef ROW
#undef ROWN
#undef SLOAD_HN
#undef VMW
#undef VMWN
#undef SLOAD_H
#undef SWRITE_HK
#undef SWRITE_HV
#undef SWRITE_H
#undef SLOAD_F
#undef SWRITE_KF
#undef SWRITE_VF
}
#define XB_TMO      128
#define XB_XCNT(j)  (256  + 64 * (j))
#define XB_XSUB(j)  (1280 + 64 * (j))
#define XB_XGEN(j)  (2304 + 64 * (j))
#define XB_TOP      3328
#define XB_TOPGEN   3392
#define XCD_BAR_WORDS 3456
#define XB_SPIN_CAP (1u << 18)

__device__ __forceinline__ unsigned xb_ld(unsigned* p)              { return __hip_atomic_load(p, __ATOMIC_RELAXED, __HIP_MEMORY_SCOPE_AGENT); }
__device__ __forceinline__ unsigned xb_add(unsigned* p, unsigned v) { return __hip_atomic_fetch_add(p, v, __ATOMIC_RELAXED, __HIP_MEMORY_SCOPE_AGENT); }
__device__ __forceinline__ unsigned xb_xcc_id() { return (unsigned)__builtin_amdgcn_s_getreg((3 << 11) | 20) & 0xFu; }
#define XB_SPIN(cond, bar) do { unsigned _sp = 0; while (cond) { __builtin_amdgcn_s_sleep(1); \
    if ((++_sp & 255u) == 0u) { if (xb_ld(&(bar)[XB_TMO])) break; if (_sp > XB_SPIN_CAP) { atomicAdd(&(bar)[XB_TMO], 1u); break; } } } } while (0)

struct XcdBarrier {
    unsigned* bar; unsigned x;
    volatile LAS unsigned* st;
};

__device__ __forceinline__ XcdBarrier xcd_barrier_post(unsigned* bar, volatile LAS unsigned* st) {
    XcdBarrier b; b.bar = bar; b.x = xb_xcc_id(); b.st = st;
    if (threadIdx.x == 0) (void)xb_add(&bar[XB_XCNT(b.x)], 1u);
    return b;
}
__device__ __forceinline__ void xcd_barrier_complete(unsigned* bar, unsigned x, unsigned& nloc, unsigned& nx) {
    const unsigned G = gridDim.x * gridDim.y * gridDim.z;
    unsigned sum, cnt, mine, sp = 0u;
    for (;;) {
        sum = 0u; cnt = 0u; mine = 0u;
#pragma unroll
        for (unsigned j = 0; j < 16; ++j) { const unsigned c = xb_ld(&bar[XB_XCNT(j)]); sum += c; cnt += (c > 0u) ? 1u : 0u; mine = (j == x) ? c : mine; }
        if (sum == G) break;
        __builtin_amdgcn_s_sleep(1);
        if ((++sp & 255u) == 0u) { if (xb_ld(&bar[XB_TMO])) break; if (sp > XB_SPIN_CAP) { atomicAdd(&bar[XB_TMO], 1u); break; } }
    }
    nloc = mine > 0u ? mine : 1u; nx = cnt > 0u ? cnt : 1u;
}

__device__ __forceinline__ void xcd_barrier(const XcdBarrier& b) {
    asm volatile("s_waitcnt vmcnt(0)" ::: "memory");
    __syncthreads();
    if (threadIdx.x == 0) {
        unsigned* bar = b.bar;
        __builtin_amdgcn_s_waitcnt(0);
        unsigned nloc = b.st[0], nx = b.st[1];
        if (nloc == 0u) { xcd_barrier_complete(bar, b.x, nloc, nx); b.st[0] = nloc; b.st[1] = nx; }
        const unsigned old = xb_add(&bar[XB_XSUB(b.x)], 1u);
        const unsigned gen = old / nloc;
        if (old + 1u == (gen + 1u) * nloc) {
            __builtin_amdgcn_fence(__ATOMIC_RELEASE, "agent");
            asm volatile("s_waitcnt vmcnt(0)" ::: "memory");
            const unsigned og = xb_add(&bar[XB_TOP], 1u);
            const unsigned tg = og / nx;
            if (og + 1u == (tg + 1u) * nx) xb_add(&bar[XB_TOPGEN], 1u);
            else XB_SPIN(xb_ld(&bar[XB_TOPGEN]) == tg, bar);
            __builtin_amdgcn_fence(__ATOMIC_ACQUIRE, "agent");
            xb_add(&bar[XB_XGEN(b.x)], 1u);
            asm volatile("s_waitcnt vmcnt(0)" ::: "memory");
        } else {
            XB_SPIN(xb_ld(&bar[XB_XGEN(b.x)]) == gen, bar);
            __builtin_amdgcn_fence(__ATOMIC_ACQUIRE, "agent");
            asm volatile("s_waitcnt vmcnt(0)" ::: "memory");
        }
    }
    __syncthreads();
}
struct Frame {
    LAS unsigned char* lds;
    volatile LAS unsigned* MISC;
    unsigned* ctl;
    int wave, G, gw, NGW;
    unsigned char* ws;
    const float* x; const int* pos;
    const float *attn_norm, *attn_w_in, *attn_w_out, *sg_norm, *sg_w_in, *sg_b_in, *sg_v_gain, *sg_v_bias, *sg_w_s, *sg_b_s, *sg_w_out, *ffn_norm, *ffn_w_up, *ffn_conv_w, *ffn_conv_b, *ffn_w_down, *final_norm;
    float* out;
};
#define LANE_ID() ((int)__builtin_amdgcn_mbcnt_hi(~0u, __builtin_amdgcn_mbcnt_lo(~0u, 0u)))
__device__ __forceinline__ float wave_sum(float v) {
#pragma unroll
    for (int o = 1; o < 64; o <<= 1) v += __shfl_xor(v, o);
    return v;
}
__device__ __forceinline__ float wave_max(float v) {
#pragma unroll
    for (int o = 1; o < 64; o <<= 1) v = fmaxf(v, __shfl_xor(v, o));
    return v;
}
__device__ __forceinline__ float ss_rstd(const float* ss, int r) { return pg8::rstd_from_ss(ss, r); }

__device__ __forceinline__ unsigned q8m(float x, float inv) { return __builtin_bit_cast(unsigned, __builtin_fmaf(x, inv, 12582912.0f)); }
__device__ __forceinline__ unsigned q8(float x, float inv) { return q8m(x, inv) & 0xffu; }
__device__ __forceinline__ unsigned q8x2(float a, float b, float inv) { return __builtin_amdgcn_perm(q8m(b, inv), q8m(a, inv), 0x0c0c0400u); }
__device__ __forceinline__ unsigned q8x4(float a, float b, float c, float d, float inv) { return __builtin_amdgcn_perm(q8m(b, inv), q8m(a, inv), 0x0c0c0400u) | __builtin_amdgcn_perm(q8m(d, inv), q8m(c, inv), 0x04000c0cu); }
__device__ __forceinline__ void unpack8(const v4u w, float (&f)[8]) { f[0] = bflo(w.x); f[1] = bfhi(w.x); f[2] = bflo(w.y); f[3] = bfhi(w.y); f[4] = bflo(w.z); f[5] = bfhi(w.z); f[6] = bflo(w.w); f[7] = bfhi(w.w); }
struct MapId { __device__ __forceinline__ int operator()(int n) const { return n; } };
struct MapUp { __device__ __forceinline__ int operator()(int n) const { return n < DFF ? ((n >> 7) << 8) + (n & 127) : (((n - DFF) >> 7) << 8) + 128 + ((n - DFF) & 127); } };
template <class RowMap>
__device__ __forceinline__ void transpose_item(const float* W, int K, int N, const float* gain, bf16* WT, RowMap rm, LAS float* scr, int item, int lane, unsigned* amax = nullptr) {
    const int nblk = N / 64, kb = item / nblk, nb = item - kb * nblk, k0 = 64 * kb, n0 = 64 * nb;
    const int lr = lane >> 4, lc = (lane & 15) * 4;
    f32x4 v[16];
#pragma unroll
    for (int i = 0; i < 16; ++i) v[i] = __builtin_nontemporal_load((const f32x4*)(W + (size_t)(k0 + 4 * i + lr) * N + n0 + lc));
#pragma unroll
    for (int i = 0; i < 16; ++i) { const int kk = 4 * i + lr; f32x4 x = v[i]; if (gain) x = x * gain[k0 + kk]; LAS float* d = scr + kk * 65 + lc; d[0] = x[0]; d[1] = x[1]; d[2] = x[2]; d[3] = x[3]; }
    LDS_WAIT(); asm volatile("" ::: "memory");
    const int c = lane & 7;
#pragma unroll
    for (int j = 0; j < 8; ++j) { const int n = (lane >> 3) + 8 * j; const LAS float* s = scr + (8 * c) * 65 + n;
        v4u o; o.x = pk2(s[0 * 65], s[1 * 65]); o.y = pk2(s[2 * 65], s[3 * 65]); o.z = pk2(s[4 * 65], s[5 * 65]); o.w = pk2(s[6 * 65], s[7 * 65]);
        *(v4u*)(WT + (size_t)rm(n0 + n) * K + k0 + 8 * c) = o;
        if (amax) {
            float mx = fmaxf(fmaxf(fmaxf(fabsf(s[0 * 65]), fabsf(s[1 * 65])), fmaxf(fabsf(s[2 * 65]), fabsf(s[3 * 65]))), fmaxf(fmaxf(fabsf(s[4 * 65]), fabsf(s[5 * 65])), fmaxf(fabsf(s[6 * 65]), fabsf(s[7 * 65]))));
            mx = fmaxf(mx, __shfl_xor(mx, 1)); mx = fmaxf(mx, __shfl_xor(mx, 2)); mx = fmaxf(mx, __shfl_xor(mx, 4));
            if (c == 0) atomicMax(amax + rm(n0 + n), __builtin_bit_cast(unsigned, mx));
        } }
    LDS_WAIT(); asm volatile("" ::: "memory");
}
__device__ __forceinline__ void sincos_d(double a, double& sn, double& cs) {
    const double n = __builtin_rint(a * 0.15915494309189535);
    const double r = a - n * 6.283185307179586;
    const double r2 = r * r;
    double ts = r, tc = 1.0, s = r, c = 1.0;
#pragma unroll
    for (int k = 1; k <= 15; ++k) { tc = -tc * r2 / (double)((2 * k - 1) * (2 * k)); ts = -ts * r2 / (double)((2 * k) * (2 * k + 1)); c += tc; s += ts; }
    sn = s; cs = c;
}
struct TItem { const float* W; const float* gain; bf16* WT; unsigned* amax; int K, N, mapup, k0, n0; };
__device__ __forceinline__ bool titem_decode(const Frame& F, int it, TItem& t) {
    constexpr int I_SQ = 64 * (DM / 64), I_SGIN = 64 * (2 * DM / 64), I_DN = (DFF / 64) * (DM / 64);
    constexpr int NITEMS = I_SGIN + I_SQ + 2 * I_DN;
    if (it >= NITEMS) return false;
    int r = it; t.mapup = 0; t.amax = nullptr; t.gain = nullptr; t.K = DM;
    if (r < I_SGIN) { t.W = F.sg_w_in; t.N = 2 * DM; t.gain = F.sg_norm; t.WT = (bf16*)(F.ws + WS_SGWIN); }
    else if ((r -= I_SGIN) < I_SQ) { t.W = F.sg_w_out; t.N = DM; t.WT = (bf16*)(F.ws + WS_SGWOUT); }
    else if ((r -= I_SQ) < I_DN) { t.W = F.ffn_w_down; t.N = DM; t.K = DFF; t.WT = (bf16*)(F.ws + WS_WDOWN); }
    else { r -= I_DN; t.W = F.ffn_w_down + (size_t)DFF * DM; t.N = DM; t.K = DFF; t.WT = (bf16*)(F.ws + WS_WDOWN + WDOWN_L); }
    const int nblk = t.N / 64, kb = r / nblk, nb = r - kb * nblk; t.k0 = 64 * kb; t.n0 = 64 * nb;
    return true;
}
__device__ __forceinline__ void titem_load(const TItem& t, f32x4 (&v)[16], int lane) {
    const int lr = lane >> 4, lc = (lane & 15) * 4;
#pragma unroll
    for (int i = 0; i < 16; ++i) v[i] = __builtin_nontemporal_load((const f32x4*)(t.W + (size_t)(t.k0 + 4 * i + lr) * t.N + t.n0 + lc));
}
__device__ __forceinline__ void titem_process(const TItem& t, const f32x4 (&v)[16], LAS float* scr, int lane) {
    const int lr = lane >> 4, lc = (lane & 15) * 4;
#pragma unroll
    for (int i = 0; i < 16; ++i) { const int kk = 4 * i + lr; f32x4 x = v[i]; if (t.gain) x = x * t.gain[t.k0 + kk]; LAS float* d = scr + kk * 65 + lc; d[0] = x[0]; d[1] = x[1]; d[2] = x[2]; d[3] = x[3]; }
    LDS_WAIT(); asm volatile("" ::: "memory");
    const int c = lane & 7;
#pragma unroll
    for (int j = 0; j < 8; ++j) { const int n = (lane >> 3) + 8 * j; const LAS float* s = scr + (8 * c) * 65 + n;
        const int nn = t.n0 + n, drow = t.mapup ? MapUp()(nn) : nn;
        v4u o; o.x = pg8::cvt_pk_bf16(s[0 * 65], s[1 * 65]); o.y = pg8::cvt_pk_bf16(s[2 * 65], s[3 * 65]); o.z = pg8::cvt_pk_bf16(s[4 * 65], s[5 * 65]); o.w = pg8::cvt_pk_bf16(s[6 * 65], s[7 * 65]);
        *(v4u*)(t.WT + (size_t)drow * t.K + t.k0 + 8 * c) = o;
        if (t.amax) {
            float mx = fmaxf(fmaxf(fmaxf(fabsf(s[0 * 65]), fabsf(s[1 * 65])), fmaxf(fabsf(s[2 * 65]), fabsf(s[3 * 65]))), fmaxf(fmaxf(fabsf(s[4 * 65]), fabsf(s[5 * 65])), fmaxf(fabsf(s[6 * 65]), fabsf(s[7 * 65]))));
            mx = fmaxf(mx, __shfl_xor(mx, 1)); mx = fmaxf(mx, __shfl_xor(mx, 2)); mx = fmaxf(mx, __shfl_xor(mx, 4));
            if (c == 0) atomicMax(t.amax + drow, __builtin_bit_cast(unsigned, mx));
        } }
    LDS_WAIT(); asm volatile("" ::: "memory");
}
__device__ __forceinline__ void qw_load(const bf16* src, int n, v4u (&v)[8]) {
    const v4u* s = (const v4u*)(src + (size_t)n * DM) + LANE_ID();
#pragma unroll
    for (int i = 0; i < 8; ++i) v[i] = s[64 * i];
}
__device__ __forceinline__ void qw_store(signed char* dst, const unsigned* amax, float* scale, int n, const v4u (&v)[8]) {
    const float am = __builtin_bit_cast(float, amax[n]), inv = am > 0.f ? 127.0f / am : 0.f;
    if (LANE_ID() == 0) scale[n] = am * (1.0f / 127.0f);
    v2u* d = (v2u*)(dst + (size_t)n * DM) + LANE_ID();
#pragma unroll
    for (int i = 0; i < 8; ++i) { float f[8]; unpack8(v[i], f);
        v2u o; o.x = q8(f[0], inv) | (q8(f[1], inv) << 8) | (q8(f[2], inv) << 16) | (q8(f[3], inv) << 24); o.y = q8(f[4], inv) | (q8(f[5], inv) << 8) | (q8(f[6], inv) << 16) | (q8(f[7], inv) << 24);
        d[64 * i] = o; }
}
__device__ __forceinline__ void quant_weight_rows(Frame& F, const bf16* src, signed char* dst, const unsigned* amax, float* scale, int N) {
    v4u a[8], b[8];
    int n = F.gw;
    if (n < N) qw_load(src, n, a);
    while (n < N) {
        const int n2 = n + F.NGW;
        if (n2 < N) qw_load(src, n2, b);
        qw_store(dst, amax, scale, n, a);
        if (n2 >= N) break;
        n = n2 + F.NGW;
        if (n < N) qw_load(src, n, a);
        qw_store(dst, amax, scale, n2, b);
    }
}
__device__ __forceinline__ void qa_load(const float* src, int m, f32x4 (&v)[16]) {
    const f32x4* s = (const f32x4*)(src + (size_t)m * DM) + LANE_ID();
#pragma unroll
    for (int j = 0; j < 16; ++j) v[j] = s[64 * j];
}
__device__ __forceinline__ void qa_store(signed char* dst, float* scale, float* ssq, int m, const f32x4 (&v)[16]) {
    unsigned* d = (unsigned*)(dst + (size_t)m * DM) + LANE_ID();
    float am = 0.f, sq = 0.f;
#pragma unroll
    for (int j = 0; j < 16; ++j) { am = fmaxf(am, fmaxf(fmaxf(fabsf(v[j][0]), fabsf(v[j][1])), fmaxf(fabsf(v[j][2]), fabsf(v[j][3]))));
        sq += (v[j][0] * v[j][0] + v[j][1] * v[j][1]) + (v[j][2] * v[j][2] + v[j][3] * v[j][3]); }
    am = wave_max(am); sq = wave_sum(sq);
    const float inv = am > 0.f ? 127.0f / am : 0.f;
    if (LANE_ID() == 0) { scale[m] = am * (1.0f / 127.0f); ssq[m] = sq; }
#pragma unroll
    for (int j = 0; j < 16; ++j) d[64 * j] = q8(v[j][0], inv) | (q8(v[j][1], inv) << 8) | (q8(v[j][2], inv) << 16) | (q8(v[j][3], inv) << 24);
}
__device__ __forceinline__ void quant_act_rows(Frame& F, const float* src, signed char* dst, float* scale, float* ssq) {
    f32x4 a[16], b[16];
    int m = F.gw;
    if (m < MR) qa_load(src, m, a);
    while (m < MR) {
        const int m2 = m + F.NGW;
        if (m2 < MR) qa_load(src, m2, b);
        qa_store(dst, scale, ssq, m, a);
        if (m2 >= MR) break;
        m = m2 + F.NGW;
        if (m < MR) qa_load(src, m, a);
        qa_store(dst, scale, ssq, m2, b);
    }
}
__device__ __forceinline__ void qh_store(signed char* dst, float* scale, float* ssq, int m, const v4u (&v)[8]) {
    v2u* d = (v2u*)(dst + (size_t)m * DM) + LANE_ID();
    float am = 0.f, sq = 0.f;
#pragma unroll
    for (int i = 0; i < 8; ++i) { float f[8]; unpack8(v[i], f);
#pragma unroll
        for (int e = 0; e < 8; ++e) { am = fmaxf(am, fabsf(f[e])); sq += f[e] * f[e]; } }
    am = wave_max(am); sq = wave_sum(sq);
    const float inv = am > 0.f ? 127.0f / am : 0.f;
    if (LANE_ID() == 0) { scale[m] = am * (1.0f / 127.0f); ssq[m] = sq; }
#pragma unroll
    for (int i = 0; i < 8; ++i) { float f[8]; unpack8(v[i], f);
        v2u o; o.x = q8(f[0], inv) | (q8(f[1], inv) << 8) | (q8(f[2], inv) << 16) | (q8(f[3], inv) << 24); o.y = q8(f[4], inv) | (q8(f[5], inv) << 8) | (q8(f[6], inv) << 16) | (q8(f[7], inv) << 24);
        d[64 * i] = o; }
}
__device__ __forceinline__ void quant_stream_rows(Frame& F, const bf16* src, signed char* dst, float* scale, float* ssq) {
    v4u a[8], b[8];
    int m = F.gw;
    if (m < MR) qw_load(src, m, a);
    while (m < MR) {
        const int m2 = m + F.NGW;
        if (m2 < MR) qw_load(src, m2, b);
        qh_store(dst, scale, ssq, m, a);
        if (m2 >= MR) break;
        m = m2 + F.NGW;
        if (m < MR) qw_load(src, m, a);
        qh_store(dst, scale, ssq, m2, b);
    }
}
constexpr int STRIP_RS = 8208;
constexpr int STRIP_RS8 = 4112;
struct SItem { const float* W; const float* gain; signed char* dst; float* sw; int N, n0, mapup; float gflag; };
__device__ __forceinline__ bool sitem_decode(const Frame& F, int s, SItem& t) {
    constexpr int S_WIN = QKVC / 32, S_SQ = DM / 32, S_UP = F2 / 32;
    if (s >= S_WIN + S_SQ + 2 * S_UP) return false;
    float* SW = (float*)(F.ws + WS_SW);
    int r = s; t.mapup = 0; t.gflag = 1.0f;
    if (r < S_WIN) { t.W = F.attn_w_in; t.N = QKVC; t.gain = F.attn_norm; t.dst = (signed char*)(F.ws + WS_WIN8); t.sw = SW + AM_WIN; }
    else if ((r -= S_WIN) < S_SQ) { t.W = F.attn_w_out; t.N = DM; t.gain = F.attn_norm; t.gflag = 0.0f; t.dst = (signed char*)(F.ws + WS_WOUT8); t.sw = SW + AM_WOUT; }
    else if ((r -= S_SQ) < S_UP) { t.W = F.ffn_w_up; t.N = F2; t.gain = F.ffn_norm; t.dst = (signed char*)(F.ws + WS_WUP8); t.sw = SW + AM_WUP; t.mapup = 1; }
    else { r -= S_UP; t.W = F.ffn_w_up + (size_t)DM * F2; t.N = F2; t.gain = F.ffn_norm + DM; t.dst = (signed char*)(F.ws + WS_WUP8 + WUP8_L); t.sw = SW + AM_WUP + F2; t.mapup = 1; }
    t.n0 = 32 * r;
    return true;
}
__device__ __forceinline__ void sbatch_load(const SItem& t, int h, f32x4 (&v)[16], f32x2 (&g)[4], int tid) {
    const int q = tid & 3, rr = tid >> 2;
    const unsigned voff = (unsigned)((2 * rr) * t.N + t.n0 + 8 * q) * 4u;
#pragma unroll
    for (int p = 0; p < 4; ++p) { const int kb = h * 1024 + p * 256;
        const char* b0 = (const char*)(t.W + (size_t)kb * t.N); const char* b1 = (const char*)(t.W + (size_t)(kb + 1) * t.N);
        v[4 * p] = *(const f32x4*)(b0 + voff); v[4 * p + 1] = *(const f32x4*)(b0 + voff + 16);
        v[4 * p + 2] = *(const f32x4*)(b1 + voff); v[4 * p + 3] = *(const f32x4*)(b1 + voff + 16);
        const f32x2 gv = *(const f32x2*)((const char*)(t.gain + kb) + (unsigned)(8 * rr));
        g[p] = gv; }
}
__device__ __forceinline__ void sbatch_park(int h, const f32x4 (&v)[16], const f32x2 (&g)[4], float gflag, LAS unsigned char* strip, v4u (&held)[16], float (&mx)[8], int tid) {
    const int q = tid & 3, rr = tid >> 2;
#pragma unroll
    for (int p = 0; p < 4; ++p) { const int k2 = h * 512 + p * 128 + rr;
        const f32x2 gg = g[p] * gflag + (1.0f - gflag);
        const f32x4 a0 = v[4 * p] * gg.x, b0 = v[4 * p + 1] * gg.x, a1 = v[4 * p + 2] * gg.y, b1 = v[4 * p + 3] * gg.y;
#pragma unroll
        for (int j = 0; j < 4; ++j) { mx[j] = fmaxf(mx[j], fmaxf(fabsf(a0[j]), fabsf(a1[j]))); mx[4 + j] = fmaxf(mx[4 + j], fmaxf(fabsf(b0[j]), fabsf(b1[j])));
            *(LAS unsigned*)(strip + (4 * q + j) * STRIP_RS + k2 * 4) = pg8::cvt_pk_bf16(a0[j], a1[j]); }
        v4u hw; hw.x = pg8::cvt_pk_bf16(b0[0], b1[0]); hw.y = pg8::cvt_pk_bf16(b0[1], b1[1]); hw.z = pg8::cvt_pk_bf16(b0[2], b1[2]); hw.w = pg8::cvt_pk_bf16(b0[3], b1[3]);
        held[4 * h + p] = hw;
#pragma unroll
        for (int j = 0; j < 8; ++j) asm volatile("" : "+v"(mx[j]));
    }
}
__device__ __forceinline__ unsigned q8pair(unsigned w, float inv) { return q8x2(bflo(w), bfhi(w), inv); }
__device__ __forceinline__ unsigned q8quad(unsigned w0, unsigned w1, float inv) { return q8x4(bflo(w0), bfhi(w0), bflo(w1), bfhi(w1), inv); }
template <int MODE> __device__ __forceinline__ void p0_strips(Frame& F) {
    LAS unsigned char* strip = F.lds + RING_OFF;
    LAS unsigned* mxl = (LAS unsigned*)(F.lds + XTRA_OFF);
    const int lane = LANE_ID(); int tid = F.wave * 64 + lane;
    unsigned* ctr = F.ctl + 24;
    LAS unsigned* slot = (LAS unsigned*)(F.lds + XTRA_OFF + 256);
    if (tid < 64) mxl[tid] = 0u;
    if (tid == 0) { slot[0] = __hip_atomic_fetch_add(ctr, 1u, __ATOMIC_RELAXED, __HIP_MEMORY_SCOPE_AGENT); slot[1] = __hip_atomic_fetch_add(ctr, 1u, __ATOMIC_RELAXED, __HIP_MEMORY_SCOPE_AGENT); }
    __syncthreads();
    int s = __builtin_amdgcn_readfirstlane((int)slot[0]), sn = __builtin_amdgcn_readfirstlane((int)slot[1]);
    __syncthreads();
    SItem t; f32x4 va[16], vb[16]; f32x2 ga[4], gb[4];
    bool has = sitem_decode(F, s, t);
    if (has) { sbatch_load(t, 0, va, ga, tid); sbatch_load(t, 1, vb, gb, tid); }
    int par = 0;
    while (has) {
        float mx[8] = {0.f, 0.f, 0.f, 0.f, 0.f, 0.f, 0.f, 0.f};
        v4u held[16];
        asm volatile("" : "+v"(tid));
        unsigned pend = 0u;
        if (tid == 0) pend = __hip_atomic_fetch_add(ctr, 1u, __ATOMIC_RELAXED, __HIP_MEMORY_SCOPE_AGENT);
        sbatch_park(0, va, ga, t.gflag, strip, held, mx, tid); sbatch_load(t, 2, va, ga, tid); asm volatile("" ::: "memory");
        sbatch_park(1, vb, gb, t.gflag, strip, held, mx, tid); sbatch_load(t, 3, vb, gb, tid); asm volatile("" ::: "memory");
        SItem tn; const bool hn = sitem_decode(F, sn, tn);
        sbatch_park(2, va, ga, t.gflag, strip, held, mx, tid); if (hn) sbatch_load(tn, 0, va, ga, tid); asm volatile("" ::: "memory");
        sbatch_park(3, vb, gb, t.gflag, strip, held, mx, tid); if (hn) sbatch_load(tn, 1, vb, gb, tid); asm volatile("" ::: "memory");
#pragma unroll
        for (int j = 0; j < 8; ++j) { float m = mx[j]; m = fmaxf(m, __shfl_xor(m, 4)); m = fmaxf(m, __shfl_xor(m, 8)); m = fmaxf(m, __shfl_xor(m, 16)); m = fmaxf(m, __shfl_xor(m, 32));
            if ((lane >> 2) == 0) __hip_atomic_fetch_max((unsigned*)(mxl + par * 32 + (j >> 2) * 16 + 4 * (lane & 3) + (j & 3)), __builtin_bit_cast(unsigned, m), __ATOMIC_RELAXED, __HIP_MEMORY_SCOPE_WORKGROUP); }
        if (tid == 0) slot[0] = pend;
        __syncthreads();
        const int snn = __builtin_amdgcn_readfirstlane((int)slot[0]);
        if (tid < 32) mxl[(par ^ 1) * 32 + tid] = 0u;
        asm volatile("" : "+v"(tid));
#pragma unroll 4
        for (int r = 0; r < (MODE == 0 ? 16 : 0); ++r) {
            const float am = __builtin_bit_cast(float, mxl[par * 32 + r]), inv = am > 0.f ? 127.0f / am : 0.f;
            const v4u w = *(const LAS v4u*)(strip + r * STRIP_RS + tid * 16);
            v2u o; o.x = q8quad(w.x, w.y, inv); o.y = q8quad(w.z, w.w, inv);
            const int nn = t.n0 + 8 * (r >> 2) + (r & 3), drow = t.mapup ? MapUp()(nn) : nn;
            *(v2u*)(t.dst + (size_t)drow * DM + 8 * tid) = o;
            if (tid == 0) t.sw[drow] = am * (1.0f / 127.0f);
        }
        __syncthreads();
        asm volatile("" : "+v"(tid));
        if (MODE == 0) {
            const int q = tid & 3, rr = tid >> 2;
            float inv[4];
#pragma unroll
            for (int j = 0; j < 4; ++j) { const float am = __builtin_bit_cast(float, mxl[par * 32 + 16 + 4 * q + j]); inv[j] = am > 0.f ? 127.0f / am : 0.f; }
#pragma unroll
            for (int hp = 0; hp < 16; ++hp) { const int k = hp * 256 + 2 * rr;
                *(LAS unsigned short*)(strip + (4 * q + 0) * STRIP_RS8 + k) = (unsigned short)q8pair(held[hp].x, inv[0]);
                *(LAS unsigned short*)(strip + (4 * q + 1) * STRIP_RS8 + k) = (unsigned short)q8pair(held[hp].y, inv[1]);
                *(LAS unsigned short*)(strip + (4 * q + 2) * STRIP_RS8 + k) = (unsigned short)q8pair(held[hp].z, inv[2]);
                *(LAS unsigned short*)(strip + (4 * q + 3) * STRIP_RS8 + k) = (unsigned short)q8pair(held[hp].w, inv[3]); }
        }
        __syncthreads();
        asm volatile("" : "+v"(tid));
#pragma unroll 4
        for (int ps = 0; ps < (MODE == 0 ? 8 : 0); ++ps) { const int r = 2 * ps + (tid >> 8), tt = tid & 255;
            const v4u w = *(const LAS v4u*)(strip + r * STRIP_RS8 + tt * 16);
            const int nn = t.n0 + 8 * (r >> 2) + 4 + (r & 3), drow = t.mapup ? MapUp()(nn) : nn;
            *(v4u*)(t.dst + (size_t)drow * DM + 16 * tt) = w;
            if (tt == 0) t.sw[drow] = __builtin_bit_cast(float, mxl[par * 32 + 16 + r]) * (1.0f / 127.0f);
        }
        __syncthreads();
        t = tn; has = hn; s = sn; sn = snn; par ^= 1;
    }
}
__device__ __forceinline__ void p0_prologue(Frame& F) {
    LAS float* scr = (LAS float*)(F.lds + RING_OFF + F.wave * 16640);
    {
        const int lane = LANE_ID();
        TItem ta, tb; f32x4 va[16], vb[16];
#ifdef PROBE_TR2
        for (int rep = 0; rep < PROBE_TR2; ++rep) {
#else
        {
#endif
        int it = F.gw;
        bool ha = titem_decode(F, it, ta);
        if (ha) titem_load(ta, va, lane);
        while (ha) {
            const bool hb = titem_decode(F, it + F.NGW, tb);
            if (hb) titem_load(tb, vb, lane);
            titem_process(ta, va, scr, lane);
            if (!hb) break;
            it += 2 * F.NGW;
            ha = titem_decode(F, it, ta);
            if (ha) titem_load(ta, va, lane);
            titem_process(tb, vb, scr, lane);
        }
        }
    }
    quant_act_rows(F, F.x, (signed char*)(F.ws + WS_HQ8), (float*)(F.ws + WS_SAH), (float*)(F.ws + WS_SSQ));
    float* rc = (float*)(F.ws + WS_ROPE); float* rs = rc + MR * 16;
    for (int idx = F.gw * 64 + LANE_ID(); idx < MR * 16; idx += F.NGW * 64) {
        const int r = idx >> 4, i = idx & 15;
        double invd = 1.0;
        for (int k = 0; k < i; ++k) invd *= 0.44036660267178046;
        const float inv = (float)invd;
        const float ang = (float)F.pos[r] * inv;
        double sn, cs; sincos_d((double)ang, sn, cs);
        rc[idx] = (float)cs; rs[idx] = (float)sn;
    }
}

__device__ __forceinline__ void p_kmean(Frame& F) {
    const bf16* QKV = (const bf16*)(F.ws + WS_QKV); float* KM = (float*)(F.ws + WS_KMEAN);
    LAS float* red = (LAS float*)(F.lds + RING_OFF);
    for (int item = blockIdx.x; item < NB * NHA * 16; item += F.G) {
        const int j = item & 15, bh = item >> 4, b = bh / NHA, h = bh - b * NHA;
        const bf16* kb = QKV + ((size_t)((1 * 2 + b) * NHQ + h) * NS + 256 * j) * HD;
        const int d = (F.wave * 64 + LANE_ID()) & 127, part = (F.wave * 64 + LANE_ID()) >> 7;
        float s = 0.f;
        for (int i = 0; i < 64; ++i) s += bf1(kb[(size_t)(part * 64 + i) * HD + d]);
        red[part * 128 + d] = s;
        __syncthreads();
        if ((F.wave * 64 + LANE_ID()) < 128) KM[(size_t)item * 128 + (F.wave * 64 + LANE_ID())] = (red[(F.wave * 64 + LANE_ID())] + red[128 + (F.wave * 64 + LANE_ID())] + red[256 + (F.wave * 64 + LANE_ID())] + red[384 + (F.wave * 64 + LANE_ID())]) * (1.0f / 256.0f);
        __syncthreads();
    }
}

__device__ __forceinline__ float dot128(const LAS float* qs, const bf16* krow) {
    float s = 0.f;
#pragma unroll 4
    for (int c = 0; c < 16; ++c) {
        const v4u kv = *(const v4u*)(krow + 8 * c); const LAS float* q8 = qs + 8 * c;
        s += q8[0] * bflo(kv.x) + q8[1] * bfhi(kv.x) + q8[2] * bflo(kv.y) + q8[3] * bfhi(kv.y) + q8[4] * bflo(kv.z) + q8[5] * bfhi(kv.z) + q8[6] * bflo(kv.w) + q8[7] * bfhi(kv.w);
    }
    return s;
}
__device__ __forceinline__ void p_attn_naive(Frame& F, bf16* O) {
    const bf16* QKV = (const bf16*)(F.ws + WS_QKV); const float* KM = (const float*)(F.ws + WS_KMEAN);
    LAS float* qs = (LAS float*)(F.lds + RING_OFF + F.wave * 8192);
    LAS float* ps = qs + 128;
    const int lane = LANE_ID();
    constexpr int NMOBA = NB * NHA * NS, NDIL = NB * 8 * NS;
    const float NEG = -__builtin_inff();
    for (int task = F.gw; task < NMOBA + NDIL; task += F.NGW) {
        if (task < NMOBA) {
            const int b = task / (NHA * NS), rem = task - b * (NHA * NS), h = rem >> 12, t = rem & 4095;
            const bf16* qrow = QKV + ((size_t)((0 * 2 + b) * NHQ + h) * NS + t) * HD;
            const bf16* Kb = QKV + (size_t)((1 * 2 + b) * NHQ + h) * NS * HD;
            const bf16* Vb = QKV + (size_t)((2 * 2 + b) * NHQ + h) * NS * HD;
            { const unsigned w = *(const unsigned*)(qrow + 2 * lane); qs[2 * lane] = bflo(w); qs[2 * lane + 1] = bfhi(w); }
            LDS_WAIT(); asm volatile("" ::: "memory");
            const int qb = t >> 8, tin = t & 255;
            float g = NEG;
            if (lane < qb) { const float* km = KM + ((size_t)((b * NHA + h) * 16 + lane)) * 128; float s = 0.f; for (int d = 0; d < 128; ++d) s += qs[d] * km[d]; g = s; }
            unsigned selmask = 0u;
            if (qb <= 3) selmask = (1u << qb) - 1u;
            else {
#pragma unroll
                for (int rd = 0; rd < 3; ++rd) {
                    float best = g; int bi = lane;
#pragma unroll
                    for (int o = 1; o < 64; o <<= 1) { const float ob = __shfl_xor(best, o); const int oi = __shfl_xor(bi, o); if (ob > best || (ob == best && oi < bi)) { best = ob; bi = oi; } }
                    selmask |= 1u << bi; if (lane == bi) g = NEG;
                }
            }
            float sc[4][4]; int jsel[3];
            unsigned mk = selmask;
#pragma unroll
            for (int sl = 0; sl < 3; ++sl) {
                int j = -1; if (mk) { j = __builtin_ctz(mk); mk &= mk - 1u; }
                jsel[sl] = j;
#pragma unroll
                for (int c = 0; c < 4; ++c) sc[sl][c] = (j >= 0) ? ATT_SCALE * dot128(qs, Kb + (size_t)(256 * j + lane + 64 * c) * HD) : NEG;
            }
#pragma unroll
            for (int c = 0; c < 4; ++c) { const int i = lane + 64 * c; sc[3][c] = (i <= tin) ? ATT_SCALE * dot128(qs, Kb + (size_t)(256 * qb + i) * HD) : NEG; }
            float mx = NEG;
#pragma unroll
            for (int sl = 0; sl < 4; ++sl)
#pragma unroll
                for (int c = 0; c < 4; ++c) mx = fmaxf(mx, sc[sl][c]);
            mx = wave_max(mx);
            float sum = 0.f;
#pragma unroll
            for (int sl = 0; sl < 4; ++sl)
#pragma unroll
                for (int c = 0; c < 4; ++c) { sc[sl][c] = __expf(sc[sl][c] - mx); sum += sc[sl][c]; }
            sum = wave_sum(sum);
            const float inv = 1.0f / sum;
#pragma unroll
            for (int sl = 0; sl < 4; ++sl)
#pragma unroll
                for (int c = 0; c < 4; ++c) ps[sl * 256 + lane + 64 * c] = sc[sl][c] * inv;
            LDS_WAIT(); asm volatile("" ::: "memory");
            float o0 = 0.f, o1 = 0.f;
#pragma unroll
            for (int sl = 0; sl < 3; ++sl) {
                if (jsel[sl] >= 0) { const bf16* vb = Vb + (size_t)(256 * jsel[sl]) * HD + 2 * lane;
                    for (int i = 0; i < 256; ++i) { const float p = ps[sl * 256 + i]; const unsigned w = *(const unsigned*)(vb + (size_t)i * HD); o0 += p * bflo(w); o1 += p * bfhi(w); } }
            }
            { const bf16* vb = Vb + (size_t)(256 * qb) * HD + 2 * lane;
              for (int i = 0; i <= tin; ++i) { const float p = ps[3 * 256 + i]; const unsigned w = *(const unsigned*)(vb + (size_t)i * HD); o0 += p * bflo(w); o1 += p * bfhi(w); } }
            *(unsigned*)(O + (size_t)(b * NS + t) * DM + h * HD + 2 * lane) = pk2(o0, o1);
            LDS_WAIT(); asm volatile("" ::: "memory");
        } else {
            const int td = task - NMOBA, b = td / (8 * NS), rem = td - b * (8 * NS), hh = rem >> 12, t = rem & 4095;
            float lse[3], og0[3], og1[3];
#pragma unroll
            for (int g = 0; g < 3; ++g) {
                const int head = NHA + g * 8 + hh, dil = g == 0 ? 1 : (g == 1 ? 4 : 16);
                const bf16* qrow = QKV + ((size_t)((0 * 2 + b) * NHQ + head) * NS + t) * HD;
                const bf16* Kb = QKV + (size_t)((1 * 2 + b) * NHQ + head) * NS * HD;
                const bf16* Vb = QKV + (size_t)((2 * 2 + b) * NHQ + head) * NS * HD;
                { const unsigned w = *(const unsigned*)(qrow + 2 * lane); qs[2 * lane] = bflo(w); qs[2 * lane + 1] = bfhi(w); }
                LDS_WAIT(); asm volatile("" ::: "memory");
                float sc[3];
#pragma unroll
                for (int c = 0; c < 3; ++c) { const int m = lane + 64 * c; const int kp = t - m * dil; sc[c] = (m <= 128 && kp >= 0) ? ATT_SCALE * dot128(qs, Kb + (size_t)kp * HD) : NEG; }
                float mx = wave_max(fmaxf(fmaxf(sc[0], sc[1]), sc[2]));
                float e0 = __expf(sc[0] - mx), e1 = __expf(sc[1] - mx), e2 = __expf(sc[2] - mx);
                const float sum = wave_sum(e0 + e1 + e2), inv = 1.0f / sum;
                lse[g] = mx + __logf(sum);
                ps[lane] = e0 * inv; ps[lane + 64] = e1 * inv; if (lane == 0) ps[128] = e2 * inv;
                LDS_WAIT(); asm volatile("" ::: "memory");
                const int nb = t / dil, nk = (nb < 128 ? nb : 128) + 1;
                float o0 = 0.f, o1 = 0.f;
                for (int m = 0; m < nk; ++m) { const float p = ps[m]; const unsigned w = *(const unsigned*)(Vb + (size_t)(t - m * dil) * HD + 2 * lane); o0 += p * bflo(w); o1 += p * bfhi(w); }
                og0[g] = o0; og1[g] = o1;
                LDS_WAIT(); asm volatile("" ::: "memory");
            }
            const float ml = fmaxf(fmaxf(lse[0], lse[1]), lse[2]);
            const float w0 = __expf(lse[0] - ml), w1 = __expf(lse[1] - ml), w2 = __expf(lse[2] - ml), wi = 1.0f / (w0 + w1 + w2);
            const float r0 = (w0 * og0[0] + w1 * og0[1] + w2 * og0[2]) * wi, r1 = (w0 * og1[0] + w1 * og1[1] + w2 * og1[2]) * wi;
            *(unsigned*)(O + (size_t)(b * NS + t) * DM + (NHA + hh) * HD + 2 * lane) = pk2(r0, r1);
        }
    }
}

__device__ __forceinline__ float silu_f(float x) { return x / (1.0f + __expf(-x)); }
__device__ __forceinline__ void p_conv(Frame& F, int layer) {
    const bf16* AP = (const bf16*)(F.ws + WS_APRE); bf16* Gb = (bf16*)(F.ws + WS_G);
    const float* cw = F.ffn_conv_w + (size_t)layer * 3 * F2; const float* cb = F.ffn_conv_b + (size_t)layer * F2;
    constexpr int C8 = DFF / 8;
    const size_t total = (size_t)MR * C8;
    for (size_t idx = (size_t)blockIdx.x * 512 + (F.wave * 64 + LANE_ID()); idx < total; idx += (size_t)F.G * 512) {
        const int r = (int)(idx / C8), j0 = (int)(idx - (size_t)r * C8) * 8, s = r & 4095;
        float cg[8], cu[8];
#pragma unroll
        for (int e = 0; e < 8; ++e) { cg[e] = cb[j0 + e]; cu[e] = cb[DFF + j0 + e]; }
#pragma unroll
        for (int tp = 0; tp < 3; ++tp) {
            const int back = 2 - tp;
            if (s >= back) {
                float ag[8], au[8];
                unpack8(*(const v4u*)(AP + (size_t)(r - back) * F2 + j0), ag);
                unpack8(*(const v4u*)(AP + (size_t)(r - back) * F2 + DFF + j0), au);
#pragma unroll
                for (int e = 0; e < 8; ++e) { cg[e] += cw[(size_t)tp * F2 + j0 + e] * ag[e]; cu[e] += cw[(size_t)tp * F2 + DFF + j0 + e] * au[e]; }
            }
        }
        v4u o; o.x = pk2(silu_f(cg[0]) * cu[0], silu_f(cg[1]) * cu[1]); o.y = pk2(silu_f(cg[2]) * cu[2], silu_f(cg[3]) * cu[3]);
        o.z = pk2(silu_f(cg[4]) * cu[4], silu_f(cg[5]) * cu[5]); o.w = pk2(silu_f(cg[6]) * cu[6], silu_f(cg[7]) * cu[7]);
        *(v4u*)(Gb + (size_t)r * DFF + j0) = o;
    }
}

__device__ __forceinline__ void p_sgate_naive(Frame& F) {
    const bf16* U = (const bf16*)(F.ws + WS_U); const bf16* V = (const bf16*)(F.ws + WS_V); const float* VS = (const float*)(F.ws + WS_VSQ); bf16* GT = (bf16*)(F.ws + WS_O);
    LAS float* vn = (LAS float*)(F.lds + RING_OFF);
    LAS float* wsl = vn + 128 * 128;
    LAS float* rstat = (LAS float*)(F.lds + XTRA_OFF);
    for (int item = blockIdx.x; item < 64 * 32; item += F.G) {
        const int bc = item >> 5, g = item & 31, r0 = bc * 128;
        if ((F.wave * 64 + LANE_ID()) < 128) {
            const float s1 = VS[2 * (r0 + (F.wave * 64 + LANE_ID()))], s2 = VS[2 * (r0 + (F.wave * 64 + LANE_ID())) + 1];
            const float mean = s1 * (1.0f / 4096.0f), var = s2 * (1.0f / 4096.0f) - mean * mean;
            rstat[2 * (F.wave * 64 + LANE_ID())] = mean; rstat[2 * (F.wave * 64 + LANE_ID()) + 1] = 1.0f / sqrtf(var + NORM_EPS);
        }
        __syncthreads();
        for (int idx = (F.wave * 64 + LANE_ID()); idx < 128 * 128; idx += 512) {
            const int s = idx >> 7, d = idx & 127, col = g * 128 + d;
            const float v = bf1(V[(size_t)(r0 + s) * DM + col]);
            vn[idx] = (v - rstat[2 * s]) * rstat[2 * s + 1] * F.sg_v_gain[col] + F.sg_v_bias[col];
            wsl[idx] = F.sg_w_s[(size_t)g * 16384 + idx];
        }
        __syncthreads();
        for (int idx = (F.wave * 64 + LANE_ID()); idx < 128 * 128; idx += 512) {
            const int t = idx >> 7, d = idx & 127;
            float a = 0.f;
            for (int s = 0; s <= t; ++s) a += wsl[t * 128 + s] * vn[s * 128 + d];
            const float f = a + F.sg_b_s[g * 128 + t];
            const size_t o = (size_t)(r0 + t) * DM + g * 128 + d;
            GT[o] = (bf16)f2bf(bf1(U[o]) * f);
        }
        __syncthreads();
    }
}

__device__ __forceinline__ void pf_store(Frame& F, int m, const v4u (&v)[8]) {
    const f32x4* gr = (const f32x4*)F.final_norm + 2 * LANE_ID(); f32x4* orow = (f32x4*)(F.out + (size_t)m * DM) + 2 * LANE_ID();
    float sq = 0.f;
#pragma unroll
    for (int i = 0; i < 8; ++i) { float f[8]; unpack8(v[i], f);
#pragma unroll
        for (int e = 0; e < 8; ++e) sq += f[e] * f[e]; }
    sq = wave_sum(sq);
    float rs = 1.0f / sqrtf(sq * (1.0f / 4096.0f) + NORM_EPS);
#ifdef CHECK_ATTN
    if (__hip_atomic_load(F.ctl + 8, __ATOMIC_RELAXED, __HIP_MEMORY_SCOPE_AGENT) > CHECK_ATTN) rs = __builtin_nanf("");
#endif
#pragma unroll
    for (int i = 0; i < 8; ++i) { float f[8]; unpack8(v[i], f);
        orow[128 * i] = (f32x4){f[0], f[1], f[2], f[3]} * rs * gr[128 * i]; orow[128 * i + 1] = (f32x4){f[4], f[5], f[6], f[7]} * rs * gr[128 * i + 1]; }
}
__device__ __forceinline__ void p_final(Frame& F) {
    const bf16* H = (const bf16*)(F.ws + WS_XB);
    v4u a[8], b[8];
    int m = F.gw;
    if (m < MR) qw_load(H, m, a);
    while (m < MR) {
        const int m2 = m + F.NGW;
        if (m2 < MR) qw_load(H, m2, b);
        pf_store(F, m, a);
        if (m2 >= MR) break;
        m = m2 + F.NGW;
        if (m < MR) qw_load(H, m, a);
        pf_store(F, m2, b);
    }
}

__device__ __forceinline__ void quant_bf16_rows(Frame& F, const bf16* src, signed char* dst, float* scale) {
    for (int m = F.gw; m < MR; m += F.NGW) {
        const v4u* s = (const v4u*)(src + (size_t)m * DM) + LANE_ID(); v2u* d = (v2u*)(dst + (size_t)m * DM) + LANE_ID();
        v4u v[8]; float am = 0.f;
#pragma unroll
        for (int i = 0; i < 8; ++i) { v[i] = s[64 * i]; float f[8]; unpack8(v[i], f);
#pragma unroll
            for (int e = 0; e < 8; ++e) am = fmaxf(am, fabsf(f[e])); }
        am = wave_max(am);
        const float inv = am > 0.f ? 127.0f / am : 0.f;
        if (LANE_ID() == 0) scale[m] = am * (1.0f / 127.0f);
#pragma unroll
        for (int i = 0; i < 8; ++i) { float f[8]; unpack8(v[i], f);
            v2u o; o.x = q8(f[0], inv) | (q8(f[1], inv) << 8) | (q8(f[2], inv) << 16) | (q8(f[3], inv) << 24); o.y = q8(f[4], inv) | (q8(f[5], inv) << 8) | (q8(f[6], inv) << 16) | (q8(f[7], inv) << 24);
            d[64 * i] = o; }
    }
}
__device__ __forceinline__ unsigned moba_select(const LAS float* km, const bf16* qrow, int qb) {
    const float NEG = -__builtin_inff();
    if (qb <= 3) return (1u << qb) - 1u;
    float g[16];
#pragma unroll
    for (int j = 0; j < 16; ++j) g[j] = 0.f;
#pragma unroll 1
    for (int c = 0; c < 16; ++c) {
        float q8[8]; unpack8(*(const v4u*)(qrow + 8 * c), q8);
#pragma unroll
        for (int j = 0; j < 16; ++j) {
            const f32x4 k0 = *(const LAS f32x4*)(km + j * 128 + 8 * c), k1 = *(const LAS f32x4*)(km + j * 128 + 8 * c + 4);
            g[j] += q8[0] * k0[0] + q8[1] * k0[1] + q8[2] * k0[2] + q8[3] * k0[3] + q8[4] * k1[0] + q8[5] * k1[1] + q8[6] * k1[2] + q8[7] * k1[3];
        }
    }
#pragma unroll
    for (int j = 0; j < 16; ++j) if (j >= qb) g[j] = NEG;
    unsigned sel = 0u;
#pragma unroll
    for (int rd = 0; rd < 3; ++rd) {
        float best = NEG; unsigned bi = 0u;
#pragma unroll
        for (int j = 0; j < 16; ++j) { const bool take = (((sel >> j) & 1u) == 0u) && (g[j] > best); best = take ? g[j] : best; bi = take ? (unsigned)j : bi; }
        sel |= 1u << bi;
    }
    return sel;
}

typedef att::BlockRef<bf16, bf16> ABR;
#ifndef DIL_SK
#define DIL_SK false
#endif
constexpr int ATT_SEL_OFF = 69632, ATT_KM_OFF = 73728;
__device__ __forceinline__ void moba_unit(int vc, int i, int& bh, int& qb) {
    const int grp = vc >> 4, a = vc & 15;
    const unsigned long long PB = 0x24310cbfed5a9687ull, PC = 0x6579b13024c8aedfull;
    qb = i == 0 ? a : (i == 1 ? (int)((PB >> (4 * a)) & 15ull) : (int)((PC >> (4 * a)) & 15ull));
    bh = 3 * grp + i;
}
__device__ __forceinline__ ABR moba_ref(const Frame& F, int vc, int i, const LAS unsigned short* selL) {
    int bh, qb; moba_unit(vc, i, bh, qb);
    const int b = bh / NHA, h = bh - NHA * b;
    const bf16* QKV = (const bf16*)(F.ws + WS_QKV);
    ABR r;
    r.Q = QKV + ((size_t)((0 * 2 + b) * NHQ + h) * NS + 256 * qb) * HD;
    r.K = QKV + (size_t)((1 * 2 + b) * NHQ + h) * NS * HD;
    r.V = QKV + (size_t)((2 * 2 + b) * NHQ + h) * NS * HD;
    r.O = (bf16*)(F.ws + WS_O) + (size_t)(b * NS + 256 * qb) * DM + h * HD;
    r.P0 = 256 * qb;
    r.sel = selL + 256 * i; r.L = nullptr;
    return r;
}
__device__ __forceinline__ ABR dil_ref(const Frame& F, int vc, int g) {
    const int bhh = vc >> 4, b = bhh >> 3, hh = bhh & 7, lo = vc & 15;
    const int dil = g == 0 ? 1 : (g == 1 ? 4 : 16);
    const int res = g == 0 ? 0 : (g == 1 ? (lo >> 2) : lo), blk = g == 0 ? lo : (g == 1 ? (lo & 3) : 0);
    const int head = NHA + 8 * g + hh, pos0 = res + dil * 256 * blk;
    const bf16* QKV = (const bf16*)(F.ws + WS_QKV);
    ABR r;
    r.Q = QKV + ((size_t)((0 * 2 + b) * NHQ + head) * NS + pos0) * HD;
    r.K = QKV + ((size_t)((1 * 2 + b) * NHQ + head) * NS + res) * HD;
    r.V = QKV + ((size_t)((2 * 2 + b) * NHQ + head) * NS + res) * HD;
    r.O = (bf16*)(F.ws + WS_DO) + (size_t)(b * NS + pos0) * 3072 + g * 1024 + hh * HD;
    r.P0 = 256 * blk;
    r.sel = nullptr; r.L = (float*)(F.ws + WS_LSE) + (size_t)(b * NS + pos0) * 24 + g * 8 + hh;
    return r;
}
__device__ __forceinline__ void p_attn(Frame& F, char* lds) {
#define ATT_VC(bx) ((F.G % 8 == 0 && F.G == 256) ? (((bx) & 7) * 32 + ((bx) >> 3)) : (bx))
    for (int vb = blockIdx.x; vb < 256; vb += F.G) { const int vc = ATT_VC(vb);
#ifndef NO_MOBA
        {
            const bf16* QKVq = (const bf16*)(F.ws + WS_QKV); const float* KM = (const float*)(F.ws + WS_KMEAN);
            LAS float* kmL = (LAS float*)(F.lds + RING_OFF + ATT_KM_OFF); LAS unsigned short* selW = (LAS unsigned short*)(F.lds + RING_OFF + ATT_SEL_OFF);
            const LAS unsigned short* selL = selW;
#ifndef NO_GATEPRE
            for (int idx = (F.wave * 64 + LANE_ID()); idx < 3 * 2048; idx += 512) { int bh, qb; moba_unit(vc, idx >> 11, bh, qb); kmL[idx] = KM[(size_t)bh * 2048 + (idx & 2047)]; }
            __syncthreads();
            for (int qi = (F.wave * 64 + LANE_ID()); qi < 768; qi += 512) { int bh, qb; moba_unit(vc, qi >> 8, bh, qb); const int b = bh / NHA, h = bh - NHA * b;
                selW[qi] = (unsigned short)moba_select(kmL + (qi >> 8) * 2048, QKVq + ((size_t)((0 * 2 + b) * NHQ + h) * NS + 256 * qb + (qi & 255)) * HD, qb); }
            __syncthreads();
#endif
            asm volatile("" ::: "memory");
            int vcb = vc; asm volatile("" : "+s"(vcb));
            att::Seam<bf16> S;
            constexpr int WM = 1 << 30;
            ABR cur = moba_ref(F, vcb, 0, selL);
            att::causal_swa_prime<bf16, bf16, 128, WM>(cur, lds, S);
            for (int i = 0; i < 3; ++i) {
                const ABR nxt = moba_ref(F, vcb, i < 2 ? i + 1 : 2, selL);
                att::causal_swa_block<bf16, bf16, false, 0, 128, 128, DM, WM, WM, NS>(cur, nxt, lds, S);
                cur = nxt;
            }
        }
#endif
    }
    for (int vb = blockIdx.x; vb < 256; vb += F.G) { const int vc = ATT_VC(vb);
#ifndef NO_DIL
        {
            att::Seam<bf16> S;
            const ABR r0 = dil_ref(F, vc, 0), r1 = dil_ref(F, vc, 1), r2 = dil_ref(F, vc, 2);
            att::causal_swa_prime<bf16, bf16, 128, 129>(r0, lds, S);
            att::causal_swa_block<bf16, bf16, DIL_SK, 1, 128, 512, 3072, 129, 129, NS>(r0, r1, lds, S);
            att::causal_swa_block<bf16, bf16, DIL_SK, 1, 512, 2048, 4 * 3072, 129, 129, NS / 4>(r1, r2, lds, S);
            att::causal_swa_block<bf16, bf16, DIL_SK, 1, 2048, 2048, 16 * 3072, 129, 129, NS / 16>(r2, r2, lds, S);
        }
#endif
    }
}
__device__ __forceinline__ void p_dilmerge(Frame& F) {
    const bf16* DO = (const bf16*)(F.ws + WS_DO); const float* LSE = (const float*)(F.ws + WS_LSE); const bf16* O = (const bf16*)(F.ws + WS_O);
    signed char* OQ = (signed char*)(F.ws + WS_OQ8); float* SAO = (float*)(F.ws + WS_SAO);
    const int lane = LANE_ID();
    for (int r = F.gw; r < MR; r += F.NGW) {
        float v[64];
        if (lane < 48) {
#pragma unroll
            for (int i = 0; i < 8; ++i) { float f[8]; unpack8(*(const v4u*)(O + (size_t)r * DM + 64 * lane + 8 * i), f);
#pragma unroll
                for (int e = 0; e < 8; ++e) v[8 * i + e] = f[e]; }
        } else {
            const int hh = (lane - 48) >> 1, c0 = ((lane - 48) & 1) * 64;
            const float l0 = LSE[(size_t)r * 24 + hh], l1 = LSE[(size_t)r * 24 + 8 + hh], l2 = LSE[(size_t)r * 24 + 16 + hh];
            const float ml = fmaxf(fmaxf(l0, l1), l2);
            float w0 = __expf(l0 - ml), w1 = __expf(l1 - ml), w2 = __expf(l2 - ml); const float wi = 1.0f / (w0 + w1 + w2); w0 *= wi; w1 *= wi; w2 *= wi;
            const bf16* d0 = DO + (size_t)r * 3072 + hh * HD + c0;
#pragma unroll
            for (int i = 0; i < 8; ++i) { float a0[8], a1[8], a2[8]; unpack8(*(const v4u*)(d0 + 8 * i), a0); unpack8(*(const v4u*)(d0 + 1024 + 8 * i), a1); unpack8(*(const v4u*)(d0 + 2048 + 8 * i), a2);
#pragma unroll
                for (int e = 0; e < 8; ++e) v[8 * i + e] = w0 * a0[e] + w1 * a1[e] + w2 * a2[e]; }
        }
        float am = 0.f;
#pragma unroll
        for (int i = 0; i < 64; ++i) am = fmaxf(am, fabsf(v[i]));
        am = wave_max(am);
        const float inv = am > 0.f ? 127.0f / am : 0.f;
        if (lane == 0) SAO[r] = am * (1.0f / 127.0f);
        v4u* d = (v4u*)(OQ + (size_t)r * DM + 64 * lane);
#pragma unroll
        for (int i = 0; i < 4; ++i) { v4u o;
            o.x = q8(v[16 * i + 0], inv) | (q8(v[16 * i + 1], inv) << 8) | (q8(v[16 * i + 2], inv) << 16) | (q8(v[16 * i + 3], inv) << 24);
            o.y = q8(v[16 * i + 4], inv) | (q8(v[16 * i + 5], inv) << 8) | (q8(v[16 * i + 6], inv) << 16) | (q8(v[16 * i + 7], inv) << 24);
            o.z = q8(v[16 * i + 8], inv) | (q8(v[16 * i + 9], inv) << 8) | (q8(v[16 * i + 10], inv) << 16) | (q8(v[16 * i + 11], inv) << 24);
            o.w = q8(v[16 * i + 12], inv) | (q8(v[16 * i + 13], inv) << 8) | (q8(v[16 * i + 14], inv) << 16) | (q8(v[16 * i + 15], inv) << 24);
            d[i] = o; }
    }
}
__device__ __forceinline__ void p_convfix(Frame& F, int layer) {
    const float* top = (const float*)(F.ws + WS_TOP); const float* bot = (const float*)(F.ws + WS_BOT); bf16* Gb = (bf16*)(F.ws + WS_G);
    const float* cw = F.ffn_conv_w + (size_t)layer * 3 * F2; const float* cb = F.ffn_conv_b + (size_t)layer * F2;
    constexpr int C4 = DFF / 4, NIT = 30 * C4;
    for (int idx = blockIdx.x * 512 + (F.wave * 64 + LANE_ID()); idx < NIT; idx += F.G * 512) {
        const int pmi = idx / C4, j0 = (idx - pmi * C4) * 4, pm = pmi + 1 + (pmi >= 15 ? 1 : 0);
        f32x4 c0[2], c1[2];
#pragma unroll
        for (int bj = 0; bj < 2; ++bj) {
            const int col = bj * DFF + j0;
            const f32x4 w0 = *(const f32x4*)(cw + col), w1 = *(const f32x4*)(cw + F2 + col), w2 = *(const f32x4*)(cw + 2 * F2 + col), bb = *(const f32x4*)(cb + col);
            const f32x4 am2 = *(const f32x4*)(bot + (size_t)((pm - 1) * 2 + 0) * F2 + col), am1 = *(const f32x4*)(bot + (size_t)((pm - 1) * 2 + 1) * F2 + col);
            const f32x4 a0 = *(const f32x4*)(top + (size_t)(pm * 2 + 0) * F2 + col), a1 = *(const f32x4*)(top + (size_t)(pm * 2 + 1) * F2 + col);
            c0[bj] = bb + w0 * am2 + w1 * am1 + w2 * a0;
            c1[bj] = bb + w0 * am1 + w1 * a0 + w2 * a1;
        }
        v2u o0, o1;
        o0.x = pk2(silu_f(c0[0][0]) * c0[1][0], silu_f(c0[0][1]) * c0[1][1]); o0.y = pk2(silu_f(c0[0][2]) * c0[1][2], silu_f(c0[0][3]) * c0[1][3]);
        o1.x = pk2(silu_f(c1[0][0]) * c1[1][0], silu_f(c1[0][1]) * c1[1][1]); o1.y = pk2(silu_f(c1[0][2]) * c1[1][2], silu_f(c1[0][3]) * c1[1][3]);
        *(v2u*)(Gb + (size_t)(pm * 256) * DFF + j0) = o0;
        *(v2u*)(Gb + (size_t)(pm * 256 + 1) * DFF + j0) = o1;
    }
}

__device__ __forceinline__ void sg_prefetch(const Frame& F, int item, v4u (&v)[4], v4u (&u)[4], unsigned long long (&st)[2]) {
    const bf16* U = (const bf16*)(F.ws + WS_U); const bf16* V = (const bf16*)(F.ws + WS_V); const unsigned long long* VS = (const unsigned long long*)(F.ws + WS_VSX);
    const int tid = F.wave * 64 + LANE_ID(), g = item & 31, r0 = (item >> 5) * 128, d8 = (tid & 15) * 8;
#pragma unroll
    for (int k = 0; k < 4; ++k) { const size_t o = (size_t)(r0 + (tid >> 4) + 32 * k) * DM + g * 128 + d8; v[k] = *(const v4u*)(V + o); u[k] = *(const v4u*)(U + o); }
    st[0] = 0ull; st[1] = 0ull;
    if (tid < 128) { st[0] = VS[2 * (size_t)(r0 + tid)]; st[1] = VS[2 * (size_t)(r0 + tid) + 1]; }
}
__device__ __forceinline__ void sg_item(Frame& F, int item, int& gcur, const v4u (&v)[4], const v4u (&u)[4], const unsigned long long (&st)[2]) {
    typedef short bf16x8 __attribute__((ext_vector_type(8))); typedef float f32x16 __attribute__((ext_vector_type(16)));
    bf16* GT = (bf16*)(F.ws + WS_O);
    constexpr int PT = 136;
    LAS bf16* Wc = (LAS bf16*)(F.lds + RING_OFF);
    LAS bf16* vnT = Wc + 128 * PT;
    LAS float* rstat = (LAS float*)(F.lds + RING_OFF + 2 * 128 * PT * 2);
    const int lane = LANE_ID(), tid = F.wave * 64 + lane, r32 = lane & 31, hi = lane >> 5, tb = F.wave >> 1, dh = F.wave & 1;
    const int g = item & 31, r0 = (item >> 5) * 128, d8 = (tid & 15) * 8, col = g * 128 + d8;
    if (g != gcur) {
        for (int idx = tid; idx < 128 * 32; idx += 512) { const int t = idx >> 5, s4 = (idx & 31) * 4;
            const f32x4 w = *(const f32x4*)(F.sg_w_s + (size_t)g * 16384 + t * 128 + s4);
            v2u o; o.x = pk2(s4 <= t ? w[0] : 0.f, s4 + 1 <= t ? w[1] : 0.f); o.y = pk2(s4 + 2 <= t ? w[2] : 0.f, s4 + 3 <= t ? w[3] : 0.f);
            *(LAS v2u*)(Wc + t * PT + s4) = o; }
        gcur = g;
    }
    float gn[8], bs[8];
#pragma unroll
    for (int e = 0; e < 8; ++e) { gn[e] = F.sg_v_gain[col + e]; bs[e] = F.sg_v_bias[col + e]; }
    if (tid < 128) { const float s1 = pg8::unfx20(st[0]), s2 = pg8::unfx20(st[1]);
        const float mean = s1 * (1.0f / 4096.0f), var = s2 * (1.0f / 4096.0f) - mean * mean;
        rstat[2 * tid] = mean; rstat[2 * tid + 1] = 1.0f / sqrtf(var + NORM_EPS); }
    __syncthreads();
#pragma unroll
    for (int k = 0; k < 4; ++k) { const int s = (tid >> 4) + 32 * k;
        float v8[8]; unpack8(v[k], v8);
        const float mean = rstat[2 * s], rstd = rstat[2 * s + 1];
#pragma unroll
        for (int e = 0; e < 8; ++e) vnT[(d8 + e) * PT + s] = (bf16)f2bf((v8[e] - mean) * rstd * gn[e] + bs[e]); }
    __syncthreads();
    f32x16 acc0 = {}, acc1 = {};
    const LAS bf16* ap = Wc + (32 * tb + r32) * PT + 8 * hi;
    const LAS bf16* bp0 = vnT + (64 * dh + r32) * PT + 8 * hi, * bp1 = bp0 + 32 * PT;
    for (int ks = 0; ks < 2 * tb + 2; ++ks) {
        const bf16x8 a = *(const LAS bf16x8*)(ap + 16 * ks), b0 = *(const LAS bf16x8*)(bp0 + 16 * ks), b1 = *(const LAS bf16x8*)(bp1 + 16 * ks);
        acc0 = __builtin_amdgcn_mfma_f32_32x32x16_bf16(a, b0, acc0, 0, 0, 0);
        acc1 = __builtin_amdgcn_mfma_f32_32x32x16_bf16(a, b1, acc1, 0, 0, 0);
    }
    __syncthreads();
    LAS float* ft = (LAS float*)(vnT);
#pragma unroll
    for (int i = 0; i < 16; ++i) {
        const int t = 32 * tb + (i & 3) + 8 * (i >> 2) + 4 * hi;
        const float bsv = F.sg_b_s[g * 128 + t];
        ft[t * 132 + 64 * dh + r32] = acc0[i] + bsv;
        ft[t * 132 + 64 * dh + 32 + r32] = acc1[i] + bsv;
    }
    __syncthreads();
#pragma unroll
    for (int k = 0; k < 4; ++k) {
        const int t = (tid >> 4) + 32 * k; const size_t o = (size_t)(r0 + t) * DM + col;
        float u8[8]; unpack8(u[k], u8);
        const f32x4 f0 = *(const LAS f32x4*)(ft + t * 132 + d8), f1 = *(const LAS f32x4*)(ft + t * 132 + d8 + 4);
        v4u w; w.x = pk2(u8[0] * f0[0], u8[1] * f0[1]); w.y = pk2(u8[2] * f0[2], u8[3] * f0[3]); w.z = pk2(u8[4] * f1[0], u8[5] * f1[1]); w.w = pk2(u8[6] * f1[2], u8[7] * f1[3]);
        *(v4u*)(GT + o) = w;
    }
    __syncthreads();
}
__device__ __forceinline__ void p_sgate(Frame& F) {
    constexpr int NIT = 64 * 32;
    v4u vA[4], uA[4], vB[4], uB[4]; unsigned long long sA[2], sB[2];
    int gcur = -1, item = blockIdx.x;
    if (item < NIT) sg_prefetch(F, item, vA, uA, sA);
    while (item < NIT) {
        const int item2 = item + F.G;
        if (item2 < NIT) sg_prefetch(F, item2, vB, uB, sB);
        sg_item(F, item, gcur, vA, uA, sA);
        if (item2 >= NIT) break;
        item = item2 + F.G;
        if (item < NIT) sg_prefetch(F, item, vA, uA, sA);
        sg_item(F, item2, gcur, vB, uB, sB);
    }
}
#ifdef PROBE_RES
constexpr int N_PHASES = 19;
#else
constexpr int N_PHASES = 18;
#endif
struct Args { const void* in[19]; float* out; unsigned char* ws; int ph_lo, ph_hi, li, pad; };
__global__ void __launch_bounds__(NWAVES * 64, 2) mk_fwd(Args args) {
    extern __shared__ __attribute__((aligned(16))) unsigned char lds[];
    Frame F;
    F.lds = (LAS unsigned char*)lds;
    F.MISC = (volatile LAS unsigned*)(F.lds + MISC_OFF);
    F.wave = __builtin_amdgcn_readfirstlane((int)threadIdx.x >> 6);
    F.G = gridDim.x; F.gw = blockIdx.x * NWAVES + F.wave; F.NGW = F.G * NWAVES;
    F.ws = args.ws; F.ctl = (unsigned*)(args.ws + WS_CTL);
    F.x = (const float*)args.in[0]; F.pos = (const int*)args.in[1];
    F.attn_norm = (const float*)args.in[2]; F.attn_w_in = (const float*)args.in[3]; F.attn_w_out = (const float*)args.in[4];
    F.sg_norm = (const float*)args.in[5]; F.sg_w_in = (const float*)args.in[6]; F.sg_b_in = (const float*)args.in[7]; F.sg_v_gain = (const float*)args.in[8]; F.sg_v_bias = (const float*)args.in[9];
    F.sg_w_s = (const float*)args.in[10]; F.sg_b_s = (const float*)args.in[11]; F.sg_w_out = (const float*)args.in[12];
    F.ffn_norm = (const float*)args.in[13]; F.ffn_w_up = (const float*)args.in[14]; F.ffn_conv_w = (const float*)args.in[15]; F.ffn_conv_b = (const float*)args.in[16]; F.ffn_w_down = (const float*)args.in[17];
    F.final_norm = (const float*)args.in[18]; F.out = args.out;
    for (int u = (int)threadIdx.x; u < (XTRA_OFF - LDSCTL_OFF) / 4; u += NWAVES * 64) ((LAS unsigned*)(F.lds + LDSCTL_OFF))[u] = 0u;
#ifdef DIAG_LDSZERO
    for (int u = (int)threadIdx.x; u < LDS_BYTES / 4; u += NWAVES * 64) ((LAS unsigned*)(F.lds))[u] = 0u;
#endif
    __syncthreads();
    const int lo = args.ph_lo, hi = args.ph_hi;
    XcdBarrier bar; bar.bar = F.ctl + CW_BAR + args.li * XCD_BAR_WORDS; bar.x = 0; bar.st = nullptr;
    if (hi - lo > 1) bar = xcd_barrier_post(F.ctl + CW_BAR + args.li * XCD_BAR_WORDS, F.MISC + 8);
#define IN(k) (lo <= (k) && (k) < hi)
#ifdef PROBE_SUM
    unsigned long long pt_acc = 0ull, pt_t0 = wall_clock64();
#define SEAM(k) do { if (IN(k) && IN((k) + 1)) xcd_barrier(bar); { const unsigned long long t_ = wall_clock64(); if ((PROBE_SUM >> (k)) & 1) pt_acc += t_ - pt_t0; pt_t0 = t_; } } while (0)
#elif defined(PROBE_IDLE)
    unsigned long long idle_acc = 0ull;
#define SEAM(k) do { if (IN(k) && IN((k) + 1)) { const unsigned long long tb_ = wall_clock64(); xcd_barrier(bar); if ((PROBE_IDLE >> (k)) & 1) idle_acc += wall_clock64() - tb_; } } while (0)
#else
#define SEAM(k) do { if (IN(k) && IN((k) + 1)) xcd_barrier(bar); } while (0)
#endif
    unsigned char* ws = args.ws;
    bf16* H = (bf16*)(ws + WS_XB); bf16* O = (bf16*)(ws + WS_O); bf16* Gb = (bf16*)(ws + WS_G); bf16* AP = (bf16*)(ws + WS_APRE);
    float* SS = (float*)(ws + WS_SSQ); constexpr size_t SSF = SSQ_SITE / 4;
    const int c = (int)blockIdx.x;

    if (IN(0)) {
        p0_prologue(F);
        p0_strips<0>(F);
    } SEAM(0);
    if (IN(2)) {
        pg8::Gemm g{(const bf16*)(ws + WS_HQ8), (const bf16*)(ws + WS_WIN8), MR, QKVC, DM / 2}; pg8::StaticOrder S; S.init(MR, QKVC, F.G, c);
        pg8::EpiQKV8 E{(bf16*)(ws + WS_QKV), SS, (const float*)(ws + WS_ROPE), (const float*)(ws + WS_ROPE) + MR * 16, (float*)(ws + WS_KMEAN), (const float*)(ws + WS_SAH), (const float*)(ws + WS_SW) + AM_WIN};
        pg8::gemm_phase<pg8::EpiQKV8, pg8::StaticOrder, PG8_ALIGN, PG8_SP2>(F.lds + RING_OFF, g, S, E, F.wave);
    } SEAM(2);
    if (IN(3)) { p_attn(F, (char*)lds + RING_OFF); } SEAM(3);
    if (IN(4)) { p_dilmerge(F);
#ifdef CHECK_ATTN
        xcd_barrier(bar); p_attn_naive(F, AP); xcd_barrier(bar);
        { unsigned bad = 0; const signed char* OQc = (const signed char*)(ws + WS_OQ8); const float* SAc = (const float*)(ws + WS_SAO);
          for (size_t idx = (size_t)blockIdx.x * 512 + (F.wave * 64 + LANE_ID()); idx < (size_t)MR * DM; idx += (size_t)F.G * 512) { const int col = (int)(idx & 4095); const size_t row = idx >> 12;
            const float b = bf1(AP[idx]), sc = SAc[row], a = col < 3072 ? bf1(O[idx]) : (float)OQc[idx] * sc;
            if (!(fabsf(a - b) <= 0.004f + 0.03f * fabsf(b) + (col < 3072 ? 0.f : sc))) ++bad; }
          if (bad) atomicAdd(F.ctl + 8, bad); }
#endif
    } SEAM(4);
    if (IN(5)) {
        pg8::Gemm g{(const bf16*)(ws + WS_OQ8), (const bf16*)(ws + WS_WOUT8), MR, DM, DM / 2}; pg8::StaticOrder S; S.init(MR, DM, F.G, c);
        pg8::EpiResX8 E{F.x, H, SS + 1 * SSF, (const float*)(ws + WS_SAO), (const float*)(ws + WS_SW) + AM_WOUT};
        pg8::gemm_phase<pg8::EpiResX8, pg8::StaticOrder, PG8_ALIGN, PG8_SP2>(F.lds + RING_OFF, g, S, E, F.wave);
    } SEAM(5);
    if (IN(6)) { quant_stream_rows(F, H, (signed char*)(ws + WS_HQ8), (float*)(ws + WS_SAH), SS + 1 * SSF); } SEAM(6);
    if (IN(7)) {
        pg8::Gemm g{(const bf16*)(ws + WS_HQ8), (const bf16*)(ws + WS_WUP8), MR, F2, DM / 2}; pg8::StaticOrder S; S.init(MR, F2, F.G, c);
        pg8::EpiUpConv8 E{Gb, SS + 1 * SSF, F.ffn_conv_w, F.ffn_conv_b, (float*)(ws + WS_TOP), (float*)(ws + WS_BOT), (LAS float*)(F.lds + XTRA_OFF), (const float*)(ws + WS_SAH), (const float*)(ws + WS_SW) + AM_WUP};
        pg8::gemm_phase<pg8::EpiUpConv8, pg8::StaticOrder, true, PG8_SP2>(F.lds + RING_OFF, g, S, E, F.wave);
    } SEAM(7);
    if (IN(8)) { p_convfix(F, 0); } SEAM(8);
    if (IN(9)) {
        pg8::Gemm g{Gb, (const bf16*)(ws + WS_WDOWN), MR, DM, DFF}; pg8::StaticOrder S; S.init(MR, DM, F.G, c);
        pg8::EpiRes E{H, H, (float*)(ws + WS_SSX), nullptr, nullptr};
        pg8::gemm_phase<pg8::EpiRes, pg8::StaticOrder, PG8_ALIGN, PG8_SP2>(F.lds + RING_OFF, g, S, E, F.wave);
    } SEAM(9);
    if (IN(10)) {
        pg8::Gemm g{H, (const bf16*)(ws + WS_SGWIN), MR, 2 * DM, DM}; pg8::StaticOrder S; S.init(MR, 2 * DM, F.G, c);
        pg8::EpiSgIn E{(bf16*)(ws + WS_U), (bf16*)(ws + WS_V), (const float*)(ws + WS_SSX), F.sg_b_in, (float*)(ws + WS_VSX)};
        pg8::gemm_phase<pg8::EpiSgIn, pg8::StaticOrder, PG8_ALIGN, PG8_SP2>(F.lds + RING_OFF, g, S, E, F.wave);
    } SEAM(10);
    if (IN(11)) { p_sgate(F); } SEAM(11);
    if (IN(12)) {
        pg8::Gemm g{O, (const bf16*)(ws + WS_SGWOUT), MR, DM, DM}; pg8::StaticOrder S; S.init(MR, DM, F.G, c);
        pg8::EpiResNX E{H, H, nullptr, nullptr, nullptr};
        pg8::gemm_phase<pg8::EpiResNX, pg8::StaticOrder, PG8_ALIGN, PG8_SP2>(F.lds + RING_OFF, g, S, E, F.wave);
    } SEAM(12);
    if (IN(13)) { quant_stream_rows(F, H, (signed char*)(ws + WS_HQ8), (float*)(ws + WS_SAH), SS + 3 * SSF); } SEAM(13);
    if (IN(14)) {
        pg8::Gemm g{(const bf16*)(ws + WS_HQ8), (const bf16*)(ws + WS_WUP8 + WUP8_L), MR, F2, DM / 2}; pg8::StaticOrder S; S.init(MR, F2, F.G, c);
        pg8::EpiUpConv8 E{Gb, SS + 3 * SSF, F.ffn_conv_w + 3 * F2, F.ffn_conv_b + F2, (float*)(ws + WS_TOP), (float*)(ws + WS_BOT), (LAS float*)(F.lds + XTRA_OFF), (const float*)(ws + WS_SAH), (const float*)(ws + WS_SW) + AM_WUP + F2};
        pg8::gemm_phase<pg8::EpiUpConv8, pg8::StaticOrder, true, PG8_SP2>(F.lds + RING_OFF, g, S, E, F.wave);
    } SEAM(14);
    if (IN(15)) { p_convfix(F, 1); } SEAM(15);
    if (IN(16)) {
        pg8::Gemm g{Gb, (const bf16*)(ws + WS_WDOWN + WDOWN_L), MR, DM, DFF}; pg8::StaticOrder S; S.init(MR, DM, F.G, c);
        pg8::EpiResNX E{H, H, nullptr, nullptr, nullptr};
        pg8::gemm_phase<pg8::EpiResNX, pg8::StaticOrder, PG8_ALIGN, PG8_SP2>(F.lds + RING_OFF, g, S, E, F.wave);
    } SEAM(16);
#ifdef PROBE_BAR
    if (hi - lo > 1) for (int i = 0; i < PROBE_BAR; ++i) xcd_barrier(bar);
#endif
    if (IN(17)) { p_final(F); }
#ifdef PROBE_SUM
    { const unsigned long long t_ = wall_clock64(); if ((PROBE_SUM >> 17) & 1) pt_acc += t_ - pt_t0;
      if (blockIdx.x == 0 && (F.wave * 64 + LANE_ID()) == 0) { const unsigned long long w1 = wall_clock64(); while (wall_clock64() - w1 < pt_acc) __builtin_amdgcn_s_sleep(8); } }
#endif
#ifdef PROBE_IDLE
    if (hi - lo > 1) {
        if ((F.wave * 64 + LANE_ID()) == 0) atomicAdd((unsigned long long*)(F.ctl + 16), idle_acc);
        xcd_barrier(bar);
        if (blockIdx.x == 0 && (F.wave * 64 + LANE_ID()) == 0) { const unsigned long long tot = __hip_atomic_load((unsigned long long*)(F.ctl + 16), __ATOMIC_RELAXED, __HIP_MEMORY_SCOPE_AGENT);
            const unsigned long long span = tot / F.G * PROBE_AMP; const unsigned long long w1 = wall_clock64(); while (wall_clock64() - w1 < span) __builtin_amdgcn_s_sleep(8); }
    }
#endif
#ifdef PROBE_RES
    if (IN(18)) {
#if PROBE_RES == 1
        pg8::Gemm g{Gb, (const bf16*)(ws + WS_WDOWN), MR, DM, DFF};
#else
        pg8::Gemm g{O, (const bf16*)(ws + WS_WOUT), MR, DM, DM};
#endif
        pg8::StaticOrder S; S.init(MR, DM, F.G, c);
        pg8::EpiRes E{H, (bf16*)(ws + WS_APRE), (float*)(ws + WS_APRE + 256 * MiB), nullptr, nullptr};
        pg8::gemm_phase<pg8::EpiRes, pg8::StaticOrder, PG8_ALIGN, PG8_SP2>(F.lds + RING_OFF, g, S, E, F.wave);
    }
#endif
#undef IN
#undef SEAM
}

extern "C" void kernel_launch(void* const* d_in, const int* in_sizes, int n_in, void* d_out, int out_size, void* d_ws, size_t ws_size, hipStream_t stream) {
    static int grid = 0;
    if (grid == 0) {
        if (n_in != 19 || out_size != MR * DM || ws_size < WS_END) { fprintf(stderr, "kernel_launch: unexpected shapes (n_in %d, out %d, ws %zu); nothing launched\n", n_in, out_size, ws_size); grid = -1; return; }
        int dev = 0, cus = 0, per_cu = 0;
        if (hipGetDevice(&dev) != hipSuccess || hipDeviceGetAttribute(&cus, hipDeviceAttributeMultiprocessorCount, dev) != hipSuccess) { grid = -1; return; }
        if (hipFuncSetAttribute((const void*)mk_fwd, hipFuncAttributeMaxDynamicSharedMemorySize, LDS_BYTES) != hipSuccess) { fprintf(stderr, "kernel_launch: hipFuncSetAttribute failed\n"); grid = -1; return; }
        if (hipOccupancyMaxActiveBlocksPerMultiprocessor(&per_cu, (const void*)mk_fwd, NWAVES * 64, LDS_BYTES) != hipSuccess || per_cu < 1) fprintf(stderr, "kernel_launch: occupancy query reports %d\n", per_cu);
        (void)hipGetLastError();
        grid = cus;
    }
    if (grid < 0) return;
    if (hipMemsetAsync((char*)d_ws + WS_CTL, 0, CTL_ZERO_BYTES, stream) != hipSuccess) return;
#ifdef DIAG_POISON
    (void)hipMemsetAsync((char*)d_ws + DIAG_POISON_LO, 0xAA, DIAG_POISON_HI - DIAG_POISON_LO, stream);
#endif
    Args a{};
    for (int i = 0; i < 19; ++i) a.in[i] = d_in[i];
    a.out = (float*)d_out; a.ws = (unsigned char*)d_ws; a.pad = 0;
    if (MK_N_LAUNCHES == 1) {
        a.ph_lo = 0; a.ph_hi = N_PHASES; a.li = 0;
        hipLaunchKernelGGL(mk_fwd, dim3(grid), dim3(NWAVES * 64), LDS_BYTES, stream, a);
    } else {
        for (int p = 0; p < N_PHASES; ++p) { a.ph_lo = p; a.ph_hi = p + 1; a.li = 0; hipLaunchKernelGGL(mk_fwd, dim3(grid), dim3(NWAVES * 64), LDS_BYTES, stream, a);
#ifdef PROBE_MASK
            if ((PROBE_MASK >> p) & 1) hipLaunchKernelGGL(mk_fwd, dim3(grid), dim3(NWAVES * 64), LDS_BYTES, stream, a);
#endif
        }
    }
}
```

```cpp
#include <hip/hip_runtime.h>
#include <cstdio>
#include <cstdint>
#ifndef MK_N_LAUNCHES
#define MK_N_LAUNCHES 1
#endif
namespace pg8 {
#define PG8_LAS __attribute__((address_space(3)))
typedef unsigned short bf16_t;
typedef short bf16x8 __attribute__((ext_vector_type(8)));
typedef float f32x4 __attribute__((ext_vector_type(4)));
typedef unsigned u32x4 __attribute__((ext_vector_type(4)));
constexpr int BM = 256, BK = 64, HALF = 128, HTB = HALF * BK * 2  , STAGE_BYTES = 8 * HTB, NXCD = 8, WGM = 8;

__host__ __device__ __forceinline__ int lds_byte(int r, int c) { const int st = (r >> 4) * 2 + (c >> 5), rr = r & 15, cc = c & 31, ob = rr * 64 + cc * 2; return st * 1024 + (ob ^ (((ob >> 9) & 1) << 5)); }
__host__ __device__ __forceinline__ void stage_rc(int b, int& R, int& C) { const int st = b / 1024, sb = b % 1024, swz = sb ^ (((sb >> 9) & 1) << 5); R = (st >> 1) * 16 + swz / 64; C = (st & 1) * 32 + (swz % 64) / 2; }
__host__ __device__ __forceinline__ int perm32(int rho) { const int n = rho >> 4, i = rho & 15; return 8 * (i >> 2) + 4 * n + (i & 3); }

struct Unit { int pm, pn; };
struct Gemm { const bf16_t* A; const bf16_t* Bt; int M, N, K; };

struct StaticOrder {
    int nM, nN, nwg, G, c, same;
    __host__ __device__ void init(int M, int N, int G_, int c_) { nM = M / BM; nN = N / BM; nwg = nM * nN; G = G_; c = c_; same = -1; }
    __host__ __device__ bool next(int i, Unit& u) const {
        const long L = (long)i * G + c; if (L >= nwg) return false;
        int wgid = (int)L; { const int q = nwg / NXCD, r = nwg % NXCD, xcd = wgid % NXCD, off = wgid / NXCD; wgid = (xcd < r ? xcd * (q + 1) : r * (q + 1) + (xcd - r) * q) + off; }
        const int nig = WGM * nN, gid = wgid / nig, fm = gid * WGM, gsz = (nM - fm) < WGM ? (nM - fm) : WGM;
        u.pm = fm + ((wgid % nig) % gsz); u.pn = (wgid % nig) / gsz; u.pm &= same; u.pn &= same; return true;
    }
    __device__ __forceinline__ void a_ready(const Unit&) const {}
    __device__ __forceinline__ void done(const Unit&) const {}
};
__device__ __forceinline__ unsigned cvt_pk_bf16(float lo, float hi) { unsigned r; asm volatile("v_cvt_pk_bf16_f32 %0, %1, %2" : "=v"(r) : "v"(lo), "v"(hi)); return r; }
typedef float f32x2 __attribute__((ext_vector_type(2)));
__device__ __forceinline__ f32x2 gelu_pk(f32x2 v) {
    const f32x2 av = __builtin_elementwise_abs(v), d = av * 0.2316418882f + 1.0f;
    f32x2 t; t.x = __builtin_amdgcn_rcpf(d.x); t.y = __builtin_amdgcn_rcpf(d.y);
    f32x2 q = t * 0.5307027145f + (-0.7265760135f); q = q * t + 0.7107068705f; q = q * t + (-0.142248368f); q = q * t + 0.127414796f; q = q * t;
    const f32x2 s = (v * v) * (-0.72134752044f);
    f32x2 e; e.x = __builtin_amdgcn_exp2f(s.x); e.y = __builtin_amdgcn_exp2f(s.y);
    const f32x2 Q = q * e;
    f32x2 mx; mx.x = __builtin_fmaxf(v.x, 0.f); mx.y = __builtin_fmaxf(v.y, 0.f);
    return mx - av * Q;
}
typedef unsigned u32x2 __attribute__((ext_vector_type(2)));
typedef int i32x4 __attribute__((ext_vector_type(4)));
__device__ __forceinline__ unsigned long long fx20(float x) { return (unsigned long long)(long long)__builtin_rintf(x * 1048576.0f); }
__device__ __forceinline__ float unfx20(unsigned long long v) { return (float)(long long)v * (1.0f / 1048576.0f); }
template <bool I8> struct AccT { typedef f32x4 type; };
template <> struct AccT<true> { typedef i32x4 type; };
__device__ __forceinline__ f32x4 tof(f32x4 a) { return a; }
__device__ __forceinline__ f32x4 tof(i32x4 a) { return (f32x4){(float)a[0], (float)a[1], (float)a[2], (float)a[3]}; }
__device__ __forceinline__ float rstd_from_ss(const float* ss, int r) { return 1.0f / sqrtf(ss[r] * (1.0f / 4096.0f) + 1e-5f); }

template <bool Q8> struct EpiQKVT {
    static constexpr bool PERM = false, AFTER_DRAIN = false, I8 = Q8, APERM = false; static constexpr bool PREFETCH = false;
    typedef typename AccT<Q8>::type acc_t;
    bf16_t* qkv; const float* ss; const float* ropec; const float* ropes; float* km; const float* sa; const float* sw;
    __device__ __forceinline__ void operator()(const acc_t (&acc)[2][2][4][2], const Unit& u, int wr, int wc, int fr_in, int fq_in) const {
        int fr = fr_in, fq = fq_in; asm volatile("" : "+v"(fr), "+v"(fq));
        const int row0 = u.pm * BM + wr * 64 + fr;
        f32x4 swv[2][2];
#pragma unroll
        for (int bj = 0; bj < 2; ++bj)
#pragma unroll
            for (int n = 0; n < 2; ++n) swv[bj][n] = Q8 ? *(const f32x4*)(sw + u.pn * BM + bj * HALF + wc * 32 + 16 * n + 4 * fq) : (f32x4){1.f, 1.f, 1.f, 1.f};
        const bool kmu = u.pn >= 24 && u.pn < 36;
        const bool rot = wc == 0 && u.pn < 48;
        f32x4 cs[2][2];
#pragma unroll
        for (int bj = 0; bj < 2; ++bj)
#pragma unroll
            for (int n = 0; n < 2; ++n) cs[bj][n] = (f32x4){0.f, 0.f, 0.f, 0.f};
#pragma unroll
        for (int ai = 0; ai < 2; ++ai) {
            float rs[4]; f32x4 cz[4], sn[4];
            float sar[4];
#pragma unroll
            for (int m = 0; m < 4; ++m) sar[m] = Q8 ? sa[row0 + ai * HALF + m * 16] : 1.0f;
#pragma unroll
            for (int m = 0; m < 4; ++m) { const int r = row0 + ai * HALF + m * 16; rs[m] = ss[r];
                cz[m] = (f32x4){1.f, 1.f, 1.f, 1.f}; sn[m] = (f32x4){0.f, 0.f, 0.f, 0.f};
                if (rot) { cz[m] = *(const f32x4*)(ropec + (size_t)r * 16 + 4 * fq); sn[m] = *(const f32x4*)(ropes + (size_t)r * 16 + 4 * fq); } }
#pragma unroll
            for (int m = 0; m < 4; ++m) {
                const int r = row0 + ai * HALF + m * 16;
                const float rsv = sar[m] / sqrtf(rs[m] * (1.0f / 4096.0f) + 1e-5f);
                const int b = r >> 12, s = r & 4095;
#pragma unroll
                for (int bj = 0; bj < 2; ++bj) {
                    const int colh = 2 * u.pn + bj, which = colh / 48, head = colh - which * 48;
                    bf16_t* dst = qkv + ((size_t)((which * 2 + b) * 48 + head) * 4096 + s) * 128 + wc * 32 + 4 * fq;
                    f32x4 v0 = tof(acc[ai][bj][m][0]) * rsv, v1 = tof(acc[ai][bj][m][1]) * rsv;
                    if (Q8) { v0 = v0 * swv[bj][0]; v1 = v1 * swv[bj][1]; }
                    if (rot) { const f32x4 n0 = v0 * cz[m] - v1 * sn[m], n1 = v1 * cz[m] + v0 * sn[m]; v0 = n0; v1 = n1; }
                    if (kmu) { cs[bj][0] += v0; cs[bj][1] += v1; }
                    u32x2 w0, w1; w0.x = cvt_pk_bf16(v0[0], v0[1]); w0.y = cvt_pk_bf16(v0[2], v0[3]); w1.x = cvt_pk_bf16(v1[0], v1[1]); w1.y = cvt_pk_bf16(v1[2], v1[3]);
                    *(u32x2*)(dst) = w0; *(u32x2*)(dst + 16) = w1;
                }
            }
            asm volatile("" ::: "memory");
        }
        if (kmu) {
            const int b = u.pm >> 4, blk = u.pm & 15;
#pragma unroll
            for (int bj = 0; bj < 2; ++bj) {
                const int head = 2 * u.pn + bj - 48;
                float* dst = km + ((size_t)((b * 24 + head) * 16 + blk)) * 128 + wc * 32 + 4 * fq;
#pragma unroll
                for (int n = 0; n < 2; ++n)
#pragma unroll
                    for (int j = 0; j < 4; ++j) {
                        float v = cs[bj][n][j];
                        v += __shfl_xor(v, 1); v += __shfl_xor(v, 2); v += __shfl_xor(v, 4); v += __shfl_xor(v, 8);
                        if (fr == 0) atomicAdd(dst + 16 * n + j, v * (1.0f / 256.0f));
                    }
            }
        }
    }
};
typedef EpiQKVT<false> EpiQKV;
typedef EpiQKVT<true> EpiQKV8;

__device__ __forceinline__ f32x4 bf4a(u32x4 w) { return (f32x4){__builtin_bit_cast(float, w.x << 16), __builtin_bit_cast(float, w.x & 0xffff0000u), __builtin_bit_cast(float, w.y << 16), __builtin_bit_cast(float, w.y & 0xffff0000u)}; }
__device__ __forceinline__ f32x4 bf4b(u32x4 w) { return (f32x4){__builtin_bit_cast(float, w.z << 16), __builtin_bit_cast(float, w.z & 0xffff0000u), __builtin_bit_cast(float, w.w << 16), __builtin_bit_cast(float, w.w & 0xffff0000u)}; }
template <bool HF32, bool Q8, bool WST> struct EpiResT {
    static constexpr bool PERM = true, AFTER_DRAIN = false, I8 = Q8, APERM = false; static constexpr bool PREFETCH = false;
    typedef typename AccT<Q8>::type acc_t;
    const void* hin; bf16_t* hout; float* ss; const float* sa; const float* sw;
    __device__ __forceinline__ void operator()(const acc_t (&acc)[2][2][4][2], const Unit& u, int wr, int wc, int fr_in, int fq_in) const {
        int fr = fr_in, fq = fq_in; asm volatile("" : "+v"(fr), "+v"(fq));
        const int row0 = u.pm * BM + wr * 64 + fr, col0 = u.pn * BM + wc * 32 + 8 * fq;
        f32x4 swv[2][2];
#pragma unroll
        for (int bj = 0; bj < 2; ++bj)
#pragma unroll
            for (int n = 0; n < 2; ++n) swv[bj][n] = Q8 ? *(const f32x4*)(sw + col0 + bj * HALF + 4 * n) : (f32x4){1.f, 1.f, 1.f, 1.f};
        constexpr int MB = HF32 ? 2 : 4;
#pragma unroll
        for (int ai = 0; ai < 2; ++ai)
#pragma unroll
            for (int mb = 0; mb < 4; mb += MB) {
                f32x4 h[MB][2][2]; float sar[MB];
#pragma unroll
                for (int mi = 0; mi < MB; ++mi) { sar[mi] = Q8 ? sa[row0 + ai * HALF + (mb + mi) * 16] : 1.0f;
                    const size_t off = (size_t)(row0 + ai * HALF + (mb + mi) * 16) * 4096 + col0;
#pragma unroll
                    for (int bj = 0; bj < 2; ++bj) {
                        if (HF32) { h[mi][bj][0] = *(const f32x4*)((const float*)hin + off + bj * HALF); h[mi][bj][1] = *(const f32x4*)((const float*)hin + off + bj * HALF + 4); }
                        else { const u32x4 w = *(const u32x4*)((const bf16_t*)hin + off + bj * HALF); h[mi][bj][0] = bf4a(w); h[mi][bj][1] = bf4b(w); }
                    } }
#pragma unroll
                for (int mi = 0; mi < MB; ++mi) {
                    const int m = mb + mi, r = row0 + ai * HALF + m * 16; const size_t off = (size_t)r * 4096 + col0;
                    float sq = 0.f;
#pragma unroll
                    for (int bj = 0; bj < 2; ++bj) {
                        const f32x4 v0 = Q8 ? h[mi][bj][0] + tof(acc[ai][bj][m][0]) * swv[bj][0] * sar[mi] : h[mi][bj][0] + tof(acc[ai][bj][m][0]);
                        const f32x4 v1 = Q8 ? h[mi][bj][1] + tof(acc[ai][bj][m][1]) * swv[bj][1] * sar[mi] : h[mi][bj][1] + tof(acc[ai][bj][m][1]);
                        u32x4 w; w.x = cvt_pk_bf16(v0[0], v0[1]); w.y = cvt_pk_bf16(v0[2], v0[3]); w.z = cvt_pk_bf16(v1[0], v1[1]); w.w = cvt_pk_bf16(v1[2], v1[3]);
                        *(u32x4*)(hout + off + bj * HALF) = w;
                        sq += ((v0[0] * v0[0] + v0[1] * v0[1]) + (v0[2] * v0[2] + v0[3] * v0[3])) + ((v1[0] * v1[0] + v1[1] * v1[1]) + (v1[2] * v1[2] + v1[3] * v1[3]));
                    }
                    if (WST) { sq += __shfl_xor(sq, 16); sq += __shfl_xor(sq, 32);
                        if (fq == 0) atomicAdd((unsigned long long*)ss + r, fx20(sq)); }
                }
                asm volatile("" ::: "memory");
            }
    }
};
typedef EpiResT<false, false, true> EpiRes;
typedef EpiResT<false, false, false> EpiResNX;
typedef EpiResT<true, true, false> EpiResX8;

struct EpiUpPre {
    static constexpr bool PERM = true, AFTER_DRAIN = false, I8 = false, APERM = false; static constexpr bool PREFETCH = false;
    bf16_t* apre; const float* ss;
    __device__ __forceinline__ void operator()(const f32x4 (&acc)[2][2][4][2], const Unit& u, int wr, int wc, int fr, int fq) const {
        const int row0 = u.pm * BM + wr * 64 + fr, col0 = u.pn * 128 + wc * 32 + 8 * fq;
#pragma unroll
        for (int ai = 0; ai < 2; ++ai)
#pragma unroll
            for (int m = 0; m < 4; ++m) {
                const int r = row0 + ai * HALF + m * 16;
                const float rs = rstd_from_ss(ss, r);
                bf16_t* rowp = apre + (size_t)r * 28672 + col0;
#pragma unroll
                for (int bj = 0; bj < 2; ++bj) {
                    const f32x4 v0 = acc[ai][bj][m][0] * rs, v1 = acc[ai][bj][m][1] * rs;
                    u32x4 w; w.x = cvt_pk_bf16(v0[0], v0[1]); w.y = cvt_pk_bf16(v0[2], v0[3]); w.z = cvt_pk_bf16(v1[0], v1[1]); w.w = cvt_pk_bf16(v1[2], v1[3]);
                    *(u32x4*)(rowp + bj * 14336) = w;
                }
                asm volatile("" ::: "memory");
            }
    }
};

struct EpiSgIn {
    static constexpr bool PERM = true, AFTER_DRAIN = false, I8 = false, APERM = false; static constexpr bool PREFETCH = false;
    bf16_t* U; bf16_t* V; const float* ss; const float* bias; float* vs;
    __device__ __forceinline__ void operator()(const f32x4 (&acc)[2][2][4][2], const Unit& u, int wr, int wc, int fr, int fq) const {
        const int row0 = u.pm * BM + wr * 64 + fr, gcol0 = u.pn * BM + wc * 32 + 8 * fq;
        const bool isv = u.pn >= 16;
        bf16_t* base = isv ? V : U; const int col0 = isv ? gcol0 - 4096 : gcol0;
        f32x4 bv[2][2];
#pragma unroll
        for (int bj = 0; bj < 2; ++bj)
#pragma unroll
            for (int n = 0; n < 2; ++n) bv[bj][n] = *(const f32x4*)(bias + gcol0 + bj * HALF + 4 * n);
        float rsq[2][4];
#pragma unroll
        for (int ai = 0; ai < 2; ++ai)
#pragma unroll
            for (int m = 0; m < 4; ++m) rsq[ai][m] = unfx20(((const unsigned long long*)ss)[row0 + ai * HALF + m * 16]);
#pragma unroll
        for (int ai = 0; ai < 2; ++ai)
#pragma unroll
            for (int m = 0; m < 4; ++m) {
                const int r = row0 + ai * HALF + m * 16;
                const float rs = 1.0f / sqrtf(rsq[ai][m] * (1.0f / 4096.0f) + 1e-5f);
                bf16_t* rowp = base + (size_t)r * 4096 + col0;
                float s1 = 0.f, s2 = 0.f;
#pragma unroll
                for (int bj = 0; bj < 2; ++bj) {
                    f32x4 v0 = acc[ai][bj][m][0] * rs + bv[bj][0], v1 = acc[ai][bj][m][1] * rs + bv[bj][1];
                    const f32x2 a = gelu_pk((f32x2){v0[0], v0[1]}), b = gelu_pk((f32x2){v0[2], v0[3]}), c = gelu_pk((f32x2){v1[0], v1[1]}), d = gelu_pk((f32x2){v1[2], v1[3]});
                    if (isv) {
                        s1 += (a.x + a.y) + (b.x + b.y) + (c.x + c.y) + (d.x + d.y);
                        s2 += (a.x * a.x + a.y * a.y) + (b.x * b.x + b.y * b.y) + (c.x * c.x + c.y * c.y) + (d.x * d.x + d.y * d.y); }
                    u32x4 w; w.x = cvt_pk_bf16(a.x, a.y); w.y = cvt_pk_bf16(b.x, b.y); w.z = cvt_pk_bf16(c.x, c.y); w.w = cvt_pk_bf16(d.x, d.y);
                    *(u32x4*)(rowp + bj * HALF) = w;
                }
                if (isv) {
                    s1 += __shfl_xor(s1, 16); s1 += __shfl_xor(s1, 32); s2 += __shfl_xor(s2, 16); s2 += __shfl_xor(s2, 32);
                    if (fq == 0) { atomicAdd((unsigned long long*)vs + 2 * r, fx20(s1)); atomicAdd((unsigned long long*)vs + 2 * r + 1, fx20(s2)); }
                }
            }
    }
};

#define PG8_DPP(oldv, srcv, ctrl) __builtin_bit_cast(float, __builtin_amdgcn_update_dpp(__builtin_bit_cast(int, (float)(oldv)), __builtin_bit_cast(int, (float)(srcv)), (ctrl), 0xf, 0xf, false))
template <bool Q8> struct EpiUpConvT {
    static constexpr bool PERM = true, APERM = true, AFTER_DRAIN = false, I8 = Q8; static constexpr bool PREFETCH = true;
    typedef typename AccT<Q8>::type acc_t;
    bf16_t* G; const float* ss; const float* cw; const float* cb; float* top; float* bot; PG8_LAS float* xch; const float* sa; const float* sw;
    __device__ __forceinline__ static float silu(float x) { return x * __builtin_amdgcn_rcpf(1.0f + __builtin_amdgcn_exp2f(-1.4426950408889634f * x)); }
    __device__ __forceinline__ void prefetch(const Unit& u, int par, int wid, int lane) const {
        const int t = wid * 64 + lane, c = t & 255, gcol = (c < 128 ? 0 : 14336 - 128) + u.pn * 128 + c;
        PG8_LAS float* wl = xch + 2048 + par * 1280 + wid * 64; PG8_LAS float* rl = xch + 4608 + par * 512 + wid * 64;
        __builtin_amdgcn_global_load_lds((const unsigned*)(cw + (t >> 8) * 28672 + gcol), (PG8_LAS unsigned*)(wl), 4, 0, 0);
        __builtin_amdgcn_global_load_lds((const unsigned*)((t < 256 ? cw + 2 * 28672 : cb) + gcol), (PG8_LAS unsigned*)(wl + 512), 4, 0, 0);
        if (wid < 4) __builtin_amdgcn_global_load_lds((const unsigned*)(sw + u.pn * 256 + t), (PG8_LAS unsigned*)(wl + 1024), 4, 0, 0);
        __builtin_amdgcn_global_load_lds((const unsigned*)((t < 256 ? ss : sa) + u.pm * BM + c), (PG8_LAS unsigned*)(rl), 4, 0, 0);
    }
    __device__ __forceinline__ void operator()(const acc_t (&acc)[2][2][4][2], const Unit& u, int wr, int wc, int fr_in, int fq_in, int par) const {
        int fr = fr_in, fq = fq_in; asm volatile("" : "+v"(fr), "+v"(fq));
        const int rb0 = u.pm * BM + wr * 64 + 4 * fr, colg = u.pn * 128 + wc * 32 + 8 * fq;
        PG8_LAS float* wl = xch + 2048 + par * 1280;
        const PG8_LAS float* rl = xch + 4608 + par * 512 + wr * 64 + 4 * fr;
        f32x4 rsv[2];
#pragma unroll
        for (int ai = 0; ai < 2; ++ai) { const f32x4 s = *(const PG8_LAS f32x4*)(rl + ai * HALF);
            f32x4 r; r[0] = 1.0f / sqrtf(s[0] * (1.0f / 4096.0f) + 1e-5f); r[1] = 1.0f / sqrtf(s[1] * (1.0f / 4096.0f) + 1e-5f); r[2] = 1.0f / sqrtf(s[2] * (1.0f / 4096.0f) + 1e-5f); r[3] = 1.0f / sqrtf(s[3] * (1.0f / 4096.0f) + 1e-5f);
            if (Q8) r = r * *(const PG8_LAS f32x4*)(rl + 256 + ai * HALF);
            rsv[ai] = r; }
#pragma unroll
        for (int ai = 0; ai < 2; ++ai)
#pragma unroll
            for (int bj = 0; bj < 2; ++bj)
#pragma unroll
                for (int n = 0; n < 2; ++n) {
                    if (fr == 15) {
#pragma unroll
                        for (int m = 2; m < 4; ++m) { const f32x4 v = tof(acc[ai][bj][m][n]) * rsv[ai][m];
                            *(PG8_LAS f32x4*)(xch + ((((((ai * 2 + wr) * 4 + wc) * 2 + bj) * 2 + n) * 4 + fq) * 2 + (m - 2)) * 4) = v;
                            if (ai == 1 && wr == 1) { f32x4 vs = v; if (Q8) vs = vs * *(const f32x4*)(sw + u.pn * 256 + bj * 128 + wc * 32 + 8 * fq + 4 * n);
                                *(f32x4*)(bot + ((size_t)(u.pm * 2 + (m - 2)) * 28672) + bj * 14336 + colg + 4 * n) = vs; } }
                    }
                    if (ai == 0 && wr == 0 && fr == 0) {
#pragma unroll
                        for (int m = 0; m < 2; ++m) { f32x4 vs = tof(acc[0][bj][m][n]) * rsv[0][m]; if (Q8) vs = vs * *(const f32x4*)(sw + u.pn * 256 + bj * 128 + wc * 32 + 8 * fq + 4 * n);
                            *(f32x4*)(top + ((size_t)(u.pm * 2 + m) * 28672) + bj * 14336 + colg + 4 * n) = vs; }
                    }
                }
        asm volatile("s_waitcnt lgkmcnt(0)" ::: "memory"); __builtin_amdgcn_s_barrier(); asm volatile("" ::: "memory");
#pragma unroll
        for (int n = 0; n < 2; ++n) {
            f32x4 w0[2], w1[2], w2[2], cbv[2];
#pragma unroll
            for (int bj = 0; bj < 2; ++bj) { const int lc = bj * 128 + wc * 32 + 8 * fq + 4 * n;
                w0[bj] = *(const PG8_LAS f32x4*)(wl + lc); w1[bj] = *(const PG8_LAS f32x4*)(wl + 256 + lc); w2[bj] = *(const PG8_LAS f32x4*)(wl + 512 + lc); cbv[bj] = *(const PG8_LAS f32x4*)(wl + 768 + lc);
                if (Q8) { const f32x4 sc = *(const PG8_LAS f32x4*)(wl + 1024 + lc); w0[bj] = w0[bj] * sc; w1[bj] = w1[bj] * sc; w2[bj] = w2[bj] * sc; }
                const float ks = bj == 0 ? 1.4426950408889634f : 0.6931471805599453f;
                w0[bj] = w0[bj] * ks; w1[bj] = w1[bj] * ks; w2[bj] = w2[bj] * ks; cbv[bj] = cbv[bj] * ks; }
#pragma unroll
            for (int ai = 0; ai < 2; ++ai) {
                const bool has = !(ai == 0 && wr == 0);
                const int pai = wr == 1 ? ai : 0, pwr = wr == 1 ? 0 : 1;
                f32x4 cv[2][4];
#pragma unroll
                for (int bj = 0; bj < 2; ++bj) {
                    f32x4 hm2 = (f32x4){0.f, 0.f, 0.f, 0.f}, hm1 = hm2;
                    if (has && fr == 0) { const PG8_LAS float* hp = xch + ((((((pai * 2 + pwr) * 4 + wc) * 2 + bj) * 2 + n) * 4 + fq) * 2) * 4; hm2 = *(const PG8_LAS f32x4*)(hp); hm1 = *(const PG8_LAS f32x4*)(hp + 4); }
                    const f32x4 a0 = tof(acc[ai][bj][0][n]) * rsv[ai][0], a1 = tof(acc[ai][bj][1][n]) * rsv[ai][1], a2 = tof(acc[ai][bj][2][n]) * rsv[ai][2], a3 = tof(acc[ai][bj][3][n]) * rsv[ai][3];
                    f32x4 s3, s2;
#pragma unroll
                    for (int j = 0; j < 4; ++j) { s3[j] = PG8_DPP(hm1[j], a3[j], 0x111); s2[j] = PG8_DPP(hm2[j], a2[j], 0x111); }
                    cv[bj][0] = cbv[bj] + w2[bj] * a0 + w1[bj] * s3 + w0[bj] * s2;
                    cv[bj][1] = cbv[bj] + w2[bj] * a1 + w1[bj] * a0 + w0[bj] * s3;
                    cv[bj][2] = cbv[bj] + w2[bj] * a2 + w1[bj] * a1 + w0[bj] * a0;
                    cv[bj][3] = cbv[bj] + w2[bj] * a3 + w1[bj] * a2 + w0[bj] * a1;
                }
#pragma unroll
                for (int m = 0; m < 4; ++m) {
                    const f32x4 gu = cv[0][m] * cv[1][m];
                    f32x4 d; d[0] = __builtin_amdgcn_exp2f(-cv[0][m][0]); d[1] = __builtin_amdgcn_exp2f(-cv[0][m][1]); d[2] = __builtin_amdgcn_exp2f(-cv[0][m][2]); d[3] = __builtin_amdgcn_exp2f(-cv[0][m][3]);
                    d = d + 1.0f;
                    f32x4 r; r[0] = __builtin_amdgcn_rcpf(d[0]); r[1] = __builtin_amdgcn_rcpf(d[1]); r[2] = __builtin_amdgcn_rcpf(d[2]); r[3] = __builtin_amdgcn_rcpf(d[3]);
                    const f32x4 o = gu * r;
                    u32x2 w; w.x = cvt_pk_bf16(o[0], o[1]); w.y = cvt_pk_bf16(o[2], o[3]);
                    *(u32x2*)(G + (size_t)(rb0 + ai * HALF + m) * 14336 + colg + 4 * n) = w;
                }
                asm volatile("" ::: "memory");
            }
        }
    }
};
typedef EpiUpConvT<false> EpiUpConv;
typedef EpiUpConvT<true> EpiUpConv8;
struct EpiNull {
    static constexpr bool PERM = true, AFTER_DRAIN = false, I8 = false, APERM = false; static constexpr bool PREFETCH = false;
    float* sink; int never;
    __device__ __forceinline__ void operator()(const f32x4 (&acc)[2][2][4][2], const Unit& u, int wr, int wc, int fr, int fq) const {
        if (never == 12345) {
#pragma unroll
            for (int ai = 0; ai < 2; ++ai)
#pragma unroll
                for (int bj = 0; bj < 2; ++bj)
#pragma unroll
                    for (int m = 0; m < 4; ++m)
#pragma unroll
                        for (int n = 0; n < 2; ++n) *(f32x4*)(sink + ((((ai * 2 + bj) * 4 + m) * 2 + n) * 512 + threadIdx.x) * 4) = acc[ai][bj][m][n];
        }
    }
};
__device__ __forceinline__ f32x4 mma16(bf16x8 a, bf16x8 b, f32x4 c) { return __builtin_amdgcn_mfma_f32_16x16x32_bf16(a, b, c, 0, 0, 0); }
__device__ __forceinline__ i32x4 mma16(bf16x8 a, bf16x8 b, i32x4 c) { return __builtin_amdgcn_mfma_i32_16x16x64_i8(__builtin_bit_cast(i32x4, a), __builtin_bit_cast(i32x4, b), c, 0, 0, 0); }
template <class Epi, class Sched, bool ALIGN_EPI = false, bool SP2 = false>
__device__ __forceinline__ void gemm_phase(PG8_LAS unsigned char* lds, const Gemm g, const Sched& S, const Epi& E, const int wave_id) {
    constexpr bool I8 = Epi::I8;
    typedef typename AccT<I8>::type acc_t;
    const int lane = (int)__builtin_amdgcn_mbcnt_hi(~0u, __builtin_amdgcn_mbcnt_lo(~0u, 0u)), wid = wave_id, tid = wid * 64 + lane, wr = wid >> 2, wc = wid & 3, fr = lane & 15, fq = lane >> 4;
    const int K = g.K, nt = K / BK;
    unsigned voffA[2], voffB[2];
#pragma unroll
    for (int i = 0; i < 2; ++i) { int R, C; stage_rc(tid * 16 + i * 8192, R, C); const int Rb = Epi::PERM ? ((R & ~31) + perm32(R & 31)) : R;
        const int Ra = Epi::APERM ? ((R & ~63) + 4 * (R & 15) + ((R & 63) >> 4)) : R;
        voffA[i] = (unsigned)(Ra * K + C) * 2u; voffB[i] = (unsigned)(Rb * K + C) * 2u; }
    const size_t kstep = (size_t)(BK * 2);
    const size_t hstep = (size_t)HALF * K * 2;
    const size_t tstep = 2 * hstep;
    const unsigned ldsw = (unsigned)wid * 1024u;
    const int aoff = lds_byte(wr * 64 + fr, fq * 8), boff = lds_byte(wc * 32 + fr, fq * 8);
#define PG8_SA(b, h) (((b) * 2 + (h)) * HTB)
#define PG8_SB(b, h) ((4 + (b) * 2 + (h)) * HTB)
#define PG8_STAGE(bufoff, gbase, voff) do { _Pragma("unroll") for (int _i = 0; _i < 2; ++_i) \
        __builtin_amdgcn_global_load_lds((const unsigned*)((const char*)(gbase) + (voff)[_i]), (PG8_LAS unsigned*)(lds + (bufoff) + ldsw + _i * 8192), 16, 0, 0); } while (0)
#define PG8_LDA(dst, b, h) do { _Pragma("unroll") for (int m = 0; m < 4; ++m) _Pragma("unroll") for (int k = 0; k < 2; ++k) dst[m][k] = *(const PG8_LAS bf16x8*)(lds + PG8_SA(b, h) + aoff + m * 2048 + k * 1024); } while (0)
#define PG8_LDB(dst, b, h) do { _Pragma("unroll") for (int n = 0; n < 2; ++n) _Pragma("unroll") for (int k = 0; k < 2; ++k) dst[n][k] = *(const PG8_LAS bf16x8*)(lds + PG8_SB(b, h) + boff + n * 2048 + k * 1024); } while (0)
#define PG8_MMA(ai, bj, At, Bt) do { __builtin_amdgcn_s_setprio(1); _Pragma("unroll") for (int m = 0; m < 4; ++m) _Pragma("unroll") for (int n = 0; n < 2; ++n) _Pragma("unroll") for (int k = 0; k < 2; ++k) \
        acc[ai][bj][m][n] = mma16(Bt[n][k], At[m][k], acc[ai][bj][m][n]); __builtin_amdgcn_s_setprio(0); } while (0)
#define PG8_WAIT_V(n) asm volatile("s_waitcnt vmcnt(" #n ")" ::: "memory")
#define PG8_WAIT_L(n) asm volatile("s_waitcnt lgkmcnt(" #n ")" ::: "memory")
#define PG8_BAR __builtin_amdgcn_s_barrier()
#define PG8_SCHED __builtin_amdgcn_sched_barrier(0)
    Unit cur, nxt; int ui = 0;
    if (!S.next(0, cur)) return;
    acc_t acc[2][2][4][2];
#pragma unroll
    for (int a = 0; a < 2; ++a)
#pragma unroll
        for (int b = 0; b < 2; ++b)
#pragma unroll
            for (int m = 0; m < 4; ++m)
#pragma unroll
                for (int n = 0; n < 2; ++n) acc[a][b][m][n] = acc_t{};
    bf16x8 At[4][2], B0[2][2], B1[2][2];
    const char* cA = (const char*)g.A + (size_t)cur.pm * tstep; const char* cB = (const char*)g.Bt + (size_t)cur.pn * tstep;
    S.a_ready(cur);
    if constexpr (Epi::PREFETCH) E.prefetch(cur, 0, wid, lane);
    if constexpr (SP2) {
        PG8_STAGE(PG8_SB(0, 0), cB, voffB); PG8_STAGE(PG8_SB(0, 1), cB + hstep, voffB); PG8_STAGE(PG8_SA(0, 0), cA, voffA); PG8_STAGE(PG8_SA(0, 1), cA + hstep, voffA);
        if (wr == 1) PG8_BAR;
        PG8_WAIT_V(2); PG8_BAR;
        PG8_STAGE(PG8_SB(1, 0), cB + kstep, voffB); PG8_STAGE(PG8_SA(1, 0), cA + kstep, voffA); PG8_STAGE(PG8_SB(1, 1), cB + hstep + kstep, voffB);
        PG8_WAIT_V(6); PG8_BAR;
    } else {
        PG8_STAGE(PG8_SB(0, 0), cB, voffB); PG8_STAGE(PG8_SA(0, 0), cA, voffA); PG8_STAGE(PG8_SB(0, 1), cB + hstep, voffB); PG8_STAGE(PG8_SA(0, 1), cA + hstep, voffA);
        if (wr == 1) PG8_BAR;
        PG8_WAIT_V(4); PG8_BAR;
        PG8_STAGE(PG8_SB(1, 0), cB + kstep, voffB); PG8_STAGE(PG8_SA(1, 0), cA + kstep, voffA); PG8_STAGE(PG8_SB(1, 1), cB + hstep + kstep, voffB);
        PG8_WAIT_V(6); PG8_BAR;
    }
    for (;;) {
        const bool has_next = S.next(ui + 1, nxt);
        const char* nA = has_next ? (const char*)g.A + (size_t)nxt.pm * tstep : cA; const char* nB = has_next ? (const char*)g.Bt + (size_t)nxt.pn * tstep : cB;
        for (int t = 0; t < nt; t += 2) {
            const bool last = (t == nt - 2);
            const char* a1 = cA + (size_t)(t + 1) * kstep;
            const char* a2 = last ? nA : cA + (size_t)(t + 2) * kstep; const char* b2 = last ? nB : cB + (size_t)(t + 2) * kstep;
            const char* a3 = a2 + kstep; const char* b3 = b2 + kstep;
            if (last && has_next) S.a_ready(nxt);
            if constexpr (SP2) {
            PG8_LDB(B0, 0, 0); PG8_LDB(B1, 0, 1); PG8_SCHED; PG8_LDA(At, 0, 0); PG8_STAGE(PG8_SA(1, 1), a1 + hstep, voffA);
            PG8_WAIT_V(8); PG8_WAIT_L(0); PG8_BAR; PG8_MMA(0, 0, At, B0); PG8_MMA(0, 1, At, B1); PG8_BAR; PG8_SCHED;
            PG8_LDA(At, 0, 1); PG8_STAGE(PG8_SB(0, 0), b2, voffB); PG8_STAGE(PG8_SB(0, 1), b2 + hstep, voffB); PG8_STAGE(PG8_SA(0, 0), a2, voffA);
            PG8_WAIT_V(8); PG8_WAIT_L(0); PG8_BAR; PG8_MMA(1, 0, At, B0); PG8_MMA(1, 1, At, B1); PG8_BAR; PG8_SCHED;
            PG8_LDB(B0, 1, 0); PG8_LDB(B1, 1, 1); PG8_SCHED; PG8_LDA(At, 1, 0); PG8_STAGE(PG8_SA(0, 1), a2 + hstep, voffA);
            PG8_WAIT_V(8); PG8_WAIT_L(0); PG8_BAR; PG8_MMA(0, 0, At, B0); PG8_MMA(0, 1, At, B1); PG8_BAR; PG8_SCHED;
            PG8_LDA(At, 1, 1); PG8_STAGE(PG8_SB(1, 0), b3, voffB); PG8_STAGE(PG8_SB(1, 1), b3 + hstep, voffB); PG8_STAGE(PG8_SA(1, 0), a3, voffA);
            PG8_WAIT_V(8); PG8_WAIT_L(0); PG8_BAR; PG8_MMA(1, 0, At, B0); PG8_MMA(1, 1, At, B1); PG8_BAR; PG8_SCHED;
            } else {
            PG8_LDB(B0, 0, 0); PG8_SCHED; PG8_LDA(At, 0, 0); PG8_STAGE(PG8_SA(1, 1), a1 + hstep, voffA);
            PG8_WAIT_L(8); PG8_BAR; PG8_WAIT_L(0); PG8_MMA(0, 0, At, B0); PG8_BAR; PG8_SCHED;
            PG8_LDB(B1, 0, 1); PG8_STAGE(PG8_SB(0, 0), b2, voffB);
            PG8_BAR; PG8_WAIT_L(0); PG8_MMA(0, 1, At, B1); PG8_BAR;
            PG8_LDA(At, 0, 1); PG8_STAGE(PG8_SA(0, 0), a2, voffA);
            PG8_BAR; PG8_WAIT_L(0); PG8_MMA(1, 0, At, B0); PG8_BAR; PG8_SCHED;
            PG8_STAGE(PG8_SB(0, 1), b2 + hstep, voffB);
            PG8_WAIT_V(6); PG8_BAR; PG8_MMA(1, 1, At, B1); PG8_BAR;
            PG8_LDB(B0, 1, 0); PG8_SCHED; PG8_LDA(At, 1, 0); PG8_STAGE(PG8_SA(0, 1), a2 + hstep, voffA);
            PG8_WAIT_L(8); PG8_BAR; PG8_WAIT_L(0); PG8_MMA(0, 0, At, B0); PG8_BAR; PG8_SCHED;
            PG8_LDB(B1, 1, 1); PG8_STAGE(PG8_SB(1, 0), b3, voffB);
            PG8_BAR; PG8_WAIT_L(0); PG8_MMA(0, 1, At, B1); PG8_BAR;
            PG8_LDA(At, 1, 1); PG8_STAGE(PG8_SA(1, 0), a3, voffA);
            PG8_BAR; PG8_WAIT_L(0); PG8_MMA(1, 0, At, B0); PG8_BAR; PG8_SCHED;
            PG8_STAGE(PG8_SB(1, 1), b3 + hstep, voffB);
            PG8_WAIT_V(6); PG8_BAR; PG8_MMA(1, 1, At, B1); PG8_BAR;
            }
        }
        if constexpr (ALIGN_EPI) { if (wr == 0) PG8_BAR; }
        if constexpr (!Epi::AFTER_DRAIN) { if constexpr (Epi::PREFETCH) E(acc, cur, wr, wc, fr, fq, ui & 1); else E(acc, cur, wr, wc, fr, fq); S.done(cur); }
        if (!has_next) break;
#pragma unroll
        for (int a = 0; a < 2; ++a)
#pragma unroll
            for (int b = 0; b < 2; ++b)
#pragma unroll
                for (int m = 0; m < 4; ++m)
#pragma unroll
                    for (int n = 0; n < 2; ++n) acc[a][b][m][n] = acc_t{};
        cur = nxt; cA = nA; cB = nB; ++ui;
        if constexpr (Epi::PREFETCH) E.prefetch(cur, ui & 1, wid, lane);
        if constexpr (ALIGN_EPI) { if (wr == 1) PG8_BAR; }
    }
    PG8_WAIT_V(0);
    if constexpr (!ALIGN_EPI) { if (wr == 0) PG8_BAR; }
    PG8_BAR;
    if constexpr (Epi::AFTER_DRAIN) { E.fused(acc, cur, wr, wc, fr, fq, lds, wid, lane); S.done(cur); }
#undef PG8_SA
#undef PG8_SB
#undef PG8_STAGE
#undef PG8_LDA
#undef PG8_LDB
#undef PG8_MMA
#undef PG8_WAIT_V
#undef PG8_WAIT_L
#undef PG8_BAR
#undef PG8_SCHED
}
}
#ifndef PG8_SP2
#define PG8_SP2 true
#endif
#ifndef PG8_ALIGN
#define PG8_ALIGN true
#endif
constexpr int NWAVES = 8;
constexpr int NB = 2, NS = 4096, DM = 4096, MR = NB * NS;
constexpr int NHQ = 48, NHA = 24, HD = 128, QKVC = 3 * NHQ * HD;
constexpr int DFF = 14336, F2 = 2 * DFF;
constexpr float ATT_SCALE = 0.08838834764831845f;
constexpr float NORM_EPS = 1e-5f;
constexpr size_t MiB = 1u << 20;
constexpr size_t WS_CTL = 0, CTL_ZERO_BYTES = 2 * MiB;
constexpr size_t WS_SSQ = 256 * 1024, SSQ_SITE = 32 * 1024;
constexpr size_t WS_VSQ = 512 * 1024;
constexpr size_t WS_AMAX = 1 * MiB;
constexpr int AM_WIN = 0, AM_WOUT = 18432, AM_SGWIN = 22528, AM_WUP = 30720, AM_SGWOUT = 30720 + 2 * 28672, AM_END = AM_SGWOUT + 4096;
constexpr size_t WS_SW = 3 * MiB;
constexpr size_t WS_SSX = 1536 * 1024;
constexpr size_t WS_VSX = 1664 * 1024;
constexpr size_t WS_SAH = 4 * MiB;
constexpr size_t WS_ROPE = 2 * MiB;
constexpr size_t WS_KMEAN = 576 * 1024;
constexpr size_t WS_SS = 3 * MiB, SS_SITE = 2 * MiB;
constexpr size_t WS_VS = 13 * MiB;
constexpr size_t WS_SEL = 18 * MiB;
constexpr size_t WS_LSE = 20 * MiB;
constexpr size_t WS_WIN = 32 * MiB;
constexpr size_t WS_WOUT = 176 * MiB;
constexpr size_t WS_SGWIN = 208 * MiB;
constexpr size_t WS_SGWOUT = 272 * MiB;
constexpr size_t WS_WUP = 304 * MiB, WUP_L = 224 * MiB;
constexpr size_t WS_WDOWN = 752 * MiB, WDOWN_L = 112 * MiB;
constexpr size_t WS_XB = 976 * MiB;
constexpr size_t WS_H = 1040 * MiB;
constexpr size_t WS_QKV = 1168 * MiB;
constexpr size_t WS_U = WS_QKV, WS_V = WS_QKV + 64 * MiB;
constexpr size_t WS_O = 1456 * MiB;
constexpr size_t WS_G = 1520 * MiB;
constexpr size_t WS_DO = WS_G;
constexpr size_t WS_APRE = 1744 * MiB;
constexpr size_t WS_TOP = WS_APRE + 128 * MiB, WS_BOT = WS_APRE + 136 * MiB;
constexpr size_t WS_WUP8 = 2192 * MiB, WUP8_L = 112 * MiB;
constexpr size_t WS_HQ8 = 2416 * MiB;
constexpr size_t WS_WIN8 = 2448 * MiB;
constexpr size_t WS_WOUT8 = 2520 * MiB, WS_SGWOUT8 = 2536 * MiB;
constexpr size_t WS_OQ8 = 2552 * MiB;
constexpr size_t WS_SAO = WS_SAH + 65536, WS_SAO2 = WS_SAH + 131072;
constexpr size_t WS_END = 2584 * MiB;
constexpr int RING_OFF = 0, RING_BYTES = 131072;
constexpr int SCR_BYTES = 133120;
constexpr int LDSCTL_OFF = SCR_BYTES, MISC_OFF = LDSCTL_OFF + 320;
constexpr int XTRA_OFF = SCR_BYTES + 1024;
constexpr int LDS_BYTES = 163840;
static_assert(MISC_OFF + 128 <= XTRA_OFF, "LDS map");
constexpr int CW_TMO = 0, CW_BAR = 4096;

#define GAS __attribute__((address_space(1)))
#define LAS __attribute__((address_space(3)))
typedef unsigned short bf16;
typedef unsigned v4u __attribute__((ext_vector_type(4)));
typedef unsigned v2u __attribute__((ext_vector_type(2)));
typedef float f32x4 __attribute__((ext_vector_type(4)));
typedef float f32x2 __attribute__((ext_vector_type(2)));
#define LDS_WAIT() asm volatile("s_waitcnt lgkmcnt(0)" ::: "memory")
#define VM_WAIT() asm volatile("s_waitcnt vmcnt(0)" ::: "memory")
__device__ __forceinline__ unsigned f2bf(float f) { unsigned u = __builtin_bit_cast(unsigned, f); return (u + 0x7fffu + ((u >> 16) & 1u)) >> 16; }
__device__ __forceinline__ unsigned pk2(float lo, float hi) { return f2bf(lo) | (f2bf(hi) << 16); }
__device__ __forceinline__ float bflo(unsigned w) { return __builtin_bit_cast(float, w << 16); }
__device__ __forceinline__ float bfhi(unsigned w) { return __builtin_bit_cast(float, w & 0xffff0000u); }
__device__ __forceinline__ float bf1(bf16 h) { return __builtin_bit_cast(float, (unsigned)h << 16); }
namespace att {
typedef unsigned short bf16;
typedef short bf16x8 __attribute__((ext_vector_type(8)));
typedef short s16x4 __attribute__((ext_vector_type(4)));
typedef float f32x16 __attribute__((ext_vector_type(16)));
typedef float f32x4 __attribute__((ext_vector_type(4)));
typedef unsigned u32x4 __attribute__((ext_vector_type(4)));
template <class A, class Bt> struct same_t { static constexpr bool v = false; };
template <class A> struct same_t<A, A> { static constexpr bool v = true; };
constexpr int D = 128;
constexpr float SCALE = 0.08838834764831845f, THR = 8.f;
constexpr int NW = 8, QBLK = 32, KVBLK = 64, QB = NW * QBLK;
constexpr int SHM_V = KVBLK * D * 2, SHM_K = KVBLK * D * 2;
constexpr int ATT_LDS_BYTES = 2 * SHM_V + 2 * SHM_K + NW * 64 * 4;
#define KSWZ(row, colB) ((row) * 256 + ((colB) ^ (((row) & 7) << 4)))
#define SBAR() __builtin_amdgcn_sched_barrier(0)
__device__ __forceinline__ int v_st(int k, int c) { const int kk = (k & ~0xC) | ((k & 4) << 1) | ((k & 8) >> 1); return ((kk >> 3) * 4 + (c >> 5)) * 512 + ((kk & 7) * 32 + (c & 31)) * 2; }
__device__ __forceinline__ int v_rd_base(int lane) { return ((lane & 3) << 3) | (((lane >> 2) & 3) << 6) | (((lane >> 4) & 1) << 5) | (((lane >> 5) & 1) << 8); }
constexpr int v_rd_off(int d0, int ks, int half) { return d0 * 512 + ks * 4096 + half * 2048; }
__device__ __forceinline__ int crow(int r, int hi) { return (r & 3) + 8 * (r >> 2) + 4 * hi; }
__device__ __forceinline__ unsigned cvtpk(float lo, float hi) {
    unsigned r; asm volatile("v_cvt_pk_bf16_f32 %0, %1, %2" : "=v"(r) : "v"(lo), "v"(hi)); return r;
}
__device__ __forceinline__ bf16x8 pack8(f32x4 a, f32x4 b) {
    u32x4 w = {cvtpk(a[0], a[1]), cvtpk(a[2], a[3]), cvtpk(b[0], b[1]), cvtpk(b[2], b[3])};
    return *reinterpret_cast<bf16x8*>(&w);
}
template <class T> __device__ __forceinline__ bf16x8 load8(const T* p) {
    if constexpr (same_t<T, float>::v) { return pack8(*(const f32x4*)p, *(const f32x4*)(p + 4)); }
    else { return *reinterpret_cast<const bf16x8*>(p); }
}
__device__ __forceinline__ void mask_tile(f32x16& p0, f32x16& p1, int dq, unsigned W) {
    const float NEG = -__builtin_inff();
#pragma unroll
    for (int r = 0; r < 16; ++r) {
        const int c = (r & 3) + 8 * (r >> 2);
        if ((unsigned)(dq - c) >= W) p0[r] = NEG;
        if ((unsigned)(dq - c - 32) >= W) p1[r] = NEG;
    }
}
__device__ __forceinline__ void partialSM(f32x16& p0, f32x16& p1, float& m_reg, float& mn, float& alpha, bool dead = false) {
    float pmax = p0[0]; for (int r = 1; r < 16; ++r) pmax = fmaxf(pmax, p0[r]); for (int r = 0; r < 16; ++r) pmax = fmaxf(pmax, p1[r]);
    { auto rr = __builtin_amdgcn_permlane32_swap(__float_as_uint(pmax), __float_as_uint(pmax), false, false);
      pmax = fmaxf(__uint_as_float(rr[0]), __uint_as_float(rr[1])); }
    if (dead) pmax = -__builtin_inff();
    constexpr float C2 = 1.4426950408889634f * SCALE;
    if (__builtin_expect(__all((pmax - m_reg) * SCALE <= THR), 1)) { mn = m_reg; alpha = 1.f; }
    else { mn = fmaxf(m_reg, pmax); alpha = __builtin_amdgcn_exp2f((m_reg - mn) * C2); m_reg = mn; }
    const float mnL = dead ? -__builtin_inff() : -mn * C2;
    for (int r = 0; r < 16; ++r) p0[r] = fmaf(p0[r], C2, mnL); for (int r = 0; r < 16; ++r) p1[r] = fmaf(p1[r], C2, mnL);
    for (int r = 0; r < 16; ++r) p0[r] = __builtin_amdgcn_exp2f(p0[r]);
}
__device__ __forceinline__ void finishSM(f32x16& p0, f32x16& p1, float alpha, float& l_reg, bf16x8& pa0, bf16x8& pa1, bf16x8& pa2, bf16x8& pa3) {
    for (int r = 0; r < 16; ++r) p1[r] = __builtin_amdgcn_exp2f(p1[r]);
    float ps = 0; for (int r = 0; r < 16; ++r) ps += p0[r]; for (int r = 0; r < 16; ++r) ps += p1[r];
    { auto rr = __builtin_amdgcn_permlane32_swap(__float_as_uint(ps), __float_as_uint(ps), false, false);
      ps = __uint_as_float(rr[0]) + __uint_as_float(rr[1]); }
    l_reg = l_reg * alpha + ps;
#define PK4(P, B_, OUT) do { unsigned a0 = cvtpk(P[B_+0], P[B_+1]), a1 = cvtpk(P[B_+2], P[B_+3]);                          \
        unsigned b0 = cvtpk(P[B_+4], P[B_+5]), b1 = cvtpk(P[B_+6], P[B_+7]);                                             \
        auto r0 = __builtin_amdgcn_permlane32_swap(a0, b0, false, false); auto r1 = __builtin_amdgcn_permlane32_swap(a1, b1, false, false); \
        u32x4 w = {r0[0], r1[0], r0[1], r1[1]}; OUT = *reinterpret_cast<bf16x8*>(&w); } while (0)
    PK4(p0, 0, pa0); PK4(p0, 8, pa1); PK4(p1, 0, pa2); PK4(p1, 8, pa3);
#undef PK4
}
template <int KB, bool SK>
__device__ __forceinline__ void qkt(f32x16& p0, f32x16& p1, const char* K_lds, int r32, int hi, const bf16x8* qr, bool act) {
    if (SK && !act) { const float NEG = -__builtin_inff();
#pragma unroll
        for (int r = 0; r < 16; ++r) { p0[r] = NEG; p1[r] = NEG; } return; }
    p0 = f32x16{}; p1 = f32x16{};
    const char* kb[4];
#pragma unroll
    for (int dd = 0; dd < 4; ++dd) kb[dd] = K_lds + KB * SHM_K + KSWZ(r32, (dd * 16 + hi * 8) * 2);
#pragma unroll
    for (int d0 = 0; d0 < 8; ++d0) { const char* a = kb[d0 & 3] + (d0 >> 2) * 128;
        bf16x8 b0 = *reinterpret_cast<const bf16x8*>(a);
        bf16x8 b1 = *reinterpret_cast<const bf16x8*>(a + 32 * 256);
        p0 = __builtin_amdgcn_mfma_f32_32x32x16_bf16(b0, qr[d0], p0, 0, 0, 0);
        p1 = __builtin_amdgcn_mfma_f32_32x32x16_bf16(b1, qr[d0], p1, 0, 0, 0); }
}
template <int VB, bool SK>
__device__ __forceinline__ void pv_tile(f32x16* o, int vb0, bf16x8 pa0, bf16x8 pa1, bf16x8 pa2, bf16x8 pa3, bool act) {
    if (SK && !act) return;
#define TRRD(dst, off) asm volatile("ds_read_b64_tr_b16 %0, %1 offset:%2" : "=&v"(dst) : "v"(vb0), "i"(off) : "memory")
#define PV_D0(d0) do { s16x4 l0, l1, l2, l3, h0, h1, h2, h3; constexpr int b_ = VB * SHM_V + v_rd_off(d0, 0, 0);     \
        TRRD(l0, b_); TRRD(h0, b_ + 2048); TRRD(l1, b_ + 4096); TRRD(h1, b_ + 6144); TRRD(l2, b_ + 8192); TRRD(h2, b_ + 10240); TRRD(l3, b_ + 12288); TRRD(h3, b_ + 14336); \
        asm volatile("s_waitcnt lgkmcnt(0)" ::: "memory"); SBAR();                 \
        o[d0] = __builtin_amdgcn_mfma_f32_32x32x16_bf16(pa0, (bf16x8){l0[0], l0[1], l0[2], l0[3], h0[0], h0[1], h0[2], h0[3]}, o[d0], 0, 0, 0);   \
        o[d0] = __builtin_amdgcn_mfma_f32_32x32x16_bf16(pa1, (bf16x8){l1[0], l1[1], l1[2], l1[3], h1[0], h1[1], h1[2], h1[3]}, o[d0], 0, 0, 0);   \
        o[d0] = __builtin_amdgcn_mfma_f32_32x32x16_bf16(pa2, (bf16x8){l2[0], l2[1], l2[2], l2[3], h2[0], h2[1], h2[2], h2[3]}, o[d0], 0, 0, 0);   \
        o[d0] = __builtin_amdgcn_mfma_f32_32x32x16_bf16(pa3, (bf16x8){l3[0], l3[1], l3[2], l3[3], h3[0], h3[1], h3[2], h3[3]}, o[d0], 0, 0, 0); } while (0)
    PV_D0(0); PV_D0(1); PV_D0(2); PV_D0(3);
#undef PV_D0
#undef TRRD
}

template <class TIn, class TOut> struct BlockRef { const TIn* Q; const TIn* K; const TIn* V; TOut* O; int P0; const __attribute__((address_space(3))) unsigned short* sel; float* L; };
template <class TIn> struct Seam {
    bf16x8 qr[8];
    bf16x8 st_v0, st_v1, st_k0, st_k1; f32x4 sf0, sf1, sf2, sf3;
    f32x4 tq[16];
};
__device__ __forceinline__ int swa_jlo(int P0, int W) { const int lowk = P0 - W + 1; return lowk > 0 ? lowk / KVBLK : 0; }
#define ROW(p, k0, rr) ((p) + (size_t)((k0) + (rr)) * rs_ + sc)
#define ROWN(p, k0, rr) ((p) + (size_t)((k0) + (rr)) * rsn_ + sc)
#define VMW() asm volatile("s_waitcnt vmcnt(0)" ::: "memory")
#define VMWN(n) asm volatile("s_waitcnt vmcnt(%0)" :: "i"(n) : "memory")
#define SLOAD_H(Kp, Vp, k0) do { S.st_v0 = load8<TIn>(ROW(Vp, k0, sr)); S.st_v1 = load8<TIn>(ROW(Vp, k0, 32 + sr));              \
                         S.st_k0 = load8<TIn>(ROW(Kp, k0, sr)); S.st_k1 = load8<TIn>(ROW(Kp, k0, 32 + sr)); } while (0)
#define SLOAD_HN(Kp, Vp, k0) do { S.st_v0 = load8<TIn>(ROWN(Vp, k0, sr)); S.st_v1 = load8<TIn>(ROWN(Vp, k0, 32 + sr));              \
                         S.st_k0 = load8<TIn>(ROWN(Kp, k0, sr)); S.st_k1 = load8<TIn>(ROWN(Kp, k0, 32 + sr)); } while (0)
#define SWRITE_HK(bf) do { *(bf16x8*)(K_lds + (bf) * SHM_K + kws) = S.st_k0; *(bf16x8*)(K_lds + (bf) * SHM_K + kws + 32 * 256) = S.st_k1; } while (0)
#define SWRITE_HV(bf) do { *(bf16x8*)(V_lds + (bf) * SHM_V + vst0) = S.st_v0; *(bf16x8*)(V_lds + (bf) * SHM_V + vst1) = S.st_v1; } while (0)
#define SWRITE_H(bf) do { SWRITE_HV(bf); SWRITE_HK(bf); } while (0)
#define SLOAD_F(p, k0) do { S.sf0 = *(const f32x4*)ROW(p, k0, sr); S.sf1 = *(const f32x4*)(ROW(p, k0, sr) + 4);                \
                            S.sf2 = *(const f32x4*)ROW(p, k0, 32 + sr); S.sf3 = *(const f32x4*)(ROW(p, k0, 32 + sr) + 4); } while (0)
#define SWRITE_KF(bf) do { *(bf16x8*)(K_lds + (bf) * SHM_K + kws) = pack8(S.sf0, S.sf1); *(bf16x8*)(K_lds + (bf) * SHM_K + kws + 32 * 256) = pack8(S.sf2, S.sf3); } while (0)
#define SWRITE_VF(bf) do { *(bf16x8*)(V_lds + (bf) * SHM_V + vst0) = pack8(S.sf0, S.sf1); *(bf16x8*)(V_lds + (bf) * SHM_V + vst1) = pack8(S.sf2, S.sf3); } while (0)
template <class TIn, class TOut, int RSC, int W>
__device__ __forceinline__ void causal_swa_prime(const BlockRef<TIn, TOut>& cur, char* lds, Seam<TIn>& S) {
    constexpr bool F32 = same_t<TIn, float>::v;
    int tid_ = threadIdx.x; asm volatile("" : "+v"(tid_));
    const int tid = tid_, wid = __builtin_amdgcn_readfirstlane(tid >> 6), lane = tid & 63, r32 = lane & 31, hi = lane >> 5;
    const int sr = tid >> 4, sc = (tid & 15) * 8, kws = KSWZ(sr, sc * 2); char* K_lds = lds + 2 * SHM_V;
    const int kb0 = swa_jlo(cur.P0, W) * KVBLK; constexpr int rs_ = RSC;
    for (int d0 = 0; d0 < 8; ++d0) S.qr[d0] = load8<TIn>(cur.Q + (size_t)(wid * QBLK + r32) * rs_ + d0 * 16 + hi * 8);
    if constexpr (F32) { SLOAD_F((const float*)cur.K, kb0); VMW(); SWRITE_KF(0); SBAR(); SLOAD_F((const float*)cur.V, kb0); }
    else { SLOAD_H(cur.K, cur.V, kb0); VMW(); SWRITE_HK(0); }
    __syncthreads();
}
template <class TIn, class TOut, bool SKP, int MODE, int RSC, int RSN, int OSC, int W, int WN, int skv>
__device__ __forceinline__ void causal_swa_block(const BlockRef<TIn, TOut>& cur, const BlockRef<TIn, TOut>& nxt, char* lds, Seam<TIn>& S) {
    constexpr bool F32 = same_t<TIn, float>::v; static_assert(!F32, "bf16 inputs only in this build");
    constexpr int rs_ = RSC, rsn_ = RSN, os_ = OSC;
    int tid_ = threadIdx.x; asm volatile("" : "+v"(tid_));
    const int tid = tid_, wid = __builtin_amdgcn_readfirstlane(tid >> 6), lane = tid & 63, r32 = lane & 31, hi = lane >> 5;
    const int j_lo = swa_jlo(cur.P0, W);
    int j_hi = (cur.P0 + QB - 1) / KVBLK + 1; if (j_hi > skv / KVBLK) j_hi = skv / KVBLK;
    const int NT = j_hi - j_lo;
    const int kbn = swa_jlo(nxt.P0, WN) * KVBLK;
    const int qlo = cur.P0 + wid * QBLK, qm = qlo + r32 - 4 * hi;
    char* V_lds = lds; char* K_lds = lds + 2 * SHM_V;
    float* ws = (float*)(lds + 2 * SHM_V + 2 * SHM_K) + wid * 64; float* li_l = ws, * al_l = ws + 32;
    float m_reg = -1e30f, l_reg = 0; f32x16 o[4] = {};
    unsigned selm = 0u; if constexpr (MODE == 0) selm = cur.sel[wid * QBLK + r32];
    bool deadq = false;
    const int sr = tid >> 4, sc = (tid & 15) * 8, vst0 = v_st(sr, sc), vst1 = v_st(32 + sr, sc), kws = KSWZ(sr, sc * 2);
    const int vb0 = (int)(uintptr_t)V_lds + v_rd_base(lane);
    const TIn* Kh = cur.K; const TIn* Vh = cur.V;
#define RESC(a) do { if (__any((a) < 1.f)) { if (hi == 0) al_l[r32] = (a); asm volatile("s_waitcnt lgkmcnt(0)" ::: "memory");              \
                     for (int d_ = 0; d_ < 4; ++d_) for (int r = 0; r < 16; ++r) o[d_][r] *= al_l[crow(r, hi)]; } } while (0)
#define KBASE(t) ((j_lo + (t)) * KVBLK)
#define ACT(t) (KBASE(t) <= qlo + QBLK - 1 && KBASE(t) + KVBLK - 1 >= qlo - W + 1)
#define MASKT(P0_, P1_, t) do { const int kb_ = KBASE(t); if ((!SK || ACT(t)) && (kb_ + KVBLK - 1 > qlo || kb_ <= qlo + QBLK - 1 - W)) mask_tile(P0_, P1_, qm - kb_, (unsigned)W); \
        if constexpr (MODE == 0) { deadq = (kb_ < cur.P0) && (((selm >> (kb_ >> 8)) & 1u) == 0u); } } while (0)
    constexpr int NQL = F32 ? 16 : 8;
    constexpr bool SK = SKP && !F32;
#define SEAM_K0() do { VMWN(NQL); if constexpr (F32) { SWRITE_KF(0); SBAR(); SLOAD_F((const float*)nxt.V, kbn); } else { SWRITE_HK(0); } SBAR(); } while (0)
    f32x16 pA0, pA1, pB0, pB1; float mnA, mnB, alA, alB; bf16x8 pa0, pa1, pa2, pa3;
    if constexpr (F32) { VMW(); SWRITE_VF(0); SBAR(); } else { SWRITE_HV(0); SBAR(); }
    if (NT > 1) { if constexpr (F32) SLOAD_F((const float*)Kh, KBASE(1)); else SLOAD_H(Kh, Vh, KBASE(1)); }
    SBAR(); qkt<0, SK>(pA0, pA1, K_lds, r32, hi, S.qr, ACT(0));
    if constexpr (F32) { if (NT > 1) { VMW(); SWRITE_KF(1); SBAR(); SLOAD_F((const float*)Vh, KBASE(1)); } }
    MASKT(pA0, pA1, 0); partialSM(pA0, pA1, m_reg, mnA, alA, deadq);
    if (NT > 1) { VMW(); if constexpr (F32) { SWRITE_VF(1); SBAR(); if (NT > 2) SLOAD_F((const float*)Kh, KBASE(2)); } else SWRITE_H(1); }
    __syncthreads();
#define HALF_STEP(PX0, PX1, mnX, alX, PY0, PY1, alY, t, KB, VB, SB) do {                                                      \
        SBAR(); qkt<KB, SK>(PX0, PX1, K_lds, r32, hi, S.qr, ACT(t));                                             \
        finishSM(PY0, PY1, alY, l_reg, pa0, pa1, pa2, pa3); SBAR();                                                           \
        if ((t) + 1 < NT) { if constexpr (F32) { VMW(); SWRITE_KF(SB); SBAR(); SLOAD_F((const float*)Vh, KBASE((t) + 1)); }  \
                            else { SLOAD_H(Kh, Vh, KBASE((t) + 1)); } SBAR(); }                                               \
        pv_tile<VB, SK>(o, vb0, pa0, pa1, pa2, pa3, ACT((t) - 1)); MASKT(PX0, PX1, (t)); partialSM(PX0, PX1, m_reg, mnX, alX, deadq);                                        \
        __syncthreads();                                                                                                      \
        if ((t) + 1 < NT) { VMW(); if constexpr (F32) { SWRITE_VF(SB); SBAR(); if ((t) + 2 < NT) SLOAD_F((const float*)Kh, KBASE((t) + 2)); } \
                            else { SWRITE_H(SB); } }                                                                          \
        RESC(alX); __syncthreads(); } while (0)
    for (int t = 1; t + 1 < NT; t += 2) {
        HALF_STEP(pB0, pB1, mnB, alB, pA0, pA1, alA, t, 1, 0, 0);
        HALF_STEP(pA0, pA1, mnA, alA, pB0, pB1, alB, t + 1, 0, 1, 1);
    }
    const bool even = (NT & 1) == 0;
    if (even) { SBAR(); qkt<1, SK>(pB0, pB1, K_lds, r32, hi, S.qr, ACT(NT - 1)); SBAR(); }
#define QROW(e) (nxt.Q + (size_t)(wid * QBLK + r32) * rsn_ + ((e) >> 1) * 16 + hi * 8 + ((e) & 1) * 4)
    if constexpr (F32) { SLOAD_F((const float*)nxt.K, kbn); SBAR();
#pragma unroll
        for (int e = 0; e < 8; ++e) S.tq[e] = *(const f32x4*)QROW(e); }
    else { SLOAD_HN(nxt.K, nxt.V, kbn); SBAR();
#pragma unroll
        for (int d0 = 0; d0 < 8; ++d0) S.qr[d0] = load8<TIn>(nxt.Q + (size_t)(wid * QBLK + r32) * rsn_ + d0 * 16 + hi * 8); }
    SBAR();
    finishSM(pA0, pA1, alA, l_reg, pa0, pa1, pa2, pa3); SBAR();
    if constexpr (F32) {
#pragma unroll
        for (int e = 8; e < 16; ++e) S.tq[e] = *(const f32x4*)QROW(e); SBAR(); }
#undef QROW
    pv_tile<0, SK>(o, vb0, pa0, pa1, pa2, pa3, ACT(even ? NT - 2 : NT - 1));
    if (even) { MASKT(pB0, pB1, NT - 1); partialSM(pB0, pB1, m_reg, mnB, alB, deadq); __syncthreads(); RESC(alB);
        finishSM(pB0, pB1, alB, l_reg, pa0, pa1, pa2, pa3); SBAR(); pv_tile<1, SK>(o, vb0, pa0, pa1, pa2, pa3, ACT(NT - 1)); }
    SBAR(); SEAM_K0();
    if (hi == 0) li_l[r32] = l_reg; asm volatile("s_waitcnt lgkmcnt(0)" ::: "memory");
    if constexpr (MODE == 1) { if (hi == 0) cur.L[(size_t)(wid * QBLK + r32) * (RSC / 128 * 24)] = m_reg * SCALE + __logf(l_reg); }
    float rli[16];
#pragma unroll
    for (int r = 0; r < 16; ++r) rli[r] = __builtin_amdgcn_rcpf(li_l[crow(r, hi)]);
    TOut* Ow = cur.O + (size_t)(wid * QBLK) * os_;
#pragma unroll
    for (int r = 0; r < 16; ++r) { const int orow = crow(r, hi);
#pragma unroll
        for (int d0 = 0; d0 < 4; ++d0) { const float v = o[d0][r] * rli[r];
            if constexpr (same_t<TOut, float>::v) { Ow[(size_t)orow * os_ + d0 * 32 + r32] = v; }
            else { const float vn = __shfl_xor(v, 1);
                   if ((r32 & 1) == 0) *(unsigned*)(Ow + (size_t)orow * os_ + d0 * 32 + r32) = cvtpk(v, vn); } } }
    if constexpr (F32) {
#pragma unroll
        for (int d0 = 0; d0 < 8; ++d0) S.qr[d0] = pack8(S.tq[2 * d0], S.tq[2 * d0 + 1]); }
    __syncthreads();
#undef RESC
#undef KBASE
#undef ACT
#undef MASKT
#undef SEAM_K0
#undef HALF_STEP
}
#undef ROW
#undef ROWN
#undef SLOAD_HN
#undef VMW
#undef VMWN
#undef SLOAD_H
#undef SWRITE_HK
#undef SWRITE_HV
#undef SWRITE_H
#undef SLOAD_F
#undef SWRITE_KF
#undef SWRITE_VF
}
#define XB_TMO      128
#define XB_XCNT(j)  (256  + 64 * (j))
#define XB_XSUB(j)  (1280 + 64 * (j))
#define XB_XGEN(j)  (2304 + 64 * (j))
#define XB_TOP      3328
#define XB_TOPGEN   3392
#define XCD_BAR_WORDS 3456
#define XB_SPIN_CAP (1u << 18)

__device__ __forceinline__ unsigned xb_ld(unsigned* p)              { return __hip_atomic_load(p, __ATOMIC_RELAXED, __HIP_MEMORY_SCOPE_AGENT); }
__device__ __forceinline__ unsigned xb_add(unsigned* p, unsigned v) { return __hip_atomic_fetch_add(p, v, __ATOMIC_RELAXED, __HIP_MEMORY_SCOPE_AGENT); }
__device__ __forceinline__ unsigned xb_xcc_id() { return (unsigned)__builtin_amdgcn_s_getreg((3 << 11) | 20) & 0xFu; }
#define XB_SPIN(cond, bar) do { unsigned _sp = 0; while (cond) { __builtin_amdgcn_s_sleep(1); \
    if ((++_sp & 255u) == 0u) { if (xb_ld(&(bar)[XB_TMO])) break; if (_sp > XB_SPIN_CAP) { atomicAdd(&(bar)[XB_TMO], 1u); break; } } } } while (0)

struct XcdBarrier {
    unsigned* bar; unsigned x;
    volatile LAS unsigned* st;
};

__device__ __forceinline__ XcdBarrier xcd_barrier_post(unsigned* bar, volatile LAS unsigned* st) {
    XcdBarrier b; b.bar = bar; b.x = xb_xcc_id(); b.st = st;
    if (threadIdx.x == 0) (void)xb_add(&bar[XB_XCNT(b.x)], 1u);
    return b;
}
__device__ __forceinline__ void xcd_barrier_complete(unsigned* bar, unsigned x, unsigned& nloc, unsigned& nx) {
    const unsigned G = gridDim.x * gridDim.y * gridDim.z;
    unsigned sum, cnt, mine, sp = 0u;
    for (;;) {
        sum = 0u; cnt = 0u; mine = 0u;
#pragma unroll
        for (unsigned j = 0; j < 16; ++j) { const unsigned c = xb_ld(&bar[XB_XCNT(j)]); sum += c; cnt += (c > 0u) ? 1u : 0u; mine = (j == x) ? c : mine; }
        if (sum == G) break;
        __builtin_amdgcn_s_sleep(1);
        if ((++sp & 255u) == 0u) { if (xb_ld(&bar[XB_TMO])) break; if (sp > XB_SPIN_CAP) { atomicAdd(&bar[XB_TMO], 1u); break; } }
    }
    nloc = mine > 0u ? mine : 1u; nx = cnt > 0u ? cnt : 1u;
}

__device__ __forceinline__ void xcd_barrier(const XcdBarrier& b) {
    asm volatile("s_waitcnt vmcnt(0)" ::: "memory");
    __syncthreads();
    if (threadIdx.x == 0) {
        unsigned* bar = b.bar;
        __builtin_amdgcn_s_waitcnt(0);
        unsigned nloc = b.st[0], nx = b.st[1];
        if (nloc == 0u) { xcd_barrier_complete(bar, b.x, nloc, nx); b.st[0] = nloc; b.st[1] = nx; }
        const unsigned old = xb_add(&bar[XB_XSUB(b.x)], 1u);
        const unsigned gen = old / nloc;
        if (old + 1u == (gen + 1u) * nloc) {
            __builtin_amdgcn_fence(__ATOMIC_RELEASE, "agent");
            asm volatile("s_waitcnt vmcnt(0)" ::: "memory");
            const unsigned og = xb_add(&bar[XB_TOP], 1u);
            const unsigned tg = og / nx;
            if (og + 1u == (tg + 1u) * nx) xb_add(&bar[XB_TOPGEN], 1u);
            else XB_SPIN(xb_ld(&bar[XB_TOPGEN]) == tg, bar);
            __builtin_amdgcn_fence(__ATOMIC_ACQUIRE, "agent");
            xb_add(&bar[XB_XGEN(b.x)], 1u);
            asm volatile("s_waitcnt vmcnt(0)" ::: "memory");
        } else {
            XB_SPIN(xb_ld(&bar[XB_XGEN(b.x)]) == gen, bar);
            __builtin_amdgcn_fence(__ATOMIC_ACQUIRE, "agent");
            asm volatile("s_waitcnt vmcnt(0)" ::: "memory");
        }
    }
    __syncthreads();
}
struct Frame {
    LAS unsigned char* lds;
    volatile LAS unsigned* MISC;
    unsigned* ctl;
    int wave, G, gw, NGW;
    unsigned char* ws;
    const float* x; const int* pos;
    const float *attn_norm, *attn_w_in, *attn_w_out, *sg_norm, *sg_w_in, *sg_b_in, *sg_v_gain, *sg_v_bias, *sg_w_s, *sg_b_s, *sg_w_out, *ffn_norm, *ffn_w_up, *ffn_conv_w, *ffn_conv_b, *ffn_w_down, *final_norm;
    float* out;
};
#define LANE_ID() ((int)__builtin_amdgcn_mbcnt_hi(~0u, __builtin_amdgcn_mbcnt_lo(~0u, 0u)))
__device__ __forceinline__ float wave_sum(float v) {
#pragma unroll
    for (int o = 1; o < 64; o <<= 1) v += __shfl_xor(v, o);
    return v;
}
__device__ __forceinline__ float wave_max(float v) {
#pragma unroll
    for (int o = 1; o < 64; o <<= 1) v = fmaxf(v, __shfl_xor(v, o));
    return v;
}
__device__ __forceinline__ float ss_rstd(const float* ss, int r) { return pg8::rstd_from_ss(ss, r); }

__device__ __forceinline__ unsigned q8m(float x, float inv) { return __builtin_bit_cast(unsigned, __builtin_fmaf(x, inv, 12582912.0f)); }
__device__ __forceinline__ unsigned q8(float x, float inv) { return q8m(x, inv) & 0xffu; }
__device__ __forceinline__ unsigned q8x2(float a, float b, float inv) { return __builtin_amdgcn_perm(q8m(b, inv), q8m(a, inv), 0x0c0c0400u); }
__device__ __forceinline__ unsigned q8x4(float a, float b, float c, float d, float inv) { return __builtin_amdgcn_perm(q8m(b, inv), q8m(a, inv), 0x0c0c0400u) | __builtin_amdgcn_perm(q8m(d, inv), q8m(c, inv), 0x04000c0cu); }
__device__ __forceinline__ void unpack8(const v4u w, float (&f)[8]) { f[0] = bflo(w.x); f[1] = bfhi(w.x); f[2] = bflo(w.y); f[3] = bfhi(w.y); f[4] = bflo(w.z); f[5] = bfhi(w.z); f[6] = bflo(w.w); f[7] = bfhi(w.w); }
struct MapId { __device__ __forceinline__ int operator()(int n) const { return n; } };
struct MapUp { __device__ __forceinline__ int operator()(int n) const { return n < DFF ? ((n >> 7) << 8) + (n & 127) : (((n - DFF) >> 7) << 8) + 128 + ((n - DFF) & 127); } };
template <class RowMap>
__device__ __forceinline__ void transpose_item(const float* W, int K, int N, const float* gain, bf16* WT, RowMap rm, LAS float* scr, int item, int lane, unsigned* amax = nullptr) {
    const int nblk = N / 64, kb = item / nblk, nb = item - kb * nblk, k0 = 64 * kb, n0 = 64 * nb;
    const int lr = lane >> 4, lc = (lane & 15) * 4;
    f32x4 v[16];
#pragma unroll
    for (int i = 0; i < 16; ++i) v[i] = __builtin_nontemporal_load((const f32x4*)(W + (size_t)(k0 + 4 * i + lr) * N + n0 + lc));
#pragma unroll
    for (int i = 0; i < 16; ++i) { const int kk = 4 * i + lr; f32x4 x = v[i]; if (gain) x = x * gain[k0 + kk]; LAS float* d = scr + kk * 65 + lc; d[0] = x[0]; d[1] = x[1]; d[2] = x[2]; d[3] = x[3]; }
    LDS_WAIT(); asm volatile("" ::: "memory");
    const int c = lane & 7;
#pragma unroll
    for (int j = 0; j < 8; ++j) { const int n = (lane >> 3) + 8 * j; const LAS float* s = scr + (8 * c) * 65 + n;
        v4u o; o.x = pk2(s[0 * 65], s[1 * 65]); o.y = pk2(s[2 * 65], s[3 * 65]); o.z = pk2(s[4 * 65], s[5 * 65]); o.w = pk2(s[6 * 65], s[7 * 65]);
        *(v4u*)(WT + (size_t)rm(n0 + n) * K + k0 + 8 * c) = o;
        if (amax) {
            float mx = fmaxf(fmaxf(fmaxf(fabsf(s[0 * 65]), fabsf(s[1 * 65])), fmaxf(fabsf(s[2 * 65]), fabsf(s[3 * 65]))), fmaxf(fmaxf(fabsf(s[4 * 65]), fabsf(s[5 * 65])), fmaxf(fabsf(s[6 * 65]), fabsf(s[7 * 65]))));
            mx = fmaxf(mx, __shfl_xor(mx, 1)); mx = fmaxf(mx, __shfl_xor(mx, 2)); mx = fmaxf(mx, __shfl_xor(mx, 4));
            if (c == 0) atomicMax(amax + rm(n0 + n), __builtin_bit_cast(unsigned, mx));
        } }
    LDS_WAIT(); asm volatile("" ::: "memory");
}
__device__ __forceinline__ void sincos_d(double a, double& sn, double& cs) {
    const double n = __builtin_rint(a * 0.15915494309189535);
    const double r = a - n * 6.283185307179586;
    const double r2 = r * r;
    double ts = r, tc = 1.0, s = r, c = 1.0;
#pragma unroll
    for (int k = 1; k <= 15; ++k) { tc = -tc * r2 / (double)((2 * k - 1) * (2 * k)); ts = -ts * r2 / (double)((2 * k) * (2 * k + 1)); c += tc; s += ts; }
    sn = s; cs = c;
}
struct TItem { const float* W; const float* gain; bf16* WT; unsigned* amax; int K, N, mapup, k0, n0; };
__device__ __forceinline__ bool titem_decode(const Frame& F, int it, TItem& t) {
    constexpr int I_SQ = 64 * (DM / 64), I_SGIN = 64 * (2 * DM / 64), I_DN = (DFF / 64) * (DM / 64);
    constexpr int NITEMS = I_SGIN + I_SQ + 2 * I_DN;
    if (it >= NITEMS) return false;
    int r = it; t.mapup = 0; t.amax = nullptr; t.gain = nullptr; t.K = DM;
    if (r < I_SGIN) { t.W = F.sg_w_in; t.N = 2 * DM; t.gain = F.sg_norm; t.WT = (bf16*)(F.ws + WS_SGWIN); }
    else if ((r -= I_SGIN) < I_SQ) { t.W = F.sg_w_out; t.N = DM; t.WT = (bf16*)(F.ws + WS_SGWOUT); }
    else if ((r -= I_SQ) < I_DN) { t.W = F.ffn_w_down; t.N = DM; t.K = DFF; t.WT = (bf16*)(F.ws + WS_WDOWN); }
    else { r -= I_DN; t.W = F.ffn_w_down + (size_t)DFF * DM; t.N = DM; t.K = DFF; t.WT = (bf16*)(F.ws + WS_WDOWN + WDOWN_L); }
    const int nblk = t.N / 64, kb = r / nblk, nb = r - kb * nblk; t.k0 = 64 * kb; t.n0 = 64 * nb;
    return true;
}
__device__ __forceinline__ void titem_load(const TItem& t, f32x4 (&v)[16], int lane) {
    const int lr = lane >> 4, lc = (lane & 15) * 4;
#pragma unroll
    for (int i = 0; i < 16; ++i) v[i] = __builtin_nontemporal_load((const f32x4*)(t.W + (size_t)(t.k0 + 4 * i + lr) * t.N + t.n0 + lc));
}
__device__ __forceinline__ void titem_process(const TItem& t, const f32x4 (&v)[16], LAS float* scr, int lane) {
    const int lr = lane >> 4, lc = (lane & 15) * 4;
#pragma unroll
    for (int i = 0; i < 16; ++i) { const int kk = 4 * i + lr; f32x4 x = v[i]; if (t.gain) x = x * t.gain[t.k0 + kk]; LAS float* d = scr + kk * 65 + lc; d[0] = x[0]; d[1] = x[1]; d[2] = x[2]; d[3] = x[3]; }
    LDS_WAIT(); asm volatile("" ::: "memory");
    const int c = lane & 7;
#pragma unroll
    for (int j = 0; j < 8; ++j) { const int n = (lane >> 3) + 8 * j; const LAS float* s = scr + (8 * c) * 65 + n;
        const int nn = t.n0 + n, drow = t.mapup ? MapUp()(nn) : nn;
        v4u o; o.x = pg8::cvt_pk_bf16(s[0 * 65], s[1 * 65]); o.y = pg8::cvt_pk_bf16(s[2 * 65], s[3 * 65]); o.z = pg8::cvt_pk_bf16(s[4 * 65], s[5 * 65]); o.w = pg8::cvt_pk_bf16(s[6 * 65], s[7 * 65]);
        *(v4u*)(t.WT + (size_t)drow * t.K + t.k0 + 8 * c) = o;
        if (t.amax) {
            float mx = fmaxf(fmaxf(fmaxf(fabsf(s[0 * 65]), fabsf(s[1 * 65])), fmaxf(fabsf(s[2 * 65]), fabsf(s[3 * 65]))), fmaxf(fmaxf(fabsf(s[4 * 65]), fabsf(s[5 * 65])), fmaxf(fabsf(s[6 * 65]), fabsf(s[7 * 65]))));
            mx = fmaxf(mx, __shfl_xor(mx, 1)); mx = fmaxf(mx, __shfl_xor(mx, 2)); mx = fmaxf(mx, __shfl_xor(mx, 4));
            if (c == 0) atomicMax(t.amax + drow, __builtin_bit_cast(unsigned, mx));
        } }
    LDS_WAIT(); asm volatile("" ::: "memory");
}
__device__ __forceinline__ void qw_load(const bf16* src, int n, v4u (&v)[8]) {
    const v4u* s = (const v4u*)(src + (size_t)n * DM) + LANE_ID();
#pragma unroll
    for (int i = 0; i < 8; ++i) v[i] = s[64 * i];
}
__device__ __forceinline__ void qw_store(signed char* dst, const unsigned* amax, float* scale, int n, const v4u (&v)[8]) {
    const float am = __builtin_bit_cast(float, amax[n]), inv = am > 0.f ? 127.0f / am : 0.f;
    if (LANE_ID() == 0) scale[n] = am * (1.0f / 127.0f);
    v2u* d = (v2u*)(dst + (size_t)n * DM) + LANE_ID();
#pragma unroll
    for (int i = 0; i < 8; ++i) { float f[8]; unpack8(v[i], f);
        v2u o; o.x = q8(f[0], inv) | (q8(f[1], inv) << 8) | (q8(f[2], inv) << 16) | (q8(f[3], inv) << 24); o.y = q8(f[4], inv) | (q8(f[5], inv) << 8) | (q8(f[6], inv) << 16) | (q8(f[7], inv) << 24);
        d[64 * i] = o; }
}
__device__ __forceinline__ void quant_weight_rows(Frame& F, const bf16* src, signed char* dst, const unsigned* amax, float* scale, int N) {
    v4u a[8], b[8];
    int n = F.gw;
    if (n < N) qw_load(src, n, a);
    while (n < N) {
        const int n2 = n + F.NGW;
        if (n2 < N) qw_load(src, n2, b);
        qw_store(dst, amax, scale, n, a);
        if (n2 >= N) break;
        n = n2 + F.NGW;
        if (n < N) qw_load(src, n, a);
        qw_store(dst, amax, scale, n2, b);
    }
}
__device__ __forceinline__ void qa_load(const float* src, int m, f32x4 (&v)[16]) {
    const f32x4* s = (const f32x4*)(src + (size_t)m * DM) + LANE_ID();
#pragma unroll
    for (int j = 0; j < 16; ++j) v[j] = s[64 * j];
}
__device__ __forceinline__ void qa_store(signed char* dst, float* scale, float* ssq, int m, const f32x4 (&v)[16]) {
    unsigned* d = (unsigned*)(dst + (size_t)m * DM) + LANE_ID();
    float am = 0.f, sq = 0.f;
#pragma unroll
    for (int j = 0; j < 16; ++j) { am = fmaxf(am, fmaxf(fmaxf(fabsf(v[j][0]), fabsf(v[j][1])), fmaxf(fabsf(v[j][2]), fabsf(v[j][3]))));
        sq += (v[j][0] * v[j][0] + v[j][1] * v[j][1]) + (v[j][2] * v[j][2] + v[j][3] * v[j][3]); }
    am = wave_max(am); sq = wave_sum(sq);
    const float inv = am > 0.f ? 127.0f / am : 0.f;
    if (LANE_ID() == 0) { scale[m] = am * (1.0f / 127.0f); ssq[m] = sq; }
#pragma unroll
    for (int j = 0; j < 16; ++j) d[64 * j] = q8(v[j][0], inv) | (q8(v[j][1], inv) << 8) | (q8(v[j][2], inv) << 16) | (q8(v[j][3], inv) << 24);
}
__device__ __forceinline__ void quant_act_rows(Frame& F, const float* src, signed char* dst, float* scale, float* ssq) {
    f32x4 a[16], b[16];
    int m = F.gw;
    if (m < MR) qa_load(src, m, a);
    while (m < MR) {
        const int m2 = m + F.NGW;
        if (m2 < MR) qa_load(src, m2, b);
        qa_store(dst, scale, ssq, m, a);
        if (m2 >= MR) break;
        m = m2 + F.NGW;
        if (m < MR) qa_load(src, m, a);
        qa_store(dst, scale, ssq, m2, b);
    }
}
__device__ __forceinline__ void qh_store(signed char* dst, float* scale, float* ssq, int m, const v4u (&v)[8]) {
    v2u* d = (v2u*)(dst + (size_t)m * DM) + LANE_ID();
    float am = 0.f, sq = 0.f;
#pragma unroll
    for (int i = 0; i < 8; ++i) { float f[8]; unpack8(v[i], f);
#pragma unroll
        for (int e = 0; e < 8; ++e) { am = fmaxf(am, fabsf(f[e])); sq += f[e] * f[e]; } }
    am = wave_max(am); sq = wave_sum(sq);
    const float inv = am > 0.f ? 127.0f / am : 0.f;
    if (LANE_ID() == 0) { scale[m] = am * (1.0f / 127.0f); ssq[m] = sq; }
#pragma unroll
    for (int i = 0; i < 8; ++i) { float f[8]; unpack8(v[i], f);
        v2u o; o.x = q8(f[0], inv) | (q8(f[1], inv) << 8) | (q8(f[2], inv) << 16) | (q8(f[3], inv) << 24); o.y = q8(f[4], inv) | (q8(f[5], inv) << 8) | (q8(f[6], inv) << 16) | (q8(f[7], inv) << 24);
        d[64 * i] = o; }
}
__device__ __forceinline__ void quant_stream_rows(Frame& F, const bf16* src, signed char* dst, float* scale, float* ssq) {
    v4u a[8], b[8];
    int m = F.gw;
    if (m < MR) qw_load(src, m, a);
    while (m < MR) {
        const int m2 = m + F.NGW;
        if (m2 < MR) qw_load(src, m2, b);
        qh_store(dst, scale, ssq, m, a);
        if (m2 >= MR) break;
        m = m2 + F.NGW;
        if (m < MR) qw_load(src, m, a);
        qh_store(dst, scale, ssq, m2, b);
    }
}
constexpr int STRIP_RS = 8208;
constexpr int STRIP_RS8 = 4112;
struct SItem { const float* W; const float* gain; signed char* dst; float* sw; int N, n0, mapup; float gflag; };
__device__ __forceinline__ bool sitem_decode(const Frame& F, int s, SItem& t) {
    constexpr int S_WIN = QKVC / 32, S_SQ = DM / 32, S_UP = F2 / 32;
    if (s >= S_WIN + S_SQ + 2 * S_UP) return false;
    float* SW = (float*)(F.ws + WS_SW);
    int r = s; t.mapup = 0; t.gflag = 1.0f;
    if (r < S_WIN) { t.W = F.attn_w_in; t.N = QKVC; t.gain = F.attn_norm; t.dst = (signed char*)(F.ws + WS_WIN8); t.sw = SW + AM_WIN; }
    else if ((r -= S_WIN) < S_SQ) { t.W = F.attn_w_out; t.N = DM; t.gain = F.attn_norm; t.gflag = 0.0f; t.dst = (signed char*)(F.ws + WS_WOUT8); t.sw = SW + AM_WOUT; }
    else if ((r -= S_SQ) < S_UP) { t.W = F.ffn_w_up; t.N = F2; t.gain = F.ffn_norm; t.dst = (signed char*)(F.ws + WS_WUP8); t.sw = SW + AM_WUP; t.mapup = 1; }
    else { r -= S_UP; t.W = F.ffn_w_up + (size_t)DM * F2; t.N = F2; t.gain = F.ffn_norm + DM; t.dst = (signed char*)(F.ws + WS_WUP8 + WUP8_L); t.sw = SW + AM_WUP + F2; t.mapup = 1; }
    t.n0 = 32 * r;
    return true;
}
__device__ __forceinline__ void sbatch_load(const SItem& t, int h, f32x4 (&v)[16], f32x2 (&g)[4], int tid) {
    const int q = tid & 3, rr = tid >> 2;
    const unsigned voff = (unsigned)((2 * rr) * t.N + t.n0 + 8 * q) * 4u;
#pragma unroll
    for (int p = 0; p < 4; ++p) { const int kb = h * 1024 + p * 256;
        const char* b0 = (const char*)(t.W + (size_t)kb * t.N); const char* b1 = (const char*)(t.W + (size_t)(kb + 1) * t.N);
        v[4 * p] = *(const f32x4*)(b0 + voff); v[4 * p + 1] = *(const f32x4*)(b0 + voff + 16);
        v[4 * p + 2] = *(const f32x4*)(b1 + voff); v[4 * p + 3] = *(const f32x4*)(b1 + voff + 16);
        const f32x2 gv = *(const f32x2*)((const char*)(t.gain + kb) + (unsigned)(8 * rr));
        g[p] = gv; }
}
__device__ __forceinline__ void sbatch_park(int h, const f32x4 (&v)[16], const f32x2 (&g)[4], float gflag, LAS unsigned char* strip, v4u (&held)[16], float (&mx)[8], int tid) {
    const int q = tid & 3, rr = tid >> 2;
#pragma unroll
    for (int p = 0; p < 4; ++p) { const int k2 = h * 512 + p * 128 + rr;
        const f32x2 gg = g[p] * gflag + (1.0f - gflag);
        const f32x4 a0 = v[4 * p] * gg.x, b0 = v[4 * p + 1] * gg.x, a1 = v[4 * p + 2] * gg.y, b1 = v[4 * p + 3] * gg.y;
#pragma unroll
        for (int j = 0; j < 4; ++j) { mx[j] = fmaxf(mx[j], fmaxf(fabsf(a0[j]), fabsf(a1[j]))); mx[4 + j] = fmaxf(mx[4 + j], fmaxf(fabsf(b0[j]), fabsf(b1[j])));
            *(LAS unsigned*)(strip + (4 * q + j) * STRIP_RS + k2 * 4) = pg8::cvt_pk_bf16(a0[j], a1[j]); }
        v4u hw; hw.x = pg8::cvt_pk_bf16(b0[0], b1[0]); hw.y = pg8::cvt_pk_bf16(b0[1], b1[1]); hw.z = pg8::cvt_pk_bf16(b0[2], b1[2]); hw.w = pg8::cvt_pk_bf16(b0[3], b1[3]);
        held[4 * h + p] = hw;
#pragma unroll
        for (int j = 0; j < 8; ++j) asm volatile("" : "+v"(mx[j]));
    }
}
__device__ __forceinline__ unsigned q8pair(unsigned w, float inv) { return q8x2(bflo(w), bfhi(w), inv); }
__device__ __forceinline__ unsigned q8quad(unsigned w0, unsigned w1, float inv) { return q8x4(bflo(w0), bfhi(w0), bflo(w1), bfhi(w1), inv); }
template <int MODE> __device__ __forceinline__ void p0_strips(Frame& F) {
    LAS unsigned char* strip = F.lds + RING_OFF;
    LAS unsigned* mxl = (LAS unsigned*)(F.lds + XTRA_OFF);
    const int lane = LANE_ID(); int tid = F.wave * 64 + lane;
    unsigned* ctr = F.ctl + 24;
    LAS unsigned* slot = (LAS unsigned*)(F.lds + XTRA_OFF + 256);
    if (tid < 64) mxl[tid] = 0u;
    if (tid == 0) { slot[0] = __hip_atomic_fetch_add(ctr, 1u, __ATOMIC_RELAXED, __HIP_MEMORY_SCOPE_AGENT); slot[1] = __hip_atomic_fetch_add(ctr, 1u, __ATOMIC_RELAXED, __HIP_MEMORY_SCOPE_AGENT); }
    __syncthreads();
    int s = __builtin_amdgcn_readfirstlane((int)slot[0]), sn = __builtin_amdgcn_readfirstlane((int)slot[1]);
    __syncthreads();
    SItem t; f32x4 va[16], vb[16]; f32x2 ga[4], gb[4];
    bool has = sitem_decode(F, s, t);
    if (has) { sbatch_load(t, 0, va, ga, tid); sbatch_load(t, 1, vb, gb, tid); }
    int par = 0;
    while (has) {
        float mx[8] = {0.f, 0.f, 0.f, 0.f, 0.f, 0.f, 0.f, 0.f};
        v4u held[16];
        asm volatile("" : "+v"(tid));
        unsigned pend = 0u;
        if (tid == 0) pend = __hip_atomic_fetch_add(ctr, 1u, __ATOMIC_RELAXED, __HIP_MEMORY_SCOPE_AGENT);
        sbatch_park(0, va, ga, t.gflag, strip, held, mx, tid); sbatch_load(t, 2, va, ga, tid); asm volatile("" ::: "memory");
        sbatch_park(1, vb, gb, t.gflag, strip, held, mx, tid); sbatch_load(t, 3, vb, gb, tid); asm volatile("" ::: "memory");
        SItem tn; const bool hn = sitem_decode(F, sn, tn);
        sbatch_park(2, va, ga, t.gflag, strip, held, mx, tid); if (hn) sbatch_load(tn, 0, va, ga, tid); asm volatile("" ::: "memory");
        sbatch_park(3, vb, gb, t.gflag, strip, held, mx, tid); if (hn) sbatch_load(tn, 1, vb, gb, tid); asm volatile("" ::: "memory");
#pragma unroll
        for (int j = 0; j < 8; ++j) { float m = mx[j]; m = fmaxf(m, __shfl_xor(m, 4)); m = fmaxf(m, __shfl_xor(m, 8)); m = fmaxf(m, __shfl_xor(m, 16)); m = fmaxf(m, __shfl_xor(m, 32));
            if ((lane >> 2) == 0) __hip_atomic_fetch_max((unsigned*)(mxl + par * 32 + (j >> 2) * 16 + 4 * (lane & 3) + (j & 3)), __builtin_bit_cast(unsigned, m), __ATOMIC_RELAXED, __HIP_MEMORY_SCOPE_WORKGROUP); }
        if (tid == 0) slot[0] = pend;
        __syncthreads();
        const int snn = __builtin_amdgcn_readfirstlane((int)slot[0]);
        if (tid < 32) mxl[(par ^ 1) * 32 + tid] = 0u;
        asm volatile("" : "+v"(tid));
#pragma unroll 4
        for (int r = 0; r < (MODE == 0 ? 16 : 0); ++r) {
            const float am = __builtin_bit_cast(float, mxl[par * 32 + r]), inv = am > 0.f ? 127.0f / am : 0.f;
            const v4u w = *(const LAS v4u*)(strip + r * STRIP_RS + tid * 16);
            v2u o; o.x = q8quad(w.x, w.y, inv); o.y = q8quad(w.z, w.w, inv);
            const int nn = t.n0 + 8 * (r >> 2) + (r & 3), drow = t.mapup ? MapUp()(nn) : nn;
            *(v2u*)(t.dst + (size_t)drow * DM + 8 * tid) = o;
            if (tid == 0) t.sw[drow] = am * (1.0f / 127.0f);
        }
        __syncthreads();
        asm volatile("" : "+v"(tid));
        if (MODE == 0) {
            const int q = tid & 3, rr = tid >> 2;
            float inv[4];
#pragma unroll
            for (int j = 0; j < 4; ++j) { const float am = __builtin_bit_cast(float, mxl[par * 32 + 16 + 4 * q + j]); inv[j] = am > 0.f ? 127.0f / am : 0.f; }
#pragma unroll
            for (int hp = 0; hp < 16; ++hp) { const int k = hp * 256 + 2 * rr;
                *(LAS unsigned short*)(strip + (4 * q + 0) * STRIP_RS8 + k) = (unsigned short)q8pair(held[hp].x, inv[0]);
                *(LAS unsigned short*)(strip + (4 * q + 1) * STRIP_RS8 + k) = (unsigned short)q8pair(held[hp].y, inv[1]);
                *(LAS unsigned short*)(strip + (4 * q + 2) * STRIP_RS8 + k) = (unsigned short)q8pair(held[hp].z, inv[2]);
                *(LAS unsigned short*)(strip + (4 * q + 3) * STRIP_RS8 + k) = (unsigned short)q8pair(held[hp].w, inv[3]); }
        }
        __syncthreads();
        asm volatile("" : "+v"(tid));
#pragma unroll 4
        for (int ps = 0; ps < (MODE == 0 ? 8 : 0); ++ps) { const int r = 2 * ps + (tid >> 8), tt = tid & 255;
            const v4u w = *(const LAS v4u*)(strip + r * STRIP_RS8 + tt * 16);
            const int nn = t.n0 + 8 * (r >> 2) + 4 + (r & 3), drow = t.mapup ? MapUp()(nn) : nn;
            *(v4u*)(t.dst + (size_t)drow * DM + 16 * tt) = w;
            if (tt == 0) t.sw[drow] = __builtin_bit_cast(float, mxl[par * 32 + 16 + r]) * (1.0f / 127.0f);
        }
        __syncthreads();
        t = tn; has = hn; s = sn; sn = snn; par ^= 1;
    }
}
__device__ __forceinline__ void p0_prologue(Frame& F) {
    LAS float* scr = (LAS float*)(F.lds + RING_OFF + F.wave * 16640);
    {
        const int lane = LANE_ID();
        TItem ta, tb; f32x4 va[16], vb[16];
#ifdef PROBE_TR2
        for (int rep = 0; rep < PROBE_TR2; ++rep) {
#else
        {
#endif
        int it = F.gw;
        bool ha = titem_decode(F, it, ta);
        if (ha) titem_load(ta, va, lane);
        while (ha) {
            const bool hb = titem_decode(F, it + F.NGW, tb);
            if (hb) titem_load(tb, vb, lane);
            titem_process(ta, va, scr, lane);
            if (!hb) break;
            it += 2 * F.NGW;
            ha = titem_decode(F, it, ta);
            if (ha) titem_load(ta, va, lane);
            titem_process(tb, vb, scr, lane);
        }
        }
    }
    quant_act_rows(F, F.x, (signed char*)(F.ws + WS_HQ8), (float*)(F.ws + WS_SAH), (float*)(F.ws + WS_SSQ));
    float* rc = (float*)(F.ws + WS_ROPE); float* rs = rc + MR * 16;
    for (int idx = F.gw * 64 + LANE_ID(); idx < MR * 16; idx += F.NGW * 64) {
        const int r = idx >> 4, i = idx & 15;
        double invd = 1.0;
        for (int k = 0; k < i; ++k) invd *= 0.44036660267178046;
        const float inv = (float)invd;
        const float ang = (float)F.pos[r] * inv;
        double sn, cs; sincos_d((double)ang, sn, cs);
        rc[idx] = (float)cs; rs[idx] = (float)sn;
    }
}

__device__ __forceinline__ void p_kmean(Frame& F) {
    const bf16* QKV = (const bf16*)(F.ws + WS_QKV); float* KM = (float*)(F.ws + WS_KMEAN);
    LAS float* red = (LAS float*)(F.lds + RING_OFF);
    for (int item = blockIdx.x; item < NB * NHA * 16; item += F.G) {
        const int j = item & 15, bh = item >> 4, b = bh / NHA, h = bh - b * NHA;
        const bf16* kb = QKV + ((size_t)((1 * 2 + b) * NHQ + h) * NS + 256 * j) * HD;
        const int d = (F.wave * 64 + LANE_ID()) & 127, part = (F.wave * 64 + LANE_ID()) >> 7;
        float s = 0.f;
        for (int i = 0; i < 64; ++i) s += bf1(kb[(size_t)(part * 64 + i) * HD + d]);
        red[part * 128 + d] = s;
        __syncthreads();
        if ((F.wave * 64 + LANE_ID()) < 128) KM[(size_t)item * 128 + (F.wave * 64 + LANE_ID())] = (red[(F.wave * 64 + LANE_ID())] + red[128 + (F.wave * 64 + LANE_ID())] + red[256 + (F.wave * 64 + LANE_ID())] + red[384 + (F.wave * 64 + LANE_ID())]) * (1.0f / 256.0f);
        __syncthreads();
    }
}

__device__ __forceinline__ float dot128(const LAS float* qs, const bf16* krow) {
    float s = 0.f;
#pragma unroll 4
    for (int c = 0; c < 16; ++c) {
        const v4u kv = *(const v4u*)(krow + 8 * c); const LAS float* q8 = qs + 8 * c;
        s += q8[0] * bflo(kv.x) + q8[1] * bfhi(kv.x) + q8[2] * bflo(kv.y) + q8[3] * bfhi(kv.y) + q8[4] * bflo(kv.z) + q8[5] * bfhi(kv.z) + q8[6] * bflo(kv.w) + q8[7] * bfhi(kv.w);
    }
    return s;
}
__device__ __forceinline__ void p_attn_naive(Frame& F, bf16* O) {
    const bf16* QKV = (const bf16*)(F.ws + WS_QKV); const float* KM = (const float*)(F.ws + WS_KMEAN);
    LAS float* qs = (LAS float*)(F.lds + RING_OFF + F.wave * 8192);
    LAS float* ps = qs + 128;
    const int lane = LANE_ID();
    constexpr int NMOBA = NB * NHA * NS, NDIL = NB * 8 * NS;
    const float NEG = -__builtin_inff();
    for (int task = F.gw; task < NMOBA + NDIL; task += F.NGW) {
        if (task < NMOBA) {
            const int b = task / (NHA * NS), rem = task - b * (NHA * NS), h = rem >> 12, t = rem & 4095;
            const bf16* qrow = QKV + ((size_t)((0 * 2 + b) * NHQ + h) * NS + t) * HD;
            const bf16* Kb = QKV + (size_t)((1 * 2 + b) * NHQ + h) * NS * HD;
            const bf16* Vb = QKV + (size_t)((2 * 2 + b) * NHQ + h) * NS * HD;
            { const unsigned w = *(const unsigned*)(qrow + 2 * lane); qs[2 * lane] = bflo(w); qs[2 * lane + 1] = bfhi(w); }
            LDS_WAIT(); asm volatile("" ::: "memory");
            const int qb = t >> 8, tin = t & 255;
            float g = NEG;
            if (lane < qb) { const float* km = KM + ((size_t)((b * NHA + h) * 16 + lane)) * 128; float s = 0.f; for (int d = 0; d < 128; ++d) s += qs[d] * km[d]; g = s; }
            unsigned selmask = 0u;
            if (qb <= 3) selmask = (1u << qb) - 1u;
            else {
#pragma unroll
                for (int rd = 0; rd < 3; ++rd) {
                    float best = g; int bi = lane;
#pragma unroll
                    for (int o = 1; o < 64; o <<= 1) { const float ob = __shfl_xor(best, o); const int oi = __shfl_xor(bi, o); if (ob > best || (ob == best && oi < bi)) { best = ob; bi = oi; } }
                    selmask |= 1u << bi; if (lane == bi) g = NEG;
                }
            }
            float sc[4][4]; int jsel[3];
            unsigned mk = selmask;
#pragma unroll
            for (int sl = 0; sl < 3; ++sl) {
                int j = -1; if (mk) { j = __builtin_ctz(mk); mk &= mk - 1u; }
                jsel[sl] = j;
#pragma unroll
                for (int c = 0; c < 4; ++c) sc[sl][c] = (j >= 0) ? ATT_SCALE * dot128(qs, Kb + (size_t)(256 * j + lane + 64 * c) * HD) : NEG;
            }
#pragma unroll
            for (int c = 0; c < 4; ++c) { const int i = lane + 64 * c; sc[3][c] = (i <= tin) ? ATT_SCALE * dot128(qs, Kb + (size_t)(256 * qb + i) * HD) : NEG; }
            float mx = NEG;
#pragma unroll
            for (int sl = 0; sl < 4; ++sl)
#pragma unroll
                for (int c = 0; c < 4; ++c) mx = fmaxf(mx, sc[sl][c]);
            mx = wave_max(mx);
            float sum = 0.f;
#pragma unroll
            for (int sl = 0; sl < 4; ++sl)
#pragma unroll
                for (int c = 0; c < 4; ++c) { sc[sl][c] = __expf(sc[sl][c] - mx); sum += sc[sl][c]; }
            sum = wave_sum(sum);
            const float inv = 1.0f / sum;
#pragma unroll
            for (int sl = 0; sl < 4; ++sl)
#pragma unroll
                for (int c = 0; c < 4; ++c) ps[sl * 256 + lane + 64 * c] = sc[sl][c] * inv;
            LDS_WAIT(); asm volatile("" ::: "memory");
            float o0 = 0.f, o1 = 0.f;
#pragma unroll
            for (int sl = 0; sl < 3; ++sl) {
                if (jsel[sl] >= 0) { const bf16* vb = Vb + (size_t)(256 * jsel[sl]) * HD + 2 * lane;
                    for (int i = 0; i < 256; ++i) { const float p = ps[sl * 256 + i]; const unsigned w = *(const unsigned*)(vb + (size_t)i * HD); o0 += p * bflo(w); o1 += p * bfhi(w); } }
            }
            { const bf16* vb = Vb + (size_t)(256 * qb) * HD + 2 * lane;
              for (int i = 0; i <= tin; ++i) { const float p = ps[3 * 256 + i]; const unsigned w = *(const unsigned*)(vb + (size_t)i * HD); o0 += p * bflo(w); o1 += p * bfhi(w); } }
            *(unsigned*)(O + (size_t)(b * NS + t) * DM + h * HD + 2 * lane) = pk2(o0, o1);
            LDS_WAIT(); asm volatile("" ::: "memory");
        } else {
            const int td = task - NMOBA, b = td / (8 * NS), rem = td - b * (8 * NS), hh = rem >> 12, t = rem & 4095;
            float lse[3], og0[3], og1[3];
#pragma unroll
            for (int g = 0; g < 3; ++g) {
                const int head = NHA + g * 8 + hh, dil = g == 0 ? 1 : (g == 1 ? 4 : 16);
                const bf16* qrow = QKV + ((size_t)((0 * 2 + b) * NHQ + head) * NS + t) * HD;
                const bf16* Kb = QKV + (size_t)((1 * 2 + b) * NHQ + head) * NS * HD;
                const bf16* Vb = QKV + (size_t)((2 * 2 + b) * NHQ + head) * NS * HD;
                { const unsigned w = *(const unsigned*)(qrow + 2 * lane); qs[2 * lane] = bflo(w); qs[2 * lane + 1] = bfhi(w); }
                LDS_WAIT(); asm volatile("" ::: "memory");
                float sc[3];
#pragma unroll
                for (int c = 0; c < 3; ++c) { const int m = lane + 64 * c; const int kp = t - m * dil; sc[c] = (m <= 128 && kp >= 0) ? ATT_SCALE * dot128(qs, Kb + (size_t)kp * HD) : NEG; }
                float mx = wave_max(fmaxf(fmaxf(sc[0], sc[1]), sc[2]));
                float e0 = __expf(sc[0] - mx), e1 = __expf(sc[1] - mx), e2 = __expf(sc[2] - mx);
                const float sum = wave_sum(e0 + e1 + e2), inv = 1.0f / sum;
                lse[g] = mx + __logf(sum);
                ps[lane] = e0 * inv; ps[lane + 64] = e1 * inv; if (lane == 0) ps[128] = e2 * inv;
                LDS_WAIT(); asm volatile("" ::: "memory");
                const int nb = t / dil, nk = (nb < 128 ? nb : 128) + 1;
                float o0 = 0.f, o1 = 0.f;
                for (int m = 0; m < nk; ++m) { const float p = ps[m]; const unsigned w = *(const unsigned*)(Vb + (size_t)(t - m * dil) * HD + 2 * lane); o0 += p * bflo(w); o1 += p * bfhi(w); }
                og0[g] = o0; og1[g] = o1;
                LDS_WAIT(); asm volatile("" ::: "memory");
            }
            const float ml = fmaxf(fmaxf(lse[0], lse[1]), lse[2]);
            const float w0 = __expf(lse[0] - ml), w1 = __expf(lse[1] - ml), w2 = __expf(lse[2] - ml), wi = 1.0f / (w0 + w1 + w2);
            const float r0 = (w0 * og0[0] + w1 * og0[1] + w2 * og0[2]) * wi, r1 = (w0 * og1[0] + w1 * og1[1] + w2 * og1[2]) * wi;
            *(unsigned*)(O + (size_t)(b * NS + t) * DM + (NHA + hh) * HD + 2 * lane) = pk2(r0, r1);
        }
    }
}

__device__ __forceinline__ float silu_f(float x) { return x / (1.0f + __expf(-x)); }
__device__ __forceinline__ void p_conv(Frame& F, int layer) {
    const bf16* AP = (const bf16*)(F.ws + WS_APRE); bf16* Gb = (bf16*)(F.ws + WS_G);
    const float* cw = F.ffn_conv_w + (size_t)layer * 3 * F2; const float* cb = F.ffn_conv_b + (size_t)layer * F2;
    constexpr int C8 = DFF / 8;
    const size_t total = (size_t)MR * C8;
    for (size_t idx = (size_t)blockIdx.x * 512 + (F.wave * 64 + LANE_ID()); idx < total; idx += (size_t)F.G * 512) {
        const int r = (int)(idx / C8), j0 = (int)(idx - (size_t)r * C8) * 8, s = r & 4095;
        float cg[8], cu[8];
#pragma unroll
        for (int e = 0; e < 8; ++e) { cg[e] = cb[j0 + e]; cu[e] = cb[DFF + j0 + e]; }
#pragma unroll
        for (int tp = 0; tp < 3; ++tp) {
            const int back = 2 - tp;
            if (s >= back) {
                float ag[8], au[8];
                unpack8(*(const v4u*)(AP + (size_t)(r - back) * F2 + j0), ag);
                unpack8(*(const v4u*)(AP + (size_t)(r - back) * F2 + DFF + j0), au);
#pragma unroll
                for (int e = 0; e < 8; ++e) { cg[e] += cw[(size_t)tp * F2 + j0 + e] * ag[e]; cu[e] += cw[(size_t)tp * F2 + DFF + j0 + e] * au[e]; }
            }
        }
        v4u o; o.x = pk2(silu_f(cg[0]) * cu[0], silu_f(cg[1]) * cu[1]); o.y = pk2(silu_f(cg[2]) * cu[2], silu_f(cg[3]) * cu[3]);
        o.z = pk2(silu_f(cg[4]) * cu[4], silu_f(cg[5]) * cu[5]); o.w = pk2(silu_f(cg[6]) * cu[6], silu_f(cg[7]) * cu[7]);
        *(v4u*)(Gb + (size_t)r * DFF + j0) = o;
    }
}

__device__ __forceinline__ void p_sgate_naive(Frame& F) {
    const bf16* U = (const bf16*)(F.ws + WS_U); const bf16* V = (const bf16*)(F.ws + WS_V); const float* VS = (const float*)(F.ws + WS_VSQ); bf16* GT = (bf16*)(F.ws + WS_O);
    LAS float* vn = (LAS float*)(F.lds + RING_OFF);
    LAS float* wsl = vn + 128 * 128;
    LAS float* rstat = (LAS float*)(F.lds + XTRA_OFF);
    for (int item = blockIdx.x; item < 64 * 32; item += F.G) {
        const int bc = item >> 5, g = item & 31, r0 = bc * 128;
        if ((F.wave * 64 + LANE_ID()) < 128) {
            const float s1 = VS[2 * (r0 + (F.wave * 64 + LANE_ID()))], s2 = VS[2 * (r0 + (F.wave * 64 + LANE_ID())) + 1];
            const float mean = s1 * (1.0f / 4096.0f), var = s2 * (1.0f / 4096.0f) - mean * mean;
            rstat[2 * (F.wave * 64 + LANE_ID())] = mean; rstat[2 * (F.wave * 64 + LANE_ID()) + 1] = 1.0f / sqrtf(var + NORM_EPS);
        }
        __syncthreads();
        for (int idx = (F.wave * 64 + LANE_ID()); idx < 128 * 128; idx += 512) {
            const int s = idx >> 7, d = idx & 127, col = g * 128 + d;
            const float v = bf1(V[(size_t)(r0 + s) * DM + col]);
            vn[idx] = (v - rstat[2 * s]) * rstat[2 * s + 1] * F.sg_v_gain[col] + F.sg_v_bias[col];
            wsl[idx] = F.sg_w_s[(size_t)g * 16384 + idx];
        }
        __syncthreads();
        for (int idx = (F.wave * 64 + LANE_ID()); idx < 128 * 128; idx += 512) {
            const int t = idx >> 7, d = idx & 127;
            float a = 0.f;
            for (int s = 0; s <= t; ++s) a += wsl[t * 128 + s] * vn[s * 128 + d];
            const float f = a + F.sg_b_s[g * 128 + t];
            const size_t o = (size_t)(r0 + t) * DM + g * 128 + d;
            GT[o] = (bf16)f2bf(bf1(U[o]) * f);
        }
        __syncthreads();
    }
}

__device__ __forceinline__ void pf_store(Frame& F, int m, const v4u (&v)[8]) {
    const f32x4* gr = (const f32x4*)F.final_norm + 2 * LANE_ID(); f32x4* orow = (f32x4*)(F.out + (size_t)m * DM) + 2 * LANE_ID();
    float sq = 0.f;
#pragma unroll
    for (int i = 0; i < 8; ++i) { float f[8]; unpack8(v[i], f);
#pragma unroll
        for (int e = 0; e < 8; ++e) sq += f[e] * f[e]; }
    sq = wave_sum(sq);
    float rs = 1.0f / sqrtf(sq * (1.0f / 4096.0f) + NORM_EPS);
#ifdef CHECK_ATTN
    if (__hip_atomic_load(F.ctl + 8, __ATOMIC_RELAXED, __HIP_MEMORY_SCOPE_AGENT) > CHECK_ATTN) rs = __builtin_nanf("");
#endif
#pragma unroll
    for (int i = 0; i < 8; ++i) { float f[8]; unpack8(v[i], f);
        orow[128 * i] = (f32x4){f[0], f[1], f[2], f[3]} * rs * gr[128 * i]; orow[128 * i + 1] = (f32x4){f[4], f[5], f[6], f[7]} * rs * gr[128 * i + 1]; }
}
__device__ __forceinline__ void p_final(Frame& F) {
    const bf16* H = (const bf16*)(F.ws + WS_XB);
    v4u a[8], b[8];
    int m = F.gw;
    if (m < MR) qw_load(H, m, a);
    while (m < MR) {
        const int m2 = m + F.NGW;
        if (m2 < MR) qw_load(H, m2, b);
        pf_store(F, m, a);
        if (m2 >= MR) break;
        m = m2 + F.NGW;
        if (m < MR) qw_load(H, m, a);
        pf_store(F, m2, b);
    }
}

__device__ __forceinline__ void quant_bf16_rows(Frame& F, const bf16* src, signed char* dst, float* scale) {
    for (int m = F.gw; m < MR; m += F.NGW) {
        const v4u* s = (const v4u*)(src + (size_t)m * DM) + LANE_ID(); v2u* d = (v2u*)(dst + (size_t)m * DM) + LANE_ID();
        v4u v[8]; float am = 0.f;
#pragma unroll
        for (int i = 0; i < 8; ++i) { v[i] = s[64 * i]; float f[8]; unpack8(v[i], f);
#pragma unroll
            for (int e = 0; e < 8; ++e) am = fmaxf(am, fabsf(f[e])); }
        am = wave_max(am);
        const float inv = am > 0.f ? 127.0f / am : 0.f;
        if (LANE_ID() == 0) scale[m] = am * (1.0f / 127.0f);
#pragma unroll
        for (int i = 0; i < 8; ++i) { float f[8]; unpack8(v[i], f);
            v2u o; o.x = q8(f[0], inv) | (q8(f[1], inv) << 8) | (q8(f[2], inv) << 16) | (q8(f[3], inv) << 24); o.y = q8(f[4], inv) | (q8(f[5], inv) << 8) | (q8(f[6], inv) << 16) | (q8(f[7], inv) << 24);
            d[64 * i] = o; }
    }
}
__device__ __forceinline__ unsigned moba_select(const LAS float* km, const bf16* qrow, int qb) {
    const float NEG = -__builtin_inff();
    if (qb <= 3) return (1u << qb) - 1u;
    float g[16];
#pragma unroll
    for (int j = 0; j < 16; ++j) g[j] = 0.f;
#pragma unroll 1
    for (int c = 0; c < 16; ++c) {
        float q8[8]; unpack8(*(const v4u*)(qrow + 8 * c), q8);
#pragma unroll
        for (int j = 0; j < 16; ++j) {
            const f32x4 k0 = *(const LAS f32x4*)(km + j * 128 + 8 * c), k1 = *(const LAS f32x4*)(km + j * 128 + 8 * c + 4);
            g[j] += q8[0] * k0[0] + q8[1] * k0[1] + q8[2] * k0[2] + q8[3] * k0[3] + q8[4] * k1[0] + q8[5] * k1[1] + q8[6] * k1[2] + q8[7] * k1[3];
        }
    }
#pragma unroll
    for (int j = 0; j < 16; ++j) if (j >= qb) g[j] = NEG;
    unsigned sel = 0u;
#pragma unroll
    for (int rd = 0; rd < 3; ++rd) {
        float best = NEG; unsigned bi = 0u;
#pragma unroll
        for (int j = 0; j < 16; ++j) { const bool take = (((sel >> j) & 1u) == 0u) && (g[j] > best); best = take ? g[j] : best; bi = take ? (unsigned)j : bi; }
        sel |= 1u << bi;
    }
    return sel;
}

typedef att::BlockRef<bf16, bf16> ABR;
#ifndef DIL_SK
#define DIL_SK false
#endif
constexpr int ATT_SEL_OFF = 69632, ATT_KM_OFF = 73728;
__device__ __forceinline__ void moba_unit(int vc, int i, int& bh, int& qb) {
    const int grp = vc >> 4, a = vc & 15;
    const unsigned long long PB = 0x24310cbfed5a9687ull, PC = 0x6579b13024c8aedfull;
    qb = i == 0 ? a : (i == 1 ? (int)((PB >> (4 * a)) & 15ull) : (int)((PC >> (4 * a)) & 15ull));
    bh = 3 * grp + i;
}
__device__ __forceinline__ ABR moba_ref(const Frame& F, int vc, int i, const LAS unsigned short* selL) {
    int bh, qb; moba_unit(vc, i, bh, qb);
    const int b = bh / NHA, h = bh - NHA * b;
    const bf16* QKV = (const bf16*)(F.ws + WS_QKV);
    ABR r;
    r.Q = QKV + ((size_t)((0 * 2 + b) * NHQ + h) * NS + 256 * qb) * HD;
    r.K = QKV + (size_t)((1 * 2 + b) * NHQ + h) * NS * HD;
    r.V = QKV + (size_t)((2 * 2 + b) * NHQ + h) * NS * HD;
    r.O = (bf16*)(F.ws + WS_O) + (size_t)(b * NS + 256 * qb) * DM + h * HD;
    r.P0 = 256 * qb;
    r.sel = selL + 256 * i; r.L = nullptr;
    return r;
}
__device__ __forceinline__ ABR dil_ref(const Frame& F, int vc, int g) {
    const int bhh = vc >> 4, b = bhh >> 3, hh = bhh & 7, lo = vc & 15;
    const int dil = g == 0 ? 1 : (g == 1 ? 4 : 16);
    const int res = g == 0 ? 0 : (g == 1 ? (lo >> 2) : lo), blk = g == 0 ? lo : (g == 1 ? (lo & 3) : 0);
    const int head = NHA + 8 * g + hh, pos0 = res + dil * 256 * blk;
    const bf16* QKV = (const bf16*)(F.ws + WS_QKV);
    ABR r;
    r.Q = QKV + ((size_t)((0 * 2 + b) * NHQ + head) * NS + pos0) * HD;
    r.K = QKV + ((size_t)((1 * 2 + b) * NHQ + head) * NS + res) * HD;
    r.V = QKV + ((size_t)((2 * 2 + b) * NHQ + head) * NS + res) * HD;
    r.O = (bf16*)(F.ws + WS_DO) + (size_t)(b * NS + pos0) * 3072 + g * 1024 + hh * HD;
    r.P0 = 256 * blk;
    r.sel = nullptr; r.L = (float*)(F.ws + WS_LSE) + (size_t)(b * NS + pos0) * 24 + g * 8 + hh;
    return r;
}
__device__ __forceinline__ void p_attn(Frame& F, char* lds) {
#define ATT_VC(bx) ((F.G % 8 == 0 && F.G == 256) ? (((bx) & 7) * 32 + ((bx) >> 3)) : (bx))
    for (int vb = blockIdx.x; vb < 256; vb += F.G) { const int vc = ATT_VC(vb);
#ifndef NO_MOBA
        {
            const bf16* QKVq = (const bf16*)(F.ws + WS_QKV); const float* KM = (const float*)(F.ws + WS_KMEAN);
            LAS float* kmL = (LAS float*)(F.lds + RING_OFF + ATT_KM_OFF); LAS unsigned short* selW = (LAS unsigned short*)(F.lds + RING_OFF + ATT_SEL_OFF);
            const LAS unsigned short* selL = selW;
#ifndef NO_GATEPRE
            for (int idx = (F.wave * 64 + LANE_ID()); idx < 3 * 2048; idx += 512) { int bh, qb; moba_unit(vc, idx >> 11, bh, qb); kmL[idx] = KM[(size_t)bh * 2048 + (idx & 2047)]; }
            __syncthreads();
            for (int qi = (F.wave * 64 + LANE_ID()); qi < 768; qi += 512) { int bh, qb; moba_unit(vc, qi >> 8, bh, qb); const int b = bh / NHA, h = bh - NHA * b;
                selW[qi] = (unsigned short)moba_select(kmL + (qi >> 8) * 2048, QKVq + ((size_t)((0 * 2 + b) * NHQ + h) * NS + 256 * qb + (qi & 255)) * HD, qb); }
            __syncthreads();
#endif
            asm volatile("" ::: "memory");
            int vcb = vc; asm volatile("" : "+s"(vcb));
            att::Seam<bf16> S;
            constexpr int WM = 1 << 30;
            ABR cur = moba_ref(F, vcb, 0, selL);
            att::causal_swa_prime<bf16, bf16, 128, WM>(cur, lds, S);
            for (int i = 0; i < 3; ++i) {
                const ABR nxt = moba_ref(F, vcb, i < 2 ? i + 1 : 2, selL);
                att::causal_swa_block<bf16, bf16, false, 0, 128, 128, DM, WM, WM, NS>(cur, nxt, lds, S);
                cur = nxt;
            }
        }
#endif
    }
    for (int vb = blockIdx.x; vb < 256; vb += F.G) { const int vc = ATT_VC(vb);
#ifndef NO_DIL
        {
            att::Seam<bf16> S;
            const ABR r0 = dil_ref(F, vc, 0), r1 = dil_ref(F, vc, 1), r2 = dil_ref(F, vc, 2);
            att::causal_swa_prime<bf16, bf16, 128, 129>(r0, lds, S);
            att::causal_swa_block<bf16, bf16, DIL_SK, 1, 128, 512, 3072, 129, 129, NS>(r0, r1, lds, S);
            att::causal_swa_block<bf16, bf16, DIL_SK, 1, 512, 2048, 4 * 3072, 129, 129, NS / 4>(r1, r2, lds, S);
            att::causal_swa_block<bf16, bf16, DIL_SK, 1, 2048, 2048, 16 * 3072, 129, 129, NS / 16>(r2, r2, lds, S);
        }
#endif
    }
}
__device__ __forceinline__ void p_dilmerge(Frame& F) {
    const bf16* DO = (const bf16*)(F.ws + WS_DO); const float* LSE = (const float*)(F.ws + WS_LSE); const bf16* O = (const bf16*)(F.ws + WS_O);
    signed char* OQ = (signed char*)(F.ws + WS_OQ8); float* SAO = (float*)(F.ws + WS_SAO);
    const int lane = LANE_ID();
    for (int r = F.gw; r < MR; r += F.NGW) {
        float v[64];
        if (lane < 48) {
#pragma unroll
            for (int i = 0; i < 8; ++i) { float f[8]; unpack8(*(const v4u*)(O + (size_t)r * DM + 64 * lane + 8 * i), f);
#pragma unroll
                for (int e = 0; e < 8; ++e) v[8 * i + e] = f[e]; }
        } else {
            const int hh = (lane - 48) >> 1, c0 = ((lane - 48) & 1) * 64;
            const float l0 = LSE[(size_t)r * 24 + hh], l1 = LSE[(size_t)r * 24 + 8 + hh], l2 = LSE[(size_t)r * 24 + 16 + hh];
            const float ml = fmaxf(fmaxf(l0, l1), l2);
            float w0 = __expf(l0 - ml), w1 = __expf(l1 - ml), w2 = __expf(l2 - ml); const float wi = 1.0f / (w0 + w1 + w2); w0 *= wi; w1 *= wi; w2 *= wi;
            const bf16* d0 = DO + (size_t)r * 3072 + hh * HD + c0;
#pragma unroll
            for (int i = 0; i < 8; ++i) { float a0[8], a1[8], a2[8]; unpack8(*(const v4u*)(d0 + 8 * i), a0); unpack8(*(const v4u*)(d0 + 1024 + 8 * i), a1); unpack8(*(const v4u*)(d0 + 2048 + 8 * i), a2);
#pragma unroll
                for (int e = 0; e < 8; ++e) v[8 * i + e] = w0 * a0[e] + w1 * a1[e] + w2 * a2[e]; }
        }
        float am = 0.f;
#pragma unroll
        for (int i = 0; i < 64; ++i) am = fmaxf(am, fabsf(v[i]));
        am = wave_max(am);
        const float inv = am > 0.f ? 127.0f / am : 0.f;
        if (lane == 0) SAO[r] = am * (1.0f / 127.0f);
        v4u* d = (v4u*)(OQ + (size_t)r * DM + 64 * lane);
#pragma unroll
        for (int i = 0; i < 4; ++i) { v4u o;
            o.x = q8(v[16 * i + 0], inv) | (q8(v[16 * i + 1], inv) << 8) | (q8(v[16 * i + 2], inv) << 16) | (q8(v[16 * i + 3], inv) << 24);
            o.y = q8(v[16 * i + 4], inv) | (q8(v[16 * i + 5], inv) << 8) | (q8(v[16 * i + 6], inv) << 16) | (q8(v[16 * i + 7], inv) << 24);
            o.z = q8(v[16 * i + 8], inv) | (q8(v[16 * i + 9], inv) << 8) | (q8(v[16 * i + 10], inv) << 16) | (q8(v[16 * i + 11], inv) << 24);
            o.w = q8(v[16 * i + 12], inv) | (q8(v[16 * i + 13], inv) << 8) | (q8(v[16 * i + 14], inv) << 16) | (q8(v[16 * i + 15], inv) << 24);
            d[i] = o; }
    }
}
__device__ __forceinline__ void p_convfix(Frame& F, int layer) {
    const float* top = (const float*)(F.ws + WS_TOP); const float* bot = (const float*)(F.ws + WS_BOT); bf16* Gb = (bf16*)(F.ws + WS_G);
    const float* cw = F.ffn_conv_w + (size_t)layer * 3 * F2; const float* cb = F.ffn_conv_b + (size_t)layer * F2;
    constexpr int C4 = DFF / 4, NIT = 30 * C4;
    for (int idx = blockIdx.x * 512 + (F.wave * 64 + LANE_ID()); idx < NIT; idx += F.G * 512) {
        const int pmi = idx / C4, j0 = (idx - pmi * C4) * 4, pm = pmi + 1 + (pmi >= 15 ? 1 : 0);
        f32x4 c0[2], c1[2];
#pragma unroll
        for (int bj = 0; bj < 2; ++bj) {
            const int col = bj * DFF + j0;
            const f32x4 w0 = *(const f32x4*)(cw + col), w1 = *(const f32x4*)(cw + F2 + col), w2 = *(const f32x4*)(cw + 2 * F2 + col), bb = *(const f32x4*)(cb + col);
            const f32x4 am2 = *(const f32x4*)(bot + (size_t)((pm - 1) * 2 + 0) * F2 + col), am1 = *(const f32x4*)(bot + (size_t)((pm - 1) * 2 + 1) * F2 + col);
            const f32x4 a0 = *(const f32x4*)(top + (size_t)(pm * 2 + 0) * F2 + col), a1 = *(const f32x4*)(top + (size_t)(pm * 2 + 1) * F2 + col);
            c0[bj] = bb + w0 * am2 + w1 * am1 + w2 * a0;
            c1[bj] = bb + w0 * am1 + w1 * a0 + w2 * a1;
        }
        v2u o0, o1;
        o0.x = pk2(silu_f(c0[0][0]) * c0[1][0], silu_f(c0[0][1]) * c0[1][1]); o0.y = pk2(silu_f(c0[0][2]) * c0[1][2], silu_f(c0[0][3]) * c0[1][3]);
        o1.x = pk2(silu_f(c1[0][0]) * c1[1][0], silu_f(c1[0][1]) * c1[1][1]); o1.y = pk2(silu_f(c1[0][2]) * c1[1][2], silu_f(c1[0][3]) * c1[1][3]);
        *(v2u*)(Gb + (size_t)(pm * 256) * DFF + j0) = o0;
        *(v2u*)(Gb + (size_t)(pm * 256 + 1) * DFF + j0) = o1;
    }
}

__device__ __forceinline__ void sg_prefetch(const Frame& F, int item, v4u (&v)[4], v4u (&u)[4], unsigned long long (&st)[2]) {
    const bf16* U = (const bf16*)(F.ws + WS_U); const bf16* V = (const bf16*)(F.ws + WS_V); const unsigned long long* VS = (const unsigned long long*)(F.ws + WS_VSX);
    const int tid = F.wave * 64 + LANE_ID(), g = item & 31, r0 = (item >> 5) * 128, d8 = (tid & 15) * 8;
#pragma unroll
    for (int k = 0; k < 4; ++k) { const size_t o = (size_t)(r0 + (tid >> 4) + 32 * k) * DM + g * 128 + d8; v[k] = *(const v4u*)(V + o); u[k] = *(const v4u*)(U + o); }
    st[0] = 0ull; st[1] = 0ull;
    if (tid < 128) { st[0] = VS[2 * (size_t)(r0 + tid)]; st[1] = VS[2 * (size_t)(r0 + tid) + 1]; }
}
__device__ __forceinline__ void sg_item(Frame& F, int item, int& gcur, const v4u (&v)[4], const v4u (&u)[4], const unsigned long long (&st)[2]) {
    typedef short bf16x8 __attribute__((ext_vector_type(8))); typedef float f32x16 __attribute__((ext_vector_type(16)));
    bf16* GT = (bf16*)(F.ws + WS_O);
    constexpr int PT = 136;
    LAS bf16* Wc = (LAS bf16*)(F.lds + RING_OFF);
    LAS bf16* vnT = Wc + 128 * PT;
    LAS float* rstat = (LAS float*)(F.lds + RING_OFF + 2 * 128 * PT * 2);
    const int lane = LANE_ID(), tid = F.wave * 64 + lane, r32 = lane & 31, hi = lane >> 5, tb = F.wave >> 1, dh = F.wave & 1;
    const int g = item & 31, r0 = (item >> 5) * 128, d8 = (tid & 15) * 8, col = g * 128 + d8;
    if (g != gcur) {
        for (int idx = tid; idx < 128 * 32; idx += 512) { const int t = idx >> 5, s4 = (idx & 31) * 4;
            const f32x4 w = *(const f32x4*)(F.sg_w_s + (size_t)g * 16384 + t * 128 + s4);
            v2u o; o.x = pk2(s4 <= t ? w[0] : 0.f, s4 + 1 <= t ? w[1] : 0.f); o.y = pk2(s4 + 2 <= t ? w[2] : 0.f, s4 + 3 <= t ? w[3] : 0.f);
            *(LAS v2u*)(Wc + t * PT + s4) = o; }
        gcur = g;
    }
    float gn[8], bs[8];
#pragma unroll
    for (int e = 0; e < 8; ++e) { gn[e] = F.sg_v_gain[col + e]; bs[e] = F.sg_v_bias[col + e]; }
    if (tid < 128) { const float s1 = pg8::unfx20(st[0]), s2 = pg8::unfx20(st[1]);
        const float mean = s1 * (1.0f / 4096.0f), var = s2 * (1.0f / 4096.0f) - mean * mean;
        rstat[2 * tid] = mean; rstat[2 * tid + 1] = 1.0f / sqrtf(var + NORM_EPS); }
    __syncthreads();
#pragma unroll
    for (int k = 0; k < 4; ++k) { const int s = (tid >> 4) + 32 * k;
        float v8[8]; unpack8(v[k], v8);
        const float mean = rstat[2 * s], rstd = rstat[2 * s + 1];
#pragma unroll
        for (int e = 0; e < 8; ++e) vnT[(d8 + e) * PT + s] = (bf16)f2bf((v8[e] - mean) * rstd * gn[e] + bs[e]); }
    __syncthreads();
    f32x16 acc0 = {}, acc1 = {};
    const LAS bf16* ap = Wc + (32 * tb + r32) * PT + 8 * hi;
    const LAS bf16* bp0 = vnT + (64 * dh + r32) * PT + 8 * hi, * bp1 = bp0 + 32 * PT;
    for (int ks = 0; ks < 2 * tb + 2; ++ks) {
        const bf16x8 a = *(const LAS bf16x8*)(ap + 16 * ks), b0 = *(const LAS bf16x8*)(bp0 + 16 * ks), b1 = *(const LAS bf16x8*)(bp1 + 16 * ks);
        acc0 = __builtin_amdgcn_mfma_f32_32x32x16_bf16(a, b0, acc0, 0, 0, 0);
        acc1 = __builtin_amdgcn_mfma_f32_32x32x16_bf16(a, b1, acc1, 0, 0, 0);
    }
    __syncthreads();
    LAS float* ft = (LAS float*)(vnT);
#pragma unroll
    for (int i = 0; i < 16; ++i) {
        const int t = 32 * tb + (i & 3) + 8 * (i >> 2) + 4 * hi;
        const float bsv = F.sg_b_s[g * 128 + t];
        ft[t * 132 + 64 * dh + r32] = acc0[i] + bsv;
        ft[t * 132 + 64 * dh + 32 + r32] = acc1[i] + bsv;
    }
    __syncthreads();
#pragma unroll
    for (int k = 0; k < 4; ++k) {
        const int t = (tid >> 4) + 32 * k; const size_t o = (size_t)(r0 + t) * DM + col;
        float u8[8]; unpack8(u[k], u8);
        const f32x4 f0 = *(const LAS f32x4*)(ft + t * 132 + d8), f1 = *(const LAS f32x4*)(ft + t * 132 + d8 + 4);
        v4u w; w.x = pk2(u8[0] * f0[0], u8[1] * f0[1]); w.y = pk2(u8[2] * f0[2], u8[3] * f0[3]); w.z = pk2(u8[4] * f1[0], u8[5] * f1[1]); w.w = pk2(u8[6] * f1[2], u8[7] * f1[3]);
        *(v4u*)(GT + o) = w;
    }
    __syncthreads();
}
__device__ __forceinline__ void p_sgate(Frame& F) {
    constexpr int NIT = 64 * 32;
    v4u vA[4], uA[4], vB[4], uB[4]; unsigned long long sA[2], sB[2];
    int gcur = -1, item = blockIdx.x;
    if (item < NIT) sg_prefetch(F, item, vA, uA, sA);
    while (item < NIT) {
        const int item2 = item + F.G;
        if (item2 < NIT) sg_prefetch(F, item2, vB, uB, sB);
        sg_item(F, item, gcur, vA, uA, sA);
        if (item2 >= NIT) break;
        item = item2 + F.G;
        if (item < NIT) sg_prefetch(F, item, vA, uA, sA);
        sg_item(F, item2, gcur, vB, uB, sB);
    }
}
#ifdef PROBE_RES
constexpr int N_PHASES = 19;
#else
constexpr int N_PHASES = 18;
#endif
struct Args { const void* in[19]; float* out; unsigned char* ws; int ph_lo, ph_hi, li, pad; };
__global__ void __launch_bounds__(NWAVES * 64, 2) mk_fwd(Args args) {
    extern __shared__ __attribute__((aligned(16))) unsigned char lds[];
    Frame F;
    F.lds = (LAS unsigned char*)lds;
    F.MISC = (volatile LAS unsigned*)(F.lds + MISC_OFF);
    F.wave = __builtin_amdgcn_readfirstlane((int)threadIdx.x >> 6);
    F.G = gridDim.x; F.gw = blockIdx.x * NWAVES + F.wave; F.NGW = F.G * NWAVES;
    F.ws = args.ws; F.ctl = (unsigned*)(args.ws + WS_CTL);
    F.x = (const float*)args.in[0]; F.pos = (const int*)args.in[1];
    F.attn_norm = (const float*)args.in[2]; F.attn_w_in = (const float*)args.in[3]; F.attn_w_out = (const float*)args.in[4];
    F.sg_norm = (const float*)args.in[5]; F.sg_w_in = (const float*)args.in[6]; F.sg_b_in = (const float*)args.in[7]; F.sg_v_gain = (const float*)args.in[8]; F.sg_v_bias = (const float*)args.in[9];
    F.sg_w_s = (const float*)args.in[10]; F.sg_b_s = (const float*)args.in[11]; F.sg_w_out = (const float*)args.in[12];
    F.ffn_norm = (const float*)args.in[13]; F.ffn_w_up = (const float*)args.in[14]; F.ffn_conv_w = (const float*)args.in[15]; F.ffn_conv_b = (const float*)args.in[16]; F.ffn_w_down = (const float*)args.in[17];
    F.final_norm = (const float*)args.in[18]; F.out = args.out;
    for (int u = (int)threadIdx.x; u < (XTRA_OFF - LDSCTL_OFF) / 4; u += NWAVES * 64) ((LAS unsigned*)(F.lds + LDSCTL_OFF))[u] = 0u;
#ifdef DIAG_LDSZERO
    for (int u = (int)threadIdx.x; u < LDS_BYTES / 4; u += NWAVES * 64) ((LAS unsigned*)(F.lds))[u] = 0u;
#endif
    __syncthreads();
    const int lo = args.ph_lo, hi = args.ph_hi;
    XcdBarrier bar; bar.bar = F.ctl + CW_BAR + args.li * XCD_BAR_WORDS; bar.x = 0; bar.st = nullptr;
    if (hi - lo > 1) bar = xcd_barrier_post(F.ctl + CW_BAR + args.li * XCD_BAR_WORDS, F.MISC + 8);
#define IN(k) (lo <= (k) && (k) < hi)
#ifdef PROBE_SUM
    unsigned long long pt_acc = 0ull, pt_t0 = wall_clock64();
#define SEAM(k) do { if (IN(k) && IN((k) + 1)) xcd_barrier(bar); { const unsigned long long t_ = wall_clock64(); if ((PROBE_SUM >> (k)) & 1) pt_acc += t_ - pt_t0; pt_t0 = t_; } } while (0)
#elif defined(PROBE_IDLE)
    unsigned long long idle_acc = 0ull;
#define SEAM(k) do { if (IN(k) && IN((k) + 1)) { const unsigned long long tb_ = wall_clock64(); xcd_barrier(bar); if ((PROBE_IDLE >> (k)) & 1) idle_acc += wall_clock64() - tb_; } } while (0)
#else
#define SEAM(k) do { if (IN(k) && IN((k) + 1)) xcd_barrier(bar); } while (0)
#endif
    unsigned char* ws = args.ws;
    bf16* H = (bf16*)(ws + WS_XB); bf16* O = (bf16*)(ws + WS_O); bf16* Gb = (bf16*)(ws + WS_G); bf16* AP = (bf16*)(ws + WS_APRE);
    float* SS = (float*)(ws + WS_SSQ); constexpr size_t SSF = SSQ_SITE / 4;
    const int c = (int)blockIdx.x;

    if (IN(0)) {
        p0_prologue(F);
        p0_strips<0>(F);
    } SEAM(0);
    if (IN(2)) {
        pg8::Gemm g{(const bf16*)(ws + WS_HQ8), (const bf16*)(ws + WS_WIN8), MR, QKVC, DM / 2}; pg8::StaticOrder S; S.init(MR, QKVC, F.G, c);
        pg8::EpiQKV8 E{(bf16*)(ws + WS_QKV), SS, (const float*)(ws + WS_ROPE), (const float*)(ws + WS_ROPE) + MR * 16, (float*)(ws + WS_KMEAN), (const float*)(ws + WS_SAH), (const float*)(ws + WS_SW) + AM_WIN};
        pg8::gemm_phase<pg8::EpiQKV8, pg8::StaticOrder, PG8_ALIGN, PG8_SP2>(F.lds + RING_OFF, g, S, E, F.wave);
    } SEAM(2);
    if (IN(3)) { p_attn(F, (char*)lds + RING_OFF); } SEAM(3);
    if (IN(4)) { p_dilmerge(F);
#ifdef CHECK_ATTN
        xcd_barrier(bar); p_attn_naive(F, AP); xcd_barrier(bar);
        { unsigned bad = 0; const signed char* OQc = (const signed char*)(ws + WS_OQ8); const float* SAc = (const float*)(ws + WS_SAO);
          for (size_t idx = (size_t)blockIdx.x * 512 + (F.wave * 64 + LANE_ID()); idx < (size_t)MR * DM; idx += (size_t)F.G * 512) { const int col = (int)(idx & 4095); const size_t row = idx >> 12;
            const float b = bf1(AP[idx]), sc = SAc[row], a = col < 3072 ? bf1(O[idx]) : (float)OQc[idx] * sc;
            if (!(fabsf(a - b) <= 0.004f + 0.03f * fabsf(b) + (col < 3072 ? 0.f : sc))) ++bad; }
          if (bad) atomicAdd(F.ctl + 8, bad); }
#endif
    } SEAM(4);
    if (IN(5)) {
        pg8::Gemm g{(const bf16*)(ws + WS_OQ8), (const bf16*)(ws + WS_WOUT8), MR, DM, DM / 2}; pg8::StaticOrder S; S.init(MR, DM, F.G, c);
        pg8::EpiResX8 E{F.x, H, SS + 1 * SSF, (const float*)(ws + WS_SAO), (const float*)(ws + WS_SW) + AM_WOUT};
        pg8::gemm_phase<pg8::EpiResX8, pg8::StaticOrder, PG8_ALIGN, PG8_SP2>(F.lds + RING_OFF, g, S, E, F.wave);
    } SEAM(5);
    if (IN(6)) { quant_stream_rows(F, H, (signed char*)(ws + WS_HQ8), (float*)(ws + WS_SAH), SS + 1 * SSF); } SEAM(6);
    if (IN(7)) {
        pg8::Gemm g{(const bf16*)(ws + WS_HQ8), (const bf16*)(ws + WS_WUP8), MR, F2, DM / 2}; pg8::StaticOrder S; S.init(MR, F2, F.G, c);
        pg8::EpiUpConv8 E{Gb, SS + 1 * SSF, F.ffn_conv_w, F.ffn_conv_b, (float*)(ws + WS_TOP), (float*)(ws + WS_BOT), (LAS float*)(F.lds + XTRA_OFF), (const float*)(ws + WS_SAH), (const float*)(ws + WS_SW) + AM_WUP};
        pg8::gemm_phase<pg8::EpiUpConv8, pg8::StaticOrder, true, PG8_SP2>(F.lds + RING_OFF, g, S, E, F.wave);
    } SEAM(7);
    if (IN(8)) { p_convfix(F, 0); } SEAM(8);
    if (IN(9)) {
        pg8::Gemm g{Gb, (const bf16*)(ws + WS_WDOWN), MR, DM, DFF}; pg8::StaticOrder S; S.init(MR, DM, F.G, c);
        pg8::EpiRes E{H, H, (float*)(ws + WS_SSX), nullptr, nullptr};
        pg8::gemm_phase<pg8::EpiRes, pg8::StaticOrder, PG8_ALIGN, PG8_SP2>(F.lds + RING_OFF, g, S, E, F.wave);
    } SEAM(9);
    if (IN(10)) {
        pg8::Gemm g{H, (const bf16*)(ws + WS_SGWIN), MR, 2 * DM, DM}; pg8::StaticOrder S; S.init(MR, 2 * DM, F.G, c);
        pg8::EpiSgIn E{(bf16*)(ws + WS_U), (bf16*)(ws + WS_V), (const float*)(ws + WS_SSX), F.sg_b_in, (float*)(ws + WS_VSX)};
        pg8::gemm_phase<pg8::EpiSgIn, pg8::StaticOrder, PG8_ALIGN, PG8_SP2>(F.lds + RING_OFF, g, S, E, F.wave);
    } SEAM(10);
    if (IN(11)) { p_sgate(F); } SEAM(11);
    if (IN(12)) {
        pg8::Gemm g{O, (const bf16*)(ws + WS_SGWOUT), MR, DM, DM}; pg8::StaticOrder S; S.init(MR, DM, F.G, c);
        pg8::EpiResNX E{H, H, nullptr, nullptr, nullptr};
        pg8::gemm_phase<pg8::EpiResNX, pg8::StaticOrder, PG8_ALIGN, PG8_SP2>(F.lds + RING_OFF, g, S, E, F.wave);
    } SEAM(12);
    if (IN(13)) { quant_stream_rows(F, H, (signed char*)(ws + WS_HQ8), (float*)(ws + WS_SAH), SS + 3 * SSF); } SEAM(13);
    if (IN(14)) {
        pg8::Gemm g{(const bf16*)(ws + WS_HQ8), (const bf16*)(ws + WS_WUP8 + WUP8_L), MR, F2, DM / 2}; pg8::StaticOrder S; S.init(MR, F2, F.G, c);
        pg8::EpiUpConv8 E{Gb, SS + 3 * SSF, F.ffn_conv_w + 3 * F2, F.ffn_conv_b + F2, (float*)(ws + WS_TOP), (float*)(ws + WS_BOT), (LAS float*)(F.lds + XTRA_OFF), (const float*)(ws + WS_SAH), (const float*)(ws + WS_SW) + AM_WUP + F2};
        pg8::gemm_phase<pg8::EpiUpConv8, pg8::StaticOrder, true, PG8_SP2>(F.lds + RING_OFF, g, S, E, F.wave);
    } SEAM(14);
    if (IN(15)) { p_convfix(F, 1); } SEAM(15);
    if (IN(16)) {
        pg8::Gemm g{Gb, (const bf16*)(ws + WS_WDOWN + WDOWN_L), MR, DM, DFF}; pg8::StaticOrder S; S.init(MR, DM, F.G, c);
        pg8::EpiResNX E{H, H, nullptr, nullptr, nullptr};
        pg8::gemm_phase<pg8::EpiResNX, pg8::StaticOrder, PG8_ALIGN, PG8_SP2>(F.lds + RING_OFF, g, S, E, F.wave);
    } SEAM(16);
#ifdef PROBE_BAR
    if (hi - lo > 1) for (int i = 0; i < PROBE_BAR; ++i) xcd_barrier(bar);
#endif
    if (IN(17)) { p_final(F); }
#ifdef PROBE_SUM
    { const unsigned long long t_ = wall_clock64(); if ((PROBE_SUM >> 17) & 1) pt_acc += t_ - pt_t0;
      if (blockIdx.x == 0 && (F.wave * 64 + LANE_ID()) == 0) { const unsigned long long w1 = wall_clock64(); while (wall_clock64() - w1 < pt_acc) __builtin_amdgcn_s_sleep(8); } }
#endif
#ifdef PROBE_IDLE
    if (hi - lo > 1) {
        if ((F.wave * 64 + LANE_ID()) == 0) atomicAdd((unsigned long long*)(F.ctl + 16), idle_acc);
        xcd_barrier(bar);
        if (blockIdx.x == 0 && (F.wave * 64 + LANE_ID()) == 0) { const unsigned long long tot = __hip_atomic_load((unsigned long long*)(F.ctl + 16), __ATOMIC_RELAXED, __HIP_MEMORY_SCOPE_AGENT);
            const unsigned long long span = tot / F.G * PROBE_AMP; const unsigned long long w1 = wall_clock64(); while (wall_clock64() - w1 < span) __builtin_amdgcn_s_sleep(8); }
    }
#endif
#ifdef PROBE_RES
    if (IN(18)) {
#if PROBE_RES == 1
        pg8::Gemm g{Gb, (const bf16*)(ws + WS_WDOWN), MR, DM, DFF};
#else
        pg8::Gemm g{O, (const bf16*)(ws + WS_WOUT), MR, DM, DM};
#endif
        pg8::StaticOrder S; S.init(MR, DM, F.G, c);
        pg8::EpiRes E{H, (bf16*)(ws + WS_APRE), (float*)(ws + WS_APRE + 256 * MiB), nullptr, nullptr};
        pg8::gemm_phase<pg8::EpiRes, pg8::StaticOrder, PG8_ALIGN, PG8_SP2>(F.lds + RING_OFF, g, S, E, F.wave);
    }
#endif
#undef IN
#undef SEAM
}

extern "C" void kernel_launch(void* const* d_in, const int* in_sizes, int n_in, void* d_out, int out_size, void* d_ws, size_t ws_size, hipStream_t stream) {
    static int grid = 0;
    if (grid == 0) {
        if (n_in != 19 || out_size != MR * DM || ws_size < WS_END) { fprintf(stderr, "kernel_launch: unexpected shapes (n_in %d, out %d, ws %zu); nothing launched\n", n_in, out_size, ws_size); grid = -1; return; }
        int dev = 0, cus = 0, per_cu = 0;
        if (hipGetDevice(&dev) != hipSuccess || hipDeviceGetAttribute(&cus, hipDeviceAttributeMultiprocessorCount, dev) != hipSuccess) { grid = -1; return; }
        if (hipFuncSetAttribute((const void*)mk_fwd, hipFuncAttributeMaxDynamicSharedMemorySize, LDS_BYTES) != hipSuccess) { fprintf(stderr, "kernel_launch: hipFuncSetAttribute failed\n"); grid = -1; return; }
        if (hipOccupancyMaxActiveBlocksPerMultiprocessor(&per_cu, (const void*)mk_fwd, NWAVES * 64, LDS_BYTES) != hipSuccess || per_cu < 1) fprintf(stderr, "kernel_launch: occupancy query reports %d\n", per_cu);
        (void)hipGetLastError();
        grid = cus;
    }
    if (grid < 0) return;
    if (hipMemsetAsync((char*)d_ws + WS_CTL, 0, CTL_ZERO_BYTES, stream) != hipSuccess) return;
#ifdef DIAG_POISON
    (void)hipMemsetAsync((char*)d_ws + DIAG_POISON_LO, 0xAA, DIAG_POISON_HI - DIAG_POISON_LO, stream);
#endif
    Args a{};
    for (int i = 0; i < 19; ++i) a.in[i] = d_in[i];
    a.out = (float*)d_out; a.ws = (unsigned char*)d_ws; a.pad = 0;
    if (MK_N_LAUNCHES == 1) {
        a.ph_lo = 0; a.ph_hi = N_PHASES; a.li = 0;
        hipLaunchKernelGGL(mk_fwd, dim3(grid), dim3(NWAVES * 64), LDS_BYTES, stream, a);
    } else {
        for (int p = 0; p < N_PHASES; ++p) { a.ph_lo = p; a.ph_hi = p + 1; a.li = 0; hipLaunchKernelGGL(mk_fwd, dim3(grid), dim3(NWAVES * 64), LDS_BYTES, stream, a);
#ifdef PROBE_MASK
            if ((PROBE_MASK >> p) & 1) hipLaunchKernelGGL(mk_fwd, dim3(grid), dim3(NWAVES * 64), LDS_BYTES, stream, a);
#endif
        }
    }
}
```
